# Optimizing an MI355X kernel written in HIP

```python
import math
import jax
import jax.numpy as jnp
from jax import lax
import numpy as np

D_MODEL = 1024
BATCH = 2
SEQ = 8192
DEPTH = 2

GRID_W = 64
CTX_LEN = 256
N_BRANCH = 4
BRANCH_W = D_MODEL // 4
N_HEADS = 4
HEAD_DIM = BRANCH_W // N_HEADS
GLA_RANK = 16
GLA_NORMALIZER = 16.0
CHUNK = 64
CONV_W = 5
DIFF_QK = HEAD_DIM // 2
ROPE_AXIS = DIFF_QK // 2
ROPE_BASE = 10000.0
ATTN_BLOCK = 128
N_EXPERTS = 16
N_GROUPS = 4
EXPERTS_PER_GROUP = N_EXPERTS // N_GROUPS
TOP_K = 2
D_EXPERT = 512
EPS = 1e-6

IN_SIZES = (
    BRANCH_W, BRANCH_W, BRANCH_W, BRANCH_W, GLA_RANK, GLA_RANK,
    BRANCH_W, BRANCH_W, BRANCH_W, BRANCH_W, 2 * N_HEADS, 2 * N_HEADS,
    BRANCH_W, BRANCH_W, BRANCH_W, BRANCH_W, 2 * N_HEADS, 2 * N_HEADS,
    BRANCH_W, BRANCH_W, BRANCH_W,
    N_BRANCH * D_MODEL,
)
IN_COLS = sum(IN_SIZES)

kernel_name = 'hybrid_gla_mlstm_gdn_diffattn_grouped_moe'


def _split_cols(p):
    return jnp.split(p, [int(o) for o in np.cumsum(IN_SIZES)[:-1]], axis=-1)


def _rms(x, g):
    xf = x.astype(jnp.float32)
    y = xf * lax.rsqrt(jnp.mean(xf * xf, axis=-1, keepdims=True) + EPS)
    return (y * g.astype(jnp.float32)).astype(x.dtype)


def _heads(t):
    b, n, w = t.shape
    return t.reshape(b, n, N_HEADS, w // N_HEADS).transpose(0, 2, 1, 3)


def _gate_heads(t):
    return jnp.swapaxes(t, 1, 2)


def _merge_heads(o):
    b, h, n, d = o.shape
    return o.transpose(0, 2, 1, 3).reshape(b, n, h * d)


def _head_norm(y, g):
    b, n, w = y.shape
    yh = y.reshape(b, n, N_HEADS, w // N_HEADS)
    yh = yh * lax.rsqrt(jnp.mean(yh * yh, axis=-1, keepdims=True) + EPS)
    return yh.reshape(b, n, w) * g.astype(jnp.float32)


def _l2(t):
    return t * lax.rsqrt(jnp.sum(t * t, axis=-1, keepdims=True) + EPS)


def _conv_centred(x, w):
    ch = x.shape[-1]
    return lax.conv_general_dilated(
        x, w[:, None, :].astype(x.dtype), window_strides=(1,),
        padding=((CONV_W // 2, CONV_W // 2),),
        dimension_numbers=('NWC', 'WIO', 'NWC'), feature_group_count=ch)


def _axial_rope_tables(row, col):
    inv = ROPE_BASE ** (-jnp.arange(0, ROPE_AXIS, 2, dtype=jnp.float32) / ROPE_AXIS)
    ang = jnp.concatenate([row.astype(jnp.float32)[:, None] * inv,
                           col.astype(jnp.float32)[:, None] * inv], axis=-1)
    return jnp.cos(ang), jnp.sin(ang)


def _rope(x, cos, sin):
    x1, x2 = jnp.split(x, 2, axis=-1)
    return jnp.concatenate([x1 * cos - x2 * sin, x1 * sin + x2 * cos], axis=-1)


def _bidirectional(scan_fn, s0, lat_f, ctx_f, lat_b, ctx_b):
    rev = lambda ts: tuple(jnp.flip(t, axis=2) for t in ts)
    oc_f, sc_f = scan_fn(*ctx_f, s0)
    o_f, _ = scan_fn(*lat_f, sc_f)
    oc_b, sc_b = scan_fn(*rev(ctx_b), s0)
    o_b, _ = scan_fn(*rev(lat_b), sc_b)
    return o_f + jnp.flip(o_b, axis=2), oc_f + jnp.flip(oc_b, axis=2)


def _gla_chunked(q, k, v, log_a, s0):
    b, h, n, dk = q.shape
    dv = v.shape[-1]
    nc = n // CHUNK
    q, k, log_a = (t.reshape(b, h, nc, CHUNK, dk) for t in (q, k, log_a))
    v = v.reshape(b, h, nc, CHUNK, dv)
    tril = jnp.tril(jnp.ones((CHUNK, CHUNK), dtype=bool))
    cum = jnp.cumsum(log_a, axis=3)
    cum_end = cum[:, :, :, -1:, :]
    q_in = q * jnp.exp(cum)
    att = jnp.einsum('bhncd,bhnsd->bhncs', q_in, k * jnp.exp(-cum))
    att = jnp.where(tril, att, 0.0)
    kv = jnp.einsum('bhnsd,bhnse->bhnde', k * jnp.exp(cum_end - cum), v)
    decay = jnp.exp(cum_end[:, :, :, 0, :])

    def step(s, xs):
        dec, kv_n = xs
        return dec[..., None] * s + kv_n, s

    s_fin, s_in = lax.scan(step, s0, (jnp.moveaxis(decay, 2, 0), jnp.moveaxis(kv, 2, 0)))
    s_in = jnp.moveaxis(s_in, 0, 2)
    o = jnp.einsum('bhncs,bhnse->bhnce', att, v) + jnp.einsum('bhncd,bhnde->bhnce', q_in, s_in)
    return o.reshape(b, h, n, dv), s_fin


def _gla_branch(cols, cols_c, a2, a_bias, norm_g, with_ctx):
    def prep(cs):
        q, k, v, g, r_f, r_b = (t.astype(jnp.float32) for t in cs)
        la_f = jax.nn.log_sigmoid(r_f @ a2[0] + a_bias[0]) / GLA_NORMALIZER
        la_b = jax.nn.log_sigmoid(r_b @ a2[1] + a_bias[1]) / GLA_NORMALIZER
        qkv = (_heads(q) * HEAD_DIM ** -0.5, _heads(k), _heads(v))
        return qkv + (_heads(la_f),), qkv + (_heads(la_b),), g

    lat_f, lat_b, g = prep(cols)
    ctx_f, ctx_b, g_c = prep(cols_c)
    s0 = jnp.zeros((g.shape[0], N_HEADS, HEAD_DIM, HEAD_DIM), jnp.float32)
    o, o_c = _bidirectional(_gla_chunked, s0, lat_f, ctx_f, lat_b, ctx_b)
    out = lambda oo, gg: _head_norm(_merge_heads(oo), norm_g) * jax.nn.silu(gg)
    return out(o, g), (out(o_c, g_c) if with_ctx else None)


def _mlstm_chunked(q, k, v, i_pre, log_f, state):
    b, h, n, dk = q.shape
    dv = v.shape[-1]
    nc = n // CHUNK
    q, k = (t.reshape(b, h, nc, CHUNK, dk) for t in (q, k))
    v = v.reshape(b, h, nc, CHUNK, dv)
    i_pre, log_f = (t.reshape(b, h, nc, CHUNK) for t in (i_pre, log_f))
    tril = jnp.tril(jnp.ones((CHUNK, CHUNK), dtype=bool))
    f_cum = jnp.cumsum(log_f, axis=-1)
    f_end = f_cum[..., -1]
    log_w_end = f_end[..., None] - f_cum + i_pre
    a_end = jnp.max(log_w_end, axis=-1)
    w_end = jnp.exp(log_w_end - a_end[..., None])
    kv = jnp.einsum('bhns,bhnsd,bhnse->bhnde', w_end, k, v)
    k_sum = jnp.einsum('bhns,bhnsd->bhnd', w_end, k)

    def step(carry, xs):
        c_mat, n_vec, m = carry
        fe, ae, kv_n, ks_n = xs
        m_new = jnp.maximum(fe + m, ae)
        old = jnp.exp(fe + m - m_new)
        new = jnp.exp(ae - m_new)
        c_new = old[..., None, None] * c_mat + new[..., None, None] * kv_n
        n_new = old[..., None] * n_vec + new[..., None] * ks_n
        return (c_new, n_new, m_new), carry

    xs = tuple(jnp.moveaxis(t, 2, 0) for t in (f_end, a_end, kv, k_sum))
    final, (c_in, n_in, m_in) = lax.scan(step, state, xs)
    c_in, n_in, m_in = (jnp.moveaxis(t, 0, 2) for t in (c_in, n_in, m_in))
    log_d = jnp.where(tril, f_cum[..., :, None] - f_cum[..., None, :] + i_pre[..., None, :], -jnp.inf)
    g = f_cum + m_in[..., None]
    m = jnp.maximum(g, jnp.max(log_d, axis=-1))
    s = jnp.einsum('bhncd,bhnsd->bhncs', q, k) * jnp.exp(log_d - m[..., None])
    e = jnp.exp(g - m)
    num = jnp.einsum('bhncs,bhnse->bhnce', s, v) + e[..., None] * jnp.einsum('bhncd,bhnde->bhnce', q, c_in)
    den = jnp.sum(s, axis=-1) + e * jnp.einsum('bhncd,bhnd->bhnc', q, n_in)
    hid = num / jnp.maximum(jnp.abs(den), jnp.exp(-m))[..., None]
    return hid.reshape(b, h, n, dv), final


def _mlstm_branch(cols, cols_c, gate_b, norm_g, with_ctx):
    def prep(cs):
        q, k, v, o, g_f, g_b = (t.astype(jnp.float32) for t in cs)
        qkv = (_heads(q), _heads(k) * HEAD_DIM ** -0.5, _heads(v))

        def gates(gp, bias):
            i_p, f_p = jnp.split(gp, 2, axis=-1)
            return (_gate_heads(i_p + bias[0]), _gate_heads(jax.nn.log_sigmoid(f_p + bias[1])))

        return qkv + gates(g_f, gate_b[0]), qkv + gates(g_b, gate_b[1]), o

    lat_f, lat_b, o_g = prep(cols)
    ctx_f, ctx_b, o_gc = prep(cols_c)
    bsz = o_g.shape[0]
    s0 = (jnp.zeros((bsz, N_HEADS, HEAD_DIM, HEAD_DIM), jnp.float32),
          jnp.zeros((bsz, N_HEADS, HEAD_DIM), jnp.float32),
          jnp.zeros((bsz, N_HEADS), jnp.float32))
    o, o_c = _bidirectional(_mlstm_chunked, s0, lat_f, ctx_f, lat_b, ctx_b)
    out = lambda oo, gg: _head_norm(_merge_heads(oo), norm_g) * jax.nn.sigmoid(gg)
    return out(o, o_g), (out(o_c, o_gc) if with_ctx else None)


def _gdn_chunked(q, k, v, beta, g, s0):
    b, h, n, dk = q.shape
    dv = v.shape[-1]
    nc = n // CHUNK
    q, k = (t.reshape(b, h, nc, CHUNK, dk) for t in (q, k))
    v = v.reshape(b, h, nc, CHUNK, dv)
    beta, g = (t.reshape(b, h, nc, CHUNK) for t in (beta, g))
    tril = jnp.tril(jnp.ones((CHUNK, CHUNK), dtype=bool))
    strict = jnp.tril(jnp.ones((CHUNK, CHUNK), dtype=bool), -1)
    cum = jnp.cumsum(g, axis=-1)
    cum_end = cum[..., -1]
    gam = jnp.exp(jnp.where(tril, cum[..., :, None] - cum[..., None, :], -jnp.inf))
    k_beta = k * beta[..., None]
    v_beta = v * beta[..., None]
    a_mat = jnp.where(strict, jnp.einsum('bhncd,bhnsd->bhncs', k_beta, k) * gam, 0.0)
    a_mat = a_mat + jnp.eye(CHUNK, dtype=a_mat.dtype)
    rhs = jnp.concatenate([k_beta * jnp.exp(cum)[..., None], v_beta], axis=-1)
    sol = lax.linalg.triangular_solve(a_mat, rhs, left_side=True, lower=True, unit_diagonal=True)
    w, u = sol[..., :dk], sol[..., dk:]
    attn = jnp.einsum('bhncd,bhnsd->bhncs', q, k) * gam
    q_dec = q * jnp.exp(cum)[..., None]
    k_end = k * jnp.exp(cum_end[..., None] - cum)[..., None]
    dec_end = jnp.exp(cum_end)

    def step(s, xs):
        at_n, w_n, u_n, qd_n, ke_n, de_n = xs
        v_new = u_n - jnp.einsum('bhcd,bhde->bhce', w_n, s)
        o_n = jnp.einsum('bhcd,bhde->bhce', qd_n, s) + jnp.einsum('bhcs,bhse->bhce', at_n, v_new)
        s = de_n[..., None, None] * s + jnp.einsum('bhsd,bhse->bhde', ke_n, v_new)
        return s, o_n

    xs = tuple(jnp.moveaxis(t, 2, 0) for t in (attn, w, u, q_dec, k_end, dec_end))
    s_fin, o = lax.scan(step, s0, xs)
    return jnp.moveaxis(o, 0, 2).reshape(b, h, n, dv), s_fin


def _gdn_branch(cols, cols_c, conv_w, a_log, dt_bias, norm_g, with_ctx):
    def prep(cs):
        q, k, v, og, g_f, g_b = (t.astype(jnp.float32) for t in cs)
        qkv = jax.nn.silu(_conv_centred(jnp.concatenate([q, k, v], axis=-1), conv_w))
        q, k, v = jnp.split(qkv, 3, axis=-1)
        qkv = (_l2(_heads(q)) * HEAD_DIM ** -0.5, _l2(_heads(k)), _heads(v))

        def gates(gp, d):
            b_p, a_p = jnp.split(gp, 2, axis=-1)
            decay = -jnp.exp(a_log[d]) * jax.nn.softplus(a_p + dt_bias[d])
            return (_gate_heads(jax.nn.sigmoid(b_p)), _gate_heads(decay))

        return qkv + gates(g_f, 0), qkv + gates(g_b, 1), og

    lat_f, lat_b, og = prep(cols)
    ctx_f, ctx_b, og_c = prep(cols_c)
    s0 = jnp.zeros((og.shape[0], N_HEADS, HEAD_DIM, HEAD_DIM), jnp.float32)
    o, o_c = _bidirectional(_gdn_chunked, s0, lat_f, ctx_f, lat_b, ctx_b)
    out = lambda oo, gg: _head_norm(_merge_heads(oo), norm_g) * jax.nn.silu(gg)
    return out(o, og), (out(o_c, og_c) if with_ctx else None)


def _diff_branch(cols, cols_c, cos, sin, lam_p, norm_g, lam_init, with_ctx):
    halves = lambda t: t.reshape(*t.shape[:-1], 2, DIFF_QK)
    q, k, v = (_heads(t.astype(jnp.float32)) for t in cols)
    qc, kc, vc = (_heads(t.astype(jnp.float32)) for t in cols_c)
    q = _rope(halves(q), cos[:, None], sin[:, None])
    k = _rope(halves(k), cos[:, None], sin[:, None])
    qc, kc = halves(qc), halves(kc)
    lp = lam_p.astype(jnp.float32)
    lam = jnp.exp(jnp.sum(lp[0] * lp[1], -1)) - jnp.exp(jnp.sum(lp[2] * lp[3], -1)) + lam_init
    lam = lam[None, :, None, None]
    scale = DIFF_QK ** -0.5

    def attend(qb, keys, vals):
        s = jnp.einsum('bhqid,bhkid->ibhqk', qb, keys) * scale
        p = jax.nn.softmax(s, axis=-1)
        return jnp.einsum('bhqk,bhkd->bhqd', p[0] - lam * p[1], vals)

    k_all = jnp.concatenate([kc, k], axis=2)
    v_all = jnp.concatenate([vc, v], axis=2)
    b, h, n = q.shape[:3]
    qb = jnp.moveaxis(q.reshape(b, h, n // ATTN_BLOCK, ATTN_BLOCK, 2, DIFF_QK), 2, 0)
    o = lax.map(lambda blk: attend(blk, k_all, v_all), qb)
    o = jnp.moveaxis(o, 0, 2).reshape(b, h, n, HEAD_DIM)
    out = lambda oo: _head_norm(_merge_heads(oo), norm_g) * (1.0 - lam_init)
    return out(o), (out(attend(qc, kc, vc)) if with_ctx else None)


def _merge(branches, gate_cols, w_branch, w_out, dtype):
    gates = jnp.split(jax.nn.sigmoid(gate_cols.astype(jnp.float32)), N_BRANCH, axis=-1)
    terms = [gt * (yb.astype(dtype) @ w_branch[i]) for i, (gt, yb) in enumerate(zip(gates, branches))]
    acc = terms[0]
    for t in terms[1:]:
        acc = acc + t
    return acc.astype(dtype) @ w_out


def _moe(h, router_w, router_b, w_gate, w_up, w_down):
    lead = h.shape[:-1]
    scores = jax.nn.sigmoid((h @ router_w).astype(jnp.float32))
    sel = scores + router_b.astype(jnp.float32)
    grp = sel.reshape(*lead, N_GROUPS, EXPERTS_PER_GROUP)
    grp_score = jnp.sum(lax.top_k(grp, 2)[0], axis=-1)
    _, g_idx = lax.top_k(grp_score, 1)
    e_mask = jnp.repeat(jax.nn.one_hot(g_idx[..., 0], N_GROUPS, dtype=jnp.bool_), EXPERTS_PER_GROUP, axis=-1)
    _, e_idx = lax.top_k(jnp.where(e_mask, sel, -jnp.inf), TOP_K)
    w_sel = jnp.take_along_axis(scores, e_idx, axis=-1)
    w_sel = w_sel / jnp.sum(w_sel, axis=-1, keepdims=True)
    gates = jnp.sum(jax.nn.one_hot(e_idx, N_EXPERTS, dtype=jnp.float32) * w_sel[..., None], axis=-2)
    gates = gates.astype(h.dtype)
    out = gates[..., 0:1] * ((jax.nn.silu(h @ w_gate[0]) * (h @ w_up[0])) @ w_down[0])
    for e in range(1, N_EXPERTS):
        out = out + gates[..., e:e + 1] * ((jax.nn.silu(h @ w_gate[e]) * (h @ w_up[e])) @ w_down[e])
    return out


def setup_inputs(seed: int = 0) -> dict:
    key = jax.random.key(seed)
    ks = jax.random.split(key, 26)
    f32 = jnp.float32
    nrm = lambda kk, shape, s: jax.random.normal(kk, shape, f32) * s
    d = D_MODEL
    x = nrm(ks[0], (BATCH, SEQ, d), 1.0)
    c = nrm(ks[1], (BATCH, d), 1.0)
    ctx = nrm(ks[2], (BATCH, CTX_LEN, d), 1.0)
    c_ctx = nrm(ks[3], (d,), 1.0)
    w_mod = nrm(ks[4], (DEPTH, d, 6 * d), 0.5 * d ** -0.5)
    b_mod = nrm(ks[5], (DEPTH, 6 * d), 0.02)
    norm_mix = 1.0 + nrm(ks[6], (DEPTH, d), 0.02)
    norm_ffn = 1.0 + nrm(ks[7], (DEPTH, d), 0.02)
    w_in = nrm(ks[8], (DEPTH, d, IN_COLS), d ** -0.5)
    gla_a2 = nrm(ks[9], (DEPTH, 2, GLA_RANK, BRANCH_W), GLA_RANK ** -0.5)
    gla_ab = nrm(ks[10], (DEPTH, 2, BRANCH_W), 0.1)
    i_bias = nrm(ks[11], (DEPTH, 2, 1, N_HEADS), 0.1)
    f_bias = jnp.linspace(3.0, 6.0, N_HEADS, dtype=f32) + nrm(ks[12], (DEPTH, 2, 1, N_HEADS), 0.1)
    mlstm_gate_b = jnp.concatenate([i_bias, f_bias], axis=2)
    gdn_conv = nrm(ks[13], (DEPTH, CONV_W, 3 * BRANCH_W), CONV_W ** -0.5)
    gdn_a_log = jnp.log(jax.random.uniform(ks[14], (DEPTH, 2, N_HEADS), f32, 1.0, 16.0))
    dt = jnp.exp(jax.random.uniform(ks[15], (DEPTH, 2, N_HEADS), f32, math.log(1e-3), math.log(1e-1)))
    gdn_dt_bias = dt + jnp.log(-jnp.expm1(-dt))
    diff_lambda = nrm(ks[16], (DEPTH, 4, N_HEADS, DIFF_QK), 0.1)
    head_norm = 1.0 + nrm(ks[17], (DEPTH, N_BRANCH, BRANCH_W), 0.02)
    w_branch = nrm(ks[18], (DEPTH, N_BRANCH, BRANCH_W, d), BRANCH_W ** -0.5)
    w_out = nrm(ks[19], (DEPTH, d, d), d ** -0.5)
    router_w = nrm(ks[20], (d, N_EXPERTS), d ** -0.5)
    router_b = nrm(ks[21], (N_EXPERTS,), 0.01)
    w_gate = nrm(ks[22], (DEPTH, N_EXPERTS, d, D_EXPERT), d ** -0.5)
    w_up = nrm(ks[23], (DEPTH, N_EXPERTS, d, D_EXPERT), d ** -0.5)
    w_down = nrm(ks[24], (DEPTH, N_EXPERTS, D_EXPERT, d), D_EXPERT ** -0.5)
    norm_final = 1.0 + nrm(ks[25], (d,), 0.02)
    return {'x': x, 'c': c, 'ctx': ctx, 'c_ctx': c_ctx, 'w_mod': w_mod, 'b_mod': b_mod,
            'norm_mix': norm_mix, 'norm_ffn': norm_ffn, 'w_in': w_in, 'gla_a2': gla_a2, 'gla_ab': gla_ab,
            'mlstm_gate_b': mlstm_gate_b, 'gdn_conv': gdn_conv, 'gdn_a_log': gdn_a_log,
            'gdn_dt_bias': gdn_dt_bias, 'diff_lambda': diff_lambda, 'head_norm': head_norm,
            'w_branch': w_branch, 'w_out': w_out, 'router_w': router_w, 'router_b': router_b,
            'w_gate': w_gate, 'w_up': w_up, 'w_down': w_down, 'norm_final': norm_final}


def reference(x, c, ctx, c_ctx, w_mod, b_mod, norm_mix, norm_ffn, w_in, gla_a2, gla_ab, mlstm_gate_b,
              gdn_conv, gdn_a_log, gdn_dt_bias, diff_lambda, head_norm, w_branch, w_out, router_w,
              router_b, w_gate, w_up, w_down, norm_final):
    n_tok = x.shape[1]
    n_rows = n_tok // GRID_W
    row = jnp.repeat(jnp.arange(n_rows), GRID_W)
    col = jnp.tile(jnp.arange(GRID_W), n_rows)
    cos, sin = _axial_rope_tables(row, col)
    xc = ctx
    for l in range(DEPTH):
        with_ctx = l < DEPTH - 1
        lam_init = 0.8 - 0.6 * math.exp(-0.3 * l)
        mod = jax.nn.silu(c) @ w_mod[l] + b_mod[l]
        mod_c = jax.nn.silu(c_ctx) @ w_mod[l] + b_mod[l]
        sh1, sc1, g1, sh2, sc2, g2 = jnp.split(mod[:, None, :], 6, axis=-1)
        shc1, scc1, gc1, shc2, scc2, gc2 = jnp.split(mod_c[None, None, :], 6, axis=-1)
        h = _rms(x, norm_mix[l]) * (1 + sc1) + sh1
        hc = _rms(xc, norm_mix[l]) * (1 + scc1) + shc1
        cl = _split_cols(h @ w_in[l])
        cc = _split_cols(hc @ w_in[l])
        ya, ya_c = _gla_branch(cl[0:6], cc[0:6], gla_a2[l], gla_ab[l], head_norm[l, 0], with_ctx)
        yb, yb_c = _mlstm_branch(cl[6:12], cc[6:12], mlstm_gate_b[l], head_norm[l, 1], with_ctx)
        yg, yg_c = _gdn_branch(cl[12:18], cc[12:18], gdn_conv[l], gdn_a_log[l], gdn_dt_bias[l],
                               head_norm[l, 2], with_ctx)
        yd, yd_c = _diff_branch(cl[18:21], cc[18:21], cos, sin, diff_lambda[l], head_norm[l, 3],
                                lam_init, with_ctx)
        x = x + g1 * _merge([ya, yb, yg, yd], cl[21], w_branch[l], w_out[l], x.dtype)
        if with_ctx:
            xc = xc + gc1 * _merge([ya_c, yb_c, yg_c, yd_c], cc[21], w_branch[l], w_out[l], xc.dtype)
        h = _rms(x, norm_ffn[l]) * (1 + sc2) + sh2
        x = x + g2 * _moe(h, router_w, router_b, w_gate[l], w_up[l], w_down[l])
        if with_ctx:
            hc = _rms(xc, norm_ffn[l]) * (1 + scc2) + shc2
            xc = xc + gc2 * _moe(hc, router_w, router_b, w_gate[l], w_up[l], w_down[l])
    return _rms(x, norm_final)
```

```cpp
#include <hip/hip_runtime.h>
#include <stdint.h>
#include <math.h>

typedef unsigned short u16;
typedef short bf16x8 __attribute__((ext_vector_type(8)));
typedef float f32x4 __attribute__((ext_vector_type(4)));
typedef unsigned u32x2 __attribute__((ext_vector_type(2)));
typedef unsigned u32x4 __attribute__((ext_vector_type(4)));

#define DEV __device__ __forceinline__
#define NTHR 256

#define DM 1024
#define RLAT 16384
#define RCTX 512
#define RTOT 16896
#define SEQ 8192
#define CTXL 256
#define NCM 3968
#define NGATE 4096
#define NSTEP 132
#define KPOS 8448
#define EPSF 1e-6f
#define GLA_Q 0
#define GLA_K 256
#define GLA_V 512
#define GLA_G 768
#define GLA_RF 1024
#define GLA_RB 1040
#define ML_Q 1056
#define ML_K 1312
#define ML_V 1568
#define ML_O 1824
#define ML_GF 2080
#define ML_GB 2088
#define GD_Q 2096
#define GD_K 2352
#define GD_V 2608
#define GD_OG 2864
#define GD_GF 3120
#define GD_GB 3128
#define DF_Q 3136
#define DF_K 3392
#define DF_V 3648

DEV int tidx() { int t = threadIdx.x; asm volatile("" : "+v"(t)); __builtin_assume(t >= 0 && t < NTHR); return t; }
DEV int launder_s(int v) { asm volatile("" : "+s"(v)); return v; }
DEV u16 f2bf(float f) { unsigned u = __float_as_uint(f); u += 0x7fffu + ((u >> 16) & 1u); return (u16)(u >> 16); }
DEV float bf2f(u16 h) { return __uint_as_float(((unsigned)h) << 16); }
DEV unsigned pack2(float a, float b) { return (unsigned)f2bf(a) | ((unsigned)f2bf(b) << 16); }
DEV float sigm(float x) { return 1.f / (1.f + __expf(-x)); }
DEV float silu(float x) { return x / (1.f + __expf(-x)); }
DEV float logsig(float x) { return fminf(x, 0.f) - log1pf(__expf(-fabsf(x))); }
DEV float softplus(float x) { return fmaxf(x, 0.f) + log1pf(__expf(-fabsf(x))); }
DEV float wsum(float v) {
#pragma unroll
    for (int o = 32; o; o >>= 1) v += __shfl_xor(v, o, 64);
    return v;
}
DEV float wmaxr(float v) {
#pragma unroll
    for (int o = 32; o; o >>= 1) v = fmaxf(v, __shfl_xor(v, o, 64));
    return v;
}
DEV f32x4 mfma16(bf16x8 a, bf16x8 b, f32x4 c) { return __builtin_amdgcn_mfma_f32_16x16x32_bf16(a, b, c, 0, 0, 0); }

struct P {
    const float *x, *c, *ctx, *c_ctx, *w_mod, *b_mod, *norm_mix, *norm_ffn, *w_in, *gla_a2, *gla_ab, *mlstm_gate_b,
        *gdn_conv, *gdn_a_log, *gdn_dt_bias, *diff_lambda, *head_norm, *w_branch, *w_out, *router_w, *router_b,
        *w_gate, *w_up, *w_down, *norm_final;
    float* out;
    unsigned* bar;
    int* cnt;
    float* modp;
    float* mod;
    float* xctx;
    u16* hbuf;
    u16* ybuf;
    u16* Wt;
    u16* dq;
    u16* dk;
    u16* dvT;
    float* glaDec;
    float* mlN;
    float* mlFE;
    float* mlAE;
    float* mlM;
    u16* glaS;
    u16* mlS;
    u16* gdM;
    u16* gdN;
    u16* gdQ;
    u16* gdO;
    u16* cols;
};
#define MOE_WGU_OFF 0
#define MOE_WD_OFF (16u * 1024u * 1024u)
#define MOE_ACT_OFF (MOE_WD_OFF + 16u * 1024u * 512u)
#define MOE_LIST_OFF (MOE_ACT_OFF + 2u * RTOT * 512u)

DEV const float* xrow_in(const P& p, int l, int r) {
    if (l == 0) return r < RLAT ? p.x + (size_t)r * DM : p.ctx + (size_t)(r - RLAT) * DM;
    return r < RLAT ? p.out + (size_t)r * DM : p.xctx + (size_t)(r - RLAT) * DM;
}
DEV float* xrow_out(const P& p, int r) { return r < RLAT ? p.out + (size_t)r * DM : p.xctx + (size_t)(r - RLAT) * DM; }
DEV int modidx(int r) { return r < RLAT ? (r >> 13) : 2; }
DEV int chunk_row0(int b, int dir, int st) {
    if (st < 4) { int c = dir ? 3 - st : st; return RLAT + b * CTXL + c * 64; }
    int c = dir ? 131 - st : st - 4; return b * SEQ + c * 64;
}
DEV size_t state_idx(int dir, int b, int st, int h) { return ((size_t)((dir * 2 + b) * NSTEP + st) * 4 + h); }
#define XB_TMO      128
#define XB_XCNT(j)  (256  + 64 * (j))
#define XB_XSUB(j)  (1280 + 64 * (j))
#define XB_XGEN(j)  (2304 + 64 * (j))
#define XB_TOP      3328
#define XB_TOPGEN   3392
#define XCD_BAR_WORDS 3456
#define XB_SPIN_CAP (1u << 18)
#define LAS __attribute__((address_space(3)))

__device__ __forceinline__ unsigned xb_ld(unsigned* p)              { return __hip_atomic_load(p, __ATOMIC_RELAXED, __HIP_MEMORY_SCOPE_AGENT); }
__device__ __forceinline__ unsigned xb_add(unsigned* p, unsigned v) { return __hip_atomic_fetch_add(p, v, __ATOMIC_RELAXED, __HIP_MEMORY_SCOPE_AGENT); }
__device__ __forceinline__ unsigned xb_xcc_id() { return (unsigned)__builtin_amdgcn_s_getreg((3 << 11) | 20) & 0xFu; }
#define XB_SPIN(cond, bar) do { unsigned _sp = 0; while (cond) { __builtin_amdgcn_s_sleep(1); \
    if ((++_sp & 255u) == 0u) { if (xb_ld(&(bar)[XB_TMO])) break; if (_sp > XB_SPIN_CAP) { atomicAdd(&(bar)[XB_TMO], 1u); break; } } } } while (0)

struct XcdBarrier {
    unsigned* bar; unsigned x;
    volatile LAS unsigned* st;
};

__device__ __forceinline__ XcdBarrier xcd_barrier_post(unsigned* bar, volatile LAS unsigned* st) {
    XcdBarrier b; b.bar = bar; b.x = xb_xcc_id(); b.st = st;
    if (threadIdx.x == 0) (void)xb_add(&bar[XB_XCNT(b.x)], 1u);
    return b;
}
__device__ __forceinline__ void xcd_barrier_complete(unsigned* bar, unsigned x, unsigned& nloc, unsigned& nx) {
    const unsigned G = gridDim.x * gridDim.y * gridDim.z;
    unsigned sum, cnt, mine, sp = 0u;
    for (;;) {
        sum = 0u; cnt = 0u; mine = 0u;
#pragma unroll
        for (unsigned j = 0; j < 16; ++j) { const unsigned c = xb_ld(&bar[XB_XCNT(j)]); sum += c; cnt += (c > 0u) ? 1u : 0u; mine = (j == x) ? c : mine; }
        if (sum == G) break;
        __builtin_amdgcn_s_sleep(1);
        if ((++sp & 255u) == 0u) { if (xb_ld(&bar[XB_TMO])) break; if (sp > XB_SPIN_CAP) { atomicAdd(&bar[XB_TMO], 1u); break; } }
    }
    nloc = mine > 0u ? mine : 1u; nx = cnt > 0u ? cnt : 1u;
}

__device__ __forceinline__ void xcd_barrier(const XcdBarrier& b) {
    asm volatile("s_waitcnt vmcnt(0)" ::: "memory");
    __syncthreads();
    if (threadIdx.x == 0) {
        unsigned* bar = b.bar;
        __builtin_amdgcn_s_waitcnt(0);
        unsigned nloc = b.st[0], nx = b.st[1];
        if (nloc == 0u) { xcd_barrier_complete(bar, b.x, nloc, nx); b.st[0] = nloc; b.st[1] = nx; }
        const unsigned old = xb_add(&bar[XB_XSUB(b.x)], 1u);
        const unsigned gen = old / nloc;
        if (old + 1u == (gen + 1u) * nloc) {
            __builtin_amdgcn_fence(__ATOMIC_RELEASE, "agent");
            asm volatile("s_waitcnt vmcnt(0)" ::: "memory");
            const unsigned og = xb_add(&bar[XB_TOP], 1u);
            const unsigned tg = og / nx;
            if (og + 1u == (tg + 1u) * nx) xb_add(&bar[XB_TOPGEN], 1u);
            else XB_SPIN(xb_ld(&bar[XB_TOPGEN]) == tg, bar);
            __builtin_amdgcn_fence(__ATOMIC_ACQUIRE, "agent");
            xb_add(&bar[XB_XGEN(b.x)], 1u);
            asm volatile("s_waitcnt vmcnt(0)" ::: "memory");
        } else {
            XB_SPIN(xb_ld(&bar[XB_XGEN(b.x)]) == gen, bar);
            __builtin_amdgcn_fence(__ATOMIC_ACQUIRE, "agent");
            asm volatile("s_waitcnt vmcnt(0)" ::: "memory");
        }
    }
    __syncthreads();
}
template <class RowMap>
DEV void tr_tile(const float* __restrict__ src, int lds_, u16* __restrict__ dst, int ldd, int k0, int n0, RowMap rowmap, float* sm) {
    const int t = tidx();
    {
        const int n = t & 63, kk = t >> 6;
#pragma unroll
        for (int i = 0; i < 16; ++i) {
            const int k = kk + 4 * i;
            sm[k * 65 + n] = src[(size_t)(k0 + k) * lds_ + n0 + n];
        }
    }
    __syncthreads();
    {
        const int kp = t & 31, nn = t >> 5;
#pragma unroll
        for (int i = 0; i < 8; ++i) {
            const int n = nn + 8 * i;
            const unsigned v = pack2(sm[(2 * kp) * 65 + n], sm[(2 * kp + 1) * 65 + n]);
            *(unsigned*)(dst + (size_t)rowmap(n0 + n) * ldd + k0 + 2 * kp) = v;
        }
    }
    __syncthreads();
}

struct RmId { DEV int operator()(int n) const { return n; } };
struct RmWin { DEV int operator()(int n) const { return n < 3904 ? n : n + 64; } };
struct RmGate { DEV int operator()(int n) const { return (n >> 5) * 64 + (n & 31); } };
struct RmUp { DEV int operator()(int n) const { return (n >> 5) * 64 + 32 + (n & 31); } };

#define WT_WB_OFF (8064u * 1024u)
#define WT_WO_OFF (WT_WB_OFF + 4u * 1024u * 256u)
#define WT_TOTAL (WT_WO_OFF + 1024u * 1024u)

DEV void phase_conv_mixw(const P& p, int l, int bid, int nb, float* sm) {
    for (int u = bid; u < 2513; u += nb) {
        if (u < 2000) {
            const int kt = u / 125, nt = u % 125;
            tr_tile(p.w_in + (size_t)l * 1024 * 8000, 8000, p.Wt, 1024, kt * 64, nt * 64, RmWin(), sm);
        } else if (u < 2256) {
            const int v = u - 2000, i = v >> 6, w = v & 63, kt = w >> 4, nt = w & 15;
            tr_tile(p.w_branch + (size_t)(l * 4 + i) * 256 * 1024, 1024, p.Wt + WT_WB_OFF + (size_t)i * 1024 * 256, 256, kt * 64, nt * 64, RmId(), sm);
        } else if (u < 2512) {
            const int v = u - 2256, kt = v >> 4, nt = v & 15;
            tr_tile(p.w_out + (size_t)l * 1024 * 1024, 1024, p.Wt + WT_WO_OFF, 1024, kt * 64, nt * 64, RmId(), sm);
        } else {
            unsigned* z = (unsigned*)(p.Wt + (size_t)3904 * 1024);
            for (int i = tidx(); i < 64 * 1024 / 2; i += NTHR) z[i] = 0u;
        }
    }
}
DEV void phase_conv_moew(const P& p, int l, int bid, int nb, float* sm) {
    u16* wgu = p.cols + MOE_WGU_OFF;
    u16* wd = p.cols + MOE_WD_OFF;
    for (int u = bid; u < 16 * 384; u += nb) {
        const int e = u / 384, v = u % 384;
        const size_t le = (size_t)(l * 16 + e);
        if (v < 128) {
            const int kt = v >> 3, nt = v & 7;
            tr_tile(p.w_gate + le * 1024 * 512, 512, wgu + (size_t)e * 1024 * 1024, 1024, kt * 64, nt * 64, RmGate(), sm);
        } else if (v < 256) {
            const int w = v - 128, kt = w >> 3, nt = w & 7;
            tr_tile(p.w_up + le * 1024 * 512, 512, wgu + (size_t)e * 1024 * 1024, 1024, kt * 64, nt * 64, RmUp(), sm);
        } else {
            const int w = v - 256, kt = w >> 4, nt = w & 15;
            tr_tile(p.w_down + le * 512 * 1024, 1024, wd + (size_t)e * 1024 * 512, 512, kt * 64, nt * 64, RmId(), sm);
        }
    }
}

DEV void phase_mod_partial(const P& p, int bid, int nb, float* sm) {
    for (int u = bid; u < 768; u += nb) {
        const int l = u / 384, v = u % 384, kc = v / 24, jb = v % 24;
        const int t = tidx();
        __syncthreads();
        if (t < 192) {
            const int m = t >> 6, k = kc * 64 + (t & 63);
            const float cv = m < 2 ? p.c[m * 1024 + k] : p.c_ctx[k];
            sm[t] = silu(cv);
        }
        __syncthreads();
        const int j = jb * 256 + t;
        const float* w = p.w_mod + ((size_t)l * 1024 + kc * 64) * 6144 + j;
        float a0 = 0.f, a1 = 0.f, a2 = 0.f;
#pragma unroll 8
        for (int k = 0; k < 64; ++k) {
            const float wv = w[(size_t)k * 6144];
            a0 += sm[k] * wv; a1 += sm[64 + k] * wv; a2 += sm[128 + k] * wv;
        }
        float* o = p.modp + ((size_t)(l * 16 + kc) * 3) * 6144 + j;
        o[0] = a0; o[6144] = a1; o[2 * 6144] = a2;
    }
}
DEV void phase_mod_reduce(const P& p, int bid, int nb) {
    for (int i = bid * NTHR + tidx(); i < 2 * 3 * 6144; i += nb * NTHR) {
        const int l = i / (3 * 6144), r = i % (3 * 6144), m = r / 6144, j = r % 6144;
        float a = p.b_mod[l * 6144 + j];
        for (int kc = 0; kc < 16; ++kc) a += p.modp[((size_t)(l * 16 + kc) * 3 + m) * 6144 + j];
        p.mod[i] = a;
    }
}

DEV void phase_norm1(const P& p, int l, int bid, int nb) {
    const int lane = tidx() & 63, w = tidx() >> 6;
    for (int r = bid * 4 + w; r < RTOT; r += nb * 4) {
        const float* xr = xrow_in(p, l, r);
        const int m = modidx(r);
        const float* sh = p.mod + ((size_t)(l * 3 + m)) * 6144;
        const float* sc = sh + 1024;
        float4 v[4]; float ss = 0.f;
#pragma unroll
        for (int i = 0; i < 4; ++i) {
            v[i] = *(const float4*)(xr + lane * 4 + i * 256);
            ss += v[i].x * v[i].x + v[i].y * v[i].y + v[i].z * v[i].z + v[i].w * v[i].w;
        }
        ss = wsum(ss);
        const float rs = rsqrtf(ss * (1.f / 1024.f) + EPSF);
#pragma unroll
        for (int i = 0; i < 4; ++i) {
            const int c = lane * 4 + i * 256;
            const float4 g = *(const float4*)(p.norm_mix + l * 1024 + c);
            const float4 s1 = *(const float4*)(sc + c);
            const float4 h1 = *(const float4*)(sh + c);
            const float o0 = v[i].x * rs * g.x * (1.f + s1.x) + h1.x;
            const float o1 = v[i].y * rs * g.y * (1.f + s1.y) + h1.y;
            const float o2 = v[i].z * rs * g.z * (1.f + s1.z) + h1.z;
            const float o3 = v[i].w * rs * g.w * (1.f + s1.w) + h1.w;
            u32x2 pk; pk.x = pack2(o0, o1); pk.y = pack2(o2, o3);
            *(u32x2*)(p.hbuf + (size_t)r * 1024 + c) = pk;
        }
    }
}

#define LDP 72
#define GEMM_SMEM_BYTES (2 * 128 * LDP * 2)
DEV void gemm_mainloop(f32x4 (&acc)[4][4], const u16* const (&xp)[4], const u16* const (&wp)[4], int KT, u16* sX, u16* sW) {
    const int tid = tidx(), lane = tid & 63, w = tid >> 6, wn = w & 1, wm = w >> 1;
    const int fr = lane & 15, fq = lane >> 4;
    bf16x8 rx[4], rw[4];
#pragma unroll
    for (int i = 0; i < 4; ++i) { rx[i] = *(const bf16x8*)(xp[i]); rw[i] = *(const bf16x8*)(wp[i]); }
    const int so = (tid >> 3) * LDP + (tid & 7) * 8;
    for (int kt = 0; kt < KT; ++kt) {
#pragma unroll
        for (int i = 0; i < 4; ++i) {
            *(bf16x8*)(sX + so + i * 32 * LDP) = rx[i];
            *(bf16x8*)(sW + so + i * 32 * LDP) = rw[i];
        }
        __syncthreads();
        if (kt + 1 < KT) {
#pragma unroll
            for (int i = 0; i < 4; ++i) { rx[i] = *(const bf16x8*)(xp[i] + (kt + 1) * 64); rw[i] = *(const bf16x8*)(wp[i] + (kt + 1) * 64); }
        }
#pragma unroll
        for (int ks = 0; ks < 2; ++ks) {
            bf16x8 a[4], b[4];
#pragma unroll
            for (int q = 0; q < 4; ++q) {
                a[q] = *(const bf16x8*)(sW + (wn * 64 + q * 16 + fr) * LDP + ks * 32 + fq * 8);
                b[q] = *(const bf16x8*)(sX + (wm * 64 + q * 16 + fr) * LDP + ks * 32 + fq * 8);
            }
#pragma unroll
            for (int nt = 0; nt < 4; ++nt)
#pragma unroll
                for (int mt = 0; mt < 4; ++mt) acc[nt][mt] = mfma16(a[nt], b[mt], acc[nt][mt]);
        }
        __syncthreads();
    }
}
DEV void zero_acc(f32x4 (&acc)[4][4]) {
#pragma unroll
    for (int a = 0; a < 4; ++a)
#pragma unroll
        for (int b = 0; b < 4; ++b) acc[a][b] = f32x4{0.f, 0.f, 0.f, 0.f};
}

template <bool SIG>
DEV void phase_inproj(const P& p, int wrow0, int ntn, int ldc, int mtiles, int bid, int nb, u16* sm) {
    u16* sX = sm; u16* sW = sm + 128 * LDP;
    const int tid = tidx(), lane = tid & 63, w = tid >> 6, wn = w & 1, wm = w >> 1, fr = lane & 15, fq = lane >> 4;
    for (int u = bid; u < mtiles * ntn; u += nb) {
        const int mt_ = u / ntn, nt_ = u % ntn;
        const int m0 = mt_ * 128, n0 = nt_ * 128;
        const u16* xp[4]; const u16* wp[4];
#pragma unroll
        for (int i = 0; i < 4; ++i) {
            const int row = (tid >> 3) + 32 * i, kc = (tid & 7) * 8;
            xp[i] = p.hbuf + (size_t)(m0 + row) * 1024 + kc;
            wp[i] = p.Wt + (size_t)(wrow0 + n0 + row) * 1024 + kc;
        }
        f32x4 acc[4][4]; zero_acc(acc);
        gemm_mainloop(acc, xp, wp, 16, sX, sW);
#pragma unroll
        for (int nt = 0; nt < 4; ++nt)
#pragma unroll
            for (int mt = 0; mt < 4; ++mt) {
                const int n = n0 + wn * 64 + nt * 16 + fq * 4, m = m0 + wm * 64 + mt * 16 + fr;
                f32x4 v = acc[nt][mt];
                if (SIG) { v[0] = sigm(v[0]); v[1] = sigm(v[1]); v[2] = sigm(v[2]); v[3] = sigm(v[3]); }
                u32x2 pk; pk.x = pack2(v[0], v[1]); pk.y = pack2(v[2], v[3]);
                *(u32x2*)(p.cols + (size_t)m * ldc + n) = pk;
            }
    }
}

DEV void phase_merge1(const P& p, u16* ubuf, int mtiles, int bid, int nb, u16* sm) {
    u16* sX = sm; u16* sW = sm + 128 * LDP;
    const int tid = tidx(), lane = tid & 63, w = tid >> 6, wn = w & 1, wm = w >> 1, fr = lane & 15, fq = lane >> 4;
    for (int u = bid; u < mtiles * 8; u += nb) {
        const int mt_ = u >> 3, nt_ = u & 7;
        const int m0 = mt_ * 128, n0 = nt_ * 128;
        f32x4 tot[4][4]; zero_acc(tot);
        for (int br = 0; br < 4; ++br) {
            const u16* xp[4]; const u16* wp[4];
#pragma unroll
            for (int i = 0; i < 4; ++i) {
                const int row = (tid >> 3) + 32 * i, kc = (tid & 7) * 8;
                xp[i] = p.ybuf + (size_t)(m0 + row) * 1024 + br * 256 + kc;
                wp[i] = p.Wt + WT_WB_OFF + ((size_t)br * 1024 + n0 + row) * 256 + kc;
            }
            f32x4 acc[4][4]; zero_acc(acc);
            gemm_mainloop(acc, xp, wp, 4, sX, sW);
#pragma unroll
            for (int nt = 0; nt < 4; ++nt)
#pragma unroll
                for (int mt = 0; mt < 4; ++mt) {
                    const int n = n0 + wn * 64 + nt * 16 + fq * 4, m = m0 + wm * 64 + mt * 16 + fr;
                    const u32x2 g = *(const u32x2*)(p.cols + (size_t)m * NGATE + br * 1024 + n);
                    tot[nt][mt][0] += bf2f((u16)(g.x & 0xffff)) * acc[nt][mt][0];
                    tot[nt][mt][1] += bf2f((u16)(g.x >> 16)) * acc[nt][mt][1];
                    tot[nt][mt][2] += bf2f((u16)(g.y & 0xffff)) * acc[nt][mt][2];
                    tot[nt][mt][3] += bf2f((u16)(g.y >> 16)) * acc[nt][mt][3];
                }
        }
#pragma unroll
        for (int nt = 0; nt < 4; ++nt)
#pragma unroll
            for (int mt = 0; mt < 4; ++mt) {
                const int n = n0 + wn * 64 + nt * 16 + fq * 4, m = m0 + wm * 64 + mt * 16 + fr;
                u32x2 pk; pk.x = pack2(tot[nt][mt][0], tot[nt][mt][1]); pk.y = pack2(tot[nt][mt][2], tot[nt][mt][3]);
                *(u32x2*)(ubuf + (size_t)m * 1024 + n) = pk;
            }
    }
}

DEV void phase_merge2(const P& p, int l, const u16* ubuf, int mtiles, int bid, int nb, u16* sm) {
    u16* sX = sm; u16* sW = sm + 128 * LDP;
    const int tid = tidx(), lane = tid & 63, w = tid >> 6, wn = w & 1, wm = w >> 1, fr = lane & 15, fq = lane >> 4;
    for (int u = bid; u < mtiles * 8; u += nb) {
        const int mt_ = u >> 3, nt_ = u & 7;
        const int m0 = mt_ * 128, n0 = nt_ * 128;
        const u16* xp[4]; const u16* wp[4];
#pragma unroll
        for (int i = 0; i < 4; ++i) {
            const int row = (tid >> 3) + 32 * i, kc = (tid & 7) * 8;
            xp[i] = ubuf + (size_t)(m0 + row) * 1024 + kc;
            wp[i] = p.Wt + WT_WO_OFF + (size_t)(n0 + row) * 1024 + kc;
        }
        f32x4 acc[4][4]; zero_acc(acc);
        gemm_mainloop(acc, xp, wp, 16, sX, sW);
#pragma unroll
        for (int nt = 0; nt < 4; ++nt)
#pragma unroll
            for (int mt = 0; mt < 4; ++mt) {
                const int n = n0 + wn * 64 + nt * 16 + fq * 4, m = m0 + wm * 64 + mt * 16 + fr;
                const float4 xo = *(const float4*)(xrow_in(p, l, m) + n);
                const float4 g = *(const float4*)(p.mod + (size_t)(l * 3 + modidx(m)) * 6144 + 2048 + n);
                float4 o;
                o.x = xo.x + g.x * acc[nt][mt][0]; o.y = xo.y + g.y * acc[nt][mt][1];
                o.z = xo.z + g.z * acc[nt][mt][2]; o.w = xo.w + g.w * acc[nt][mt][3];
                *(float4*)(xrow_out(p, m) + n) = o;
            }
    }
}
DEV void phase_norm2_router(const P& p, int l, int nrows, int bid, int nb, float* sm) {
    const int tid = tidx(), lane = tid & 63, w = tid >> 6;
    int* list = (int*)(p.cols + MOE_LIST_OFF);
    float* slotw = (float*)(list + 16 * RTOT);
    for (int i = tid; i < 16 * 1024; i += NTHR) { const int c = i >> 4, e = i & 15; sm[e * 1024 + c] = p.router_w[i]; }
    __syncthreads();
    for (int r = bid * 4 + w; r < nrows; r += nb * 4) {
        const float* xr = xrow_out(p, r);
        const int m = modidx(r);
        const float* sh = p.mod + ((size_t)(l * 3 + m)) * 6144 + 3072;
        const float* sc = sh + 1024;
        float4 v[4]; float ss = 0.f;
#pragma unroll
        for (int i = 0; i < 4; ++i) {
            v[i] = *(const float4*)(xr + lane * 4 + i * 256);
            ss += v[i].x * v[i].x + v[i].y * v[i].y + v[i].z * v[i].z + v[i].w * v[i].w;
        }
        ss = wsum(ss);
        const float rs = rsqrtf(ss * (1.f / 1024.f) + EPSF);
#pragma unroll
        for (int i = 0; i < 4; ++i) {
            const int c = lane * 4 + i * 256;
            const float4 g = *(const float4*)(p.norm_ffn + l * 1024 + c);
            const float4 s1 = *(const float4*)(sc + c);
            const float4 h1 = *(const float4*)(sh + c);
            v[i].x = v[i].x * rs * g.x * (1.f + s1.x) + h1.x;
            v[i].y = v[i].y * rs * g.y * (1.f + s1.y) + h1.y;
            v[i].z = v[i].z * rs * g.z * (1.f + s1.z) + h1.z;
            v[i].w = v[i].w * rs * g.w * (1.f + s1.w) + h1.w;
            u32x2 pk; pk.x = pack2(v[i].x, v[i].y); pk.y = pack2(v[i].z, v[i].w);
            *(u32x2*)(p.hbuf + (size_t)r * 1024 + c) = pk;
        }
        float sel[16], scr[16];
#pragma unroll
        for (int e = 0; e < 16; ++e) scr[e] = 0.f;
#pragma unroll
        for (int i = 0; i < 4; ++i) {
#pragma unroll
            for (int e = 0; e < 16; ++e) {
                const float4 rw = *(const float4*)(sm + e * 1024 + lane * 4 + i * 256);
                scr[e] += v[i].x * rw.x + v[i].y * rw.y + v[i].z * rw.z + v[i].w * rw.w;
            }
            __builtin_amdgcn_sched_barrier(0);
        }
#pragma unroll
        for (int e = 0; e < 16; ++e) {
            const float a = wsum(scr[e]);
            scr[e] = sigm(a);
            sel[e] = scr[e] + p.router_b[e];
        }
        int bg = 0; float bgs = -INFINITY;
#pragma unroll
        for (int g = 0; g < 4; ++g) {
            float m1 = -INFINITY, m2 = -INFINITY;
#pragma unroll
            for (int j = 0; j < 4; ++j) {
                const float s = sel[g * 4 + j];
                if (s > m1) { m2 = m1; m1 = s; } else if (s > m2) { m2 = s; }
            }
            const float gs = m1 + m2;
            if (gs > bgs) { bgs = gs; bg = g; }
        }
        float gsel[4], gscr[4];
#pragma unroll
        for (int j = 0; j < 4; ++j) { gsel[j] = -INFINITY; gscr[j] = 0.f; }
#pragma unroll
        for (int g = 0; g < 4; ++g)
#pragma unroll
            for (int j = 0; j < 4; ++j) if (bg == g) { gsel[j] = sel[g * 4 + j]; gscr[j] = scr[g * 4 + j]; }
        int j1 = 0; float v1 = gsel[0], w1 = gscr[0];
#pragma unroll
        for (int j = 1; j < 4; ++j) if (gsel[j] > v1) { v1 = gsel[j]; w1 = gscr[j]; j1 = j; }
        int j2 = -1; float v2 = -INFINITY, w2 = 0.f;
#pragma unroll
        for (int j = 0; j < 4; ++j) if (j != j1 && (j2 < 0 || gsel[j] > v2)) { v2 = gsel[j]; w2 = gscr[j]; j2 = j; }
        const float inv = 1.f / (w1 + w2);
        if (lane == 0) {
            const int e1 = bg * 4 + j1, e2 = bg * 4 + j2;
            const int p1 = atomicAdd(p.cnt + l * 16 + e1, 1);
            list[e1 * RTOT + p1] = r; slotw[e1 * RTOT + p1] = w1 * inv;
            const int p2 = atomicAdd(p.cnt + l * 16 + e2, 1);
            list[e2 * RTOT + p2] = r; slotw[e2 * RTOT + p2] = w2 * inv;
        }
    }
    __syncthreads();
}

DEV bool moe_find(const int* cnt, int ut, int& e, int& mt, int& off, int& ce) {
    int tb = 0, o = 0;
    for (int k = 0; k < 16; ++k) {
        const int c = cnt[k], nt = (c + 127) >> 7;
        if (ut < tb + nt) { e = k; mt = ut - tb; off = o; ce = c; return true; }
        tb += nt; o += c;
    }
    return false;
}

DEV void phase_moe_up(const P& p, int l, int bid, int nb, u16* sm) {
    u16* sX = sm; u16* sW = sm + 128 * LDP;
    const int tid = tidx(), lane = tid & 63, w = tid >> 6, wn = w & 1, wm = w >> 1, fr = lane & 15, fq = lane >> 4;
    const int* cnt = p.cnt + l * 16;
    const int* list = (const int*)(p.cols + MOE_LIST_OFF);
    const u16* wgu = p.cols + MOE_WGU_OFF;
    u16* act = p.cols + MOE_ACT_OFF;
    for (int u = bid;; u += nb) {
        int e, mtile, off, ce;
        if (!moe_find(cnt, u >> 3, e, mtile, off, ce)) break;
        const int n0 = (u & 7) * 128;
        const u16* xp[4]; const u16* wp[4];
#pragma unroll
        for (int i = 0; i < 4; ++i) {
            const int row = (tid >> 3) + 32 * i, kc = (tid & 7) * 8;
            int s = mtile * 128 + row; s = s < ce ? s : ce - 1;
            const int tok = list[e * RTOT + s];
            xp[i] = p.hbuf + (size_t)tok * 1024 + kc;
            wp[i] = wgu + ((size_t)e * 1024 + n0 + row) * 1024 + kc;
        }
        f32x4 acc[4][4]; zero_acc(acc);
        gemm_mainloop(acc, xp, wp, 16, sX, sW);
#pragma unroll
        for (int nt = 0; nt < 2; ++nt)
#pragma unroll
            for (int mt = 0; mt < 4; ++mt) {
                const int col = ((n0 >> 6) + wn) * 32 + nt * 16 + fq * 4;
                const int s = mtile * 128 + wm * 64 + mt * 16 + fr;
                if (s < ce) {
                    const f32x4 g = acc[nt][mt], uu = acc[nt + 2][mt];
                    u32x2 pk; pk.x = pack2(silu(g[0]) * uu[0], silu(g[1]) * uu[1]); pk.y = pack2(silu(g[2]) * uu[2], silu(g[3]) * uu[3]);
                    *(u32x2*)(act + (size_t)(off + s) * 512 + col) = pk;
                }
            }
    }
}

DEV void phase_moe_down(const P& p, int l, int bid, int nb, u16* sm) {
    u16* sX = sm; u16* sW = sm + 128 * LDP;
    const int tid = tidx(), lane = tid & 63, w = tid >> 6, wn = w & 1, wm = w >> 1, fr = lane & 15, fq = lane >> 4;
    const int* cnt = p.cnt + l * 16;
    const int* list = (const int*)(p.cols + MOE_LIST_OFF);
    const float* slotw = (const float*)(list + 16 * RTOT);
    const u16* wd = p.cols + MOE_WD_OFF;
    const u16* act = p.cols + MOE_ACT_OFF;
    for (int u = bid;; u += nb) {
        int e, mtile, off, ce;
        if (!moe_find(cnt, u >> 3, e, mtile, off, ce)) break;
        const int n0 = (u & 7) * 128;
        const u16* xp[4]; const u16* wp[4];
#pragma unroll
        for (int i = 0; i < 4; ++i) {
            const int row = (tid >> 3) + 32 * i, kc = (tid & 7) * 8;
            int s = mtile * 128 + row; s = s < ce ? s : ce - 1;
            xp[i] = act + (size_t)(off + s) * 512 + kc;
            wp[i] = wd + ((size_t)e * 1024 + n0 + row) * 512 + kc;
        }
        f32x4 acc[4][4]; zero_acc(acc);
        gemm_mainloop(acc, xp, wp, 8, sX, sW);
#pragma unroll
        for (int mt = 0; mt < 4; ++mt) {
            const int s = mtile * 128 + wm * 64 + mt * 16 + fr;
            if (s < ce) {
                const int tok = list[e * RTOT + s];
                const float wg = slotw[e * RTOT + s];
                float* dst = xrow_out(p, tok);
                const float* g2 = p.mod + (size_t)(l * 3 + modidx(tok)) * 6144 + 5120;
#pragma unroll
                for (int nt = 0; nt < 4; ++nt) {
                    const int n = n0 + wn * 64 + nt * 16 + fq * 4;
                    const float4 g = *(const float4*)(g2 + n);
                    unsafeAtomicAdd(dst + n + 0, g.x * wg * acc[nt][mt][0]);
                    unsafeAtomicAdd(dst + n + 1, g.y * wg * acc[nt][mt][1]);
                    unsafeAtomicAdd(dst + n + 2, g.z * wg * acc[nt][mt][2]);
                    unsafeAtomicAdd(dst + n + 3, g.w * wg * acc[nt][mt][3]);
                }
            }
        }
    }
}

DEV void phase_final_norm(const P& p, int bid, int nb) {
    const int lane = tidx() & 63, w = tidx() >> 6;
    for (int r = bid * 4 + w; r < RLAT; r += nb * 4) {
        float* xr = p.out + (size_t)r * DM;
        float4 v[4]; float ss = 0.f;
#pragma unroll
        for (int i = 0; i < 4; ++i) {
            v[i] = *(const float4*)(xr + lane * 4 + i * 256);
            ss += v[i].x * v[i].x + v[i].y * v[i].y + v[i].z * v[i].z + v[i].w * v[i].w;
        }
        ss = wsum(ss);
        const float rs = rsqrtf(ss * (1.f / 1024.f) + EPSF);
#pragma unroll
        for (int i = 0; i < 4; ++i) {
            const int c = lane * 4 + i * 256;
            const float4 g = *(const float4*)(p.norm_final + c);
            float4 o; o.x = v[i].x * rs * g.x; o.y = v[i].y * rs * g.y; o.z = v[i].z * rs * g.z; o.w = v[i].w * rs * g.w;
            *(float4*)(xr + c) = o;
        }
    }
}
DEV float wscan_add(float v, int lane) {
#pragma unroll
    for (int o = 1; o < 64; o <<= 1) { const float t = __shfl_up(v, o, 64); if (lane >= o) v += t; }
    return v;
}
DEV float wscan_max(float v, int lane) {
#pragma unroll
    for (int o = 1; o < 64; o <<= 1) { const float t = __shfl_up(v, o, 64); if (lane >= o) v = fmaxf(v, t); }
    return v;
}
DEV void mm64(f32x4 (&acc)[4], const u16* A, int lda, const u16* Bt, int ldb) {
    const int lane = tidx() & 63, w = tidx() >> 6, fr = lane & 15, fq = lane >> 4;
#pragma unroll
    for (int ks = 0; ks < 2; ++ks) {
        const bf16x8 a = *(const bf16x8*)(A + (16 * w + fr) * lda + ks * 32 + fq * 8);
#pragma unroll
        for (int nt = 0; nt < 4; ++nt) {
            const bf16x8 b = *(const bf16x8*)(Bt + (nt * 16 + fr) * ldb + ks * 32 + fq * 8);
            acc[nt] = mfma16(a, b, acc[nt]);
        }
    }
}
DEV void zero4(f32x4 (&acc)[4]) {
#pragma unroll
    for (int i = 0; i < 4; ++i) acc[i] = f32x4{0.f, 0.f, 0.f, 0.f};
}
DEV void ld16bf(const u16* p, float (&o)[16]) {
    const u32x4 a = *(const u32x4*)p, b = *(const u32x4*)(p + 8);
    const unsigned w[8] = {a.x, a.y, a.z, a.w, b.x, b.y, b.z, b.w};
#pragma unroll
    for (int i = 0; i < 8; ++i) { o[2 * i] = __uint_as_float(w[i] << 16); o[2 * i + 1] = __uint_as_float(w[i] & 0xffff0000u); }
}
DEV void st16bf(u16* p, const float (&v)[16]) {
    u32x4 a, b;
    a.x = pack2(v[0], v[1]); a.y = pack2(v[2], v[3]); a.z = pack2(v[4], v[5]); a.w = pack2(v[6], v[7]);
    b.x = pack2(v[8], v[9]); b.y = pack2(v[10], v[11]); b.z = pack2(v[12], v[13]); b.w = pack2(v[14], v[15]);
    *(u32x4*)p = a; *(u32x4*)(p + 8) = b;
}

DEV void phase_prep(const P& p, int l, u16* gqkv, int bid, int nb, u16* sm) {
    const int tid = tidx(), lane = tid & 63, w = tid >> 6;
    for (int g = bid; g < 264; g += nb) {
        int b, t0, r0, T, pos0;
        if (g < 256) { b = g >> 7; t0 = (g & 127) * 64; r0 = b * SEQ + t0; T = SEQ; pos0 = CTXL + t0; }
        else { const int q = g - 256; b = q >> 2; t0 = (q & 3) * 64; r0 = RLAT + b * CTXL + t0; T = CTXL; pos0 = t0; }
        for (int i = 0; i < 16; ++i) {
            const int s = w * 16 + i, r = r0 + s, t = t0 + s;
            float val[12];
#pragma unroll
            for (int c = 0; c < 12; ++c) {
                const int ch = lane + 64 * c;
                float a = 0.f;
#pragma unroll
                for (int j = 0; j < 5; ++j) {
                    const int tt = t + j - 2;
                    if (tt >= 0 && tt < T) a += bf2f(p.cols[(size_t)(r + j - 2) * NCM + GD_Q + ch]) * p.gdn_conv[(l * 5 + j) * 768 + ch];
                }
                val[c] = silu(a);
            }
#pragma unroll
            for (int c = 0; c < 12; ++c) {
                float sc = 1.f;
                if (c < 8) { const float ss = wsum(val[c] * val[c]); sc = rsqrtf(ss + EPSF) * (c < 4 ? 0.125f : 1.f); }
                gqkv[(size_t)r * 768 + lane + 64 * c] = f2bf(val[c] * sc);
            }
        }
        for (int i = 0; i < 16; ++i) {
            const int s = w * 16 + i, r = r0 + s, t = t0 + s;
            const int dd = lane & 31, idx = dd & 15;
            float cs = 1.f, sn = 0.f;
            if (g < 256) {
                const int fi = idx & 7;
                const float inv = __expf(-(float)(2 * fi) * (1.f / 16.f) * 9.210340371976184f);
                const float pos = idx < 8 ? (float)(t >> 6) : (float)(t & 63);
                const float ang = pos * inv;
                cs = cosf(ang); sn = sinf(ang);
            }
#pragma unroll
            for (int h = 0; h < 4; ++h) {
                const float qv = bf2f(p.cols[(size_t)r * NCM + DF_Q + h * 64 + lane]);
                const float kv = bf2f(p.cols[(size_t)r * NCM + DF_K + h * 64 + lane]);
                const float qo = __shfl_xor(qv, 16, 64), ko = __shfl_xor(kv, 16, 64);
                float qr, kr;
                if (dd < 16) { qr = qv * cs - qo * sn; kr = kv * cs - ko * sn; }
                else { qr = qo * sn + qv * cs; kr = ko * sn + kv * cs; }
                const size_t o = ((size_t)(b * 4 + h) * KPOS + pos0 + s) * 64 + lane;
                p.dq[o] = f2bf(qr * (0.17677669529663687f * 1.4426950408889634f));
                p.dk[o] = f2bf(kr);
            }
        }
        for (int h = 0; h < 4; ++h) {
            __syncthreads();
            {
                const int s = tid >> 2, dg = tid & 3;
                const u32x4 a = *(const u32x4*)(p.cols + (size_t)(r0 + s) * NCM + DF_V + h * 64 + dg * 16);
                const u32x4 c = *(const u32x4*)(p.cols + (size_t)(r0 + s) * NCM + DF_V + h * 64 + dg * 16 + 8);
                const unsigned wv[8] = {a.x, a.y, a.z, a.w, c.x, c.y, c.z, c.w};
#pragma unroll
                for (int k = 0; k < 8; ++k) {
                    sm[(dg * 16 + 2 * k) * 72 + s] = (u16)(wv[k] & 0xffff);
                    sm[(dg * 16 + 2 * k + 1) * 72 + s] = (u16)(wv[k] >> 16);
                }
            }
            __syncthreads();
            {
                const int dv = tid >> 2, sg = tid & 3;
                const u32x4 a = *(const u32x4*)(sm + dv * 72 + sg * 16);
                const u32x4 c = *(const u32x4*)(sm + dv * 72 + sg * 16 + 8);
                u16* o = p.dvT + ((size_t)(b * 4 + h) * 64 + dv) * KPOS + pos0 + sg * 16;
                *(u32x4*)o = a; *(u32x4*)(o + 8) = c;
            }
        }
        __syncthreads();
    }
}
#define TILE_B (64 * LDP * 2)

DEV void gla_cum(const P& p, int l, int dir, int h, int row0, float* cum, float* rt, float* sg) {
    const int tid = tidx();
    {
        const int s = tid >> 2, q4 = tid & 3, row = row0 + (dir ? 63 - s : s);
        const u32x2 v = *(const u32x2*)(p.cols + (size_t)row * NCM + GLA_RF + dir * 16 + q4 * 4);
        rt[s * 17 + q4 * 4 + 0] = __uint_as_float(v.x << 16); rt[s * 17 + q4 * 4 + 1] = __uint_as_float(v.x & 0xffff0000u);
        rt[s * 17 + q4 * 4 + 2] = __uint_as_float(v.y << 16); rt[s * 17 + q4 * 4 + 3] = __uint_as_float(v.y & 0xffff0000u);
    }
    __syncthreads();
    const int d = tid & 63, sq = tid >> 6;
    float a2r[16];
#pragma unroll
    for (int j = 0; j < 16; ++j) a2r[j] = p.gla_a2[((size_t)(l * 2 + dir) * 16 + j) * 256 + h * 64 + d];
    const float ab = p.gla_ab[(l * 2 + dir) * 256 + h * 64 + d];
    float loc[16]; float run = 0.f;
#pragma unroll
    for (int i = 0; i < 16; ++i) {
        const int s = sq * 16 + i;
        float x = ab;
#pragma unroll
        for (int j = 0; j < 16; ++j) x += rt[s * 17 + j] * a2r[j];
        run += logsig(x) * (1.f / 16.f);
        loc[i] = run;
    }
    sg[sq * 64 + d] = run;
    __syncthreads();
    float off = 0.f;
    for (int k = 0; k < sq; ++k) off += sg[k * 64 + d];
#pragma unroll
    for (int i = 0; i < 16; ++i) cum[(sq * 16 + i) * 65 + d] = loc[i] + off;
    __syncthreads();
}

DEV void gla_phaseA(const P& p, int l, int dir, int b, int st, int h, unsigned char* smraw) {
    float* cum = (float*)smraw;
    float* rt = cum + 64 * 65;
    float* sg = rt + 64 * 17;
    u16* kwT = (u16*)(sg + 256);
    u16* vT = kwT + 64 * LDP;
    const int tid = tidx(), lane = tid & 63, w = tid >> 6, fr = lane & 15, fq = lane >> 4;
    const int row0 = chunk_row0(b, dir, st);
    const size_t idx = state_idx(dir, b, st, h);
    gla_cum(p, l, dir, h, row0, cum, rt, sg);
    {
        const int s = tid >> 2, dg = tid & 3, row = row0 + (dir ? 63 - s : s);
        float kk[16], vv[16];
        ld16bf(p.cols + (size_t)row * NCM + GLA_K + h * 64 + dg * 16, kk);
        ld16bf(p.cols + (size_t)row * NCM + GLA_V + h * 64 + dg * 16, vv);
#pragma unroll
        for (int i = 0; i < 16; ++i) {
            const int d = dg * 16 + i;
            kwT[d * LDP + s] = f2bf(kk[i] * __expf(cum[63 * 65 + d] - cum[s * 65 + d]));
            vT[d * LDP + s] = f2bf(vv[i]);
        }
        if (tid < 64) p.glaDec[idx * 64 + tid] = __expf(cum[63 * 65 + tid]);
    }
    __syncthreads();
    f32x4 acc[4]; zero4(acc);
    mm64(acc, kwT, LDP, vT, LDP);
#pragma unroll
    for (int nt = 0; nt < 4; ++nt) {
        const int d = 16 * w + fq * 4, e = nt * 16 + fr;
        u32x2 pk; pk.x = pack2(acc[nt][0], acc[nt][1]); pk.y = pack2(acc[nt][2], acc[nt][3]);
        *(u32x2*)(p.glaS + idx * 4096 + e * 64 + d) = pk;
    }
    __syncthreads();
}

DEV void ml_phaseA(const P& p, int l, int dir, int b, int st, int h, unsigned char* smraw) {
    float* wend = (float*)smraw;
    u16* kwT = (u16*)(wend + 64);
    u16* vT = kwT + 64 * LDP;
    const int tid = tidx(), lane = tid & 63, w = tid >> 6, fr = lane & 15, fq = lane >> 4;
    const int row0 = chunk_row0(b, dir, st);
    const size_t idx = state_idx(dir, b, st, h);
    if (w == 0) {
        const int row = row0 + (dir ? 63 - lane : lane);
        const float ip = bf2f(p.cols[(size_t)row * NCM + ML_GF + dir * 8 + h]) + p.mlstm_gate_b[((l * 2 + dir) * 2 + 0) * 4 + h];
        const float lf = logsig(bf2f(p.cols[(size_t)row * NCM + ML_GF + dir * 8 + 4 + h]) + p.mlstm_gate_b[((l * 2 + dir) * 2 + 1) * 4 + h]);
        const float fc = wscan_add(lf, lane);
        const float fe = __shfl(fc, 63, 64);
        const float lw = fe - fc + ip;
        const float ae = wmaxr(lw);
        wend[lane] = __expf(lw - ae);
        if (lane == 0) { p.mlFE[idx] = fe; p.mlAE[idx] = ae; }
    }
    __syncthreads();
    {
        const int s = tid >> 2, dg = tid & 3, row = row0 + (dir ? 63 - s : s);
        float kk[16], vv[16];
        ld16bf(p.cols + (size_t)row * NCM + ML_K + h * 64 + dg * 16, kk);
        ld16bf(p.cols + (size_t)row * NCM + ML_V + h * 64 + dg * 16, vv);
        const float ws = wend[s] * 0.125f;
#pragma unroll
        for (int i = 0; i < 16; ++i) {
            const int d = dg * 16 + i;
            kwT[d * LDP + s] = f2bf(kk[i] * ws);
            vT[d * LDP + s] = f2bf(vv[i]);
        }
    }
    __syncthreads();
    if (tid < 64) {
        float a = 0.f;
        for (int s = 0; s < 64; ++s) a += bf2f(kwT[tid * LDP + s]);
        p.mlN[idx * 64 + tid] = a;
    }
    f32x4 acc[4]; zero4(acc);
    mm64(acc, kwT, LDP, vT, LDP);
#pragma unroll
    for (int nt = 0; nt < 4; ++nt) {
        const int d = 16 * w + fq * 4, e = nt * 16 + fr;
        u32x2 pk; pk.x = pack2(acc[nt][0], acc[nt][1]); pk.y = pack2(acc[nt][2], acc[nt][3]);
        *(u32x2*)(p.mlS + idx * 4096 + e * 64 + d) = pk;
    }
    __syncthreads();
}

DEV void gd_phaseA(const P& p, int l, const u16* gqkv, int dir, int b, int st, int h, unsigned char* smraw) {
    float* X = (float*)smraw;
    float* cum = X + 64 * 65 + 32;
    float* beta = cum + 64;
    float* be = beta + 64;
    float* ke = be + 64;
    float* scal = ke + 64;
    u16* Y0 = (u16*)(scal + 64);
    u16* Y1 = Y0 + 64 * LDP;
    u16* Y2 = Y1 + 64 * LDP;
    u16* Y3 = Y2 + 64 * LDP;
    u16* Y4 = Y3 + 64 * LDP;
    u16* Y5 = Y4 + 64 * LDP;
    u16* wT = (u16*)X;
    const int tid = tidx(), lane = tid & 63, w = tid >> 6, fr = lane & 15, fq = lane >> 4;
    const int row0 = chunk_row0(b, dir, st);
    const size_t idx = state_idx(dir, b, st, h);
    if (w == 0) {
        const int row = row0 + (dir ? 63 - lane : lane);
        const float bp = bf2f(p.cols[(size_t)row * NCM + GD_GF + dir * 8 + h]);
        const float ap = bf2f(p.cols[(size_t)row * NCM + GD_GF + dir * 8 + 4 + h]);
        const float bt = sigm(bp);
        const float g = -__expf(p.gdn_a_log[(l * 2 + dir) * 4 + h]) * softplus(ap + p.gdn_dt_bias[(l * 2 + dir) * 4 + h]);
        const float cm = wscan_add(g, lane);
        const float ce = __shfl(cm, 63, 64);
        cum[lane] = cm; beta[lane] = bt; be[lane] = bt * __expf(cm); ke[lane] = __expf(ce - cm);
        if (lane == 0) scal[0] = __expf(ce);
    }
    {
        const int s = tid >> 2, dg = tid & 3, row = row0 + (dir ? 63 - s : s);
        const u16* src = gqkv + (size_t)row * 768 + h * 64 + dg * 16;
        const u32x4 q0 = *(const u32x4*)src, q1 = *(const u32x4*)(src + 8);
        const u32x4 k0 = *(const u32x4*)(src + 256), k1 = *(const u32x4*)(src + 264);
        const u32x4 v0 = *(const u32x4*)(src + 512), v1 = *(const u32x4*)(src + 520);
        *(u32x4*)(Y0 + s * LDP + dg * 16) = q0; *(u32x4*)(Y0 + s * LDP + dg * 16 + 8) = q1;
        *(u32x4*)(Y1 + s * LDP + dg * 16) = k0; *(u32x4*)(Y1 + s * LDP + dg * 16 + 8) = k1;
        const unsigned kw[8] = {k0.x, k0.y, k0.z, k0.w, k1.x, k1.y, k1.z, k1.w};
        const unsigned vw[8] = {v0.x, v0.y, v0.z, v0.w, v1.x, v1.y, v1.z, v1.w};
#pragma unroll
        for (int i = 0; i < 8; ++i) {
            Y2[(dg * 16 + 2 * i) * LDP + s] = (u16)(kw[i] & 0xffff); Y2[(dg * 16 + 2 * i + 1) * LDP + s] = (u16)(kw[i] >> 16);
            Y3[(dg * 16 + 2 * i) * LDP + s] = (u16)(vw[i] & 0xffff); Y3[(dg * 16 + 2 * i + 1) * LDP + s] = (u16)(vw[i] >> 16);
        }
    }
    __syncthreads();
    {
        f32x4 kk[4], qk[4]; zero4(kk); zero4(qk);
        mm64(kk, Y1, LDP, Y1, LDP);
        mm64(qk, Y0, LDP, Y1, LDP);
#pragma unroll
        for (int nt = 0; nt < 4; ++nt)
#pragma unroll
            for (int j = 0; j < 4; ++j) {
                const int c = 16 * w + fq * 4 + j, s = nt * 16 + fr;
                const float gam = s <= c ? __expf(cum[c] - cum[s]) : 0.f;
                if (s < c) X[c * 65 + s] = beta[c] * kk[nt][j] * gam;
                Y4[c * LDP + s] = f2bf(qk[nt][j] * gam);
            }
    }
    __syncthreads();
    if (w == 0) {
        const int col = lane;
        X[col * 65 + col + 1] = 1.f;
        for (int c = 1; c < 64; ++c) {
            float a = 0.f;
            for (int s = 0; s < c; ++s) {
                const float av = X[c * 65 + s];
                const float tv = (s >= col) ? X[col * 65 + s + 1] : 0.f;
                a += av * tv;
            }
            if (c > col) X[col * 65 + c + 1] = -a;
        }
    }
    __syncthreads();
    {
        const int c = tid >> 2, sgp = tid & 3;
        float tw[16], tu[16];
#pragma unroll
        for (int i = 0; i < 16; ++i) {
            const int s = sgp * 16 + i;
            const float t = s <= c ? X[s * 65 + c + 1] : 0.f;
            tw[i] = t * be[s]; tu[i] = t * beta[s];
        }
        st16bf(Y0 + c * LDP + sgp * 16, tw);
        st16bf(Y1 + c * LDP + sgp * 16, tu);
    }
    __syncthreads();
    {
        f32x4 wa[4], ua[4]; zero4(wa); zero4(ua);
        mm64(wa, Y0, LDP, Y2, LDP);
        mm64(ua, Y1, LDP, Y3, LDP);
        __syncthreads();
        const int c0 = 16 * w + fq * 4;
        const float k0 = ke[c0], k1 = ke[c0 + 1], k2 = ke[c0 + 2], k3 = ke[c0 + 3];
#pragma unroll
        for (int nt = 0; nt < 4; ++nt) {
            const int d = nt * 16 + fr;
            u32x2 a, bq, c, dq_;
            a.x = pack2(wa[nt][0], wa[nt][1]); a.y = pack2(wa[nt][2], wa[nt][3]);
            bq.x = pack2(wa[nt][0] * k0, wa[nt][1] * k1); bq.y = pack2(wa[nt][2] * k2, wa[nt][3] * k3);
            c.x = pack2(ua[nt][0], ua[nt][1]); c.y = pack2(ua[nt][2], ua[nt][3]);
            dq_.x = pack2(ua[nt][0] * k0, ua[nt][1] * k1); dq_.y = pack2(ua[nt][2] * k2, ua[nt][3] * k3);
            *(u32x2*)(wT + d * LDP + c0) = a;
            *(u32x2*)(Y5 + d * LDP + c0) = bq;
            *(u32x2*)(Y0 + d * LDP + c0) = c;
            *(u32x2*)(Y1 + d * LDP + c0) = dq_;
        }
    }
    __syncthreads();
    {
        const float dec = scal[0];
        f32x4 acc[4];
        zero4(acc); mm64(acc, wT, LDP, Y4, LDP);
#pragma unroll
        for (int nt = 0; nt < 4; ++nt) {
            const int d = 16 * w + fq * 4, c = nt * 16 + fr, row = row0 + (dir ? 63 - c : c);
            const u32x2 qv = *(const u32x2*)(gqkv + (size_t)row * 768 + h * 64 + d);
            const float ec = __expf(cum[c]);
            u32x2 pk;
            pk.x = pack2(__uint_as_float(qv.x << 16) * ec - acc[nt][0], __uint_as_float(qv.x & 0xffff0000u) * ec - acc[nt][1]);
            pk.y = pack2(__uint_as_float(qv.y << 16) * ec - acc[nt][2], __uint_as_float(qv.y & 0xffff0000u) * ec - acc[nt][3]);
            *(u32x2*)(p.gdQ + idx * 4096 + c * 64 + d) = pk;
        }
        zero4(acc); mm64(acc, Y5, LDP, Y2, LDP);
#pragma unroll
        for (int nt = 0; nt < 4; ++nt) {
            const int d = 16 * w + fq * 4, d2 = nt * 16 + fr;
            u32x2 pk;
            pk.x = pack2((d == d2 ? dec : 0.f) - acc[nt][0], (d + 1 == d2 ? dec : 0.f) - acc[nt][1]);
            pk.y = pack2((d + 2 == d2 ? dec : 0.f) - acc[nt][2], (d + 3 == d2 ? dec : 0.f) - acc[nt][3]);
            *(u32x2*)(p.gdM + idx * 4096 + d2 * 64 + d) = pk;
        }
        zero4(acc); mm64(acc, Y2, LDP, Y1, LDP);
#pragma unroll
        for (int nt = 0; nt < 4; ++nt) {
            const int d2 = 16 * w + fq * 4, e = nt * 16 + fr;
            u32x2 pk; pk.x = pack2(acc[nt][0], acc[nt][1]); pk.y = pack2(acc[nt][2], acc[nt][3]);
            *(u32x2*)(p.gdN + idx * 4096 + e * 64 + d2) = pk;
        }
        zero4(acc); mm64(acc, Y4, LDP, Y0, LDP);
#pragma unroll
        for (int nt = 0; nt < 4; ++nt) {
            const int c = 16 * w + fq * 4, e = nt * 16 + fr;
            u32x2 pk; pk.x = pack2(acc[nt][0], acc[nt][1]); pk.y = pack2(acc[nt][2], acc[nt][3]);
            *(u32x2*)(p.gdO + idx * 4096 + e * 64 + c) = pk;
        }
    }
    __syncthreads();
}

DEV void phase_chunkA(const P& p, int l, const u16* gqkv, int bid, int nb, unsigned char* sm) {
    for (int u = bid; u < 3 * 2112; u += nb) {
        const int mix = u / 2112, v = u % 2112;
        const int h = v & 3, st = (v >> 2) % NSTEP, db = (v >> 2) / NSTEP, b = db & 1, dir = db >> 1;
        if (mix == 0) gd_phaseA(p, l, gqkv, dir, b, st, h, sm);
        else if (mix == 1) gla_phaseA(p, l, dir, b, st, h, sm);
        else ml_phaseA(p, l, dir, b, st, h, sm);
    }
}
DEV void gd_scan(const P& p, int chain, u16* sm) {
    const int dir = chain >> 3, b = (chain >> 2) & 1, h = chain & 3;
    const int lane = tidx() & 63, w = tidx() >> 6, fr = lane & 15, fq = lane >> 4;
    u16* sl = sm + w * 16 * LDP;
    bf16x8 sb[2];
    sb[0] = bf16x8{0, 0, 0, 0, 0, 0, 0, 0}; sb[1] = sb[0];
    bf16x8 a[4][2]; u32x2 nv[4];
    {
        const size_t idx = state_idx(dir, b, 0, h);
#pragma unroll
        for (int mt = 0; mt < 4; ++mt) {
#pragma unroll
            for (int ks = 0; ks < 2; ++ks) a[mt][ks] = *(const bf16x8*)(p.gdM + idx * 4096 + (mt * 16 + fr) * 64 + ks * 32 + fq * 8);
            nv[mt] = *(const u32x2*)(p.gdN + idx * 4096 + (16 * w + fr) * 64 + mt * 16 + fq * 4);
        }
    }
    for (int st = 0; st < NSTEP; ++st) {
        const size_t idx = state_idx(dir, b, st, h);
        f32x4 acc[4];
#pragma unroll
        for (int mt = 0; mt < 4; ++mt) {
            acc[mt][0] = __uint_as_float(nv[mt].x << 16); acc[mt][1] = __uint_as_float(nv[mt].x & 0xffff0000u);
            acc[mt][2] = __uint_as_float(nv[mt].y << 16); acc[mt][3] = __uint_as_float(nv[mt].y & 0xffff0000u);
        }
#pragma unroll
        for (int mt = 0; mt < 4; ++mt)
#pragma unroll
            for (int ks = 0; ks < 2; ++ks) acc[mt] = mfma16(a[mt][ks], sb[ks], acc[mt]);
#pragma unroll
        for (int ks = 0; ks < 2; ++ks) *(bf16x8*)(p.gdN + idx * 4096 + (16 * w + fr) * 64 + ks * 32 + fq * 8) = sb[ks];
        if (st + 1 < NSTEP) {
            const size_t nx = state_idx(dir, b, st + 1, h);
#pragma unroll
            for (int mt = 0; mt < 4; ++mt) {
#pragma unroll
                for (int ks = 0; ks < 2; ++ks) a[mt][ks] = *(const bf16x8*)(p.gdM + nx * 4096 + (mt * 16 + fr) * 64 + ks * 32 + fq * 8);
                nv[mt] = *(const u32x2*)(p.gdN + nx * 4096 + (16 * w + fr) * 64 + mt * 16 + fq * 4);
            }
        }
#pragma unroll
        for (int mt = 0; mt < 4; ++mt) {
            u32x2 pk; pk.x = pack2(acc[mt][0], acc[mt][1]); pk.y = pack2(acc[mt][2], acc[mt][3]);
            *(u32x2*)(sl + fr * LDP + mt * 16 + fq * 4) = pk;
        }
        __builtin_amdgcn_fence(__ATOMIC_RELEASE, "wavefront");
        __builtin_amdgcn_wave_barrier();
        __builtin_amdgcn_fence(__ATOMIC_ACQUIRE, "wavefront");
#pragma unroll
        for (int ks = 0; ks < 2; ++ks) sb[ks] = *(const bf16x8*)(sl + fr * LDP + ks * 32 + fq * 8);
        __builtin_amdgcn_wave_barrier();
    }
}

DEV void gla_scan(const P& p, int v) {
    const int chain = v >> 3, sub = v & 7;
    const int dir = chain >> 3, b = (chain >> 2) & 1, h = chain & 3;
    const int ep = sub * 256 + tidx(), d = (2 * ep) & 63;
    float s0 = 0.f, s1 = 0.f;
    for (int st0 = 0; st0 < NSTEP; st0 += 4) {
        unsigned kv[4]; float2 dc[4];
#pragma unroll
        for (int k = 0; k < 4; ++k) {
            const size_t idx = state_idx(dir, b, st0 + k, h);
            kv[k] = *(const unsigned*)(p.glaS + idx * 4096 + 2 * ep);
            dc[k] = *(const float2*)(p.glaDec + idx * 64 + d);
        }
#pragma unroll
        for (int k = 0; k < 4; ++k) {
            const size_t idx = state_idx(dir, b, st0 + k, h);
            *(unsigned*)(p.glaS + idx * 4096 + 2 * ep) = pack2(s0, s1);
            s0 = dc[k].x * s0 + __uint_as_float(kv[k] << 16);
            s1 = dc[k].y * s1 + __uint_as_float(kv[k] & 0xffff0000u);
        }
    }
}

DEV void ml_scan(const P& p, int v) {
    const int chain = v >> 3, sub = v & 7;
    const int dir = chain >> 3, b = (chain >> 2) & 1, h = chain & 3;
    const int ep = sub * 256 + tidx();
    float s0 = 0.f, s1 = 0.f, m = 0.f, nn = 0.f;
    const bool do_n = (sub == 0 && tidx() < 64);
    for (int st0 = 0; st0 < NSTEP; st0 += 4) {
        unsigned kv[4]; float fe[4], ae[4], ks[4];
#pragma unroll
        for (int k = 0; k < 4; ++k) {
            const size_t idx = state_idx(dir, b, st0 + k, h);
            kv[k] = *(const unsigned*)(p.mlS + idx * 4096 + 2 * ep);
            fe[k] = p.mlFE[idx]; ae[k] = p.mlAE[idx];
            ks[k] = do_n ? p.mlN[idx * 64 + tidx()] : 0.f;
        }
#pragma unroll
        for (int k = 0; k < 4; ++k) {
            const size_t idx = state_idx(dir, b, st0 + k, h);
            *(unsigned*)(p.mlS + idx * 4096 + 2 * ep) = pack2(s0, s1);
            if (do_n) p.mlN[idx * 64 + tidx()] = nn;
            if (sub == 0 && tidx() == 0) p.mlM[idx] = m;
            const float mn = fmaxf(fe[k] + m, ae[k]);
            const float od = __expf(fe[k] + m - mn), nw = __expf(ae[k] - mn);
            s0 = od * s0 + nw * __uint_as_float(kv[k] << 16);
            s1 = od * s1 + nw * __uint_as_float(kv[k] & 0xffff0000u);
            nn = od * nn + nw * ks[k];
            m = mn;
        }
    }
}

DEV void phase_scan(const P& p, int bid, int nb, u16* sm) {
    for (int u = bid; u < 16 + 128 + 128; u += nb) {
        if (u < 16) gd_scan(p, u, sm);
        else if (u < 144) gla_scan(p, u - 16);
        else ml_scan(p, u - 144);
    }
}
DEV void chunk_geom(int g, int& b, int& row0, int& stf, int& stb) {
    b = g / NSTEP; const int wv = g % NSTEP;
    row0 = wv < 4 ? RLAT + b * CTXL + wv * 64 : b * SEQ + (wv - 4) * 64;
    stf = wv; stb = wv < 4 ? 3 - wv : 135 - wv;
}
DEV void obuf_acc(float* obuf, const f32x4 (&acc)[4], int dir) {
    const int lane = tidx() & 63, w = tidx() >> 6, fr = lane & 15, fq = lane >> 4;
#pragma unroll
    for (int nt = 0; nt < 4; ++nt)
#pragma unroll
        for (int j = 0; j < 4; ++j) {
            const int c = 16 * w + fq * 4 + j, e = nt * 16 + fr;
            if (dir == 0) obuf[c * 65 + e] = acc[nt][j]; else obuf[(63 - c) * 65 + e] += acc[nt][j];
        }
}
template <int ACT>
DEV void head_out(const P& p, int l, int br, int h, int row0, int gcol, const float* obuf) {
    const int tid = tidx(), row = tid >> 2, eg = tid & 3;
    float o[16]; float ss = 0.f;
#pragma unroll
    for (int i = 0; i < 16; ++i) { o[i] = obuf[row * 65 + eg * 16 + i]; ss += o[i] * o[i]; }
    ss += __shfl_xor(ss, 1, 64); ss += __shfl_xor(ss, 2, 64);
    const float rs = rsqrtf(ss * (1.f / 64.f) + EPSF);
    float gt[16];
    ld16bf(p.cols + (size_t)(row0 + row) * NCM + gcol + h * 64 + eg * 16, gt);
    float y[16];
#pragma unroll
    for (int i = 0; i < 16; ++i) {
        const float hn = p.head_norm[(l * 4 + br) * 256 + h * 64 + eg * 16 + i];
        const float a = ACT == 0 ? silu(gt[i]) : sigm(gt[i]);
        y[i] = o[i] * rs * hn * a;
    }
    st16bf(p.ybuf + (size_t)(row0 + row) * 1024 + br * 256 + h * 64 + eg * 16, y);
}

DEV void gla_phaseC(const P& p, int l, int g, int h, unsigned char* smraw) {
    float* cum = (float*)smraw;
    float* rt = cum + 64 * 65;
    float* sg = rt + 64 * 17;
    float* obuf = sg + 256;
    u16* qi = (u16*)(obuf + 64 * 65);
    u16* ko = qi + 64 * LDP;
    u16* vT = ko + 64 * LDP;
    const int tid = tidx(), lane = tid & 63, w = tid >> 6, fr = lane & 15, fq = lane >> 4;
    int b, row0, stf, stb; chunk_geom(g, b, row0, stf, stb);
    for (int dir = 0; dir < 2; ++dir) {
        const size_t idx = state_idx(dir, b, dir ? stb : stf, h);
        gla_cum(p, l, dir, h, row0, cum, rt, sg);
        {
            const int s = tid >> 2, dg = tid & 3, row = row0 + (dir ? 63 - s : s);
            float qq[16], kk[16], vv[16];
            ld16bf(p.cols + (size_t)row * NCM + GLA_Q + h * 64 + dg * 16, qq);
            ld16bf(p.cols + (size_t)row * NCM + GLA_K + h * 64 + dg * 16, kk);
            ld16bf(p.cols + (size_t)row * NCM + GLA_V + h * 64 + dg * 16, vv);
#pragma unroll
            for (int i = 0; i < 16; ++i) {
                const float cv = cum[s * 65 + dg * 16 + i];
                qq[i] *= 0.125f * __expf(cv); kk[i] *= __expf(-cv);
                vT[(dg * 16 + i) * LDP + s] = f2bf(vv[i]);
            }
            st16bf(qi + s * LDP + dg * 16, qq);
            st16bf(ko + s * LDP + dg * 16, kk);
        }
        __syncthreads();
        f32x4 sa[4]; zero4(sa);
        mm64(sa, qi, LDP, ko, LDP);
        __syncthreads();
#pragma unroll
        for (int nt = 0; nt < 4; ++nt)
#pragma unroll
            for (int j = 0; j < 4; ++j) {
                const int c = 16 * w + fq * 4 + j, s = nt * 16 + fr;
                ko[c * LDP + s] = f2bf(s <= c ? sa[nt][j] : 0.f);
            }
        __syncthreads();
        f32x4 oa[4]; zero4(oa);
        mm64(oa, ko, LDP, vT, LDP);
        mm64(oa, qi, LDP, p.glaS + idx * 4096, 64);
        obuf_acc(obuf, oa, dir);
        __syncthreads();
    }
    head_out<0>(p, l, 0, h, row0, GLA_G, obuf);
    __syncthreads();
}

DEV void ml_phaseC(const P& p, int l, int g, int h, unsigned char* smraw) {
    float* obuf = (float*)smraw;
    float* fcum = obuf + 64 * 65;
    float* ipre = fcum + 64;
    float* mrow = ipre + 64;
    float* denl = mrow + 64;
    float* qn = denl + 64;
    float* nin = qn + 64;
    u16* qs = (u16*)(nin + 64 + 64);
    u16* ks = qs + 64 * LDP;
    u16* vT = ks + 64 * LDP;
    const int tid = tidx(), lane = tid & 63, w = tid >> 6, fr = lane & 15, fq = lane >> 4;
    int b, row0, stf, stb; chunk_geom(g, b, row0, stf, stb);
    for (int dir = 0; dir < 2; ++dir) {
        const size_t idx = state_idx(dir, b, dir ? stb : stf, h);
        const float m_in = p.mlM[idx];
        if (w == 0) {
            const int row = row0 + (dir ? 63 - lane : lane);
            const float ip = bf2f(p.cols[(size_t)row * NCM + ML_GF + dir * 8 + h]) + p.mlstm_gate_b[((l * 2 + dir) * 2 + 0) * 4 + h];
            const float lf = logsig(bf2f(p.cols[(size_t)row * NCM + ML_GF + dir * 8 + 4 + h]) + p.mlstm_gate_b[((l * 2 + dir) * 2 + 1) * 4 + h]);
            const float fc = wscan_add(lf, lane);
            const float pm = wscan_max(ip - fc, lane);
            fcum[lane] = fc; ipre[lane] = ip; mrow[lane] = fc + fmaxf(m_in, pm);
            nin[lane] = p.mlN[idx * 64 + lane];
        }
        {
            const int s = tid >> 2, dg = tid & 3, row = row0 + (dir ? 63 - s : s);
            float kk[16], vv[16];
            const u16* qsrc = p.cols + (size_t)row * NCM + ML_Q + h * 64 + dg * 16;
            *(u32x4*)(qs + s * LDP + dg * 16) = *(const u32x4*)qsrc;
            *(u32x4*)(qs + s * LDP + dg * 16 + 8) = *(const u32x4*)(qsrc + 8);
            ld16bf(p.cols + (size_t)row * NCM + ML_K + h * 64 + dg * 16, kk);
            ld16bf(p.cols + (size_t)row * NCM + ML_V + h * 64 + dg * 16, vv);
#pragma unroll
            for (int i = 0; i < 16; ++i) { kk[i] *= 0.125f; vT[(dg * 16 + i) * LDP + s] = f2bf(vv[i]); }
            st16bf(ks + s * LDP + dg * 16, kk);
        }
        __syncthreads();
        {
            const int c = tid >> 2, dg = tid & 3;
            float a = 0.f;
#pragma unroll
            for (int i = 0; i < 16; ++i) a += bf2f(qs[c * LDP + dg * 16 + i]) * nin[dg * 16 + i];
            a += __shfl_xor(a, 1, 64); a += __shfl_xor(a, 2, 64);
            if (dg == 0) qn[c] = a;
        }
        f32x4 sa[4]; zero4(sa);
        mm64(sa, qs, LDP, ks, LDP);
        __syncthreads();
        float dsum[4] = {0.f, 0.f, 0.f, 0.f};
#pragma unroll
        for (int nt = 0; nt < 4; ++nt)
#pragma unroll
            for (int j = 0; j < 4; ++j) {
                const int c = 16 * w + fq * 4 + j, s = nt * 16 + fr;
                float val = 0.f;
                if (s <= c) val = sa[nt][j] * __expf(fcum[c] - fcum[s] + ipre[s] - mrow[c]);
                dsum[j] += val;
                ks[c * LDP + s] = f2bf(val);
            }
#pragma unroll
        for (int j = 0; j < 4; ++j) {
            float v = dsum[j];
            v += __shfl_xor(v, 1, 64); v += __shfl_xor(v, 2, 64); v += __shfl_xor(v, 4, 64); v += __shfl_xor(v, 8, 64);
            if (fr == 0) denl[16 * w + fq * 4 + j] = v;
        }
        __syncthreads();
        f32x4 n1[4], n2[4]; zero4(n1); zero4(n2);
        mm64(n1, ks, LDP, vT, LDP);
        mm64(n2, qs, LDP, p.mlS + idx * 4096, 64);
        f32x4 oa[4];
#pragma unroll
        for (int j = 0; j < 4; ++j) {
            const int c = 16 * w + fq * 4 + j;
            const float mr = mrow[c];
            const float ec = __expf(fcum[c] + m_in - mr);
            const float den = denl[c] + ec * qn[c];
            const float inv = 1.f / fmaxf(fabsf(den), __expf(-mr));
#pragma unroll
            for (int nt = 0; nt < 4; ++nt) oa[nt][j] = (n1[nt][j] + ec * n2[nt][j]) * inv;
        }
        obuf_acc(obuf, oa, dir);
        __syncthreads();
    }
    head_out<1>(p, l, 1, h, row0, ML_O, obuf);
    __syncthreads();
}

DEV void gd_phaseC(const P& p, int l, int g, int h, unsigned char* smraw) {
    float* obuf = (float*)smraw;
    const int tid = tidx(), lane = tid & 63, w = tid >> 6, fr = lane & 15, fq = lane >> 4;
    int b, row0, stf, stb; chunk_geom(g, b, row0, stf, stb);
    for (int dir = 0; dir < 2; ++dir) {
        const size_t idx = state_idx(dir, b, dir ? stb : stf, h);
        f32x4 oa[4];
#pragma unroll
        for (int nt = 0; nt < 4; ++nt) {
            const u32x2 ov = *(const u32x2*)(p.gdO + idx * 4096 + (nt * 16 + fr) * 64 + 16 * w + fq * 4);
            oa[nt][0] = __uint_as_float(ov.x << 16); oa[nt][1] = __uint_as_float(ov.x & 0xffff0000u);
            oa[nt][2] = __uint_as_float(ov.y << 16); oa[nt][3] = __uint_as_float(ov.y & 0xffff0000u);
        }
        mm64(oa, p.gdQ + idx * 4096, 64, p.gdN + idx * 4096, 64);
        obuf_acc(obuf, oa, dir);
        __syncthreads();
    }
    head_out<0>(p, l, 2, h, row0, GD_OG, obuf);
    __syncthreads();
}
DEV float fexp2(float x) { return __builtin_amdgcn_exp2f(x); }

DEV void attn_unit(const P& p, int l, int b, int h, int q0pos, int nkeys, int rowbase, u16* sm) {
    u16* Ks = sm;
    u16* Vs = sm + 64 * LDP;
    const int tid = tidx(), lane = tid & 63, w = tid >> 6, fr = lane & 15, fq = lane >> 4;
    const size_t bh = (size_t)(b * 4 + h);
    float lam;
    {
        const float* lp = p.diff_lambda + (size_t)l * 4 * 4 * 32;
        float a = 0.f, c = 0.f;
        if (lane < 32) { a = lp[(0 * 4 + h) * 32 + lane] * lp[(1 * 4 + h) * 32 + lane]; c = lp[(2 * 4 + h) * 32 + lane] * lp[(3 * 4 + h) * 32 + lane]; }
        a = wsum(a); c = wsum(c);
        const float lam_init = 0.8f - 0.6f * expf(-0.3f * (float)l);
        lam = expf(a) - expf(c) + lam_init;
    }
    const float lam_init = 0.8f - 0.6f * expf(-0.3f * (float)l);
    bf16x8 qf[2][2];
#pragma unroll
    for (int g = 0; g < 2; ++g)
#pragma unroll
        for (int i = 0; i < 2; ++i)
            qf[g][i] = *(const bf16x8*)(p.dq + (bh * KPOS + q0pos + w * 32 + g * 16 + fr) * 64 + i * 32 + fq * 8);
    f32x4 O[2][2][4];
    float mrun[2][2], lsum[2][2];
#pragma unroll
    for (int i = 0; i < 2; ++i)
#pragma unroll
        for (int g = 0; g < 2; ++g) {
            mrun[i][g] = -INFINITY; lsum[i][g] = 0.f;
#pragma unroll
            for (int t = 0; t < 4; ++t) O[i][g][t] = f32x4{0.f, 0.f, 0.f, 0.f};
        }
    const u16* kbase = p.dk + bh * KPOS * 64;
    const u16* vbase = p.dvT + bh * 64 * KPOS;
    const int nk = nkeys >> 6;
    u32x4 rk[2], rv[2];
#pragma unroll
    for (int i = 0; i < 2; ++i) {
        const int c = tid + i * 256, r = c >> 3, cc = c & 7;
        rk[i] = *(const u32x4*)(kbase + (size_t)r * 64 + cc * 8);
        rv[i] = *(const u32x4*)(vbase + (size_t)r * KPOS + cc * 8);
    }
    for (int kt = 0; kt < nk; ++kt) {
#pragma unroll
        for (int i = 0; i < 2; ++i) {
            const int c = tid + i * 256, r = c >> 3, cc = c & 7;
            *(u32x4*)(Ks + r * LDP + cc * 8) = rk[i];
            *(u32x4*)(Vs + r * LDP + cc * 8) = rv[i];
        }
        __syncthreads();
        if (kt + 1 < nk) {
#pragma unroll
            for (int i = 0; i < 2; ++i) {
                const int c = tid + i * 256, r = c >> 3, cc = c & 7;
                rk[i] = *(const u32x4*)(kbase + (size_t)((kt + 1) * 64 + r) * 64 + cc * 8);
                rv[i] = *(const u32x4*)(vbase + (size_t)r * KPOS + (kt + 1) * 64 + cc * 8);
            }
        }
#pragma unroll
        for (int i = 0; i < 2; ++i) {
            f32x4 s[2][4];
#pragma unroll
            for (int st = 0; st < 4; ++st) {
                const bf16x8 kf = *(const bf16x8*)(Ks + (st * 16 + fr) * LDP + i * 32 + fq * 8);
#pragma unroll
                for (int g = 0; g < 2; ++g) s[g][st] = mfma16(kf, qf[g][i], f32x4{0.f, 0.f, 0.f, 0.f});
            }
            bf16x8 pb[2][2];
#pragma unroll
            for (int g = 0; g < 2; ++g) {
                float mx = s[g][0][0];
#pragma unroll
                for (int st = 0; st < 4; ++st)
#pragma unroll
                    for (int j = 0; j < 4; ++j) mx = fmaxf(mx, s[g][st][j]);
                mx = fmaxf(mx, __shfl_xor(mx, 16, 64)); mx = fmaxf(mx, __shfl_xor(mx, 32, 64));
                const float mn = fmaxf(mrun[i][g], mx);
                const float alpha = fexp2(mrun[i][g] - mn);
                mrun[i][g] = mn;
                float ps = 0.f;
#pragma unroll
                for (int st = 0; st < 4; ++st)
#pragma unroll
                    for (int j = 0; j < 4; ++j) { const float e = fexp2(s[g][st][j] - mn); s[g][st][j] = e; ps += e; }
                lsum[i][g] = lsum[i][g] * alpha + ps;
#pragma unroll
                for (int t = 0; t < 4; ++t) { O[i][g][t][0] *= alpha; O[i][g][t][1] *= alpha; O[i][g][t][2] *= alpha; O[i][g][t][3] *= alpha; }
#pragma unroll
                for (int ks = 0; ks < 2; ++ks) {
                    union { bf16x8 v; unsigned u[4]; } pk;
                    pk.u[0] = pack2(s[g][2 * ks][0], s[g][2 * ks][1]); pk.u[1] = pack2(s[g][2 * ks][2], s[g][2 * ks][3]);
                    pk.u[2] = pack2(s[g][2 * ks + 1][0], s[g][2 * ks + 1][1]); pk.u[3] = pack2(s[g][2 * ks + 1][2], s[g][2 * ks + 1][3]);
                    pb[g][ks] = pk.v;
                }
            }
#pragma unroll
            for (int ks = 0; ks < 2; ++ks)
#pragma unroll
                for (int t = 0; t < 4; ++t) {
                    union { bf16x8 v; u32x2 h2[2]; } va;
                    va.h2[0] = *(const u32x2*)(Vs + (t * 16 + fr) * LDP + (2 * ks) * 16 + fq * 4);
                    va.h2[1] = *(const u32x2*)(Vs + (t * 16 + fr) * LDP + (2 * ks + 1) * 16 + fq * 4);
#pragma unroll
                    for (int g = 0; g < 2; ++g) O[i][g][t] = mfma16(va.v, pb[g][ks], O[i][g][t]);
                }
        }
        __syncthreads();
    }
#pragma unroll
    for (int g = 0; g < 2; ++g) {
        float l0 = lsum[0][g], l1 = lsum[1][g];
        l0 += __shfl_xor(l0, 16, 64); l0 += __shfl_xor(l0, 32, 64);
        l1 += __shfl_xor(l1, 16, 64); l1 += __shfl_xor(l1, 32, 64);
        const float i0 = 1.f / l0, i1 = lam / l1;
        float o[4][4]; float ss = 0.f;
#pragma unroll
        for (int t = 0; t < 4; ++t)
#pragma unroll
            for (int j = 0; j < 4; ++j) { o[t][j] = O[0][g][t][j] * i0 - O[1][g][t][j] * i1; ss += o[t][j] * o[t][j]; }
        ss += __shfl_xor(ss, 16, 64); ss += __shfl_xor(ss, 32, 64);
        const float rs = rsqrtf(ss * (1.f / 64.f) + EPSF) * (1.f - lam_init);
        const int row = rowbase + w * 32 + g * 16 + fr;
#pragma unroll
        for (int t = 0; t < 4; ++t) {
            const int dv = t * 16 + fq * 4;
            const float4 hn = *(const float4*)(p.head_norm + (l * 4 + 3) * 256 + h * 64 + dv);
            u32x2 pk; pk.x = pack2(o[t][0] * rs * hn.x, o[t][1] * rs * hn.y); pk.y = pack2(o[t][2] * rs * hn.z, o[t][3] * rs * hn.w);
            *(u32x2*)(p.ybuf + (size_t)row * 1024 + 768 + h * 64 + dv) = pk;
        }
    }
}

DEV void phase_outputs(const P& p, int l, int bid, int nb, unsigned char* sm) {
    const int n_att = 512 + (l == 0 ? 16 : 0);
    for (int u = bid; u < n_att; u += nb) {
        int b, h, q0pos, nkeys, rowbase;
        if (u < 512) { b = u >> 8; h = (u >> 6) & 3; const int qt = u & 63; q0pos = CTXL + qt * 128; nkeys = KPOS; rowbase = b * SEQ + qt * 128; }
        else { const int v = u - 512; b = v >> 3; h = (v >> 1) & 3; const int qt = v & 1; q0pos = qt * 128; nkeys = CTXL; rowbase = RLAT + b * CTXL + qt * 128; }
        attn_unit(p, l, b, h, q0pos, nkeys, rowbase, (u16*)sm);
    }
    __builtin_amdgcn_sched_barrier(0);
    const int v0 = ((bid - n_att) % nb + nb) % nb;
    for (int v = v0; v < 3 * 1056; v += nb) {
        const int mix = v / 1056, r = v % 1056, g = r >> 2, h = r & 3;
        if (l == 1 && (g % NSTEP) < 4) continue;
        if (mix == 0) gla_phaseC(p, l, g, h, sm);
        else if (mix == 1) ml_phaseC(p, l, g, h, sm);
        else gd_phaseC(p, l, g, h, sm);
    }
}
#define LDS_BYTES 73728
#ifndef MULTI
#define MULTI 0
#endif
#ifndef STAGE
#define STAGE 99
#endif

enum { PH_PRO0 = 0, PH_PRO1, PH_NORM1, PH_INPROJ, PH_PREP, PH_CHUNKA, PH_SCAN, PH_OUT, PH_GATES, PH_MERGE1, PH_MERGE2, PH_ROUTER, PH_MOEUP, PH_MOEDOWN, PH_FINAL };

template <int PH>
DEV void run_phase(const P& p, int l, int bid_, int nb_, unsigned char* sm) {
    const int bid = launder_s(bid_), nb = launder_s(nb_);
    u16* gqkv = p.ybuf;
    u16* ubuf = p.glaS;
    const int mtiles = l == 0 ? 132 : 128;
    if (PH == PH_PRO0) { phase_conv_mixw(p, 0, bid, nb, (float*)sm); phase_mod_partial(p, bid, nb, (float*)sm); }
    else if (PH == PH_PRO1) phase_mod_reduce(p, bid, nb);
    else if (PH == PH_NORM1) phase_norm1(p, l, bid, nb);
    else if (PH == PH_INPROJ) phase_inproj<false>(p, 0, 31, NCM, 132, bid, nb, (u16*)sm);
    else if (PH == PH_PREP) phase_prep(p, l, gqkv, bid, nb, (u16*)sm);
    else if (PH == PH_CHUNKA) phase_chunkA(p, l, gqkv, bid, nb, sm);
    else if (PH == PH_SCAN) phase_scan(p, bid, nb, (u16*)sm);
    else if (PH == PH_OUT) phase_outputs(p, l, bid, nb, sm);
    else if (PH == PH_GATES) phase_inproj<true>(p, 3968, 32, NGATE, mtiles, bid, nb, (u16*)sm);
    else if (PH == PH_MERGE1) phase_merge1(p, ubuf, mtiles, bid, nb, (u16*)sm);
    else if (PH == PH_MERGE2) phase_merge2(p, l, ubuf, mtiles, bid, nb, (u16*)sm);
    else if (PH == PH_ROUTER) {
        phase_norm2_router(p, l, l == 0 ? RTOT : RLAT, bid, nb, (float*)sm);
        phase_conv_moew(p, l, bid, nb, (float*)sm);
        if (l == 0) phase_conv_mixw(p, 1, bid, nb, (float*)sm);
    }
    else if (PH == PH_MOEUP) phase_moe_up(p, l, bid, nb, (u16*)sm);
    else if (PH == PH_MOEDOWN) phase_moe_down(p, l, bid, nb, (u16*)sm);
    else if (PH == PH_FINAL) phase_final_norm(p, bid, nb);
}

#if MULTI
template <int PH>
__global__ void __launch_bounds__(NTHR, 2) k_phase(P p, int l) {
    extern __shared__ __attribute__((aligned(16))) unsigned char smem[];
    run_phase<PH>(p, l, blockIdx.x, gridDim.x, smem);
}
#else
__global__ void __launch_bounds__(NTHR, 2) k_mega(P p) {
    extern __shared__ __attribute__((aligned(16))) unsigned char smem[];
    volatile LAS unsigned* xbw = (volatile LAS unsigned*)(smem + LDS_BYTES);
    if (threadIdx.x == 0) { xbw[0] = 0u; xbw[1] = 0u; xbw[2] = 0u; xbw[3] = 0u; }
    __syncthreads();
    (void)xcd_barrier_post(p.bar, xbw);
    const int bid = blockIdx.x, nb = gridDim.x;
#define GBAR() do { XcdBarrier b_; b_.bar = p.bar; b_.x = xb_xcc_id(); b_.st = (volatile LAS unsigned*)(smem + LDS_BYTES); xcd_barrier(b_); } while (0)
    run_phase<PH_PRO0>(p, 0, bid, nb, smem); GBAR();
    run_phase<PH_PRO1>(p, 0, bid, nb, smem); GBAR();
    for (int l = 0; l < 2; ++l) {
        run_phase<PH_NORM1>(p, l, bid, nb, smem); GBAR();
        run_phase<PH_INPROJ>(p, l, bid, nb, smem); GBAR();
        run_phase<PH_PREP>(p, l, bid, nb, smem); GBAR();
        run_phase<PH_CHUNKA>(p, l, bid, nb, smem); GBAR();
        run_phase<PH_SCAN>(p, l, bid, nb, smem); GBAR();
        run_phase<PH_OUT>(p, l, bid, nb, smem); GBAR();
        run_phase<PH_GATES>(p, l, bid, nb, smem); GBAR();
        run_phase<PH_MERGE1>(p, l, bid, nb, smem); GBAR();
        run_phase<PH_MERGE2>(p, l, bid, nb, smem); GBAR();
        run_phase<PH_ROUTER>(p, l, bid, nb, smem); GBAR();
        run_phase<PH_MOEUP>(p, l, bid, nb, smem); GBAR();
        run_phase<PH_MOEDOWN>(p, l, bid, nb, smem); GBAR();
    }
    run_phase<PH_FINAL>(p, 0, bid, nb, smem);
}
#endif

static size_t al256(size_t x) { return (x + 255) & ~(size_t)255; }

extern "C" void kernel_launch(void* const* d_in, const int* in_sizes, int n_in, void* d_out, int out_size, void* d_ws, size_t ws_size,
                              hipStream_t stream) {
    (void)in_sizes; (void)n_in; (void)out_size; (void)ws_size;
    P p{};
    p.x = (const float*)d_in[0]; p.c = (const float*)d_in[1]; p.ctx = (const float*)d_in[2]; p.c_ctx = (const float*)d_in[3];
    p.w_mod = (const float*)d_in[4]; p.b_mod = (const float*)d_in[5]; p.norm_mix = (const float*)d_in[6]; p.norm_ffn = (const float*)d_in[7];
    p.w_in = (const float*)d_in[8]; p.gla_a2 = (const float*)d_in[9]; p.gla_ab = (const float*)d_in[10]; p.mlstm_gate_b = (const float*)d_in[11];
    p.gdn_conv = (const float*)d_in[12]; p.gdn_a_log = (const float*)d_in[13]; p.gdn_dt_bias = (const float*)d_in[14];
    p.diff_lambda = (const float*)d_in[15]; p.head_norm = (const float*)d_in[16]; p.w_branch = (const float*)d_in[17];
    p.w_out = (const float*)d_in[18]; p.router_w = (const float*)d_in[19]; p.router_b = (const float*)d_in[20];
    p.w_gate = (const float*)d_in[21]; p.w_up = (const float*)d_in[22]; p.w_down = (const float*)d_in[23]; p.norm_final = (const float*)d_in[24];
    p.out = (float*)d_out;
    unsigned char* ws = (unsigned char*)d_ws;
    size_t o = 0;
    auto take = [&](size_t bytes) { unsigned char* r = ws + o; o = al256(o + bytes); return r; };
    p.bar = (unsigned*)take(XCD_BAR_WORDS * 4);
    p.cnt = (int*)take(256);
    const size_t zero_bytes = o;
    p.modp = (float*)take((size_t)2 * 16 * 3 * 6144 * 4);
    p.mod = (float*)take((size_t)2 * 3 * 6144 * 4);
    p.xctx = (float*)take((size_t)RCTX * DM * 4);
    p.hbuf = (u16*)take((size_t)RTOT * DM * 2);
    p.ybuf = (u16*)take((size_t)RTOT * DM * 2);
    p.Wt = (u16*)take((size_t)WT_TOTAL * 2);
    p.dq = (u16*)take((size_t)8 * KPOS * 64 * 2);
    p.dk = (u16*)take((size_t)8 * KPOS * 64 * 2);
    p.dvT = (u16*)take((size_t)8 * KPOS * 64 * 2);
    const size_t nst = (size_t)2 * 2 * NSTEP * 4;
    p.glaDec = (float*)take(nst * 64 * 4);
    p.mlN = (float*)take(nst * 64 * 4);
    p.mlFE = (float*)take(nst * 4);
    p.mlAE = (float*)take(nst * 4);
    p.mlM = (float*)take(nst * 4);
    p.glaS = (u16*)take(nst * 4096 * 2);
    p.mlS = (u16*)take(nst * 4096 * 2);
    p.gdM = (u16*)take(nst * 4096 * 2);
    p.gdN = (u16*)take(nst * 4096 * 2);
    p.gdQ = (u16*)take(nst * 4096 * 2);
    p.gdO = (u16*)take(nst * 4096 * 2);
    p.cols = (u16*)take((size_t)RTOT * NGATE * 2);
    hipMemsetAsync(ws, 0, zero_bytes, stream);

    static int grid = 0;
#if MULTI
#define SETUP(PH) hipFuncSetAttribute((const void*)k_phase<PH>, hipFuncAttributeMaxDynamicSharedMemorySize, LDS_BYTES + 16)
    if (!grid) {
        SETUP(PH_PRO0); SETUP(PH_PRO1); SETUP(PH_NORM1); SETUP(PH_INPROJ); SETUP(PH_PREP); SETUP(PH_CHUNKA); SETUP(PH_SCAN); SETUP(PH_OUT);
        SETUP(PH_GATES); SETUP(PH_MERGE1); SETUP(PH_MERGE2); SETUP(PH_ROUTER); SETUP(PH_MOEUP); SETUP(PH_MOEDOWN); SETUP(PH_FINAL);
        grid = 512;
    }
#define LAUNCH(PH, l) k_phase<PH><<<grid, NTHR, LDS_BYTES + 16, stream>>>(p, l)
    LAUNCH(PH_PRO0, 0); LAUNCH(PH_PRO1, 0);
    for (int l = 0; l < 2; ++l) {
        LAUNCH(PH_NORM1, l);
#if STAGE >= 1
        LAUNCH(PH_INPROJ, l); LAUNCH(PH_PREP, l); LAUNCH(PH_CHUNKA, l); LAUNCH(PH_SCAN, l); LAUNCH(PH_OUT, l);
        LAUNCH(PH_GATES, l); LAUNCH(PH_MERGE1, l); LAUNCH(PH_MERGE2, l);
#endif
        LAUNCH(PH_ROUTER, l); LAUNCH(PH_MOEUP, l); LAUNCH(PH_MOEDOWN, l);
    }
    LAUNCH(PH_FINAL, 0);
#else
    if (!grid) {
        hipFuncSetAttribute((const void*)k_mega, hipFuncAttributeMaxDynamicSharedMemorySize, LDS_BYTES + 16);
        int dev = 0, cus = 0, per_cu = 0;
        hipGetDevice(&dev);
        hipDeviceGetAttribute(&cus, hipDeviceAttributeMultiprocessorCount, dev);
        hipOccupancyMaxActiveBlocksPerMultiprocessor(&per_cu, (const void*)k_mega, NTHR, LDS_BYTES + 16);
        if (per_cu > 2) per_cu = 2;
        if (per_cu < 1) per_cu = 1;
        grid = cus * per_cu;
    }
    k_mega<<<grid, NTHR, LDS_BYTES + 16, stream>>>(p);
#endif
}
```

```cpp
#include <hip/hip_runtime.h>
#include <stdint.h>
#include <math.h>

typedef unsigned short u16;
typedef short bf16x8 __attribute__((ext_vector_type(8)));
typedef float f32x4 __attribute__((ext_vector_type(4)));
typedef unsigned u32x2 __attribute__((ext_vector_type(2)));
typedef unsigned u32x4 __attribute__((ext_vector_type(4)));

#define DEV __device__ __forceinline__
#define NTHR 256

#define DM 1024
#define RLAT 16384
#define RCTX 512
#define RTOT 16896
#define SEQ 8192
#define CTXL 256
#define NCM 3968
#define NGATE 4096
#define NSTEP 132
#define KPOS 8448
#define EPSF 1e-6f
#define GLA_Q 0
#define GLA_K 256
#define GLA_V 512
#define GLA_G 768
#define GLA_RF 1024
#define GLA_RB 1040
#define ML_Q 1056
#define ML_K 1312
#define ML_V 1568
#define ML_O 1824
#define ML_GF 2080
#define ML_GB 2088
#define GD_Q 2096
#define GD_K 2352
#define GD_V 2608
#define GD_OG 2864
#define GD_GF 3120
#define GD_GB 3128
#define DF_Q 3136
#define DF_K 3392
#define DF_V 3648

DEV int tidx() { int t = threadIdx.x; asm volatile("" : "+v"(t)); __builtin_assume(t >= 0 && t < NTHR); return t; }
DEV int launder_s(int v) { asm volatile("" : "+s"(v)); return v; }
typedef __bf16 bf2_t __attribute__((ext_vector_type(2)));
typedef float f2_t __attribute__((ext_vector_type(2)));
DEV unsigned pack2(float a, float b) { f2_t v; v.x = a; v.y = b; return __builtin_bit_cast(unsigned, __builtin_convertvector(v, bf2_t)); }
DEV u16 f2bf(float f) { return (u16)(pack2(f, 0.f) & 0xffffu); }
DEV float bf2f(u16 h) { return __uint_as_float(((unsigned)h) << 16); }
DEV float sigm(float x) { return 1.f / (1.f + __expf(-x)); }
DEV float silu(float x) { return x / (1.f + __expf(-x)); }
DEV float logsig(float x) { return fminf(x, 0.f) - log1pf(__expf(-fabsf(x))); }
DEV float softplus(float x) { return fmaxf(x, 0.f) + log1pf(__expf(-fabsf(x))); }
DEV float wsum(float v) {
#pragma unroll
    for (int o = 32; o; o >>= 1) v += __shfl_xor(v, o, 64);
    return v;
}
DEV float wmaxr(float v) {
#pragma unroll
    for (int o = 32; o; o >>= 1) v = fmaxf(v, __shfl_xor(v, o, 64));
    return v;
}
DEV f32x4 mfma16(bf16x8 a, bf16x8 b, f32x4 c) { return __builtin_amdgcn_mfma_f32_16x16x32_bf16(a, b, c, 0, 0, 0); }

struct P {
    const float *x, *c, *ctx, *c_ctx, *w_mod, *b_mod, *norm_mix, *norm_ffn, *w_in, *gla_a2, *gla_ab, *mlstm_gate_b,
        *gdn_conv, *gdn_a_log, *gdn_dt_bias, *diff_lambda, *head_norm, *w_branch, *w_out, *router_w, *router_b,
        *w_gate, *w_up, *w_down, *norm_final;
    float* out;
    unsigned* bar;
    int* cnt;
    float* modp;
    float* mod;
    float* xctx;
    u16* hbuf;
    u16* ybuf;
    u16* Wt;
    u16* dq;
    u16* dk;
    u16* dvT;
    float* glaDec;
    float* mlN;
    float* mlFE;
    float* mlAE;
    float* mlM;
    u16* glaS;
    u16* mlS;
    u16* gdM;
    u16* gdN;
    u16* gdQ;
    u16* gdO;
    u16* cols;
};
#define MOE_WGU_OFF 0
#define MOE_WD_OFF (16u * 1024u * 1024u)
#define MOE_ACT_OFF (MOE_WD_OFF + 16u * 1024u * 512u)
#define MOE_LIST_OFF (MOE_ACT_OFF + 2u * RTOT * 512u)

DEV const float* xrow_in(const P& p, int l, int r) {
    if (l == 0) return r < RLAT ? p.x + (size_t)r * DM : p.ctx + (size_t)(r - RLAT) * DM;
    return r < RLAT ? p.out + (size_t)r * DM : p.xctx + (size_t)(r - RLAT) * DM;
}
DEV float* xrow_out(const P& p, int r) { return r < RLAT ? p.out + (size_t)r * DM : p.xctx + (size_t)(r - RLAT) * DM; }
DEV int modidx(int r) { return r < RLAT ? (r >> 13) : 2; }
DEV int chunk_row0(int b, int dir, int st) {
    if (st < 4) { int c = dir ? 3 - st : st; return RLAT + b * CTXL + c * 64; }
    int c = dir ? 131 - st : st - 4; return b * SEQ + c * 64;
}
DEV size_t state_idx(int dir, int b, int st, int h) { return ((size_t)((dir * 2 + b) * NSTEP + st) * 4 + h); }
#define XB_TMO      128
#define XB_XCNT(j)  (256  + 64 * (j))
#define XB_XSUB(j)  (1280 + 64 * (j))
#define XB_XGEN(j)  (2304 + 64 * (j))
#define XB_TOP      3328
#define XB_TOPGEN   3392
#define XCD_BAR_WORDS 3456
#define XB_SPIN_CAP (1u << 18)
#define LAS __attribute__((address_space(3)))

__device__ __forceinline__ unsigned xb_ld(unsigned* p)              { return __hip_atomic_load(p, __ATOMIC_RELAXED, __HIP_MEMORY_SCOPE_AGENT); }
__device__ __forceinline__ unsigned xb_add(unsigned* p, unsigned v) { return __hip_atomic_fetch_add(p, v, __ATOMIC_RELAXED, __HIP_MEMORY_SCOPE_AGENT); }
__device__ __forceinline__ unsigned xb_xcc_id() { return (unsigned)__builtin_amdgcn_s_getreg((3 << 11) | 20) & 0xFu; }
#define XB_SPIN(cond, bar) do { unsigned _sp = 0; while (cond) { __builtin_amdgcn_s_sleep(1); \
    if ((++_sp & 255u) == 0u) { if (xb_ld(&(bar)[XB_TMO])) break; if (_sp > XB_SPIN_CAP) { atomicAdd(&(bar)[XB_TMO], 1u); break; } } } } while (0)

struct XcdBarrier {
    unsigned* bar; unsigned x;
    volatile LAS unsigned* st;
};

__device__ __forceinline__ XcdBarrier xcd_barrier_post(unsigned* bar, volatile LAS unsigned* st) {
    XcdBarrier b; b.bar = bar; b.x = xb_xcc_id(); b.st = st;
    if (threadIdx.x == 0) (void)xb_add(&bar[XB_XCNT(b.x)], 1u);
    return b;
}
__device__ __forceinline__ void xcd_barrier_complete(unsigned* bar, unsigned x, unsigned& nloc, unsigned& nx) {
    const unsigned G = gridDim.x * gridDim.y * gridDim.z;
    unsigned sum, cnt, mine, sp = 0u;
    for (;;) {
        sum = 0u; cnt = 0u; mine = 0u;
#pragma unroll
        for (unsigned j = 0; j < 16; ++j) { const unsigned c = xb_ld(&bar[XB_XCNT(j)]); sum += c; cnt += (c > 0u) ? 1u : 0u; mine = (j == x) ? c : mine; }
        if (sum == G) break;
        __builtin_amdgcn_s_sleep(1);
        if ((++sp & 255u) == 0u) { if (xb_ld(&bar[XB_TMO])) break; if (sp > XB_SPIN_CAP) { atomicAdd(&bar[XB_TMO], 1u); break; } }
    }
    nloc = mine > 0u ? mine : 1u; nx = cnt > 0u ? cnt : 1u;
}

__device__ __forceinline__ void xcd_barrier(const XcdBarrier& b) {
    asm volatile("s_waitcnt vmcnt(0)" ::: "memory");
    __syncthreads();
    if (threadIdx.x == 0) {
        unsigned* bar = b.bar;
        __builtin_amdgcn_s_waitcnt(0);
        unsigned nloc = b.st[0], nx = b.st[1];
        if (nloc == 0u) { xcd_barrier_complete(bar, b.x, nloc, nx); b.st[0] = nloc; b.st[1] = nx; }
        const unsigned old = xb_add(&bar[XB_XSUB(b.x)], 1u);
        const unsigned gen = old / nloc;
        if (old + 1u == (gen + 1u) * nloc) {
            __builtin_amdgcn_fence(__ATOMIC_RELEASE, "agent");
            asm volatile("s_waitcnt vmcnt(0)" ::: "memory");
            const unsigned og = xb_add(&bar[XB_TOP], 1u);
            const unsigned tg = og / nx;
            if (og + 1u == (tg + 1u) * nx) xb_add(&bar[XB_TOPGEN], 1u);
            else XB_SPIN(xb_ld(&bar[XB_TOPGEN]) == tg, bar);
            __builtin_amdgcn_fence(__ATOMIC_ACQUIRE, "agent");
            xb_add(&bar[XB_XGEN(b.x)], 1u);
            asm volatile("s_waitcnt vmcnt(0)" ::: "memory");
        } else {
            XB_SPIN(xb_ld(&bar[XB_XGEN(b.x)]) == gen, bar);
            __builtin_amdgcn_fence(__ATOMIC_ACQUIRE, "agent");
            asm volatile("s_waitcnt vmcnt(0)" ::: "memory");
        }
    }
    __syncthreads();
}
template <class RowMap>
DEV void tr_tile(const float* __restrict__ src, int lds_, u16* __restrict__ dst, int ldd, int k0, int n0, RowMap rowmap, float* sm) {
    const int t = tidx();
    {
        const int n = t & 63, kk = t >> 6;
#pragma unroll
        for (int i = 0; i < 16; ++i) {
            const int k = kk + 4 * i;
            sm[k * 65 + n] = src[(size_t)(k0 + k) * lds_ + n0 + n];
        }
    }
    __syncthreads();
    {
        const int kp = t & 31, nn = t >> 5;
#pragma unroll
        for (int i = 0; i < 8; ++i) {
            const int n = nn + 8 * i;
            const unsigned v = pack2(sm[(2 * kp) * 65 + n], sm[(2 * kp + 1) * 65 + n]);
            *(unsigned*)(dst + (size_t)rowmap(n0 + n) * ldd + k0 + 2 * kp) = v;
        }
    }
    __syncthreads();
}

struct RmId { DEV int operator()(int n) const { return n; } };
struct RmWin { DEV int operator()(int n) const { return n < 3904 ? n : n + 64; } };
struct RmGate { DEV int operator()(int n) const { return (n >> 5) * 64 + (n & 31); } };
struct RmUp { DEV int operator()(int n) const { return (n >> 5) * 64 + 32 + (n & 31); } };

#define WT_WB_OFF (8064u * 1024u)
#define WT_WO_OFF (WT_WB_OFF + 4u * 1024u * 256u)
#define WT_TOTAL (WT_WO_OFF + 1024u * 1024u)

DEV void phase_conv_mixw(const P& p, int l, int bid, int nb, float* sm) {
    for (int u = bid; u < 2513; u += nb) {
        if (u < 2000) {
            const int kt = u / 125, nt = u % 125;
            tr_tile(p.w_in + (size_t)l * 1024 * 8000, 8000, p.Wt, 1024, kt * 64, nt * 64, RmWin(), sm);
        } else if (u < 2256) {
            const int v = u - 2000, i = v >> 6, w = v & 63, kt = w >> 4, nt = w & 15;
            tr_tile(p.w_branch + (size_t)(l * 4 + i) * 256 * 1024, 1024, p.Wt + WT_WB_OFF + (size_t)i * 1024 * 256, 256, kt * 64, nt * 64, RmId(), sm);
        } else if (u < 2512) {
            const int v = u - 2256, kt = v >> 4, nt = v & 15;
            tr_tile(p.w_out + (size_t)l * 1024 * 1024, 1024, p.Wt + WT_WO_OFF, 1024, kt * 64, nt * 64, RmId(), sm);
        } else {
            unsigned* z = (unsigned*)(p.Wt + (size_t)3904 * 1024);
            for (int i = tidx(); i < 64 * 1024 / 2; i += NTHR) z[i] = 0u;
        }
    }
}
DEV void phase_conv_moew(const P& p, int l, int bid, int nb, float* sm) {
    u16* wgu = p.cols + MOE_WGU_OFF;
    u16* wd = p.cols + MOE_WD_OFF;
    for (int u = bid; u < 16 * 384; u += nb) {
        const int e = u / 384, v = u % 384;
        const size_t le = (size_t)(l * 16 + e);
        if (v < 128) {
            const int kt = v >> 3, nt = v & 7;
            tr_tile(p.w_gate + le * 1024 * 512, 512, wgu + (size_t)e * 1024 * 1024, 1024, kt * 64, nt * 64, RmGate(), sm);
        } else if (v < 256) {
            const int w = v - 128, kt = w >> 3, nt = w & 7;
            tr_tile(p.w_up + le * 1024 * 512, 512, wgu + (size_t)e * 1024 * 1024, 1024, kt * 64, nt * 64, RmUp(), sm);
        } else {
            const int w = v - 256, kt = w >> 4, nt = w & 15;
            tr_tile(p.w_down + le * 512 * 1024, 1024, wd + (size_t)e * 1024 * 512, 512, kt * 64, nt * 64, RmId(), sm);
        }
    }
}

DEV void phase_mod_partial(const P& p, int bid, int nb, float* sm) {
    for (int u = bid; u < 768; u += nb) {
        const int l = u / 384, v = u % 384, kc = v / 24, jb = v % 24;
        const int t = tidx();
        __syncthreads();
        if (t < 192) {
            const int m = t >> 6, k = kc * 64 + (t & 63);
            const float cv = m < 2 ? p.c[m * 1024 + k] : p.c_ctx[k];
            sm[t] = silu(cv);
        }
        __syncthreads();
        const int j = jb * 256 + t;
        const float* w = p.w_mod + ((size_t)l * 1024 + kc * 64) * 6144 + j;
        float a0 = 0.f, a1 = 0.f, a2 = 0.f;
#pragma unroll 8
        for (int k = 0; k < 64; ++k) {
            const float wv = w[(size_t)k * 6144];
            a0 += sm[k] * wv; a1 += sm[64 + k] * wv; a2 += sm[128 + k] * wv;
        }
        float* o = p.modp + ((size_t)(l * 16 + kc) * 3) * 6144 + j;
        o[0] = a0; o[6144] = a1; o[2 * 6144] = a2;
    }
}
DEV void phase_mod_reduce(const P& p, int bid, int nb) {
    for (int i = bid * NTHR + tidx(); i < 2 * 3 * 6144; i += nb * NTHR) {
        const int l = i / (3 * 6144), r = i % (3 * 6144), m = r / 6144, j = r % 6144;
        float a = p.b_mod[l * 6144 + j];
        for (int kc = 0; kc < 16; ++kc) a += p.modp[((size_t)(l * 16 + kc) * 3 + m) * 6144 + j];
        p.mod[i] = a;
    }
}

DEV void moe_combine_row(const P& p, int l, int r, int lane, float4 (&v)[4]);
DEV void phase_norm1(const P& p, int l, int bid, int nb) {
    const int lane = tidx() & 63, w = tidx() >> 6;
    for (int r = bid * 4 + w; r < RTOT; r += nb * 4) {
        const float* xr = xrow_in(p, l, r);
        const int m = modidx(r);
        const float* sh = p.mod + ((size_t)(l * 3 + m)) * 6144;
        const float* sc = sh + 1024;
        float4 v[4]; float ss = 0.f;
#pragma unroll
        for (int i = 0; i < 4; ++i) v[i] = *(const float4*)(xr + lane * 4 + i * 256);
        if (l == 1) {
            moe_combine_row(p, 0, r, lane, v);
            float* xw = xrow_out(p, r);
#pragma unroll
            for (int i = 0; i < 4; ++i) *(float4*)(xw + lane * 4 + i * 256) = v[i];
        }
#pragma unroll
        for (int i = 0; i < 4; ++i) ss += v[i].x * v[i].x + v[i].y * v[i].y + v[i].z * v[i].z + v[i].w * v[i].w;
        ss = wsum(ss);
        const float rs = rsqrtf(ss * (1.f / 1024.f) + EPSF);
#pragma unroll
        for (int i = 0; i < 4; ++i) {
            const int c = lane * 4 + i * 256;
            const float4 g = *(const float4*)(p.norm_mix + l * 1024 + c);
            const float4 s1 = *(const float4*)(sc + c);
            const float4 h1 = *(const float4*)(sh + c);
            const float o0 = v[i].x * rs * g.x * (1.f + s1.x) + h1.x;
            const float o1 = v[i].y * rs * g.y * (1.f + s1.y) + h1.y;
            const float o2 = v[i].z * rs * g.z * (1.f + s1.z) + h1.z;
            const float o3 = v[i].w * rs * g.w * (1.f + s1.w) + h1.w;
            u32x2 pk; pk.x = pack2(o0, o1); pk.y = pack2(o2, o3);
            *(u32x2*)(p.hbuf + (size_t)r * 1024 + c) = pk;
        }
    }
}

#define LDP 72
#define GEMM_SMEM_BYTES (2 * 128 * LDP * 2)
DEV void gemm_mainloop(f32x4 (&acc)[4][4], const u16* const (&xp)[4], const u16* const (&wp)[4], int KT, u16* sX, u16* sW) {
    const int tid = tidx(), lane = tid & 63, w = tid >> 6, wn = w & 1, wm = w >> 1;
    const int fr = lane & 15, fq = lane >> 4;
    bf16x8 rx[4], rw[4];
#pragma unroll
    for (int i = 0; i < 4; ++i) { rx[i] = *(const bf16x8*)(xp[i]); rw[i] = *(const bf16x8*)(wp[i]); }
    const int so = (tid >> 3) * LDP + (tid & 7) * 8;
    for (int kt = 0; kt < KT; ++kt) {
#pragma unroll
        for (int i = 0; i < 4; ++i) {
            *(bf16x8*)(sX + so + i * 32 * LDP) = rx[i];
            *(bf16x8*)(sW + so + i * 32 * LDP) = rw[i];
        }
        __syncthreads();
        if (kt + 1 < KT) {
#pragma unroll
            for (int i = 0; i < 4; ++i) { rx[i] = *(const bf16x8*)(xp[i] + (kt + 1) * 64); rw[i] = *(const bf16x8*)(wp[i] + (kt + 1) * 64); }
        }
#pragma unroll
        for (int ks = 0; ks < 2; ++ks) {
            bf16x8 a[4], b[4];
#pragma unroll
            for (int q = 0; q < 4; ++q) {
                a[q] = *(const bf16x8*)(sW + (wn * 64 + q * 16 + fr) * LDP + ks * 32 + fq * 8);
                b[q] = *(const bf16x8*)(sX + (wm * 64 + q * 16 + fr) * LDP + ks * 32 + fq * 8);
            }
#pragma unroll
            for (int nt = 0; nt < 4; ++nt)
#pragma unroll
                for (int mt = 0; mt < 4; ++mt) acc[nt][mt] = mfma16(a[nt], b[mt], acc[nt][mt]);
        }
        __syncthreads();
    }
}
DEV void zero_acc(f32x4 (&acc)[4][4]) {
#pragma unroll
    for (int a = 0; a < 4; ++a)
#pragma unroll
        for (int b = 0; b < 4; ++b) acc[a][b] = f32x4{0.f, 0.f, 0.f, 0.f};
}

template <bool SIG>
DEV void phase_inproj(const P& p, int wrow0, int ntn, int ldc, int mtiles, int bid, int nb, u16* sm) {
    u16* sX = sm; u16* sW = sm + 128 * LDP;
    const int tid = tidx(), lane = tid & 63, w = tid >> 6, wn = w & 1, wm = w >> 1, fr = lane & 15, fq = lane >> 4;
    for (int u = bid; u < mtiles * ntn; u += nb) {
        const int mt_ = u / ntn, nt_ = u % ntn;
        const int m0 = mt_ * 128, n0 = nt_ * 128;
        const u16* xp[4]; const u16* wp[4];
#pragma unroll
        for (int i = 0; i < 4; ++i) {
            const int row = (tid >> 3) + 32 * i, kc = (tid & 7) * 8;
            xp[i] = p.hbuf + (size_t)(m0 + row) * 1024 + kc;
            wp[i] = p.Wt + (size_t)(wrow0 + n0 + row) * 1024 + kc;
        }
        f32x4 acc[4][4]; zero_acc(acc);
        gemm_mainloop(acc, xp, wp, 16, sX, sW);
#pragma unroll
        for (int nt = 0; nt < 4; ++nt)
#pragma unroll
            for (int mt = 0; mt < 4; ++mt) {
                const int n = n0 + wn * 64 + nt * 16 + fq * 4, m = m0 + wm * 64 + mt * 16 + fr;
                f32x4 v = acc[nt][mt];
                if (SIG) { v[0] = sigm(v[0]); v[1] = sigm(v[1]); v[2] = sigm(v[2]); v[3] = sigm(v[3]); }
                u32x2 pk; pk.x = pack2(v[0], v[1]); pk.y = pack2(v[2], v[3]);
                *(u32x2*)(p.cols + (size_t)m * ldc + n) = pk;
            }
    }
}

DEV void phase_merge1(const P& p, u16* ubuf, int mtiles, int bid, int nb, u16* sm) {
    u16* sX = sm; u16* sW = sm + 128 * LDP;
    const int tid = tidx(), lane = tid & 63, w = tid >> 6, wn = w & 1, wm = w >> 1, fr = lane & 15, fq = lane >> 4;
    for (int u = bid; u < mtiles * 8; u += nb) {
        const int mt_ = u >> 3, nt_ = u & 7;
        const int m0 = mt_ * 128, n0 = nt_ * 128;
        f32x4 tot[4][4]; zero_acc(tot);
        for (int br = 0; br < 4; ++br) {
            const u16* xp[4]; const u16* wp[4];
#pragma unroll
            for (int i = 0; i < 4; ++i) {
                const int row = (tid >> 3) + 32 * i, kc = (tid & 7) * 8;
                xp[i] = p.ybuf + (size_t)(m0 + row) * 1024 + br * 256 + kc;
                wp[i] = p.Wt + WT_WB_OFF + ((size_t)br * 1024 + n0 + row) * 256 + kc;
            }
            f32x4 acc[4][4]; zero_acc(acc);
            gemm_mainloop(acc, xp, wp, 4, sX, sW);
#pragma unroll
            for (int nt = 0; nt < 4; ++nt)
#pragma unroll
                for (int mt = 0; mt < 4; ++mt) {
                    const int n = n0 + wn * 64 + nt * 16 + fq * 4, m = m0 + wm * 64 + mt * 16 + fr;
                    const u32x2 g = *(const u32x2*)(p.cols + (size_t)m * NGATE + br * 1024 + n);
                    tot[nt][mt][0] += bf2f((u16)(g.x & 0xffff)) * acc[nt][mt][0];
                    tot[nt][mt][1] += bf2f((u16)(g.x >> 16)) * acc[nt][mt][1];
                    tot[nt][mt][2] += bf2f((u16)(g.y & 0xffff)) * acc[nt][mt][2];
                    tot[nt][mt][3] += bf2f((u16)(g.y >> 16)) * acc[nt][mt][3];
                }
        }
#pragma unroll
        for (int nt = 0; nt < 4; ++nt)
#pragma unroll
            for (int mt = 0; mt < 4; ++mt) {
                const int n = n0 + wn * 64 + nt * 16 + fq * 4, m = m0 + wm * 64 + mt * 16 + fr;
                u32x2 pk; pk.x = pack2(tot[nt][mt][0], tot[nt][mt][1]); pk.y = pack2(tot[nt][mt][2], tot[nt][mt][3]);
                *(u32x2*)(ubuf + (size_t)m * 1024 + n) = pk;
            }
    }
}

DEV void phase_merge2(const P& p, int l, const u16* ubuf, int mtiles, int bid, int nb, u16* sm) {
    u16* sX = sm; u16* sW = sm + 128 * LDP;
    const int tid = tidx(), lane = tid & 63, w = tid >> 6, wn = w & 1, wm = w >> 1, fr = lane & 15, fq = lane >> 4;
    for (int u = bid; u < mtiles * 8; u += nb) {
        const int mt_ = u >> 3, nt_ = u & 7;
        const int m0 = mt_ * 128, n0 = nt_ * 128;
        const u16* xp[4]; const u16* wp[4];
#pragma unroll
        for (int i = 0; i < 4; ++i) {
            const int row = (tid >> 3) + 32 * i, kc = (tid & 7) * 8;
            xp[i] = ubuf + (size_t)(m0 + row) * 1024 + kc;
            wp[i] = p.Wt + WT_WO_OFF + (size_t)(n0 + row) * 1024 + kc;
        }
        f32x4 acc[4][4]; zero_acc(acc);
        gemm_mainloop(acc, xp, wp, 16, sX, sW);
#pragma unroll
        for (int nt = 0; nt < 4; ++nt)
#pragma unroll
            for (int mt = 0; mt < 4; ++mt) {
                const int n = n0 + wn * 64 + nt * 16 + fq * 4, m = m0 + wm * 64 + mt * 16 + fr;
                const float4 xo = *(const float4*)(xrow_in(p, l, m) + n);
                const float4 g = *(const float4*)(p.mod + (size_t)(l * 3 + modidx(m)) * 6144 + 2048 + n);
                float4 o;
                o.x = xo.x + g.x * acc[nt][mt][0]; o.y = xo.y + g.y * acc[nt][mt][1];
                o.z = xo.z + g.z * acc[nt][mt][2]; o.w = xo.w + g.w * acc[nt][mt][3];
                *(float4*)(xrow_out(p, m) + n) = o;
            }
    }
}
DEV void phase_norm2_router(const P& p, int l, int nrows, int bid, int nb, float* sm) {
    const int tid = tidx(), lane = tid & 63, w = tid >> 6;
    int* list = (int*)(p.cols + MOE_LIST_OFF);
    float* slotw = (float*)(list + 16 * RTOT);
    int* tokslot = (int*)(slotw + 16 * RTOT);
    float* tokw = (float*)(tokslot + 2 * RTOT);
    int* lcnt = (int*)(sm + 16 * 1024);
    int* rinfo = lcnt + 32;
    float* rwgt = (float*)(rinfo + 4 * 40 * 2);
    for (int i = tid; i < 16 * 1024; i += NTHR) { const int c = i >> 4, e = i & 15; sm[e * 1024 + c] = p.router_w[i]; }
    if (tid < 32) lcnt[tid] = 0;
    __syncthreads();
    int kk = 0;
    for (int r = bid * 4 + w; r < nrows; r += nb * 4, ++kk) {
        const float* xr = xrow_out(p, r);
        const int m = modidx(r);
        const float* sh = p.mod + ((size_t)(l * 3 + m)) * 6144 + 3072;
        const float* sc = sh + 1024;
        float4 v[4]; float ss = 0.f;
#pragma unroll
        for (int i = 0; i < 4; ++i) {
            v[i] = *(const float4*)(xr + lane * 4 + i * 256);
            ss += v[i].x * v[i].x + v[i].y * v[i].y + v[i].z * v[i].z + v[i].w * v[i].w;
        }
        ss = wsum(ss);
        const float rs = rsqrtf(ss * (1.f / 1024.f) + EPSF);
#pragma unroll
        for (int i = 0; i < 4; ++i) {
            const int c = lane * 4 + i * 256;
            const float4 g = *(const float4*)(p.norm_ffn + l * 1024 + c);
            const float4 s1 = *(const float4*)(sc + c);
            const float4 h1 = *(const float4*)(sh + c);
            v[i].x = v[i].x * rs * g.x * (1.f + s1.x) + h1.x;
            v[i].y = v[i].y * rs * g.y * (1.f + s1.y) + h1.y;
            v[i].z = v[i].z * rs * g.z * (1.f + s1.z) + h1.z;
            v[i].w = v[i].w * rs * g.w * (1.f + s1.w) + h1.w;
            u32x2 pk; pk.x = pack2(v[i].x, v[i].y); pk.y = pack2(v[i].z, v[i].w);
            *(u32x2*)(p.hbuf + (size_t)r * 1024 + c) = pk;
        }
        float sel[16], scr[16];
#pragma unroll
        for (int e = 0; e < 16; ++e) scr[e] = 0.f;
#pragma unroll
        for (int i = 0; i < 4; ++i) {
#pragma unroll
            for (int e = 0; e < 16; ++e) {
                const float4 rw = *(const float4*)(sm + e * 1024 + lane * 4 + i * 256);
                scr[e] += v[i].x * rw.x + v[i].y * rw.y + v[i].z * rw.z + v[i].w * rw.w;
            }
            __builtin_amdgcn_sched_barrier(0);
        }
#pragma unroll
        for (int e = 0; e < 16; ++e) {
            const float a = wsum(scr[e]);
            scr[e] = sigm(a);
            sel[e] = scr[e] + p.router_b[e];
        }
        int bg = 0; float bgs = -INFINITY;
#pragma unroll
        for (int g = 0; g < 4; ++g) {
            float m1 = -INFINITY, m2 = -INFINITY;
#pragma unroll
            for (int j = 0; j < 4; ++j) {
                const float s = sel[g * 4 + j];
                if (s > m1) { m2 = m1; m1 = s; } else if (s > m2) { m2 = s; }
            }
            const float gs = m1 + m2;
            if (gs > bgs) { bgs = gs; bg = g; }
        }
        float gsel[4], gscr[4];
#pragma unroll
        for (int j = 0; j < 4; ++j) { gsel[j] = -INFINITY; gscr[j] = 0.f; }
#pragma unroll
        for (int g = 0; g < 4; ++g)
#pragma unroll
            for (int j = 0; j < 4; ++j) if (bg == g) { gsel[j] = sel[g * 4 + j]; gscr[j] = scr[g * 4 + j]; }
        int j1 = 0; float v1 = gsel[0], w1 = gscr[0];
#pragma unroll
        for (int j = 1; j < 4; ++j) if (gsel[j] > v1) { v1 = gsel[j]; w1 = gscr[j]; j1 = j; }
        int j2 = -1; float v2 = -INFINITY, w2 = 0.f;
#pragma unroll
        for (int j = 0; j < 4; ++j) if (j != j1 && (j2 < 0 || gsel[j] > v2)) { v2 = gsel[j]; w2 = gscr[j]; j2 = j; }
        const float inv = 1.f / (w1 + w2);
        if (lane == 0) {
            const int e1 = bg * 4 + j1, e2 = bg * 4 + j2;
            const int p1 = atomicAdd(lcnt + e1, 1);
            const int p2 = atomicAdd(lcnt + e2, 1);
            rinfo[(w * 40 + kk) * 2 + 0] = e1 * 65536 + p1; rwgt[(w * 40 + kk) * 2 + 0] = w1 * inv;
            rinfo[(w * 40 + kk) * 2 + 1] = e2 * 65536 + p2; rwgt[(w * 40 + kk) * 2 + 1] = w2 * inv;
        }
    }
    __syncthreads();
    if (tid < 16) lcnt[16 + tid] = lcnt[tid] ? atomicAdd(p.cnt + l * 16 + tid, lcnt[tid]) : 0;
    __syncthreads();
    if (lane < 2) {
        int k2 = 0;
        for (int r = bid * 4 + w; r < nrows; r += nb * 4, ++k2) {
            const int inf = rinfo[(w * 40 + k2) * 2 + lane], e = inf >> 16, slot = lcnt[16 + e] + (inf & 65535);
            const float wg = rwgt[(w * 40 + k2) * 2 + lane];
            list[e * RTOT + slot] = r; slotw[e * RTOT + slot] = wg;
            tokslot[r * 2 + lane] = e * RTOT + slot; tokw[r * 2 + lane] = wg;
        }
    }
    __syncthreads();
}

DEV bool moe_find(const int* cnt, int ut, int& e, int& mt, int& off, int& ce) {
    int tb = 0, o = 0;
    for (int k = 0; k < 16; ++k) {
        const int c = cnt[k], nt = (c + 127) >> 7;
        if (ut < tb + nt) { e = k; mt = ut - tb; off = o; ce = c; return true; }
        tb += nt; o += c;
    }
    return false;
}

DEV void phase_moe_up(const P& p, int l, int bid, int nb, u16* sm) {
    u16* sX = sm; u16* sW = sm + 128 * LDP;
    const int tid = tidx(), lane = tid & 63, w = tid >> 6, wn = w & 1, wm = w >> 1, fr = lane & 15, fq = lane >> 4;
    const int* cnt = p.cnt + l * 16;
    const int* list = (const int*)(p.cols + MOE_LIST_OFF);
    const u16* wgu = p.cols + MOE_WGU_OFF;
    u16* act = p.cols + MOE_ACT_OFF;
    for (int u = bid;; u += nb) {
        int e, mtile, off, ce;
        if (!moe_find(cnt, u >> 3, e, mtile, off, ce)) break;
        const int n0 = (u & 7) * 128;
        const u16* xp[4]; const u16* wp[4];
#pragma unroll
        for (int i = 0; i < 4; ++i) {
            const int row = (tid >> 3) + 32 * i, kc = (tid & 7) * 8;
            int s = mtile * 128 + row; s = s < ce ? s : ce - 1;
            const int tok = list[e * RTOT + s];
            xp[i] = p.hbuf + (size_t)tok * 1024 + kc;
            wp[i] = wgu + ((size_t)e * 1024 + n0 + row) * 1024 + kc;
        }
        f32x4 acc[4][4]; zero_acc(acc);
        gemm_mainloop(acc, xp, wp, 16, sX, sW);
#pragma unroll
        for (int nt = 0; nt < 2; ++nt)
#pragma unroll
            for (int mt = 0; mt < 4; ++mt) {
                const int col = ((n0 >> 6) + wn) * 32 + nt * 16 + fq * 4;
                const int s = mtile * 128 + wm * 64 + mt * 16 + fr;
                if (s < ce) {
                    const f32x4 g = acc[nt][mt], uu = acc[nt + 2][mt];
                    u32x2 pk; pk.x = pack2(silu(g[0]) * uu[0], silu(g[1]) * uu[1]); pk.y = pack2(silu(g[2]) * uu[2], silu(g[3]) * uu[3]);
                    *(u32x2*)(act + (size_t)(off + s) * 512 + col) = pk;
                }
            }
    }
}

DEV void phase_moe_down(const P& p, int l, int bid, int nb, u16* sm) {
    u16* sX = sm; u16* sW = sm + 128 * LDP;
    const int tid = tidx(), lane = tid & 63, w = tid >> 6, wn = w & 1, wm = w >> 1, fr = lane & 15, fq = lane >> 4;
    const int* cnt = p.cnt + l * 16;
    const int* list = (const int*)(p.cols + MOE_LIST_OFF);
    u16* yslot = p.glaS;
    const u16* wd = p.cols + MOE_WD_OFF;
    const u16* act = p.cols + MOE_ACT_OFF;
    for (int u = bid;; u += nb) {
        int e, mtile, off, ce;
        if (!moe_find(cnt, u >> 3, e, mtile, off, ce)) break;
        const int n0 = (u & 7) * 128;
        const u16* xp[4]; const u16* wp[4];
#pragma unroll
        for (int i = 0; i < 4; ++i) {
            const int row = (tid >> 3) + 32 * i, kc = (tid & 7) * 8;
            int s = mtile * 128 + row; s = s < ce ? s : ce - 1;
            xp[i] = act + (size_t)(off + s) * 512 + kc;
            wp[i] = wd + ((size_t)e * 1024 + n0 + row) * 512 + kc;
        }
        f32x4 acc[4][4]; zero_acc(acc);
        gemm_mainloop(acc, xp, wp, 8, sX, sW);
#pragma unroll
        for (int mt = 0; mt < 4; ++mt) {
            const int s = mtile * 128 + wm * 64 + mt * 16 + fr;
            if (s < ce) {
#pragma unroll
                for (int nt = 0; nt < 4; ++nt) {
                    const int n = n0 + wn * 64 + nt * 16 + fq * 4;
                    u32x2 pk; pk.x = pack2(acc[nt][mt][0], acc[nt][mt][1]); pk.y = pack2(acc[nt][mt][2], acc[nt][mt][3]);
                    *(u32x2*)(yslot + (size_t)(off + s) * 1024 + n) = pk;
                }
            }
        }
    }
}

DEV void moe_combine_row(const P& p, int l, int r, int lane, float4 (&v)[4]) {
    const int* cnt = p.cnt + l * 16;
    const int* list = (const int*)(p.cols + MOE_LIST_OFF);
    const int* tokslot = (const int*)((const float*)(list + 16 * RTOT) + 16 * RTOT);
    const float* tokw = (const float*)(tokslot + 2 * RTOT);
    const u16* yslot = p.glaS;
    const float* g2 = p.mod + (size_t)(l * 3 + modidx(r)) * 6144 + 5120;
#pragma unroll
    for (int j = 0; j < 2; ++j) {
        const int ts = tokslot[r * 2 + j], e = ts / RTOT, slot = ts % RTOT;
        const float wg = tokw[r * 2 + j];
        int off = 0;
        for (int k = 0; k < e; ++k) off += cnt[k];
        const u16* yr = yslot + (size_t)(off + slot) * 1024;
#pragma unroll
        for (int i = 0; i < 4; ++i) {
            const int c = lane * 4 + i * 256;
            const u32x2 yv = *(const u32x2*)(yr + c);
            const float4 g = *(const float4*)(g2 + c);
            v[i].x += g.x * wg * __uint_as_float(yv.x << 16); v[i].y += g.y * wg * __uint_as_float(yv.x & 0xffff0000u);
            v[i].z += g.z * wg * __uint_as_float(yv.y << 16); v[i].w += g.w * wg * __uint_as_float(yv.y & 0xffff0000u);
        }
    }
}

DEV void phase_final_norm(const P& p, int bid, int nb) {
    const int lane = tidx() & 63, w = tidx() >> 6;
    for (int r = bid * 4 + w; r < RLAT; r += nb * 4) {
        float* xr = p.out + (size_t)r * DM;
        float4 v[4]; float ss = 0.f;
#pragma unroll
        for (int i = 0; i < 4; ++i) v[i] = *(const float4*)(xr + lane * 4 + i * 256);
        moe_combine_row(p, 1, r, lane, v);
#pragma unroll
        for (int i = 0; i < 4; ++i) ss += v[i].x * v[i].x + v[i].y * v[i].y + v[i].z * v[i].z + v[i].w * v[i].w;
        ss = wsum(ss);
        const float rs = rsqrtf(ss * (1.f / 1024.f) + EPSF);
#pragma unroll
        for (int i = 0; i < 4; ++i) {
            const int c = lane * 4 + i * 256;
            const float4 g = *(const float4*)(p.norm_final + c);
            float4 o; o.x = v[i].x * rs * g.x; o.y = v[i].y * rs * g.y; o.z = v[i].z * rs * g.z; o.w = v[i].w * rs * g.w;
            *(float4*)(xr + c) = o;
        }
    }
}
DEV float wscan_add(float v, int lane) {
#pragma unroll
    for (int o = 1; o < 64; o <<= 1) { const float t = __shfl_up(v, o, 64); if (lane >= o) v += t; }
    return v;
}
DEV float wscan_max(float v, int lane) {
#pragma unroll
    for (int o = 1; o < 64; o <<= 1) { const float t = __shfl_up(v, o, 64); if (lane >= o) v = fmaxf(v, t); }
    return v;
}
DEV void mm64(f32x4 (&acc)[4], const u16* A, int lda, const u16* Bt, int ldb) {
    const int lane = tidx() & 63, w = tidx() >> 6, fr = lane & 15, fq = lane >> 4;
#pragma unroll
    for (int ks = 0; ks < 2; ++ks) {
        const bf16x8 a = *(const bf16x8*)(A + (16 * w + fr) * lda + ks * 32 + fq * 8);
#pragma unroll
        for (int nt = 0; nt < 4; ++nt) {
            const bf16x8 b = *(const bf16x8*)(Bt + (nt * 16 + fr) * ldb + ks * 32 + fq * 8);
            acc[nt] = mfma16(a, b, acc[nt]);
        }
    }
}
DEV void zero4(f32x4 (&acc)[4]) {
#pragma unroll
    for (int i = 0; i < 4; ++i) acc[i] = f32x4{0.f, 0.f, 0.f, 0.f};
}
DEV void ld16bf(const u16* p, float (&o)[16]) {
    const u32x4 a = *(const u32x4*)p, b = *(const u32x4*)(p + 8);
    const unsigned w[8] = {a.x, a.y, a.z, a.w, b.x, b.y, b.z, b.w};
#pragma unroll
    for (int i = 0; i < 8; ++i) { o[2 * i] = __uint_as_float(w[i] << 16); o[2 * i + 1] = __uint_as_float(w[i] & 0xffff0000u); }
}
DEV void st16bf(u16* p, const float (&v)[16]) {
    u32x4 a, b;
    a.x = pack2(v[0], v[1]); a.y = pack2(v[2], v[3]); a.z = pack2(v[4], v[5]); a.w = pack2(v[6], v[7]);
    b.x = pack2(v[8], v[9]); b.y = pack2(v[10], v[11]); b.z = pack2(v[12], v[13]); b.w = pack2(v[14], v[15]);
    *(u32x4*)p = a; *(u32x4*)(p + 8) = b;
}

DEV void phase_prep(const P& p, int l, u16* gqkv, int bid, int nb, u16* sm) {
    const int tid = tidx(), lane = tid & 63, w = tid >> 6;
    for (int g = bid; g < 264; g += nb) {
        int b, t0, r0, T, pos0;
        if (g < 256) { b = g >> 7; t0 = (g & 127) * 64; r0 = b * SEQ + t0; T = SEQ; pos0 = CTXL + t0; }
        else { const int q = g - 256; b = q >> 2; t0 = (q & 3) * 64; r0 = RLAT + b * CTXL + t0; T = CTXL; pos0 = t0; }
        for (int i = 0; i < 16; ++i) {
            const int s = w * 16 + i, r = r0 + s, t = t0 + s;
            float val[12];
#pragma unroll
            for (int c = 0; c < 12; ++c) {
                const int ch = lane + 64 * c;
                float a = 0.f;
#pragma unroll
                for (int j = 0; j < 5; ++j) {
                    const int tt = t + j - 2;
                    if (tt >= 0 && tt < T) a += bf2f(p.cols[(size_t)(r + j - 2) * NCM + GD_Q + ch]) * p.gdn_conv[(l * 5 + j) * 768 + ch];
                }
                val[c] = silu(a);
            }
#pragma unroll
            for (int c = 0; c < 12; ++c) {
                float sc = 1.f;
                if (c < 8) { const float ss = wsum(val[c] * val[c]); sc = rsqrtf(ss + EPSF) * (c < 4 ? 0.125f : 1.f); }
                gqkv[(size_t)r * 768 + lane + 64 * c] = f2bf(val[c] * sc);
            }
        }
        for (int i = 0; i < 16; ++i) {
            const int s = w * 16 + i, r = r0 + s, t = t0 + s;
            const int dd = lane & 31, idx = dd & 15;
            float cs = 1.f, sn = 0.f;
            if (g < 256) {
                const int fi = idx & 7;
                const float inv = __expf(-(float)(2 * fi) * (1.f / 16.f) * 9.210340371976184f);
                const float pos = idx < 8 ? (float)(t >> 6) : (float)(t & 63);
                const float ang = pos * inv;
                cs = cosf(ang); sn = sinf(ang);
            }
#pragma unroll
            for (int h = 0; h < 4; ++h) {
                const float qv = bf2f(p.cols[(size_t)r * NCM + DF_Q + h * 64 + lane]);
                const float kv = bf2f(p.cols[(size_t)r * NCM + DF_K + h * 64 + lane]);
                const float qo = __shfl_xor(qv, 16, 64), ko = __shfl_xor(kv, 16, 64);
                float qr, kr;
                if (dd < 16) { qr = qv * cs - qo * sn; kr = kv * cs - ko * sn; }
                else { qr = qo * sn + qv * cs; kr = ko * sn + kv * cs; }
                const size_t o = ((size_t)(b * 4 + h) * KPOS + pos0 + s) * 64 + lane;
                p.dq[o] = f2bf(qr * (0.17677669529663687f * 1.4426950408889634f));
                p.dk[o] = f2bf(kr);
            }
        }
        for (int h = 0; h < 4; ++h) {
            __syncthreads();
            {
                const int s = tid >> 2, dg = tid & 3;
                const u32x4 a = *(const u32x4*)(p.cols + (size_t)(r0 + s) * NCM + DF_V + h * 64 + dg * 16);
                const u32x4 c = *(const u32x4*)(p.cols + (size_t)(r0 + s) * NCM + DF_V + h * 64 + dg * 16 + 8);
                const unsigned wv[8] = {a.x, a.y, a.z, a.w, c.x, c.y, c.z, c.w};
#pragma unroll
                for (int k = 0; k < 8; ++k) {
                    sm[(dg * 16 + 2 * k) * 72 + s] = (u16)(wv[k] & 0xffff);
                    sm[(dg * 16 + 2 * k + 1) * 72 + s] = (u16)(wv[k] >> 16);
                }
            }
            __syncthreads();
            {
                const int dv = tid >> 2, sg = tid & 3;
                const u32x4 a = *(const u32x4*)(sm + dv * 72 + sg * 16);
                const u32x4 c = *(const u32x4*)(sm + dv * 72 + sg * 16 + 8);
                u16* o = p.dvT + ((size_t)(b * 4 + h) * 64 + dv) * KPOS + pos0 + sg * 16;
                *(u32x4*)o = a; *(u32x4*)(o + 8) = c;
            }
        }
        __syncthreads();
    }
}
#define TILE_B (64 * LDP * 2)

DEV void gla_cum(const P& p, int l, int dir, int h, int row0, float* cum, float* rt, float* sg) {
    const int tid = tidx();
    {
        const int s = tid >> 2, q4 = tid & 3, row = row0 + (dir ? 63 - s : s);
        const u32x2 v = *(const u32x2*)(p.cols + (size_t)row * NCM + GLA_RF + dir * 16 + q4 * 4);
        rt[s * 17 + q4 * 4 + 0] = __uint_as_float(v.x << 16); rt[s * 17 + q4 * 4 + 1] = __uint_as_float(v.x & 0xffff0000u);
        rt[s * 17 + q4 * 4 + 2] = __uint_as_float(v.y << 16); rt[s * 17 + q4 * 4 + 3] = __uint_as_float(v.y & 0xffff0000u);
    }
    __syncthreads();
    const int d = tid & 63, sq = tid >> 6;
    float a2r[16];
#pragma unroll
    for (int j = 0; j < 16; ++j) a2r[j] = p.gla_a2[((size_t)(l * 2 + dir) * 16 + j) * 256 + h * 64 + d];
    const float ab = p.gla_ab[(l * 2 + dir) * 256 + h * 64 + d];
    float loc[16]; float run = 0.f;
#pragma unroll
    for (int i = 0; i < 16; ++i) {
        const int s = sq * 16 + i;
        float x = ab;
#pragma unroll
        for (int j = 0; j < 16; ++j) x += rt[s * 17 + j] * a2r[j];
        run += logsig(x) * (1.f / 16.f);
        loc[i] = run;
    }
    sg[sq * 64 + d] = run;
    __syncthreads();
    float off = 0.f;
    for (int k = 0; k < sq; ++k) off += sg[k * 64 + d];
#pragma unroll
    for (int i = 0; i < 16; ++i) cum[(sq * 16 + i) * 65 + d] = loc[i] + off;
    __syncthreads();
}

DEV void gla_phaseA(const P& p, int l, int dir, int b, int st, int h, unsigned char* smraw) {
    float* cum = (float*)smraw;
    float* rt = cum + 64 * 65;
    float* sg = rt + 64 * 17;
    u16* kwT = (u16*)(sg + 256);
    u16* vT = kwT + 64 * LDP;
    const int tid = tidx(), lane = tid & 63, w = tid >> 6, fr = lane & 15, fq = lane >> 4;
    const int row0 = chunk_row0(b, dir, st);
    const size_t idx = state_idx(dir, b, st, h);
    gla_cum(p, l, dir, h, row0, cum, rt, sg);
    {
        const int s = tid >> 2, dg = tid & 3, row = row0 + (dir ? 63 - s : s);
        float kk[16], vv[16];
        ld16bf(p.cols + (size_t)row * NCM + GLA_K + h * 64 + dg * 16, kk);
        ld16bf(p.cols + (size_t)row * NCM + GLA_V + h * 64 + dg * 16, vv);
#pragma unroll
        for (int i = 0; i < 16; ++i) {
            const int d = dg * 16 + i;
            kwT[d * LDP + s] = f2bf(kk[i] * __expf(cum[63 * 65 + d] - cum[s * 65 + d]));
            vT[d * LDP + s] = f2bf(vv[i]);
        }
        if (tid < 64) p.glaDec[idx * 64 + tid] = __expf(cum[63 * 65 + tid]);
    }
    __syncthreads();
    f32x4 acc[4]; zero4(acc);
    mm64(acc, kwT, LDP, vT, LDP);
#pragma unroll
    for (int nt = 0; nt < 4; ++nt) {
        const int d = 16 * w + fq * 4, e = nt * 16 + fr;
        u32x2 pk; pk.x = pack2(acc[nt][0], acc[nt][1]); pk.y = pack2(acc[nt][2], acc[nt][3]);
        *(u32x2*)(p.glaS + idx * 4096 + e * 64 + d) = pk;
    }
    __syncthreads();
}

DEV void ml_phaseA(const P& p, int l, int dir, int b, int st, int h, unsigned char* smraw) {
    float* wend = (float*)smraw;
    u16* kwT = (u16*)(wend + 64);
    u16* vT = kwT + 64 * LDP;
    const int tid = tidx(), lane = tid & 63, w = tid >> 6, fr = lane & 15, fq = lane >> 4;
    const int row0 = chunk_row0(b, dir, st);
    const size_t idx = state_idx(dir, b, st, h);
    if (w == 0) {
        const int row = row0 + (dir ? 63 - lane : lane);
        const float ip = bf2f(p.cols[(size_t)row * NCM + ML_GF + dir * 8 + h]) + p.mlstm_gate_b[((l * 2 + dir) * 2 + 0) * 4 + h];
        const float lf = logsig(bf2f(p.cols[(size_t)row * NCM + ML_GF + dir * 8 + 4 + h]) + p.mlstm_gate_b[((l * 2 + dir) * 2 + 1) * 4 + h]);
        const float fc = wscan_add(lf, lane);
        const float fe = __shfl(fc, 63, 64);
        const float lw = fe - fc + ip;
        const float ae = wmaxr(lw);
        wend[lane] = __expf(lw - ae);
        if (lane == 0) { p.mlFE[idx] = fe; p.mlAE[idx] = ae; }
    }
    __syncthreads();
    {
        const int s = tid >> 2, dg = tid & 3, row = row0 + (dir ? 63 - s : s);
        float kk[16], vv[16];
        ld16bf(p.cols + (size_t)row * NCM + ML_K + h * 64 + dg * 16, kk);
        ld16bf(p.cols + (size_t)row * NCM + ML_V + h * 64 + dg * 16, vv);
        const float ws = wend[s] * 0.125f;
#pragma unroll
        for (int i = 0; i < 16; ++i) {
            const int d = dg * 16 + i;
            kwT[d * LDP + s] = f2bf(kk[i] * ws);
            vT[d * LDP + s] = f2bf(vv[i]);
        }
    }
    __syncthreads();
    if (tid < 64) {
        float a = 0.f;
        for (int s = 0; s < 64; ++s) a += bf2f(kwT[tid * LDP + s]);
        p.mlN[idx * 64 + tid] = a;
    }
    f32x4 acc[4]; zero4(acc);
    mm64(acc, kwT, LDP, vT, LDP);
#pragma unroll
    for (int nt = 0; nt < 4; ++nt) {
        const int d = 16 * w + fq * 4, e = nt * 16 + fr;
        u32x2 pk; pk.x = pack2(acc[nt][0], acc[nt][1]); pk.y = pack2(acc[nt][2], acc[nt][3]);
        *(u32x2*)(p.mlS + idx * 4096 + e * 64 + d) = pk;
    }
    __syncthreads();
}

DEV void gd_phaseA(const P& p, int l, const u16* gqkv, int dir, int b, int st, int h, unsigned char* smraw) {
    float* X = (float*)smraw;
    float* cum = X + 64 * 65 + 32;
    float* beta = cum + 64;
    float* be = beta + 64;
    float* ke = be + 64;
    float* scal = ke + 64;
    u16* Y0 = (u16*)(scal + 64);
    u16* Y1 = Y0 + 64 * LDP;
    u16* Y2 = Y1 + 64 * LDP;
    u16* Y3 = Y2 + 64 * LDP;
    u16* Y4 = Y3 + 64 * LDP;
    u16* Y5 = Y4 + 64 * LDP;
    u16* wT = (u16*)X;
    const int tid = tidx(), lane = tid & 63, w = tid >> 6, fr = lane & 15, fq = lane >> 4;
    const int row0 = chunk_row0(b, dir, st);
    const size_t idx = state_idx(dir, b, st, h);
    if (w == 0) {
        const int row = row0 + (dir ? 63 - lane : lane);
        const float bp = bf2f(p.cols[(size_t)row * NCM + GD_GF + dir * 8 + h]);
        const float ap = bf2f(p.cols[(size_t)row * NCM + GD_GF + dir * 8 + 4 + h]);
        const float bt = sigm(bp);
        const float g = -__expf(p.gdn_a_log[(l * 2 + dir) * 4 + h]) * softplus(ap + p.gdn_dt_bias[(l * 2 + dir) * 4 + h]);
        const float cm = wscan_add(g, lane);
        const float ce = __shfl(cm, 63, 64);
        cum[lane] = cm; beta[lane] = bt; be[lane] = bt * __expf(cm); ke[lane] = __expf(ce - cm);
        if (lane == 0) scal[0] = __expf(ce);
    }
    {
        const int s = tid >> 2, dg = tid & 3, row = row0 + (dir ? 63 - s : s);
        const u16* src = gqkv + (size_t)row * 768 + h * 64 + dg * 16;
        const u32x4 q0 = *(const u32x4*)src, q1 = *(const u32x4*)(src + 8);
        const u32x4 k0 = *(const u32x4*)(src + 256), k1 = *(const u32x4*)(src + 264);
        const u32x4 v0 = *(const u32x4*)(src + 512), v1 = *(const u32x4*)(src + 520);
        *(u32x4*)(Y0 + s * LDP + dg * 16) = q0; *(u32x4*)(Y0 + s * LDP + dg * 16 + 8) = q1;
        *(u32x4*)(Y1 + s * LDP + dg * 16) = k0; *(u32x4*)(Y1 + s * LDP + dg * 16 + 8) = k1;
        const unsigned kw[8] = {k0.x, k0.y, k0.z, k0.w, k1.x, k1.y, k1.z, k1.w};
        const unsigned vw[8] = {v0.x, v0.y, v0.z, v0.w, v1.x, v1.y, v1.z, v1.w};
#pragma unroll
        for (int i = 0; i < 8; ++i) {
            Y2[(dg * 16 + 2 * i) * LDP + s] = (u16)(kw[i] & 0xffff); Y2[(dg * 16 + 2 * i + 1) * LDP + s] = (u16)(kw[i] >> 16);
            Y3[(dg * 16 + 2 * i) * LDP + s] = (u16)(vw[i] & 0xffff); Y3[(dg * 16 + 2 * i + 1) * LDP + s] = (u16)(vw[i] >> 16);
        }
    }
    __syncthreads();
    {
        f32x4 kk[4], qk[4]; zero4(kk); zero4(qk);
        mm64(kk, Y1, LDP, Y1, LDP);
        mm64(qk, Y0, LDP, Y1, LDP);
#pragma unroll
        for (int nt = 0; nt < 4; ++nt)
#pragma unroll
            for (int j = 0; j < 4; ++j) {
                const int c = 16 * w + fq * 4 + j, s = nt * 16 + fr;
                const float gam = s <= c ? __expf(cum[c] - cum[s]) : 0.f;
                if (s < c) X[c * 65 + s] = beta[c] * kk[nt][j] * gam;
                Y4[c * LDP + s] = f2bf(qk[nt][j] * gam);
            }
    }
    __syncthreads();
    {
        float* Pb = (float*)Y5;
        if (tid < 64) {
            const int blk = tid >> 4, col = tid & 15, base = blk * 16;
            float tc[16];
#pragma unroll
            for (int r = 0; r < 16; ++r) tc[r] = (r == col) ? 1.f : 0.f;
#pragma unroll
            for (int r = 1; r < 16; ++r) {
                float a = 0.f;
#pragma unroll
                for (int s2 = 0; s2 < r; ++s2) a += X[(base + r) * 65 + base + s2] * tc[s2];
                if (r > col) tc[r] = -a;
            }
#pragma unroll
            for (int r = 0; r < 16; ++r) if (r >= col) X[(base + col) * 65 + base + r + 1] = tc[r];
        }
        __syncthreads();
        for (int d = 1; d < 4; ++d) {
            const int nblk = 4 - d;
            for (int e = tid; e < nblk * 256; e += NTHR) {
                const int jb = e >> 8, r = (e >> 4) & 15, c = e & 15, ib = jb + d;
                float a = 0.f;
                for (int k = jb; k < ib; ++k)
#pragma unroll
                    for (int s2 = 0; s2 < 16; ++s2) {
                        const int rr = 16 * k + s2, cc = 16 * jb + c;
                        const float tv = rr >= cc ? X[cc * 65 + rr + 1] : 0.f;
                        a += X[(16 * ib + r) * 65 + rr] * tv;
                    }
                Pb[(jb * 16 + r) * 17 + c] = a;
            }
            __syncthreads();
            for (int e = tid; e < nblk * 256; e += NTHR) {
                const int jb = e >> 8, r = (e >> 4) & 15, c = e & 15, ib = jb + d;
                float a = 0.f;
#pragma unroll
                for (int s2 = 0; s2 < 16; ++s2) {
                    const float tv = s2 <= r ? X[(16 * ib + s2) * 65 + 16 * ib + r + 1] : 0.f;
                    a += tv * Pb[(jb * 16 + s2) * 17 + c];
                }
                X[(16 * jb + c) * 65 + 16 * ib + r + 1] = -a;
            }
            __syncthreads();
        }
    }
    {
        const int c = tid >> 2, sgp = tid & 3;
        float tw[16], tu[16];
#pragma unroll
        for (int i = 0; i < 16; ++i) {
            const int s = sgp * 16 + i;
            const float t = s <= c ? X[s * 65 + c + 1] : 0.f;
            tw[i] = t * be[s]; tu[i] = t * beta[s];
        }
        st16bf(Y0 + c * LDP + sgp * 16, tw);
        st16bf(Y1 + c * LDP + sgp * 16, tu);
    }
    __syncthreads();
    {
        f32x4 wa[4], ua[4]; zero4(wa); zero4(ua);
        mm64(wa, Y0, LDP, Y2, LDP);
        mm64(ua, Y1, LDP, Y3, LDP);
        __syncthreads();
        const int c0 = 16 * w + fq * 4;
        const float k0 = ke[c0], k1 = ke[c0 + 1], k2 = ke[c0 + 2], k3 = ke[c0 + 3];
#pragma unroll
        for (int nt = 0; nt < 4; ++nt) {
            const int d = nt * 16 + fr;
            u32x2 a, bq, c, dq_;
            a.x = pack2(wa[nt][0], wa[nt][1]); a.y = pack2(wa[nt][2], wa[nt][3]);
            bq.x = pack2(wa[nt][0] * k0, wa[nt][1] * k1); bq.y = pack2(wa[nt][2] * k2, wa[nt][3] * k3);
            c.x = pack2(ua[nt][0], ua[nt][1]); c.y = pack2(ua[nt][2], ua[nt][3]);
            dq_.x = pack2(ua[nt][0] * k0, ua[nt][1] * k1); dq_.y = pack2(ua[nt][2] * k2, ua[nt][3] * k3);
            *(u32x2*)(wT + d * LDP + c0) = a;
            *(u32x2*)(Y5 + d * LDP + c0) = bq;
            *(u32x2*)(Y0 + d * LDP + c0) = c;
            *(u32x2*)(Y1 + d * LDP + c0) = dq_;
        }
    }
    __syncthreads();
    {
        const float dec = scal[0];
        f32x4 acc[4];
        zero4(acc); mm64(acc, wT, LDP, Y4, LDP);
#pragma unroll
        for (int nt = 0; nt < 4; ++nt) {
            const int d = 16 * w + fq * 4, c = nt * 16 + fr, row = row0 + (dir ? 63 - c : c);
            const u32x2 qv = *(const u32x2*)(gqkv + (size_t)row * 768 + h * 64 + d);
            const float ec = __expf(cum[c]);
            u32x2 pk;
            pk.x = pack2(__uint_as_float(qv.x << 16) * ec - acc[nt][0], __uint_as_float(qv.x & 0xffff0000u) * ec - acc[nt][1]);
            pk.y = pack2(__uint_as_float(qv.y << 16) * ec - acc[nt][2], __uint_as_float(qv.y & 0xffff0000u) * ec - acc[nt][3]);
            *(u32x2*)(p.gdQ + idx * 4096 + c * 64 + d) = pk;
        }
        zero4(acc); mm64(acc, Y5, LDP, Y2, LDP);
#pragma unroll
        for (int nt = 0; nt < 4; ++nt) {
            const int d = 16 * w + fq * 4, d2 = nt * 16 + fr;
            u32x2 pk;
            pk.x = pack2((d == d2 ? dec : 0.f) - acc[nt][0], (d + 1 == d2 ? dec : 0.f) - acc[nt][1]);
            pk.y = pack2((d + 2 == d2 ? dec : 0.f) - acc[nt][2], (d + 3 == d2 ? dec : 0.f) - acc[nt][3]);
            *(u32x2*)(p.gdM + idx * 4096 + d2 * 64 + d) = pk;
        }
        zero4(acc); mm64(acc, Y2, LDP, Y1, LDP);
#pragma unroll
        for (int nt = 0; nt < 4; ++nt) {
            const int d2 = 16 * w + fq * 4, e = nt * 16 + fr;
            u32x2 pk; pk.x = pack2(acc[nt][0], acc[nt][1]); pk.y = pack2(acc[nt][2], acc[nt][3]);
            *(u32x2*)(p.gdN + idx * 4096 + e * 64 + d2) = pk;
        }
        zero4(acc); mm64(acc, Y4, LDP, Y0, LDP);
#pragma unroll
        for (int nt = 0; nt < 4; ++nt) {
            const int c = 16 * w + fq * 4, e = nt * 16 + fr;
            u32x2 pk; pk.x = pack2(acc[nt][0], acc[nt][1]); pk.y = pack2(acc[nt][2], acc[nt][3]);
            *(u32x2*)(p.gdO + idx * 4096 + e * 64 + c) = pk;
        }
    }
    __syncthreads();
}

DEV void phase_chunkA(const P& p, int l, const u16* gqkv, int bid, int nb, unsigned char* sm) {
    for (int u = bid; u < 3 * 2112; u += nb) {
        const int mix = u / 2112, v = u % 2112;
        const int h = v & 3, st = (v >> 2) % NSTEP, db = (v >> 2) / NSTEP, b = db & 1, dir = db >> 1;
        if (mix == 0) gd_phaseA(p, l, gqkv, dir, b, st, h, sm);
        else if (mix == 1) gla_phaseA(p, l, dir, b, st, h, sm);
        else ml_phaseA(p, l, dir, b, st, h, sm);
    }
}
DEV void gd_scan(const P& p, int chain, u16* sm) {
    const int dir = chain >> 3, b = (chain >> 2) & 1, h = chain & 3;
    const int tid_ = tidx();
    const int lane = tid_ & 63, w = tid_ >> 6, fr = lane & 15, fq = lane >> 4;
    u16* sl = sm + w * 16 * LDP;
    bf16x8 sb[2];
    sb[0] = bf16x8{0, 0, 0, 0, 0, 0, 0, 0}; sb[1] = sb[0];
    bf16x8 a[4][2]; u32x2 nv[4];
    {
        const size_t idx = state_idx(dir, b, 0, h);
#pragma unroll
        for (int mt = 0; mt < 4; ++mt) {
#pragma unroll
            for (int ks = 0; ks < 2; ++ks) a[mt][ks] = *(const bf16x8*)(p.gdM + idx * 4096 + (mt * 16 + fr) * 64 + ks * 32 + fq * 8);
            nv[mt] = *(const u32x2*)(p.gdN + idx * 4096 + (16 * w + fr) * 64 + mt * 16 + fq * 4);
        }
    }
    for (int st = 0; st < NSTEP; ++st) {
        const size_t idx = state_idx(dir, b, st, h);
        f32x4 acc[4];
#pragma unroll
        for (int mt = 0; mt < 4; ++mt) {
            acc[mt][0] = __uint_as_float(nv[mt].x << 16); acc[mt][1] = __uint_as_float(nv[mt].x & 0xffff0000u);
            acc[mt][2] = __uint_as_float(nv[mt].y << 16); acc[mt][3] = __uint_as_float(nv[mt].y & 0xffff0000u);
        }
#pragma unroll
        for (int mt = 0; mt < 4; ++mt)
#pragma unroll
            for (int ks = 0; ks < 2; ++ks) acc[mt] = mfma16(a[mt][ks], sb[ks], acc[mt]);
#pragma unroll
        for (int ks = 0; ks < 2; ++ks) *(bf16x8*)(p.gdN + idx * 4096 + (16 * w + fr) * 64 + ks * 32 + fq * 8) = sb[ks];
        if (st + 1 < NSTEP) {
            const size_t nx = state_idx(dir, b, st + 1, h);
#pragma unroll
            for (int mt = 0; mt < 4; ++mt) {
#pragma unroll
                for (int ks = 0; ks < 2; ++ks) a[mt][ks] = *(const bf16x8*)(p.gdM + nx * 4096 + (mt * 16 + fr) * 64 + ks * 32 + fq * 8);
                nv[mt] = *(const u32x2*)(p.gdN + nx * 4096 + (16 * w + fr) * 64 + mt * 16 + fq * 4);
            }
        }
#pragma unroll
        for (int mt = 0; mt < 4; ++mt) {
            u32x2 pk; pk.x = pack2(acc[mt][0], acc[mt][1]); pk.y = pack2(acc[mt][2], acc[mt][3]);
            *(u32x2*)(sl + fr * LDP + mt * 16 + fq * 4) = pk;
        }
        __builtin_amdgcn_fence(__ATOMIC_RELEASE, "wavefront");
        __builtin_amdgcn_wave_barrier();
        __builtin_amdgcn_fence(__ATOMIC_ACQUIRE, "wavefront");
#pragma unroll
        for (int ks = 0; ks < 2; ++ks) sb[ks] = *(const bf16x8*)(sl + fr * LDP + ks * 32 + fq * 8);
        __builtin_amdgcn_wave_barrier();
    }
}

DEV void gla_scan(const P& p, int v) {
    const int chain = v >> 3, sub = v & 7;
    const int dir = chain >> 3, b = (chain >> 2) & 1, h = chain & 3;
    const int ep = sub * 256 + tidx(), d = (2 * ep) & 63;
    float s0 = 0.f, s1 = 0.f;
    for (int st0 = 0; st0 < NSTEP; st0 += 4) {
        unsigned kv[4]; float2 dc[4];
#pragma unroll
        for (int k = 0; k < 4; ++k) {
            const size_t idx = state_idx(dir, b, st0 + k, h);
            kv[k] = *(const unsigned*)(p.glaS + idx * 4096 + 2 * ep);
            dc[k] = *(const float2*)(p.glaDec + idx * 64 + d);
        }
#pragma unroll
        for (int k = 0; k < 4; ++k) {
            const size_t idx = state_idx(dir, b, st0 + k, h);
            *(unsigned*)(p.glaS + idx * 4096 + 2 * ep) = pack2(s0, s1);
            s0 = dc[k].x * s0 + __uint_as_float(kv[k] << 16);
            s1 = dc[k].y * s1 + __uint_as_float(kv[k] & 0xffff0000u);
        }
    }
}

DEV void ml_scan(const P& p, int v) {
    const int chain = v >> 3, sub = v & 7;
    const int dir = chain >> 3, b = (chain >> 2) & 1, h = chain & 3;
    const int tid = tidx();
    const int ep = sub * 256 + tid;
    float s0 = 0.f, s1 = 0.f, m = 0.f, nn = 0.f;
    const bool do_n = (sub == 0 && tid < 64);
    for (int st0 = 0; st0 < NSTEP; st0 += 4) {
        unsigned kv[4]; float fe[4], ae[4], ks[4];
#pragma unroll
        for (int k = 0; k < 4; ++k) {
            const size_t idx = state_idx(dir, b, st0 + k, h);
            kv[k] = *(const unsigned*)(p.mlS + idx * 4096 + 2 * ep);
            fe[k] = p.mlFE[idx]; ae[k] = p.mlAE[idx];
            ks[k] = do_n ? p.mlN[idx * 64 + tid] : 0.f;
        }
#pragma unroll
        for (int k = 0; k < 4; ++k) {
            const size_t idx = state_idx(dir, b, st0 + k, h);
            *(unsigned*)(p.mlS + idx * 4096 + 2 * ep) = pack2(s0, s1);
            if (do_n) p.mlN[idx * 64 + tid] = nn;
            if (sub == 0 && tid == 0) p.mlM[idx] = m;
            const float mn = fmaxf(fe[k] + m, ae[k]);
            const float od = __expf(fe[k] + m - mn), nw = __expf(ae[k] - mn);
            s0 = od * s0 + nw * __uint_as_float(kv[k] << 16);
            s1 = od * s1 + nw * __uint_as_float(kv[k] & 0xffff0000u);
            nn = od * nn + nw * ks[k];
            m = mn;
        }
    }
}

DEV void phase_scan(const P& p, int bid, int nb, u16* sm) {
    for (int u = bid; u < 16 + 128 + 128; u += nb) {
        if (u < 16) gd_scan(p, u, sm);
        else if (u < 144) gla_scan(p, u - 16);
        else ml_scan(p, u - 144);
    }
}
DEV void chunk_geom(int g, int& b, int& row0, int& stf, int& stb) {
    b = g / NSTEP; const int wv = g % NSTEP;
    row0 = wv < 4 ? RLAT + b * CTXL + wv * 64 : b * SEQ + (wv - 4) * 64;
    stf = wv; stb = wv < 4 ? 3 - wv : 135 - wv;
}
DEV void obuf_acc(float* obuf, const f32x4 (&acc)[4], int dir) {
    const int lane = tidx() & 63, w = tidx() >> 6, fr = lane & 15, fq = lane >> 4;
#pragma unroll
    for (int nt = 0; nt < 4; ++nt)
#pragma unroll
        for (int j = 0; j < 4; ++j) {
            const int c = 16 * w + fq * 4 + j, e = nt * 16 + fr;
            if (dir == 0) obuf[c * 65 + e] = acc[nt][j]; else obuf[(63 - c) * 65 + e] += acc[nt][j];
        }
}
template <int ACT>
DEV void head_out(const P& p, int l, int br, int h, int row0, int gcol, const float* obuf) {
    const int tid = tidx(), row = tid >> 2, eg = tid & 3;
    float o[16]; float ss = 0.f;
#pragma unroll
    for (int i = 0; i < 16; ++i) { o[i] = obuf[row * 65 + eg * 16 + i]; ss += o[i] * o[i]; }
    ss += __shfl_xor(ss, 1, 64); ss += __shfl_xor(ss, 2, 64);
    const float rs = rsqrtf(ss * (1.f / 64.f) + EPSF);
    float gt[16];
    ld16bf(p.cols + (size_t)(row0 + row) * NCM + gcol + h * 64 + eg * 16, gt);
    float y[16];
#pragma unroll
    for (int i = 0; i < 16; ++i) {
        const float hn = p.head_norm[(l * 4 + br) * 256 + h * 64 + eg * 16 + i];
        const float a = ACT == 0 ? silu(gt[i]) : sigm(gt[i]);
        y[i] = o[i] * rs * hn * a;
    }
    st16bf(p.ybuf + (size_t)(row0 + row) * 1024 + br * 256 + h * 64 + eg * 16, y);
}

DEV void gla_phaseC(const P& p, int l, int g, int h, unsigned char* smraw) {
    float* cum = (float*)smraw;
    float* rt = cum + 64 * 65;
    float* sg = rt + 64 * 17;
    float* obuf = sg + 256;
    u16* qi = (u16*)(obuf + 64 * 65);
    u16* ko = qi + 64 * LDP;
    u16* vT = ko + 64 * LDP;
    const int tid = tidx(), lane = tid & 63, w = tid >> 6, fr = lane & 15, fq = lane >> 4;
    int b, row0, stf, stb; chunk_geom(g, b, row0, stf, stb);
    for (int dir = 0; dir < 2; ++dir) {
        const size_t idx = state_idx(dir, b, dir ? stb : stf, h);
        gla_cum(p, l, dir, h, row0, cum, rt, sg);
        {
            const int s = tid >> 2, dg = tid & 3, row = row0 + (dir ? 63 - s : s);
            float qq[16], kk[16], vv[16];
            ld16bf(p.cols + (size_t)row * NCM + GLA_Q + h * 64 + dg * 16, qq);
            ld16bf(p.cols + (size_t)row * NCM + GLA_K + h * 64 + dg * 16, kk);
            ld16bf(p.cols + (size_t)row * NCM + GLA_V + h * 64 + dg * 16, vv);
#pragma unroll
            for (int i = 0; i < 16; ++i) {
                const float cv = cum[s * 65 + dg * 16 + i];
                qq[i] *= 0.125f * __expf(cv); kk[i] *= __expf(-cv);
                vT[(dg * 16 + i) * LDP + s] = f2bf(vv[i]);
            }
            st16bf(qi + s * LDP + dg * 16, qq);
            st16bf(ko + s * LDP + dg * 16, kk);
        }
        __syncthreads();
        f32x4 sa[4]; zero4(sa);
        mm64(sa, qi, LDP, ko, LDP);
        __syncthreads();
#pragma unroll
        for (int nt = 0; nt < 4; ++nt)
#pragma unroll
            for (int j = 0; j < 4; ++j) {
                const int c = 16 * w + fq * 4 + j, s = nt * 16 + fr;
                ko[c * LDP + s] = f2bf(s <= c ? sa[nt][j] : 0.f);
            }
        __syncthreads();
        f32x4 oa[4]; zero4(oa);
        mm64(oa, ko, LDP, vT, LDP);
        mm64(oa, qi, LDP, p.glaS + idx * 4096, 64);
        obuf_acc(obuf, oa, dir);
        __syncthreads();
    }
    head_out<0>(p, l, 0, h, row0, GLA_G, obuf);
    __syncthreads();
}

DEV void ml_phaseC(const P& p, int l, int g, int h, unsigned char* smraw) {
    float* obuf = (float*)smraw;
    float* fcum = obuf + 64 * 65;
    float* ipre = fcum + 64;
    float* mrow = ipre + 64;
    float* denl = mrow + 64;
    float* qn = denl + 64;
    float* nin = qn + 64;
    u16* qs = (u16*)(nin + 64 + 64);
    u16* ks = qs + 64 * LDP;
    u16* vT = ks + 64 * LDP;
    const int tid = tidx(), lane = tid & 63, w = tid >> 6, fr = lane & 15, fq = lane >> 4;
    int b, row0, stf, stb; chunk_geom(g, b, row0, stf, stb);
    for (int dir = 0; dir < 2; ++dir) {
        const size_t idx = state_idx(dir, b, dir ? stb : stf, h);
        const float m_in = p.mlM[idx];
        if (w == 0) {
            const int row = row0 + (dir ? 63 - lane : lane);
            const float ip = bf2f(p.cols[(size_t)row * NCM + ML_GF + dir * 8 + h]) + p.mlstm_gate_b[((l * 2 + dir) * 2 + 0) * 4 + h];
            const float lf = logsig(bf2f(p.cols[(size_t)row * NCM + ML_GF + dir * 8 + 4 + h]) + p.mlstm_gate_b[((l * 2 + dir) * 2 + 1) * 4 + h]);
            const float fc = wscan_add(lf, lane);
            const float pm = wscan_max(ip - fc, lane);
            fcum[lane] = fc; ipre[lane] = ip; mrow[lane] = fc + fmaxf(m_in, pm);
            nin[lane] = p.mlN[idx * 64 + lane];
        }
        {
            const int s = tid >> 2, dg = tid & 3, row = row0 + (dir ? 63 - s : s);
            float kk[16], vv[16];
            const u16* qsrc = p.cols + (size_t)row * NCM + ML_Q + h * 64 + dg * 16;
            *(u32x4*)(qs + s * LDP + dg * 16) = *(const u32x4*)qsrc;
            *(u32x4*)(qs + s * LDP + dg * 16 + 8) = *(const u32x4*)(qsrc + 8);
            ld16bf(p.cols + (size_t)row * NCM + ML_K + h * 64 + dg * 16, kk);
            ld16bf(p.cols + (size_t)row * NCM + ML_V + h * 64 + dg * 16, vv);
#pragma unroll
            for (int i = 0; i < 16; ++i) { kk[i] *= 0.125f; vT[(dg * 16 + i) * LDP + s] = f2bf(vv[i]); }
            st16bf(ks + s * LDP + dg * 16, kk);
        }
        __syncthreads();
        {
            const int c = tid >> 2, dg = tid & 3;
            float a = 0.f;
#pragma unroll
            for (int i = 0; i < 16; ++i) a += bf2f(qs[c * LDP + dg * 16 + i]) * nin[dg * 16 + i];
            a += __shfl_xor(a, 1, 64); a += __shfl_xor(a, 2, 64);
            if (dg == 0) qn[c] = a;
        }
        f32x4 sa[4]; zero4(sa);
        mm64(sa, qs, LDP, ks, LDP);
        __syncthreads();
        float dsum[4] = {0.f, 0.f, 0.f, 0.f};
#pragma unroll
        for (int nt = 0; nt < 4; ++nt)
#pragma unroll
            for (int j = 0; j < 4; ++j) {
                const int c = 16 * w + fq * 4 + j, s = nt * 16 + fr;
                float val = 0.f;
                if (s <= c) val = sa[nt][j] * __expf(fcum[c] - fcum[s] + ipre[s] - mrow[c]);
                dsum[j] += val;
                ks[c * LDP + s] = f2bf(val);
            }
#pragma unroll
        for (int j = 0; j < 4; ++j) {
            float v = dsum[j];
            v += __shfl_xor(v, 1, 64); v += __shfl_xor(v, 2, 64); v += __shfl_xor(v, 4, 64); v += __shfl_xor(v, 8, 64);
            if (fr == 0) denl[16 * w + fq * 4 + j] = v;
        }
        __syncthreads();
        f32x4 n1[4], n2[4]; zero4(n1); zero4(n2);
        mm64(n1, ks, LDP, vT, LDP);
        mm64(n2, qs, LDP, p.mlS + idx * 4096, 64);
        f32x4 oa[4];
#pragma unroll
        for (int j = 0; j < 4; ++j) {
            const int c = 16 * w + fq * 4 + j;
            const float mr = mrow[c];
            const float ec = __expf(fcum[c] + m_in - mr);
            const float den = denl[c] + ec * qn[c];
            const float inv = 1.f / fmaxf(fabsf(den), __expf(-mr));
#pragma unroll
            for (int nt = 0; nt < 4; ++nt) oa[nt][j] = (n1[nt][j] + ec * n2[nt][j]) * inv;
        }
        obuf_acc(obuf, oa, dir);
        __syncthreads();
    }
    head_out<1>(p, l, 1, h, row0, ML_O, obuf);
    __syncthreads();
}

DEV void gd_phaseC(const P& p, int l, int g, int h, unsigned char* smraw) {
    float* obuf = (float*)smraw;
    const int tid = tidx(), lane = tid & 63, w = tid >> 6, fr = lane & 15, fq = lane >> 4;
    int b, row0, stf, stb; chunk_geom(g, b, row0, stf, stb);
    for (int dir = 0; dir < 2; ++dir) {
        const size_t idx = state_idx(dir, b, dir ? stb : stf, h);
        f32x4 oa[4];
#pragma unroll
        for (int nt = 0; nt < 4; ++nt) {
            const u32x2 ov = *(const u32x2*)(p.gdO + idx * 4096 + (nt * 16 + fr) * 64 + 16 * w + fq * 4);
            oa[nt][0] = __uint_as_float(ov.x << 16); oa[nt][1] = __uint_as_float(ov.x & 0xffff0000u);
            oa[nt][2] = __uint_as_float(ov.y << 16); oa[nt][3] = __uint_as_float(ov.y & 0xffff0000u);
        }
        mm64(oa, p.gdQ + idx * 4096, 64, p.gdN + idx * 4096, 64);
        obuf_acc(obuf, oa, dir);
        __syncthreads();
    }
    head_out<0>(p, l, 2, h, row0, GD_OG, obuf);
    __syncthreads();
}
DEV float fexp2(float x) { return __builtin_amdgcn_exp2f(x); }

DEV void attn_unit(const P& p, int l, int b, int h, int q0pos, int nkeys, int rowbase, u16* sm) {
    u16* Ks = sm;
    u16* Vs = sm + 64 * LDP;
    const int tid = tidx(), lane = tid & 63, w = tid >> 6, fr = lane & 15, fq = lane >> 4;
    const size_t bh = (size_t)(b * 4 + h);
    float lam;
    {
        const float* lp = p.diff_lambda + (size_t)l * 4 * 4 * 32;
        float a = 0.f, c = 0.f;
        if (lane < 32) { a = lp[(0 * 4 + h) * 32 + lane] * lp[(1 * 4 + h) * 32 + lane]; c = lp[(2 * 4 + h) * 32 + lane] * lp[(3 * 4 + h) * 32 + lane]; }
        a = wsum(a); c = wsum(c);
        const float lam_init = 0.8f - 0.6f * expf(-0.3f * (float)l);
        lam = expf(a) - expf(c) + lam_init;
    }
    const float lam_init = 0.8f - 0.6f * expf(-0.3f * (float)l);
    bf16x8 qf[2][2];
#pragma unroll
    for (int g = 0; g < 2; ++g)
#pragma unroll
        for (int i = 0; i < 2; ++i)
            qf[g][i] = *(const bf16x8*)(p.dq + (bh * KPOS + q0pos + w * 32 + g * 16 + fr) * 64 + i * 32 + fq * 8);
    f32x4 O[2][2][4];
    float mrun[2][2], lsum[2][2];
#pragma unroll
    for (int i = 0; i < 2; ++i)
#pragma unroll
        for (int g = 0; g < 2; ++g) {
            mrun[i][g] = -INFINITY; lsum[i][g] = 0.f;
#pragma unroll
            for (int t = 0; t < 4; ++t) O[i][g][t] = f32x4{0.f, 0.f, 0.f, 0.f};
        }
    const u16* kbase = p.dk + bh * KPOS * 64;
    const u16* vbase = p.dvT + bh * 64 * KPOS;
    const int nk = nkeys >> 6;
    u32x4 rk[2], rv[2];
#pragma unroll
    for (int i = 0; i < 2; ++i) {
        const int c = tid + i * 256, r = c >> 3, cc = c & 7;
        rk[i] = *(const u32x4*)(kbase + (size_t)r * 64 + cc * 8);
        rv[i] = *(const u32x4*)(vbase + (size_t)r * KPOS + cc * 8);
    }
    for (int kt = 0; kt < nk; ++kt) {
#pragma unroll
        for (int i = 0; i < 2; ++i) {
            const int c = tid + i * 256, r = c >> 3, cc = c & 7;
            *(u32x4*)(Ks + r * LDP + cc * 8) = rk[i];
            *(u32x4*)(Vs + r * LDP + cc * 8) = rv[i];
        }
        __syncthreads();
        if (kt + 1 < nk) {
#pragma unroll
            for (int i = 0; i < 2; ++i) {
                const int c = tid + i * 256, r = c >> 3, cc = c & 7;
                rk[i] = *(const u32x4*)(kbase + (size_t)((kt + 1) * 64 + r) * 64 + cc * 8);
                rv[i] = *(const u32x4*)(vbase + (size_t)r * KPOS + (kt + 1) * 64 + cc * 8);
            }
        }
#pragma unroll
        for (int i = 0; i < 2; ++i) {
            f32x4 s[2][4];
#pragma unroll
            for (int st = 0; st < 4; ++st) {
                const bf16x8 kf = *(const bf16x8*)(Ks + (st * 16 + fr) * LDP + i * 32 + fq * 8);
#pragma unroll
                for (int g = 0; g < 2; ++g) s[g][st] = mfma16(kf, qf[g][i], f32x4{0.f, 0.f, 0.f, 0.f});
            }
            bf16x8 pb[2][2];
#pragma unroll
            for (int g = 0; g < 2; ++g) {
                float mx = s[g][0][0];
#pragma unroll
                for (int st = 0; st < 4; ++st)
#pragma unroll
                    for (int j = 0; j < 4; ++j) mx = fmaxf(mx, s[g][st][j]);
                mx = fmaxf(mx, __shfl_xor(mx, 16, 64)); mx = fmaxf(mx, __shfl_xor(mx, 32, 64));
                const float mn = fmaxf(mrun[i][g], mx);
                const float alpha = fexp2(mrun[i][g] - mn);
                mrun[i][g] = mn;
                float ps = 0.f;
#pragma unroll
                for (int st = 0; st < 4; ++st)
#pragma unroll
                    for (int j = 0; j < 4; ++j) { const float e = fexp2(s[g][st][j] - mn); s[g][st][j] = e; ps += e; }
                lsum[i][g] = lsum[i][g] * alpha + ps;
#pragma unroll
                for (int t = 0; t < 4; ++t) { O[i][g][t][0] *= alpha; O[i][g][t][1] *= alpha; O[i][g][t][2] *= alpha; O[i][g][t][3] *= alpha; }
#pragma unroll
                for (int ks = 0; ks < 2; ++ks) {
                    union { bf16x8 v; unsigned u[4]; } pk;
                    pk.u[0] = pack2(s[g][2 * ks][0], s[g][2 * ks][1]); pk.u[1] = pack2(s[g][2 * ks][2], s[g][2 * ks][3]);
                    pk.u[2] = pack2(s[g][2 * ks + 1][0], s[g][2 * ks + 1][1]); pk.u[3] = pack2(s[g][2 * ks + 1][2], s[g][2 * ks + 1][3]);
                    pb[g][ks] = pk.v;
                }
            }
#pragma unroll
            for (int ks = 0; ks < 2; ++ks)
#pragma unroll
                for (int t = 0; t < 4; ++t) {
                    union { bf16x8 v; u32x2 h2[2]; } va;
                    va.h2[0] = *(const u32x2*)(Vs + (t * 16 + fr) * LDP + (2 * ks) * 16 + fq * 4);
                    va.h2[1] = *(const u32x2*)(Vs + (t * 16 + fr) * LDP + (2 * ks + 1) * 16 + fq * 4);
#pragma unroll
                    for (int g = 0; g < 2; ++g) O[i][g][t] = mfma16(va.v, pb[g][ks], O[i][g][t]);
                }
        }
        __syncthreads();
    }
#pragma unroll
    for (int g = 0; g < 2; ++g) {
        float l0 = lsum[0][g], l1 = lsum[1][g];
        l0 += __shfl_xor(l0, 16, 64); l0 += __shfl_xor(l0, 32, 64);
        l1 += __shfl_xor(l1, 16, 64); l1 += __shfl_xor(l1, 32, 64);
        const float i0 = 1.f / l0, i1 = lam / l1;
        float o[4][4]; float ss = 0.f;
#pragma unroll
        for (int t = 0; t < 4; ++t)
#pragma unroll
            for (int j = 0; j < 4; ++j) { o[t][j] = O[0][g][t][j] * i0 - O[1][g][t][j] * i1; ss += o[t][j] * o[t][j]; }
        ss += __shfl_xor(ss, 16, 64); ss += __shfl_xor(ss, 32, 64);
        const float rs = rsqrtf(ss * (1.f / 64.f) + EPSF) * (1.f - lam_init);
        const int row = rowbase + w * 32 + g * 16 + fr;
#pragma unroll
        for (int t = 0; t < 4; ++t) {
            const int dv = t * 16 + fq * 4;
            const float4 hn = *(const float4*)(p.head_norm + (l * 4 + 3) * 256 + h * 64 + dv);
            u32x2 pk; pk.x = pack2(o[t][0] * rs * hn.x, o[t][1] * rs * hn.y); pk.y = pack2(o[t][2] * rs * hn.z, o[t][3] * rs * hn.w);
            *(u32x2*)(p.ybuf + (size_t)row * 1024 + 768 + h * 64 + dv) = pk;
        }
    }
}

DEV void phase_outputs(const P& p, int l, int bid, int nb, unsigned char* sm) {
    const int n_att = 512 + (l == 0 ? 16 : 0);
    for (int u = bid; u < n_att; u += nb) {
        int b, h, q0pos, nkeys, rowbase;
        if (u < 512) { b = u >> 8; h = (u >> 6) & 3; const int qt = u & 63; q0pos = CTXL + qt * 128; nkeys = KPOS; rowbase = b * SEQ + qt * 128; }
        else { const int v = u - 512; b = v >> 3; h = (v >> 1) & 3; const int qt = v & 1; q0pos = qt * 128; nkeys = CTXL; rowbase = RLAT + b * CTXL + qt * 128; }
        attn_unit(p, l, b, h, q0pos, nkeys, rowbase, (u16*)sm);
    }
    __builtin_amdgcn_sched_barrier(0);
    const int v0 = ((bid - n_att) % nb + nb) % nb;
    for (int v = v0; v < 3 * 1056; v += nb) {
        const int mix = v / 1056, r = v % 1056, g = r >> 2, h = r & 3;
        if (l == 1 && (g % NSTEP) < 4) continue;
        if (mix == 0) gla_phaseC(p, l, g, h, sm);
        else if (mix == 1) ml_phaseC(p, l, g, h, sm);
        else gd_phaseC(p, l, g, h, sm);
    }
}
#define LDS_BYTES 73728
#ifndef MULTI
#define MULTI 0
#endif
#ifndef STAGE
#define STAGE 99
#endif

enum { PH_PRO0 = 0, PH_PRO1, PH_NORM1, PH_INPROJ, PH_PREP, PH_CHUNKA, PH_SCAN, PH_OUT, PH_GATES, PH_MERGE1, PH_MERGE2, PH_ROUTER, PH_MOEUP, PH_MOEDOWN, PH_FINAL };

template <int PH>
DEV void run_phase(const P& p, int l, int bid_, int nb_, unsigned char* sm) {
    const int bid = launder_s(bid_), nb = launder_s(nb_);
    u16* gqkv = p.ybuf;
    u16* ubuf = p.glaS;
    const int mtiles = l == 0 ? 132 : 128;
    if (PH == PH_PRO0) { phase_conv_mixw(p, 0, bid, nb, (float*)sm); phase_mod_partial(p, bid, nb, (float*)sm); }
    else if (PH == PH_PRO1) phase_mod_reduce(p, bid, nb);
    else if (PH == PH_NORM1) phase_norm1(p, l, bid, nb);
    else if (PH == PH_INPROJ) phase_inproj<false>(p, 0, 31, NCM, 132, bid, nb, (u16*)sm);
    else if (PH == PH_PREP) phase_prep(p, l, gqkv, bid, nb, (u16*)sm);
    else if (PH == PH_CHUNKA) phase_chunkA(p, l, gqkv, bid, nb, sm);
    else if (PH == PH_SCAN) phase_scan(p, bid, nb, (u16*)sm);
    else if (PH == PH_OUT) phase_outputs(p, l, bid, nb, sm);
    else if (PH == PH_GATES) phase_inproj<true>(p, 3968, 32, NGATE, mtiles, bid, nb, (u16*)sm);
    else if (PH == PH_MERGE1) phase_merge1(p, ubuf, mtiles, bid, nb, (u16*)sm);
    else if (PH == PH_MERGE2) phase_merge2(p, l, ubuf, mtiles, bid, nb, (u16*)sm);
    else if (PH == PH_ROUTER) {
        phase_norm2_router(p, l, l == 0 ? RTOT : RLAT, bid, nb, (float*)sm);
        phase_conv_moew(p, l, bid, nb, (float*)sm);
        if (l == 0) phase_conv_mixw(p, 1, bid, nb, (float*)sm);
    }
    else if (PH == PH_MOEUP) phase_moe_up(p, l, bid, nb, (u16*)sm);
    else if (PH == PH_MOEDOWN) phase_moe_down(p, l, bid, nb, (u16*)sm);
    else if (PH == PH_FINAL) phase_final_norm(p, bid, nb);
}

#if MULTI
template <int PH>
__global__ void __launch_bounds__(NTHR, 2) k_phase(P p, int l) {
    extern __shared__ __attribute__((aligned(16))) unsigned char smem[];
    run_phase<PH>(p, l, blockIdx.x, gridDim.x, smem);
}
#else
__global__ void __launch_bounds__(NTHR, 2) k_mega(P p) {
    extern __shared__ __attribute__((aligned(16))) unsigned char smem[];
    volatile LAS unsigned* xbw = (volatile LAS unsigned*)(smem + LDS_BYTES);
    if (threadIdx.x == 0) { xbw[0] = 0u; xbw[1] = 0u; xbw[2] = 0u; xbw[3] = 0u; }
    __syncthreads();
    (void)xcd_barrier_post(p.bar, xbw);
    const int bid = blockIdx.x, nb = gridDim.x;
#ifdef PROBE_SEL
    unsigned long long pr_acc = 0, pr_t0 = wall_clock64();
#define PSTAMP(PH) do { const unsigned long long t_ = wall_clock64(); if ((PH) == PROBE_SEL) pr_acc += t_ - pr_t0; pr_t0 = t_; } while (0)
#else
#define PSTAMP(PH) do { } while (0)
#endif
#define GBAR() do { XcdBarrier b_; b_.bar = p.bar; b_.x = xb_xcc_id(); b_.st = (volatile LAS unsigned*)(smem + LDS_BYTES); xcd_barrier(b_); } while (0)
    run_phase<PH_PRO0>(p, 0, bid, nb, smem); GBAR(); PSTAMP(PH_PRO0);
    run_phase<PH_PRO1>(p, 0, bid, nb, smem); GBAR(); PSTAMP(PH_PRO1);
    for (int l = 0; l < 2; ++l) {
        run_phase<PH_NORM1>(p, l, bid, nb, smem); GBAR(); PSTAMP(PH_NORM1);
        run_phase<PH_INPROJ>(p, l, bid, nb, smem); GBAR(); PSTAMP(PH_INPROJ);
        run_phase<PH_PREP>(p, l, bid, nb, smem); GBAR(); PSTAMP(PH_PREP);
        run_phase<PH_CHUNKA>(p, l, bid, nb, smem); GBAR(); PSTAMP(PH_CHUNKA);
        run_phase<PH_SCAN>(p, l, bid, nb, smem); GBAR(); PSTAMP(PH_SCAN);
        run_phase<PH_OUT>(p, l, bid, nb, smem); GBAR(); PSTAMP(PH_OUT);
        run_phase<PH_GATES>(p, l, bid, nb, smem); GBAR(); PSTAMP(PH_GATES);
        run_phase<PH_MERGE1>(p, l, bid, nb, smem); GBAR(); PSTAMP(PH_MERGE1);
        run_phase<PH_MERGE2>(p, l, bid, nb, smem); GBAR(); PSTAMP(PH_MERGE2);
        run_phase<PH_ROUTER>(p, l, bid, nb, smem); GBAR(); PSTAMP(PH_ROUTER);
        run_phase<PH_MOEUP>(p, l, bid, nb, smem); GBAR(); PSTAMP(PH_MOEUP);
        run_phase<PH_MOEDOWN>(p, l, bid, nb, smem); GBAR(); PSTAMP(PH_MOEDOWN);
    }
    run_phase<PH_FINAL>(p, 0, bid, nb, smem);
#ifdef PROBE_SEL
    if (blockIdx.x == 0) { const unsigned long long te = wall_clock64(); while (wall_clock64() - te < pr_acc * 4ull) __builtin_amdgcn_s_sleep(8); }
#endif
}
#endif

static size_t al256(size_t x) { return (x + 255) & ~(size_t)255; }

extern "C" void kernel_launch(void* const* d_in, const int* in_sizes, int n_in, void* d_out, int out_size, void* d_ws, size_t ws_size,
                              hipStream_t stream) {
    (void)in_sizes; (void)n_in; (void)out_size; (void)ws_size;
    P p{};
    p.x = (const float*)d_in[0]; p.c = (const float*)d_in[1]; p.ctx = (const float*)d_in[2]; p.c_ctx = (const float*)d_in[3];
    p.w_mod = (const float*)d_in[4]; p.b_mod = (const float*)d_in[5]; p.norm_mix = (const float*)d_in[6]; p.norm_ffn = (const float*)d_in[7];
    p.w_in = (const float*)d_in[8]; p.gla_a2 = (const float*)d_in[9]; p.gla_ab = (const float*)d_in[10]; p.mlstm_gate_b = (const float*)d_in[11];
    p.gdn_conv = (const float*)d_in[12]; p.gdn_a_log = (const float*)d_in[13]; p.gdn_dt_bias = (const float*)d_in[14];
    p.diff_lambda = (const float*)d_in[15]; p.head_norm = (const float*)d_in[16]; p.w_branch = (const float*)d_in[17];
    p.w_out = (const float*)d_in[18]; p.router_w = (const float*)d_in[19]; p.router_b = (const float*)d_in[20];
    p.w_gate = (const float*)d_in[21]; p.w_up = (const float*)d_in[22]; p.w_down = (const float*)d_in[23]; p.norm_final = (const float*)d_in[24];
    p.out = (float*)d_out;
    unsigned char* ws = (unsigned char*)d_ws;
    size_t o = 0;
    auto take = [&](size_t bytes) { unsigned char* r = ws + o; o = al256(o + bytes); return r; };
    p.bar = (unsigned*)take(XCD_BAR_WORDS * 4);
    p.cnt = (int*)take(256);
    const size_t zero_bytes = o;
    p.modp = (float*)take((size_t)2 * 16 * 3 * 6144 * 4);
    p.mod = (float*)take((size_t)2 * 3 * 6144 * 4);
    p.xctx = (float*)take((size_t)RCTX * DM * 4);
    p.hbuf = (u16*)take((size_t)RTOT * DM * 2);
    p.ybuf = (u16*)take((size_t)RTOT * DM * 2);
    p.Wt = (u16*)take((size_t)WT_TOTAL * 2);
    p.dq = (u16*)take((size_t)8 * KPOS * 64 * 2);
    p.dk = (u16*)take((size_t)8 * KPOS * 64 * 2);
    p.dvT = (u16*)take((size_t)8 * KPOS * 64 * 2);
    const size_t nst = (size_t)2 * 2 * NSTEP * 4;
    p.glaDec = (float*)take(nst * 64 * 4);
    p.mlN = (float*)take(nst * 64 * 4);
    p.mlFE = (float*)take(nst * 4);
    p.mlAE = (float*)take(nst * 4);
    p.mlM = (float*)take(nst * 4);
    p.glaS = (u16*)take(nst * 4096 * 2);
    p.mlS = (u16*)take(nst * 4096 * 2);
    p.gdM = (u16*)take(nst * 4096 * 2);
    p.gdN = (u16*)take(nst * 4096 * 2);
    p.gdQ = (u16*)take(nst * 4096 * 2);
    p.gdO = (u16*)take(nst * 4096 * 2);
    p.cols = (u16*)take((size_t)RTOT * NGATE * 2);
    hipMemsetAsync(ws, 0, zero_bytes, stream);

    static int grid = 0;
#if MULTI
#define SETUP(PH) hipFuncSetAttribute((const void*)k_phase<PH>, hipFuncAttributeMaxDynamicSharedMemorySize, LDS_BYTES + 16)
    if (!grid) {
        SETUP(PH_PRO0); SETUP(PH_PRO1); SETUP(PH_NORM1); SETUP(PH_INPROJ); SETUP(PH_PREP); SETUP(PH_CHUNKA); SETUP(PH_SCAN); SETUP(PH_OUT);
        SETUP(PH_GATES); SETUP(PH_MERGE1); SETUP(PH_MERGE2); SETUP(PH_ROUTER); SETUP(PH_MOEUP); SETUP(PH_MOEDOWN); SETUP(PH_FINAL);
        grid = 512;
    }
#define LAUNCH(PH, l) k_phase<PH><<<grid, NTHR, LDS_BYTES + 16, stream>>>(p, l)
    LAUNCH(PH_PRO0, 0); LAUNCH(PH_PRO1, 0);
    for (int l = 0; l < 2; ++l) {
        LAUNCH(PH_NORM1, l);
#if STAGE >= 1
        LAUNCH(PH_INPROJ, l); LAUNCH(PH_PREP, l); LAUNCH(PH_CHUNKA, l); LAUNCH(PH_SCAN, l); LAUNCH(PH_OUT, l);
        LAUNCH(PH_GATES, l); LAUNCH(PH_MERGE1, l); LAUNCH(PH_MERGE2, l);
#endif
        LAUNCH(PH_ROUTER, l); LAUNCH(PH_MOEUP, l); LAUNCH(PH_MOEDOWN, l);
    }
    LAUNCH(PH_FINAL, 0);
#else
    if (!grid) {
        hipFuncSetAttribute((const void*)k_mega, hipFuncAttributeMaxDynamicSharedMemorySize, LDS_BYTES + 16);
        int dev = 0, cus = 0, per_cu = 0;
        hipGetDevice(&dev);
        hipDeviceGetAttribute(&cus, hipDeviceAttributeMultiprocessorCount, dev);
        hipOccupancyMaxActiveBlocksPerMultiprocessor(&per_cu, (const void*)k_mega, NTHR, LDS_BYTES + 16);
        if (per_cu > 2) per_cu = 2;
        if (per_cu < 1) per_cu = 1;
        grid = cus * per_cu;
    }
    k_mega<<<grid, NTHR, LDS_BYTES + 16, stream>>>(p);
#endif
}
```

```cpp
#include <hip/hip_runtime.h>
#include <stdint.h>
#include <math.h>

typedef unsigned short u16;
typedef short bf16x8 __attribute__((ext_vector_type(8)));
typedef float f32x4 __attribute__((ext_vector_type(4)));
typedef unsigned u32x2 __attribute__((ext_vector_type(2)));
typedef unsigned u32x4 __attribute__((ext_vector_type(4)));

#define DEV __device__ __forceinline__
#define NTHR 256

#define DM 1024
#define RLAT 16384
#define RCTX 512
#define RTOT 16896
#define SEQ 8192
#define CTXL 256
#define NCM 3968
#define NGATE 4096
#define NSTEP 132
#define KPOS 8448
#define EPSF 1e-6f
#define GLA_Q 0
#define GLA_K 256
#define GLA_V 512
#define GLA_G 768
#define GLA_RF 1024
#define GLA_RB 1040
#define ML_Q 1056
#define ML_K 1312
#define ML_V 1568
#define ML_O 1824
#define ML_GF 2080
#define ML_GB 2088
#define GD_Q 2096
#define GD_K 2352
#define GD_V 2608
#define GD_OG 2864
#define GD_GF 3120
#define GD_GB 3128
#define DF_Q 3136
#define DF_K 3392
#define DF_V 3648

DEV int tidx() { int t = threadIdx.x; asm volatile("" : "+v"(t)); __builtin_assume(t >= 0 && t < NTHR); return t; }
DEV int launder_s(int v) { asm volatile("" : "+s"(v)); return v; }
typedef __bf16 bf2_t __attribute__((ext_vector_type(2)));
typedef float f2_t __attribute__((ext_vector_type(2)));
DEV unsigned pack2(float a, float b) { f2_t v; v.x = a; v.y = b; return __builtin_bit_cast(unsigned, __builtin_convertvector(v, bf2_t)); }
DEV u16 f2bf(float f) { return (u16)(pack2(f, 0.f) & 0xffffu); }
DEV float bf2f(u16 h) { return __uint_as_float(((unsigned)h) << 16); }
DEV float sigm(float x) { return 1.f / (1.f + __expf(-x)); }
DEV float silu(float x) { return x / (1.f + __expf(-x)); }
DEV float logsig(float x) { return fminf(x, 0.f) - __logf(1.f + __expf(-fabsf(x))); }
DEV float softplus(float x) { return fmaxf(x, 0.f) + __logf(1.f + __expf(-fabsf(x))); }
DEV float wsum(float v) {
#pragma unroll
    for (int o = 32; o; o >>= 1) v += __shfl_xor(v, o, 64);
    return v;
}
DEV float wmaxr(float v) {
#pragma unroll
    for (int o = 32; o; o >>= 1) v = fmaxf(v, __shfl_xor(v, o, 64));
    return v;
}
DEV f32x4 mfma16(bf16x8 a, bf16x8 b, f32x4 c) { return __builtin_amdgcn_mfma_f32_16x16x32_bf16(a, b, c, 0, 0, 0); }

struct P {
    const float *x, *c, *ctx, *c_ctx, *w_mod, *b_mod, *norm_mix, *norm_ffn, *w_in, *gla_a2, *gla_ab, *mlstm_gate_b,
        *gdn_conv, *gdn_a_log, *gdn_dt_bias, *diff_lambda, *head_norm, *w_branch, *w_out, *router_w, *router_b,
        *w_gate, *w_up, *w_down, *norm_final;
    float* out;
    unsigned* bar;
    int* cnt;
    float* modp;
    float* mod;
    float* xctx;
    float* rope;
    u16* hbuf;
    u16* ybuf;
    u16* Wt;
    u16* dq;
    u16* dk;
    u16* dvT;
    float* glaDec;
    float* mlN;
    float* mlFE;
    float* mlAE;
    float* mlM;
    u16* glaS;
    u16* mlS;
    u16* gdM;
    u16* gdN;
    u16* gdQ;
    u16* gdO;
    u16* cols;
};
#define MOE_WGU_OFF 0
#define MOE_WD_OFF (16u * 1024u * 1024u)
#define MOE_ACT_OFF (MOE_WD_OFF + 16u * 1024u * 512u)
#define MOE_LIST_OFF (MOE_ACT_OFF + 2u * RTOT * 512u)

DEV const float* xrow_in(const P& p, int l, int r) {
    if (l == 0) return r < RLAT ? p.x + (size_t)r * DM : p.ctx + (size_t)(r - RLAT) * DM;
    return r < RLAT ? p.out + (size_t)r * DM : p.xctx + (size_t)(r - RLAT) * DM;
}
DEV float* xrow_out(const P& p, int r) { return r < RLAT ? p.out + (size_t)r * DM : p.xctx + (size_t)(r - RLAT) * DM; }
DEV int modidx(int r) { return r < RLAT ? (r >> 13) : 2; }
DEV int chunk_row0(int b, int dir, int st) {
    if (st < 4) { int c = dir ? 3 - st : st; return RLAT + b * CTXL + c * 64; }
    int c = dir ? 131 - st : st - 4; return b * SEQ + c * 64;
}
DEV size_t state_idx(int dir, int b, int st, int h) { return ((size_t)((dir * 2 + b) * NSTEP + st) * 4 + h); }
#define XB_TMO      128
#define XB_XCNT(j)  (256  + 64 * (j))
#define XB_XSUB(j)  (1280 + 64 * (j))
#define XB_XGEN(j)  (2304 + 64 * (j))
#define XB_TOP      3328
#define XB_TOPGEN   3392
#define XCD_BAR_WORDS 3456
#define XB_SPIN_CAP (1u << 18)
#define LAS __attribute__((address_space(3)))

__device__ __forceinline__ unsigned xb_ld(unsigned* p)              { return __hip_atomic_load(p, __ATOMIC_RELAXED, __HIP_MEMORY_SCOPE_AGENT); }
__device__ __forceinline__ unsigned xb_add(unsigned* p, unsigned v) { return __hip_atomic_fetch_add(p, v, __ATOMIC_RELAXED, __HIP_MEMORY_SCOPE_AGENT); }
__device__ __forceinline__ unsigned xb_xcc_id() { return (unsigned)__builtin_amdgcn_s_getreg((3 << 11) | 20) & 0xFu; }
#define XB_SPIN(cond, bar) do { unsigned _sp = 0; while (cond) { __builtin_amdgcn_s_sleep(1); \
    if ((++_sp & 255u) == 0u) { if (xb_ld(&(bar)[XB_TMO])) break; if (_sp > XB_SPIN_CAP) { atomicAdd(&(bar)[XB_TMO], 1u); break; } } } } while (0)

struct XcdBarrier {
    unsigned* bar; unsigned x;
    volatile LAS unsigned* st;
};

__device__ __forceinline__ XcdBarrier xcd_barrier_post(unsigned* bar, volatile LAS unsigned* st) {
    XcdBarrier b; b.bar = bar; b.x = xb_xcc_id(); b.st = st;
    if (threadIdx.x == 0) (void)xb_add(&bar[XB_XCNT(b.x)], 1u);
    return b;
}
__device__ __forceinline__ void xcd_barrier_complete(unsigned* bar, unsigned x, unsigned& nloc, unsigned& nx) {
    const unsigned G = gridDim.x * gridDim.y * gridDim.z;
    unsigned sum, cnt, mine, sp = 0u;
    for (;;) {
        sum = 0u; cnt = 0u; mine = 0u;
#pragma unroll
        for (unsigned j = 0; j < 16; ++j) { const unsigned c = xb_ld(&bar[XB_XCNT(j)]); sum += c; cnt += (c > 0u) ? 1u : 0u; mine = (j == x) ? c : mine; }
        if (sum == G) break;
        __builtin_amdgcn_s_sleep(1);
        if ((++sp & 255u) == 0u) { if (xb_ld(&bar[XB_TMO])) break; if (sp > XB_SPIN_CAP) { atomicAdd(&bar[XB_TMO], 1u); break; } }
    }
    nloc = mine > 0u ? mine : 1u; nx = cnt > 0u ? cnt : 1u;
}

__device__ __forceinline__ void xcd_barrier(const XcdBarrier& b) {
    asm volatile("s_waitcnt vmcnt(0)" ::: "memory");
    __syncthreads();
    if (threadIdx.x == 0) {
        unsigned* bar = b.bar;
        __builtin_amdgcn_s_waitcnt(0);
        unsigned nloc = b.st[0], nx = b.st[1];
        if (nloc == 0u) { xcd_barrier_complete(bar, b.x, nloc, nx); b.st[0] = nloc; b.st[1] = nx; }
        const unsigned old = xb_add(&bar[XB_XSUB(b.x)], 1u);
        const unsigned gen = old / nloc;
        if (old + 1u == (gen + 1u) * nloc) {
            __builtin_amdgcn_fence(__ATOMIC_RELEASE, "agent");
            asm volatile("s_waitcnt vmcnt(0)" ::: "memory");
            const unsigned og = xb_add(&bar[XB_TOP], 1u);
            const unsigned tg = og / nx;
            if (og + 1u == (tg + 1u) * nx) xb_add(&bar[XB_TOPGEN], 1u);
            else XB_SPIN(xb_ld(&bar[XB_TOPGEN]) == tg, bar);
            __builtin_amdgcn_fence(__ATOMIC_ACQUIRE, "agent");
            xb_add(&bar[XB_XGEN(b.x)], 1u);
            asm volatile("s_waitcnt vmcnt(0)" ::: "memory");
        } else {
            XB_SPIN(xb_ld(&bar[XB_XGEN(b.x)]) == gen, bar);
            __builtin_amdgcn_fence(__ATOMIC_ACQUIRE, "agent");
            asm volatile("s_waitcnt vmcnt(0)" ::: "memory");
        }
    }
    __syncthreads();
}
template <class RowMap>
DEV void tr_tile(const float* __restrict__ src, int lds_, u16* __restrict__ dst, int ldd, int k0, int n0, RowMap rowmap, float* sm) {
    const int t = tidx();
    {
        const int n = t & 63, kk = t >> 6;
#pragma unroll
        for (int i = 0; i < 16; ++i) {
            const int k = kk + 4 * i;
            sm[k * 65 + n] = src[(size_t)(k0 + k) * lds_ + n0 + n];
        }
    }
    __syncthreads();
    {
        const int kp = t & 31, nn = t >> 5;
#pragma unroll
        for (int i = 0; i < 8; ++i) {
            const int n = nn + 8 * i;
            const unsigned v = pack2(sm[(2 * kp) * 65 + n], sm[(2 * kp + 1) * 65 + n]);
            *(unsigned*)(dst + (size_t)rowmap(n0 + n) * ldd + k0 + 2 * kp) = v;
        }
    }
    __syncthreads();
}

struct RmId { DEV int operator()(int n) const { return n; } };
struct RmWin { DEV int operator()(int n) const { return n < 3904 ? n : n + 64; } };
struct RmGate { DEV int operator()(int n) const { return (n >> 5) * 64 + (n & 31); } };
struct RmUp { DEV int operator()(int n) const { return (n >> 5) * 64 + 32 + (n & 31); } };

#define WT_WB_OFF (8064u * 1024u)
#define WT_WO_OFF (WT_WB_OFF + 4u * 1024u * 256u)
#define WT_TOTAL (WT_WO_OFF + 1024u * 1024u)

DEV void phase_conv_mixw(const P& p, int l, int bid, int nb, float* sm) {
    for (int u = bid; u < 2513; u += nb) {
        if (u < 2000) {
            const int kt = u / 125, nt = u % 125;
            tr_tile(p.w_in + (size_t)l * 1024 * 8000, 8000, p.Wt, 1024, kt * 64, nt * 64, RmWin(), sm);
        } else if (u < 2256) {
            const int v = u - 2000, i = v >> 6, w = v & 63, kt = w >> 4, nt = w & 15;
            tr_tile(p.w_branch + (size_t)(l * 4 + i) * 256 * 1024, 1024, p.Wt + WT_WB_OFF + (size_t)i * 1024 * 256, 256, kt * 64, nt * 64, RmId(), sm);
        } else if (u < 2512) {
            const int v = u - 2256, kt = v >> 4, nt = v & 15;
            tr_tile(p.w_out + (size_t)l * 1024 * 1024, 1024, p.Wt + WT_WO_OFF, 1024, kt * 64, nt * 64, RmId(), sm);
        } else {
            unsigned* z = (unsigned*)(p.Wt + (size_t)3904 * 1024);
            for (int i = tidx(); i < 64 * 1024 / 2; i += NTHR) z[i] = 0u;
        }
    }
}
DEV void phase_conv_moew(const P& p, int l, int bid, int nb, float* sm) {
    u16* wgu = p.cols + MOE_WGU_OFF;
    u16* wd = p.cols + MOE_WD_OFF;
    for (int u = bid; u < 16 * 384; u += nb) {
        const int e = u / 384, v = u % 384;
        const size_t le = (size_t)(l * 16 + e);
        if (v < 128) {
            const int kt = v >> 3, nt = v & 7;
            tr_tile(p.w_gate + le * 1024 * 512, 512, wgu + (size_t)e * 1024 * 1024, 1024, kt * 64, nt * 64, RmGate(), sm);
        } else if (v < 256) {
            const int w = v - 128, kt = w >> 3, nt = w & 7;
            tr_tile(p.w_up + le * 1024 * 512, 512, wgu + (size_t)e * 1024 * 1024, 1024, kt * 64, nt * 64, RmUp(), sm);
        } else {
            const int w = v - 256, kt = w >> 4, nt = w & 15;
            tr_tile(p.w_down + le * 512 * 1024, 1024, wd + (size_t)e * 1024 * 512, 512, kt * 64, nt * 64, RmId(), sm);
        }
    }
}

DEV void phase_mod_partial(const P& p, int bid, int nb, float* sm) {
    for (int u = bid; u < 768; u += nb) {
        const int l = u / 384, v = u % 384, kc = v / 24, jb = v % 24;
        const int t = tidx();
        __syncthreads();
        if (t < 192) {
            const int m = t >> 6, k = kc * 64 + (t & 63);
            const float cv = m < 2 ? p.c[m * 1024 + k] : p.c_ctx[k];
            sm[t] = silu(cv);
        }
        __syncthreads();
        const int j = jb * 256 + t;
        const float* w = p.w_mod + ((size_t)l * 1024 + kc * 64) * 6144 + j;
        float a0 = 0.f, a1 = 0.f, a2 = 0.f;
#pragma unroll 8
        for (int k = 0; k < 64; ++k) {
            const float wv = w[(size_t)k * 6144];
            a0 += sm[k] * wv; a1 += sm[64 + k] * wv; a2 += sm[128 + k] * wv;
        }
        float* o = p.modp + ((size_t)(l * 16 + kc) * 3) * 6144 + j;
        o[0] = a0; o[6144] = a1; o[2 * 6144] = a2;
    }
}
DEV void phase_mod_reduce(const P& p, int bid, int nb) {
    for (int i = bid * NTHR + tidx(); i < 2 * 3 * 6144; i += nb * NTHR) {
        const int l = i / (3 * 6144), r = i % (3 * 6144), m = r / 6144, j = r % 6144;
        float a = p.b_mod[l * 6144 + j];
        for (int kc = 0; kc < 16; ++kc) a += p.modp[((size_t)(l * 16 + kc) * 3 + m) * 6144 + j];
        p.mod[i] = a;
    }
}

DEV void moe_combine_row(const P& p, int l, int r, int lane, float4 (&v)[4]);
DEV void phase_norm1(const P& p, int l, int bid, int nb) {
    const int lane = tidx() & 63, w = tidx() >> 6;
    for (int r = bid * 4 + w; r < RTOT; r += nb * 4) {
        const float* xr = xrow_in(p, l, r);
        const int m = modidx(r);
        const float* sh = p.mod + ((size_t)(l * 3 + m)) * 6144;
        const float* sc = sh + 1024;
        float4 v[4]; float ss = 0.f;
#pragma unroll
        for (int i = 0; i < 4; ++i) v[i] = *(const float4*)(xr + lane * 4 + i * 256);
        if (l == 1) {
            moe_combine_row(p, 0, r, lane, v);
            float* xw = xrow_out(p, r);
#pragma unroll
            for (int i = 0; i < 4; ++i) *(float4*)(xw + lane * 4 + i * 256) = v[i];
        }
#pragma unroll
        for (int i = 0; i < 4; ++i) ss += v[i].x * v[i].x + v[i].y * v[i].y + v[i].z * v[i].z + v[i].w * v[i].w;
        ss = wsum(ss);
        const float rs = rsqrtf(ss * (1.f / 1024.f) + EPSF);
#pragma unroll
        for (int i = 0; i < 4; ++i) {
            const int c = lane * 4 + i * 256;
            const float4 g = *(const float4*)(p.norm_mix + l * 1024 + c);
            const float4 s1 = *(const float4*)(sc + c);
            const float4 h1 = *(const float4*)(sh + c);
            const float o0 = v[i].x * rs * g.x * (1.f + s1.x) + h1.x;
            const float o1 = v[i].y * rs * g.y * (1.f + s1.y) + h1.y;
            const float o2 = v[i].z * rs * g.z * (1.f + s1.z) + h1.z;
            const float o3 = v[i].w * rs * g.w * (1.f + s1.w) + h1.w;
            u32x2 pk; pk.x = pack2(o0, o1); pk.y = pack2(o2, o3);
            *(u32x2*)(p.hbuf + (size_t)r * 1024 + c) = pk;
        }
    }
}

#define LDP 72
#define GEMM_SMEM_BYTES (2 * 128 * LDP * 2)
DEV void gemm_mainloop(f32x4 (&acc)[4][4], const u16* const (&xp)[4], const u16* const (&wp)[4], int KT, u16* sX, u16* sW) {
    const int tid = tidx(), lane = tid & 63, w = tid >> 6, wn = w & 1, wm = w >> 1;
    const int fr = lane & 15, fq = lane >> 4;
    bf16x8 rx[4], rw[4];
#pragma unroll
    for (int i = 0; i < 4; ++i) { rx[i] = *(const bf16x8*)(xp[i]); rw[i] = *(const bf16x8*)(wp[i]); }
    const int so = (tid >> 3) * LDP + (tid & 7) * 8;
    for (int kt = 0; kt < KT; ++kt) {
#pragma unroll
        for (int i = 0; i < 4; ++i) {
            *(bf16x8*)(sX + so + i * 32 * LDP) = rx[i];
            *(bf16x8*)(sW + so + i * 32 * LDP) = rw[i];
        }
        __syncthreads();
        if (kt + 1 < KT) {
#pragma unroll
            for (int i = 0; i < 4; ++i) { rx[i] = *(const bf16x8*)(xp[i] + (kt + 1) * 64); rw[i] = *(const bf16x8*)(wp[i] + (kt + 1) * 64); }
        }
#pragma unroll
        for (int ks = 0; ks < 2; ++ks) {
            bf16x8 a[4], b[4];
#pragma unroll
            for (int q = 0; q < 4; ++q) {
                a[q] = *(const bf16x8*)(sW + (wn * 64 + q * 16 + fr) * LDP + ks * 32 + fq * 8);
                b[q] = *(const bf16x8*)(sX + (wm * 64 + q * 16 + fr) * LDP + ks * 32 + fq * 8);
            }
#pragma unroll
            for (int nt = 0; nt < 4; ++nt)
#pragma unroll
                for (int mt = 0; mt < 4; ++mt) acc[nt][mt] = mfma16(a[nt], b[mt], acc[nt][mt]);
        }
        __syncthreads();
    }
}
DEV void zero_acc(f32x4 (&acc)[4][4]) {
#pragma unroll
    for (int a = 0; a < 4; ++a)
#pragma unroll
        for (int b = 0; b < 4; ++b) acc[a][b] = f32x4{0.f, 0.f, 0.f, 0.f};
}

template <bool SIG>
DEV void phase_inproj(const P& p, int wrow0, int ntn, int ldc, int mtiles, int bid, int nb, u16* sm) {
    u16* sX = sm; u16* sW = sm + 128 * LDP;
    const int tid = tidx(), lane = tid & 63, w = tid >> 6, wn = w & 1, wm = w >> 1, fr = lane & 15, fq = lane >> 4;
    for (int u = bid; u < mtiles * ntn; u += nb) {
        const int mt_ = u / ntn, nt_ = u % ntn;
        const int m0 = mt_ * 128, n0 = nt_ * 128;
        const u16* xp[4]; const u16* wp[4];
#pragma unroll
        for (int i = 0; i < 4; ++i) {
            const int row = (tid >> 3) + 32 * i, kc = (tid & 7) * 8;
            xp[i] = p.hbuf + (size_t)(m0 + row) * 1024 + kc;
            wp[i] = p.Wt + (size_t)(wrow0 + n0 + row) * 1024 + kc;
        }
        f32x4 acc[4][4]; zero_acc(acc);
        gemm_mainloop(acc, xp, wp, 16, sX, sW);
#pragma unroll
        for (int nt = 0; nt < 4; ++nt)
#pragma unroll
            for (int mt = 0; mt < 4; ++mt) {
                const int n = n0 + wn * 64 + nt * 16 + fq * 4, m = m0 + wm * 64 + mt * 16 + fr;
                f32x4 v = acc[nt][mt];
                if (SIG) { v[0] = sigm(v[0]); v[1] = sigm(v[1]); v[2] = sigm(v[2]); v[3] = sigm(v[3]); }
                u32x2 pk; pk.x = pack2(v[0], v[1]); pk.y = pack2(v[2], v[3]);
                *(u32x2*)(p.cols + (size_t)m * ldc + n) = pk;
            }
    }
}

DEV void phase_merge1(const P& p, u16* ubuf, int mtiles, int bid, int nb, u16* sm) {
    u16* sX = sm; u16* sW = sm + 128 * LDP;
    const int tid = tidx(), lane = tid & 63, w = tid >> 6, wn = w & 1, wm = w >> 1, fr = lane & 15, fq = lane >> 4;
    for (int u = bid; u < mtiles * 8; u += nb) {
        const int mt_ = u >> 3, nt_ = u & 7;
        const int m0 = mt_ * 128, n0 = nt_ * 128;
        f32x4 tot[4][4]; zero_acc(tot);
        for (int br = 0; br < 4; ++br) {
            const u16* xp[4]; const u16* wp[4];
#pragma unroll
            for (int i = 0; i < 4; ++i) {
                const int row = (tid >> 3) + 32 * i, kc = (tid & 7) * 8;
                xp[i] = p.ybuf + (size_t)(m0 + row) * 1024 + br * 256 + kc;
                wp[i] = p.Wt + WT_WB_OFF + ((size_t)br * 1024 + n0 + row) * 256 + kc;
            }
            f32x4 acc[4][4]; zero_acc(acc);
            gemm_mainloop(acc, xp, wp, 4, sX, sW);
#pragma unroll
            for (int nt = 0; nt < 4; ++nt)
#pragma unroll
                for (int mt = 0; mt < 4; ++mt) {
                    const int n = n0 + wn * 64 + nt * 16 + fq * 4, m = m0 + wm * 64 + mt * 16 + fr;
                    const u32x2 g = *(const u32x2*)(p.cols + (size_t)m * NGATE + br * 1024 + n);
                    tot[nt][mt][0] += bf2f((u16)(g.x & 0xffff)) * acc[nt][mt][0];
                    tot[nt][mt][1] += bf2f((u16)(g.x >> 16)) * acc[nt][mt][1];
                    tot[nt][mt][2] += bf2f((u16)(g.y & 0xffff)) * acc[nt][mt][2];
                    tot[nt][mt][3] += bf2f((u16)(g.y >> 16)) * acc[nt][mt][3];
                }
        }
#pragma unroll
        for (int nt = 0; nt < 4; ++nt)
#pragma unroll
            for (int mt = 0; mt < 4; ++mt) {
                const int n = n0 + wn * 64 + nt * 16 + fq * 4, m = m0 + wm * 64 + mt * 16 + fr;
                u32x2 pk; pk.x = pack2(tot[nt][mt][0], tot[nt][mt][1]); pk.y = pack2(tot[nt][mt][2], tot[nt][mt][3]);
                *(u32x2*)(ubuf + (size_t)m * 1024 + n) = pk;
            }
    }
}

DEV void phase_merge2(const P& p, int l, const u16* ubuf, int mtiles, int bid, int nb, u16* sm) {
    u16* sX = sm; u16* sW = sm + 128 * LDP;
    const int tid = tidx(), lane = tid & 63, w = tid >> 6, wn = w & 1, wm = w >> 1, fr = lane & 15, fq = lane >> 4;
    for (int u = bid; u < mtiles * 8; u += nb) {
        const int mt_ = u >> 3, nt_ = u & 7;
        const int m0 = mt_ * 128, n0 = nt_ * 128;
        const u16* xp[4]; const u16* wp[4];
#pragma unroll
        for (int i = 0; i < 4; ++i) {
            const int row = (tid >> 3) + 32 * i, kc = (tid & 7) * 8;
            xp[i] = ubuf + (size_t)(m0 + row) * 1024 + kc;
            wp[i] = p.Wt + WT_WO_OFF + (size_t)(n0 + row) * 1024 + kc;
        }
        f32x4 acc[4][4]; zero_acc(acc);
        gemm_mainloop(acc, xp, wp, 16, sX, sW);
#pragma unroll
        for (int nt = 0; nt < 4; ++nt)
#pragma unroll
            for (int mt = 0; mt < 4; ++mt) {
                const int n = n0 + wn * 64 + nt * 16 + fq * 4, m = m0 + wm * 64 + mt * 16 + fr;
                const float4 xo = *(const float4*)(xrow_in(p, l, m) + n);
                const float4 g = *(const float4*)(p.mod + (size_t)(l * 3 + modidx(m)) * 6144 + 2048 + n);
                float4 o;
                o.x = xo.x + g.x * acc[nt][mt][0]; o.y = xo.y + g.y * acc[nt][mt][1];
                o.z = xo.z + g.z * acc[nt][mt][2]; o.w = xo.w + g.w * acc[nt][mt][3];
                *(float4*)(xrow_out(p, m) + n) = o;
            }
    }
}
DEV void phase_norm2_router(const P& p, int l, int nrows, int bid, int nb, float* sm) {
    const int tid = tidx(), lane = tid & 63, w = tid >> 6;
    int* list = (int*)(p.cols + MOE_LIST_OFF);
    float* slotw = (float*)(list + 16 * RTOT);
    int* tokslot = (int*)(slotw + 16 * RTOT);
    float* tokw = (float*)(tokslot + 2 * RTOT);
    int* lcnt = (int*)(sm + 16 * 1024);
    int* rinfo = lcnt + 32;
    float* rwgt = (float*)(rinfo + 4 * 40 * 2);
    for (int i = tid; i < 16 * 1024; i += NTHR) { const int c = i >> 4, e = i & 15; sm[e * 1024 + c] = p.router_w[i]; }
    if (tid < 32) lcnt[tid] = 0;
    __syncthreads();
    int kk = 0;
    for (int r = bid * 4 + w; r < nrows; r += nb * 4, ++kk) {
        const float* xr = xrow_out(p, r);
        const int m = modidx(r);
        const float* sh = p.mod + ((size_t)(l * 3 + m)) * 6144 + 3072;
        const float* sc = sh + 1024;
        float4 v[4]; float ss = 0.f;
#pragma unroll
        for (int i = 0; i < 4; ++i) {
            v[i] = *(const float4*)(xr + lane * 4 + i * 256);
            ss += v[i].x * v[i].x + v[i].y * v[i].y + v[i].z * v[i].z + v[i].w * v[i].w;
        }
        ss = wsum(ss);
        const float rs = rsqrtf(ss * (1.f / 1024.f) + EPSF);
#pragma unroll
        for (int i = 0; i < 4; ++i) {
            const int c = lane * 4 + i * 256;
            const float4 g = *(const float4*)(p.norm_ffn + l * 1024 + c);
            const float4 s1 = *(const float4*)(sc + c);
            const float4 h1 = *(const float4*)(sh + c);
            v[i].x = v[i].x * rs * g.x * (1.f + s1.x) + h1.x;
            v[i].y = v[i].y * rs * g.y * (1.f + s1.y) + h1.y;
            v[i].z = v[i].z * rs * g.z * (1.f + s1.z) + h1.z;
            v[i].w = v[i].w * rs * g.w * (1.f + s1.w) + h1.w;
            u32x2 pk; pk.x = pack2(v[i].x, v[i].y); pk.y = pack2(v[i].z, v[i].w);
            *(u32x2*)(p.hbuf + (size_t)r * 1024 + c) = pk;
        }
        float sel[16], scr[16];
#pragma unroll
        for (int e = 0; e < 16; ++e) scr[e] = 0.f;
#pragma unroll
        for (int i = 0; i < 4; ++i) {
#pragma unroll
            for (int e = 0; e < 16; ++e) {
                const float4 rw = *(const float4*)(sm + e * 1024 + lane * 4 + i * 256);
                scr[e] += v[i].x * rw.x + v[i].y * rw.y + v[i].z * rw.z + v[i].w * rw.w;
            }
            __builtin_amdgcn_sched_barrier(0);
        }
#pragma unroll
        for (int e = 0; e < 16; ++e) {
            const float a = wsum(scr[e]);
            scr[e] = sigm(a);
            sel[e] = scr[e] + p.router_b[e];
        }
        int bg = 0; float bgs = -INFINITY;
#pragma unroll
        for (int g = 0; g < 4; ++g) {
            float m1 = -INFINITY, m2 = -INFINITY;
#pragma unroll
            for (int j = 0; j < 4; ++j) {
                const float s = sel[g * 4 + j];
                if (s > m1) { m2 = m1; m1 = s; } else if (s > m2) { m2 = s; }
            }
            const float gs = m1 + m2;
            if (gs > bgs) { bgs = gs; bg = g; }
        }
        float gsel[4], gscr[4];
#pragma unroll
        for (int j = 0; j < 4; ++j) { gsel[j] = -INFINITY; gscr[j] = 0.f; }
#pragma unroll
        for (int g = 0; g < 4; ++g)
#pragma unroll
            for (int j = 0; j < 4; ++j) if (bg == g) { gsel[j] = sel[g * 4 + j]; gscr[j] = scr[g * 4 + j]; }
        int j1 = 0; float v1 = gsel[0], w1 = gscr[0];
#pragma unroll
        for (int j = 1; j < 4; ++j) if (gsel[j] > v1) { v1 = gsel[j]; w1 = gscr[j]; j1 = j; }
        int j2 = -1; float v2 = -INFINITY, w2 = 0.f;
#pragma unroll
        for (int j = 0; j < 4; ++j) if (j != j1 && (j2 < 0 || gsel[j] > v2)) { v2 = gsel[j]; w2 = gscr[j]; j2 = j; }
        const float inv = 1.f / (w1 + w2);
        if (lane == 0) {
            const int e1 = bg * 4 + j1, e2 = bg * 4 + j2;
            const int p1 = atomicAdd(lcnt + e1, 1);
            const int p2 = atomicAdd(lcnt + e2, 1);
            rinfo[(w * 40 + kk) * 2 + 0] = e1 * 65536 + p1; rwgt[(w * 40 + kk) * 2 + 0] = w1 * inv;
            rinfo[(w * 40 + kk) * 2 + 1] = e2 * 65536 + p2; rwgt[(w * 40 + kk) * 2 + 1] = w2 * inv;
        }
    }
    __syncthreads();
    if (tid < 16) lcnt[16 + tid] = lcnt[tid] ? atomicAdd(p.cnt + l * 16 + tid, lcnt[tid]) : 0;
    __syncthreads();
    if (lane < 2) {
        int k2 = 0;
        for (int r = bid * 4 + w; r < nrows; r += nb * 4, ++k2) {
            const int inf = rinfo[(w * 40 + k2) * 2 + lane], e = inf >> 16, slot = lcnt[16 + e] + (inf & 65535);
            const float wg = rwgt[(w * 40 + k2) * 2 + lane];
            list[e * RTOT + slot] = r; slotw[e * RTOT + slot] = wg;
            tokslot[r * 2 + lane] = e * RTOT + slot; tokw[r * 2 + lane] = wg;
        }
    }
    __syncthreads();
}

DEV bool moe_find(const int* cnt, int ut, int& e, int& mt, int& off, int& ce) {
    int tb = 0, o = 0;
    for (int k = 0; k < 16; ++k) {
        const int c = cnt[k], nt = (c + 127) >> 7;
        if (ut < tb + nt) { e = k; mt = ut - tb; off = o; ce = c; return true; }
        tb += nt; o += c;
    }
    return false;
}

DEV void phase_moe_up(const P& p, int l, int bid, int nb, u16* sm) {
    u16* sX = sm; u16* sW = sm + 128 * LDP;
    const int tid = tidx(), lane = tid & 63, w = tid >> 6, wn = w & 1, wm = w >> 1, fr = lane & 15, fq = lane >> 4;
    const int* cnt = p.cnt + l * 16;
    const int* list = (const int*)(p.cols + MOE_LIST_OFF);
    const u16* wgu = p.cols + MOE_WGU_OFF;
    u16* act = p.cols + MOE_ACT_OFF;
    for (int u = bid;; u += nb) {
        int e, mtile, off, ce;
        if (!moe_find(cnt, u >> 3, e, mtile, off, ce)) break;
        const int n0 = (u & 7) * 128;
        const u16* xp[4]; const u16* wp[4];
#pragma unroll
        for (int i = 0; i < 4; ++i) {
            const int row = (tid >> 3) + 32 * i, kc = (tid & 7) * 8;
            int s = mtile * 128 + row; s = s < ce ? s : ce - 1;
            const int tok = list[e * RTOT + s];
            xp[i] = p.hbuf + (size_t)tok * 1024 + kc;
            wp[i] = wgu + ((size_t)e * 1024 + n0 + row) * 1024 + kc;
        }
        f32x4 acc[4][4]; zero_acc(acc);
        gemm_mainloop(acc, xp, wp, 16, sX, sW);
#pragma unroll
        for (int nt = 0; nt < 2; ++nt)
#pragma unroll
            for (int mt = 0; mt < 4; ++mt) {
                const int col = ((n0 >> 6) + wn) * 32 + nt * 16 + fq * 4;
                const int s = mtile * 128 + wm * 64 + mt * 16 + fr;
                if (s < ce) {
                    const f32x4 g = acc[nt][mt], uu = acc[nt + 2][mt];
                    u32x2 pk; pk.x = pack2(silu(g[0]) * uu[0], silu(g[1]) * uu[1]); pk.y = pack2(silu(g[2]) * uu[2], silu(g[3]) * uu[3]);
                    *(u32x2*)(act + (size_t)(off + s) * 512 + col) = pk;
                }
            }
    }
}

DEV void phase_moe_down(const P& p, int l, int bid, int nb, u16* sm) {
    u16* sX = sm; u16* sW = sm + 128 * LDP;
    const int tid = tidx(), lane = tid & 63, w = tid >> 6, wn = w & 1, wm = w >> 1, fr = lane & 15, fq = lane >> 4;
    const int* cnt = p.cnt + l * 16;
    const int* list = (const int*)(p.cols + MOE_LIST_OFF);
    u16* yslot = p.glaS;
    const u16* wd = p.cols + MOE_WD_OFF;
    const u16* act = p.cols + MOE_ACT_OFF;
    for (int u = bid;; u += nb) {
        int e, mtile, off, ce;
        if (!moe_find(cnt, u >> 3, e, mtile, off, ce)) break;
        const int n0 = (u & 7) * 128;
        const u16* xp[4]; const u16* wp[4];
#pragma unroll
        for (int i = 0; i < 4; ++i) {
            const int row = (tid >> 3) + 32 * i, kc = (tid & 7) * 8;
            int s = mtile * 128 + row; s = s < ce ? s : ce - 1;
            xp[i] = act + (size_t)(off + s) * 512 + kc;
            wp[i] = wd + ((size_t)e * 1024 + n0 + row) * 512 + kc;
        }
        f32x4 acc[4][4]; zero_acc(acc);
        gemm_mainloop(acc, xp, wp, 8, sX, sW);
#pragma unroll
        for (int mt = 0; mt < 4; ++mt) {
            const int s = mtile * 128 + wm * 64 + mt * 16 + fr;
            if (s < ce) {
#pragma unroll
                for (int nt = 0; nt < 4; ++nt) {
                    const int n = n0 + wn * 64 + nt * 16 + fq * 4;
                    u32x2 pk; pk.x = pack2(acc[nt][mt][0], acc[nt][mt][1]); pk.y = pack2(acc[nt][mt][2], acc[nt][mt][3]);
                    *(u32x2*)(yslot + (size_t)(off + s) * 1024 + n) = pk;
                }
            }
        }
    }
}

DEV void moe_combine_row(const P& p, int l, int r, int lane, float4 (&v)[4]) {
    const int* cnt = p.cnt + l * 16;
    const int* list = (const int*)(p.cols + MOE_LIST_OFF);
    const int* tokslot = (const int*)((const float*)(list + 16 * RTOT) + 16 * RTOT);
    const float* tokw = (const float*)(tokslot + 2 * RTOT);
    const u16* yslot = p.glaS;
    const float* g2 = p.mod + (size_t)(l * 3 + modidx(r)) * 6144 + 5120;
#pragma unroll
    for (int j = 0; j < 2; ++j) {
        const int ts = tokslot[r * 2 + j], e = ts / RTOT, slot = ts % RTOT;
        const float wg = tokw[r * 2 + j];
        int off = 0;
        for (int k = 0; k < e; ++k) off += cnt[k];
        const u16* yr = yslot + (size_t)(off + slot) * 1024;
#pragma unroll
        for (int i = 0; i < 4; ++i) {
            const int c = lane * 4 + i * 256;
            const u32x2 yv = *(const u32x2*)(yr + c);
            const float4 g = *(const float4*)(g2 + c);
            v[i].x += g.x * wg * __uint_as_float(yv.x << 16); v[i].y += g.y * wg * __uint_as_float(yv.x & 0xffff0000u);
            v[i].z += g.z * wg * __uint_as_float(yv.y << 16); v[i].w += g.w * wg * __uint_as_float(yv.y & 0xffff0000u);
        }
    }
}

DEV void phase_final_norm(const P& p, int bid, int nb) {
    const int lane = tidx() & 63, w = tidx() >> 6;
    for (int r = bid * 4 + w; r < RLAT; r += nb * 4) {
        float* xr = p.out + (size_t)r * DM;
        float4 v[4]; float ss = 0.f;
#pragma unroll
        for (int i = 0; i < 4; ++i) v[i] = *(const float4*)(xr + lane * 4 + i * 256);
        moe_combine_row(p, 1, r, lane, v);
#pragma unroll
        for (int i = 0; i < 4; ++i) ss += v[i].x * v[i].x + v[i].y * v[i].y + v[i].z * v[i].z + v[i].w * v[i].w;
        ss = wsum(ss);
        const float rs = rsqrtf(ss * (1.f / 1024.f) + EPSF);
#pragma unroll
        for (int i = 0; i < 4; ++i) {
            const int c = lane * 4 + i * 256;
            const float4 g = *(const float4*)(p.norm_final + c);
            float4 o; o.x = v[i].x * rs * g.x; o.y = v[i].y * rs * g.y; o.z = v[i].z * rs * g.z; o.w = v[i].w * rs * g.w;
            *(float4*)(xr + c) = o;
        }
    }
}
DEV float wscan_add(float v, int lane) {
#pragma unroll
    for (int o = 1; o < 64; o <<= 1) { const float t = __shfl_up(v, o, 64); if (lane >= o) v += t; }
    return v;
}
DEV float wscan_max(float v, int lane) {
#pragma unroll
    for (int o = 1; o < 64; o <<= 1) { const float t = __shfl_up(v, o, 64); if (lane >= o) v = fmaxf(v, t); }
    return v;
}
DEV void mm64(f32x4 (&acc)[4], const u16* A, int lda, const u16* Bt, int ldb) {
    const int lane = tidx() & 63, w = tidx() >> 6, fr = lane & 15, fq = lane >> 4;
#pragma unroll
    for (int ks = 0; ks < 2; ++ks) {
        const bf16x8 a = *(const bf16x8*)(A + (16 * w + fr) * lda + ks * 32 + fq * 8);
#pragma unroll
        for (int nt = 0; nt < 4; ++nt) {
            const bf16x8 b = *(const bf16x8*)(Bt + (nt * 16 + fr) * ldb + ks * 32 + fq * 8);
            acc[nt] = mfma16(a, b, acc[nt]);
        }
    }
}
DEV void zero4(f32x4 (&acc)[4]) {
#pragma unroll
    for (int i = 0; i < 4; ++i) acc[i] = f32x4{0.f, 0.f, 0.f, 0.f};
}
DEV void ld16bf(const u16* p, float (&o)[16]) {
    const u32x4 a = *(const u32x4*)p, b = *(const u32x4*)(p + 8);
    const unsigned w[8] = {a.x, a.y, a.z, a.w, b.x, b.y, b.z, b.w};
#pragma unroll
    for (int i = 0; i < 8; ++i) { o[2 * i] = __uint_as_float(w[i] << 16); o[2 * i + 1] = __uint_as_float(w[i] & 0xffff0000u); }
}
DEV void st16bf(u16* p, const float (&v)[16]) {
    u32x4 a, b;
    a.x = pack2(v[0], v[1]); a.y = pack2(v[2], v[3]); a.z = pack2(v[4], v[5]); a.w = pack2(v[6], v[7]);
    b.x = pack2(v[8], v[9]); b.y = pack2(v[10], v[11]); b.z = pack2(v[12], v[13]); b.w = pack2(v[14], v[15]);
    *(u32x4*)p = a; *(u32x4*)(p + 8) = b;
}

DEV void phase_rope_table(const P& p, int bid, int nb) {
    for (int i = bid * NTHR + tidx(); i < 192 * 8; i += nb * NTHR) {
        const int e = i >> 3, f = i & 7;
        const float inv = expf(-(float)(2 * f) * (1.f / 16.f) * 9.210340371976184f);
        const float pos = (float)(e < 128 ? e : e - 128);
        const float ang = pos * inv;
        p.rope[2 * i] = cosf(ang); p.rope[2 * i + 1] = sinf(ang);
    }
}
DEV void phase_prep(const P& p, int l, u16* gqkv, int bid, int nb, u16* sm) {
    const int tid = tidx();
    for (int g = bid; g < 264; g += nb) {
        int b, t0, r0, T, pos0;
        if (g < 256) { b = g >> 7; t0 = (g & 127) * 64; r0 = b * SEQ + t0; T = SEQ; pos0 = CTXL + t0; }
        else { const int q = g - 256; b = q >> 2; t0 = (q & 3) * 64; r0 = RLAT + b * CTXL + t0; T = CTXL; pos0 = t0; }
        for (int k = 0; k < 24; ++k) {
            const int id = tid + 256 * k, cg = id % 96, s = id / 96, r = r0 + s, t = t0 + s;
            float a[8];
#pragma unroll
            for (int i = 0; i < 8; ++i) a[i] = 0.f;
#pragma unroll
            for (int j = 0; j < 5; ++j) {
                const int tt = t + j - 2;
                if (tt >= 0 && tt < T) {
                    const u32x4 xv = *(const u32x4*)(p.cols + (size_t)(r + j - 2) * NCM + GD_Q + cg * 8);
                    const float4 w0 = *(const float4*)(p.gdn_conv + (l * 5 + j) * 768 + cg * 8);
                    const float4 w1 = *(const float4*)(p.gdn_conv + (l * 5 + j) * 768 + cg * 8 + 4);
                    a[0] += __uint_as_float(xv.x << 16) * w0.x; a[1] += __uint_as_float(xv.x & 0xffff0000u) * w0.y;
                    a[2] += __uint_as_float(xv.y << 16) * w0.z; a[3] += __uint_as_float(xv.y & 0xffff0000u) * w0.w;
                    a[4] += __uint_as_float(xv.z << 16) * w1.x; a[5] += __uint_as_float(xv.z & 0xffff0000u) * w1.y;
                    a[6] += __uint_as_float(xv.w << 16) * w1.z; a[7] += __uint_as_float(xv.w & 0xffff0000u) * w1.w;
                }
            }
            float ss = 0.f;
#pragma unroll
            for (int i = 0; i < 8; ++i) { a[i] = silu(a[i]); ss += a[i] * a[i]; }
            ss += __shfl_xor(ss, 1, 64); ss += __shfl_xor(ss, 2, 64); ss += __shfl_xor(ss, 4, 64);
            float sc = 1.f;
            if (cg < 64) sc = rsqrtf(ss + EPSF) * (cg < 32 ? 0.125f : 1.f);
            u32x4 o;
            o.x = pack2(a[0] * sc, a[1] * sc); o.y = pack2(a[2] * sc, a[3] * sc); o.z = pack2(a[4] * sc, a[5] * sc); o.w = pack2(a[6] * sc, a[7] * sc);
            *(u32x4*)(gqkv + (size_t)r * 768 + cg * 8) = o;
        }
        for (int k = 0; k < 8; ++k) {
            const int id = tid + 256 * k, c = id & 1, half = (id >> 1) & 1, h = (id >> 2) & 3, qk = (id >> 4) & 1, s = id >> 5;
            const int r = r0 + s, t = t0 + s;
            const u16* src = p.cols + (size_t)r * NCM + (qk ? DF_K : DF_Q) + h * 64 + half * 32 + c * 8;
            const u32x4 v1 = *(const u32x4*)src, v2 = *(const u32x4*)(src + 16);
            const unsigned w1[4] = {v1.x, v1.y, v1.z, v1.w}, w2[4] = {v2.x, v2.y, v2.z, v2.w};
            float x1[8], x2[8], o1[8], o2[8];
#pragma unroll
            for (int i = 0; i < 4; ++i) {
                x1[2 * i] = __uint_as_float(w1[i] << 16); x1[2 * i + 1] = __uint_as_float(w1[i] & 0xffff0000u);
                x2[2 * i] = __uint_as_float(w2[i] << 16); x2[2 * i + 1] = __uint_as_float(w2[i] & 0xffff0000u);
            }
            const float qs = qk ? 1.f : (0.17677669529663687f * 1.4426950408889634f);
            if (g < 256) {
                const float* tb = p.rope + (size_t)(c == 0 ? (t >> 6) : 128 + (t & 63)) * 16;
#pragma unroll
                for (int i = 0; i < 8; ++i) {
                    const float cs = tb[2 * i], sn = tb[2 * i + 1];
                    o1[i] = (x1[i] * cs - x2[i] * sn) * qs; o2[i] = (x1[i] * sn + x2[i] * cs) * qs;
                }
            } else {
#pragma unroll
                for (int i = 0; i < 8; ++i) { o1[i] = x1[i] * qs; o2[i] = x2[i] * qs; }
            }
            u16* dst = (qk ? p.dk : p.dq) + ((size_t)(b * 4 + h) * KPOS + pos0 + s) * 64 + half * 32 + c * 8;
            u32x4 a1, a2;
            a1.x = pack2(o1[0], o1[1]); a1.y = pack2(o1[2], o1[3]); a1.z = pack2(o1[4], o1[5]); a1.w = pack2(o1[6], o1[7]);
            a2.x = pack2(o2[0], o2[1]); a2.y = pack2(o2[2], o2[3]); a2.z = pack2(o2[4], o2[5]); a2.w = pack2(o2[6], o2[7]);
            *(u32x4*)dst = a1; *(u32x4*)(dst + 16) = a2;
        }
        for (int h = 0; h < 4; ++h) {
            __syncthreads();
            {
                const int s = tid >> 2, dg = tid & 3;
                const u32x4 a = *(const u32x4*)(p.cols + (size_t)(r0 + s) * NCM + DF_V + h * 64 + dg * 16);
                const u32x4 c = *(const u32x4*)(p.cols + (size_t)(r0 + s) * NCM + DF_V + h * 64 + dg * 16 + 8);
                const unsigned wv[8] = {a.x, a.y, a.z, a.w, c.x, c.y, c.z, c.w};
#pragma unroll
                for (int k = 0; k < 8; ++k) {
                    sm[(dg * 16 + 2 * k) * 72 + s] = (u16)(wv[k] & 0xffff);
                    sm[(dg * 16 + 2 * k + 1) * 72 + s] = (u16)(wv[k] >> 16);
                }
            }
            __syncthreads();
            {
                const int dv = tid >> 2, sg = tid & 3;
                const u32x4 a = *(const u32x4*)(sm + dv * 72 + sg * 16);
                const u32x4 c = *(const u32x4*)(sm + dv * 72 + sg * 16 + 8);
                u16* o = p.dvT + ((size_t)(b * 4 + h) * 64 + dv) * KPOS + pos0 + sg * 16;
                *(u32x4*)o = a; *(u32x4*)(o + 8) = c;
            }
        }
        __syncthreads();
    }
}
#define TILE_B (64 * LDP * 2)

DEV void gla_cum(const P& p, int l, int dir, int h, int row0, float* cum, float* rt, float* sg) {
    const int tid = tidx();
    {
        const int s = tid >> 2, q4 = tid & 3, row = row0 + (dir ? 63 - s : s);
        const u32x2 v = *(const u32x2*)(p.cols + (size_t)row * NCM + GLA_RF + dir * 16 + q4 * 4);
        rt[s * 17 + q4 * 4 + 0] = __uint_as_float(v.x << 16); rt[s * 17 + q4 * 4 + 1] = __uint_as_float(v.x & 0xffff0000u);
        rt[s * 17 + q4 * 4 + 2] = __uint_as_float(v.y << 16); rt[s * 17 + q4 * 4 + 3] = __uint_as_float(v.y & 0xffff0000u);
    }
    __syncthreads();
    const int d = tid & 63, sq = tid >> 6;
    float a2r[16];
#pragma unroll
    for (int j = 0; j < 16; ++j) a2r[j] = p.gla_a2[((size_t)(l * 2 + dir) * 16 + j) * 256 + h * 64 + d];
    const float ab = p.gla_ab[(l * 2 + dir) * 256 + h * 64 + d];
    float loc[16]; float run = 0.f;
#pragma unroll
    for (int i = 0; i < 16; ++i) {
        const int s = sq * 16 + i;
        float x = ab;
#pragma unroll
        for (int j = 0; j < 16; ++j) x += rt[s * 17 + j] * a2r[j];
        run += logsig(x) * (1.f / 16.f);
        loc[i] = run;
    }
    sg[sq * 64 + d] = run;
    __syncthreads();
    float off = 0.f;
    for (int k = 0; k < sq; ++k) off += sg[k * 64 + d];
#pragma unroll
    for (int i = 0; i < 16; ++i) cum[(sq * 16 + i) * 65 + d] = loc[i] + off;
    __syncthreads();
}

DEV void gla_phaseA(const P& p, int l, int dir, int b, int st, int h, unsigned char* smraw) {
    float* cum = (float*)smraw;
    float* rt = cum + 64 * 65;
    float* sg = rt + 64 * 17;
    u16* kwT = (u16*)(sg + 256);
    u16* vT = kwT + 64 * LDP;
    const int tid = tidx(), lane = tid & 63, w = tid >> 6, fr = lane & 15, fq = lane >> 4;
    const int row0 = chunk_row0(b, dir, st);
    const size_t idx = state_idx(dir, b, st, h);
    gla_cum(p, l, dir, h, row0, cum, rt, sg);
    {
        const int s = tid >> 2, dg = tid & 3, row = row0 + (dir ? 63 - s : s);
        float kk[16], vv[16];
        ld16bf(p.cols + (size_t)row * NCM + GLA_K + h * 64 + dg * 16, kk);
        ld16bf(p.cols + (size_t)row * NCM + GLA_V + h * 64 + dg * 16, vv);
#pragma unroll
        for (int i = 0; i < 16; ++i) {
            const int d = dg * 16 + i;
            kwT[d * LDP + s] = f2bf(kk[i] * __expf(cum[63 * 65 + d] - cum[s * 65 + d]));
            vT[d * LDP + s] = f2bf(vv[i]);
        }
        if (tid < 64) p.glaDec[idx * 64 + tid] = __expf(cum[63 * 65 + tid]);
    }
    __syncthreads();
    f32x4 acc[4]; zero4(acc);
    mm64(acc, kwT, LDP, vT, LDP);
#pragma unroll
    for (int nt = 0; nt < 4; ++nt) {
        const int d = 16 * w + fq * 4, e = nt * 16 + fr;
        u32x2 pk; pk.x = pack2(acc[nt][0], acc[nt][1]); pk.y = pack2(acc[nt][2], acc[nt][3]);
        *(u32x2*)(p.glaS + idx * 4096 + e * 64 + d) = pk;
    }
    __syncthreads();
}

DEV void ml_phaseA(const P& p, int l, int dir, int b, int st, int h, unsigned char* smraw) {
    float* wend = (float*)smraw;
    u16* kwT = (u16*)(wend + 64);
    u16* vT = kwT + 64 * LDP;
    const int tid = tidx(), lane = tid & 63, w = tid >> 6, fr = lane & 15, fq = lane >> 4;
    const int row0 = chunk_row0(b, dir, st);
    const size_t idx = state_idx(dir, b, st, h);
    if (w == 0) {
        const int row = row0 + (dir ? 63 - lane : lane);
        const float ip = bf2f(p.cols[(size_t)row * NCM + ML_GF + dir * 8 + h]) + p.mlstm_gate_b[((l * 2 + dir) * 2 + 0) * 4 + h];
        const float lf = logsig(bf2f(p.cols[(size_t)row * NCM + ML_GF + dir * 8 + 4 + h]) + p.mlstm_gate_b[((l * 2 + dir) * 2 + 1) * 4 + h]);
        const float fc = wscan_add(lf, lane);
        const float fe = __shfl(fc, 63, 64);
        const float lw = fe - fc + ip;
        const float ae = wmaxr(lw);
        wend[lane] = __expf(lw - ae);
        if (lane == 0) { p.mlFE[idx] = fe; p.mlAE[idx] = ae; }
    }
    __syncthreads();
    {
        const int s = tid >> 2, dg = tid & 3, row = row0 + (dir ? 63 - s : s);
        float kk[16], vv[16];
        ld16bf(p.cols + (size_t)row * NCM + ML_K + h * 64 + dg * 16, kk);
        ld16bf(p.cols + (size_t)row * NCM + ML_V + h * 64 + dg * 16, vv);
        const float ws = wend[s] * 0.125f;
#pragma unroll
        for (int i = 0; i < 16; ++i) {
            const int d = dg * 16 + i;
            kwT[d * LDP + s] = f2bf(kk[i] * ws);
            vT[d * LDP + s] = f2bf(vv[i]);
        }
    }
    __syncthreads();
    if (tid < 64) {
        float a = 0.f;
        for (int s = 0; s < 64; ++s) a += bf2f(kwT[tid * LDP + s]);
        p.mlN[idx * 64 + tid] = a;
    }
    f32x4 acc[4]; zero4(acc);
    mm64(acc, kwT, LDP, vT, LDP);
#pragma unroll
    for (int nt = 0; nt < 4; ++nt) {
        const int d = 16 * w + fq * 4, e = nt * 16 + fr;
        u32x2 pk; pk.x = pack2(acc[nt][0], acc[nt][1]); pk.y = pack2(acc[nt][2], acc[nt][3]);
        *(u32x2*)(p.mlS + idx * 4096 + e * 64 + d) = pk;
    }
    __syncthreads();
}

DEV void gd_phaseA(const P& p, int l, const u16* gqkv, int dir, int b, int st, int h, unsigned char* smraw) {
    float* X = (float*)smraw;
    float* cum = X + 64 * 65 + 32;
    float* beta = cum + 64;
    float* be = beta + 64;
    float* ke = be + 64;
    float* scal = ke + 64;
    u16* Y0 = (u16*)(scal + 64);
    u16* Y1 = Y0 + 64 * LDP;
    u16* Y2 = Y1 + 64 * LDP;
    u16* Y3 = Y2 + 64 * LDP;
    u16* Y4 = Y3 + 64 * LDP;
    u16* Y5 = Y4 + 64 * LDP;
    u16* wT = (u16*)X;
    const int tid = tidx(), lane = tid & 63, w = tid >> 6, fr = lane & 15, fq = lane >> 4;
    const int row0 = chunk_row0(b, dir, st);
    const size_t idx = state_idx(dir, b, st, h);
    if (w == 0) {
        const int row = row0 + (dir ? 63 - lane : lane);
        const float bp = bf2f(p.cols[(size_t)row * NCM + GD_GF + dir * 8 + h]);
        const float ap = bf2f(p.cols[(size_t)row * NCM + GD_GF + dir * 8 + 4 + h]);
        const float bt = sigm(bp);
        const float g = -__expf(p.gdn_a_log[(l * 2 + dir) * 4 + h]) * softplus(ap + p.gdn_dt_bias[(l * 2 + dir) * 4 + h]);
        const float cm = wscan_add(g, lane);
        const float ce = __shfl(cm, 63, 64);
        cum[lane] = cm; beta[lane] = bt; be[lane] = bt * __expf(cm); ke[lane] = __expf(ce - cm);
        if (lane == 0) scal[0] = __expf(ce);
    }
    {
        const int s = tid >> 2, dg = tid & 3, row = row0 + (dir ? 63 - s : s);
        const u16* src = gqkv + (size_t)row * 768 + h * 64 + dg * 16;
        const u32x4 q0 = *(const u32x4*)src, q1 = *(const u32x4*)(src + 8);
        const u32x4 k0 = *(const u32x4*)(src + 256), k1 = *(const u32x4*)(src + 264);
        const u32x4 v0 = *(const u32x4*)(src + 512), v1 = *(const u32x4*)(src + 520);
        *(u32x4*)(Y0 + s * LDP + dg * 16) = q0; *(u32x4*)(Y0 + s * LDP + dg * 16 + 8) = q1;
        *(u32x4*)(Y1 + s * LDP + dg * 16) = k0; *(u32x4*)(Y1 + s * LDP + dg * 16 + 8) = k1;
        const unsigned kw[8] = {k0.x, k0.y, k0.z, k0.w, k1.x, k1.y, k1.z, k1.w};
        const unsigned vw[8] = {v0.x, v0.y, v0.z, v0.w, v1.x, v1.y, v1.z, v1.w};
#pragma unroll
        for (int i = 0; i < 8; ++i) {
            Y2[(dg * 16 + 2 * i) * LDP + s] = (u16)(kw[i] & 0xffff); Y2[(dg * 16 + 2 * i + 1) * LDP + s] = (u16)(kw[i] >> 16);
            Y3[(dg * 16 + 2 * i) * LDP + s] = (u16)(vw[i] & 0xffff); Y3[(dg * 16 + 2 * i + 1) * LDP + s] = (u16)(vw[i] >> 16);
        }
    }
    __syncthreads();
    {
        f32x4 kk[4], qk[4]; zero4(kk); zero4(qk);
        mm64(kk, Y1, LDP, Y1, LDP);
        mm64(qk, Y0, LDP, Y1, LDP);
#pragma unroll
        for (int nt = 0; nt < 4; ++nt)
#pragma unroll
            for (int j = 0; j < 4; ++j) {
                const int c = 16 * w + fq * 4 + j, s = nt * 16 + fr;
                const float gam = s <= c ? __expf(cum[c] - cum[s]) : 0.f;
                if (s < c) X[c * 65 + s] = beta[c] * kk[nt][j] * gam;
                Y4[c * LDP + s] = f2bf(qk[nt][j] * gam);
            }
    }
    __syncthreads();
    {
        float* Pb = (float*)Y5;
        if (tid < 64) {
            const int blk = tid >> 4, col = tid & 15, base = blk * 16;
            float tc[16];
#pragma unroll
            for (int r = 0; r < 16; ++r) tc[r] = (r == col) ? 1.f : 0.f;
#pragma unroll
            for (int r = 1; r < 16; ++r) {
                float a = 0.f;
#pragma unroll
                for (int s2 = 0; s2 < r; ++s2) a += X[(base + r) * 65 + base + s2] * tc[s2];
                if (r > col) tc[r] = -a;
            }
#pragma unroll
            for (int r = 0; r < 16; ++r) if (r >= col) X[(base + col) * 65 + base + r + 1] = tc[r];
        }
        __syncthreads();
        for (int d = 1; d < 4; ++d) {
            const int nblk = 4 - d;
            for (int e = tid; e < nblk * 256; e += NTHR) {
                const int jb = e >> 8, r = (e >> 4) & 15, c = e & 15, ib = jb + d;
                float a = 0.f;
                for (int k = jb; k < ib; ++k)
#pragma unroll
                    for (int s2 = 0; s2 < 16; ++s2) {
                        const int rr = 16 * k + s2, cc = 16 * jb + c;
                        const float tv = rr >= cc ? X[cc * 65 + rr + 1] : 0.f;
                        a += X[(16 * ib + r) * 65 + rr] * tv;
                    }
                Pb[(jb * 16 + r) * 17 + c] = a;
            }
            __syncthreads();
            for (int e = tid; e < nblk * 256; e += NTHR) {
                const int jb = e >> 8, r = (e >> 4) & 15, c = e & 15, ib = jb + d;
                float a = 0.f;
#pragma unroll
                for (int s2 = 0; s2 < 16; ++s2) {
                    const float tv = s2 <= r ? X[(16 * ib + s2) * 65 + 16 * ib + r + 1] : 0.f;
                    a += tv * Pb[(jb * 16 + s2) * 17 + c];
                }
                X[(16 * jb + c) * 65 + 16 * ib + r + 1] = -a;
            }
            __syncthreads();
        }
    }
    {
        const int c = tid >> 2, sgp = tid & 3;
        float tw[16], tu[16];
#pragma unroll
        for (int i = 0; i < 16; ++i) {
            const int s = sgp * 16 + i;
            const float t = s <= c ? X[s * 65 + c + 1] : 0.f;
            tw[i] = t * be[s]; tu[i] = t * beta[s];
        }
        st16bf(Y0 + c * LDP + sgp * 16, tw);
        st16bf(Y1 + c * LDP + sgp * 16, tu);
    }
    __syncthreads();
    {
        f32x4 wa[4], ua[4]; zero4(wa); zero4(ua);
        mm64(wa, Y0, LDP, Y2, LDP);
        mm64(ua, Y1, LDP, Y3, LDP);
        __syncthreads();
        const int c0 = 16 * w + fq * 4;
        const float k0 = ke[c0], k1 = ke[c0 + 1], k2 = ke[c0 + 2], k3 = ke[c0 + 3];
#pragma unroll
        for (int nt = 0; nt < 4; ++nt) {
            const int d = nt * 16 + fr;
            u32x2 a, bq, c, dq_;
            a.x = pack2(wa[nt][0], wa[nt][1]); a.y = pack2(wa[nt][2], wa[nt][3]);
            bq.x = pack2(wa[nt][0] * k0, wa[nt][1] * k1); bq.y = pack2(wa[nt][2] * k2, wa[nt][3] * k3);
            c.x = pack2(ua[nt][0], ua[nt][1]); c.y = pack2(ua[nt][2], ua[nt][3]);
            dq_.x = pack2(ua[nt][0] * k0, ua[nt][1] * k1); dq_.y = pack2(ua[nt][2] * k2, ua[nt][3] * k3);
            *(u32x2*)(wT + d * LDP + c0) = a;
            *(u32x2*)(Y5 + d * LDP + c0) = bq;
            *(u32x2*)(Y0 + d * LDP + c0) = c;
            *(u32x2*)(Y1 + d * LDP + c0) = dq_;
        }
    }
    __syncthreads();
    {
        const float dec = scal[0];
        f32x4 acc[4];
        zero4(acc); mm64(acc, wT, LDP, Y4, LDP);
#pragma unroll
        for (int nt = 0; nt < 4; ++nt) {
            const int d = 16 * w + fq * 4, c = nt * 16 + fr, row = row0 + (dir ? 63 - c : c);
            const u32x2 qv = *(const u32x2*)(gqkv + (size_t)row * 768 + h * 64 + d);
            const float ec = __expf(cum[c]);
            u32x2 pk;
            pk.x = pack2(__uint_as_float(qv.x << 16) * ec - acc[nt][0], __uint_as_float(qv.x & 0xffff0000u) * ec - acc[nt][1]);
            pk.y = pack2(__uint_as_float(qv.y << 16) * ec - acc[nt][2], __uint_as_float(qv.y & 0xffff0000u) * ec - acc[nt][3]);
            *(u32x2*)(p.gdQ + idx * 4096 + c * 64 + d) = pk;
        }
        zero4(acc); mm64(acc, Y5, LDP, Y2, LDP);
#pragma unroll
        for (int nt = 0; nt < 4; ++nt) {
            const int d = 16 * w + fq * 4, d2 = nt * 16 + fr;
            u32x2 pk;
            pk.x = pack2((d == d2 ? dec : 0.f) - acc[nt][0], (d + 1 == d2 ? dec : 0.f) - acc[nt][1]);
            pk.y = pack2((d + 2 == d2 ? dec : 0.f) - acc[nt][2], (d + 3 == d2 ? dec : 0.f) - acc[nt][3]);
            *(u32x2*)(p.gdM + idx * 4096 + d2 * 64 + d) = pk;
        }
        zero4(acc); mm64(acc, Y2, LDP, Y1, LDP);
#pragma unroll
        for (int nt = 0; nt < 4; ++nt) {
            const int d2 = 16 * w + fq * 4, e = nt * 16 + fr;
            u32x2 pk; pk.x = pack2(acc[nt][0], acc[nt][1]); pk.y = pack2(acc[nt][2], acc[nt][3]);
            *(u32x2*)(p.gdN + idx * 4096 + e * 64 + d2) = pk;
        }
        zero4(acc); mm64(acc, Y4, LDP, Y0, LDP);
#pragma unroll
        for (int nt = 0; nt < 4; ++nt) {
            const int c = 16 * w + fq * 4, e = nt * 16 + fr;
            u32x2 pk; pk.x = pack2(acc[nt][0], acc[nt][1]); pk.y = pack2(acc[nt][2], acc[nt][3]);
            *(u32x2*)(p.gdO + idx * 4096 + e * 64 + c) = pk;
        }
    }
    __syncthreads();
}

DEV void phase_chunkA(const P& p, int l, const u16* gqkv, int bid, int nb, unsigned char* sm) {
    for (int u = bid; u < 3 * 2112; u += nb) {
        const int mix = u / 2112, v = u % 2112;
        const int h = v & 3, st = (v >> 2) % NSTEP, db = (v >> 2) / NSTEP, b = db & 1, dir = db >> 1;
        if (mix == 0) gd_phaseA(p, l, gqkv, dir, b, st, h, sm);
        else if (mix == 1) gla_phaseA(p, l, dir, b, st, h, sm);
        else ml_phaseA(p, l, dir, b, st, h, sm);
    }
}
DEV void gd_load(const P& p, size_t idx, int w, int fr, int fq, bf16x8 (&a)[4][2], u32x2 (&nv)[4]) {
#pragma unroll
    for (int mt = 0; mt < 4; ++mt) {
#pragma unroll
        for (int ks = 0; ks < 2; ++ks) a[mt][ks] = *(const bf16x8*)(p.gdM + idx * 4096 + (mt * 16 + fr) * 64 + ks * 32 + fq * 8);
        nv[mt] = *(const u32x2*)(p.gdN + idx * 4096 + (16 * w + fr) * 64 + mt * 16 + fq * 4);
    }
}
DEV void gd_step(const P& p, size_t idx, int w, int fr, int fq, const bf16x8 (&a)[4][2], const u32x2 (&nv)[4], bf16x8 (&sb)[2], u16* sl) {
    f32x4 acc[4];
#pragma unroll
    for (int mt = 0; mt < 4; ++mt) {
        acc[mt][0] = __uint_as_float(nv[mt].x << 16); acc[mt][1] = __uint_as_float(nv[mt].x & 0xffff0000u);
        acc[mt][2] = __uint_as_float(nv[mt].y << 16); acc[mt][3] = __uint_as_float(nv[mt].y & 0xffff0000u);
    }
#pragma unroll
    for (int mt = 0; mt < 4; ++mt)
#pragma unroll
        for (int ks = 0; ks < 2; ++ks) acc[mt] = mfma16(a[mt][ks], sb[ks], acc[mt]);
#pragma unroll
    for (int ks = 0; ks < 2; ++ks) *(bf16x8*)(p.gdN + idx * 4096 + (16 * w + fr) * 64 + ks * 32 + fq * 8) = sb[ks];
#pragma unroll
    for (int mt = 0; mt < 4; ++mt) {
        u32x2 pk; pk.x = pack2(acc[mt][0], acc[mt][1]); pk.y = pack2(acc[mt][2], acc[mt][3]);
        *(u32x2*)(sl + fr * LDP + mt * 16 + fq * 4) = pk;
    }
    __builtin_amdgcn_fence(__ATOMIC_RELEASE, "wavefront");
    __builtin_amdgcn_wave_barrier();
    __builtin_amdgcn_fence(__ATOMIC_ACQUIRE, "wavefront");
#pragma unroll
    for (int ks = 0; ks < 2; ++ks) sb[ks] = *(const bf16x8*)(sl + fr * LDP + ks * 32 + fq * 8);
    __builtin_amdgcn_wave_barrier();
}
DEV void gd_scan(const P& p, int chain, u16* sm) {
    const int dir = chain >> 3, b = (chain >> 2) & 1, h = chain & 3;
    const int tid_ = tidx();
    const int lane = tid_ & 63, w = tid_ >> 6, fr = lane & 15, fq = lane >> 4;
    u16* sl = sm + w * 16 * LDP;
    bf16x8 sb[2];
    sb[0] = bf16x8{0, 0, 0, 0, 0, 0, 0, 0}; sb[1] = sb[0];
    bf16x8 a0[4][2], a1[4][2], a2[4][2]; u32x2 n0[4], n1[4], n2[4];
    const size_t base = state_idx(dir, b, 0, h);
    gd_load(p, base, w, fr, fq, a0, n0);
    gd_load(p, base + 4, w, fr, fq, a1, n1);
    gd_load(p, base + 8, w, fr, fq, a2, n2);
    for (int st = 0; st < NSTEP; st += 3) {
        gd_step(p, base + (size_t)st * 4, w, fr, fq, a0, n0, sb, sl);
        if (st + 3 < NSTEP) gd_load(p, base + (size_t)(st + 3) * 4, w, fr, fq, a0, n0);
        gd_step(p, base + (size_t)(st + 1) * 4, w, fr, fq, a1, n1, sb, sl);
        if (st + 4 < NSTEP) gd_load(p, base + (size_t)(st + 4) * 4, w, fr, fq, a1, n1);
        gd_step(p, base + (size_t)(st + 2) * 4, w, fr, fq, a2, n2, sb, sl);
        if (st + 5 < NSTEP) gd_load(p, base + (size_t)(st + 5) * 4, w, fr, fq, a2, n2);
    }
}

DEV void gla_scan(const P& p, int v) {
    const int chain = v >> 3, sub = v & 7;
    const int dir = chain >> 3, b = (chain >> 2) & 1, h = chain & 3;
    const int ep = sub * 256 + tidx(), d = (2 * ep) & 63;
    float s0 = 0.f, s1 = 0.f;
    for (int st0 = 0; st0 < NSTEP; st0 += 12) {
        unsigned kv[12]; float2 dc[12];
#pragma unroll
        for (int k = 0; k < 12; ++k) {
            const size_t idx = state_idx(dir, b, st0 + k, h);
            kv[k] = *(const unsigned*)(p.glaS + idx * 4096 + 2 * ep);
            dc[k] = *(const float2*)(p.glaDec + idx * 64 + d);
        }
#pragma unroll
        for (int k = 0; k < 12; ++k) {
            const size_t idx = state_idx(dir, b, st0 + k, h);
            *(unsigned*)(p.glaS + idx * 4096 + 2 * ep) = pack2(s0, s1);
            s0 = dc[k].x * s0 + __uint_as_float(kv[k] << 16);
            s1 = dc[k].y * s1 + __uint_as_float(kv[k] & 0xffff0000u);
        }
    }
}

DEV void ml_scan(const P& p, int v) {
    const int chain = v >> 3, sub = v & 7;
    const int dir = chain >> 3, b = (chain >> 2) & 1, h = chain & 3;
    const int tid = tidx();
    const int ep = sub * 256 + tid;
    float s0 = 0.f, s1 = 0.f, m = 0.f, nn = 0.f;
    const bool do_n = (sub == 0 && tid < 64);
    for (int st0 = 0; st0 < NSTEP; st0 += 12) {
        unsigned kv[12]; float fe[12], ae[12], ks[12];
#pragma unroll
        for (int k = 0; k < 12; ++k) {
            const size_t idx = state_idx(dir, b, st0 + k, h);
            kv[k] = *(const unsigned*)(p.mlS + idx * 4096 + 2 * ep);
            fe[k] = p.mlFE[idx]; ae[k] = p.mlAE[idx];
            ks[k] = do_n ? p.mlN[idx * 64 + tid] : 0.f;
        }
#pragma unroll
        for (int k = 0; k < 12; ++k) {
            const size_t idx = state_idx(dir, b, st0 + k, h);
            *(unsigned*)(p.mlS + idx * 4096 + 2 * ep) = pack2(s0, s1);
            if (do_n) p.mlN[idx * 64 + tid] = nn;
            if (sub == 0 && tid == 0) p.mlM[idx] = m;
            const float mn = fmaxf(fe[k] + m, ae[k]);
            const float od = __expf(fe[k] + m - mn), nw = __expf(ae[k] - mn);
            s0 = od * s0 + nw * __uint_as_float(kv[k] << 16);
            s1 = od * s1 + nw * __uint_as_float(kv[k] & 0xffff0000u);
            nn = od * nn + nw * ks[k];
            m = mn;
        }
    }
}

DEV void phase_scan(const P& p, int bid, int nb, u16* sm) {
    for (int u = bid; u < 16 + 128 + 128; u += nb) {
        if (u < 16) gd_scan(p, u, sm);
        else if (u < 144) gla_scan(p, u - 16);
        else ml_scan(p, u - 144);
    }
}
DEV void chunk_geom(int g, int& b, int& row0, int& stf, int& stb) {
    b = g / NSTEP; const int wv = g % NSTEP;
    row0 = wv < 4 ? RLAT + b * CTXL + wv * 64 : b * SEQ + (wv - 4) * 64;
    stf = wv; stb = wv < 4 ? 3 - wv : 135 - wv;
}
DEV void obuf_acc(float* obuf, const f32x4 (&acc)[4], int dir) {
    const int lane = tidx() & 63, w = tidx() >> 6, fr = lane & 15, fq = lane >> 4;
#pragma unroll
    for (int nt = 0; nt < 4; ++nt)
#pragma unroll
        for (int j = 0; j < 4; ++j) {
            const int c = 16 * w + fq * 4 + j, e = nt * 16 + fr;
            if (dir == 0) obuf[c * 65 + e] = acc[nt][j]; else obuf[(63 - c) * 65 + e] += acc[nt][j];
        }
}
template <int ACT>
DEV void head_out(const P& p, int l, int br, int h, int row0, int gcol, const float* obuf) {
    const int tid = tidx(), row = tid >> 2, eg = tid & 3;
    float o[16]; float ss = 0.f;
#pragma unroll
    for (int i = 0; i < 16; ++i) { o[i] = obuf[row * 65 + eg * 16 + i]; ss += o[i] * o[i]; }
    ss += __shfl_xor(ss, 1, 64); ss += __shfl_xor(ss, 2, 64);
    const float rs = rsqrtf(ss * (1.f / 64.f) + EPSF);
    float gt[16];
    ld16bf(p.cols + (size_t)(row0 + row) * NCM + gcol + h * 64 + eg * 16, gt);
    float y[16];
#pragma unroll
    for (int i = 0; i < 16; ++i) {
        const float hn = p.head_norm[(l * 4 + br) * 256 + h * 64 + eg * 16 + i];
        const float a = ACT == 0 ? silu(gt[i]) : sigm(gt[i]);
        y[i] = o[i] * rs * hn * a;
    }
    st16bf(p.ybuf + (size_t)(row0 + row) * 1024 + br * 256 + h * 64 + eg * 16, y);
}

DEV void gla_phaseC(const P& p, int l, int g, int h, unsigned char* smraw) {
    float* cum = (float*)smraw;
    float* rt = cum + 64 * 65;
    float* sg = rt + 64 * 17;
    float* obuf = sg + 256;
    u16* qi = (u16*)(obuf + 64 * 65);
    u16* ko = qi + 64 * LDP;
    u16* vT = ko + 64 * LDP;
    const int tid = tidx(), lane = tid & 63, w = tid >> 6, fr = lane & 15, fq = lane >> 4;
    int b, row0, stf, stb; chunk_geom(g, b, row0, stf, stb);
    for (int dir = 0; dir < 2; ++dir) {
        const size_t idx = state_idx(dir, b, dir ? stb : stf, h);
        gla_cum(p, l, dir, h, row0, cum, rt, sg);
        {
            const int s = tid >> 2, dg = tid & 3, row = row0 + (dir ? 63 - s : s);
            float qq[16], kk[16], vv[16];
            ld16bf(p.cols + (size_t)row * NCM + GLA_Q + h * 64 + dg * 16, qq);
            ld16bf(p.cols + (size_t)row * NCM + GLA_K + h * 64 + dg * 16, kk);
            ld16bf(p.cols + (size_t)row * NCM + GLA_V + h * 64 + dg * 16, vv);
#pragma unroll
            for (int i = 0; i < 16; ++i) {
                const float cv = cum[s * 65 + dg * 16 + i];
                qq[i] *= 0.125f * __expf(cv); kk[i] *= __expf(-cv);
                vT[(dg * 16 + i) * LDP + s] = f2bf(vv[i]);
            }
            st16bf(qi + s * LDP + dg * 16, qq);
            st16bf(ko + s * LDP + dg * 16, kk);
        }
        __syncthreads();
        f32x4 sa[4]; zero4(sa);
        mm64(sa, qi, LDP, ko, LDP);
        __syncthreads();
#pragma unroll
        for (int nt = 0; nt < 4; ++nt)
#pragma unroll
            for (int j = 0; j < 4; ++j) {
                const int c = 16 * w + fq * 4 + j, s = nt * 16 + fr;
                ko[c * LDP + s] = f2bf(s <= c ? sa[nt][j] : 0.f);
            }
        __syncthreads();
        f32x4 oa[4]; zero4(oa);
        mm64(oa, ko, LDP, vT, LDP);
        mm64(oa, qi, LDP, p.glaS + idx * 4096, 64);
        obuf_acc(obuf, oa, dir);
        __syncthreads();
    }
    head_out<0>(p, l, 0, h, row0, GLA_G, obuf);
    __syncthreads();
}

DEV void ml_phaseC(const P& p, int l, int g, int h, unsigned char* smraw) {
    float* obuf = (float*)smraw;
    float* fcum = obuf + 64 * 65;
    float* ipre = fcum + 64;
    float* mrow = ipre + 64;
    float* denl = mrow + 64;
    float* qn = denl + 64;
    float* nin = qn + 64;
    u16* qs = (u16*)(nin + 64 + 64);
    u16* ks = qs + 64 * LDP;
    u16* vT = ks + 64 * LDP;
    const int tid = tidx(), lane = tid & 63, w = tid >> 6, fr = lane & 15, fq = lane >> 4;
    int b, row0, stf, stb; chunk_geom(g, b, row0, stf, stb);
    for (int dir = 0; dir < 2; ++dir) {
        const size_t idx = state_idx(dir, b, dir ? stb : stf, h);
        const float m_in = p.mlM[idx];
        if (w == 0) {
            const int row = row0 + (dir ? 63 - lane : lane);
            const float ip = bf2f(p.cols[(size_t)row * NCM + ML_GF + dir * 8 + h]) + p.mlstm_gate_b[((l * 2 + dir) * 2 + 0) * 4 + h];
            const float lf = logsig(bf2f(p.cols[(size_t)row * NCM + ML_GF + dir * 8 + 4 + h]) + p.mlstm_gate_b[((l * 2 + dir) * 2 + 1) * 4 + h]);
            const float fc = wscan_add(lf, lane);
            const float pm = wscan_max(ip - fc, lane);
            fcum[lane] = fc; ipre[lane] = ip; mrow[lane] = fc + fmaxf(m_in, pm);
            nin[lane] = p.mlN[idx * 64 + lane];
        }
        {
            const int s = tid >> 2, dg = tid & 3, row = row0 + (dir ? 63 - s : s);
            float kk[16], vv[16];
            const u16* qsrc = p.cols + (size_t)row * NCM + ML_Q + h * 64 + dg * 16;
            *(u32x4*)(qs + s * LDP + dg * 16) = *(const u32x4*)qsrc;
            *(u32x4*)(qs + s * LDP + dg * 16 + 8) = *(const u32x4*)(qsrc + 8);
            ld16bf(p.cols + (size_t)row * NCM + ML_K + h * 64 + dg * 16, kk);
            ld16bf(p.cols + (size_t)row * NCM + ML_V + h * 64 + dg * 16, vv);
#pragma unroll
            for (int i = 0; i < 16; ++i) { kk[i] *= 0.125f; vT[(dg * 16 + i) * LDP + s] = f2bf(vv[i]); }
            st16bf(ks + s * LDP + dg * 16, kk);
        }
        __syncthreads();
        {
            const int c = tid >> 2, dg = tid & 3;
            float a = 0.f;
#pragma unroll
            for (int i = 0; i < 16; ++i) a += bf2f(qs[c * LDP + dg * 16 + i]) * nin[dg * 16 + i];
            a += __shfl_xor(a, 1, 64); a += __shfl_xor(a, 2, 64);
            if (dg == 0) qn[c] = a;
        }
        f32x4 sa[4]; zero4(sa);
        mm64(sa, qs, LDP, ks, LDP);
        __syncthreads();
        float dsum[4] = {0.f, 0.f, 0.f, 0.f};
#pragma unroll
        for (int nt = 0; nt < 4; ++nt)
#pragma unroll
            for (int j = 0; j < 4; ++j) {
                const int c = 16 * w + fq * 4 + j, s = nt * 16 + fr;
                float val = 0.f;
                if (s <= c) val = sa[nt][j] * __expf(fcum[c] - fcum[s] + ipre[s] - mrow[c]);
                dsum[j] += val;
                ks[c * LDP + s] = f2bf(val);
            }
#pragma unroll
        for (int j = 0; j < 4; ++j) {
            float v = dsum[j];
            v += __shfl_xor(v, 1, 64); v += __shfl_xor(v, 2, 64); v += __shfl_xor(v, 4, 64); v += __shfl_xor(v, 8, 64);
            if (fr == 0) denl[16 * w + fq * 4 + j] = v;
        }
        __syncthreads();
        f32x4 n1[4], n2[4]; zero4(n1); zero4(n2);
        mm64(n1, ks, LDP, vT, LDP);
        mm64(n2, qs, LDP, p.mlS + idx * 4096, 64);
        f32x4 oa[4];
#pragma unroll
        for (int j = 0; j < 4; ++j) {
            const int c = 16 * w + fq * 4 + j;
            const float mr = mrow[c];
            const float ec = __expf(fcum[c] + m_in - mr);
            const float den = denl[c] + ec * qn[c];
            const float inv = 1.f / fmaxf(fabsf(den), __expf(-mr));
#pragma unroll
            for (int nt = 0; nt < 4; ++nt) oa[nt][j] = (n1[nt][j] + ec * n2[nt][j]) * inv;
        }
        obuf_acc(obuf, oa, dir);
        __syncthreads();
    }
    head_out<1>(p, l, 1, h, row0, ML_O, obuf);
    __syncthreads();
}

DEV void gd_phaseC(const P& p, int l, int g, int h, unsigned char* smraw) {
    float* obuf = (float*)smraw;
    const int tid = tidx(), lane = tid & 63, w = tid >> 6, fr = lane & 15, fq = lane >> 4;
    int b, row0, stf, stb; chunk_geom(g, b, row0, stf, stb);
    for (int dir = 0; dir < 2; ++dir) {
        const size_t idx = state_idx(dir, b, dir ? stb : stf, h);
        f32x4 oa[4];
#pragma unroll
        for (int nt = 0; nt < 4; ++nt) {
            const u32x2 ov = *(const u32x2*)(p.gdO + idx * 4096 + (nt * 16 + fr) * 64 + 16 * w + fq * 4);
            oa[nt][0] = __uint_as_float(ov.x << 16); oa[nt][1] = __uint_as_float(ov.x & 0xffff0000u);
            oa[nt][2] = __uint_as_float(ov.y << 16); oa[nt][3] = __uint_as_float(ov.y & 0xffff0000u);
        }
        mm64(oa, p.gdQ + idx * 4096, 64, p.gdN + idx * 4096, 64);
        obuf_acc(obuf, oa, dir);
        __syncthreads();
    }
    head_out<0>(p, l, 2, h, row0, GD_OG, obuf);
    __syncthreads();
}
DEV float fexp2(float x) { return __builtin_amdgcn_exp2f(x); }

#define RAW_BARRIER() do { asm volatile("s_waitcnt lgkmcnt(0)" ::: "memory"); __builtin_amdgcn_s_barrier(); } while (0)
#define ATT_STAGE_ELEMS (2 * 64 * 64)
DEV void attn_issue(const u16* kbase, const u16* vbase, int kt, u16* ring, int stg, int w, int lane) {
    u16* kd = ring + stg * ATT_STAGE_ELEMS;
    u16* vd = kd + 64 * 64;
#pragma unroll
    for (int i = 0; i < 2; ++i) {
        const int r = (w * 2 + i) * 8 + (lane >> 3), c = (lane & 7) ^ ((r >> 1) & 7);
        __builtin_amdgcn_global_load_lds((const unsigned*)(kbase + (size_t)(kt * 64 + r) * 64 + c * 8), (unsigned*)(kd + (w * 2 + i) * 512), 16, 0, 0);
        __builtin_amdgcn_global_load_lds((const unsigned*)(vbase + (size_t)r * KPOS + kt * 64 + c * 8), (unsigned*)(vd + (w * 2 + i) * 512), 16, 0, 0);
    }
}

DEV void attn_unit(const P& p, int l, int b, int h, int q0pos, int nkeys, int rowbase, u16* ring) {
    const int tid = tidx(), lane = tid & 63, w = tid >> 6, fr = lane & 15, fq = lane >> 4;
    const size_t bh = (size_t)(b * 4 + h);
    float lam;
    {
        const float* lp = p.diff_lambda + (size_t)l * 4 * 4 * 32;
        float a = 0.f, c = 0.f;
        if (lane < 32) { a = lp[(0 * 4 + h) * 32 + lane] * lp[(1 * 4 + h) * 32 + lane]; c = lp[(2 * 4 + h) * 32 + lane] * lp[(3 * 4 + h) * 32 + lane]; }
        a = wsum(a); c = wsum(c);
        lam = expf(a) - expf(c) + (0.8f - 0.6f * expf(-0.3f * (float)l));
    }
    const float lam_init = 0.8f - 0.6f * expf(-0.3f * (float)l);
    bf16x8 qf[2][2];
#pragma unroll
    for (int g = 0; g < 2; ++g)
#pragma unroll
        for (int i = 0; i < 2; ++i)
            qf[g][i] = *(const bf16x8*)(p.dq + (bh * KPOS + q0pos + w * 32 + g * 16 + fr) * 64 + i * 32 + fq * 8);
    f32x4 O[2][2][4];
    float mrun[2][2], lsum[2][2];
#pragma unroll
    for (int i = 0; i < 2; ++i)
#pragma unroll
        for (int g = 0; g < 2; ++g) {
            mrun[i][g] = -INFINITY; lsum[i][g] = 0.f;
#pragma unroll
            for (int t = 0; t < 4; ++t) O[i][g][t] = f32x4{0.f, 0.f, 0.f, 0.f};
        }
    const u16* kbase = p.dk + bh * KPOS * 64;
    const u16* vbase = p.dvT + bh * 64 * KPOS;
    const int nk = nkeys >> 6;
    asm volatile("s_waitcnt vmcnt(0)" ::: "memory");
    attn_issue(kbase, vbase, 0, ring, 0, w, lane);
    attn_issue(kbase, vbase, 1, ring, 1, w, lane);
    const int sw = (fr >> 1) & 7;
    for (int kt = 0; kt < nk; ++kt) {
        if (kt + 1 < nk) asm volatile("s_waitcnt vmcnt(4)" ::: "memory"); else asm volatile("s_waitcnt vmcnt(0)" ::: "memory");
        RAW_BARRIER();
        if (kt + 2 < nk) attn_issue(kbase, vbase, kt + 2, ring, (kt + 2) % 3, w, lane);
        const u16* Ks = ring + (kt % 3) * ATT_STAGE_ELEMS;
        const u16* Vs = Ks + 64 * 64;
#pragma unroll
        for (int i = 0; i < 2; ++i) {
            f32x4 s[2][4];
#pragma unroll
            for (int st = 0; st < 4; ++st) {
                const bf16x8 kf = *(const bf16x8*)(Ks + (st * 16 + fr) * 64 + (((i * 4 + fq) ^ sw) * 8));
#pragma unroll
                for (int g = 0; g < 2; ++g) s[g][st] = mfma16(kf, qf[g][i], f32x4{0.f, 0.f, 0.f, 0.f});
            }
            bf16x8 pb[2][2];
#pragma unroll
            for (int g = 0; g < 2; ++g) {
                float mx = s[g][0][0];
#pragma unroll
                for (int st = 0; st < 4; ++st)
#pragma unroll
                    for (int j = 0; j < 4; ++j) mx = fmaxf(mx, s[g][st][j]);
                mx = fmaxf(mx, __shfl_xor(mx, 16, 64)); mx = fmaxf(mx, __shfl_xor(mx, 32, 64));
                const float mn = fmaxf(mrun[i][g], mx);
                const float alpha = fexp2(mrun[i][g] - mn);
                mrun[i][g] = mn;
                float ps = 0.f;
#pragma unroll
                for (int st = 0; st < 4; ++st)
#pragma unroll
                    for (int j = 0; j < 4; ++j) { const float e = fexp2(s[g][st][j] - mn); s[g][st][j] = e; ps += e; }
                lsum[i][g] = lsum[i][g] * alpha + ps;
#pragma unroll
                for (int t = 0; t < 4; ++t) { O[i][g][t][0] *= alpha; O[i][g][t][1] *= alpha; O[i][g][t][2] *= alpha; O[i][g][t][3] *= alpha; }
#pragma unroll
                for (int ks = 0; ks < 2; ++ks) {
                    union { bf16x8 v; unsigned u[4]; } pk;
                    pk.u[0] = pack2(s[g][2 * ks][0], s[g][2 * ks][1]); pk.u[1] = pack2(s[g][2 * ks][2], s[g][2 * ks][3]);
                    pk.u[2] = pack2(s[g][2 * ks + 1][0], s[g][2 * ks + 1][1]); pk.u[3] = pack2(s[g][2 * ks + 1][2], s[g][2 * ks + 1][3]);
                    pb[g][ks] = pk.v;
                }
            }
#pragma unroll
            for (int ks = 0; ks < 2; ++ks)
#pragma unroll
                for (int t = 0; t < 4; ++t) {
                    union { bf16x8 v; u32x2 h2[2]; } va;
                    va.h2[0] = *(const u32x2*)(Vs + (t * 16 + fr) * 64 + ((((2 * ks) * 2 + (fq >> 1)) ^ sw) * 8) + (fq & 1) * 4);
                    va.h2[1] = *(const u32x2*)(Vs + (t * 16 + fr) * 64 + ((((2 * ks + 1) * 2 + (fq >> 1)) ^ sw) * 8) + (fq & 1) * 4);
#pragma unroll
                    for (int g = 0; g < 2; ++g) O[i][g][t] = mfma16(va.v, pb[g][ks], O[i][g][t]);
                }
        }
    }
    RAW_BARRIER();
#pragma unroll
    for (int g = 0; g < 2; ++g) {
        float l0 = lsum[0][g], l1 = lsum[1][g];
        l0 += __shfl_xor(l0, 16, 64); l0 += __shfl_xor(l0, 32, 64);
        l1 += __shfl_xor(l1, 16, 64); l1 += __shfl_xor(l1, 32, 64);
        const float i0 = 1.f / l0, i1 = lam / l1;
        float o[4][4]; float ss = 0.f;
#pragma unroll
        for (int t = 0; t < 4; ++t)
#pragma unroll
            for (int j = 0; j < 4; ++j) { o[t][j] = O[0][g][t][j] * i0 - O[1][g][t][j] * i1; ss += o[t][j] * o[t][j]; }
        ss += __shfl_xor(ss, 16, 64); ss += __shfl_xor(ss, 32, 64);
        const float rs = rsqrtf(ss * (1.f / 64.f) + EPSF) * (1.f - lam_init);
        const int row = rowbase + w * 32 + g * 16 + fr;
#pragma unroll
        for (int t = 0; t < 4; ++t) {
            const int dv = t * 16 + fq * 4;
            const float4 hn = *(const float4*)(p.head_norm + (l * 4 + 3) * 256 + h * 64 + dv);
            u32x2 pk; pk.x = pack2(o[t][0] * rs * hn.x, o[t][1] * rs * hn.y); pk.y = pack2(o[t][2] * rs * hn.z, o[t][3] * rs * hn.w);
            *(u32x2*)(p.ybuf + (size_t)row * 1024 + 768 + h * 64 + dv) = pk;
        }
    }
}

template <int PART>
DEV void phase_outputs(const P& p, int l, int bid, int nb, unsigned char* sm) {
    if (PART != 2) {
    const int nq = 64 + (l == 0 ? 2 : 0);
    int* qctr = p.cnt + 64 + l * 8;
    volatile int* slot = (volatile int*)(sm + 3 * ATT_STAGE_ELEMS * 2);
    const int x0 = (int)(xb_xcc_id() & 7u);
    for (int a = 0; a < 8; ++a) {
        const int bh = (x0 + a) & 7;
        for (;;) {
            if (tidx() == 0) *slot = atomicAdd(qctr + bh, 1);
            __syncthreads();
            const int qt = *slot;
            __syncthreads();
            if (qt >= nq) break;
            const int b = bh >> 2, h = bh & 3;
            if (qt < 64) attn_unit(p, l, b, h, CTXL + qt * 128, KPOS, b * SEQ + qt * 128, (u16*)sm);
            else attn_unit(p, l, b, h, (qt - 64) * 128, CTXL, RLAT + b * CTXL + (qt - 64) * 128, (u16*)sm);
        }
    }
    }
    __builtin_amdgcn_sched_barrier(0);
    if (PART != 1)
    for (int v = bid; v < 3 * 1056; v += nb) {
        const int mix = v / 1056, r = v % 1056, g = r >> 2, h = r & 3;
        if (l == 1 && (g % NSTEP) < 4) continue;
        if (mix == 0) gla_phaseC(p, l, g, h, sm);
        else if (mix == 1) ml_phaseC(p, l, g, h, sm);
        else gd_phaseC(p, l, g, h, sm);
    }
}
#define LDS_BYTES 73728
#ifndef MULTI
#define MULTI 0
#endif
#ifndef STAGE
#define STAGE 99
#endif

enum { PH_PRO0 = 0, PH_PRO1, PH_NORM1, PH_INPROJ, PH_PREP, PH_CHUNKA, PH_SCAN, PH_OUT, PH_GATES, PH_MERGE1, PH_MERGE2, PH_ROUTER, PH_MOEUP, PH_MOEDOWN, PH_FINAL, PH_OUTC };

template <int PH>
DEV void run_phase(const P& p, int l, int bid_, int nb_, unsigned char* sm) {
    const int bid = launder_s(bid_), nb = launder_s(nb_);
    u16* gqkv = p.ybuf;
    u16* ubuf = p.glaS;
    const int mtiles = l == 0 ? 132 : 128;
    if (PH == PH_PRO0) { phase_conv_mixw(p, 0, bid, nb, (float*)sm); phase_mod_partial(p, bid, nb, (float*)sm); phase_rope_table(p, bid, nb); }
    else if (PH == PH_PRO1) phase_mod_reduce(p, bid, nb);
    else if (PH == PH_NORM1) phase_norm1(p, l, bid, nb);
    else if (PH == PH_INPROJ) phase_inproj<false>(p, 0, 31, NCM, 132, bid, nb, (u16*)sm);
    else if (PH == PH_PREP) phase_prep(p, l, gqkv, bid, nb, (u16*)sm);
    else if (PH == PH_CHUNKA) phase_chunkA(p, l, gqkv, bid, nb, sm);
    else if (PH == PH_SCAN) phase_scan(p, bid, nb, (u16*)sm);
#ifdef PROBE_SPLIT
    else if (PH == PH_OUT) phase_outputs<1>(p, l, bid, nb, sm);
    else if (PH == PH_OUTC) phase_outputs<2>(p, l, bid, nb, sm);
#else
    else if (PH == PH_OUT) phase_outputs<0>(p, l, bid, nb, sm);
#endif
    else if (PH == PH_GATES) phase_inproj<true>(p, 3968, 32, NGATE, mtiles, bid, nb, (u16*)sm);
    else if (PH == PH_MERGE1) phase_merge1(p, ubuf, mtiles, bid, nb, (u16*)sm);
    else if (PH == PH_MERGE2) phase_merge2(p, l, ubuf, mtiles, bid, nb, (u16*)sm);
    else if (PH == PH_ROUTER) {
        phase_norm2_router(p, l, l == 0 ? RTOT : RLAT, bid, nb, (float*)sm);
        phase_conv_moew(p, l, bid, nb, (float*)sm);
        if (l == 0) phase_conv_mixw(p, 1, bid, nb, (float*)sm);
    }
    else if (PH == PH_MOEUP) phase_moe_up(p, l, bid, nb, (u16*)sm);
    else if (PH == PH_MOEDOWN) phase_moe_down(p, l, bid, nb, (u16*)sm);
    else if (PH == PH_FINAL) phase_final_norm(p, bid, nb);
}

#if MULTI
template <int PH>
__global__ void __launch_bounds__(NTHR, 2) k_phase(P p, int l) {
    extern __shared__ __attribute__((aligned(16))) unsigned char smem[];
    run_phase<PH>(p, l, blockIdx.x, gridDim.x, smem);
}
#else
__global__ void __launch_bounds__(NTHR, 2) k_mega(P p) {
    extern __shared__ __attribute__((aligned(16))) unsigned char smem[];
    volatile LAS unsigned* xbw = (volatile LAS unsigned*)(smem + LDS_BYTES);
    if (threadIdx.x == 0) { xbw[0] = 0u; xbw[1] = 0u; xbw[2] = 0u; xbw[3] = 0u; }
    __syncthreads();
    (void)xcd_barrier_post(p.bar, xbw);
    const int bid = blockIdx.x, nb = gridDim.x;
#ifdef PROBE_SEL
    unsigned long long pr_acc = 0, pr_t0 = wall_clock64();
#define PSTAMP(PH) do { const unsigned long long t_ = wall_clock64(); if ((PH) == PROBE_SEL) pr_acc += t_ - pr_t0; pr_t0 = t_; } while (0)
#else
#define PSTAMP(PH) do { } while (0)
#endif
#define GBAR() do { XcdBarrier b_; b_.bar = p.bar; b_.x = xb_xcc_id(); b_.st = (volatile LAS unsigned*)(smem + LDS_BYTES); xcd_barrier(b_); } while (0)
    run_phase<PH_PRO0>(p, 0, bid, nb, smem); GBAR(); PSTAMP(PH_PRO0);
    run_phase<PH_PRO1>(p, 0, bid, nb, smem); GBAR(); PSTAMP(PH_PRO1);
    for (int l = 0; l < 2; ++l) {
        run_phase<PH_NORM1>(p, l, bid, nb, smem); GBAR(); PSTAMP(PH_NORM1);
        run_phase<PH_INPROJ>(p, l, bid, nb, smem); GBAR(); PSTAMP(PH_INPROJ);
        run_phase<PH_PREP>(p, l, bid, nb, smem); GBAR(); PSTAMP(PH_PREP);
        run_phase<PH_CHUNKA>(p, l, bid, nb, smem); GBAR(); PSTAMP(PH_CHUNKA);
        run_phase<PH_SCAN>(p, l, bid, nb, smem); GBAR(); PSTAMP(PH_SCAN);
        run_phase<PH_OUT>(p, l, bid, nb, smem); GBAR(); PSTAMP(PH_OUT);
#ifdef PROBE_SPLIT
        run_phase<PH_OUTC>(p, l, bid, nb, smem); GBAR(); PSTAMP(PH_OUTC);
#endif
        run_phase<PH_GATES>(p, l, bid, nb, smem); GBAR(); PSTAMP(PH_GATES);
        run_phase<PH_MERGE1>(p, l, bid, nb, smem); GBAR(); PSTAMP(PH_MERGE1);
        run_phase<PH_MERGE2>(p, l, bid, nb, smem); GBAR(); PSTAMP(PH_MERGE2);
        run_phase<PH_ROUTER>(p, l, bid, nb, smem); GBAR(); PSTAMP(PH_ROUTER);
        run_phase<PH_MOEUP>(p, l, bid, nb, smem); GBAR(); PSTAMP(PH_MOEUP);
        run_phase<PH_MOEDOWN>(p, l, bid, nb, smem); GBAR(); PSTAMP(PH_MOEDOWN);
    }
    run_phase<PH_FINAL>(p, 0, bid, nb, smem);
#ifdef PROBE_SEL
    if (blockIdx.x == 0) { const unsigned long long te = wall_clock64(); while (wall_clock64() - te < pr_acc * 4ull) __builtin_amdgcn_s_sleep(8); }
#endif
}
#endif

static size_t al256(size_t x) { return (x + 255) & ~(size_t)255; }

extern "C" void kernel_launch(void* const* d_in, const int* in_sizes, int n_in, void* d_out, int out_size, void* d_ws, size_t ws_size,
                              hipStream_t stream) {
    (void)in_sizes; (void)n_in; (void)out_size; (void)ws_size;
    P p{};
    p.x = (const float*)d_in[0]; p.c = (const float*)d_in[1]; p.ctx = (const float*)d_in[2]; p.c_ctx = (const float*)d_in[3];
    p.w_mod = (const float*)d_in[4]; p.b_mod = (const float*)d_in[5]; p.norm_mix = (const float*)d_in[6]; p.norm_ffn = (const float*)d_in[7];
    p.w_in = (const float*)d_in[8]; p.gla_a2 = (const float*)d_in[9]; p.gla_ab = (const float*)d_in[10]; p.mlstm_gate_b = (const float*)d_in[11];
    p.gdn_conv = (const float*)d_in[12]; p.gdn_a_log = (const float*)d_in[13]; p.gdn_dt_bias = (const float*)d_in[14];
    p.diff_lambda = (const float*)d_in[15]; p.head_norm = (const float*)d_in[16]; p.w_branch = (const float*)d_in[17];
    p.w_out = (const float*)d_in[18]; p.router_w = (const float*)d_in[19]; p.router_b = (const float*)d_in[20];
    p.w_gate = (const float*)d_in[21]; p.w_up = (const float*)d_in[22]; p.w_down = (const float*)d_in[23]; p.norm_final = (const float*)d_in[24];
    p.out = (float*)d_out;
    unsigned char* ws = (unsigned char*)d_ws;
    size_t o = 0;
    auto take = [&](size_t bytes) { unsigned char* r = ws + o; o = al256(o + bytes); return r; };
    p.bar = (unsigned*)take(XCD_BAR_WORDS * 4);
    p.cnt = (int*)take(1024);
    const size_t zero_bytes = o;
    p.modp = (float*)take((size_t)2 * 16 * 3 * 6144 * 4);
    p.mod = (float*)take((size_t)2 * 3 * 6144 * 4);
    p.xctx = (float*)take((size_t)RCTX * DM * 4);
    p.rope = (float*)take((size_t)192 * 8 * 2 * 4);
    p.hbuf = (u16*)take((size_t)RTOT * DM * 2);
    p.ybuf = (u16*)take((size_t)RTOT * DM * 2);
    p.Wt = (u16*)take((size_t)WT_TOTAL * 2);
    p.dq = (u16*)take((size_t)8 * KPOS * 64 * 2);
    p.dk = (u16*)take((size_t)8 * KPOS * 64 * 2);
    p.dvT = (u16*)take((size_t)8 * KPOS * 64 * 2);
    const size_t nst = (size_t)2 * 2 * NSTEP * 4;
    p.glaDec = (float*)take(nst * 64 * 4);
    p.mlN = (float*)take(nst * 64 * 4);
    p.mlFE = (float*)take(nst * 4);
    p.mlAE = (float*)take(nst * 4);
    p.mlM = (float*)take(nst * 4);
    p.glaS = (u16*)take(nst * 4096 * 2);
    p.mlS = (u16*)take(nst * 4096 * 2);
    p.gdM = (u16*)take(nst * 4096 * 2);
    p.gdN = (u16*)take(nst * 4096 * 2);
    p.gdQ = (u16*)take(nst * 4096 * 2);
    p.gdO = (u16*)take(nst * 4096 * 2);
    p.cols = (u16*)take((size_t)RTOT * NGATE * 2);
    hipMemsetAsync(ws, 0, zero_bytes, stream);

    static int grid = 0;
#if MULTI
#define SETUP(PH) hipFuncSetAttribute((const void*)k_phase<PH>, hipFuncAttributeMaxDynamicSharedMemorySize, LDS_BYTES + 16)
    if (!grid) {
        SETUP(PH_PRO0); SETUP(PH_PRO1); SETUP(PH_NORM1); SETUP(PH_INPROJ); SETUP(PH_PREP); SETUP(PH_CHUNKA); SETUP(PH_SCAN); SETUP(PH_OUT);
        SETUP(PH_GATES); SETUP(PH_MERGE1); SETUP(PH_MERGE2); SETUP(PH_ROUTER); SETUP(PH_MOEUP); SETUP(PH_MOEDOWN); SETUP(PH_FINAL);
        grid = 512;
    }
#define LAUNCH(PH, l) k_phase<PH><<<grid, NTHR, LDS_BYTES + 16, stream>>>(p, l)
    LAUNCH(PH_PRO0, 0); LAUNCH(PH_PRO1, 0);
    for (int l = 0; l < 2; ++l) {
        LAUNCH(PH_NORM1, l);
#if STAGE >= 1
        LAUNCH(PH_INPROJ, l); LAUNCH(PH_PREP, l); LAUNCH(PH_CHUNKA, l); LAUNCH(PH_SCAN, l); LAUNCH(PH_OUT, l);
        LAUNCH(PH_GATES, l); LAUNCH(PH_MERGE1, l); LAUNCH(PH_MERGE2, l);
#endif
        LAUNCH(PH_ROUTER, l); LAUNCH(PH_MOEUP, l); LAUNCH(PH_MOEDOWN, l);
    }
    LAUNCH(PH_FINAL, 0);
#else
    if (!grid) {
        hipFuncSetAttribute((const void*)k_mega, hipFuncAttributeMaxDynamicSharedMemorySize, LDS_BYTES + 16);
        int dev = 0, cus = 0, per_cu = 0;
        hipGetDevice(&dev);
        hipDeviceGetAttribute(&cus, hipDeviceAttributeMultiprocessorCount, dev);
        hipOccupancyMaxActiveBlocksPerMultiprocessor(&per_cu, (const void*)k_mega, NTHR, LDS_BYTES + 16);
        if (per_cu > 2) per_cu = 2;
        if (per_cu < 1) per_cu = 1;
        grid = cus * per_cu;
    }
    k_mega<<<grid, NTHR, LDS_BYTES + 16, stream>>>(p);
#endif
}
```

```cpp
#include <hip/hip_runtime.h>
#include <stdint.h>
#include <math.h>

typedef unsigned short u16;
typedef short bf16x8 __attribute__((ext_vector_type(8)));
typedef float f32x4 __attribute__((ext_vector_type(4)));
typedef unsigned u32x2 __attribute__((ext_vector_type(2)));
typedef unsigned u32x4 __attribute__((ext_vector_type(4)));

#define DEV __device__ __forceinline__
#define NTHR 256

#define DM 1024
#define RLAT 16384
#define RCTX 512
#define RTOT 16896
#define SEQ 8192
#define CTXL 256
#define NCM 3968
#define NGATE 4096
#define NSTEP 132
#define KPOS 8448
#define EPSF 1e-6f
#define GLA_Q 0
#define GLA_K 256
#define GLA_V 512
#define GLA_G 768
#define GLA_RF 1024
#define GLA_RB 1040
#define ML_Q 1056
#define ML_K 1312
#define ML_V 1568
#define ML_O 1824
#define ML_GF 2080
#define ML_GB 2088
#define GD_Q 2096
#define GD_K 2352
#define GD_V 2608
#define GD_OG 2864
#define GD_GF 3120
#define GD_GB 3128
#define DF_Q 3136
#define DF_K 3392
#define DF_V 3648

DEV int tidx() { int t = threadIdx.x; asm volatile("" : "+v"(t)); __builtin_assume(t >= 0 && t < NTHR); return t; }
DEV int launder_s(int v) { asm volatile("" : "+s"(v)); return v; }
typedef __bf16 bf2_t __attribute__((ext_vector_type(2)));
typedef float f2_t __attribute__((ext_vector_type(2)));
DEV unsigned pack2(float a, float b) { f2_t v; v.x = a; v.y = b; return __builtin_bit_cast(unsigned, __builtin_convertvector(v, bf2_t)); }
DEV u16 f2bf(float f) { return (u16)(pack2(f, 0.f) & 0xffffu); }
DEV float bf2f(u16 h) { return __uint_as_float(((unsigned)h) << 16); }
DEV float sigm(float x) { return 1.f / (1.f + __expf(-x)); }
DEV float silu(float x) { return x / (1.f + __expf(-x)); }
DEV float logsig(float x) { return fminf(x, 0.f) - __logf(1.f + __expf(-fabsf(x))); }
DEV float softplus(float x) { return fmaxf(x, 0.f) + __logf(1.f + __expf(-fabsf(x))); }
DEV float wsum(float v) {
#pragma unroll
    for (int o = 32; o; o >>= 1) v += __shfl_xor(v, o, 64);
    return v;
}
DEV float wmaxr(float v) {
#pragma unroll
    for (int o = 32; o; o >>= 1) v = fmaxf(v, __shfl_xor(v, o, 64));
    return v;
}
DEV f32x4 mfma16(bf16x8 a, bf16x8 b, f32x4 c) { return __builtin_amdgcn_mfma_f32_16x16x32_bf16(a, b, c, 0, 0, 0); }

#ifdef PROBE_SEL
#define PRB_BEGIN(id) unsigned long long prb_t0_##id = ((id) == PROBE_SEL) ? wall_clock64() : 0ull
#define PRB_END(id) do { if ((id) == PROBE_SEL) { __syncthreads(); if (threadIdx.x == 0) { volatile __attribute__((address_space(3))) unsigned long long* a_ = (volatile __attribute__((address_space(3))) unsigned long long*)(size_t)(75776 + 8); *a_ = *a_ + (wall_clock64() - prb_t0_##id); } } } while (0)
#else
#define PRB_BEGIN(id) do { } while (0)
#define PRB_END(id) do { } while (0)
#endif
#define RAW_BARRIER() do { asm volatile("s_waitcnt lgkmcnt(0)" ::: "memory"); __builtin_amdgcn_s_barrier(); } while (0)
struct P {
    const float *x, *c, *ctx, *c_ctx, *w_mod, *b_mod, *norm_mix, *norm_ffn, *w_in, *gla_a2, *gla_ab, *mlstm_gate_b,
        *gdn_conv, *gdn_a_log, *gdn_dt_bias, *diff_lambda, *head_norm, *w_branch, *w_out, *router_w, *router_b,
        *w_gate, *w_up, *w_down, *norm_final;
    float* out;
    unsigned* bar;
    int* cnt;
    float* modp;
    float* mod;
    float* xctx;
    float* rope;
    u16* hbuf;
    u16* ybuf;
    u16* Wt;
    u16* dq;
    u16* dk;
    u16* dvT;
    float* glaDec;
    float* mlN;
    float* mlFE;
    float* mlAE;
    float* mlM;
    u16* glaS;
    u16* mlS;
    u16* gdM;
    u16* gdN;
    u16* gdQ;
    u16* gdO;
    u16* cols;
};
#define MOE_WGU_OFF 0
#define MOE_WD_OFF (16u * 1024u * 1024u)
#define MOE_ACT_OFF (MOE_WD_OFF + 16u * 1024u * 512u)
#define MOE_LIST_OFF (MOE_ACT_OFF + 2u * RTOT * 512u)

DEV const float* xrow_in(const P& p, int l, int r) {
    if (l == 0) return r < RLAT ? p.x + (size_t)r * DM : p.ctx + (size_t)(r - RLAT) * DM;
    return r < RLAT ? p.out + (size_t)r * DM : p.xctx + (size_t)(r - RLAT) * DM;
}
DEV float* xrow_out(const P& p, int r) { return r < RLAT ? p.out + (size_t)r * DM : p.xctx + (size_t)(r - RLAT) * DM; }
DEV int modidx(int r) { return r < RLAT ? (r >> 13) : 2; }
DEV int chunk_row0(int b, int dir, int st) {
    if (st < 4) { int c = dir ? 3 - st : st; return RLAT + b * CTXL + c * 64; }
    int c = dir ? 131 - st : st - 4; return b * SEQ + c * 64;
}
DEV size_t state_idx(int dir, int b, int st, int h) { return ((size_t)((dir * 2 + b) * NSTEP + st) * 4 + h); }
#define XB_TMO      128
#define XB_XCNT(j)  (256  + 64 * (j))
#define XB_XSUB(j)  (1280 + 64 * (j))
#define XB_XGEN(j)  (2304 + 64 * (j))
#define XB_TOP      3328
#define XB_TOPGEN   3392
#define XCD_BAR_WORDS 3456
#define XB_SPIN_CAP (1u << 18)
#define LAS __attribute__((address_space(3)))

__device__ __forceinline__ unsigned xb_ld(unsigned* p)              { return __hip_atomic_load(p, __ATOMIC_RELAXED, __HIP_MEMORY_SCOPE_AGENT); }
__device__ __forceinline__ unsigned xb_add(unsigned* p, unsigned v) { return __hip_atomic_fetch_add(p, v, __ATOMIC_RELAXED, __HIP_MEMORY_SCOPE_AGENT); }
__device__ __forceinline__ unsigned xb_xcc_id() { return (unsigned)__builtin_amdgcn_s_getreg((3 << 11) | 20) & 0xFu; }
#define XB_SPIN(cond, bar) do { unsigned _sp = 0; while (cond) { __builtin_amdgcn_s_sleep(1); \
    if ((++_sp & 255u) == 0u) { if (xb_ld(&(bar)[XB_TMO])) break; if (_sp > XB_SPIN_CAP) { atomicAdd(&(bar)[XB_TMO], 1u); break; } } } } while (0)

struct XcdBarrier {
    unsigned* bar; unsigned x;
    volatile LAS unsigned* st;
};

__device__ __forceinline__ XcdBarrier xcd_barrier_post(unsigned* bar, volatile LAS unsigned* st) {
    XcdBarrier b; b.bar = bar; b.x = xb_xcc_id(); b.st = st;
    if (threadIdx.x == 0) (void)xb_add(&bar[XB_XCNT(b.x)], 1u);
    return b;
}
__device__ __forceinline__ void xcd_barrier_complete(unsigned* bar, unsigned x, unsigned& nloc, unsigned& nx) {
    const unsigned G = gridDim.x * gridDim.y * gridDim.z;
    unsigned sum, cnt, mine, sp = 0u;
    for (;;) {
        sum = 0u; cnt = 0u; mine = 0u;
#pragma unroll
        for (unsigned j = 0; j < 16; ++j) { const unsigned c = xb_ld(&bar[XB_XCNT(j)]); sum += c; cnt += (c > 0u) ? 1u : 0u; mine = (j == x) ? c : mine; }
        if (sum == G) break;
        __builtin_amdgcn_s_sleep(1);
        if ((++sp & 255u) == 0u) { if (xb_ld(&bar[XB_TMO])) break; if (sp > XB_SPIN_CAP) { atomicAdd(&bar[XB_TMO], 1u); break; } }
    }
    nloc = mine > 0u ? mine : 1u; nx = cnt > 0u ? cnt : 1u;
}

__device__ __forceinline__ void xcd_barrier(const XcdBarrier& b) {
    asm volatile("s_waitcnt vmcnt(0)" ::: "memory");
    __syncthreads();
    if (threadIdx.x == 0) {
        unsigned* bar = b.bar;
        __builtin_amdgcn_s_waitcnt(0);
        unsigned nloc = b.st[0], nx = b.st[1];
        if (nloc == 0u) { xcd_barrier_complete(bar, b.x, nloc, nx); b.st[0] = nloc; b.st[1] = nx; }
        const unsigned old = xb_add(&bar[XB_XSUB(b.x)], 1u);
        const unsigned gen = old / nloc;
        if (old + 1u == (gen + 1u) * nloc) {
            __builtin_amdgcn_fence(__ATOMIC_RELEASE, "agent");
            asm volatile("s_waitcnt vmcnt(0)" ::: "memory");
            const unsigned og = xb_add(&bar[XB_TOP], 1u);
            const unsigned tg = og / nx;
            if (og + 1u == (tg + 1u) * nx) xb_add(&bar[XB_TOPGEN], 1u);
            else XB_SPIN(xb_ld(&bar[XB_TOPGEN]) == tg, bar);
            __builtin_amdgcn_fence(__ATOMIC_ACQUIRE, "agent");
            xb_add(&bar[XB_XGEN(b.x)], 1u);
            asm volatile("s_waitcnt vmcnt(0)" ::: "memory");
        } else {
            XB_SPIN(xb_ld(&bar[XB_XGEN(b.x)]) == gen, bar);
            __builtin_amdgcn_fence(__ATOMIC_ACQUIRE, "agent");
            asm volatile("s_waitcnt vmcnt(0)" ::: "memory");
        }
    }
    __syncthreads();
}
struct TrJob { const float* src; u16* dst; int lds_, ldd, map; };
DEV int tr_rowmap(int map, int n) {
    if (map == 1) return n < 3904 ? n : n + 64;
    if (map == 2) return (n >> 5) * 64 + (n & 31);
    if (map == 3) return (n >> 5) * 64 + 32 + (n & 31);
    return n;
}
DEV void tr_load(const TrJob& j, float (&r)[16]) {
    const int t = tidx(), n = t & 63, kk = t >> 6;
#pragma unroll
    for (int i = 0; i < 16; ++i) r[i] = j.src[(size_t)(kk + 4 * i) * j.lds_ + n];
}
DEV void tr_finish(const TrJob& j, int n0, const float (&r)[16], float* sm) {
    const int t = tidx();
    {
        const int n = t & 63, kk = t >> 6;
#pragma unroll
        for (int i = 0; i < 16; ++i) sm[(kk + 4 * i) * 65 + n] = r[i];
    }
    __syncthreads();
    {
        const int kp = t & 31, nn = t >> 5;
#pragma unroll
        for (int i = 0; i < 8; ++i) {
            const int n = nn + 8 * i;
            const unsigned v = pack2(sm[(2 * kp) * 65 + n], sm[(2 * kp + 1) * 65 + n]);
            *(unsigned*)(j.dst + (size_t)tr_rowmap(j.map, n0 + n) * j.ldd + 2 * kp) = v;
        }
    }
    __syncthreads();
}
#define WT_WB_OFF (8064u * 1024u)
#define WT_WO_OFF (WT_WB_OFF + 4u * 1024u * 256u)
#define WT_TOTAL (WT_WO_OFF + 1024u * 1024u)

DEV TrJob mixw_job(const P& p, int l, int u, int& n0) {
    TrJob j;
    if (u < 2000) {
        const int kt = u / 125, nt = u % 125; n0 = nt * 64;
        j.src = p.w_in + (size_t)l * 1024 * 8000 + (size_t)kt * 64 * 8000 + n0; j.lds_ = 8000; j.dst = p.Wt + kt * 64; j.ldd = 1024; j.map = 1;
    } else if (u < 2256) {
        const int v = u - 2000, i = v >> 6, w = v & 63, kt = w >> 4, nt = w & 15; n0 = nt * 64;
        j.src = p.w_branch + (size_t)(l * 4 + i) * 256 * 1024 + (size_t)kt * 64 * 1024 + n0; j.lds_ = 1024;
        j.dst = p.Wt + WT_WB_OFF + (size_t)i * 1024 * 256 + kt * 64; j.ldd = 256; j.map = 0;
    } else {
        const int v = u - 2256, kt = v >> 4, nt = v & 15; n0 = nt * 64;
        j.src = p.w_out + (size_t)l * 1024 * 1024 + (size_t)kt * 64 * 1024 + n0; j.lds_ = 1024; j.dst = p.Wt + WT_WO_OFF + kt * 64; j.ldd = 1024; j.map = 0;
    }
    return j;
}
DEV void phase_conv_mixw(const P& p, int l, int bid, int nb, float* sm) {
    if (bid == nb - 1) {
        unsigned* z = (unsigned*)(p.Wt + (size_t)3904 * 1024);
        for (int i = tidx(); i < 64 * 1024 / 2; i += NTHR) z[i] = 0u;
    }
    int u = bid, n0 = 0, n1 = 0;
    if (u >= 2512) return;
    float r[16];
    TrJob j = mixw_job(p, l, u, n0);
    tr_load(j, r);
    for (;;) {
        const int un = u + nb;
        float rn[16]; TrJob jn = j;
        if (un < 2512) { jn = mixw_job(p, l, un, n1); tr_load(jn, rn); }
        tr_finish(j, n0, r, sm);
        if (un >= 2512) break;
        u = un; j = jn; n0 = n1;
#pragma unroll
        for (int i = 0; i < 16; ++i) r[i] = rn[i];
    }
}
DEV TrJob moew_job(const P& p, int l, int u, int& n0) {
    TrJob j;
    u16* wgu = p.cols + MOE_WGU_OFF;
    u16* wd = p.cols + MOE_WD_OFF;
    const int e = u / 384, v = u % 384;
    const size_t le = (size_t)(l * 16 + e);
    if (v < 256) {
        const int w = v & 127, kt = w >> 3, nt = w & 7; n0 = nt * 64;
        j.src = (v < 128 ? p.w_gate : p.w_up) + le * 1024 * 512 + (size_t)kt * 64 * 512 + n0; j.lds_ = 512;
        j.dst = wgu + (size_t)e * 1024 * 1024 + kt * 64; j.ldd = 1024; j.map = v < 128 ? 2 : 3;
    } else {
        const int w = v - 256, kt = w >> 4, nt = w & 15; n0 = nt * 64;
        j.src = p.w_down + le * 512 * 1024 + (size_t)kt * 64 * 1024 + n0; j.lds_ = 1024; j.dst = wd + (size_t)e * 1024 * 512 + kt * 64; j.ldd = 512; j.map = 0;
    }
    return j;
}
DEV void phase_conv_moew(const P& p, int l, int bid, int nb, float* sm) {
    int u = bid, n0 = 0, n1 = 0;
    if (u >= 16 * 384) return;
    float r[16];
    TrJob j = moew_job(p, l, u, n0);
    tr_load(j, r);
    for (;;) {
        const int un = u + nb;
        float rn[16]; TrJob jn = j;
        if (un < 16 * 384) { jn = moew_job(p, l, un, n1); tr_load(jn, rn); }
        tr_finish(j, n0, r, sm);
        if (un >= 16 * 384) break;
        u = un; j = jn; n0 = n1;
#pragma unroll
        for (int i = 0; i < 16; ++i) r[i] = rn[i];
    }
}

DEV void phase_mod_partial(const P& p, int bid, int nb, float* sm) {
    for (int u = bid; u < 768; u += nb) {
        const int l = u / 384, v = u % 384, kc = v / 24, jb = v % 24;
        const int t = tidx();
        __syncthreads();
        if (t < 192) {
            const int m = t >> 6, k = kc * 64 + (t & 63);
            const float cv = m < 2 ? p.c[m * 1024 + k] : p.c_ctx[k];
            sm[t] = silu(cv);
        }
        __syncthreads();
        const int j = jb * 256 + t;
        const float* w = p.w_mod + ((size_t)l * 1024 + kc * 64) * 6144 + j;
        float a0 = 0.f, a1 = 0.f, a2 = 0.f;
#pragma unroll 8
        for (int k = 0; k < 64; ++k) {
            const float wv = w[(size_t)k * 6144];
            a0 += sm[k] * wv; a1 += sm[64 + k] * wv; a2 += sm[128 + k] * wv;
        }
        float* o = p.modp + ((size_t)(l * 16 + kc) * 3) * 6144 + j;
        o[0] = a0; o[6144] = a1; o[2 * 6144] = a2;
    }
}
DEV void phase_mod_reduce(const P& p, int bid, int nb) {
    for (int i = bid * NTHR + tidx(); i < 2 * 3 * 6144; i += nb * NTHR) {
        const int l = i / (3 * 6144), r = i % (3 * 6144), m = r / 6144, j = r % 6144;
        float a = p.b_mod[l * 6144 + j];
        for (int kc = 0; kc < 16; ++kc) a += p.modp[((size_t)(l * 16 + kc) * 3 + m) * 6144 + j];
        p.mod[i] = a;
    }
}

DEV void moe_combine_row(const P& p, int l, int r, int lane, float4 (&v)[4]);
DEV void phase_norm1(const P& p, int l, int bid, int nb) {
    const int lane = tidx() & 63, w = tidx() >> 6;
    for (int r = bid * 4 + w; r < RTOT; r += nb * 4) {
        const float* xr = xrow_in(p, l, r);
        const int m = modidx(r);
        const float* sh = p.mod + ((size_t)(l * 3 + m)) * 6144;
        const float* sc = sh + 1024;
        float4 v[4]; float ss = 0.f;
#pragma unroll
        for (int i = 0; i < 4; ++i) v[i] = *(const float4*)(xr + lane * 4 + i * 256);
        if (l == 1) {
            moe_combine_row(p, 0, r, lane, v);
            float* xw = xrow_out(p, r);
#pragma unroll
            for (int i = 0; i < 4; ++i) *(float4*)(xw + lane * 4 + i * 256) = v[i];
        }
#pragma unroll
        for (int i = 0; i < 4; ++i) ss += v[i].x * v[i].x + v[i].y * v[i].y + v[i].z * v[i].z + v[i].w * v[i].w;
        ss = wsum(ss);
        const float rs = rsqrtf(ss * (1.f / 1024.f) + EPSF);
#pragma unroll
        for (int i = 0; i < 4; ++i) {
            const int c = lane * 4 + i * 256;
            const float4 g = *(const float4*)(p.norm_mix + l * 1024 + c);
            const float4 s1 = *(const float4*)(sc + c);
            const float4 h1 = *(const float4*)(sh + c);
            const float o0 = v[i].x * rs * g.x * (1.f + s1.x) + h1.x;
            const float o1 = v[i].y * rs * g.y * (1.f + s1.y) + h1.y;
            const float o2 = v[i].z * rs * g.z * (1.f + s1.z) + h1.z;
            const float o3 = v[i].w * rs * g.w * (1.f + s1.w) + h1.w;
            u32x2 pk; pk.x = pack2(o0, o1); pk.y = pack2(o2, o3);
            *(u32x2*)(p.hbuf + (size_t)r * 1024 + c) = pk;
        }
    }
}

#define LDP 72
#define GEMM_SMEM_BYTES (2 * 128 * LDP * 2)
DEV void gemm_mainloop(f32x4 (&acc)[4][4], const u16* const (&xp)[4], const u16* const (&wp)[4], int KT, u16* sX, u16* sW) {
    const int tid = tidx(), lane = tid & 63, w = tid >> 6, wn = w & 1, wm = w >> 1;
    const int fr = lane & 15, fq = lane >> 4;
    bf16x8 rx[4], rw[4];
#pragma unroll
    for (int i = 0; i < 4; ++i) { rx[i] = *(const bf16x8*)(xp[i]); rw[i] = *(const bf16x8*)(wp[i]); }
    const int so = (tid >> 3) * LDP + (tid & 7) * 8;
    for (int kt = 0; kt < KT; ++kt) {
#pragma unroll
        for (int i = 0; i < 4; ++i) {
            *(bf16x8*)(sX + so + i * 32 * LDP) = rx[i];
            *(bf16x8*)(sW + so + i * 32 * LDP) = rw[i];
        }
        __syncthreads();
        if (kt + 1 < KT) {
#pragma unroll
            for (int i = 0; i < 4; ++i) { rx[i] = *(const bf16x8*)(xp[i] + (kt + 1) * 64); rw[i] = *(const bf16x8*)(wp[i] + (kt + 1) * 64); }
        }
#pragma unroll
        for (int ks = 0; ks < 2; ++ks) {
            bf16x8 a[4], b[4];
#pragma unroll
            for (int q = 0; q < 4; ++q) {
                a[q] = *(const bf16x8*)(sW + (wn * 64 + q * 16 + fr) * LDP + ks * 32 + fq * 8);
                b[q] = *(const bf16x8*)(sX + (wm * 64 + q * 16 + fr) * LDP + ks * 32 + fq * 8);
            }
#pragma unroll
            for (int nt = 0; nt < 4; ++nt)
#pragma unroll
                for (int mt = 0; mt < 4; ++mt) acc[nt][mt] = mfma16(a[nt], b[mt], acc[nt][mt]);
        }
        __syncthreads();
    }
}
DEV void zero_acc(f32x4 (&acc)[4][4]) {
#pragma unroll
    for (int a = 0; a < 4; ++a)
#pragma unroll
        for (int b = 0; b < 4; ++b) acc[a][b] = f32x4{0.f, 0.f, 0.f, 0.f};
}

template <bool SIG>
DEV void phase_inproj(const P& p, int wrow0, int ntn, int ldc, int mtiles, int bid, int nb, u16* sm) {
    u16* sX = sm; u16* sW = sm + 128 * LDP;
    const int tid = tidx(), lane = tid & 63, w = tid >> 6, wn = w & 1, wm = w >> 1, fr = lane & 15, fq = lane >> 4;
    for (int u = bid; u < mtiles * ntn; u += nb) {
        const int mt_ = u / ntn, nt_ = u % ntn;
        const int m0 = mt_ * 128, n0 = nt_ * 128;
        const u16* xp[4]; const u16* wp[4];
#pragma unroll
        for (int i = 0; i < 4; ++i) {
            const int row = (tid >> 3) + 32 * i, kc = (tid & 7) * 8;
            xp[i] = p.hbuf + (size_t)(m0 + row) * 1024 + kc;
            wp[i] = p.Wt + (size_t)(wrow0 + n0 + row) * 1024 + kc;
        }
        f32x4 acc[4][4]; zero_acc(acc);
        gemm_mainloop(acc, xp, wp, 16, sX, sW);
#pragma unroll
        for (int nt = 0; nt < 4; ++nt)
#pragma unroll
            for (int mt = 0; mt < 4; ++mt) {
                const int n = n0 + wn * 64 + nt * 16 + fq * 4, m = m0 + wm * 64 + mt * 16 + fr;
                f32x4 v = acc[nt][mt];
                if (SIG) { v[0] = sigm(v[0]); v[1] = sigm(v[1]); v[2] = sigm(v[2]); v[3] = sigm(v[3]); }
                u32x2 pk; pk.x = pack2(v[0], v[1]); pk.y = pack2(v[2], v[3]);
                *(u32x2*)(p.cols + (size_t)m * ldc + n) = pk;
            }
    }
}

DEV void phase_merge1(const P& p, u16* ubuf, int mtiles, int bid, int nb, u16* sm) {
    u16* sX = sm; u16* sW = sm + 128 * LDP;
    const int tid = tidx(), lane = tid & 63, w = tid >> 6, wn = w & 1, wm = w >> 1, fr = lane & 15, fq = lane >> 4;
    for (int u = bid; u < mtiles * 8; u += nb) {
        const int mt_ = u >> 3, nt_ = u & 7;
        const int m0 = mt_ * 128, n0 = nt_ * 128;
        f32x4 tot[4][4]; zero_acc(tot);
        for (int br = 0; br < 4; ++br) {
            const u16* xp[4]; const u16* wp[4];
#pragma unroll
            for (int i = 0; i < 4; ++i) {
                const int row = (tid >> 3) + 32 * i, kc = (tid & 7) * 8;
                xp[i] = p.ybuf + (size_t)(m0 + row) * 1024 + br * 256 + kc;
                wp[i] = p.Wt + WT_WB_OFF + ((size_t)br * 1024 + n0 + row) * 256 + kc;
            }
            f32x4 acc[4][4]; zero_acc(acc);
            gemm_mainloop(acc, xp, wp, 4, sX, sW);
#pragma unroll
            for (int nt = 0; nt < 4; ++nt)
#pragma unroll
                for (int mt = 0; mt < 4; ++mt) {
                    const int n = n0 + wn * 64 + nt * 16 + fq * 4, m = m0 + wm * 64 + mt * 16 + fr;
                    const u32x2 g = *(const u32x2*)(p.cols + (size_t)m * NGATE + br * 1024 + n);
                    tot[nt][mt][0] += bf2f((u16)(g.x & 0xffff)) * acc[nt][mt][0];
                    tot[nt][mt][1] += bf2f((u16)(g.x >> 16)) * acc[nt][mt][1];
                    tot[nt][mt][2] += bf2f((u16)(g.y & 0xffff)) * acc[nt][mt][2];
                    tot[nt][mt][3] += bf2f((u16)(g.y >> 16)) * acc[nt][mt][3];
                }
        }
#pragma unroll
        for (int nt = 0; nt < 4; ++nt)
#pragma unroll
            for (int mt = 0; mt < 4; ++mt) {
                const int n = n0 + wn * 64 + nt * 16 + fq * 4, m = m0 + wm * 64 + mt * 16 + fr;
                u32x2 pk; pk.x = pack2(tot[nt][mt][0], tot[nt][mt][1]); pk.y = pack2(tot[nt][mt][2], tot[nt][mt][3]);
                *(u32x2*)(ubuf + (size_t)m * 1024 + n) = pk;
            }
    }
}

DEV void phase_merge2(const P& p, int l, const u16* ubuf, int mtiles, int bid, int nb, u16* sm) {
    u16* sX = sm; u16* sW = sm + 128 * LDP;
    const int tid = tidx(), lane = tid & 63, w = tid >> 6, wn = w & 1, wm = w >> 1, fr = lane & 15, fq = lane >> 4;
    for (int u = bid; u < mtiles * 8; u += nb) {
        const int mt_ = u >> 3, nt_ = u & 7;
        const int m0 = mt_ * 128, n0 = nt_ * 128;
        const u16* xp[4]; const u16* wp[4];
#pragma unroll
        for (int i = 0; i < 4; ++i) {
            const int row = (tid >> 3) + 32 * i, kc = (tid & 7) * 8;
            xp[i] = ubuf + (size_t)(m0 + row) * 1024 + kc;
            wp[i] = p.Wt + WT_WO_OFF + (size_t)(n0 + row) * 1024 + kc;
        }
        f32x4 acc[4][4]; zero_acc(acc);
        gemm_mainloop(acc, xp, wp, 16, sX, sW);
#pragma unroll
        for (int nt = 0; nt < 4; ++nt)
#pragma unroll
            for (int mt = 0; mt < 4; ++mt) {
                const int n = n0 + wn * 64 + nt * 16 + fq * 4, m = m0 + wm * 64 + mt * 16 + fr;
                const float4 xo = *(const float4*)(xrow_in(p, l, m) + n);
                const float4 g = *(const float4*)(p.mod + (size_t)(l * 3 + modidx(m)) * 6144 + 2048 + n);
                float4 o;
                o.x = xo.x + g.x * acc[nt][mt][0]; o.y = xo.y + g.y * acc[nt][mt][1];
                o.z = xo.z + g.z * acc[nt][mt][2]; o.w = xo.w + g.w * acc[nt][mt][3];
                *(float4*)(xrow_out(p, m) + n) = o;
            }
    }
}
DEV void phase_norm2_router(const P& p, int l, int nrows, int bid, int nb, float* sm) {
    const int tid = tidx(), lane = tid & 63, w = tid >> 6;
    int* list = (int*)(p.cols + MOE_LIST_OFF);
    float* slotw = (float*)(list + 16 * RTOT);
    int* tokslot = (int*)(slotw + 16 * RTOT);
    float* tokw = (float*)(tokslot + 2 * RTOT);
    int* lcnt = (int*)(sm + 16 * 1024);
    int* rinfo = lcnt + 32;
    float* rwgt = (float*)(rinfo + 4 * 40 * 2);
#pragma unroll 16
    for (int i = tid; i < 16 * 1024; i += NTHR) { const int c = i >> 4, e = i & 15; sm[e * 1024 + c] = p.router_w[i]; }
    if (tid < 32) lcnt[tid] = 0;
    __syncthreads();
    int kk = 0;
    for (int r = bid * 4 + w; r < nrows; r += nb * 4, ++kk) {
        const float* xr = xrow_out(p, r);
        const int m = modidx(r);
        const float* sh = p.mod + ((size_t)(l * 3 + m)) * 6144 + 3072;
        const float* sc = sh + 1024;
        float4 v[4]; float ss = 0.f;
#pragma unroll
        for (int i = 0; i < 4; ++i) {
            v[i] = *(const float4*)(xr + lane * 4 + i * 256);
            ss += v[i].x * v[i].x + v[i].y * v[i].y + v[i].z * v[i].z + v[i].w * v[i].w;
        }
        ss = wsum(ss);
        const float rs = rsqrtf(ss * (1.f / 1024.f) + EPSF);
#pragma unroll
        for (int i = 0; i < 4; ++i) {
            const int c = lane * 4 + i * 256;
            const float4 g = *(const float4*)(p.norm_ffn + l * 1024 + c);
            const float4 s1 = *(const float4*)(sc + c);
            const float4 h1 = *(const float4*)(sh + c);
            v[i].x = v[i].x * rs * g.x * (1.f + s1.x) + h1.x;
            v[i].y = v[i].y * rs * g.y * (1.f + s1.y) + h1.y;
            v[i].z = v[i].z * rs * g.z * (1.f + s1.z) + h1.z;
            v[i].w = v[i].w * rs * g.w * (1.f + s1.w) + h1.w;
            u32x2 pk; pk.x = pack2(v[i].x, v[i].y); pk.y = pack2(v[i].z, v[i].w);
            *(u32x2*)(p.hbuf + (size_t)r * 1024 + c) = pk;
        }
        float sel[16], scr[16];
#pragma unroll
        for (int e = 0; e < 16; ++e) scr[e] = 0.f;
#pragma unroll
        for (int i = 0; i < 4; ++i) {
#pragma unroll
            for (int e = 0; e < 16; ++e) {
                const float4 rw = *(const float4*)(sm + e * 1024 + lane * 4 + i * 256);
                scr[e] += v[i].x * rw.x + v[i].y * rw.y + v[i].z * rw.z + v[i].w * rw.w;
            }
            __builtin_amdgcn_sched_barrier(0);
        }
#pragma unroll
        for (int e = 0; e < 16; ++e) {
            const float a = wsum(scr[e]);
            scr[e] = sigm(a);
            sel[e] = scr[e] + p.router_b[e];
        }
        int bg = 0; float bgs = -INFINITY;
#pragma unroll
        for (int g = 0; g < 4; ++g) {
            float m1 = -INFINITY, m2 = -INFINITY;
#pragma unroll
            for (int j = 0; j < 4; ++j) {
                const float s = sel[g * 4 + j];
                if (s > m1) { m2 = m1; m1 = s; } else if (s > m2) { m2 = s; }
            }
            const float gs = m1 + m2;
            if (gs > bgs) { bgs = gs; bg = g; }
        }
        float gsel[4], gscr[4];
#pragma unroll
        for (int j = 0; j < 4; ++j) { gsel[j] = -INFINITY; gscr[j] = 0.f; }
#pragma unroll
        for (int g = 0; g < 4; ++g)
#pragma unroll
            for (int j = 0; j < 4; ++j) if (bg == g) { gsel[j] = sel[g * 4 + j]; gscr[j] = scr[g * 4 + j]; }
        int j1 = 0; float v1 = gsel[0], w1 = gscr[0];
#pragma unroll
        for (int j = 1; j < 4; ++j) if (gsel[j] > v1) { v1 = gsel[j]; w1 = gscr[j]; j1 = j; }
        int j2 = -1; float v2 = -INFINITY, w2 = 0.f;
#pragma unroll
        for (int j = 0; j < 4; ++j) if (j != j1 && (j2 < 0 || gsel[j] > v2)) { v2 = gsel[j]; w2 = gscr[j]; j2 = j; }
        const float inv = 1.f / (w1 + w2);
        if (lane == 0) {
            const int e1 = bg * 4 + j1, e2 = bg * 4 + j2;
            const int p1 = atomicAdd(lcnt + e1, 1);
            const int p2 = atomicAdd(lcnt + e2, 1);
            rinfo[(w * 40 + kk) * 2 + 0] = e1 * 65536 + p1; rwgt[(w * 40 + kk) * 2 + 0] = w1 * inv;
            rinfo[(w * 40 + kk) * 2 + 1] = e2 * 65536 + p2; rwgt[(w * 40 + kk) * 2 + 1] = w2 * inv;
        }
    }
    __syncthreads();
    if (tid < 16) lcnt[16 + tid] = lcnt[tid] ? atomicAdd(p.cnt + l * 16 + tid, lcnt[tid]) : 0;
    __syncthreads();
    if (lane < 2) {
        int k2 = 0;
        for (int r = bid * 4 + w; r < nrows; r += nb * 4, ++k2) {
            const int inf = rinfo[(w * 40 + k2) * 2 + lane], e = inf >> 16, slot = lcnt[16 + e] + (inf & 65535);
            const float wg = rwgt[(w * 40 + k2) * 2 + lane];
            list[e * RTOT + slot] = r; slotw[e * RTOT + slot] = wg;
            tokslot[r * 2 + lane] = e * RTOT + slot; tokw[r * 2 + lane] = wg;
        }
    }
    __syncthreads();
}

DEV bool moe_find(const int* cnt, int ut, int& e, int& mt, int& off, int& ce) {
    int tb = 0, o = 0;
    for (int k = 0; k < 16; ++k) {
        const int c = cnt[k], nt = (c + 127) >> 7;
        if (ut < tb + nt) { e = k; mt = ut - tb; off = o; ce = c; return true; }
        tb += nt; o += c;
    }
    return false;
}

DEV void phase_moe_up(const P& p, int l, int bid, int nb, u16* sm) {
    u16* sX = sm; u16* sW = sm + 128 * LDP;
    const int tid = tidx(), lane = tid & 63, w = tid >> 6, wn = w & 1, wm = w >> 1, fr = lane & 15, fq = lane >> 4;
    const int* cnt = p.cnt + l * 16;
    const int* list = (const int*)(p.cols + MOE_LIST_OFF);
    const u16* wgu = p.cols + MOE_WGU_OFF;
    u16* act = p.cols + MOE_ACT_OFF;
    for (int u = bid;; u += nb) {
        int e, mtile, off, ce;
        if (!moe_find(cnt, u >> 3, e, mtile, off, ce)) break;
        const int n0 = (u & 7) * 128;
        const u16* xp[4]; const u16* wp[4];
#pragma unroll
        for (int i = 0; i < 4; ++i) {
            const int row = (tid >> 3) + 32 * i, kc = (tid & 7) * 8;
            int s = mtile * 128 + row; s = s < ce ? s : ce - 1;
            const int tok = list[e * RTOT + s];
            xp[i] = p.hbuf + (size_t)tok * 1024 + kc;
            wp[i] = wgu + ((size_t)e * 1024 + n0 + row) * 1024 + kc;
        }
        f32x4 acc[4][4]; zero_acc(acc);
        gemm_mainloop(acc, xp, wp, 16, sX, sW);
#pragma unroll
        for (int nt = 0; nt < 2; ++nt)
#pragma unroll
            for (int mt = 0; mt < 4; ++mt) {
                const int col = ((n0 >> 6) + wn) * 32 + nt * 16 + fq * 4;
                const int s = mtile * 128 + wm * 64 + mt * 16 + fr;
                if (s < ce) {
                    const f32x4 g = acc[nt][mt], uu = acc[nt + 2][mt];
                    u32x2 pk; pk.x = pack2(silu(g[0]) * uu[0], silu(g[1]) * uu[1]); pk.y = pack2(silu(g[2]) * uu[2], silu(g[3]) * uu[3]);
                    *(u32x2*)(act + (size_t)(off + s) * 512 + col) = pk;
                }
            }
    }
}

DEV void phase_moe_down(const P& p, int l, int bid, int nb, u16* sm) {
    u16* sX = sm; u16* sW = sm + 128 * LDP;
    const int tid = tidx(), lane = tid & 63, w = tid >> 6, wn = w & 1, wm = w >> 1, fr = lane & 15, fq = lane >> 4;
    const int* cnt = p.cnt + l * 16;
    const int* list = (const int*)(p.cols + MOE_LIST_OFF);
    u16* yslot = p.glaS;
    const u16* wd = p.cols + MOE_WD_OFF;
    const u16* act = p.cols + MOE_ACT_OFF;
    for (int u = bid;; u += nb) {
        int e, mtile, off, ce;
        if (!moe_find(cnt, u >> 3, e, mtile, off, ce)) break;
        const int n0 = (u & 7) * 128;
        const u16* xp[4]; const u16* wp[4];
#pragma unroll
        for (int i = 0; i < 4; ++i) {
            const int row = (tid >> 3) + 32 * i, kc = (tid & 7) * 8;
            int s = mtile * 128 + row; s = s < ce ? s : ce - 1;
            xp[i] = act + (size_t)(off + s) * 512 + kc;
            wp[i] = wd + ((size_t)e * 1024 + n0 + row) * 512 + kc;
        }
        f32x4 acc[4][4]; zero_acc(acc);
        gemm_mainloop(acc, xp, wp, 8, sX, sW);
#pragma unroll
        for (int mt = 0; mt < 4; ++mt) {
            const int s = mtile * 128 + wm * 64 + mt * 16 + fr;
            if (s < ce) {
#pragma unroll
                for (int nt = 0; nt < 4; ++nt) {
                    const int n = n0 + wn * 64 + nt * 16 + fq * 4;
                    u32x2 pk; pk.x = pack2(acc[nt][mt][0], acc[nt][mt][1]); pk.y = pack2(acc[nt][mt][2], acc[nt][mt][3]);
                    *(u32x2*)(yslot + (size_t)(off + s) * 1024 + n) = pk;
                }
            }
        }
    }
}

DEV void moe_combine_row(const P& p, int l, int r, int lane, float4 (&v)[4]) {
    const int* cnt = p.cnt + l * 16;
    const int* list = (const int*)(p.cols + MOE_LIST_OFF);
    const int* tokslot = (const int*)((const float*)(list + 16 * RTOT) + 16 * RTOT);
    const float* tokw = (const float*)(tokslot + 2 * RTOT);
    const u16* yslot = p.glaS;
    const float* g2 = p.mod + (size_t)(l * 3 + modidx(r)) * 6144 + 5120;
#pragma unroll
    for (int j = 0; j < 2; ++j) {
        const int ts = tokslot[r * 2 + j], e = ts / RTOT, slot = ts % RTOT;
        const float wg = tokw[r * 2 + j];
        int off = 0;
        for (int k = 0; k < e; ++k) off += cnt[k];
        const u16* yr = yslot + (size_t)(off + slot) * 1024;
#pragma unroll
        for (int i = 0; i < 4; ++i) {
            const int c = lane * 4 + i * 256;
            const u32x2 yv = *(const u32x2*)(yr + c);
            const float4 g = *(const float4*)(g2 + c);
            v[i].x += g.x * wg * __uint_as_float(yv.x << 16); v[i].y += g.y * wg * __uint_as_float(yv.x & 0xffff0000u);
            v[i].z += g.z * wg * __uint_as_float(yv.y << 16); v[i].w += g.w * wg * __uint_as_float(yv.y & 0xffff0000u);
        }
    }
}

DEV void phase_final_norm(const P& p, int bid, int nb) {
    const int lane = tidx() & 63, w = tidx() >> 6;
    for (int r = bid * 4 + w; r < RLAT; r += nb * 4) {
        float* xr = p.out + (size_t)r * DM;
        float4 v[4]; float ss = 0.f;
#pragma unroll
        for (int i = 0; i < 4; ++i) v[i] = *(const float4*)(xr + lane * 4 + i * 256);
        moe_combine_row(p, 1, r, lane, v);
#pragma unroll
        for (int i = 0; i < 4; ++i) ss += v[i].x * v[i].x + v[i].y * v[i].y + v[i].z * v[i].z + v[i].w * v[i].w;
        ss = wsum(ss);
        const float rs = rsqrtf(ss * (1.f / 1024.f) + EPSF);
#pragma unroll
        for (int i = 0; i < 4; ++i) {
            const int c = lane * 4 + i * 256;
            const float4 g = *(const float4*)(p.norm_final + c);
            float4 o; o.x = v[i].x * rs * g.x; o.y = v[i].y * rs * g.y; o.z = v[i].z * rs * g.z; o.w = v[i].w * rs * g.w;
            *(float4*)(xr + c) = o;
        }
    }
}
DEV float wscan_add(float v, int lane) {
#pragma unroll
    for (int o = 1; o < 64; o <<= 1) { const float t = __shfl_up(v, o, 64); if (lane >= o) v += t; }
    return v;
}
DEV float wscan_max(float v, int lane) {
#pragma unroll
    for (int o = 1; o < 64; o <<= 1) { const float t = __shfl_up(v, o, 64); if (lane >= o) v = fmaxf(v, t); }
    return v;
}
DEV void mm64(f32x4 (&acc)[4], const u16* A, int lda, const u16* Bt, int ldb) {
    const int lane = tidx() & 63, w = tidx() >> 6, fr = lane & 15, fq = lane >> 4;
#pragma unroll
    for (int ks = 0; ks < 2; ++ks) {
        const bf16x8 a = *(const bf16x8*)(A + (16 * w + fr) * lda + ks * 32 + fq * 8);
#pragma unroll
        for (int nt = 0; nt < 4; ++nt) {
            const bf16x8 b = *(const bf16x8*)(Bt + (nt * 16 + fr) * ldb + ks * 32 + fq * 8);
            acc[nt] = mfma16(a, b, acc[nt]);
        }
    }
}
DEV void zero4(f32x4 (&acc)[4]) {
#pragma unroll
    for (int i = 0; i < 4; ++i) acc[i] = f32x4{0.f, 0.f, 0.f, 0.f};
}
DEV void ld16bf(const u16* p, float (&o)[16]) {
    const u32x4 a = *(const u32x4*)p, b = *(const u32x4*)(p + 8);
    const unsigned w[8] = {a.x, a.y, a.z, a.w, b.x, b.y, b.z, b.w};
#pragma unroll
    for (int i = 0; i < 8; ++i) { o[2 * i] = __uint_as_float(w[i] << 16); o[2 * i + 1] = __uint_as_float(w[i] & 0xffff0000u); }
}
DEV void st16bf(u16* p, const float (&v)[16]) {
    u32x4 a, b;
    a.x = pack2(v[0], v[1]); a.y = pack2(v[2], v[3]); a.z = pack2(v[4], v[5]); a.w = pack2(v[6], v[7]);
    b.x = pack2(v[8], v[9]); b.y = pack2(v[10], v[11]); b.z = pack2(v[12], v[13]); b.w = pack2(v[14], v[15]);
    *(u32x4*)p = a; *(u32x4*)(p + 8) = b;
}

DEV void phase_rope_table(const P& p, int bid, int nb) {
    for (int i = bid * NTHR + tidx(); i < 192 * 8; i += nb * NTHR) {
        const int e = i >> 3, f = i & 7;
        const float inv = expf(-(float)(2 * f) * (1.f / 16.f) * 9.210340371976184f);
        const float pos = (float)(e < 128 ? e : e - 128);
        const float ang = pos * inv;
        p.rope[2 * i] = cosf(ang); p.rope[2 * i + 1] = sinf(ang);
    }
}
DEV void phase_prep(const P& p, int l, u16* gqkv, int bid, int nb, u16* sm) {
    const int tid = tidx();
    for (int g = bid; g < 264; g += nb) {
        int b, t0, r0, T, pos0;
        if (g < 256) { b = g >> 7; t0 = (g & 127) * 64; r0 = b * SEQ + t0; T = SEQ; pos0 = CTXL + t0; }
        else { const int q = g - 256; b = q >> 2; t0 = (q & 3) * 64; r0 = RLAT + b * CTXL + t0; T = CTXL; pos0 = t0; }
        for (int k = 0; k < 24; ++k) {
            const int id = tid + 256 * k, cg = id % 96, s = id / 96, r = r0 + s, t = t0 + s;
            float a[8];
#pragma unroll
            for (int i = 0; i < 8; ++i) a[i] = 0.f;
#pragma unroll
            for (int j = 0; j < 5; ++j) {
                const int tt = t + j - 2;
                if (tt >= 0 && tt < T) {
                    const u32x4 xv = *(const u32x4*)(p.cols + (size_t)(r + j - 2) * NCM + GD_Q + cg * 8);
                    const float4 w0 = *(const float4*)(p.gdn_conv + (l * 5 + j) * 768 + cg * 8);
                    const float4 w1 = *(const float4*)(p.gdn_conv + (l * 5 + j) * 768 + cg * 8 + 4);
                    a[0] += __uint_as_float(xv.x << 16) * w0.x; a[1] += __uint_as_float(xv.x & 0xffff0000u) * w0.y;
                    a[2] += __uint_as_float(xv.y << 16) * w0.z; a[3] += __uint_as_float(xv.y & 0xffff0000u) * w0.w;
                    a[4] += __uint_as_float(xv.z << 16) * w1.x; a[5] += __uint_as_float(xv.z & 0xffff0000u) * w1.y;
                    a[6] += __uint_as_float(xv.w << 16) * w1.z; a[7] += __uint_as_float(xv.w & 0xffff0000u) * w1.w;
                }
            }
            float ss = 0.f;
#pragma unroll
            for (int i = 0; i < 8; ++i) { a[i] = silu(a[i]); ss += a[i] * a[i]; }
            ss += __shfl_xor(ss, 1, 64); ss += __shfl_xor(ss, 2, 64); ss += __shfl_xor(ss, 4, 64);
            float sc = 1.f;
            if (cg < 64) sc = rsqrtf(ss + EPSF) * (cg < 32 ? 0.125f : 1.f);
            u32x4 o;
            o.x = pack2(a[0] * sc, a[1] * sc); o.y = pack2(a[2] * sc, a[3] * sc); o.z = pack2(a[4] * sc, a[5] * sc); o.w = pack2(a[6] * sc, a[7] * sc);
            *(u32x4*)(gqkv + (size_t)r * 768 + cg * 8) = o;
        }
        for (int k = 0; k < 8; ++k) {
            const int id = tid + 256 * k, c = id & 1, half = (id >> 1) & 1, h = (id >> 2) & 3, qk = (id >> 4) & 1, s = id >> 5;
            const int r = r0 + s, t = t0 + s;
            const u16* src = p.cols + (size_t)r * NCM + (qk ? DF_K : DF_Q) + h * 64 + half * 32 + c * 8;
            const u32x4 v1 = *(const u32x4*)src, v2 = *(const u32x4*)(src + 16);
            const unsigned w1[4] = {v1.x, v1.y, v1.z, v1.w}, w2[4] = {v2.x, v2.y, v2.z, v2.w};
            float x1[8], x2[8], o1[8], o2[8];
#pragma unroll
            for (int i = 0; i < 4; ++i) {
                x1[2 * i] = __uint_as_float(w1[i] << 16); x1[2 * i + 1] = __uint_as_float(w1[i] & 0xffff0000u);
                x2[2 * i] = __uint_as_float(w2[i] << 16); x2[2 * i + 1] = __uint_as_float(w2[i] & 0xffff0000u);
            }
            const float qs = qk ? 1.f : (0.17677669529663687f * 1.4426950408889634f);
            if (g < 256) {
                const float* tb = p.rope + (size_t)(c == 0 ? (t >> 6) : 128 + (t & 63)) * 16;
#pragma unroll
                for (int i = 0; i < 8; ++i) {
                    const float cs = tb[2 * i], sn = tb[2 * i + 1];
                    o1[i] = (x1[i] * cs - x2[i] * sn) * qs; o2[i] = (x1[i] * sn + x2[i] * cs) * qs;
                }
            } else {
#pragma unroll
                for (int i = 0; i < 8; ++i) { o1[i] = x1[i] * qs; o2[i] = x2[i] * qs; }
            }
            u16* dst = (qk ? p.dk : p.dq) + ((size_t)(b * 4 + h) * KPOS + pos0 + s) * 64 + half * 32 + c * 8;
            u32x4 a1, a2;
            a1.x = pack2(o1[0], o1[1]); a1.y = pack2(o1[2], o1[3]); a1.z = pack2(o1[4], o1[5]); a1.w = pack2(o1[6], o1[7]);
            a2.x = pack2(o2[0], o2[1]); a2.y = pack2(o2[2], o2[3]); a2.z = pack2(o2[4], o2[5]); a2.w = pack2(o2[6], o2[7]);
            *(u32x4*)dst = a1; *(u32x4*)(dst + 16) = a2;
        }
        for (int h = 0; h < 4; ++h) {
            __syncthreads();
            {
                const int s = tid >> 2, dg = tid & 3;
                const u32x4 a = *(const u32x4*)(p.cols + (size_t)(r0 + s) * NCM + DF_V + h * 64 + dg * 16);
                const u32x4 c = *(const u32x4*)(p.cols + (size_t)(r0 + s) * NCM + DF_V + h * 64 + dg * 16 + 8);
                const unsigned wv[8] = {a.x, a.y, a.z, a.w, c.x, c.y, c.z, c.w};
#pragma unroll
                for (int k = 0; k < 8; ++k) {
                    sm[(dg * 16 + 2 * k) * 72 + s] = (u16)(wv[k] & 0xffff);
                    sm[(dg * 16 + 2 * k + 1) * 72 + s] = (u16)(wv[k] >> 16);
                }
            }
            __syncthreads();
            {
                const int dv = tid >> 2, sg = tid & 3;
                const u32x4 a = *(const u32x4*)(sm + dv * 72 + sg * 16);
                const u32x4 c = *(const u32x4*)(sm + dv * 72 + sg * 16 + 8);
                u16* o = p.dvT + ((size_t)(b * 4 + h) * 64 + dv) * KPOS + pos0 + sg * 16;
                *(u32x4*)o = a; *(u32x4*)(o + 8) = c;
            }
        }
        __syncthreads();
    }
}
#define TILE_B (64 * LDP * 2)

DEV void gla_cum(const P& p, int l, int dir, int h, int row0, float* cum, float* rt, float* sg) {
    const int tid = tidx();
    {
        const int s = tid >> 2, q4 = tid & 3, row = row0 + (dir ? 63 - s : s);
        const u32x2 v = *(const u32x2*)(p.cols + (size_t)row * NCM + GLA_RF + dir * 16 + q4 * 4);
        rt[s * 17 + q4 * 4 + 0] = __uint_as_float(v.x << 16); rt[s * 17 + q4 * 4 + 1] = __uint_as_float(v.x & 0xffff0000u);
        rt[s * 17 + q4 * 4 + 2] = __uint_as_float(v.y << 16); rt[s * 17 + q4 * 4 + 3] = __uint_as_float(v.y & 0xffff0000u);
    }
    __syncthreads();
    const int d = tid & 63, sq = tid >> 6;
    float a2r[16];
#pragma unroll
    for (int j = 0; j < 16; ++j) a2r[j] = p.gla_a2[((size_t)(l * 2 + dir) * 16 + j) * 256 + h * 64 + d];
    const float ab = p.gla_ab[(l * 2 + dir) * 256 + h * 64 + d];
    float loc[16]; float run = 0.f;
#pragma unroll
    for (int i = 0; i < 16; ++i) {
        const int s = sq * 16 + i;
        float x = ab;
#pragma unroll
        for (int j = 0; j < 16; ++j) x += rt[s * 17 + j] * a2r[j];
        run += logsig(x) * (1.f / 16.f);
        loc[i] = run;
    }
    sg[sq * 64 + d] = run;
    __syncthreads();
    float off = 0.f;
    for (int k = 0; k < sq; ++k) off += sg[k * 64 + d];
#pragma unroll
    for (int i = 0; i < 16; ++i) cum[(sq * 16 + i) * 65 + d] = loc[i] + off;
    __syncthreads();
}

DEV void gla_phaseA(const P& p, int l, int dir, int b, int st, int h, unsigned char* smraw) {
    float* cum = (float*)smraw;
    float* rt = cum + 64 * 65;
    float* sg = rt + 64 * 17;
    u16* kwT = (u16*)(sg + 256);
    u16* vT = kwT + 64 * LDP;
    const int tid = tidx(), lane = tid & 63, w = tid >> 6, fr = lane & 15, fq = lane >> 4;
    const int row0 = chunk_row0(b, dir, st);
    const size_t idx = state_idx(dir, b, st, h);
    gla_cum(p, l, dir, h, row0, cum, rt, sg);
    {
        const int s = tid >> 2, dg = tid & 3, row = row0 + (dir ? 63 - s : s);
        float kk[16], vv[16];
        ld16bf(p.cols + (size_t)row * NCM + GLA_K + h * 64 + dg * 16, kk);
        ld16bf(p.cols + (size_t)row * NCM + GLA_V + h * 64 + dg * 16, vv);
#pragma unroll
        for (int i = 0; i < 16; ++i) {
            const int d = dg * 16 + i;
            kwT[d * LDP + s] = f2bf(kk[i] * __expf(cum[63 * 65 + d] - cum[s * 65 + d]));
            vT[d * LDP + s] = f2bf(vv[i]);
        }
        if (tid < 64) p.glaDec[idx * 64 + tid] = __expf(cum[63 * 65 + tid]);
    }
    __syncthreads();
    f32x4 acc[4]; zero4(acc);
    mm64(acc, kwT, LDP, vT, LDP);
#pragma unroll
    for (int nt = 0; nt < 4; ++nt) {
        const int d = 16 * w + fq * 4, e = nt * 16 + fr;
        u32x2 pk; pk.x = pack2(acc[nt][0], acc[nt][1]); pk.y = pack2(acc[nt][2], acc[nt][3]);
        *(u32x2*)(p.glaS + idx * 4096 + e * 64 + d) = pk;
    }
    __syncthreads();
}

DEV void ml_phaseA(const P& p, int l, int dir, int b, int st, int h, unsigned char* smraw) {
    float* wend = (float*)smraw;
    u16* kwT = (u16*)(wend + 64);
    u16* vT = kwT + 64 * LDP;
    const int tid = tidx(), lane = tid & 63, w = tid >> 6, fr = lane & 15, fq = lane >> 4;
    const int row0 = chunk_row0(b, dir, st);
    const size_t idx = state_idx(dir, b, st, h);
    if (w == 0) {
        const int row = row0 + (dir ? 63 - lane : lane);
        const float ip = bf2f(p.cols[(size_t)row * NCM + ML_GF + dir * 8 + h]) + p.mlstm_gate_b[((l * 2 + dir) * 2 + 0) * 4 + h];
        const float lf = logsig(bf2f(p.cols[(size_t)row * NCM + ML_GF + dir * 8 + 4 + h]) + p.mlstm_gate_b[((l * 2 + dir) * 2 + 1) * 4 + h]);
        const float fc = wscan_add(lf, lane);
        const float fe = __shfl(fc, 63, 64);
        const float lw = fe - fc + ip;
        const float ae = wmaxr(lw);
        wend[lane] = __expf(lw - ae);
        if (lane == 0) { p.mlFE[idx] = fe; p.mlAE[idx] = ae; }
    }
    __syncthreads();
    {
        const int s = tid >> 2, dg = tid & 3, row = row0 + (dir ? 63 - s : s);
        float kk[16], vv[16];
        ld16bf(p.cols + (size_t)row * NCM + ML_K + h * 64 + dg * 16, kk);
        ld16bf(p.cols + (size_t)row * NCM + ML_V + h * 64 + dg * 16, vv);
        const float ws = wend[s] * 0.125f;
#pragma unroll
        for (int i = 0; i < 16; ++i) {
            const int d = dg * 16 + i;
            kwT[d * LDP + s] = f2bf(kk[i] * ws);
            vT[d * LDP + s] = f2bf(vv[i]);
        }
    }
    __syncthreads();
    if (tid < 64) {
        float a = 0.f;
        for (int s = 0; s < 64; ++s) a += bf2f(kwT[tid * LDP + s]);
        p.mlN[idx * 64 + tid] = a;
    }
    f32x4 acc[4]; zero4(acc);
    mm64(acc, kwT, LDP, vT, LDP);
#pragma unroll
    for (int nt = 0; nt < 4; ++nt) {
        const int d = 16 * w + fq * 4, e = nt * 16 + fr;
        u32x2 pk; pk.x = pack2(acc[nt][0], acc[nt][1]); pk.y = pack2(acc[nt][2], acc[nt][3]);
        *(u32x2*)(p.mlS + idx * 4096 + e * 64 + d) = pk;
    }
    __syncthreads();
}

DEV void gd_phaseA(const P& p, int l, const u16* gqkv, int dir, int b, int st, int h, unsigned char* smraw) {
    float* X = (float*)smraw;
    float* cum = X + 64 * 65 + 32;
    float* beta = cum + 64;
    float* be = beta + 64;
    float* ke = be + 64;
    float* scal = ke + 64;
    u16* Y0 = (u16*)(scal + 64);
    u16* Y1 = Y0 + 64 * LDP;
    u16* Y2 = Y1 + 64 * LDP;
    u16* Y3 = Y2 + 64 * LDP;
    u16* Y4 = Y3 + 64 * LDP;
    u16* Y5 = Y4 + 64 * LDP;
    u16* wT = (u16*)X;
    const int tid = tidx(), lane = tid & 63, w = tid >> 6, fr = lane & 15, fq = lane >> 4;
    const int row0 = chunk_row0(b, dir, st);
    const size_t idx = state_idx(dir, b, st, h);
    if (w == 0) {
        const int row = row0 + (dir ? 63 - lane : lane);
        const float bp = bf2f(p.cols[(size_t)row * NCM + GD_GF + dir * 8 + h]);
        const float ap = bf2f(p.cols[(size_t)row * NCM + GD_GF + dir * 8 + 4 + h]);
        const float bt = sigm(bp);
        const float g = -__expf(p.gdn_a_log[(l * 2 + dir) * 4 + h]) * softplus(ap + p.gdn_dt_bias[(l * 2 + dir) * 4 + h]);
        const float cm = wscan_add(g, lane);
        const float ce = __shfl(cm, 63, 64);
        cum[lane] = cm; beta[lane] = bt; be[lane] = bt * __expf(cm); ke[lane] = __expf(ce - cm);
        if (lane == 0) scal[0] = __expf(ce);
    }
    {
        const int s = tid >> 2, dg = tid & 3, row = row0 + (dir ? 63 - s : s);
        const u16* src = gqkv + (size_t)row * 768 + h * 64 + dg * 16;
        const u32x4 q0 = *(const u32x4*)src, q1 = *(const u32x4*)(src + 8);
        const u32x4 k0 = *(const u32x4*)(src + 256), k1 = *(const u32x4*)(src + 264);
        const u32x4 v0 = *(const u32x4*)(src + 512), v1 = *(const u32x4*)(src + 520);
        *(u32x4*)(Y0 + s * LDP + dg * 16) = q0; *(u32x4*)(Y0 + s * LDP + dg * 16 + 8) = q1;
        *(u32x4*)(Y1 + s * LDP + dg * 16) = k0; *(u32x4*)(Y1 + s * LDP + dg * 16 + 8) = k1;
        const unsigned kw[8] = {k0.x, k0.y, k0.z, k0.w, k1.x, k1.y, k1.z, k1.w};
        const unsigned vw[8] = {v0.x, v0.y, v0.z, v0.w, v1.x, v1.y, v1.z, v1.w};
#pragma unroll
        for (int i = 0; i < 8; ++i) {
            Y2[(dg * 16 + 2 * i) * LDP + s] = (u16)(kw[i] & 0xffff); Y2[(dg * 16 + 2 * i + 1) * LDP + s] = (u16)(kw[i] >> 16);
            Y3[(dg * 16 + 2 * i) * LDP + s] = (u16)(vw[i] & 0xffff); Y3[(dg * 16 + 2 * i + 1) * LDP + s] = (u16)(vw[i] >> 16);
        }
    }
    __syncthreads();
    {
        f32x4 kk[4], qk[4]; zero4(kk); zero4(qk);
        mm64(kk, Y1, LDP, Y1, LDP);
        mm64(qk, Y0, LDP, Y1, LDP);
#pragma unroll
        for (int nt = 0; nt < 4; ++nt)
#pragma unroll
            for (int j = 0; j < 4; ++j) {
                const int c = 16 * w + fq * 4 + j, s = nt * 16 + fr;
                const float gam = s <= c ? __expf(cum[c] - cum[s]) : 0.f;
                if (s < c) X[c * 65 + s] = beta[c] * kk[nt][j] * gam;
                Y4[c * LDP + s] = f2bf(qk[nt][j] * gam);
            }
    }
    __syncthreads();
    {
        float* Pb = (float*)Y5;
        if (tid < 64) {
            const int blk = tid >> 4, col = tid & 15, base = blk * 16;
            float tc[16];
#pragma unroll
            for (int r = 0; r < 16; ++r) tc[r] = (r == col) ? 1.f : 0.f;
#pragma unroll
            for (int r = 1; r < 16; ++r) {
                float a = 0.f;
#pragma unroll
                for (int s2 = 0; s2 < r; ++s2) a += X[(base + r) * 65 + base + s2] * tc[s2];
                if (r > col) tc[r] = -a;
            }
#pragma unroll
            for (int r = 0; r < 16; ++r) if (r >= col) X[(base + col) * 65 + base + r + 1] = tc[r];
        }
        __syncthreads();
        for (int d = 1; d < 4; ++d) {
            const int nblk = 4 - d;
            for (int e = tid; e < nblk * 256; e += NTHR) {
                const int jb = e >> 8, r = (e >> 4) & 15, c = e & 15, ib = jb + d;
                float a = 0.f;
                for (int k = jb; k < ib; ++k)
#pragma unroll
                    for (int s2 = 0; s2 < 16; ++s2) {
                        const int rr = 16 * k + s2, cc = 16 * jb + c;
                        const float tv = rr >= cc ? X[cc * 65 + rr + 1] : 0.f;
                        a += X[(16 * ib + r) * 65 + rr] * tv;
                    }
                Pb[(jb * 16 + r) * 17 + c] = a;
            }
            __syncthreads();
            for (int e = tid; e < nblk * 256; e += NTHR) {
                const int jb = e >> 8, r = (e >> 4) & 15, c = e & 15, ib = jb + d;
                float a = 0.f;
#pragma unroll
                for (int s2 = 0; s2 < 16; ++s2) {
                    const float tv = s2 <= r ? X[(16 * ib + s2) * 65 + 16 * ib + r + 1] : 0.f;
                    a += tv * Pb[(jb * 16 + s2) * 17 + c];
                }
                X[(16 * jb + c) * 65 + 16 * ib + r + 1] = -a;
            }
            __syncthreads();
        }
    }
    {
        const int c = tid >> 2, sgp = tid & 3;
        float tw[16], tu[16];
#pragma unroll
        for (int i = 0; i < 16; ++i) {
            const int s = sgp * 16 + i;
            const float t = s <= c ? X[s * 65 + c + 1] : 0.f;
            tw[i] = t * be[s]; tu[i] = t * beta[s];
        }
        st16bf(Y0 + c * LDP + sgp * 16, tw);
        st16bf(Y1 + c * LDP + sgp * 16, tu);
    }
    __syncthreads();
    {
        f32x4 wa[4], ua[4]; zero4(wa); zero4(ua);
        mm64(wa, Y0, LDP, Y2, LDP);
        mm64(ua, Y1, LDP, Y3, LDP);
        __syncthreads();
        const int c0 = 16 * w + fq * 4;
        const float k0 = ke[c0], k1 = ke[c0 + 1], k2 = ke[c0 + 2], k3 = ke[c0 + 3];
#pragma unroll
        for (int nt = 0; nt < 4; ++nt) {
            const int d = nt * 16 + fr;
            u32x2 a, bq, c, dq_;
            a.x = pack2(wa[nt][0], wa[nt][1]); a.y = pack2(wa[nt][2], wa[nt][3]);
            bq.x = pack2(wa[nt][0] * k0, wa[nt][1] * k1); bq.y = pack2(wa[nt][2] * k2, wa[nt][3] * k3);
            c.x = pack2(ua[nt][0], ua[nt][1]); c.y = pack2(ua[nt][2], ua[nt][3]);
            dq_.x = pack2(ua[nt][0] * k0, ua[nt][1] * k1); dq_.y = pack2(ua[nt][2] * k2, ua[nt][3] * k3);
            *(u32x2*)(wT + d * LDP + c0) = a;
            *(u32x2*)(Y5 + d * LDP + c0) = bq;
            *(u32x2*)(Y0 + d * LDP + c0) = c;
            *(u32x2*)(Y1 + d * LDP + c0) = dq_;
        }
    }
    __syncthreads();
    {
        const float dec = scal[0];
        f32x4 acc[4];
        zero4(acc); mm64(acc, wT, LDP, Y4, LDP);
#pragma unroll
        for (int nt = 0; nt < 4; ++nt) {
            const int d = 16 * w + fq * 4, c = nt * 16 + fr, row = row0 + (dir ? 63 - c : c);
            const u32x2 qv = *(const u32x2*)(gqkv + (size_t)row * 768 + h * 64 + d);
            const float ec = __expf(cum[c]);
            u32x2 pk;
            pk.x = pack2(__uint_as_float(qv.x << 16) * ec - acc[nt][0], __uint_as_float(qv.x & 0xffff0000u) * ec - acc[nt][1]);
            pk.y = pack2(__uint_as_float(qv.y << 16) * ec - acc[nt][2], __uint_as_float(qv.y & 0xffff0000u) * ec - acc[nt][3]);
            *(u32x2*)(p.gdQ + idx * 4096 + c * 64 + d) = pk;
        }
        zero4(acc); mm64(acc, Y5, LDP, Y2, LDP);
#pragma unroll
        for (int nt = 0; nt < 4; ++nt) {
            const int d = 16 * w + fq * 4, d2 = nt * 16 + fr;
            u32x2 pk;
            pk.x = pack2((d == d2 ? dec : 0.f) - acc[nt][0], (d + 1 == d2 ? dec : 0.f) - acc[nt][1]);
            pk.y = pack2((d + 2 == d2 ? dec : 0.f) - acc[nt][2], (d + 3 == d2 ? dec : 0.f) - acc[nt][3]);
            *(u32x2*)(p.gdM + idx * 4096 + d2 * 64 + d) = pk;
        }
        zero4(acc); mm64(acc, Y2, LDP, Y1, LDP);
#pragma unroll
        for (int nt = 0; nt < 4; ++nt) {
            const int d2 = 16 * w + fq * 4, e = nt * 16 + fr;
            u32x2 pk; pk.x = pack2(acc[nt][0], acc[nt][1]); pk.y = pack2(acc[nt][2], acc[nt][3]);
            *(u32x2*)(p.gdN + idx * 4096 + e * 64 + d2) = pk;
        }
        zero4(acc); mm64(acc, Y4, LDP, Y0, LDP);
#pragma unroll
        for (int nt = 0; nt < 4; ++nt) {
            const int c = 16 * w + fq * 4, e = nt * 16 + fr;
            u32x2 pk; pk.x = pack2(acc[nt][0], acc[nt][1]); pk.y = pack2(acc[nt][2], acc[nt][3]);
            *(u32x2*)(p.gdO + idx * 4096 + e * 64 + c) = pk;
        }
    }
    __syncthreads();
}

DEV void phase_chunkA(const P& p, int l, const u16* gqkv, int bid, int nb, unsigned char* sm) {
    for (int u = bid; u < 3 * 2112; u += nb) {
        const int mix = u / 2112, v = u % 2112;
        const int h = v & 3, st = (v >> 2) % NSTEP, db = (v >> 2) / NSTEP, b = db & 1, dir = db >> 1;
        if (mix == 0) { PRB_BEGIN(120); gd_phaseA(p, l, gqkv, dir, b, st, h, sm); PRB_END(120); }
        else if (mix == 1) { PRB_BEGIN(121); gla_phaseA(p, l, dir, b, st, h, sm); PRB_END(121); }
        else { PRB_BEGIN(122); ml_phaseA(p, l, dir, b, st, h, sm); PRB_END(122); }
    }
}
#define GD_STAGE (2 * 64 * 64)
DEV void gd_issue(const P& p, size_t idx, u16* ring, int stg, int w, int lane) {
    u16* md = ring + stg * GD_STAGE;
    u16* nd = md + 64 * 64;
#pragma unroll
    for (int i = 0; i < 2; ++i) {
        const int r = (w * 2 + i) * 8 + (lane >> 3), c = (lane & 7) ^ ((r >> 1) & 7);
        __builtin_amdgcn_global_load_lds((const unsigned*)(p.gdM + idx * 4096 + r * 64 + c * 8), (unsigned*)(md + (w * 2 + i) * 512), 16, 0, 0);
        __builtin_amdgcn_global_load_lds((const unsigned*)(p.gdN + idx * 4096 + r * 64 + c * 8), (unsigned*)(nd + (w * 2 + i) * 512), 16, 0, 0);
    }
}
DEV void gd_scan(const P& p, int chain, u16* sm) {
    const int dir = chain >> 3, b = (chain >> 2) & 1, h = chain & 3;
    const int tid_ = tidx();
    const int lane = tid_ & 63, w = tid_ >> 6, fr = lane & 15, fq = lane >> 4;
    u16* ring = sm;
    u16* sl = sm + 4 * GD_STAGE + w * 16 * LDP;
    bf16x8 sb[2];
    sb[0] = bf16x8{0, 0, 0, 0, 0, 0, 0, 0}; sb[1] = sb[0];
    const size_t base = state_idx(dir, b, 0, h);
    const int sw = (fr >> 1) & 7;
    asm volatile("s_waitcnt vmcnt(0)" ::: "memory");
    gd_issue(p, base, ring, 0, w, lane);
    gd_issue(p, base + 4, ring, 1, w, lane);
    gd_issue(p, base + 8, ring, 2, w, lane);
    for (int k = 0; k < NSTEP; ++k) {
        if (k == 0) asm volatile("s_waitcnt vmcnt(8)" ::: "memory");
        else if (k == 1) asm volatile("s_waitcnt vmcnt(10)" ::: "memory");
        else if (k + 3 < NSTEP) asm volatile("s_waitcnt vmcnt(12)" ::: "memory");
        else asm volatile("s_waitcnt vmcnt(0)" ::: "memory");
        RAW_BARRIER();
        if (k + 3 < NSTEP) gd_issue(p, base + (size_t)(k + 3) * 4, ring, (k + 3) & 3, w, lane);
        asm volatile("" ::: "memory");
        const u16* Ms = ring + (k & 3) * GD_STAGE;
        const u16* Ns = Ms + 64 * 64;
        const size_t idx = base + (size_t)k * 4;
        f32x4 acc[4];
#pragma unroll
        for (int mt = 0; mt < 4; ++mt) {
            const u32x2 nv = *(const u32x2*)(Ns + (16 * w + fr) * 64 + (((mt * 2 + (fq >> 1)) ^ sw) * 8) + (fq & 1) * 4);
            acc[mt][0] = __uint_as_float(nv.x << 16); acc[mt][1] = __uint_as_float(nv.x & 0xffff0000u);
            acc[mt][2] = __uint_as_float(nv.y << 16); acc[mt][3] = __uint_as_float(nv.y & 0xffff0000u);
        }
#pragma unroll
        for (int mt = 0; mt < 4; ++mt)
#pragma unroll
            for (int ks = 0; ks < 2; ++ks) {
                const bf16x8 a = *(const bf16x8*)(Ms + (mt * 16 + fr) * 64 + (((ks * 4 + fq) ^ sw) * 8));
                acc[mt] = mfma16(a, sb[ks], acc[mt]);
            }
#pragma unroll
        for (int ks = 0; ks < 2; ++ks) *(bf16x8*)(p.gdN + idx * 4096 + (16 * w + fr) * 64 + ks * 32 + fq * 8) = sb[ks];
        asm volatile("" ::: "memory");
#pragma unroll
        for (int mt = 0; mt < 4; ++mt) {
            u32x2 pk; pk.x = pack2(acc[mt][0], acc[mt][1]); pk.y = pack2(acc[mt][2], acc[mt][3]);
            *(u32x2*)(sl + fr * LDP + mt * 16 + fq * 4) = pk;
        }
        __builtin_amdgcn_wave_barrier();
#pragma unroll
        for (int ks = 0; ks < 2; ++ks) sb[ks] = *(const bf16x8*)(sl + fr * LDP + ks * 32 + fq * 8);
        __builtin_amdgcn_wave_barrier();
    }
    asm volatile("s_waitcnt vmcnt(0)" ::: "memory");
    RAW_BARRIER();
}

DEV void gla_scan(const P& p, int v) {
    const int chain = v >> 3, sub = v & 7;
    const int dir = chain >> 3, b = (chain >> 2) & 1, h = chain & 3;
    const int ep = sub * 256 + tidx(), d = (2 * ep) & 63;
    float s0 = 0.f, s1 = 0.f;
    for (int st0 = 0; st0 < NSTEP; st0 += 12) {
        unsigned kv[12]; float2 dc[12];
#pragma unroll
        for (int k = 0; k < 12; ++k) {
            const size_t idx = state_idx(dir, b, st0 + k, h);
            kv[k] = *(const unsigned*)(p.glaS + idx * 4096 + 2 * ep);
            dc[k] = *(const float2*)(p.glaDec + idx * 64 + d);
        }
#pragma unroll
        for (int k = 0; k < 12; ++k) {
            const size_t idx = state_idx(dir, b, st0 + k, h);
            *(unsigned*)(p.glaS + idx * 4096 + 2 * ep) = pack2(s0, s1);
            s0 = dc[k].x * s0 + __uint_as_float(kv[k] << 16);
            s1 = dc[k].y * s1 + __uint_as_float(kv[k] & 0xffff0000u);
        }
    }
}

DEV void ml_scan(const P& p, int v) {
    const int chain = v >> 3, sub = v & 7;
    const int dir = chain >> 3, b = (chain >> 2) & 1, h = chain & 3;
    const int tid = tidx();
    const int ep = sub * 256 + tid;
    float s0 = 0.f, s1 = 0.f, m = 0.f;
    for (int st0 = 0; st0 < NSTEP; st0 += 12) {
        unsigned kv[12]; float fe[12], ae[12];
#pragma unroll
        for (int k = 0; k < 12; ++k) {
            const size_t idx = state_idx(dir, b, st0 + k, h);
            kv[k] = *(const unsigned*)(p.mlS + idx * 4096 + 2 * ep);
            fe[k] = p.mlFE[idx]; ae[k] = p.mlAE[idx];
        }
#pragma unroll
        for (int k = 0; k < 12; ++k) {
            const size_t idx = state_idx(dir, b, st0 + k, h);
            *(unsigned*)(p.mlS + idx * 4096 + 2 * ep) = pack2(s0, s1);
            const float mn = fmaxf(fe[k] + m, ae[k]);
            const float od = __expf(fe[k] + m - mn), nw = __expf(ae[k] - mn);
            s0 = od * s0 + nw * __uint_as_float(kv[k] << 16);
            s1 = od * s1 + nw * __uint_as_float(kv[k] & 0xffff0000u);
            m = mn;
        }
    }
}
DEV void ml_nscan(const P& p, int v) {
    const int tid = tidx(), chain = v * 4 + (tid >> 6), d = tid & 63;
    const int dir = chain >> 3, b = (chain >> 2) & 1, h = chain & 3;
    float nn = 0.f, m = 0.f;
    for (int st0 = 0; st0 < NSTEP; st0 += 12) {
        float fe[12], ae[12], ks[12];
#pragma unroll
        for (int k = 0; k < 12; ++k) {
            const size_t idx = state_idx(dir, b, st0 + k, h);
            fe[k] = p.mlFE[idx]; ae[k] = p.mlAE[idx]; ks[k] = p.mlN[idx * 64 + d];
        }
#pragma unroll
        for (int k = 0; k < 12; ++k) {
            const size_t idx = state_idx(dir, b, st0 + k, h);
            p.mlN[idx * 64 + d] = nn;
            if (d == 0) p.mlM[idx] = m;
            const float mn = fmaxf(fe[k] + m, ae[k]);
            const float od = __expf(fe[k] + m - mn), nw = __expf(ae[k] - mn);
            nn = od * nn + nw * ks[k];
            m = mn;
        }
    }
}

DEV void phase_scan(const P& p, int bid, int nb, u16* sm) {
    for (int u = bid; u < 16 + 128 + 128 + 4; u += nb) {
        if (u < 16) { PRB_BEGIN(100); gd_scan(p, u, sm); PRB_END(100); }
        else if (u < 144) { PRB_BEGIN(101); gla_scan(p, u - 16); PRB_END(101); }
        else if (u < 272) { PRB_BEGIN(102); ml_scan(p, u - 144); PRB_END(102); }
        else ml_nscan(p, u - 272);
    }
}
DEV void chunk_geom(int g, int& b, int& row0, int& stf, int& stb) {
    b = g / NSTEP; const int wv = g % NSTEP;
    row0 = wv < 4 ? RLAT + b * CTXL + wv * 64 : b * SEQ + (wv - 4) * 64;
    stf = wv; stb = wv < 4 ? 3 - wv : 135 - wv;
}
DEV void obuf_acc(float* obuf, const f32x4 (&acc)[4], int dir) {
    const int lane = tidx() & 63, w = tidx() >> 6, fr = lane & 15, fq = lane >> 4;
#pragma unroll
    for (int nt = 0; nt < 4; ++nt)
#pragma unroll
        for (int j = 0; j < 4; ++j) {
            const int c = 16 * w + fq * 4 + j, e = nt * 16 + fr;
            if (dir == 0) obuf[c * 65 + e] = acc[nt][j]; else obuf[(63 - c) * 65 + e] += acc[nt][j];
        }
}
template <int ACT>
DEV void head_out(const P& p, int l, int br, int h, int row0, int gcol, const float* obuf) {
    const int tid = tidx(), row = tid >> 2, eg = tid & 3;
    float o[16]; float ss = 0.f;
#pragma unroll
    for (int i = 0; i < 16; ++i) { o[i] = obuf[row * 65 + eg * 16 + i]; ss += o[i] * o[i]; }
    ss += __shfl_xor(ss, 1, 64); ss += __shfl_xor(ss, 2, 64);
    const float rs = rsqrtf(ss * (1.f / 64.f) + EPSF);
    float gt[16];
    ld16bf(p.cols + (size_t)(row0 + row) * NCM + gcol + h * 64 + eg * 16, gt);
    float y[16];
#pragma unroll
    for (int i = 0; i < 16; ++i) {
        const float hn = p.head_norm[(l * 4 + br) * 256 + h * 64 + eg * 16 + i];
        const float a = ACT == 0 ? silu(gt[i]) : sigm(gt[i]);
        y[i] = o[i] * rs * hn * a;
    }
    st16bf(p.ybuf + (size_t)(row0 + row) * 1024 + br * 256 + h * 64 + eg * 16, y);
}

DEV void gla_phaseC(const P& p, int l, int g, int h, unsigned char* smraw) {
    float* cum = (float*)smraw;
    float* rt = cum + 64 * 65;
    float* sg = rt + 64 * 17;
    float* obuf = sg + 256;
    u16* qi = (u16*)(obuf + 64 * 65);
    u16* ko = qi + 64 * LDP;
    u16* vT = ko + 64 * LDP;
    const int tid = tidx(), lane = tid & 63, w = tid >> 6, fr = lane & 15, fq = lane >> 4;
    int b, row0, stf, stb; chunk_geom(g, b, row0, stf, stb);
    for (int dir = 0; dir < 2; ++dir) {
        const size_t idx = state_idx(dir, b, dir ? stb : stf, h);
        gla_cum(p, l, dir, h, row0, cum, rt, sg);
        {
            const int s = tid >> 2, dg = tid & 3, row = row0 + (dir ? 63 - s : s);
            float qq[16], kk[16], vv[16];
            ld16bf(p.cols + (size_t)row * NCM + GLA_Q + h * 64 + dg * 16, qq);
            ld16bf(p.cols + (size_t)row * NCM + GLA_K + h * 64 + dg * 16, kk);
            ld16bf(p.cols + (size_t)row * NCM + GLA_V + h * 64 + dg * 16, vv);
#pragma unroll
            for (int i = 0; i < 16; ++i) {
                const float cv = cum[s * 65 + dg * 16 + i];
                qq[i] *= 0.125f * __expf(cv); kk[i] *= __expf(-cv);
                vT[(dg * 16 + i) * LDP + s] = f2bf(vv[i]);
            }
            st16bf(qi + s * LDP + dg * 16, qq);
            st16bf(ko + s * LDP + dg * 16, kk);
        }
        __syncthreads();
        f32x4 sa[4]; zero4(sa);
        mm64(sa, qi, LDP, ko, LDP);
        __syncthreads();
#pragma unroll
        for (int nt = 0; nt < 4; ++nt)
#pragma unroll
            for (int j = 0; j < 4; ++j) {
                const int c = 16 * w + fq * 4 + j, s = nt * 16 + fr;
                ko[c * LDP + s] = f2bf(s <= c ? sa[nt][j] : 0.f);
            }
        __syncthreads();
        f32x4 oa[4]; zero4(oa);
        mm64(oa, ko, LDP, vT, LDP);
        mm64(oa, qi, LDP, p.glaS + idx * 4096, 64);
        obuf_acc(obuf, oa, dir);
        __syncthreads();
    }
    head_out<0>(p, l, 0, h, row0, GLA_G, obuf);
    __syncthreads();
}

DEV void ml_phaseC(const P& p, int l, int g, int h, unsigned char* smraw) {
    float* obuf = (float*)smraw;
    float* fcum = obuf + 64 * 65;
    float* ipre = fcum + 64;
    float* mrow = ipre + 64;
    float* denl = mrow + 64;
    float* qn = denl + 64;
    float* nin = qn + 64;
    u16* qs = (u16*)(nin + 64 + 64);
    u16* ks = qs + 64 * LDP;
    u16* vT = ks + 64 * LDP;
    const int tid = tidx(), lane = tid & 63, w = tid >> 6, fr = lane & 15, fq = lane >> 4;
    int b, row0, stf, stb; chunk_geom(g, b, row0, stf, stb);
    for (int dir = 0; dir < 2; ++dir) {
        const size_t idx = state_idx(dir, b, dir ? stb : stf, h);
        const float m_in = p.mlM[idx];
        if (w == 0) {
            const int row = row0 + (dir ? 63 - lane : lane);
            const float ip = bf2f(p.cols[(size_t)row * NCM + ML_GF + dir * 8 + h]) + p.mlstm_gate_b[((l * 2 + dir) * 2 + 0) * 4 + h];
            const float lf = logsig(bf2f(p.cols[(size_t)row * NCM + ML_GF + dir * 8 + 4 + h]) + p.mlstm_gate_b[((l * 2 + dir) * 2 + 1) * 4 + h]);
            const float fc = wscan_add(lf, lane);
            const float pm = wscan_max(ip - fc, lane);
            fcum[lane] = fc; ipre[lane] = ip; mrow[lane] = fc + fmaxf(m_in, pm);
            nin[lane] = p.mlN[idx * 64 + lane];
        }
        {
            const int s = tid >> 2, dg = tid & 3, row = row0 + (dir ? 63 - s : s);
            float kk[16], vv[16];
            const u16* qsrc = p.cols + (size_t)row * NCM + ML_Q + h * 64 + dg * 16;
            *(u32x4*)(qs + s * LDP + dg * 16) = *(const u32x4*)qsrc;
            *(u32x4*)(qs + s * LDP + dg * 16 + 8) = *(const u32x4*)(qsrc + 8);
            ld16bf(p.cols + (size_t)row * NCM + ML_K + h * 64 + dg * 16, kk);
            ld16bf(p.cols + (size_t)row * NCM + ML_V + h * 64 + dg * 16, vv);
#pragma unroll
            for (int i = 0; i < 16; ++i) { kk[i] *= 0.125f; vT[(dg * 16 + i) * LDP + s] = f2bf(vv[i]); }
            st16bf(ks + s * LDP + dg * 16, kk);
        }
        __syncthreads();
        {
            const int c = tid >> 2, dg = tid & 3;
            float a = 0.f;
#pragma unroll
            for (int i = 0; i < 16; ++i) a += bf2f(qs[c * LDP + dg * 16 + i]) * nin[dg * 16 + i];
            a += __shfl_xor(a, 1, 64); a += __shfl_xor(a, 2, 64);
            if (dg == 0) qn[c] = a;
        }
        f32x4 sa[4]; zero4(sa);
        mm64(sa, qs, LDP, ks, LDP);
        __syncthreads();
        float dsum[4] = {0.f, 0.f, 0.f, 0.f};
#pragma unroll
        for (int nt = 0; nt < 4; ++nt)
#pragma unroll
            for (int j = 0; j < 4; ++j) {
                const int c = 16 * w + fq * 4 + j, s = nt * 16 + fr;
                float val = 0.f;
                if (s <= c) val = sa[nt][j] * __expf(fcum[c] - fcum[s] + ipre[s] - mrow[c]);
                dsum[j] += val;
                ks[c * LDP + s] = f2bf(val);
            }
#pragma unroll
        for (int j = 0; j < 4; ++j) {
            float v = dsum[j];
            v += __shfl_xor(v, 1, 64); v += __shfl_xor(v, 2, 64); v += __shfl_xor(v, 4, 64); v += __shfl_xor(v, 8, 64);
            if (fr == 0) denl[16 * w + fq * 4 + j] = v;
        }
        __syncthreads();
        f32x4 n1[4], n2[4]; zero4(n1); zero4(n2);
        mm64(n1, ks, LDP, vT, LDP);
        mm64(n2, qs, LDP, p.mlS + idx * 4096, 64);
        f32x4 oa[4];
#pragma unroll
        for (int j = 0; j < 4; ++j) {
            const int c = 16 * w + fq * 4 + j;
            const float mr = mrow[c];
            const float ec = __expf(fcum[c] + m_in - mr);
            const float den = denl[c] + ec * qn[c];
            const float inv = 1.f / fmaxf(fabsf(den), __expf(-mr));
#pragma unroll
            for (int nt = 0; nt < 4; ++nt) oa[nt][j] = (n1[nt][j] + ec * n2[nt][j]) * inv;
        }
        obuf_acc(obuf, oa, dir);
        __syncthreads();
    }
    head_out<1>(p, l, 1, h, row0, ML_O, obuf);
    __syncthreads();
}

DEV void gd_phaseC(const P& p, int l, int g, int h, unsigned char* smraw) {
    float* obuf = (float*)smraw;
    const int tid = tidx(), lane = tid & 63, w = tid >> 6, fr = lane & 15, fq = lane >> 4;
    int b, row0, stf, stb; chunk_geom(g, b, row0, stf, stb);
    for (int dir = 0; dir < 2; ++dir) {
        const size_t idx = state_idx(dir, b, dir ? stb : stf, h);
        f32x4 oa[4];
#pragma unroll
        for (int nt = 0; nt < 4; ++nt) {
            const u32x2 ov = *(const u32x2*)(p.gdO + idx * 4096 + (nt * 16 + fr) * 64 + 16 * w + fq * 4);
            oa[nt][0] = __uint_as_float(ov.x << 16); oa[nt][1] = __uint_as_float(ov.x & 0xffff0000u);
            oa[nt][2] = __uint_as_float(ov.y << 16); oa[nt][3] = __uint_as_float(ov.y & 0xffff0000u);
        }
        mm64(oa, p.gdQ + idx * 4096, 64, p.gdN + idx * 4096, 64);
        obuf_acc(obuf, oa, dir);
        __syncthreads();
    }
    head_out<0>(p, l, 2, h, row0, GD_OG, obuf);
    __syncthreads();
}
DEV float fexp2(float x) { return __builtin_amdgcn_exp2f(x); }

#define ATT_STAGE_ELEMS (2 * 64 * 64)
DEV void attn_issue(const u16* kbase, const u16* vbase, int kt, u16* ring, int stg, int w, int lane) {
    u16* kd = ring + stg * ATT_STAGE_ELEMS;
    u16* vd = kd + 64 * 64;
#pragma unroll
    for (int i = 0; i < 2; ++i) {
        const int r = (w * 2 + i) * 8 + (lane >> 3), c = (lane & 7) ^ ((r >> 1) & 7);
        __builtin_amdgcn_global_load_lds((const unsigned*)(kbase + (size_t)(kt * 64 + r) * 64 + c * 8), (unsigned*)(kd + (w * 2 + i) * 512), 16, 0, 0);
        __builtin_amdgcn_global_load_lds((const unsigned*)(vbase + (size_t)r * KPOS + kt * 64 + c * 8), (unsigned*)(vd + (w * 2 + i) * 512), 16, 0, 0);
    }
}

DEV void attn_unit(const P& p, int l, int b, int h, int q0pos, int nkeys, int rowbase, u16* ring) {
    const int tid = tidx(), lane = tid & 63, w = tid >> 6, fr = lane & 15, fq = lane >> 4;
    const size_t bh = (size_t)(b * 4 + h);
    float lam;
    {
        const float* lp = p.diff_lambda + (size_t)l * 4 * 4 * 32;
        float a = 0.f, c = 0.f;
        if (lane < 32) { a = lp[(0 * 4 + h) * 32 + lane] * lp[(1 * 4 + h) * 32 + lane]; c = lp[(2 * 4 + h) * 32 + lane] * lp[(3 * 4 + h) * 32 + lane]; }
        a = wsum(a); c = wsum(c);
        lam = expf(a) - expf(c) + (0.8f - 0.6f * expf(-0.3f * (float)l));
    }
    const float lam_init = 0.8f - 0.6f * expf(-0.3f * (float)l);
    bf16x8 qf[2][2];
#pragma unroll
    for (int g = 0; g < 2; ++g)
#pragma unroll
        for (int i = 0; i < 2; ++i)
            qf[g][i] = *(const bf16x8*)(p.dq + (bh * KPOS + q0pos + w * 32 + g * 16 + fr) * 64 + i * 32 + fq * 8);
    f32x4 O[2][2][4];
    float mrun[2][2], lsum[2][2];
#pragma unroll
    for (int i = 0; i < 2; ++i)
#pragma unroll
        for (int g = 0; g < 2; ++g) {
            mrun[i][g] = -INFINITY; lsum[i][g] = 0.f;
#pragma unroll
            for (int t = 0; t < 4; ++t) O[i][g][t] = f32x4{0.f, 0.f, 0.f, 0.f};
        }
    const u16* kbase = p.dk + bh * KPOS * 64;
    const u16* vbase = p.dvT + bh * 64 * KPOS;
    const int nk = nkeys >> 6;
    asm volatile("s_waitcnt vmcnt(0)" ::: "memory");
    attn_issue(kbase, vbase, 0, ring, 0, w, lane);
    attn_issue(kbase, vbase, 1, ring, 1, w, lane);
    const int sw = (fr >> 1) & 7;
    for (int kt = 0; kt < nk; ++kt) {
        if (kt + 1 < nk) asm volatile("s_waitcnt vmcnt(4)" ::: "memory"); else asm volatile("s_waitcnt vmcnt(0)" ::: "memory");
        RAW_BARRIER();
        if (kt + 2 < nk) attn_issue(kbase, vbase, kt + 2, ring, (kt + 2) % 3, w, lane);
        const u16* Ks = ring + (kt % 3) * ATT_STAGE_ELEMS;
        const u16* Vs = Ks + 64 * 64;
#pragma unroll
        for (int i = 0; i < 2; ++i) {
            f32x4 s[2][4];
#pragma unroll
            for (int st = 0; st < 4; ++st) {
                const bf16x8 kf = *(const bf16x8*)(Ks + (st * 16 + fr) * 64 + (((i * 4 + fq) ^ sw) * 8));
#pragma unroll
                for (int g = 0; g < 2; ++g) s[g][st] = mfma16(kf, qf[g][i], f32x4{0.f, 0.f, 0.f, 0.f});
            }
            bf16x8 pb[2][2];
#pragma unroll
            for (int g = 0; g < 2; ++g) {
                float mx = s[g][0][0];
#pragma unroll
                for (int st = 0; st < 4; ++st)
#pragma unroll
                    for (int j = 0; j < 4; ++j) mx = fmaxf(mx, s[g][st][j]);
                mx = fmaxf(mx, __shfl_xor(mx, 16, 64)); mx = fmaxf(mx, __shfl_xor(mx, 32, 64));
                const float mn = fmaxf(mrun[i][g], mx);
                const float alpha = fexp2(mrun[i][g] - mn);
                mrun[i][g] = mn;
                float ps = 0.f;
#pragma unroll
                for (int st = 0; st < 4; ++st)
#pragma unroll
                    for (int j = 0; j < 4; ++j) { const float e = fexp2(s[g][st][j] - mn); s[g][st][j] = e; ps += e; }
                lsum[i][g] = lsum[i][g] * alpha + ps;
#pragma unroll
                for (int t = 0; t < 4; ++t) { O[i][g][t][0] *= alpha; O[i][g][t][1] *= alpha; O[i][g][t][2] *= alpha; O[i][g][t][3] *= alpha; }
#pragma unroll
                for (int ks = 0; ks < 2; ++ks) {
                    union { bf16x8 v; unsigned u[4]; } pk;
                    pk.u[0] = pack2(s[g][2 * ks][0], s[g][2 * ks][1]); pk.u[1] = pack2(s[g][2 * ks][2], s[g][2 * ks][3]);
                    pk.u[2] = pack2(s[g][2 * ks + 1][0], s[g][2 * ks + 1][1]); pk.u[3] = pack2(s[g][2 * ks + 1][2], s[g][2 * ks + 1][3]);
                    pb[g][ks] = pk.v;
                }
            }
#pragma unroll
            for (int ks = 0; ks < 2; ++ks)
#pragma unroll
                for (int t = 0; t < 4; ++t) {
                    union { bf16x8 v; u32x2 h2[2]; } va;
                    va.h2[0] = *(const u32x2*)(Vs + (t * 16 + fr) * 64 + ((((2 * ks) * 2 + (fq >> 1)) ^ sw) * 8) + (fq & 1) * 4);
                    va.h2[1] = *(const u32x2*)(Vs + (t * 16 + fr) * 64 + ((((2 * ks + 1) * 2 + (fq >> 1)) ^ sw) * 8) + (fq & 1) * 4);
#pragma unroll
                    for (int g = 0; g < 2; ++g) O[i][g][t] = mfma16(va.v, pb[g][ks], O[i][g][t]);
                }
        }
    }
    RAW_BARRIER();
#pragma unroll
    for (int g = 0; g < 2; ++g) {
        float l0 = lsum[0][g], l1 = lsum[1][g];
        l0 += __shfl_xor(l0, 16, 64); l0 += __shfl_xor(l0, 32, 64);
        l1 += __shfl_xor(l1, 16, 64); l1 += __shfl_xor(l1, 32, 64);
        const float i0 = 1.f / l0, i1 = lam / l1;
        float o[4][4]; float ss = 0.f;
#pragma unroll
        for (int t = 0; t < 4; ++t)
#pragma unroll
            for (int j = 0; j < 4; ++j) { o[t][j] = O[0][g][t][j] * i0 - O[1][g][t][j] * i1; ss += o[t][j] * o[t][j]; }
        ss += __shfl_xor(ss, 16, 64); ss += __shfl_xor(ss, 32, 64);
        const float rs = rsqrtf(ss * (1.f / 64.f) + EPSF) * (1.f - lam_init);
        const int row = rowbase + w * 32 + g * 16 + fr;
#pragma unroll
        for (int t = 0; t < 4; ++t) {
            const int dv = t * 16 + fq * 4;
            const float4 hn = *(const float4*)(p.head_norm + (l * 4 + 3) * 256 + h * 64 + dv);
            u32x2 pk; pk.x = pack2(o[t][0] * rs * hn.x, o[t][1] * rs * hn.y); pk.y = pack2(o[t][2] * rs * hn.z, o[t][3] * rs * hn.w);
            *(u32x2*)(p.ybuf + (size_t)row * 1024 + 768 + h * 64 + dv) = pk;
        }
    }
}

template <int PART>
DEV void phase_outputs(const P& p, int l, int bid, int nb, unsigned char* sm) {
    if (PART != 2) {
    const int nq = 64 + (l == 0 ? 2 : 0);
    int* qctr = p.cnt + 64 + l * 8;
    volatile int* slot = (volatile int*)(sm + 3 * ATT_STAGE_ELEMS * 2);
    const int x0 = (int)(xb_xcc_id() & 7u);
    for (int a = 0; a < 8; ++a) {
        const int bh = (x0 + a) & 7;
        for (;;) {
            if (tidx() == 0) *slot = atomicAdd(qctr + bh, 1);
            __syncthreads();
            const int qt = *slot;
            __syncthreads();
            if (qt >= nq) break;
            const int b = bh >> 2, h = bh & 3;
            if (qt < 64) attn_unit(p, l, b, h, CTXL + qt * 128, KPOS, b * SEQ + qt * 128, (u16*)sm);
            else attn_unit(p, l, b, h, (qt - 64) * 128, CTXL, RLAT + b * CTXL + (qt - 64) * 128, (u16*)sm);
        }
    }
    }
    __builtin_amdgcn_sched_barrier(0);
    if (PART != 1)
    for (int v = bid; v < 3 * 1056; v += nb) {
        const int mix = v / 1056, r = v % 1056, g = r >> 2, h = r & 3;
        if (l == 1 && (g % NSTEP) < 4) continue;
        if (mix == 0) { PRB_BEGIN(131); gla_phaseC(p, l, g, h, sm); PRB_END(131); }
        else if (mix == 1) { PRB_BEGIN(132); ml_phaseC(p, l, g, h, sm); PRB_END(132); }
        else { PRB_BEGIN(133); gd_phaseC(p, l, g, h, sm); PRB_END(133); }
    }
}
#define LDS_BYTES 75776
#ifndef MULTI
#define MULTI 0
#endif
#ifndef STAGE
#define STAGE 99
#endif

enum { PH_PRO0 = 0, PH_PRO1, PH_NORM1, PH_INPROJ, PH_PREP, PH_CHUNKA, PH_SCAN, PH_OUT, PH_GATES, PH_MERGE1, PH_MERGE2, PH_ROUTER, PH_MOEUP, PH_MOEDOWN, PH_FINAL, PH_OUTC };

template <int PH>
DEV void run_phase(const P& p, int l, int bid_, int nb_, unsigned char* sm) {
    const int bid = launder_s(bid_), nb = launder_s(nb_);
    u16* gqkv = p.ybuf;
    u16* ubuf = p.glaS;
    const int mtiles = l == 0 ? 132 : 128;
    if (PH == PH_PRO0) { phase_conv_mixw(p, 0, bid, nb, (float*)sm); phase_mod_partial(p, bid, nb, (float*)sm); phase_rope_table(p, bid, nb); }
    else if (PH == PH_PRO1) phase_mod_reduce(p, bid, nb);
    else if (PH == PH_NORM1) phase_norm1(p, l, bid, nb);
    else if (PH == PH_INPROJ) phase_inproj<false>(p, 0, 31, NCM, 132, bid, nb, (u16*)sm);
    else if (PH == PH_PREP) phase_prep(p, l, gqkv, bid, nb, (u16*)sm);
    else if (PH == PH_CHUNKA) phase_chunkA(p, l, gqkv, bid, nb, sm);
    else if (PH == PH_SCAN) phase_scan(p, bid, nb, (u16*)sm);
#ifdef PROBE_SPLIT
    else if (PH == PH_OUT) phase_outputs<1>(p, l, bid, nb, sm);
    else if (PH == PH_OUTC) phase_outputs<2>(p, l, bid, nb, sm);
#else
    else if (PH == PH_OUT) phase_outputs<0>(p, l, bid, nb, sm);
#endif
    else if (PH == PH_GATES) phase_inproj<true>(p, 3968, 32, NGATE, mtiles, bid, nb, (u16*)sm);
    else if (PH == PH_MERGE1) phase_merge1(p, ubuf, mtiles, bid, nb, (u16*)sm);
    else if (PH == PH_MERGE2) phase_merge2(p, l, ubuf, mtiles, bid, nb, (u16*)sm);
    else if (PH == PH_ROUTER) {
        { PRB_BEGIN(110); phase_norm2_router(p, l, l == 0 ? RTOT : RLAT, bid, nb, (float*)sm); PRB_END(110); }
        { PRB_BEGIN(111); phase_conv_moew(p, l, bid, nb, (float*)sm); PRB_END(111); }
        if (l == 0) { PRB_BEGIN(112); phase_conv_mixw(p, 1, bid, nb, (float*)sm); PRB_END(112); }
    }
    else if (PH == PH_MOEUP) phase_moe_up(p, l, bid, nb, (u16*)sm);
    else if (PH == PH_MOEDOWN) phase_moe_down(p, l, bid, nb, (u16*)sm);
    else if (PH == PH_FINAL) phase_final_norm(p, bid, nb);
}

#if MULTI
template <int PH>
__global__ void __launch_bounds__(NTHR, 2) k_phase(P p, int l) {
    extern __shared__ __attribute__((aligned(16))) unsigned char smem[];
    run_phase<PH>(p, l, blockIdx.x, gridDim.x, smem);
}
#else
__global__ void __launch_bounds__(NTHR, 2) k_mega(P p) {
    extern __shared__ __attribute__((aligned(16))) unsigned char smem[];
    volatile LAS unsigned* xbw = (volatile LAS unsigned*)(smem + LDS_BYTES);
    if (threadIdx.x == 0) { xbw[0] = 0u; xbw[1] = 0u; xbw[2] = 0u; xbw[3] = 0u; }
    __syncthreads();
    (void)xcd_barrier_post(p.bar, xbw);
    const int bid = blockIdx.x, nb = gridDim.x;
#ifdef PROBE_SEL
    unsigned long long pr_t0 = wall_clock64();
    volatile LAS unsigned long long* pr_acc = (volatile LAS unsigned long long*)(smem + LDS_BYTES + 8);
#define PSTAMP(PH) do { const unsigned long long t_ = wall_clock64(); if ((PH) == PROBE_SEL && threadIdx.x == 0) *pr_acc = *pr_acc + (t_ - pr_t0); pr_t0 = t_; } while (0)
#else
#define PSTAMP(PH) do { } while (0)
#endif
#define GBAR() do { XcdBarrier b_; b_.bar = p.bar; b_.x = xb_xcc_id(); b_.st = (volatile LAS unsigned*)(smem + LDS_BYTES); xcd_barrier(b_); } while (0)
    run_phase<PH_PRO0>(p, 0, bid, nb, smem); GBAR(); PSTAMP(PH_PRO0);
    run_phase<PH_PRO1>(p, 0, bid, nb, smem); GBAR(); PSTAMP(PH_PRO1);
    for (int l = 0; l < 2; ++l) {
        run_phase<PH_NORM1>(p, l, bid, nb, smem); GBAR(); PSTAMP(PH_NORM1);
        run_phase<PH_INPROJ>(p, l, bid, nb, smem); GBAR(); PSTAMP(PH_INPROJ);
        run_phase<PH_PREP>(p, l, bid, nb, smem); GBAR(); PSTAMP(PH_PREP);
        run_phase<PH_CHUNKA>(p, l, bid, nb, smem); GBAR(); PSTAMP(PH_CHUNKA);
        run_phase<PH_SCAN>(p, l, bid, nb, smem); GBAR(); PSTAMP(PH_SCAN);
        run_phase<PH_OUT>(p, l, bid, nb, smem); GBAR(); PSTAMP(PH_OUT);
#ifdef PROBE_SPLIT
        run_phase<PH_OUTC>(p, l, bid, nb, smem); GBAR(); PSTAMP(PH_OUTC);
#endif
        run_phase<PH_GATES>(p, l, bid, nb, smem); GBAR(); PSTAMP(PH_GATES);
        run_phase<PH_MERGE1>(p, l, bid, nb, smem); GBAR(); PSTAMP(PH_MERGE1);
        run_phase<PH_MERGE2>(p, l, bid, nb, smem); GBAR(); PSTAMP(PH_MERGE2);
        run_phase<PH_ROUTER>(p, l, bid, nb, smem); GBAR(); PSTAMP(PH_ROUTER);
        run_phase<PH_MOEUP>(p, l, bid, nb, smem); GBAR(); PSTAMP(PH_MOEUP);
        run_phase<PH_MOEDOWN>(p, l, bid, nb, smem); GBAR(); PSTAMP(PH_MOEDOWN);
    }
    run_phase<PH_FINAL>(p, 0, bid, nb, smem);
#ifdef PROBE_SEL
    __syncthreads();
    { const unsigned long long te = wall_clock64(), wt = *pr_acc * 4ull; while (wall_clock64() - te < wt) __builtin_amdgcn_s_sleep(8); }
#endif
}
#endif

static size_t al256(size_t x) { return (x + 255) & ~(size_t)255; }

extern "C" void kernel_launch(void* const* d_in, const int* in_sizes, int n_in, void* d_out, int out_size, void* d_ws, size_t ws_size,
                              hipStream_t stream) {
    (void)in_sizes; (void)n_in; (void)out_size; (void)ws_size;
    P p{};
    p.x = (const float*)d_in[0]; p.c = (const float*)d_in[1]; p.ctx = (const float*)d_in[2]; p.c_ctx = (const float*)d_in[3];
    p.w_mod = (const float*)d_in[4]; p.b_mod = (const float*)d_in[5]; p.norm_mix = (const float*)d_in[6]; p.norm_ffn = (const float*)d_in[7];
    p.w_in = (const float*)d_in[8]; p.gla_a2 = (const float*)d_in[9]; p.gla_ab = (const float*)d_in[10]; p.mlstm_gate_b = (const float*)d_in[11];
    p.gdn_conv = (const float*)d_in[12]; p.gdn_a_log = (const float*)d_in[13]; p.gdn_dt_bias = (const float*)d_in[14];
    p.diff_lambda = (const float*)d_in[15]; p.head_norm = (const float*)d_in[16]; p.w_branch = (const float*)d_in[17];
    p.w_out = (const float*)d_in[18]; p.router_w = (const float*)d_in[19]; p.router_b = (const float*)d_in[20];
    p.w_gate = (const float*)d_in[21]; p.w_up = (const float*)d_in[22]; p.w_down = (const float*)d_in[23]; p.norm_final = (const float*)d_in[24];
    p.out = (float*)d_out;
    unsigned char* ws = (unsigned char*)d_ws;
    size_t o = 0;
    auto take = [&](size_t bytes) { unsigned char* r = ws + o; o = al256(o + bytes); return r; };
    p.bar = (unsigned*)take(XCD_BAR_WORDS * 4);
    p.cnt = (int*)take(1024);
    const size_t zero_bytes = o;
    p.modp = (float*)take((size_t)2 * 16 * 3 * 6144 * 4);
    p.mod = (float*)take((size_t)2 * 3 * 6144 * 4);
    p.xctx = (float*)take((size_t)RCTX * DM * 4);
    p.rope = (float*)take((size_t)192 * 8 * 2 * 4);
    p.hbuf = (u16*)take((size_t)RTOT * DM * 2);
    p.ybuf = (u16*)take((size_t)RTOT * DM * 2);
    p.Wt = (u16*)take((size_t)WT_TOTAL * 2);
    p.dq = (u16*)take((size_t)8 * KPOS * 64 * 2);
    p.dk = (u16*)take((size_t)8 * KPOS * 64 * 2);
    p.dvT = (u16*)take((size_t)8 * KPOS * 64 * 2);
    const size_t nst = (size_t)2 * 2 * NSTEP * 4;
    p.glaDec = (float*)take(nst * 64 * 4);
    p.mlN = (float*)take(nst * 64 * 4);
    p.mlFE = (float*)take(nst * 4);
    p.mlAE = (float*)take(nst * 4);
    p.mlM = (float*)take(nst * 4);
    p.glaS = (u16*)take(nst * 4096 * 2);
    p.mlS = (u16*)take(nst * 4096 * 2);
    p.gdM = (u16*)take(nst * 4096 * 2);
    p.gdN = (u16*)take(nst * 4096 * 2);
    p.gdQ = (u16*)take(nst * 4096 * 2);
    p.gdO = (u16*)take(nst * 4096 * 2);
    p.cols = (u16*)take((size_t)RTOT * NGATE * 2);
    hipMemsetAsync(ws, 0, zero_bytes, stream);

    static int grid = 0;
#if MULTI
#define SETUP(PH) hipFuncSetAttribute((const void*)k_phase<PH>, hipFuncAttributeMaxDynamicSharedMemorySize, LDS_BYTES + 16)
    if (!grid) {
        SETUP(PH_PRO0); SETUP(PH_PRO1); SETUP(PH_NORM1); SETUP(PH_INPROJ); SETUP(PH_PREP); SETUP(PH_CHUNKA); SETUP(PH_SCAN); SETUP(PH_OUT);
        SETUP(PH_GATES); SETUP(PH_MERGE1); SETUP(PH_MERGE2); SETUP(PH_ROUTER); SETUP(PH_MOEUP); SETUP(PH_MOEDOWN); SETUP(PH_FINAL);
        grid = 512;
    }
#define LAUNCH(PH, l) k_phase<PH><<<grid, NTHR, LDS_BYTES + 16, stream>>>(p, l)
    LAUNCH(PH_PRO0, 0); LAUNCH(PH_PRO1, 0);
    for (int l = 0; l < 2; ++l) {
        LAUNCH(PH_NORM1, l);
#if STAGE >= 1
        LAUNCH(PH_INPROJ, l); LAUNCH(PH_PREP, l); LAUNCH(PH_CHUNKA, l); LAUNCH(PH_SCAN, l); LAUNCH(PH_OUT, l);
        LAUNCH(PH_GATES, l); LAUNCH(PH_MERGE1, l); LAUNCH(PH_MERGE2, l);
#endif
        LAUNCH(PH_ROUTER, l); LAUNCH(PH_MOEUP, l); LAUNCH(PH_MOEDOWN, l);
    }
    LAUNCH(PH_FINAL, 0);
#else
    if (!grid) {
        hipFuncSetAttribute((const void*)k_mega, hipFuncAttributeMaxDynamicSharedMemorySize, LDS_BYTES + 16);
        int dev = 0, cus = 0, per_cu = 0;
        hipGetDevice(&dev);
        hipDeviceGetAttribute(&cus, hipDeviceAttributeMultiprocessorCount, dev);
        hipOccupancyMaxActiveBlocksPerMultiprocessor(&per_cu, (const void*)k_mega, NTHR, LDS_BYTES + 16);
        if (per_cu > 2) per_cu = 2;
        if (per_cu < 1) per_cu = 1;
        grid = cus * per_cu;
    }
    k_mega<<<grid, NTHR, LDS_BYTES + 16, stream>>>(p);
#endif
}
```

```cpp
#include <hip/hip_runtime.h>
#include <stdint.h>
#include <math.h>

typedef unsigned short u16;
typedef short bf16x8 __attribute__((ext_vector_type(8)));
typedef float f32x4 __attribute__((ext_vector_type(4)));
typedef unsigned u32x2 __attribute__((ext_vector_type(2)));
typedef unsigned u32x4 __attribute__((ext_vector_type(4)));

#define DEV __device__ __forceinline__
#define NTHR 256

#define DM 1024
#define RLAT 16384
#define RCTX 512
#define RTOT 16896
#define SEQ 8192
#define CTXL 256
#define NCM 3968
#define NGATE 4096
#define NSTEP 132
#define KPOS 8448
#define EPSF 1e-6f
#define GLA_Q 0
#define GLA_K 256
#define GLA_V 512
#define GLA_G 768
#define GLA_RF 1024
#define GLA_RB 1040
#define ML_Q 1056
#define ML_K 1312
#define ML_V 1568
#define ML_O 1824
#define ML_GF 2080
#define ML_GB 2088
#define GD_Q 2096
#define GD_K 2352
#define GD_V 2608
#define GD_OG 2864
#define GD_GF 3120
#define GD_GB 3128
#define DF_Q 3136
#define DF_K 3392
#define DF_V 3648

DEV int tidx() { int t = threadIdx.x; asm volatile("" : "+v"(t)); __builtin_assume(t >= 0 && t < NTHR); return t; }
DEV int launder_s(int v) { asm volatile("" : "+s"(v)); return v; }
typedef __bf16 bf2_t __attribute__((ext_vector_type(2)));
typedef float f2_t __attribute__((ext_vector_type(2)));
DEV unsigned pack2(float a, float b) { f2_t v; v.x = a; v.y = b; return __builtin_bit_cast(unsigned, __builtin_convertvector(v, bf2_t)); }
DEV u16 f2bf(float f) { return (u16)(pack2(f, 0.f) & 0xffffu); }
DEV float bf2f(u16 h) { return __uint_as_float(((unsigned)h) << 16); }
DEV float sigm(float x) { return 1.f / (1.f + __expf(-x)); }
DEV float silu(float x) { return x / (1.f + __expf(-x)); }
DEV float logsig(float x) { return fminf(x, 0.f) - __logf(1.f + __expf(-fabsf(x))); }
DEV float softplus(float x) { return fmaxf(x, 0.f) + __logf(1.f + __expf(-fabsf(x))); }
DEV float wsum(float v) {
#pragma unroll
    for (int o = 32; o; o >>= 1) v += __shfl_xor(v, o, 64);
    return v;
}
DEV float wmaxr(float v) {
#pragma unroll
    for (int o = 32; o; o >>= 1) v = fmaxf(v, __shfl_xor(v, o, 64));
    return v;
}
DEV f32x4 mfma16(bf16x8 a, bf16x8 b, f32x4 c) { return __builtin_amdgcn_mfma_f32_16x16x32_bf16(a, b, c, 0, 0, 0); }

#ifdef PROBE_SEL
#define PRB_BEGIN(id) unsigned long long prb_t0_##id = ((id) == PROBE_SEL) ? wall_clock64() : 0ull
#define PRB_END(id) do { if ((id) == PROBE_SEL) { __syncthreads(); if (threadIdx.x == 0) { volatile __attribute__((address_space(3))) unsigned long long* a_ = (volatile __attribute__((address_space(3))) unsigned long long*)(size_t)(75776 + 8); *a_ = *a_ + (wall_clock64() - prb_t0_##id); } } } while (0)
#else
#define PRB_BEGIN(id) do { } while (0)
#define PRB_END(id) do { } while (0)
#endif
#define RAW_BARRIER() do { asm volatile("s_waitcnt lgkmcnt(0)" ::: "memory"); __builtin_amdgcn_s_barrier(); } while (0)
struct P {
    const float *x, *c, *ctx, *c_ctx, *w_mod, *b_mod, *norm_mix, *norm_ffn, *w_in, *gla_a2, *gla_ab, *mlstm_gate_b,
        *gdn_conv, *gdn_a_log, *gdn_dt_bias, *diff_lambda, *head_norm, *w_branch, *w_out, *router_w, *router_b,
        *w_gate, *w_up, *w_down, *norm_final;
    float* out;
    unsigned* bar;
    int* cnt;
    float* modp;
    float* mod;
    float* xctx;
    float* rope;
    u16* hbuf;
    u16* ybuf;
    u16* Wt;
    u16* dq;
    u16* dk;
    u16* dvT;
    float* glaDec;
    float* mlN;
    float* mlFE;
    float* mlAE;
    float* mlM;
    u16* glaS;
    u16* mlS;
    u16* gdM;
    u16* gdN;
    u16* gdQ;
    u16* gdO;
    u16* cols;
};
#define MOE_WGU_OFF 0
#define MOE_WD_OFF (16u * 1024u * 1024u)
#define MOE_ACT_OFF (MOE_WD_OFF + 16u * 1024u * 512u)
#define MOE_LIST_OFF (MOE_ACT_OFF + 2u * RTOT * 512u)

DEV const float* xrow_in(const P& p, int l, int r) {
    if (l == 0) return r < RLAT ? p.x + (size_t)r * DM : p.ctx + (size_t)(r - RLAT) * DM;
    return r < RLAT ? p.out + (size_t)r * DM : p.xctx + (size_t)(r - RLAT) * DM;
}
DEV float* xrow_out(const P& p, int r) { return r < RLAT ? p.out + (size_t)r * DM : p.xctx + (size_t)(r - RLAT) * DM; }
DEV int modidx(int r) { return r < RLAT ? (r >> 13) : 2; }
DEV int chunk_row0(int b, int dir, int st) {
    if (st < 4) { int c = dir ? 3 - st : st; return RLAT + b * CTXL + c * 64; }
    int c = dir ? 131 - st : st - 4; return b * SEQ + c * 64;
}
DEV size_t state_idx(int dir, int b, int st, int h) { return ((size_t)((dir * 2 + b) * NSTEP + st) * 4 + h); }
#define XB_TMO      128
#define XB_XCNT(j)  (256  + 64 * (j))
#define XB_XSUB(j)  (1280 + 64 * (j))
#define XB_XGEN(j)  (2304 + 64 * (j))
#define XB_TOP      3328
#define XB_TOPGEN   3392
#define XCD_BAR_WORDS 3456
#define XB_SPIN_CAP (1u << 18)
#define LAS __attribute__((address_space(3)))

__device__ __forceinline__ unsigned xb_ld(unsigned* p)              { return __hip_atomic_load(p, __ATOMIC_RELAXED, __HIP_MEMORY_SCOPE_AGENT); }
__device__ __forceinline__ unsigned xb_add(unsigned* p, unsigned v) { return __hip_atomic_fetch_add(p, v, __ATOMIC_RELAXED, __HIP_MEMORY_SCOPE_AGENT); }
__device__ __forceinline__ unsigned xb_xcc_id() { return (unsigned)__builtin_amdgcn_s_getreg((3 << 11) | 20) & 0xFu; }
#define XB_SPIN(cond, bar) do { unsigned _sp = 0; while (cond) { __builtin_amdgcn_s_sleep(1); \
    if ((++_sp & 255u) == 0u) { if (xb_ld(&(bar)[XB_TMO])) break; if (_sp > XB_SPIN_CAP) { atomicAdd(&(bar)[XB_TMO], 1u); break; } } } } while (0)

struct XcdBarrier {
    unsigned* bar; unsigned x;
    volatile LAS unsigned* st;
};

__device__ __forceinline__ XcdBarrier xcd_barrier_post(unsigned* bar, volatile LAS unsigned* st) {
    XcdBarrier b; b.bar = bar; b.x = xb_xcc_id(); b.st = st;
    if (threadIdx.x == 0) (void)xb_add(&bar[XB_XCNT(b.x)], 1u);
    return b;
}
__device__ __forceinline__ void xcd_barrier_complete(unsigned* bar, unsigned x, unsigned& nloc, unsigned& nx) {
    const unsigned G = gridDim.x * gridDim.y * gridDim.z;
    unsigned sum, cnt, mine, sp = 0u;
    for (;;) {
        sum = 0u; cnt = 0u; mine = 0u;
#pragma unroll
        for (unsigned j = 0; j < 16; ++j) { const unsigned c = xb_ld(&bar[XB_XCNT(j)]); sum += c; cnt += (c > 0u) ? 1u : 0u; mine = (j == x) ? c : mine; }
        if (sum == G) break;
        __builtin_amdgcn_s_sleep(1);
        if ((++sp & 255u) == 0u) { if (xb_ld(&bar[XB_TMO])) break; if (sp > XB_SPIN_CAP) { atomicAdd(&bar[XB_TMO], 1u); break; } }
    }
    nloc = mine > 0u ? mine : 1u; nx = cnt > 0u ? cnt : 1u;
}

__device__ __forceinline__ void xcd_barrier(const XcdBarrier& b) {
    asm volatile("s_waitcnt vmcnt(0)" ::: "memory");
    __syncthreads();
    if (threadIdx.x == 0) {
        unsigned* bar = b.bar;
        __builtin_amdgcn_s_waitcnt(0);
        unsigned nloc = b.st[0], nx = b.st[1];
        if (nloc == 0u) { xcd_barrier_complete(bar, b.x, nloc, nx); b.st[0] = nloc; b.st[1] = nx; }
        const unsigned old = xb_add(&bar[XB_XSUB(b.x)], 1u);
        const unsigned gen = old / nloc;
        if (old + 1u == (gen + 1u) * nloc) {
            __builtin_amdgcn_fence(__ATOMIC_RELEASE, "agent");
            asm volatile("s_waitcnt vmcnt(0)" ::: "memory");
            const unsigned og = xb_add(&bar[XB_TOP], 1u);
            const unsigned tg = og / nx;
            if (og + 1u == (tg + 1u) * nx) xb_add(&bar[XB_TOPGEN], 1u);
            else XB_SPIN(xb_ld(&bar[XB_TOPGEN]) == tg, bar);
            __builtin_amdgcn_fence(__ATOMIC_ACQUIRE, "agent");
            xb_add(&bar[XB_XGEN(b.x)], 1u);
            asm volatile("s_waitcnt vmcnt(0)" ::: "memory");
        } else {
            XB_SPIN(xb_ld(&bar[XB_XGEN(b.x)]) == gen, bar);
            __builtin_amdgcn_fence(__ATOMIC_ACQUIRE, "agent");
            asm volatile("s_waitcnt vmcnt(0)" ::: "memory");
        }
    }
    __syncthreads();
}
struct TrJob { const float* src; u16* dst; int lds_, ldd, map; };
DEV int tr_rowmap(int map, int n) {
    if (map == 1) return n < 3904 ? n : n + 64;
    if (map == 2) return (n >> 5) * 64 + (n & 31);
    if (map == 3) return (n >> 5) * 64 + 32 + (n & 31);
    return n;
}
DEV void tr_load(const TrJob& j, float (&r)[16]) {
    const int t = tidx(), n = t & 63, kk = t >> 6;
#pragma unroll
    for (int i = 0; i < 16; ++i) r[i] = j.src[(size_t)(kk + 4 * i) * j.lds_ + n];
}
DEV void tr_finish(const TrJob& j, int n0, const float (&r)[16], float* sm) {
    const int t = tidx();
    {
        const int n = t & 63, kk = t >> 6;
#pragma unroll
        for (int i = 0; i < 16; ++i) sm[(kk + 4 * i) * 65 + n] = r[i];
    }
    __syncthreads();
    {
        const int kp = t & 31, nn = t >> 5;
#pragma unroll
        for (int i = 0; i < 8; ++i) {
            const int n = nn + 8 * i;
            const unsigned v = pack2(sm[(2 * kp) * 65 + n], sm[(2 * kp + 1) * 65 + n]);
            *(unsigned*)(j.dst + (size_t)tr_rowmap(j.map, n0 + n) * j.ldd + 2 * kp) = v;
        }
    }
    __syncthreads();
}
#define WT_WB_OFF (8064u * 1024u)
#define WT_WO_OFF (WT_WB_OFF + 4u * 1024u * 256u)
#define WT_TOTAL (WT_WO_OFF + 1024u * 1024u)

DEV TrJob mixw_job(const P& p, int l, int u, int& n0) {
    TrJob j;
    if (u < 2000) {
        const int kt = u / 125, nt = u % 125; n0 = nt * 64;
        j.src = p.w_in + (size_t)l * 1024 * 8000 + (size_t)kt * 64 * 8000 + n0; j.lds_ = 8000; j.dst = p.Wt + kt * 64; j.ldd = 1024; j.map = 1;
    } else if (u < 2256) {
        const int v = u - 2000, i = v >> 6, w = v & 63, kt = w >> 4, nt = w & 15; n0 = nt * 64;
        j.src = p.w_branch + (size_t)(l * 4 + i) * 256 * 1024 + (size_t)kt * 64 * 1024 + n0; j.lds_ = 1024;
        j.dst = p.Wt + WT_WB_OFF + (size_t)i * 1024 * 256 + kt * 64; j.ldd = 256; j.map = 0;
    } else {
        const int v = u - 2256, kt = v >> 4, nt = v & 15; n0 = nt * 64;
        j.src = p.w_out + (size_t)l * 1024 * 1024 + (size_t)kt * 64 * 1024 + n0; j.lds_ = 1024; j.dst = p.Wt + WT_WO_OFF + kt * 64; j.ldd = 1024; j.map = 0;
    }
    return j;
}
DEV void phase_conv_mixw(const P& p, int l, int bid, int nb, float* sm) {
    if (bid == nb - 1) {
        unsigned* z = (unsigned*)(p.Wt + (size_t)3904 * 1024);
        for (int i = tidx(); i < 64 * 1024 / 2; i += NTHR) z[i] = 0u;
    }
    int u = bid, n0 = 0, n1 = 0;
    if (u >= 2512) return;
    float r[16];
    TrJob j = mixw_job(p, l, u, n0);
    tr_load(j, r);
    for (;;) {
        const int un = u + nb;
        float rn[16]; TrJob jn = j;
        if (un < 2512) { jn = mixw_job(p, l, un, n1); tr_load(jn, rn); }
        tr_finish(j, n0, r, sm);
        if (un >= 2512) break;
        u = un; j = jn; n0 = n1;
#pragma unroll
        for (int i = 0; i < 16; ++i) r[i] = rn[i];
    }
}
DEV TrJob moew_job(const P& p, int l, int u, int& n0) {
    TrJob j;
    u16* wgu = p.cols + MOE_WGU_OFF;
    u16* wd = p.cols + MOE_WD_OFF;
    const int e = u / 384, v = u % 384;
    const size_t le = (size_t)(l * 16 + e);
    if (v < 256) {
        const int w = v & 127, kt = w >> 3, nt = w & 7; n0 = nt * 64;
        j.src = (v < 128 ? p.w_gate : p.w_up) + le * 1024 * 512 + (size_t)kt * 64 * 512 + n0; j.lds_ = 512;
        j.dst = wgu + (size_t)e * 1024 * 1024 + kt * 64; j.ldd = 1024; j.map = v < 128 ? 2 : 3;
    } else {
        const int w = v - 256, kt = w >> 4, nt = w & 15; n0 = nt * 64;
        j.src = p.w_down + le * 512 * 1024 + (size_t)kt * 64 * 1024 + n0; j.lds_ = 1024; j.dst = wd + (size_t)e * 1024 * 512 + kt * 64; j.ldd = 512; j.map = 0;
    }
    return j;
}
DEV void phase_conv_moew(const P& p, int l, int bid, int nb, float* sm) {
    int u = bid, n0 = 0, n1 = 0;
    if (u >= 16 * 384) return;
    float r[16];
    TrJob j = moew_job(p, l, u, n0);
    tr_load(j, r);
    for (;;) {
        const int un = u + nb;
        float rn[16]; TrJob jn = j;
        if (un < 16 * 384) { jn = moew_job(p, l, un, n1); tr_load(jn, rn); }
        tr_finish(j, n0, r, sm);
        if (un >= 16 * 384) break;
        u = un; j = jn; n0 = n1;
#pragma unroll
        for (int i = 0; i < 16; ++i) r[i] = rn[i];
    }
}

DEV void phase_mod_partial(const P& p, int bid, int nb, float* sm) {
    for (int u = bid; u < 768; u += nb) {
        const int l = u / 384, v = u % 384, kc = v / 24, jb = v % 24;
        const int t = tidx();
        __syncthreads();
        if (t < 192) {
            const int m = t >> 6, k = kc * 64 + (t & 63);
            const float cv = m < 2 ? p.c[m * 1024 + k] : p.c_ctx[k];
            sm[t] = silu(cv);
        }
        __syncthreads();
        const int j = jb * 256 + t;
        const float* w = p.w_mod + ((size_t)l * 1024 + kc * 64) * 6144 + j;
        float a0 = 0.f, a1 = 0.f, a2 = 0.f;
#pragma unroll 8
        for (int k = 0; k < 64; ++k) {
            const float wv = w[(size_t)k * 6144];
            a0 += sm[k] * wv; a1 += sm[64 + k] * wv; a2 += sm[128 + k] * wv;
        }
        float* o = p.modp + ((size_t)(l * 16 + kc) * 3) * 6144 + j;
        o[0] = a0; o[6144] = a1; o[2 * 6144] = a2;
    }
}
DEV void phase_mod_reduce(const P& p, int bid, int nb) {
    for (int i = bid * NTHR + tidx(); i < 2 * 3 * 6144; i += nb * NTHR) {
        const int l = i / (3 * 6144), r = i % (3 * 6144), m = r / 6144, j = r % 6144;
        float a = p.b_mod[l * 6144 + j];
        for (int kc = 0; kc < 16; ++kc) a += p.modp[((size_t)(l * 16 + kc) * 3 + m) * 6144 + j];
        p.mod[i] = a;
    }
}

DEV void moe_combine_row(const P& p, int l, int r, int lane, float4 (&v)[4]);
DEV void phase_norm1(const P& p, int l, int bid, int nb) {
    const int lane = tidx() & 63, w = tidx() >> 6;
    for (int r = bid * 4 + w; r < RTOT; r += nb * 4) {
        const float* xr = xrow_in(p, l, r);
        const int m = modidx(r);
        const float* sh = p.mod + ((size_t)(l * 3 + m)) * 6144;
        const float* sc = sh + 1024;
        float4 v[4]; float ss = 0.f;
#pragma unroll
        for (int i = 0; i < 4; ++i) v[i] = *(const float4*)(xr + lane * 4 + i * 256);
        if (l == 1) {
            moe_combine_row(p, 0, r, lane, v);
            float* xw = xrow_out(p, r);
#pragma unroll
            for (int i = 0; i < 4; ++i) *(float4*)(xw + lane * 4 + i * 256) = v[i];
        }
#pragma unroll
        for (int i = 0; i < 4; ++i) ss += v[i].x * v[i].x + v[i].y * v[i].y + v[i].z * v[i].z + v[i].w * v[i].w;
        ss = wsum(ss);
        const float rs = rsqrtf(ss * (1.f / 1024.f) + EPSF);
#pragma unroll
        for (int i = 0; i < 4; ++i) {
            const int c = lane * 4 + i * 256;
            const float4 g = *(const float4*)(p.norm_mix + l * 1024 + c);
            const float4 s1 = *(const float4*)(sc + c);
            const float4 h1 = *(const float4*)(sh + c);
            const float o0 = v[i].x * rs * g.x * (1.f + s1.x) + h1.x;
            const float o1 = v[i].y * rs * g.y * (1.f + s1.y) + h1.y;
            const float o2 = v[i].z * rs * g.z * (1.f + s1.z) + h1.z;
            const float o3 = v[i].w * rs * g.w * (1.f + s1.w) + h1.w;
            u32x2 pk; pk.x = pack2(o0, o1); pk.y = pack2(o2, o3);
            *(u32x2*)(p.hbuf + (size_t)r * 1024 + c) = pk;
        }
    }
}

#define LDP 72
#define GEMM_STAGE (2 * 128 * 64)
DEV int g_row(int tid, int i) { return (tid >> 6) * 32 + i * 8 + ((tid >> 3) & 7); }
DEV int g_kc(int tid, int row) { return ((tid & 7) ^ ((row >> 1) & 7)) * 8; }
DEV void gemm_mainloop(f32x4 (&acc)[4][4], const u16* const (&xp)[4], const u16* const (&wp)[4], int KT, u16* sm, u16*  ) {
    const int tid = tidx(), lane = tid & 63, w = tid >> 6, wn = w & 1, wm = w >> 1;
    const int fr = lane & 15, fq = lane >> 4, sw = (fr >> 1) & 7;
    asm volatile("s_waitcnt vmcnt(0)" ::: "memory");
#pragma unroll
    for (int i = 0; i < 4; ++i) {
        __builtin_amdgcn_global_load_lds((const unsigned*)xp[i], (unsigned*)(sm + (w * 4 + i) * 512), 16, 0, 0);
        __builtin_amdgcn_global_load_lds((const unsigned*)wp[i], (unsigned*)(sm + 128 * 64 + (w * 4 + i) * 512), 16, 0, 0);
    }
    for (int kt = 0; kt < KT; ++kt) {
        asm volatile("s_waitcnt vmcnt(0)" ::: "memory");
        RAW_BARRIER();
        if (kt + 1 < KT) {
            u16* nx = sm + ((kt + 1) & 1) * GEMM_STAGE;
#pragma unroll
            for (int i = 0; i < 4; ++i) {
                __builtin_amdgcn_global_load_lds((const unsigned*)(xp[i] + (kt + 1) * 64), (unsigned*)(nx + (w * 4 + i) * 512), 16, 0, 0);
                __builtin_amdgcn_global_load_lds((const unsigned*)(wp[i] + (kt + 1) * 64), (unsigned*)(nx + 128 * 64 + (w * 4 + i) * 512), 16, 0, 0);
            }
        }
        const u16* sX = sm + (kt & 1) * GEMM_STAGE;
        const u16* sW = sX + 128 * 64;
#pragma unroll
        for (int ks = 0; ks < 2; ++ks) {
            bf16x8 a[4], b[4];
#pragma unroll
            for (int q = 0; q < 4; ++q) {
                a[q] = *(const bf16x8*)(sW + (wn * 64 + q * 16 + fr) * 64 + (((ks * 4 + fq) ^ sw) * 8));
                b[q] = *(const bf16x8*)(sX + (wm * 64 + q * 16 + fr) * 64 + (((ks * 4 + fq) ^ sw) * 8));
            }
#pragma unroll
            for (int nt = 0; nt < 4; ++nt)
#pragma unroll
                for (int mt = 0; mt < 4; ++mt) acc[nt][mt] = mfma16(a[nt], b[mt], acc[nt][mt]);
        }
    }
    RAW_BARRIER();
}
DEV void zero_acc(f32x4 (&acc)[4][4]) {
#pragma unroll
    for (int a = 0; a < 4; ++a)
#pragma unroll
        for (int b = 0; b < 4; ++b) acc[a][b] = f32x4{0.f, 0.f, 0.f, 0.f};
}

#define GB_STAGE (384 * 32)
DEV void gemmb_issue(const u16* const (&xp)[4], const u16* const (&wp)[2], int kt, u16* stg, int w) {
#pragma unroll
    for (int i = 0; i < 4; ++i) __builtin_amdgcn_global_load_lds((const unsigned*)(xp[i] + kt * 32), (unsigned*)(stg + (w * 4 + i) * 512), 16, 0, 0);
#pragma unroll
    for (int i = 0; i < 2; ++i) __builtin_amdgcn_global_load_lds((const unsigned*)(wp[i] + kt * 32), (unsigned*)(stg + 256 * 32 + (w * 2 + i) * 512), 16, 0, 0);
}
template <bool SIG, int GMODE = 0>
DEV void phase_inproj(const P& p, int wrow0, int ntn, int ldc, int mtiles256, int bid, int nb, u16* sm) {
    const int tid = tidx(), lane = tid & 63, w = tid >> 6, wn = w & 1, wm = w >> 1, fr = lane & 15, fq = lane >> 4;
    const int sw = (fr >> 2) & 3;
    const int aoff = (wn * 64 + fr) * 32 + ((fq ^ sw) * 8) + 256 * 32;
    const int boff = (wm * 128 + fr) * 32 + ((fq ^ sw) * 8);
    for (int u = bid; u < mtiles256 * ntn; u += nb) {
        const int uu = GMODE >= 2 ? launder_s(u) & 1 : u;
        const int mt_ = uu / ntn, nt_ = uu % ntn;
        const int m0 = mt_ * 256, n0 = nt_ * 128;
        const u16* xb = p.hbuf + (size_t)m0 * 1024;
        const u16* wb = p.Wt + (size_t)(wrow0 + n0) * 1024;
        const int t3 = tidx(), l3 = t3 & 63, w3 = t3 >> 6;
        const unsigned cl = (unsigned)(((l3 & 3) ^ ((l3 >> 4) & 3)) * 8);
        const unsigned xo = (unsigned)((w3 * 64 + (l3 >> 2)) * 1024) + cl;
        const unsigned wo = (unsigned)((w3 * 32 + (l3 >> 2)) * 1024) + cl;
        f32x4 acc[4][8];
#pragma unroll
        for (int a = 0; a < 4; ++a)
#pragma unroll
            for (int b = 0; b < 8; ++b) acc[a][b] = f32x4{0.f, 0.f, 0.f, 0.f};
        asm volatile("s_waitcnt vmcnt(0)" ::: "memory");
#pragma unroll
        for (int t0 = 0; t0 < 2; ++t0) {
#pragma unroll
            for (int i = 0; i < 4; ++i) __builtin_amdgcn_global_load_lds((const unsigned*)(xb + xo + i * 16384 + t0 * 32), (unsigned*)(sm + t0 * GB_STAGE + (w * 4 + i) * 512), 16, 0, 0);
#pragma unroll
            for (int i = 0; i < 2; ++i) __builtin_amdgcn_global_load_lds((const unsigned*)(wb + wo + i * 16384 + t0 * 32), (unsigned*)(sm + t0 * GB_STAGE + 256 * 32 + (w * 2 + i) * 512), 16, 0, 0);
        }
        asm volatile("s_waitcnt vmcnt(6)" ::: "memory");
        RAW_BARRIER();
        bf16x8 a[4], b[8];
#pragma unroll
        for (int q = 0; q < 4; ++q) a[q] = *(const bf16x8*)(sm + aoff + q * 512);
#pragma unroll
        for (int q = 0; q < 8; ++q) b[q] = *(const bf16x8*)(sm + boff + q * 512);
        for (int kt = 0; kt < 32; ++kt) {
            asm volatile("s_waitcnt vmcnt(0)" ::: "memory");
            if (GMODE != 5 && GMODE != 6) RAW_BARRIER();
            const bool more = kt + 2 < 32 && GMODE != 4 && GMODE != 6, nxt = kt + 1 < 32 && GMODE != 3 && GMODE != 6;
            u16* nx = sm + ((kt + 2) % 3) * GB_STAGE;
            const u16* cur = sm + ((kt + 1) % 3) * GB_STAGE;
#pragma unroll
            for (int h = 0; h < 2; ++h) {
                if (more) {
                    __builtin_amdgcn_global_load_lds((const unsigned*)(xb + (kt + 2) * 32 + xo + (2 * h) * 16384), (unsigned*)(nx + (w * 4 + 2 * h) * 512), 16, 0, 0);
                    __builtin_amdgcn_global_load_lds((const unsigned*)(xb + (kt + 2) * 32 + xo + (2 * h + 1) * 16384), (unsigned*)(nx + (w * 4 + 2 * h + 1) * 512), 16, 0, 0);
                    __builtin_amdgcn_global_load_lds((const unsigned*)(wb + (kt + 2) * 32 + wo + h * 16384), (unsigned*)(nx + 256 * 32 + (w * 2 + h) * 512), 16, 0, 0);
                }
#pragma unroll
                for (int nt = 0; nt < 4; ++nt) {
#pragma unroll
                    for (int mt = 0; mt < 4; ++mt) acc[nt][4 * h + mt] = mfma16(a[nt], b[4 * h + mt], acc[nt][4 * h + mt]);
                    if (h == 1 && nxt) a[nt] = *(const bf16x8*)(cur + aoff + nt * 512);
                }
                __builtin_amdgcn_sched_barrier(0);
                if (nxt) {
#pragma unroll
                    for (int mt = 0; mt < 4; ++mt) b[4 * h + mt] = *(const bf16x8*)(cur + boff + (4 * h + mt) * 512);
                }
            }
        }
        RAW_BARRIER();
        const int t2 = tidx(), l2 = t2 & 63, w2 = t2 >> 6;
        const int en = n0 + (w2 & 1) * 64 + (l2 >> 4) * 4, em = m0 + (w2 >> 1) * 128 + (l2 & 15);
#pragma unroll
        for (int nt = 0; nt < 4; ++nt)
#pragma unroll
            for (int mt = 0; mt < 8; ++mt) {
                const int n = en + nt * 16, m = em + mt * 16;
                f32x4 v = acc[nt][mt];
                if (SIG) { v[0] = sigm(v[0]); v[1] = sigm(v[1]); v[2] = sigm(v[2]); v[3] = sigm(v[3]); }
                u32x2 pk; pk.x = pack2(v[0], v[1]); pk.y = pack2(v[2], v[3]);
                if (GMODE == 0 || v[0] == 123456.789f) *(u32x2*)(p.cols + (size_t)m * ldc + n) = pk;
            }
    }
}

DEV void phase_merge1(const P& p, u16* ubuf, int mtiles, int bid, int nb, u16* sm) {
    u16* sX = sm; u16* sW = sm + 128 * LDP;
    const int tid = tidx(), lane = tid & 63, w = tid >> 6, wn = w & 1, wm = w >> 1, fr = lane & 15, fq = lane >> 4;
    for (int u = bid; u < mtiles * 8; u += nb) {
        const int mt_ = u >> 3, nt_ = u & 7;
        const int m0 = mt_ * 128, n0 = nt_ * 128;
        f32x4 tot[4][4]; zero_acc(tot);
        for (int br = 0; br < 4; ++br) {
            const int tu = tidx();
        const u16* xp[4]; const u16* wp[4];
#pragma unroll
            for (int i = 0; i < 4; ++i) {
                const int row = g_row(tu, i), kc = g_kc(tu, row);
                xp[i] = p.ybuf + (size_t)(m0 + row) * 1024 + br * 256 + kc;
                wp[i] = p.Wt + WT_WB_OFF + ((size_t)br * 1024 + n0 + row) * 256 + kc;
            }
            f32x4 acc[4][4]; zero_acc(acc);
            gemm_mainloop(acc, xp, wp, 4, sX, sW);
#pragma unroll
            for (int nt = 0; nt < 4; ++nt)
#pragma unroll
                for (int mt = 0; mt < 4; ++mt) {
                    const int n = n0 + wn * 64 + nt * 16 + fq * 4, m = m0 + wm * 64 + mt * 16 + fr;
                    const u32x2 g = *(const u32x2*)(p.cols + (size_t)m * NGATE + br * 1024 + n);
                    tot[nt][mt][0] += bf2f((u16)(g.x & 0xffff)) * acc[nt][mt][0];
                    tot[nt][mt][1] += bf2f((u16)(g.x >> 16)) * acc[nt][mt][1];
                    tot[nt][mt][2] += bf2f((u16)(g.y & 0xffff)) * acc[nt][mt][2];
                    tot[nt][mt][3] += bf2f((u16)(g.y >> 16)) * acc[nt][mt][3];
                }
        }
#pragma unroll
        for (int nt = 0; nt < 4; ++nt)
#pragma unroll
            for (int mt = 0; mt < 4; ++mt) {
                const int n = n0 + wn * 64 + nt * 16 + fq * 4, m = m0 + wm * 64 + mt * 16 + fr;
                u32x2 pk; pk.x = pack2(tot[nt][mt][0], tot[nt][mt][1]); pk.y = pack2(tot[nt][mt][2], tot[nt][mt][3]);
                *(u32x2*)(ubuf + (size_t)m * 1024 + n) = pk;
            }
    }
}

DEV void phase_merge2(const P& p, int l, const u16* ubuf, int mtiles, int bid, int nb, u16* sm) {
    u16* sX = sm; u16* sW = sm + 128 * LDP;
    const int tid = tidx(), lane = tid & 63, w = tid >> 6, wn = w & 1, wm = w >> 1, fr = lane & 15, fq = lane >> 4;
    for (int u = bid; u < mtiles * 8; u += nb) {
        const int mt_ = u >> 3, nt_ = u & 7;
        const int m0 = mt_ * 128, n0 = nt_ * 128;
        const int tu = tidx();
        const u16* xp[4]; const u16* wp[4];
#pragma unroll
        for (int i = 0; i < 4; ++i) {
            const int row = g_row(tu, i), kc = g_kc(tu, row);
            xp[i] = ubuf + (size_t)(m0 + row) * 1024 + kc;
            wp[i] = p.Wt + WT_WO_OFF + (size_t)(n0 + row) * 1024 + kc;
        }
        f32x4 acc[4][4]; zero_acc(acc);
        gemm_mainloop(acc, xp, wp, 16, sX, sW);
#pragma unroll
        for (int nt = 0; nt < 4; ++nt)
#pragma unroll
            for (int mt = 0; mt < 4; ++mt) {
                const int n = n0 + wn * 64 + nt * 16 + fq * 4, m = m0 + wm * 64 + mt * 16 + fr;
                const float4 xo = *(const float4*)(xrow_in(p, l, m) + n);
                const float4 g = *(const float4*)(p.mod + (size_t)(l * 3 + modidx(m)) * 6144 + 2048 + n);
                float4 o;
                o.x = xo.x + g.x * acc[nt][mt][0]; o.y = xo.y + g.y * acc[nt][mt][1];
                o.z = xo.z + g.z * acc[nt][mt][2]; o.w = xo.w + g.w * acc[nt][mt][3];
                *(float4*)(xrow_out(p, m) + n) = o;
            }
    }
}
DEV void phase_norm2_router(const P& p, int l, int nrows, int bid, int nb, float* sm) {
    const int tid = tidx(), lane = tid & 63, w = tid >> 6;
    int* list = (int*)(p.cols + MOE_LIST_OFF);
    float* slotw = (float*)(list + 16 * RTOT);
    int* tokslot = (int*)(slotw + 16 * RTOT);
    float* tokw = (float*)(tokslot + 2 * RTOT);
    int* lcnt = (int*)(sm + 16 * 1024);
    int* rinfo = lcnt + 32;
    float* rwgt = (float*)(rinfo + 4 * 40 * 2);
#pragma unroll 16
    for (int i = tid; i < 16 * 1024; i += NTHR) { const int c = i >> 4, e = i & 15; sm[e * 1024 + c] = p.router_w[i]; }
    if (tid < 32) lcnt[tid] = 0;
    __syncthreads();
    int kk = 0;
    for (int r = bid * 4 + w; r < nrows; r += nb * 4, ++kk) {
        const float* xr = xrow_out(p, r);
        const int m = modidx(r);
        const float* sh = p.mod + ((size_t)(l * 3 + m)) * 6144 + 3072;
        const float* sc = sh + 1024;
        float4 v[4]; float ss = 0.f;
#pragma unroll
        for (int i = 0; i < 4; ++i) {
            v[i] = *(const float4*)(xr + lane * 4 + i * 256);
            ss += v[i].x * v[i].x + v[i].y * v[i].y + v[i].z * v[i].z + v[i].w * v[i].w;
        }
        ss = wsum(ss);
        const float rs = rsqrtf(ss * (1.f / 1024.f) + EPSF);
#pragma unroll
        for (int i = 0; i < 4; ++i) {
            const int c = lane * 4 + i * 256;
            const float4 g = *(const float4*)(p.norm_ffn + l * 1024 + c);
            const float4 s1 = *(const float4*)(sc + c);
            const float4 h1 = *(const float4*)(sh + c);
            v[i].x = v[i].x * rs * g.x * (1.f + s1.x) + h1.x;
            v[i].y = v[i].y * rs * g.y * (1.f + s1.y) + h1.y;
            v[i].z = v[i].z * rs * g.z * (1.f + s1.z) + h1.z;
            v[i].w = v[i].w * rs * g.w * (1.f + s1.w) + h1.w;
            u32x2 pk; pk.x = pack2(v[i].x, v[i].y); pk.y = pack2(v[i].z, v[i].w);
            *(u32x2*)(p.hbuf + (size_t)r * 1024 + c) = pk;
        }
        float sel[16], scr[16];
#pragma unroll
        for (int e = 0; e < 16; ++e) scr[e] = 0.f;
#pragma unroll
        for (int i = 0; i < 4; ++i) {
#pragma unroll
            for (int e = 0; e < 16; ++e) {
                const float4 rw = *(const float4*)(sm + e * 1024 + lane * 4 + i * 256);
                scr[e] += v[i].x * rw.x + v[i].y * rw.y + v[i].z * rw.z + v[i].w * rw.w;
            }
            __builtin_amdgcn_sched_barrier(0);
        }
#pragma unroll
        for (int e = 0; e < 16; ++e) {
            const float a = wsum(scr[e]);
            scr[e] = sigm(a);
            sel[e] = scr[e] + p.router_b[e];
        }
        int bg = 0; float bgs = -INFINITY;
#pragma unroll
        for (int g = 0; g < 4; ++g) {
            float m1 = -INFINITY, m2 = -INFINITY;
#pragma unroll
            for (int j = 0; j < 4; ++j) {
                const float s = sel[g * 4 + j];
                if (s > m1) { m2 = m1; m1 = s; } else if (s > m2) { m2 = s; }
            }
            const float gs = m1 + m2;
            if (gs > bgs) { bgs = gs; bg = g; }
        }
        float gsel[4], gscr[4];
#pragma unroll
        for (int j = 0; j < 4; ++j) { gsel[j] = -INFINITY; gscr[j] = 0.f; }
#pragma unroll
        for (int g = 0; g < 4; ++g)
#pragma unroll
            for (int j = 0; j < 4; ++j) if (bg == g) { gsel[j] = sel[g * 4 + j]; gscr[j] = scr[g * 4 + j]; }
        int j1 = 0; float v1 = gsel[0], w1 = gscr[0];
#pragma unroll
        for (int j = 1; j < 4; ++j) if (gsel[j] > v1) { v1 = gsel[j]; w1 = gscr[j]; j1 = j; }
        int j2 = -1; float v2 = -INFINITY, w2 = 0.f;
#pragma unroll
        for (int j = 0; j < 4; ++j) if (j != j1 && (j2 < 0 || gsel[j] > v2)) { v2 = gsel[j]; w2 = gscr[j]; j2 = j; }
        const float inv = 1.f / (w1 + w2);
        if (lane == 0) {
            const int e1 = bg * 4 + j1, e2 = bg * 4 + j2;
            const int p1 = atomicAdd(lcnt + e1, 1);
            const int p2 = atomicAdd(lcnt + e2, 1);
            rinfo[(w * 40 + kk) * 2 + 0] = e1 * 65536 + p1; rwgt[(w * 40 + kk) * 2 + 0] = w1 * inv;
            rinfo[(w * 40 + kk) * 2 + 1] = e2 * 65536 + p2; rwgt[(w * 40 + kk) * 2 + 1] = w2 * inv;
        }
    }
    __syncthreads();
    if (tid < 16) lcnt[16 + tid] = lcnt[tid] ? atomicAdd(p.cnt + l * 16 + tid, lcnt[tid]) : 0;
    __syncthreads();
    if (lane < 2) {
        int k2 = 0;
        for (int r = bid * 4 + w; r < nrows; r += nb * 4, ++k2) {
            const int inf = rinfo[(w * 40 + k2) * 2 + lane], e = inf >> 16, slot = lcnt[16 + e] + (inf & 65535);
            const float wg = rwgt[(w * 40 + k2) * 2 + lane];
            list[e * RTOT + slot] = r; slotw[e * RTOT + slot] = wg;
            tokslot[r * 2 + lane] = e * RTOT + slot; tokw[r * 2 + lane] = wg;
        }
    }
    __syncthreads();
}

DEV bool moe_find(const int* cnt, int ut, int& e, int& mt, int& off, int& ce) {
    int tb = 0, o = 0;
    for (int k = 0; k < 16; ++k) {
        const int c = cnt[k], nt = (c + 127) >> 7;
        if (ut < tb + nt) { e = k; mt = ut - tb; off = o; ce = c; return true; }
        tb += nt; o += c;
    }
    return false;
}

DEV void phase_moe_up(const P& p, int l, int bid, int nb, u16* sm) {
    u16* sX = sm; u16* sW = sm + 128 * LDP;
    const int tid = tidx(), lane = tid & 63, w = tid >> 6, wn = w & 1, wm = w >> 1, fr = lane & 15, fq = lane >> 4;
    const int* cnt = p.cnt + l * 16;
    const int* list = (const int*)(p.cols + MOE_LIST_OFF);
    const u16* wgu = p.cols + MOE_WGU_OFF;
    u16* act = p.cols + MOE_ACT_OFF;
    for (int u = bid;; u += nb) {
        int e, mtile, off, ce;
        if (!moe_find(cnt, u >> 3, e, mtile, off, ce)) break;
        const int n0 = (u & 7) * 128;
        const int tu = tidx();
        const u16* xp[4]; const u16* wp[4];
#pragma unroll
        for (int i = 0; i < 4; ++i) {
            const int row = g_row(tu, i), kc = g_kc(tu, row);
            int s = mtile * 128 + row; s = s < ce ? s : ce - 1;
            const int tok = list[e * RTOT + s];
            xp[i] = p.hbuf + (size_t)tok * 1024 + kc;
            wp[i] = wgu + ((size_t)e * 1024 + n0 + row) * 1024 + kc;
        }
        f32x4 acc[4][4]; zero_acc(acc);
        gemm_mainloop(acc, xp, wp, 16, sX, sW);
#pragma unroll
        for (int nt = 0; nt < 2; ++nt)
#pragma unroll
            for (int mt = 0; mt < 4; ++mt) {
                const int col = ((n0 >> 6) + wn) * 32 + nt * 16 + fq * 4;
                const int s = mtile * 128 + wm * 64 + mt * 16 + fr;
                if (s < ce) {
                    const f32x4 g = acc[nt][mt], uu = acc[nt + 2][mt];
                    u32x2 pk; pk.x = pack2(silu(g[0]) * uu[0], silu(g[1]) * uu[1]); pk.y = pack2(silu(g[2]) * uu[2], silu(g[3]) * uu[3]);
                    *(u32x2*)(act + (size_t)(off + s) * 512 + col) = pk;
                }
            }
    }
}

DEV void phase_moe_down(const P& p, int l, int bid, int nb, u16* sm) {
    u16* sX = sm; u16* sW = sm + 128 * LDP;
    const int tid = tidx(), lane = tid & 63, w = tid >> 6, wn = w & 1, wm = w >> 1, fr = lane & 15, fq = lane >> 4;
    const int* cnt = p.cnt + l * 16;
    const int* list = (const int*)(p.cols + MOE_LIST_OFF);
    u16* yslot = p.glaS;
    const u16* wd = p.cols + MOE_WD_OFF;
    const u16* act = p.cols + MOE_ACT_OFF;
    for (int u = bid;; u += nb) {
        int e, mtile, off, ce;
        if (!moe_find(cnt, u >> 3, e, mtile, off, ce)) break;
        const int n0 = (u & 7) * 128;
        const int tu = tidx();
        const u16* xp[4]; const u16* wp[4];
#pragma unroll
        for (int i = 0; i < 4; ++i) {
            const int row = g_row(tu, i), kc = g_kc(tu, row);
            int s = mtile * 128 + row; s = s < ce ? s : ce - 1;
            xp[i] = act + (size_t)(off + s) * 512 + kc;
            wp[i] = wd + ((size_t)e * 1024 + n0 + row) * 512 + kc;
        }
        f32x4 acc[4][4]; zero_acc(acc);
        gemm_mainloop(acc, xp, wp, 8, sX, sW);
#pragma unroll
        for (int mt = 0; mt < 4; ++mt) {
            const int s = mtile * 128 + wm * 64 + mt * 16 + fr;
            if (s < ce) {
#pragma unroll
                for (int nt = 0; nt < 4; ++nt) {
                    const int n = n0 + wn * 64 + nt * 16 + fq * 4;
                    u32x2 pk; pk.x = pack2(acc[nt][mt][0], acc[nt][mt][1]); pk.y = pack2(acc[nt][mt][2], acc[nt][mt][3]);
                    *(u32x2*)(yslot + (size_t)(off + s) * 1024 + n) = pk;
                }
            }
        }
    }
}

DEV void moe_combine_row(const P& p, int l, int r, int lane, float4 (&v)[4]) {
    const int* cnt = p.cnt + l * 16;
    const int* list = (const int*)(p.cols + MOE_LIST_OFF);
    const int* tokslot = (const int*)((const float*)(list + 16 * RTOT) + 16 * RTOT);
    const float* tokw = (const float*)(tokslot + 2 * RTOT);
    const u16* yslot = p.glaS;
    const float* g2 = p.mod + (size_t)(l * 3 + modidx(r)) * 6144 + 5120;
#pragma unroll
    for (int j = 0; j < 2; ++j) {
        const int ts = tokslot[r * 2 + j], e = ts / RTOT, slot = ts % RTOT;
        const float wg = tokw[r * 2 + j];
        int off = 0;
        for (int k = 0; k < e; ++k) off += cnt[k];
        const u16* yr = yslot + (size_t)(off + slot) * 1024;
#pragma unroll
        for (int i = 0; i < 4; ++i) {
            const int c = lane * 4 + i * 256;
            const u32x2 yv = *(const u32x2*)(yr + c);
            const float4 g = *(const float4*)(g2 + c);
            v[i].x += g.x * wg * __uint_as_float(yv.x << 16); v[i].y += g.y * wg * __uint_as_float(yv.x & 0xffff0000u);
            v[i].z += g.z * wg * __uint_as_float(yv.y << 16); v[i].w += g.w * wg * __uint_as_float(yv.y & 0xffff0000u);
        }
    }
}

DEV void phase_final_norm(const P& p, int bid, int nb) {
    const int lane = tidx() & 63, w = tidx() >> 6;
    for (int r = bid * 4 + w; r < RLAT; r += nb * 4) {
        float* xr = p.out + (size_t)r * DM;
        float4 v[4]; float ss = 0.f;
#pragma unroll
        for (int i = 0; i < 4; ++i) v[i] = *(const float4*)(xr + lane * 4 + i * 256);
        moe_combine_row(p, 1, r, lane, v);
#pragma unroll
        for (int i = 0; i < 4; ++i) ss += v[i].x * v[i].x + v[i].y * v[i].y + v[i].z * v[i].z + v[i].w * v[i].w;
        ss = wsum(ss);
        const float rs = rsqrtf(ss * (1.f / 1024.f) + EPSF);
#pragma unroll
        for (int i = 0; i < 4; ++i) {
            const int c = lane * 4 + i * 256;
            const float4 g = *(const float4*)(p.norm_final + c);
            float4 o; o.x = v[i].x * rs * g.x; o.y = v[i].y * rs * g.y; o.z = v[i].z * rs * g.z; o.w = v[i].w * rs * g.w;
            *(float4*)(xr + c) = o;
        }
    }
}
DEV float wscan_add(float v, int lane) {
#pragma unroll
    for (int o = 1; o < 64; o <<= 1) { const float t = __shfl_up(v, o, 64); if (lane >= o) v += t; }
    return v;
}
DEV float wscan_max(float v, int lane) {
#pragma unroll
    for (int o = 1; o < 64; o <<= 1) { const float t = __shfl_up(v, o, 64); if (lane >= o) v = fmaxf(v, t); }
    return v;
}
DEV void mm64(f32x4 (&acc)[4], const u16* A, int lda, const u16* Bt, int ldb) {
    const int lane = tidx() & 63, w = tidx() >> 6, fr = lane & 15, fq = lane >> 4;
#pragma unroll
    for (int ks = 0; ks < 2; ++ks) {
        const bf16x8 a = *(const bf16x8*)(A + (16 * w + fr) * lda + ks * 32 + fq * 8);
#pragma unroll
        for (int nt = 0; nt < 4; ++nt) {
            const bf16x8 b = *(const bf16x8*)(Bt + (nt * 16 + fr) * ldb + ks * 32 + fq * 8);
            acc[nt] = mfma16(a, b, acc[nt]);
        }
    }
}
DEV void zero4(f32x4 (&acc)[4]) {
#pragma unroll
    for (int i = 0; i < 4; ++i) acc[i] = f32x4{0.f, 0.f, 0.f, 0.f};
}
DEV void ld16bf(const u16* p, float (&o)[16]) {
    const u32x4 a = *(const u32x4*)p, b = *(const u32x4*)(p + 8);
    const unsigned w[8] = {a.x, a.y, a.z, a.w, b.x, b.y, b.z, b.w};
#pragma unroll
    for (int i = 0; i < 8; ++i) { o[2 * i] = __uint_as_float(w[i] << 16); o[2 * i + 1] = __uint_as_float(w[i] & 0xffff0000u); }
}
DEV void st16bf(u16* p, const float (&v)[16]) {
    u32x4 a, b;
    a.x = pack2(v[0], v[1]); a.y = pack2(v[2], v[3]); a.z = pack2(v[4], v[5]); a.w = pack2(v[6], v[7]);
    b.x = pack2(v[8], v[9]); b.y = pack2(v[10], v[11]); b.z = pack2(v[12], v[13]); b.w = pack2(v[14], v[15]);
    *(u32x4*)p = a; *(u32x4*)(p + 8) = b;
}

DEV void phase_rope_table(const P& p, int bid, int nb) {
    for (int i = bid * NTHR + tidx(); i < 192 * 8; i += nb * NTHR) {
        const int e = i >> 3, f = i & 7;
        const float inv = expf(-(float)(2 * f) * (1.f / 16.f) * 9.210340371976184f);
        const float pos = (float)(e < 128 ? e : e - 128);
        const float ang = pos * inv;
        p.rope[2 * i] = cosf(ang); p.rope[2 * i + 1] = sinf(ang);
    }
}
DEV void phase_prep(const P& p, int l, u16* gqkv, int bid, int nb, u16* sm) {
    const int tid = tidx();
    for (int g = bid; g < 264; g += nb) {
        int b, t0, r0, T, pos0;
        if (g < 256) { b = g >> 7; t0 = (g & 127) * 64; r0 = b * SEQ + t0; T = SEQ; pos0 = CTXL + t0; }
        else { const int q = g - 256; b = q >> 2; t0 = (q & 3) * 64; r0 = RLAT + b * CTXL + t0; T = CTXL; pos0 = t0; }
        for (int k = 0; k < 24; ++k) {
            const int id = tid + 256 * k, cg = id % 96, s = id / 96, r = r0 + s, t = t0 + s;
            float a[8];
#pragma unroll
            for (int i = 0; i < 8; ++i) a[i] = 0.f;
#pragma unroll
            for (int j = 0; j < 5; ++j) {
                const int tt = t + j - 2;
                if (tt >= 0 && tt < T) {
                    const u32x4 xv = *(const u32x4*)(p.cols + (size_t)(r + j - 2) * NCM + GD_Q + cg * 8);
                    const float4 w0 = *(const float4*)(p.gdn_conv + (l * 5 + j) * 768 + cg * 8);
                    const float4 w1 = *(const float4*)(p.gdn_conv + (l * 5 + j) * 768 + cg * 8 + 4);
                    a[0] += __uint_as_float(xv.x << 16) * w0.x; a[1] += __uint_as_float(xv.x & 0xffff0000u) * w0.y;
                    a[2] += __uint_as_float(xv.y << 16) * w0.z; a[3] += __uint_as_float(xv.y & 0xffff0000u) * w0.w;
                    a[4] += __uint_as_float(xv.z << 16) * w1.x; a[5] += __uint_as_float(xv.z & 0xffff0000u) * w1.y;
                    a[6] += __uint_as_float(xv.w << 16) * w1.z; a[7] += __uint_as_float(xv.w & 0xffff0000u) * w1.w;
                }
            }
            float ss = 0.f;
#pragma unroll
            for (int i = 0; i < 8; ++i) { a[i] = silu(a[i]); ss += a[i] * a[i]; }
            ss += __shfl_xor(ss, 1, 64); ss += __shfl_xor(ss, 2, 64); ss += __shfl_xor(ss, 4, 64);
            float sc = 1.f;
            if (cg < 64) sc = rsqrtf(ss + EPSF) * (cg < 32 ? 0.125f : 1.f);
            u32x4 o;
            o.x = pack2(a[0] * sc, a[1] * sc); o.y = pack2(a[2] * sc, a[3] * sc); o.z = pack2(a[4] * sc, a[5] * sc); o.w = pack2(a[6] * sc, a[7] * sc);
            *(u32x4*)(gqkv + (size_t)r * 768 + cg * 8) = o;
        }
        for (int k = 0; k < 8; ++k) {
            const int id = tid + 256 * k, c = id & 1, half = (id >> 1) & 1, h = (id >> 2) & 3, qk = (id >> 4) & 1, s = id >> 5;
            const int r = r0 + s, t = t0 + s;
            const u16* src = p.cols + (size_t)r * NCM + (qk ? DF_K : DF_Q) + h * 64 + half * 32 + c * 8;
            const u32x4 v1 = *(const u32x4*)src, v2 = *(const u32x4*)(src + 16);
            const unsigned w1[4] = {v1.x, v1.y, v1.z, v1.w}, w2[4] = {v2.x, v2.y, v2.z, v2.w};
            float x1[8], x2[8], o1[8], o2[8];
#pragma unroll
            for (int i = 0; i < 4; ++i) {
                x1[2 * i] = __uint_as_float(w1[i] << 16); x1[2 * i + 1] = __uint_as_float(w1[i] & 0xffff0000u);
                x2[2 * i] = __uint_as_float(w2[i] << 16); x2[2 * i + 1] = __uint_as_float(w2[i] & 0xffff0000u);
            }
            const float qs = qk ? 1.f : (0.17677669529663687f * 1.4426950408889634f);
            if (g < 256) {
                const float* tb = p.rope + (size_t)(c == 0 ? (t >> 6) : 128 + (t & 63)) * 16;
#pragma unroll
                for (int i = 0; i < 8; ++i) {
                    const float cs = tb[2 * i], sn = tb[2 * i + 1];
                    o1[i] = (x1[i] * cs - x2[i] * sn) * qs; o2[i] = (x1[i] * sn + x2[i] * cs) * qs;
                }
            } else {
#pragma unroll
                for (int i = 0; i < 8; ++i) { o1[i] = x1[i] * qs; o2[i] = x2[i] * qs; }
            }
            u16* dst = (qk ? p.dk : p.dq) + ((size_t)(b * 4 + h) * KPOS + pos0 + s) * 64 + half * 32 + c * 8;
            u32x4 a1, a2;
            a1.x = pack2(o1[0], o1[1]); a1.y = pack2(o1[2], o1[3]); a1.z = pack2(o1[4], o1[5]); a1.w = pack2(o1[6], o1[7]);
            a2.x = pack2(o2[0], o2[1]); a2.y = pack2(o2[2], o2[3]); a2.z = pack2(o2[4], o2[5]); a2.w = pack2(o2[6], o2[7]);
            *(u32x4*)dst = a1; *(u32x4*)(dst + 16) = a2;
        }
        for (int h = 0; h < 4; ++h) {
            __syncthreads();
            {
                const int s = tid >> 2, dg = tid & 3;
                const u32x4 a = *(const u32x4*)(p.cols + (size_t)(r0 + s) * NCM + DF_V + h * 64 + dg * 16);
                const u32x4 c = *(const u32x4*)(p.cols + (size_t)(r0 + s) * NCM + DF_V + h * 64 + dg * 16 + 8);
                const unsigned wv[8] = {a.x, a.y, a.z, a.w, c.x, c.y, c.z, c.w};
#pragma unroll
                for (int k = 0; k < 8; ++k) {
                    sm[(dg * 16 + 2 * k) * 72 + s] = (u16)(wv[k] & 0xffff);
                    sm[(dg * 16 + 2 * k + 1) * 72 + s] = (u16)(wv[k] >> 16);
                }
            }
            __syncthreads();
            {
                const int dv = tid >> 2, sg = tid & 3;
                const u32x4 a = *(const u32x4*)(sm + dv * 72 + sg * 16);
                const u32x4 c = *(const u32x4*)(sm + dv * 72 + sg * 16 + 8);
                u16* o = p.dvT + ((size_t)(b * 4 + h) * 64 + dv) * KPOS + pos0 + sg * 16;
                *(u32x4*)o = a; *(u32x4*)(o + 8) = c;
            }
        }
        __syncthreads();
    }
}
#define TILE_B (64 * LDP * 2)

DEV void gla_cum(const P& p, int l, int dir, int h, int row0, float* cum, float* rt, float* sg) {
    const int tid = tidx();
    {
        const int s = tid >> 2, q4 = tid & 3, row = row0 + (dir ? 63 - s : s);
        const u32x2 v = *(const u32x2*)(p.cols + (size_t)row * NCM + GLA_RF + dir * 16 + q4 * 4);
        rt[s * 17 + q4 * 4 + 0] = __uint_as_float(v.x << 16); rt[s * 17 + q4 * 4 + 1] = __uint_as_float(v.x & 0xffff0000u);
        rt[s * 17 + q4 * 4 + 2] = __uint_as_float(v.y << 16); rt[s * 17 + q4 * 4 + 3] = __uint_as_float(v.y & 0xffff0000u);
    }
    __syncthreads();
    const int d = tid & 63, sq = tid >> 6;
    float a2r[16];
#pragma unroll
    for (int j = 0; j < 16; ++j) a2r[j] = p.gla_a2[((size_t)(l * 2 + dir) * 16 + j) * 256 + h * 64 + d];
    const float ab = p.gla_ab[(l * 2 + dir) * 256 + h * 64 + d];
    float loc[16]; float run = 0.f;
#pragma unroll
    for (int i = 0; i < 16; ++i) {
        const int s = sq * 16 + i;
        float x = ab;
#pragma unroll
        for (int j = 0; j < 16; ++j) x += rt[s * 17 + j] * a2r[j];
        run += logsig(x) * (1.f / 16.f);
        loc[i] = run;
    }
    sg[sq * 64 + d] = run;
    __syncthreads();
    float off = 0.f;
    for (int k = 0; k < sq; ++k) off += sg[k * 64 + d];
#pragma unroll
    for (int i = 0; i < 16; ++i) cum[(sq * 16 + i) * 65 + d] = loc[i] + off;
    __syncthreads();
}

DEV void gla_phaseA(const P& p, int l, int dir, int b, int st, int h, unsigned char* smraw) {
    float* cum = (float*)smraw;
    float* rt = cum + 64 * 65;
    float* sg = rt + 64 * 17;
    u16* kwT = (u16*)(sg + 256);
    u16* vT = kwT + 64 * LDP;
    const int tid = tidx(), lane = tid & 63, w = tid >> 6, fr = lane & 15, fq = lane >> 4;
    const int row0 = chunk_row0(b, dir, st);
    const size_t idx = state_idx(dir, b, st, h);
    gla_cum(p, l, dir, h, row0, cum, rt, sg);
    {
        const int s = tid >> 2, dg = tid & 3, row = row0 + (dir ? 63 - s : s);
        float kk[16], vv[16];
        ld16bf(p.cols + (size_t)row * NCM + GLA_K + h * 64 + dg * 16, kk);
        ld16bf(p.cols + (size_t)row * NCM + GLA_V + h * 64 + dg * 16, vv);
#pragma unroll
        for (int i = 0; i < 16; ++i) {
            const int d = dg * 16 + i;
            kwT[d * LDP + s] = f2bf(kk[i] * __expf(cum[63 * 65 + d] - cum[s * 65 + d]));
            vT[d * LDP + s] = f2bf(vv[i]);
        }
        if (tid < 64) p.glaDec[idx * 64 + tid] = __expf(cum[63 * 65 + tid]);
    }
    __syncthreads();
    f32x4 acc[4]; zero4(acc);
    mm64(acc, kwT, LDP, vT, LDP);
#pragma unroll
    for (int nt = 0; nt < 4; ++nt) {
        const int d = 16 * w + fq * 4, e = nt * 16 + fr;
        u32x2 pk; pk.x = pack2(acc[nt][0], acc[nt][1]); pk.y = pack2(acc[nt][2], acc[nt][3]);
        *(u32x2*)(p.glaS + idx * 4096 + e * 64 + d) = pk;
    }
    __syncthreads();
}

DEV void ml_phaseA(const P& p, int l, int dir, int b, int st, int h, unsigned char* smraw) {
    float* wend = (float*)smraw;
    u16* kwT = (u16*)(wend + 64);
    u16* vT = kwT + 64 * LDP;
    const int tid = tidx(), lane = tid & 63, w = tid >> 6, fr = lane & 15, fq = lane >> 4;
    const int row0 = chunk_row0(b, dir, st);
    const size_t idx = state_idx(dir, b, st, h);
    if (w == 0) {
        const int row = row0 + (dir ? 63 - lane : lane);
        const float ip = bf2f(p.cols[(size_t)row * NCM + ML_GF + dir * 8 + h]) + p.mlstm_gate_b[((l * 2 + dir) * 2 + 0) * 4 + h];
        const float lf = logsig(bf2f(p.cols[(size_t)row * NCM + ML_GF + dir * 8 + 4 + h]) + p.mlstm_gate_b[((l * 2 + dir) * 2 + 1) * 4 + h]);
        const float fc = wscan_add(lf, lane);
        const float fe = __shfl(fc, 63, 64);
        const float lw = fe - fc + ip;
        const float ae = wmaxr(lw);
        wend[lane] = __expf(lw - ae);
        if (lane == 0) { p.mlFE[idx] = fe; p.mlAE[idx] = ae; }
    }
    __syncthreads();
    {
        const int s = tid >> 2, dg = tid & 3, row = row0 + (dir ? 63 - s : s);
        float kk[16], vv[16];
        ld16bf(p.cols + (size_t)row * NCM + ML_K + h * 64 + dg * 16, kk);
        ld16bf(p.cols + (size_t)row * NCM + ML_V + h * 64 + dg * 16, vv);
        const float ws = wend[s] * 0.125f;
#pragma unroll
        for (int i = 0; i < 16; ++i) {
            const int d = dg * 16 + i;
            kwT[d * LDP + s] = f2bf(kk[i] * ws);
            vT[d * LDP + s] = f2bf(vv[i]);
        }
    }
    __syncthreads();
    if (tid < 64) {
        float a = 0.f;
        for (int s = 0; s < 64; ++s) a += bf2f(kwT[tid * LDP + s]);
        p.mlN[idx * 64 + tid] = a;
    }
    f32x4 acc[4]; zero4(acc);
    mm64(acc, kwT, LDP, vT, LDP);
#pragma unroll
    for (int nt = 0; nt < 4; ++nt) {
        const int d = 16 * w + fq * 4, e = nt * 16 + fr;
        u32x2 pk; pk.x = pack2(acc[nt][0], acc[nt][1]); pk.y = pack2(acc[nt][2], acc[nt][3]);
        *(u32x2*)(p.mlS + idx * 4096 + e * 64 + d) = pk;
    }
    __syncthreads();
}

DEV void gd_phaseA(const P& p, int l, const u16* gqkv, int dir, int b, int st, int h, unsigned char* smraw) {
    float* X = (float*)smraw;
    float* cum = X + 64 * 65 + 32;
    float* beta = cum + 64;
    float* be = beta + 64;
    float* ke = be + 64;
    float* scal = ke + 64;
    u16* Y0 = (u16*)(scal + 64);
    u16* Y1 = Y0 + 64 * LDP;
    u16* Y2 = Y1 + 64 * LDP;
    u16* Y3 = Y2 + 64 * LDP;
    u16* Y4 = Y3 + 64 * LDP;
    u16* Y5 = Y4 + 64 * LDP;
    u16* wT = (u16*)X;
    const int tid = tidx(), lane = tid & 63, w = tid >> 6, fr = lane & 15, fq = lane >> 4;
    const int row0 = chunk_row0(b, dir, st);
    const size_t idx = state_idx(dir, b, st, h);
    if (w == 0) {
        const int row = row0 + (dir ? 63 - lane : lane);
        const float bp = bf2f(p.cols[(size_t)row * NCM + GD_GF + dir * 8 + h]);
        const float ap = bf2f(p.cols[(size_t)row * NCM + GD_GF + dir * 8 + 4 + h]);
        const float bt = sigm(bp);
        const float g = -__expf(p.gdn_a_log[(l * 2 + dir) * 4 + h]) * softplus(ap + p.gdn_dt_bias[(l * 2 + dir) * 4 + h]);
        const float cm = wscan_add(g, lane);
        const float ce = __shfl(cm, 63, 64);
        cum[lane] = cm; beta[lane] = bt; be[lane] = bt * __expf(cm); ke[lane] = __expf(ce - cm);
        if (lane == 0) scal[0] = __expf(ce);
    }
    {
        const int s = tid >> 2, dg = tid & 3, row = row0 + (dir ? 63 - s : s);
        const u16* src = gqkv + (size_t)row * 768 + h * 64 + dg * 16;
        const u32x4 q0 = *(const u32x4*)src, q1 = *(const u32x4*)(src + 8);
        const u32x4 k0 = *(const u32x4*)(src + 256), k1 = *(const u32x4*)(src + 264);
        const u32x4 v0 = *(const u32x4*)(src + 512), v1 = *(const u32x4*)(src + 520);
        *(u32x4*)(Y0 + s * LDP + dg * 16) = q0; *(u32x4*)(Y0 + s * LDP + dg * 16 + 8) = q1;
        *(u32x4*)(Y1 + s * LDP + dg * 16) = k0; *(u32x4*)(Y1 + s * LDP + dg * 16 + 8) = k1;
        const unsigned kw[8] = {k0.x, k0.y, k0.z, k0.w, k1.x, k1.y, k1.z, k1.w};
        const unsigned vw[8] = {v0.x, v0.y, v0.z, v0.w, v1.x, v1.y, v1.z, v1.w};
#pragma unroll
        for (int i = 0; i < 8; ++i) {
            Y2[(dg * 16 + 2 * i) * LDP + s] = (u16)(kw[i] & 0xffff); Y2[(dg * 16 + 2 * i + 1) * LDP + s] = (u16)(kw[i] >> 16);
            Y3[(dg * 16 + 2 * i) * LDP + s] = (u16)(vw[i] & 0xffff); Y3[(dg * 16 + 2 * i + 1) * LDP + s] = (u16)(vw[i] >> 16);
        }
    }
    __syncthreads();
    {
        f32x4 kk[4], qk[4]; zero4(kk); zero4(qk);
        mm64(kk, Y1, LDP, Y1, LDP);
        mm64(qk, Y0, LDP, Y1, LDP);
#pragma unroll
        for (int nt = 0; nt < 4; ++nt)
#pragma unroll
            for (int j = 0; j < 4; ++j) {
                const int c = 16 * w + fq * 4 + j, s = nt * 16 + fr;
                const float gam = s <= c ? __expf(cum[c] - cum[s]) : 0.f;
                if (s < c) X[c * 65 + s] = beta[c] * kk[nt][j] * gam;
                Y4[c * LDP + s] = f2bf(qk[nt][j] * gam);
            }
    }
    __syncthreads();
    {
        float* Pb = (float*)Y5;
        if (tid < 64) {
            const int blk = tid >> 4, col = tid & 15, base = blk * 16;
            float tc[16];
#pragma unroll
            for (int r = 0; r < 16; ++r) tc[r] = (r == col) ? 1.f : 0.f;
#pragma unroll
            for (int r = 1; r < 16; ++r) {
                float a = 0.f;
#pragma unroll
                for (int s2 = 0; s2 < r; ++s2) a += X[(base + r) * 65 + base + s2] * tc[s2];
                if (r > col) tc[r] = -a;
            }
#pragma unroll
            for (int r = 0; r < 16; ++r) if (r >= col) X[(base + col) * 65 + base + r + 1] = tc[r];
        }
        __syncthreads();
        for (int d = 1; d < 4; ++d) {
            const int nblk = 4 - d;
            for (int e = tid; e < nblk * 256; e += NTHR) {
                const int jb = e >> 8, r = (e >> 4) & 15, c = e & 15, ib = jb + d;
                float a = 0.f;
                for (int k = jb; k < ib; ++k)
#pragma unroll
                    for (int s2 = 0; s2 < 16; ++s2) {
                        const int rr = 16 * k + s2, cc = 16 * jb + c;
                        const float tv = rr >= cc ? X[cc * 65 + rr + 1] : 0.f;
                        a += X[(16 * ib + r) * 65 + rr] * tv;
                    }
                Pb[(jb * 16 + r) * 17 + c] = a;
            }
            __syncthreads();
            for (int e = tid; e < nblk * 256; e += NTHR) {
                const int jb = e >> 8, r = (e >> 4) & 15, c = e & 15, ib = jb + d;
                float a = 0.f;
#pragma unroll
                for (int s2 = 0; s2 < 16; ++s2) {
                    const float tv = s2 <= r ? X[(16 * ib + s2) * 65 + 16 * ib + r + 1] : 0.f;
                    a += tv * Pb[(jb * 16 + s2) * 17 + c];
                }
                X[(16 * jb + c) * 65 + 16 * ib + r + 1] = -a;
            }
            __syncthreads();
        }
    }
    {
        const int c = tid >> 2, sgp = tid & 3;
        float tw[16], tu[16];
#pragma unroll
        for (int i = 0; i < 16; ++i) {
            const int s = sgp * 16 + i;
            const float t = s <= c ? X[s * 65 + c + 1] : 0.f;
            tw[i] = t * be[s]; tu[i] = t * beta[s];
        }
        st16bf(Y0 + c * LDP + sgp * 16, tw);
        st16bf(Y1 + c * LDP + sgp * 16, tu);
    }
    __syncthreads();
    {
        f32x4 wa[4], ua[4]; zero4(wa); zero4(ua);
        mm64(wa, Y0, LDP, Y2, LDP);
        mm64(ua, Y1, LDP, Y3, LDP);
        __syncthreads();
        const int c0 = 16 * w + fq * 4;
        const float k0 = ke[c0], k1 = ke[c0 + 1], k2 = ke[c0 + 2], k3 = ke[c0 + 3];
#pragma unroll
        for (int nt = 0; nt < 4; ++nt) {
            const int d = nt * 16 + fr;
            u32x2 a, bq, c, dq_;
            a.x = pack2(wa[nt][0], wa[nt][1]); a.y = pack2(wa[nt][2], wa[nt][3]);
            bq.x = pack2(wa[nt][0] * k0, wa[nt][1] * k1); bq.y = pack2(wa[nt][2] * k2, wa[nt][3] * k3);
            c.x = pack2(ua[nt][0], ua[nt][1]); c.y = pack2(ua[nt][2], ua[nt][3]);
            dq_.x = pack2(ua[nt][0] * k0, ua[nt][1] * k1); dq_.y = pack2(ua[nt][2] * k2, ua[nt][3] * k3);
            *(u32x2*)(wT + d * LDP + c0) = a;
            *(u32x2*)(Y5 + d * LDP + c0) = bq;
            *(u32x2*)(Y0 + d * LDP + c0) = c;
            *(u32x2*)(Y1 + d * LDP + c0) = dq_;
        }
    }
    __syncthreads();
    {
        const float dec = scal[0];
        f32x4 acc[4];
        zero4(acc); mm64(acc, wT, LDP, Y4, LDP);
#pragma unroll
        for (int nt = 0; nt < 4; ++nt) {
            const int d = 16 * w + fq * 4, c = nt * 16 + fr, row = row0 + (dir ? 63 - c : c);
            const u32x2 qv = *(const u32x2*)(gqkv + (size_t)row * 768 + h * 64 + d);
            const float ec = __expf(cum[c]);
            u32x2 pk;
            pk.x = pack2(__uint_as_float(qv.x << 16) * ec - acc[nt][0], __uint_as_float(qv.x & 0xffff0000u) * ec - acc[nt][1]);
            pk.y = pack2(__uint_as_float(qv.y << 16) * ec - acc[nt][2], __uint_as_float(qv.y & 0xffff0000u) * ec - acc[nt][3]);
            *(u32x2*)(p.gdQ + idx * 4096 + c * 64 + d) = pk;
        }
        zero4(acc); mm64(acc, Y5, LDP, Y2, LDP);
#pragma unroll
        for (int nt = 0; nt < 4; ++nt) {
            const int d = 16 * w + fq * 4, d2 = nt * 16 + fr;
            u32x2 pk;
            pk.x = pack2((d == d2 ? dec : 0.f) - acc[nt][0], (d + 1 == d2 ? dec : 0.f) - acc[nt][1]);
            pk.y = pack2((d + 2 == d2 ? dec : 0.f) - acc[nt][2], (d + 3 == d2 ? dec : 0.f) - acc[nt][3]);
            *(u32x2*)(p.gdM + idx * 4096 + d2 * 64 + d) = pk;
        }
        zero4(acc); mm64(acc, Y2, LDP, Y1, LDP);
#pragma unroll
        for (int nt = 0; nt < 4; ++nt) {
            const int d2 = 16 * w + fq * 4, e = nt * 16 + fr;
            u32x2 pk; pk.x = pack2(acc[nt][0], acc[nt][1]); pk.y = pack2(acc[nt][2], acc[nt][3]);
            *(u32x2*)(p.gdN + idx * 4096 + e * 64 + d2) = pk;
        }
        zero4(acc); mm64(acc, Y4, LDP, Y0, LDP);
#pragma unroll
        for (int nt = 0; nt < 4; ++nt) {
            const int c = 16 * w + fq * 4, e = nt * 16 + fr;
            u32x2 pk; pk.x = pack2(acc[nt][0], acc[nt][1]); pk.y = pack2(acc[nt][2], acc[nt][3]);
            *(u32x2*)(p.gdO + idx * 4096 + e * 64 + c) = pk;
        }
    }
    __syncthreads();
}

DEV void phase_chunkA(const P& p, int l, const u16* gqkv, int bid, int nb, unsigned char* sm) {
    for (int u = bid; u < 3 * 2112; u += nb) {
        const int mix = u / 2112, v = u % 2112;
        const int h = v & 3, st = (v >> 2) % NSTEP, db = (v >> 2) / NSTEP, b = db & 1, dir = db >> 1;
        if (mix == 0) { PRB_BEGIN(120); gd_phaseA(p, l, gqkv, dir, b, st, h, sm); PRB_END(120); }
        else if (mix == 1) { PRB_BEGIN(121); gla_phaseA(p, l, dir, b, st, h, sm); PRB_END(121); }
        else { PRB_BEGIN(122); ml_phaseA(p, l, dir, b, st, h, sm); PRB_END(122); }
    }
}
#define GD_STAGE (2 * 64 * 64)
DEV void gd_issue(const P& p, size_t idx, u16* ring, int stg, int w, int lane) {
    u16* md = ring + stg * GD_STAGE;
    u16* nd = md + 64 * 64;
#pragma unroll
    for (int i = 0; i < 2; ++i) {
        const int r = (w * 2 + i) * 8 + (lane >> 3), c = (lane & 7) ^ ((r >> 1) & 7);
        __builtin_amdgcn_global_load_lds((const unsigned*)(p.gdM + idx * 4096 + r * 64 + c * 8), (unsigned*)(md + (w * 2 + i) * 512), 16, 0, 0);
        __builtin_amdgcn_global_load_lds((const unsigned*)(p.gdN + idx * 4096 + r * 64 + c * 8), (unsigned*)(nd + (w * 2 + i) * 512), 16, 0, 0);
    }
}
DEV void gd_scan(const P& p, int chain, u16* sm) {
    const int dir = chain >> 3, b = (chain >> 2) & 1, h = chain & 3;
    const int tid_ = tidx();
    const int lane = tid_ & 63, w = tid_ >> 6, fr = lane & 15, fq = lane >> 4;
    u16* ring = sm;
    u16* sl = sm + 4 * GD_STAGE + w * 16 * LDP;
    bf16x8 sb[2];
    sb[0] = bf16x8{0, 0, 0, 0, 0, 0, 0, 0}; sb[1] = sb[0];
    const size_t base = state_idx(dir, b, 0, h);
    const int sw = (fr >> 1) & 7;
    asm volatile("s_waitcnt vmcnt(0)" ::: "memory");
    gd_issue(p, base, ring, 0, w, lane);
    gd_issue(p, base + 4, ring, 1, w, lane);
    gd_issue(p, base + 8, ring, 2, w, lane);
    for (int k = 0; k < NSTEP; ++k) {
        if (k == 0) asm volatile("s_waitcnt vmcnt(8)" ::: "memory");
        else if (k == 1) asm volatile("s_waitcnt vmcnt(10)" ::: "memory");
        else if (k + 3 < NSTEP) asm volatile("s_waitcnt vmcnt(12)" ::: "memory");
        else asm volatile("s_waitcnt vmcnt(0)" ::: "memory");
        RAW_BARRIER();
        if (k + 3 < NSTEP) gd_issue(p, base + (size_t)(k + 3) * 4, ring, (k + 3) & 3, w, lane);
        asm volatile("" ::: "memory");
        const u16* Ms = ring + (k & 3) * GD_STAGE;
        const u16* Ns = Ms + 64 * 64;
        const size_t idx = base + (size_t)k * 4;
        f32x4 acc[4];
#pragma unroll
        for (int mt = 0; mt < 4; ++mt) {
            const u32x2 nv = *(const u32x2*)(Ns + (16 * w + fr) * 64 + (((mt * 2 + (fq >> 1)) ^ sw) * 8) + (fq & 1) * 4);
            acc[mt][0] = __uint_as_float(nv.x << 16); acc[mt][1] = __uint_as_float(nv.x & 0xffff0000u);
            acc[mt][2] = __uint_as_float(nv.y << 16); acc[mt][3] = __uint_as_float(nv.y & 0xffff0000u);
        }
#pragma unroll
        for (int mt = 0; mt < 4; ++mt)
#pragma unroll
            for (int ks = 0; ks < 2; ++ks) {
                const bf16x8 a = *(const bf16x8*)(Ms + (mt * 16 + fr) * 64 + (((ks * 4 + fq) ^ sw) * 8));
                acc[mt] = mfma16(a, sb[ks], acc[mt]);
            }
#pragma unroll
        for (int ks = 0; ks < 2; ++ks) *(bf16x8*)(p.gdN + idx * 4096 + (16 * w + fr) * 64 + ks * 32 + fq * 8) = sb[ks];
        asm volatile("" ::: "memory");
#pragma unroll
        for (int mt = 0; mt < 4; ++mt) {
            u32x2 pk; pk.x = pack2(acc[mt][0], acc[mt][1]); pk.y = pack2(acc[mt][2], acc[mt][3]);
            *(u32x2*)(sl + fr * LDP + mt * 16 + fq * 4) = pk;
        }
        __builtin_amdgcn_wave_barrier();
#pragma unroll
        for (int ks = 0; ks < 2; ++ks) sb[ks] = *(const bf16x8*)(sl + fr * LDP + ks * 32 + fq * 8);
        __builtin_amdgcn_wave_barrier();
    }
    asm volatile("s_waitcnt vmcnt(0)" ::: "memory");
    RAW_BARRIER();
}

DEV void gla_scan(const P& p, int v) {
    const int chain = v >> 3, sub = v & 7;
    const int dir = chain >> 3, b = (chain >> 2) & 1, h = chain & 3;
    const int ep = sub * 256 + tidx(), d = (2 * ep) & 63;
    float s0 = 0.f, s1 = 0.f;
    for (int st0 = 0; st0 < NSTEP; st0 += 12) {
        unsigned kv[12]; float2 dc[12];
#pragma unroll
        for (int k = 0; k < 12; ++k) {
            const size_t idx = state_idx(dir, b, st0 + k, h);
            kv[k] = *(const unsigned*)(p.glaS + idx * 4096 + 2 * ep);
            dc[k] = *(const float2*)(p.glaDec + idx * 64 + d);
        }
#pragma unroll
        for (int k = 0; k < 12; ++k) {
            const size_t idx = state_idx(dir, b, st0 + k, h);
            *(unsigned*)(p.glaS + idx * 4096 + 2 * ep) = pack2(s0, s1);
            s0 = dc[k].x * s0 + __uint_as_float(kv[k] << 16);
            s1 = dc[k].y * s1 + __uint_as_float(kv[k] & 0xffff0000u);
        }
    }
}

DEV void ml_scan(const P& p, int v) {
    const int chain = v >> 3, sub = v & 7;
    const int dir = chain >> 3, b = (chain >> 2) & 1, h = chain & 3;
    const int tid = tidx();
    const int ep = sub * 256 + tid;
    float s0 = 0.f, s1 = 0.f, m = 0.f;
    for (int st0 = 0; st0 < NSTEP; st0 += 12) {
        unsigned kv[12]; float fe[12], ae[12];
#pragma unroll
        for (int k = 0; k < 12; ++k) {
            const size_t idx = state_idx(dir, b, st0 + k, h);
            kv[k] = *(const unsigned*)(p.mlS + idx * 4096 + 2 * ep);
            fe[k] = p.mlFE[idx]; ae[k] = p.mlAE[idx];
        }
#pragma unroll
        for (int k = 0; k < 12; ++k) {
            const size_t idx = state_idx(dir, b, st0 + k, h);
            *(unsigned*)(p.mlS + idx * 4096 + 2 * ep) = pack2(s0, s1);
            const float mn = fmaxf(fe[k] + m, ae[k]);
            const float od = __expf(fe[k] + m - mn), nw = __expf(ae[k] - mn);
            s0 = od * s0 + nw * __uint_as_float(kv[k] << 16);
            s1 = od * s1 + nw * __uint_as_float(kv[k] & 0xffff0000u);
            m = mn;
        }
    }
}
DEV void ml_nscan(const P& p, int v) {
    const int tid = tidx(), chain = v * 4 + (tid >> 6), d = tid & 63;
    const int dir = chain >> 3, b = (chain >> 2) & 1, h = chain & 3;
    float nn = 0.f, m = 0.f;
    for (int st0 = 0; st0 < NSTEP; st0 += 12) {
        float fe[12], ae[12], ks[12];
#pragma unroll
        for (int k = 0; k < 12; ++k) {
            const size_t idx = state_idx(dir, b, st0 + k, h);
            fe[k] = p.mlFE[idx]; ae[k] = p.mlAE[idx]; ks[k] = p.mlN[idx * 64 + d];
        }
#pragma unroll
        for (int k = 0; k < 12; ++k) {
            const size_t idx = state_idx(dir, b, st0 + k, h);
            p.mlN[idx * 64 + d] = nn;
            if (d == 0) p.mlM[idx] = m;
            const float mn = fmaxf(fe[k] + m, ae[k]);
            const float od = __expf(fe[k] + m - mn), nw = __expf(ae[k] - mn);
            nn = od * nn + nw * ks[k];
            m = mn;
        }
    }
}

DEV void phase_scan(const P& p, int bid, int nb, u16* sm) {
    for (int u = bid; u < 16 + 128 + 128 + 4; u += nb) {
        if (u < 16) { PRB_BEGIN(100); gd_scan(p, u, sm); PRB_END(100); }
        else if (u < 144) { PRB_BEGIN(101); gla_scan(p, u - 16); PRB_END(101); }
        else if (u < 272) { PRB_BEGIN(102); ml_scan(p, u - 144); PRB_END(102); }
        else ml_nscan(p, u - 272);
    }
}
DEV void chunk_geom(int g, int& b, int& row0, int& stf, int& stb) {
    b = g / NSTEP; const int wv = g % NSTEP;
    row0 = wv < 4 ? RLAT + b * CTXL + wv * 64 : b * SEQ + (wv - 4) * 64;
    stf = wv; stb = wv < 4 ? 3 - wv : 135 - wv;
}
DEV void obuf_acc(float* obuf, const f32x4 (&acc)[4], int dir) {
    const int lane = tidx() & 63, w = tidx() >> 6, fr = lane & 15, fq = lane >> 4;
#pragma unroll
    for (int nt = 0; nt < 4; ++nt)
#pragma unroll
        for (int j = 0; j < 4; ++j) {
            const int c = 16 * w + fq * 4 + j, e = nt * 16 + fr;
            if (dir == 0) obuf[c * 65 + e] = acc[nt][j]; else obuf[(63 - c) * 65 + e] += acc[nt][j];
        }
}
template <int ACT>
DEV void head_out(const P& p, int l, int br, int h, int row0, int gcol, const float* obuf) {
    const int tid = tidx(), row = tid >> 2, eg = tid & 3;
    float o[16]; float ss = 0.f;
#pragma unroll
    for (int i = 0; i < 16; ++i) { o[i] = obuf[row * 65 + eg * 16 + i]; ss += o[i] * o[i]; }
    ss += __shfl_xor(ss, 1, 64); ss += __shfl_xor(ss, 2, 64);
    const float rs = rsqrtf(ss * (1.f / 64.f) + EPSF);
    float gt[16];
    ld16bf(p.cols + (size_t)(row0 + row) * NCM + gcol + h * 64 + eg * 16, gt);
    float y[16];
#pragma unroll
    for (int i = 0; i < 16; ++i) {
        const float hn = p.head_norm[(l * 4 + br) * 256 + h * 64 + eg * 16 + i];
        const float a = ACT == 0 ? silu(gt[i]) : sigm(gt[i]);
        y[i] = o[i] * rs * hn * a;
    }
    st16bf(p.ybuf + (size_t)(row0 + row) * 1024 + br * 256 + h * 64 + eg * 16, y);
}

DEV void gla_phaseC(const P& p, int l, int g, int h, unsigned char* smraw) {
    float* cum = (float*)smraw;
    float* rt = cum + 64 * 65;
    float* sg = rt + 64 * 17;
    float* obuf = sg + 256;
    u16* qi = (u16*)(obuf + 64 * 65);
    u16* ko = qi + 64 * LDP;
    u16* vT = ko + 64 * LDP;
    const int tid = tidx(), lane = tid & 63, w = tid >> 6, fr = lane & 15, fq = lane >> 4;
    int b, row0, stf, stb; chunk_geom(g, b, row0, stf, stb);
    for (int dir = 0; dir < 2; ++dir) {
        const size_t idx = state_idx(dir, b, dir ? stb : stf, h);
        gla_cum(p, l, dir, h, row0, cum, rt, sg);
        {
            const int s = tid >> 2, dg = tid & 3, row = row0 + (dir ? 63 - s : s);
            float qq[16], kk[16], vv[16];
            ld16bf(p.cols + (size_t)row * NCM + GLA_Q + h * 64 + dg * 16, qq);
            ld16bf(p.cols + (size_t)row * NCM + GLA_K + h * 64 + dg * 16, kk);
            ld16bf(p.cols + (size_t)row * NCM + GLA_V + h * 64 + dg * 16, vv);
#pragma unroll
            for (int i = 0; i < 16; ++i) {
                const float cv = cum[s * 65 + dg * 16 + i];
                qq[i] *= 0.125f * __expf(cv); kk[i] *= __expf(-cv);
                vT[(dg * 16 + i) * LDP + s] = f2bf(vv[i]);
            }
            st16bf(qi + s * LDP + dg * 16, qq);
            st16bf(ko + s * LDP + dg * 16, kk);
        }
        __syncthreads();
        f32x4 sa[4]; zero4(sa);
        mm64(sa, qi, LDP, ko, LDP);
        __syncthreads();
#pragma unroll
        for (int nt = 0; nt < 4; ++nt)
#pragma unroll
            for (int j = 0; j < 4; ++j) {
                const int c = 16 * w + fq * 4 + j, s = nt * 16 + fr;
                ko[c * LDP + s] = f2bf(s <= c ? sa[nt][j] : 0.f);
            }
        __syncthreads();
        f32x4 oa[4]; zero4(oa);
        mm64(oa, ko, LDP, vT, LDP);
        mm64(oa, qi, LDP, p.glaS + idx * 4096, 64);
        obuf_acc(obuf, oa, dir);
        __syncthreads();
    }
    head_out<0>(p, l, 0, h, row0, GLA_G, obuf);
    __syncthreads();
}

DEV void ml_phaseC(const P& p, int l, int g, int h, unsigned char* smraw) {
    float* obuf = (float*)smraw;
    float* fcum = obuf + 64 * 65;
    float* ipre = fcum + 64;
    float* mrow = ipre + 64;
    float* denl = mrow + 64;
    float* qn = denl + 64;
    float* nin = qn + 64;
    u16* qs = (u16*)(nin + 64 + 64);
    u16* ks = qs + 64 * LDP;
    u16* vT = ks + 64 * LDP;
    const int tid = tidx(), lane = tid & 63, w = tid >> 6, fr = lane & 15, fq = lane >> 4;
    int b, row0, stf, stb; chunk_geom(g, b, row0, stf, stb);
    for (int dir = 0; dir < 2; ++dir) {
        const size_t idx = state_idx(dir, b, dir ? stb : stf, h);
        const float m_in = p.mlM[idx];
        if (w == 0) {
            const int row = row0 + (dir ? 63 - lane : lane);
            const float ip = bf2f(p.cols[(size_t)row * NCM + ML_GF + dir * 8 + h]) + p.mlstm_gate_b[((l * 2 + dir) * 2 + 0) * 4 + h];
            const float lf = logsig(bf2f(p.cols[(size_t)row * NCM + ML_GF + dir * 8 + 4 + h]) + p.mlstm_gate_b[((l * 2 + dir) * 2 + 1) * 4 + h]);
            const float fc = wscan_add(lf, lane);
            const float pm = wscan_max(ip - fc, lane);
            fcum[lane] = fc; ipre[lane] = ip; mrow[lane] = fc + fmaxf(m_in, pm);
            nin[lane] = p.mlN[idx * 64 + lane];
        }
        {
            const int s = tid >> 2, dg = tid & 3, row = row0 + (dir ? 63 - s : s);
            float kk[16], vv[16];
            const u16* qsrc = p.cols + (size_t)row * NCM + ML_Q + h * 64 + dg * 16;
            *(u32x4*)(qs + s * LDP + dg * 16) = *(const u32x4*)qsrc;
            *(u32x4*)(qs + s * LDP + dg * 16 + 8) = *(const u32x4*)(qsrc + 8);
            ld16bf(p.cols + (size_t)row * NCM + ML_K + h * 64 + dg * 16, kk);
            ld16bf(p.cols + (size_t)row * NCM + ML_V + h * 64 + dg * 16, vv);
#pragma unroll
            for (int i = 0; i < 16; ++i) { kk[i] *= 0.125f; vT[(dg * 16 + i) * LDP + s] = f2bf(vv[i]); }
            st16bf(ks + s * LDP + dg * 16, kk);
        }
        __syncthreads();
        {
            const int c = tid >> 2, dg = tid & 3;
            float a = 0.f;
#pragma unroll
            for (int i = 0; i < 16; ++i) a += bf2f(qs[c * LDP + dg * 16 + i]) * nin[dg * 16 + i];
            a += __shfl_xor(a, 1, 64); a += __shfl_xor(a, 2, 64);
            if (dg == 0) qn[c] = a;
        }
        f32x4 sa[4]; zero4(sa);
        mm64(sa, qs, LDP, ks, LDP);
        __syncthreads();
        float dsum[4] = {0.f, 0.f, 0.f, 0.f};
#pragma unroll
        for (int nt = 0; nt < 4; ++nt)
#pragma unroll
            for (int j = 0; j < 4; ++j) {
                const int c = 16 * w + fq * 4 + j, s = nt * 16 + fr;
                float val = 0.f;
                if (s <= c) val = sa[nt][j] * __expf(fcum[c] - fcum[s] + ipre[s] - mrow[c]);
                dsum[j] += val;
                ks[c * LDP + s] = f2bf(val);
            }
#pragma unroll
        for (int j = 0; j < 4; ++j) {
            float v = dsum[j];
            v += __shfl_xor(v, 1, 64); v += __shfl_xor(v, 2, 64); v += __shfl_xor(v, 4, 64); v += __shfl_xor(v, 8, 64);
            if (fr == 0) denl[16 * w + fq * 4 + j] = v;
        }
        __syncthreads();
        f32x4 n1[4], n2[4]; zero4(n1); zero4(n2);
        mm64(n1, ks, LDP, vT, LDP);
        mm64(n2, qs, LDP, p.mlS + idx * 4096, 64);
        f32x4 oa[4];
#pragma unroll
        for (int j = 0; j < 4; ++j) {
            const int c = 16 * w + fq * 4 + j;
            const float mr = mrow[c];
            const float ec = __expf(fcum[c] + m_in - mr);
            const float den = denl[c] + ec * qn[c];
            const float inv = 1.f / fmaxf(fabsf(den), __expf(-mr));
#pragma unroll
            for (int nt = 0; nt < 4; ++nt) oa[nt][j] = (n1[nt][j] + ec * n2[nt][j]) * inv;
        }
        obuf_acc(obuf, oa, dir);
        __syncthreads();
    }
    head_out<1>(p, l, 1, h, row0, ML_O, obuf);
    __syncthreads();
}

DEV void gd_phaseC(const P& p, int l, int g, int h, unsigned char* smraw) {
    float* obuf = (float*)smraw;
    const int tid = tidx(), lane = tid & 63, w = tid >> 6, fr = lane & 15, fq = lane >> 4;
    int b, row0, stf, stb; chunk_geom(g, b, row0, stf, stb);
    for (int dir = 0; dir < 2; ++dir) {
        const size_t idx = state_idx(dir, b, dir ? stb : stf, h);
        f32x4 oa[4];
#pragma unroll
        for (int nt = 0; nt < 4; ++nt) {
            const u32x2 ov = *(const u32x2*)(p.gdO + idx * 4096 + (nt * 16 + fr) * 64 + 16 * w + fq * 4);
            oa[nt][0] = __uint_as_float(ov.x << 16); oa[nt][1] = __uint_as_float(ov.x & 0xffff0000u);
            oa[nt][2] = __uint_as_float(ov.y << 16); oa[nt][3] = __uint_as_float(ov.y & 0xffff0000u);
        }
        mm64(oa, p.gdQ + idx * 4096, 64, p.gdN + idx * 4096, 64);
        obuf_acc(obuf, oa, dir);
        __syncthreads();
    }
    head_out<0>(p, l, 2, h, row0, GD_OG, obuf);
    __syncthreads();
}
DEV float fexp2(float x) { return __builtin_amdgcn_exp2f(x); }

#define ATT_STAGE_ELEMS (2 * 64 * 64)
DEV void attn_issue(const u16* kbase, const u16* vbase, int kt, u16* ring, int stg, int w, int lane) {
    u16* kd = ring + stg * ATT_STAGE_ELEMS;
    u16* vd = kd + 64 * 64;
#pragma unroll
    for (int i = 0; i < 2; ++i) {
        const int r = (w * 2 + i) * 8 + (lane >> 3), c = (lane & 7) ^ ((r >> 1) & 7);
        __builtin_amdgcn_global_load_lds((const unsigned*)(kbase + (size_t)(kt * 64 + r) * 64 + c * 8), (unsigned*)(kd + (w * 2 + i) * 512), 16, 0, 0);
        __builtin_amdgcn_global_load_lds((const unsigned*)(vbase + (size_t)r * KPOS + kt * 64 + c * 8), (unsigned*)(vd + (w * 2 + i) * 512), 16, 0, 0);
    }
}

DEV void attn_unit(const P& p, int l, int b, int h, int q0pos, int nkeys, int rowbase, u16* ring) {
    const int tid = tidx(), lane = tid & 63, w = tid >> 6, fr = lane & 15, fq = lane >> 4;
    const size_t bh = (size_t)(b * 4 + h);
    float lam;
    {
        const float* lp = p.diff_lambda + (size_t)l * 4 * 4 * 32;
        float a = 0.f, c = 0.f;
        if (lane < 32) { a = lp[(0 * 4 + h) * 32 + lane] * lp[(1 * 4 + h) * 32 + lane]; c = lp[(2 * 4 + h) * 32 + lane] * lp[(3 * 4 + h) * 32 + lane]; }
        a = wsum(a); c = wsum(c);
        lam = expf(a) - expf(c) + (0.8f - 0.6f * expf(-0.3f * (float)l));
    }
    const float lam_init = 0.8f - 0.6f * expf(-0.3f * (float)l);
    bf16x8 qf[2][2];
#pragma unroll
    for (int g = 0; g < 2; ++g)
#pragma unroll
        for (int i = 0; i < 2; ++i)
            qf[g][i] = *(const bf16x8*)(p.dq + (bh * KPOS + q0pos + w * 32 + g * 16 + fr) * 64 + i * 32 + fq * 8);
    f32x4 O[2][2][4];
    float mrun[2][2], lsum[2][2];
#pragma unroll
    for (int i = 0; i < 2; ++i)
#pragma unroll
        for (int g = 0; g < 2; ++g) {
            mrun[i][g] = -INFINITY; lsum[i][g] = 0.f;
#pragma unroll
            for (int t = 0; t < 4; ++t) O[i][g][t] = f32x4{0.f, 0.f, 0.f, 0.f};
        }
    const u16* kbase = p.dk + bh * KPOS * 64;
    const u16* vbase = p.dvT + bh * 64 * KPOS;
    const int nk = nkeys >> 6;
    asm volatile("s_waitcnt vmcnt(0)" ::: "memory");
    attn_issue(kbase, vbase, 0, ring, 0, w, lane);
    attn_issue(kbase, vbase, 1, ring, 1, w, lane);
    const int sw = (fr >> 1) & 7;
    for (int kt = 0; kt < nk; ++kt) {
        if (kt + 1 < nk) asm volatile("s_waitcnt vmcnt(4)" ::: "memory"); else asm volatile("s_waitcnt vmcnt(0)" ::: "memory");
        RAW_BARRIER();
        if (kt + 2 < nk) attn_issue(kbase, vbase, kt + 2, ring, (kt + 2) % 3, w, lane);
        const u16* Ks = ring + (kt % 3) * ATT_STAGE_ELEMS;
        const u16* Vs = Ks + 64 * 64;
#pragma unroll
        for (int i = 0; i < 2; ++i) {
            f32x4 s[2][4];
#pragma unroll
            for (int st = 0; st < 4; ++st) {
                const bf16x8 kf = *(const bf16x8*)(Ks + (st * 16 + fr) * 64 + (((i * 4 + fq) ^ sw) * 8));
#pragma unroll
                for (int g = 0; g < 2; ++g) s[g][st] = mfma16(kf, qf[g][i], f32x4{0.f, 0.f, 0.f, 0.f});
            }
            bf16x8 pb[2][2];
#pragma unroll
            for (int g = 0; g < 2; ++g) {
                float mx = s[g][0][0];
#pragma unroll
                for (int st = 0; st < 4; ++st)
#pragma unroll
                    for (int j = 0; j < 4; ++j) mx = fmaxf(mx, s[g][st][j]);
                mx = fmaxf(mx, __shfl_xor(mx, 16, 64)); mx = fmaxf(mx, __shfl_xor(mx, 32, 64));
                const float mn = fmaxf(mrun[i][g], mx);
                const float alpha = fexp2(mrun[i][g] - mn);
                mrun[i][g] = mn;
                float ps = 0.f;
#pragma unroll
                for (int st = 0; st < 4; ++st)
#pragma unroll
                    for (int j = 0; j < 4; ++j) { const float e = fexp2(s[g][st][j] - mn); s[g][st][j] = e; ps += e; }
                lsum[i][g] = lsum[i][g] * alpha + ps;
#pragma unroll
                for (int t = 0; t < 4; ++t) { O[i][g][t][0] *= alpha; O[i][g][t][1] *= alpha; O[i][g][t][2] *= alpha; O[i][g][t][3] *= alpha; }
#pragma unroll
                for (int ks = 0; ks < 2; ++ks) {
                    union { bf16x8 v; unsigned u[4]; } pk;
                    pk.u[0] = pack2(s[g][2 * ks][0], s[g][2 * ks][1]); pk.u[1] = pack2(s[g][2 * ks][2], s[g][2 * ks][3]);
                    pk.u[2] = pack2(s[g][2 * ks + 1][0], s[g][2 * ks + 1][1]); pk.u[3] = pack2(s[g][2 * ks + 1][2], s[g][2 * ks + 1][3]);
                    pb[g][ks] = pk.v;
                }
            }
#pragma unroll
            for (int ks = 0; ks < 2; ++ks)
#pragma unroll
                for (int t = 0; t < 4; ++t) {
                    union { bf16x8 v; u32x2 h2[2]; } va;
                    va.h2[0] = *(const u32x2*)(Vs + (t * 16 + fr) * 64 + ((((2 * ks) * 2 + (fq >> 1)) ^ sw) * 8) + (fq & 1) * 4);
                    va.h2[1] = *(const u32x2*)(Vs + (t * 16 + fr) * 64 + ((((2 * ks + 1) * 2 + (fq >> 1)) ^ sw) * 8) + (fq & 1) * 4);
#pragma unroll
                    for (int g = 0; g < 2; ++g) O[i][g][t] = mfma16(va.v, pb[g][ks], O[i][g][t]);
                }
        }
    }
    RAW_BARRIER();
#pragma unroll
    for (int g = 0; g < 2; ++g) {
        float l0 = lsum[0][g], l1 = lsum[1][g];
        l0 += __shfl_xor(l0, 16, 64); l0 += __shfl_xor(l0, 32, 64);
        l1 += __shfl_xor(l1, 16, 64); l1 += __shfl_xor(l1, 32, 64);
        const float i0 = 1.f / l0, i1 = lam / l1;
        float o[4][4]; float ss = 0.f;
#pragma unroll
        for (int t = 0; t < 4; ++t)
#pragma unroll
            for (int j = 0; j < 4; ++j) { o[t][j] = O[0][g][t][j] * i0 - O[1][g][t][j] * i1; ss += o[t][j] * o[t][j]; }
        ss += __shfl_xor(ss, 16, 64); ss += __shfl_xor(ss, 32, 64);
        const float rs = rsqrtf(ss * (1.f / 64.f) + EPSF) * (1.f - lam_init);
        const int row = rowbase + w * 32 + g * 16 + fr;
#pragma unroll
        for (int t = 0; t < 4; ++t) {
            const int dv = t * 16 + fq * 4;
            const float4 hn = *(const float4*)(p.head_norm + (l * 4 + 3) * 256 + h * 64 + dv);
            u32x2 pk; pk.x = pack2(o[t][0] * rs * hn.x, o[t][1] * rs * hn.y); pk.y = pack2(o[t][2] * rs * hn.z, o[t][3] * rs * hn.w);
            *(u32x2*)(p.ybuf + (size_t)row * 1024 + 768 + h * 64 + dv) = pk;
        }
    }
}

template <int PART>
DEV void phase_outputs(const P& p, int l, int bid, int nb, unsigned char* sm) {
    if (PART != 2) {
    const int nq = 64 + (l == 0 ? 2 : 0);
    int* qctr = p.cnt + 64 + l * 8;
    volatile int* slot = (volatile int*)(sm + 3 * ATT_STAGE_ELEMS * 2);
    const int x0 = (int)(xb_xcc_id() & 7u);
    for (int a = 0; a < 8; ++a) {
        const int bh = (x0 + a) & 7;
        for (;;) {
            if (tidx() == 0) *slot = atomicAdd(qctr + bh, 1);
            __syncthreads();
            const int qt = *slot;
            __syncthreads();
            if (qt >= nq) break;
            const int b = bh >> 2, h = bh & 3;
            if (qt < 64) attn_unit(p, l, b, h, CTXL + qt * 128, KPOS, b * SEQ + qt * 128, (u16*)sm);
            else attn_unit(p, l, b, h, (qt - 64) * 128, CTXL, RLAT + b * CTXL + (qt - 64) * 128, (u16*)sm);
        }
    }
    }
    __builtin_amdgcn_sched_barrier(0);
    if (PART != 1)
    for (int v = bid; v < 3 * 1056; v += nb) {
        const int mix = v / 1056, r = v % 1056, g = r >> 2, h = r & 3;
        if (l == 1 && (g % NSTEP) < 4) continue;
        if (mix == 0) { PRB_BEGIN(131); gla_phaseC(p, l, g, h, sm); PRB_END(131); }
        else if (mix == 1) { PRB_BEGIN(132); ml_phaseC(p, l, g, h, sm); PRB_END(132); }
        else { PRB_BEGIN(133); gd_phaseC(p, l, g, h, sm); PRB_END(133); }
    }
}
#define LDS_BYTES 75776
#ifndef MULTI
#define MULTI 0
#endif
#ifndef STAGE
#define STAGE 99
#endif

enum { PH_PRO0 = 0, PH_PRO1, PH_NORM1, PH_INPROJ, PH_PREP, PH_CHUNKA, PH_SCAN, PH_OUT, PH_GATES, PH_MERGE1, PH_MERGE2, PH_ROUTER, PH_MOEUP, PH_MOEDOWN, PH_FINAL, PH_OUTC };

template <int PH>
DEV void run_phase(const P& p, int l, int bid_, int nb_, unsigned char* sm) {
    const int bid = launder_s(bid_), nb = launder_s(nb_);
    u16* gqkv = p.ybuf;
    u16* ubuf = p.glaS;
    const int mtiles = l == 0 ? 132 : 128;
    if (PH == PH_PRO0) { phase_conv_mixw(p, 0, bid, nb, (float*)sm); phase_mod_partial(p, bid, nb, (float*)sm); phase_rope_table(p, bid, nb); }
    else if (PH == PH_PRO1) phase_mod_reduce(p, bid, nb);
    else if (PH == PH_NORM1) phase_norm1(p, l, bid, nb);
    else if (PH == PH_INPROJ) phase_inproj<false>(p, 0, 31, NCM, 66, bid, nb, (u16*)sm);
    else if (PH == PH_PREP) phase_prep(p, l, gqkv, bid, nb, (u16*)sm);
    else if (PH == PH_CHUNKA) phase_chunkA(p, l, gqkv, bid, nb, sm);
    else if (PH == PH_SCAN) phase_scan(p, bid, nb, (u16*)sm);
#ifdef PROBE_SPLIT
    else if (PH == PH_OUT) phase_outputs<1>(p, l, bid, nb, sm);
    else if (PH == PH_OUTC) phase_outputs<2>(p, l, bid, nb, sm);
#else
    else if (PH == PH_OUT) phase_outputs<0>(p, l, bid, nb, sm);
#endif
    else if (PH == PH_GATES) phase_inproj<true>(p, 3968, 32, NGATE, mtiles / 2, bid, nb, (u16*)sm);
    else if (PH == PH_MERGE1) phase_merge1(p, ubuf, mtiles, bid, nb, (u16*)sm);
    else if (PH == PH_MERGE2) phase_merge2(p, l, ubuf, mtiles, bid, nb, (u16*)sm);
    else if (PH == PH_ROUTER) {
        { PRB_BEGIN(110); phase_norm2_router(p, l, l == 0 ? RTOT : RLAT, bid, nb, (float*)sm); PRB_END(110); }
        { PRB_BEGIN(111); phase_conv_moew(p, l, bid, nb, (float*)sm); PRB_END(111); }
        if (l == 0) { PRB_BEGIN(112); phase_conv_mixw(p, 1, bid, nb, (float*)sm); PRB_END(112); }
    }
    else if (PH == PH_MOEUP) phase_moe_up(p, l, bid, nb, (u16*)sm);
    else if (PH == PH_MOEDOWN) phase_moe_down(p, l, bid, nb, (u16*)sm);
    else if (PH == PH_FINAL) phase_final_norm(p, bid, nb);
}

#if MULTI
template <int PH>
__global__ void __launch_bounds__(NTHR, 2) k_phase(P p, int l) {
    extern __shared__ __attribute__((aligned(16))) unsigned char smem[];
    run_phase<PH>(p, l, blockIdx.x, gridDim.x, smem);
}
#else
__global__ void __launch_bounds__(NTHR, 2) k_mega(P p) {
    extern __shared__ __attribute__((aligned(16))) unsigned char smem[];
    volatile LAS unsigned* xbw = (volatile LAS unsigned*)(smem + LDS_BYTES);
    if (threadIdx.x == 0) { xbw[0] = 0u; xbw[1] = 0u; xbw[2] = 0u; xbw[3] = 0u; }
    __syncthreads();
    (void)xcd_barrier_post(p.bar, xbw);
    const int bid = blockIdx.x, nb = gridDim.x;
#ifdef PROBE_SEL
    unsigned long long pr_t0 = wall_clock64();
    volatile LAS unsigned long long* pr_acc = (volatile LAS unsigned long long*)(smem + LDS_BYTES + 8);
#ifdef PROBE_CLK
    unsigned long long pr_c0 = __builtin_readcyclecounter();
#define PSTAMP(PH) do { const unsigned long long c_ = __builtin_readcyclecounter(); if ((PH) == PROBE_SEL && threadIdx.x == 0) *pr_acc = *pr_acc + (c_ - pr_c0) / 24ull; pr_c0 = c_; } while (0)
#else
#define PSTAMP(PH) do { const unsigned long long t_ = wall_clock64(); if ((PH) == PROBE_SEL && threadIdx.x == 0) *pr_acc = *pr_acc + (t_ - pr_t0); pr_t0 = t_; } while (0)
#endif
#else
#define PSTAMP(PH) do { } while (0)
#endif
#define GBAR() do { XcdBarrier b_; b_.bar = p.bar; b_.x = xb_xcc_id(); b_.st = (volatile LAS unsigned*)(smem + LDS_BYTES); xcd_barrier(b_); } while (0)
    run_phase<PH_PRO0>(p, 0, bid, nb, smem); GBAR(); PSTAMP(PH_PRO0);
    run_phase<PH_PRO1>(p, 0, bid, nb, smem); GBAR(); PSTAMP(PH_PRO1);
    for (int l = 0; l < 2; ++l) {
        run_phase<PH_NORM1>(p, l, bid, nb, smem); GBAR(); PSTAMP(PH_NORM1);
        run_phase<PH_INPROJ>(p, l, bid, nb, smem); GBAR(); PSTAMP(PH_INPROJ);
#ifdef PROBE_GEMM
        { PRB_BEGIN(200); phase_inproj<false, PROBE_GEMM>(p, 0, 31, NCM, 66, launder_s(bid), launder_s(nb), (u16*)smem); PRB_END(200); } GBAR();
#endif
        run_phase<PH_PREP>(p, l, bid, nb, smem); GBAR(); PSTAMP(PH_PREP);
        run_phase<PH_CHUNKA>(p, l, bid, nb, smem); GBAR(); PSTAMP(PH_CHUNKA);
        run_phase<PH_SCAN>(p, l, bid, nb, smem); GBAR(); PSTAMP(PH_SCAN);
        run_phase<PH_OUT>(p, l, bid, nb, smem); GBAR(); PSTAMP(PH_OUT);
#ifdef PROBE_SPLIT
        run_phase<PH_OUTC>(p, l, bid, nb, smem); GBAR(); PSTAMP(PH_OUTC);
#endif
        run_phase<PH_GATES>(p, l, bid, nb, smem); GBAR(); PSTAMP(PH_GATES);
        run_phase<PH_MERGE1>(p, l, bid, nb, smem); GBAR(); PSTAMP(PH_MERGE1);
        run_phase<PH_MERGE2>(p, l, bid, nb, smem); GBAR(); PSTAMP(PH_MERGE2);
        run_phase<PH_ROUTER>(p, l, bid, nb, smem); GBAR(); PSTAMP(PH_ROUTER);
        run_phase<PH_MOEUP>(p, l, bid, nb, smem); GBAR(); PSTAMP(PH_MOEUP);
        run_phase<PH_MOEDOWN>(p, l, bid, nb, smem); GBAR(); PSTAMP(PH_MOEDOWN);
    }
    run_phase<PH_FINAL>(p, 0, bid, nb, smem);
#ifdef PROBE_SEL
    __syncthreads();
    { const unsigned long long te = wall_clock64(), wt = *pr_acc * 4ull; while (wall_clock64() - te < wt) __builtin_amdgcn_s_sleep(8); }
#endif
}
#endif

static size_t al256(size_t x) { return (x + 255) & ~(size_t)255; }

extern "C" void kernel_launch(void* const* d_in, const int* in_sizes, int n_in, void* d_out, int out_size, void* d_ws, size_t ws_size,
                              hipStream_t stream) {
    (void)in_sizes; (void)n_in; (void)out_size; (void)ws_size;
    P p{};
    p.x = (const float*)d_in[0]; p.c = (const float*)d_in[1]; p.ctx = (const float*)d_in[2]; p.c_ctx = (const float*)d_in[3];
    p.w_mod = (const float*)d_in[4]; p.b_mod = (const float*)d_in[5]; p.norm_mix = (const float*)d_in[6]; p.norm_ffn = (const float*)d_in[7];
    p.w_in = (const float*)d_in[8]; p.gla_a2 = (const float*)d_in[9]; p.gla_ab = (const float*)d_in[10]; p.mlstm_gate_b = (const float*)d_in[11];
    p.gdn_conv = (const float*)d_in[12]; p.gdn_a_log = (const float*)d_in[13]; p.gdn_dt_bias = (const float*)d_in[14];
    p.diff_lambda = (const float*)d_in[15]; p.head_norm = (const float*)d_in[16]; p.w_branch = (const float*)d_in[17];
    p.w_out = (const float*)d_in[18]; p.router_w = (const float*)d_in[19]; p.router_b = (const float*)d_in[20];
    p.w_gate = (const float*)d_in[21]; p.w_up = (const float*)d_in[22]; p.w_down = (const float*)d_in[23]; p.norm_final = (const float*)d_in[24];
    p.out = (float*)d_out;
    unsigned char* ws = (unsigned char*)d_ws;
    size_t o = 0;
    auto take = [&](size_t bytes) { unsigned char* r = ws + o; o = al256(o + bytes); return r; };
    p.bar = (unsigned*)take(XCD_BAR_WORDS * 4);
    p.cnt = (int*)take(1024);
    const size_t zero_bytes = o;
    p.modp = (float*)take((size_t)2 * 16 * 3 * 6144 * 4);
    p.mod = (float*)take((size_t)2 * 3 * 6144 * 4);
    p.xctx = (float*)take((size_t)RCTX * DM * 4);
    p.rope = (float*)take((size_t)192 * 8 * 2 * 4);
    p.hbuf = (u16*)take((size_t)RTOT * DM * 2);
    p.ybuf = (u16*)take((size_t)RTOT * DM * 2);
    p.Wt = (u16*)take((size_t)WT_TOTAL * 2);
    p.dq = (u16*)take((size_t)8 * KPOS * 64 * 2);
    p.dk = (u16*)take((size_t)8 * KPOS * 64 * 2);
    p.dvT = (u16*)take((size_t)8 * KPOS * 64 * 2);
    const size_t nst = (size_t)2 * 2 * NSTEP * 4;
    p.glaDec = (float*)take(nst * 64 * 4);
    p.mlN = (float*)take(nst * 64 * 4);
    p.mlFE = (float*)take(nst * 4);
    p.mlAE = (float*)take(nst * 4);
    p.mlM = (float*)take(nst * 4);
    p.glaS = (u16*)take(nst * 4096 * 2);
    p.mlS = (u16*)take(nst * 4096 * 2);
    p.gdM = (u16*)take(nst * 4096 * 2);
    p.gdN = (u16*)take(nst * 4096 * 2);
    p.gdQ = (u16*)take(nst * 4096 * 2);
    p.gdO = (u16*)take(nst * 4096 * 2);
    p.cols = (u16*)take((size_t)RTOT * NGATE * 2);
    hipMemsetAsync(ws, 0, zero_bytes, stream);

    static int grid = 0;
#if MULTI
#define SETUP(PH) hipFuncSetAttribute((const void*)k_phase<PH>, hipFuncAttributeMaxDynamicSharedMemorySize, LDS_BYTES + 16)
    if (!grid) {
        SETUP(PH_PRO0); SETUP(PH_PRO1); SETUP(PH_NORM1); SETUP(PH_INPROJ); SETUP(PH_PREP); SETUP(PH_CHUNKA); SETUP(PH_SCAN); SETUP(PH_OUT);
        SETUP(PH_GATES); SETUP(PH_MERGE1); SETUP(PH_MERGE2); SETUP(PH_ROUTER); SETUP(PH_MOEUP); SETUP(PH_MOEDOWN); SETUP(PH_FINAL);
        grid = 512;
    }
#define LAUNCH(PH, l) k_phase<PH><<<grid, NTHR, LDS_BYTES + 16, stream>>>(p, l)
    LAUNCH(PH_PRO0, 0); LAUNCH(PH_PRO1, 0);
    for (int l = 0; l < 2; ++l) {
        LAUNCH(PH_NORM1, l);
#if STAGE >= 1
        LAUNCH(PH_INPROJ, l); LAUNCH(PH_PREP, l); LAUNCH(PH_CHUNKA, l); LAUNCH(PH_SCAN, l); LAUNCH(PH_OUT, l);
        LAUNCH(PH_GATES, l); LAUNCH(PH_MERGE1, l); LAUNCH(PH_MERGE2, l);
#endif
        LAUNCH(PH_ROUTER, l); LAUNCH(PH_MOEUP, l); LAUNCH(PH_MOEDOWN, l);
    }
    LAUNCH(PH_FINAL, 0);
#else
    if (!grid) {
        hipFuncSetAttribute((const void*)k_mega, hipFuncAttributeMaxDynamicSharedMemorySize, LDS_BYTES + 16);
        int dev = 0, cus = 0, per_cu = 0;
        hipGetDevice(&dev);
        hipDeviceGetAttribute(&cus, hipDeviceAttributeMultiprocessorCount, dev);
        hipOccupancyMaxActiveBlocksPerMultiprocessor(&per_cu, (const void*)k_mega, NTHR, LDS_BYTES + 16);
        if (per_cu > 2) per_cu = 2;
        if (per_cu < 1) per_cu = 1;
        grid = cus * per_cu;
    }
    k_mega<<<grid, NTHR, LDS_BYTES + 16, stream>>>(p);
#endif
}
```

```cpp
#include <hip/hip_runtime.h>
#include <stdint.h>
#include <math.h>

typedef unsigned short u16;
typedef short bf16x8 __attribute__((ext_vector_type(8)));
typedef float f32x4 __attribute__((ext_vector_type(4)));
typedef unsigned u32x2 __attribute__((ext_vector_type(2)));
typedef unsigned u32x4 __attribute__((ext_vector_type(4)));

#define DEV __device__ __forceinline__
#define NTHR 256

#define DM 1024
#define RLAT 16384
#define RCTX 512
#define RTOT 16896
#define SEQ 8192
#define CTXL 256
#define NCM 3968
#define NGATE 4096
#define NSTEP 132
#define KPOS 8448
#define EPSF 1e-6f
#define GLA_Q 0
#define GLA_K 256
#define GLA_V 512
#define GLA_G 768
#define GLA_RF 1024
#define GLA_RB 1040
#define ML_Q 1056
#define ML_K 1312
#define ML_V 1568
#define ML_O 1824
#define ML_GF 2080
#define ML_GB 2088
#define GD_Q 2096
#define GD_K 2352
#define GD_V 2608
#define GD_OG 2864
#define GD_GF 3120
#define GD_GB 3128
#define DF_Q 3136
#define DF_K 3392
#define DF_V 3648

DEV int tidx() { int t = threadIdx.x; asm volatile("" : "+v"(t)); __builtin_assume(t >= 0 && t < NTHR); return t; }
DEV int launder_s(int v) { asm volatile("" : "+s"(v)); return v; }
typedef __bf16 bf2_t __attribute__((ext_vector_type(2)));
typedef float f2_t __attribute__((ext_vector_type(2)));
DEV unsigned pack2(float a, float b) { f2_t v; v.x = a; v.y = b; return __builtin_bit_cast(unsigned, __builtin_convertvector(v, bf2_t)); }
DEV u16 f2bf(float f) { return (u16)(pack2(f, 0.f) & 0xffffu); }
DEV float bf2f(u16 h) { return __uint_as_float(((unsigned)h) << 16); }
DEV float sigm(float x) { return 1.f / (1.f + __expf(-x)); }
DEV float silu(float x) { return x / (1.f + __expf(-x)); }
DEV float logsig(float x) { return fminf(x, 0.f) - __logf(1.f + __expf(-fabsf(x))); }
DEV float softplus(float x) { return fmaxf(x, 0.f) + __logf(1.f + __expf(-fabsf(x))); }
DEV float wsum(float v) {
#pragma unroll
    for (int o = 32; o; o >>= 1) v += __shfl_xor(v, o, 64);
    return v;
}
DEV float wmaxr(float v) {
#pragma unroll
    for (int o = 32; o; o >>= 1) v = fmaxf(v, __shfl_xor(v, o, 64));
    return v;
}
DEV f32x4 mfma16(bf16x8 a, bf16x8 b, f32x4 c) { return __builtin_amdgcn_mfma_f32_16x16x32_bf16(a, b, c, 0, 0, 0); }

#ifdef PROBE_SEL
#define PRB_BEGIN(id) unsigned long long prb_t0_##id = ((id) == PROBE_SEL) ? wall_clock64() : 0ull
#define PRB_END(id) do { if ((id) == PROBE_SEL) { __syncthreads(); if (threadIdx.x == 0) { volatile __attribute__((address_space(3))) unsigned long long* a_ = (volatile __attribute__((address_space(3))) unsigned long long*)(size_t)(75776 + 8); *a_ = *a_ + (wall_clock64() - prb_t0_##id); } } } while (0)
#else
#define PRB_BEGIN(id) do { } while (0)
#define PRB_END(id) do { } while (0)
#endif
#define RAW_BARRIER() do { asm volatile("s_waitcnt lgkmcnt(0)" ::: "memory"); __builtin_amdgcn_s_barrier(); } while (0)
struct P {
    const float *x, *c, *ctx, *c_ctx, *w_mod, *b_mod, *norm_mix, *norm_ffn, *w_in, *gla_a2, *gla_ab, *mlstm_gate_b,
        *gdn_conv, *gdn_a_log, *gdn_dt_bias, *diff_lambda, *head_norm, *w_branch, *w_out, *router_w, *router_b,
        *w_gate, *w_up, *w_down, *norm_final;
    float* out;
    unsigned* bar;
    int* cnt;
    float* modp;
    float* mod;
    float* xctx;
    float* rope;
    u16* hbuf;
    u16* ybuf;
    u16* Wt;
    u16* dq;
    u16* dk;
    u16* dvT;
    float* glaDec;
    float* mlN;
    float* mlFE;
    float* mlAE;
    float* mlM;
    u16* glaS;
    u16* mlS;
    u16* gdM;
    u16* gdN;
    u16* gdQ;
    u16* gdO;
    u16* cols;
};
#define MOE_WGU_OFF 0
#define MOE_WD_OFF (16u * 1024u * 1024u)
#define MOE_ACT_OFF (MOE_WD_OFF + 16u * 1024u * 512u)
#define MOE_LIST_OFF (MOE_ACT_OFF + 2u * RTOT * 512u)

DEV const float* xrow_in(const P& p, int l, int r) {
    if (l == 0) return r < RLAT ? p.x + (size_t)r * DM : p.ctx + (size_t)(r - RLAT) * DM;
    return r < RLAT ? p.out + (size_t)r * DM : p.xctx + (size_t)(r - RLAT) * DM;
}
DEV float* xrow_out(const P& p, int r) { return r < RLAT ? p.out + (size_t)r * DM : p.xctx + (size_t)(r - RLAT) * DM; }
DEV int modidx(int r) { return r < RLAT ? (r >> 13) : 2; }
DEV int chunk_row0(int b, int dir, int st) {
    if (st < 4) { int c = dir ? 3 - st : st; return RLAT + b * CTXL + c * 64; }
    int c = dir ? 131 - st : st - 4; return b * SEQ + c * 64;
}
DEV size_t state_idx(int dir, int b, int st, int h) { return ((size_t)((dir * 2 + b) * NSTEP + st) * 4 + h); }
#define XB_TMO      128
#define XB_XCNT(j)  (256  + 64 * (j))
#define XB_XSUB(j)  (1280 + 64 * (j))
#define XB_XGEN(j)  (2304 + 64 * (j))
#define XB_TOP      3328
#define XB_TOPGEN   3392
#define XCD_BAR_WORDS 3456
#define XB_SPIN_CAP (1u << 18)
#define LAS __attribute__((address_space(3)))

__device__ __forceinline__ unsigned xb_ld(unsigned* p)              { return __hip_atomic_load(p, __ATOMIC_RELAXED, __HIP_MEMORY_SCOPE_AGENT); }
__device__ __forceinline__ unsigned xb_add(unsigned* p, unsigned v) { return __hip_atomic_fetch_add(p, v, __ATOMIC_RELAXED, __HIP_MEMORY_SCOPE_AGENT); }
__device__ __forceinline__ unsigned xb_xcc_id() { return (unsigned)__builtin_amdgcn_s_getreg((3 << 11) | 20) & 0xFu; }
#define XB_SPIN(cond, bar) do { unsigned _sp = 0; while (cond) { __builtin_amdgcn_s_sleep(1); \
    if ((++_sp & 255u) == 0u) { if (xb_ld(&(bar)[XB_TMO])) break; if (_sp > XB_SPIN_CAP) { atomicAdd(&(bar)[XB_TMO], 1u); break; } } } } while (0)

struct XcdBarrier {
    unsigned* bar; unsigned x;
    volatile LAS unsigned* st;
};

__device__ __forceinline__ XcdBarrier xcd_barrier_post(unsigned* bar, volatile LAS unsigned* st) {
    XcdBarrier b; b.bar = bar; b.x = xb_xcc_id(); b.st = st;
    if (tidx() == 0) (void)xb_add(&bar[XB_XCNT(b.x)], 1u);
    return b;
}
__device__ __forceinline__ void xcd_barrier_complete(unsigned* bar, unsigned x, unsigned& nloc, unsigned& nx) {
    const unsigned G = gridDim.x * gridDim.y * gridDim.z;
    unsigned sum, cnt, mine, sp = 0u;
    for (;;) {
        sum = 0u; cnt = 0u; mine = 0u;
#pragma unroll
        for (unsigned j = 0; j < 16; ++j) { const unsigned c = xb_ld(&bar[XB_XCNT(j)]); sum += c; cnt += (c > 0u) ? 1u : 0u; mine = (j == x) ? c : mine; }
        if (sum == G) break;
        __builtin_amdgcn_s_sleep(1);
        if ((++sp & 255u) == 0u) { if (xb_ld(&bar[XB_TMO])) break; if (sp > XB_SPIN_CAP) { atomicAdd(&bar[XB_TMO], 1u); break; } }
    }
    nloc = mine > 0u ? mine : 1u; nx = cnt > 0u ? cnt : 1u;
}

__device__ __forceinline__ void xcd_barrier(const XcdBarrier& b) {
    asm volatile("s_waitcnt vmcnt(0)" ::: "memory");
    __syncthreads();
    if (tidx() == 0) {
        unsigned* bar = b.bar;
        __builtin_amdgcn_s_waitcnt(0);
        unsigned nloc = b.st[0], nx = b.st[1];
        if (nloc == 0u) { xcd_barrier_complete(bar, b.x, nloc, nx); b.st[0] = nloc; b.st[1] = nx; }
        const unsigned old = xb_add(&bar[XB_XSUB(b.x)], 1u);
        const unsigned gen = old / nloc;
        if (old + 1u == (gen + 1u) * nloc) {
            __builtin_amdgcn_fence(__ATOMIC_RELEASE, "agent");
            asm volatile("s_waitcnt vmcnt(0)" ::: "memory");
            const unsigned og = xb_add(&bar[XB_TOP], 1u);
            const unsigned tg = og / nx;
            if (og + 1u == (tg + 1u) * nx) xb_add(&bar[XB_TOPGEN], 1u);
            else XB_SPIN(xb_ld(&bar[XB_TOPGEN]) == tg, bar);
            __builtin_amdgcn_fence(__ATOMIC_ACQUIRE, "agent");
            xb_add(&bar[XB_XGEN(b.x)], 1u);
            asm volatile("s_waitcnt vmcnt(0)" ::: "memory");
        } else {
            XB_SPIN(xb_ld(&bar[XB_XGEN(b.x)]) == gen, bar);
            __builtin_amdgcn_fence(__ATOMIC_ACQUIRE, "agent");
            asm volatile("s_waitcnt vmcnt(0)" ::: "memory");
        }
    }
    __syncthreads();
}
struct TrJob { const float* src; u16* dst; int lds_, ldd, map; };
DEV int tr_rowmap(int map, int n) {
    if (map == 1) return n < 3904 ? n : n + 64;
    if (map == 2) return (n >> 5) * 64 + (n & 31);
    if (map == 3) return (n >> 5) * 64 + 32 + (n & 31);
    return n;
}
struct TrRegs { f32x4 r0, r1, r2, r3; };
DEV void tr_load(const TrJob& j, TrRegs& q) {
    const int t = tidx(), n4 = (t & 15) * 4, kp = t >> 4;
    const float* s0 = j.src + (size_t)(2 * kp) * j.lds_ + n4;
    const float* s1 = j.src + (size_t)(2 * (kp + 16)) * j.lds_ + n4;
    q.r0 = *(const f32x4*)s0; q.r1 = *(const f32x4*)(s0 + j.lds_);
    q.r2 = *(const f32x4*)s1; q.r3 = *(const f32x4*)(s1 + j.lds_);
}
DEV void tr_finish(const TrJob& j, int n0, const TrRegs& q, float* smf) {
    unsigned* sm = (unsigned*)smf;
    const int t = tidx();
    {
        const int n4 = (t & 15) * 4, kp = t >> 4;
        sm[(n4 + 0) * 33 + kp] = pack2(q.r0[0], q.r1[0]); sm[(n4 + 1) * 33 + kp] = pack2(q.r0[1], q.r1[1]);
        sm[(n4 + 2) * 33 + kp] = pack2(q.r0[2], q.r1[2]); sm[(n4 + 3) * 33 + kp] = pack2(q.r0[3], q.r1[3]);
        sm[(n4 + 0) * 33 + kp + 16] = pack2(q.r2[0], q.r3[0]); sm[(n4 + 1) * 33 + kp + 16] = pack2(q.r2[1], q.r3[1]);
        sm[(n4 + 2) * 33 + kp + 16] = pack2(q.r2[2], q.r3[2]); sm[(n4 + 3) * 33 + kp + 16] = pack2(q.r2[3], q.r3[3]);
    }
    __syncthreads();
    {
        const int n = t >> 2, kq = (t & 3) * 8;
        u32x4 o0, o1;
        o0.x = sm[n * 33 + kq + 0]; o0.y = sm[n * 33 + kq + 1]; o0.z = sm[n * 33 + kq + 2]; o0.w = sm[n * 33 + kq + 3];
        o1.x = sm[n * 33 + kq + 4]; o1.y = sm[n * 33 + kq + 5]; o1.z = sm[n * 33 + kq + 6]; o1.w = sm[n * 33 + kq + 7];
        u16* d = j.dst + (size_t)tr_rowmap(j.map, n0 + n) * j.ldd + kq * 2;
        *(u32x4*)d = o0; *(u32x4*)(d + 8) = o1;
    }
    __syncthreads();
}
#define WT_WB_OFF (8064u * 1024u)
#define WT_WO_OFF (WT_WB_OFF + 4u * 1024u * 256u)
#define WT_TOTAL (WT_WO_OFF + 1024u * 1024u)

DEV TrJob mixw_job(const P& p, int l, int u, int& n0) {
    TrJob j;
    if (u < 2000) {
        const int kt = u / 125, nt = u % 125; n0 = nt * 64;
        j.src = p.w_in + (size_t)l * 1024 * 8000 + (size_t)kt * 64 * 8000 + n0; j.lds_ = 8000; j.dst = p.Wt + kt * 64; j.ldd = 1024; j.map = 1;
    } else if (u < 2256) {
        const int v = u - 2000, i = v >> 6, w = v & 63, kt = w >> 4, nt = w & 15; n0 = nt * 64;
        j.src = p.w_branch + (size_t)(l * 4 + i) * 256 * 1024 + (size_t)kt * 64 * 1024 + n0; j.lds_ = 1024;
        j.dst = p.Wt + WT_WB_OFF + (size_t)i * 1024 * 256 + kt * 64; j.ldd = 256; j.map = 0;
    } else {
        const int v = u - 2256, kt = v >> 4, nt = v & 15; n0 = nt * 64;
        j.src = p.w_out + (size_t)l * 1024 * 1024 + (size_t)kt * 64 * 1024 + n0; j.lds_ = 1024; j.dst = p.Wt + WT_WO_OFF + kt * 64; j.ldd = 1024; j.map = 0;
    }
    return j;
}
DEV void phase_conv_mixw(const P& p, int l, int bid, int nb, float* sm) {
    if (bid == nb - 1) {
        unsigned* z = (unsigned*)(p.Wt + (size_t)3904 * 1024);
        for (int i = tidx(); i < 64 * 1024 / 2; i += NTHR) z[i] = 0u;
    }
    int u = bid, n0 = 0, n1 = 0;
    if (u >= 2512) return;
    TrRegs r;
    TrJob j = mixw_job(p, l, u, n0);
    tr_load(j, r);
    for (;;) {
        const int un = u + nb;
        TrRegs rn; TrJob jn = j;
        if (un < 2512) { jn = mixw_job(p, l, un, n1); tr_load(jn, rn); }
        tr_finish(j, n0, r, sm);
        if (un >= 2512) break;
        u = un; j = jn; n0 = n1; r = rn;
    }
}
DEV TrJob moew_job(const P& p, int l, int u, int& n0) {
    TrJob j;
    u16* wgu = p.cols + MOE_WGU_OFF;
    u16* wd = p.cols + MOE_WD_OFF;
    const int e = u / 384, v = u % 384;
    const size_t le = (size_t)(l * 16 + e);
    if (v < 256) {
        const int w = v & 127, kt = w >> 3, nt = w & 7; n0 = nt * 64;
        j.src = (v < 128 ? p.w_gate : p.w_up) + le * 1024 * 512 + (size_t)kt * 64 * 512 + n0; j.lds_ = 512;
        j.dst = wgu + (size_t)e * 1024 * 1024 + kt * 64; j.ldd = 1024; j.map = v < 128 ? 2 : 3;
    } else {
        const int w = v - 256, kt = w >> 4, nt = w & 15; n0 = nt * 64;
        j.src = p.w_down + le * 512 * 1024 + (size_t)kt * 64 * 1024 + n0; j.lds_ = 1024; j.dst = wd + (size_t)e * 1024 * 512 + kt * 64; j.ldd = 512; j.map = 0;
    }
    return j;
}
DEV void phase_conv_moew(const P& p, int l, int bid, int nb, float* sm) {
    int u = bid, n0 = 0, n1 = 0;
    if (u >= 16 * 384) return;
    TrRegs r;
    TrJob j = moew_job(p, l, u, n0);
    tr_load(j, r);
    for (;;) {
        const int un = u + nb;
        TrRegs rn; TrJob jn = j;
        if (un < 16 * 384) { jn = moew_job(p, l, un, n1); tr_load(jn, rn); }
        tr_finish(j, n0, r, sm);
        if (un >= 16 * 384) break;
        u = un; j = jn; n0 = n1; r = rn;
    }
}

DEV void phase_mod_partial(const P& p, int bid, int nb, float* sm) {
    for (int u = bid; u < 768; u += nb) {
        const int l = u / 384, v = u % 384, kc = v / 24, jb = v % 24;
        const int t = tidx();
        __syncthreads();
        if (t < 192) {
            const int m = t >> 6, k = kc * 64 + (t & 63);
            const float cv = m < 2 ? p.c[m * 1024 + k] : p.c_ctx[k];
            sm[t] = silu(cv);
        }
        __syncthreads();
        const int j = jb * 256 + t;
        const float* w = p.w_mod + ((size_t)l * 1024 + kc * 64) * 6144 + j;
        float a0 = 0.f, a1 = 0.f, a2 = 0.f;
#pragma unroll 8
        for (int k = 0; k < 64; ++k) {
            const float wv = w[(size_t)k * 6144];
            a0 += sm[k] * wv; a1 += sm[64 + k] * wv; a2 += sm[128 + k] * wv;
        }
        float* o = p.modp + ((size_t)(l * 16 + kc) * 3) * 6144 + j;
        o[0] = a0; o[6144] = a1; o[2 * 6144] = a2;
    }
}
DEV void phase_mod_reduce(const P& p, int bid, int nb) {
    for (int i = bid * NTHR + tidx(); i < 2 * 3 * 6144; i += nb * NTHR) {
        const int l = i / (3 * 6144), r = i % (3 * 6144), m = r / 6144, j = r % 6144;
        float a = p.b_mod[l * 6144 + j];
        for (int kc = 0; kc < 16; ++kc) a += p.modp[((size_t)(l * 16 + kc) * 3 + m) * 6144 + j];
        p.mod[i] = a;
    }
}

DEV void moe_combine_row(const P& p, int l, int r, int lane, float4 (&v)[4]);
DEV void phase_norm1(const P& p, int l, int bid, int nb) {
    const int lane = tidx() & 63, w = tidx() >> 6;
    for (int r0 = (bid * 4 + w) * 2; r0 < RTOT; r0 += nb * 8) {
        f32x4 v[2][4];
#pragma unroll
        for (int q = 0; q < 2; ++q) {
            const float* xr = xrow_in(p, l, r0 + q);
#pragma unroll
            for (int i = 0; i < 4; ++i) v[q][i] = *(const f32x4*)(xr + lane * 4 + i * 256);
        }
#pragma unroll
        for (int q = 0; q < 2; ++q) {
            const int r = r0 + q;
            const int m = modidx(r);
            const float* sh = p.mod + ((size_t)(l * 3 + m)) * 6144;
            const float* sc = sh + 1024;
            float4 t[4];
#pragma unroll
            for (int i = 0; i < 4; ++i) { t[i].x = v[q][i][0]; t[i].y = v[q][i][1]; t[i].z = v[q][i][2]; t[i].w = v[q][i][3]; }
            if (l == 1) {
                moe_combine_row(p, 0, r, lane, t);
                float* xw = xrow_out(p, r);
#pragma unroll
                for (int i = 0; i < 4; ++i) *(float4*)(xw + lane * 4 + i * 256) = t[i];
            }
            float ss = 0.f;
#pragma unroll
            for (int i = 0; i < 4; ++i) ss += t[i].x * t[i].x + t[i].y * t[i].y + t[i].z * t[i].z + t[i].w * t[i].w;
            ss = wsum(ss);
            const float rs = rsqrtf(ss * (1.f / 1024.f) + EPSF);
#pragma unroll
            for (int i = 0; i < 4; ++i) {
                const int c = lane * 4 + i * 256;
                const float4 g = *(const float4*)(p.norm_mix + l * 1024 + c);
                const float4 s1 = *(const float4*)(sc + c);
                const float4 h1 = *(const float4*)(sh + c);
                const float o0 = t[i].x * rs * g.x * (1.f + s1.x) + h1.x;
                const float o1 = t[i].y * rs * g.y * (1.f + s1.y) + h1.y;
                const float o2 = t[i].z * rs * g.z * (1.f + s1.z) + h1.z;
                const float o3 = t[i].w * rs * g.w * (1.f + s1.w) + h1.w;
                u32x2 pk; pk.x = pack2(o0, o1); pk.y = pack2(o2, o3);
                *(u32x2*)(p.hbuf + (size_t)r * 1024 + c) = pk;
            }
        }
    }
}

#define LDP 72
#define GEMM_STAGE (2 * 128 * 64)
DEV int g_row(int tid, int i) { return (tid >> 6) * 32 + i * 8 + ((tid >> 3) & 7); }
DEV int g_kc(int tid, int row) { return ((tid & 7) ^ ((row >> 1) & 7)) * 8; }
DEV void gemm_mainloop(f32x4 (&acc)[4][4], const u16* const (&xp)[4], const u16* const (&wp)[4], int KT, u16* sm, u16*  ) {
    const int tid = tidx(), lane = tid & 63, w = tid >> 6, wn = w & 1, wm = w >> 1;
    const int fr = lane & 15, fq = lane >> 4, sw = (fr >> 1) & 7;
    asm volatile("s_waitcnt vmcnt(0)" ::: "memory");
#pragma unroll
    for (int i = 0; i < 4; ++i) {
        __builtin_amdgcn_global_load_lds((const unsigned*)xp[i], (unsigned*)(sm + (w * 4 + i) * 512), 16, 0, 0);
        __builtin_amdgcn_global_load_lds((const unsigned*)wp[i], (unsigned*)(sm + 128 * 64 + (w * 4 + i) * 512), 16, 0, 0);
    }
    for (int kt = 0; kt < KT; ++kt) {
        asm volatile("s_waitcnt vmcnt(0)" ::: "memory");
        RAW_BARRIER();
        if (kt + 1 < KT) {
            u16* nx = sm + ((kt + 1) & 1) * GEMM_STAGE;
#pragma unroll
            for (int i = 0; i < 4; ++i) {
                __builtin_amdgcn_global_load_lds((const unsigned*)(xp[i] + (kt + 1) * 64), (unsigned*)(nx + (w * 4 + i) * 512), 16, 0, 0);
                __builtin_amdgcn_global_load_lds((const unsigned*)(wp[i] + (kt + 1) * 64), (unsigned*)(nx + 128 * 64 + (w * 4 + i) * 512), 16, 0, 0);
            }
        }
        const u16* sX = sm + (kt & 1) * GEMM_STAGE;
        const u16* sW = sX + 128 * 64;
#pragma unroll
        for (int ks = 0; ks < 2; ++ks) {
            bf16x8 a[4], b[4];
#pragma unroll
            for (int q = 0; q < 4; ++q) {
                a[q] = *(const bf16x8*)(sW + (wn * 64 + q * 16 + fr) * 64 + (((ks * 4 + fq) ^ sw) * 8));
                b[q] = *(const bf16x8*)(sX + (wm * 64 + q * 16 + fr) * 64 + (((ks * 4 + fq) ^ sw) * 8));
            }
#pragma unroll
            for (int nt = 0; nt < 4; ++nt)
#pragma unroll
                for (int mt = 0; mt < 4; ++mt) acc[nt][mt] = mfma16(a[nt], b[mt], acc[nt][mt]);
        }
    }
    RAW_BARRIER();
}
DEV void zero_acc(f32x4 (&acc)[4][4]) {
#pragma unroll
    for (int a = 0; a < 4; ++a)
#pragma unroll
        for (int b = 0; b < 4; ++b) acc[a][b] = f32x4{0.f, 0.f, 0.f, 0.f};
}

#define GB_STAGE (384 * 32)
DEV void gemmb_issue(const u16* const (&xp)[4], const u16* const (&wp)[2], int kt, u16* stg, int w) {
#pragma unroll
    for (int i = 0; i < 4; ++i) __builtin_amdgcn_global_load_lds((const unsigned*)(xp[i] + kt * 32), (unsigned*)(stg + (w * 4 + i) * 512), 16, 0, 0);
#pragma unroll
    for (int i = 0; i < 2; ++i) __builtin_amdgcn_global_load_lds((const unsigned*)(wp[i] + kt * 32), (unsigned*)(stg + 256 * 32 + (w * 2 + i) * 512), 16, 0, 0);
}
DEV void gemmB_lane(int i, int nrow_pieces_per_wave, int& row, int& chunk) {
    const int t = tidx(), l = t & 63, w = t >> 6;
    row = (w * nrow_pieces_per_wave + i) * 16 + (l >> 2);
    chunk = ((l & 3) ^ ((l >> 4) & 3)) * 8;
}
DEV void gemmB_mainloop(f32x4 (&acc)[4][8], const u16* xb, const unsigned (&xo)[4], const u16* wb, const unsigned (&wo)[2], int KT, u16* sm) {
    const int tid = tidx(), lane = tid & 63, w = tid >> 6, wn = w & 1, wm = w >> 1, fr = lane & 15, fq = lane >> 4;
    const int sw = (fr >> 2) & 3;
    const int aoff = (wn * 64 + fr) * 32 + ((fq ^ sw) * 8) + 256 * 32;
    const int boff = (wm * 128 + fr) * 32 + ((fq ^ sw) * 8);
#pragma unroll
    for (int a = 0; a < 4; ++a)
#pragma unroll
        for (int b = 0; b < 8; ++b) acc[a][b] = f32x4{0.f, 0.f, 0.f, 0.f};
    asm volatile("s_waitcnt vmcnt(0)" ::: "memory");
#pragma unroll
    for (int t0 = 0; t0 < 2; ++t0) {
#pragma unroll
        for (int i = 0; i < 4; ++i) __builtin_amdgcn_global_load_lds((const unsigned*)(xb + xo[i] + t0 * 32), (unsigned*)(sm + t0 * GB_STAGE + (w * 4 + i) * 512), 16, 0, 0);
#pragma unroll
        for (int i = 0; i < 2; ++i) __builtin_amdgcn_global_load_lds((const unsigned*)(wb + wo[i] + t0 * 32), (unsigned*)(sm + t0 * GB_STAGE + 256 * 32 + (w * 2 + i) * 512), 16, 0, 0);
    }
    asm volatile("s_waitcnt vmcnt(6)" ::: "memory");
    RAW_BARRIER();
    bf16x8 a[4], b[8];
#pragma unroll
    for (int q = 0; q < 4; ++q) a[q] = *(const bf16x8*)(sm + aoff + q * 512);
#pragma unroll
    for (int q = 0; q < 8; ++q) b[q] = *(const bf16x8*)(sm + boff + q * 512);
    for (int kt = 0; kt < KT; ++kt) {
        asm volatile("s_waitcnt vmcnt(0)" ::: "memory");
        RAW_BARRIER();
        const bool more = kt + 2 < KT, nxt = kt + 1 < KT;
        u16* nx = sm + ((kt + 2) % 3) * GB_STAGE;
        const u16* cur = sm + ((kt + 1) % 3) * GB_STAGE;
#pragma unroll
        for (int h = 0; h < 2; ++h) {
            if (more) {
                __builtin_amdgcn_global_load_lds((const unsigned*)(xb + (kt + 2) * 32 + xo[2 * h]), (unsigned*)(nx + (w * 4 + 2 * h) * 512), 16, 0, 0);
                __builtin_amdgcn_global_load_lds((const unsigned*)(xb + (kt + 2) * 32 + xo[2 * h + 1]), (unsigned*)(nx + (w * 4 + 2 * h + 1) * 512), 16, 0, 0);
                __builtin_amdgcn_global_load_lds((const unsigned*)(wb + (kt + 2) * 32 + wo[h]), (unsigned*)(nx + 256 * 32 + (w * 2 + h) * 512), 16, 0, 0);
            }
#pragma unroll
            for (int nt = 0; nt < 4; ++nt) {
#pragma unroll
                for (int mt = 0; mt < 4; ++mt) acc[nt][4 * h + mt] = mfma16(a[nt], b[4 * h + mt], acc[nt][4 * h + mt]);
                if (h == 1 && nxt) a[nt] = *(const bf16x8*)(cur + aoff + nt * 512);
            }
            __builtin_amdgcn_sched_barrier(0);
            if (nxt) {
#pragma unroll
                for (int mt = 0; mt < 4; ++mt) b[4 * h + mt] = *(const bf16x8*)(cur + boff + (4 * h + mt) * 512);
            }
        }
    }
    RAW_BARRIER();
}

template <bool SIG, int GMODE = 0>
DEV void phase_inproj(const P& p, int wrow0, int ntn, int ldc, int mtiles256, int bid, int nb, u16* sm) {
    for (int u = bid; u < mtiles256 * ntn; u += nb) {
        const int mt_ = u / ntn, nt_ = u % ntn;
        const int m0 = mt_ * 256, n0 = nt_ * 128;
        unsigned xo[4], wo[2];
#pragma unroll
        for (int i = 0; i < 4; ++i) { int row, ch; gemmB_lane(i, 4, row, ch); xo[i] = (unsigned)(row * 1024 + ch); }
#pragma unroll
        for (int i = 0; i < 2; ++i) { int row, ch; gemmB_lane(i, 2, row, ch); wo[i] = (unsigned)(row * 1024 + ch); }
        f32x4 acc[4][8];
        gemmB_mainloop(acc, p.hbuf + (size_t)m0 * 1024, xo, p.Wt + (size_t)(wrow0 + n0) * 1024, wo, 32, sm);
        const int t2 = tidx(), l2 = t2 & 63, w2 = t2 >> 6;
        const int en = n0 + (w2 & 1) * 64 + (l2 >> 4) * 4, em = m0 + (w2 >> 1) * 128 + (l2 & 15);
#pragma unroll
        for (int nt = 0; nt < 4; ++nt)
#pragma unroll
            for (int mt = 0; mt < 8; ++mt) {
                const int n = en + nt * 16, m = em + mt * 16;
                f32x4 v = acc[nt][mt];
                if (SIG) { v[0] = sigm(v[0]); v[1] = sigm(v[1]); v[2] = sigm(v[2]); v[3] = sigm(v[3]); }
                u32x2 pk; pk.x = pack2(v[0], v[1]); pk.y = pack2(v[2], v[3]);
                *(u32x2*)(p.cols + (size_t)m * ldc + n) = pk;
            }
    }
}

DEV void phase_merge1(const P& p, u16* ubuf, int mtiles, int bid, int nb, u16* sm) {
    u16* sX = sm; u16* sW = sm + 128 * LDP;
    const int tid = tidx(), lane = tid & 63, w = tid >> 6, wn = w & 1, wm = w >> 1, fr = lane & 15, fq = lane >> 4;
    for (int u = bid; u < mtiles * 8; u += nb) {
        const int mt_ = u >> 3, nt_ = u & 7;
        const int m0 = mt_ * 128, n0 = nt_ * 128;
        f32x4 tot[4][4]; zero_acc(tot);
        for (int br = 0; br < 4; ++br) {
            const int tu = tidx();
        const u16* xp[4]; const u16* wp[4];
#pragma unroll
            for (int i = 0; i < 4; ++i) {
                const int row = g_row(tu, i), kc = g_kc(tu, row);
                xp[i] = p.ybuf + (size_t)(m0 + row) * 1024 + br * 256 + kc;
                wp[i] = p.Wt + WT_WB_OFF + ((size_t)br * 1024 + n0 + row) * 256 + kc;
            }
            f32x4 acc[4][4]; zero_acc(acc);
            gemm_mainloop(acc, xp, wp, 4, sX, sW);
#pragma unroll
            for (int nt = 0; nt < 4; ++nt)
#pragma unroll
                for (int mt = 0; mt < 4; ++mt) {
                    const int n = n0 + wn * 64 + nt * 16 + fq * 4, m = m0 + wm * 64 + mt * 16 + fr;
                    const u32x2 g = *(const u32x2*)(p.cols + (size_t)m * NGATE + br * 1024 + n);
                    tot[nt][mt][0] += bf2f((u16)(g.x & 0xffff)) * acc[nt][mt][0];
                    tot[nt][mt][1] += bf2f((u16)(g.x >> 16)) * acc[nt][mt][1];
                    tot[nt][mt][2] += bf2f((u16)(g.y & 0xffff)) * acc[nt][mt][2];
                    tot[nt][mt][3] += bf2f((u16)(g.y >> 16)) * acc[nt][mt][3];
                }
        }
#pragma unroll
        for (int nt = 0; nt < 4; ++nt)
#pragma unroll
            for (int mt = 0; mt < 4; ++mt) {
                const int n = n0 + wn * 64 + nt * 16 + fq * 4, m = m0 + wm * 64 + mt * 16 + fr;
                u32x2 pk; pk.x = pack2(tot[nt][mt][0], tot[nt][mt][1]); pk.y = pack2(tot[nt][mt][2], tot[nt][mt][3]);
                *(u32x2*)(ubuf + (size_t)m * 1024 + n) = pk;
            }
    }
}

DEV void phase_merge2(const P& p, int l, const u16* ubuf, int mtiles, int bid, int nb, u16* sm) {
    const int mt256 = mtiles / 2;
    for (int u = bid; u < mt256 * 8; u += nb) {
        const int mt_ = u >> 3, nt_ = u & 7;
        const int m0 = mt_ * 256, n0 = nt_ * 128;
        unsigned xo[4], wo[2];
#pragma unroll
        for (int i = 0; i < 4; ++i) { int row, ch; gemmB_lane(i, 4, row, ch); xo[i] = (unsigned)(row * 1024 + ch); }
#pragma unroll
        for (int i = 0; i < 2; ++i) { int row, ch; gemmB_lane(i, 2, row, ch); wo[i] = (unsigned)(row * 1024 + ch); }
        f32x4 acc[4][8];
        gemmB_mainloop(acc, ubuf + (size_t)m0 * 1024, xo, p.Wt + WT_WO_OFF + (size_t)n0 * 1024, wo, 32, sm);
        const int t2 = tidx(), l2 = t2 & 63, w2 = t2 >> 6;
        const int en = n0 + (w2 & 1) * 64 + (l2 >> 4) * 4, em = m0 + (w2 >> 1) * 128 + (l2 & 15);
#pragma unroll
        for (int mt = 0; mt < 8; ++mt) {
            const int m = em + mt * 16;
            const float* xi = xrow_in(p, l, m);
            float* xw = xrow_out(p, m);
            const float* g1 = p.mod + (size_t)(l * 3 + modidx(m)) * 6144 + 2048;
#pragma unroll
            for (int nt = 0; nt < 4; ++nt) {
                const int n = en + nt * 16;
                const float4 xo4 = *(const float4*)(xi + n);
                const float4 g = *(const float4*)(g1 + n);
                float4 o;
                o.x = xo4.x + g.x * acc[nt][mt][0]; o.y = xo4.y + g.y * acc[nt][mt][1];
                o.z = xo4.z + g.z * acc[nt][mt][2]; o.w = xo4.w + g.w * acc[nt][mt][3];
                *(float4*)(xw + n) = o;
            }
        }
    }
}

DEV void phase_merge2s(const P& p, int l, const u16* ubuf, int mtiles, int bid, int nb, u16* sm) {
    u16* sX = sm; u16* sW = sm + 128 * LDP;
    const int tid = tidx(), lane = tid & 63, w = tid >> 6, wn = w & 1, wm = w >> 1, fr = lane & 15, fq = lane >> 4;
    for (int u = bid; u < mtiles * 8; u += nb) {
        const int mt_ = u >> 3, nt_ = u & 7;
        const int m0 = mt_ * 128, n0 = nt_ * 128;
        const int tu = tidx();
        const u16* xp[4]; const u16* wp[4];
#pragma unroll
        for (int i = 0; i < 4; ++i) {
            const int row = g_row(tu, i), kc = g_kc(tu, row);
            xp[i] = ubuf + (size_t)(m0 + row) * 1024 + kc;
            wp[i] = p.Wt + WT_WO_OFF + (size_t)(n0 + row) * 1024 + kc;
        }
        f32x4 acc[4][4]; zero_acc(acc);
        gemm_mainloop(acc, xp, wp, 16, sX, sW);
#pragma unroll
        for (int nt = 0; nt < 4; ++nt)
#pragma unroll
            for (int mt = 0; mt < 4; ++mt) {
                const int n = n0 + wn * 64 + nt * 16 + fq * 4, m = m0 + wm * 64 + mt * 16 + fr;
                const float4 xo = *(const float4*)(xrow_in(p, l, m) + n);
                const float4 g = *(const float4*)(p.mod + (size_t)(l * 3 + modidx(m)) * 6144 + 2048 + n);
                float4 o;
                o.x = xo.x + g.x * acc[nt][mt][0]; o.y = xo.y + g.y * acc[nt][mt][1];
                o.z = xo.z + g.z * acc[nt][mt][2]; o.w = xo.w + g.w * acc[nt][mt][3];
                *(float4*)(xrow_out(p, m) + n) = o;
            }
    }
}
DEV void phase_norm2_router(const P& p, int l, int nrows, int bid, int nb, float* sm) {
    const int tid = tidx(), lane = tid & 63, w = tid >> 6;
    int* list = (int*)(p.cols + MOE_LIST_OFF);
    float* slotw = (float*)(list + 16 * RTOT);
    int* tokslot = (int*)(slotw + 16 * RTOT);
    float* tokw = (float*)(tokslot + 2 * RTOT);
    int* lcnt = (int*)(sm + 16 * 1024);
    int* rinfo = lcnt + 32;
    float* rwgt = (float*)(rinfo + 4 * 40 * 2);
#pragma unroll 16
    for (int i = tid; i < 16 * 1024; i += NTHR) { const int c = i >> 4, e = i & 15; sm[e * 1024 + c] = p.router_w[i]; }
    if (tid < 32) lcnt[tid] = 0;
    __syncthreads();
    int kk = 0;
    for (int r = bid * 4 + w; r < nrows; r += nb * 4, ++kk) {
        const float* xr = xrow_out(p, r);
        const int m = modidx(r);
        const float* sh = p.mod + ((size_t)(l * 3 + m)) * 6144 + 3072;
        const float* sc = sh + 1024;
        float4 v[4]; float ss = 0.f;
#pragma unroll
        for (int i = 0; i < 4; ++i) {
            v[i] = *(const float4*)(xr + lane * 4 + i * 256);
            ss += v[i].x * v[i].x + v[i].y * v[i].y + v[i].z * v[i].z + v[i].w * v[i].w;
        }
        ss = wsum(ss);
        const float rs = rsqrtf(ss * (1.f / 1024.f) + EPSF);
#pragma unroll
        for (int i = 0; i < 4; ++i) {
            const int c = lane * 4 + i * 256;
            const float4 g = *(const float4*)(p.norm_ffn + l * 1024 + c);
            const float4 s1 = *(const float4*)(sc + c);
            const float4 h1 = *(const float4*)(sh + c);
            v[i].x = v[i].x * rs * g.x * (1.f + s1.x) + h1.x;
            v[i].y = v[i].y * rs * g.y * (1.f + s1.y) + h1.y;
            v[i].z = v[i].z * rs * g.z * (1.f + s1.z) + h1.z;
            v[i].w = v[i].w * rs * g.w * (1.f + s1.w) + h1.w;
            u32x2 pk; pk.x = pack2(v[i].x, v[i].y); pk.y = pack2(v[i].z, v[i].w);
            *(u32x2*)(p.hbuf + (size_t)r * 1024 + c) = pk;
        }
        float sel[16], scr[16];
#pragma unroll
        for (int e = 0; e < 16; ++e) scr[e] = 0.f;
#pragma unroll
        for (int i = 0; i < 4; ++i) {
#pragma unroll
            for (int e = 0; e < 16; ++e) {
                const float4 rw = *(const float4*)(sm + e * 1024 + lane * 4 + i * 256);
                scr[e] += v[i].x * rw.x + v[i].y * rw.y + v[i].z * rw.z + v[i].w * rw.w;
            }
            __builtin_amdgcn_sched_barrier(0);
        }
#pragma unroll
        for (int e = 0; e < 16; ++e) {
            const float a = wsum(scr[e]);
            scr[e] = sigm(a);
            sel[e] = scr[e] + p.router_b[e];
        }
        int bg = 0; float bgs = -INFINITY;
#pragma unroll
        for (int g = 0; g < 4; ++g) {
            float m1 = -INFINITY, m2 = -INFINITY;
#pragma unroll
            for (int j = 0; j < 4; ++j) {
                const float s = sel[g * 4 + j];
                if (s > m1) { m2 = m1; m1 = s; } else if (s > m2) { m2 = s; }
            }
            const float gs = m1 + m2;
            if (gs > bgs) { bgs = gs; bg = g; }
        }
        float gsel[4], gscr[4];
#pragma unroll
        for (int j = 0; j < 4; ++j) { gsel[j] = -INFINITY; gscr[j] = 0.f; }
#pragma unroll
        for (int g = 0; g < 4; ++g)
#pragma unroll
            for (int j = 0; j < 4; ++j) if (bg == g) { gsel[j] = sel[g * 4 + j]; gscr[j] = scr[g * 4 + j]; }
        int j1 = 0; float v1 = gsel[0], w1 = gscr[0];
#pragma unroll
        for (int j = 1; j < 4; ++j) if (gsel[j] > v1) { v1 = gsel[j]; w1 = gscr[j]; j1 = j; }
        int j2 = -1; float v2 = -INFINITY, w2 = 0.f;
#pragma unroll
        for (int j = 0; j < 4; ++j) if (j != j1 && (j2 < 0 || gsel[j] > v2)) { v2 = gsel[j]; w2 = gscr[j]; j2 = j; }
        const float inv = 1.f / (w1 + w2);
        if (lane == 0) {
            const int e1 = bg * 4 + j1, e2 = bg * 4 + j2;
            const int p1 = atomicAdd(lcnt + e1, 1);
            const int p2 = atomicAdd(lcnt + e2, 1);
            rinfo[(w * 40 + kk) * 2 + 0] = e1 * 65536 + p1; rwgt[(w * 40 + kk) * 2 + 0] = w1 * inv;
            rinfo[(w * 40 + kk) * 2 + 1] = e2 * 65536 + p2; rwgt[(w * 40 + kk) * 2 + 1] = w2 * inv;
        }
    }
    __syncthreads();
    if (tid < 16) lcnt[16 + tid] = lcnt[tid] ? atomicAdd(p.cnt + l * 16 + tid, lcnt[tid]) : 0;
    __syncthreads();
    if (lane < 2) {
        int k2 = 0;
        for (int r = bid * 4 + w; r < nrows; r += nb * 4, ++k2) {
            const int inf = rinfo[(w * 40 + k2) * 2 + lane], e = inf >> 16, slot = lcnt[16 + e] + (inf & 65535);
            const float wg = rwgt[(w * 40 + k2) * 2 + lane];
            list[e * RTOT + slot] = r; slotw[e * RTOT + slot] = wg;
            tokslot[r * 2 + lane] = e * RTOT + slot; tokw[r * 2 + lane] = wg;
        }
    }
    __syncthreads();
}

DEV bool moe_find(const int* cnt, int ut, int& e, int& mt, int& off, int& ce) {
    int tb = 0, o = 0;
    for (int k = 0; k < 16; ++k) {
        const int c = cnt[k], nt = (c + 255) >> 8;
        if (ut < tb + nt) { e = k; mt = ut - tb; off = o; ce = c; return true; }
        tb += nt; o += c;
    }
    return false;
}

DEV bool moe_find128(const int* cnt, int ut, int& e, int& mt, int& off, int& ce) {
    int tb = 0, o = 0;
    for (int k = 0; k < 16; ++k) {
        const int c = cnt[k], nt = (c + 127) >> 7;
        if (ut < tb + nt) { e = k; mt = ut - tb; off = o; ce = c; return true; }
        tb += nt; o += c;
    }
    return false;
}

DEV void phase_moe_up_s(const P& p, int l, int bid, int nb, u16* sm) {
    u16* sX = sm; u16* sW = sm + 128 * LDP;
    const int tid = tidx(), lane = tid & 63, w = tid >> 6, wn = w & 1, wm = w >> 1, fr = lane & 15, fq = lane >> 4;
    const int* cnt = p.cnt + l * 16;
    const int* list = (const int*)(p.cols + MOE_LIST_OFF);
    const u16* wgu = p.cols + MOE_WGU_OFF;
    u16* act = p.cols + MOE_ACT_OFF;
    for (int u = bid;; u += nb) {
        int e, mtile, off, ce;
        if (!moe_find128(cnt, u >> 3, e, mtile, off, ce)) break;
        const int n0 = (u & 7) * 128;
        const int tu = tidx();
        const u16* xp[4]; const u16* wp[4];
#pragma unroll
        for (int i = 0; i < 4; ++i) {
            const int row = g_row(tu, i), kc = g_kc(tu, row);
            int s = mtile * 128 + row; s = s < ce ? s : ce - 1;
            const int tok = list[e * RTOT + s];
            xp[i] = p.hbuf + (size_t)tok * 1024 + kc;
            wp[i] = wgu + ((size_t)e * 1024 + n0 + row) * 1024 + kc;
        }
        f32x4 acc[4][4]; zero_acc(acc);
        gemm_mainloop(acc, xp, wp, 16, sX, sW);
#pragma unroll
        for (int nt = 0; nt < 2; ++nt)
#pragma unroll
            for (int mt = 0; mt < 4; ++mt) {
                const int col = ((n0 >> 6) + wn) * 32 + nt * 16 + fq * 4;
                const int s = mtile * 128 + wm * 64 + mt * 16 + fr;
                if (s < ce) {
                    const f32x4 g = acc[nt][mt], uu = acc[nt + 2][mt];
                    u32x2 pk; pk.x = pack2(silu(g[0]) * uu[0], silu(g[1]) * uu[1]); pk.y = pack2(silu(g[2]) * uu[2], silu(g[3]) * uu[3]);
                    *(u32x2*)(act + (size_t)(off + s) * 512 + col) = pk;
                }
            }
    }
}

DEV void phase_moe_down_s(const P& p, int l, int bid, int nb, u16* sm) {
    u16* sX = sm; u16* sW = sm + 128 * LDP;
    const int tid = tidx(), lane = tid & 63, w = tid >> 6, wn = w & 1, wm = w >> 1, fr = lane & 15, fq = lane >> 4;
    const int* cnt = p.cnt + l * 16;
    const int* list = (const int*)(p.cols + MOE_LIST_OFF);
    u16* yslot = p.glaS;
    const u16* wd = p.cols + MOE_WD_OFF;
    const u16* act = p.cols + MOE_ACT_OFF;
    for (int u = bid;; u += nb) {
        int e, mtile, off, ce;
        if (!moe_find128(cnt, u >> 3, e, mtile, off, ce)) break;
        const int n0 = (u & 7) * 128;
        const int tu = tidx();
        const u16* xp[4]; const u16* wp[4];
#pragma unroll
        for (int i = 0; i < 4; ++i) {
            const int row = g_row(tu, i), kc = g_kc(tu, row);
            int s = mtile * 128 + row; s = s < ce ? s : ce - 1;
            xp[i] = act + (size_t)(off + s) * 512 + kc;
            wp[i] = wd + ((size_t)e * 1024 + n0 + row) * 512 + kc;
        }
        f32x4 acc[4][4]; zero_acc(acc);
        gemm_mainloop(acc, xp, wp, 8, sX, sW);
#pragma unroll
        for (int mt = 0; mt < 4; ++mt) {
            const int s = mtile * 128 + wm * 64 + mt * 16 + fr;
            if (s < ce) {
#pragma unroll
                for (int nt = 0; nt < 4; ++nt) {
                    const int n = n0 + wn * 64 + nt * 16 + fq * 4;
                    u32x2 pk; pk.x = pack2(acc[nt][mt][0], acc[nt][mt][1]); pk.y = pack2(acc[nt][mt][2], acc[nt][mt][3]);
                    *(u32x2*)(yslot + (size_t)(off + s) * 1024 + n) = pk;
                }
            }
        }
    }
}

DEV void phase_moe_up(const P& p, int l, int bid, int nb, u16* sm) {
    const int* cnt = p.cnt + l * 16;
    const int* list = (const int*)(p.cols + MOE_LIST_OFF);
    const u16* wgu = p.cols + MOE_WGU_OFF;
    u16* act = p.cols + MOE_ACT_OFF;
    for (int u = bid;; u += nb) {
        int e, mtile, off, ce;
        if (!moe_find(cnt, u >> 3, e, mtile, off, ce)) break;
        const int n0 = (u & 7) * 128;
        unsigned xo[4], wo[2];
#pragma unroll
        for (int i = 0; i < 4; ++i) {
            int row, ch; gemmB_lane(i, 4, row, ch);
            int s = mtile * 256 + row; s = s < ce ? s : ce - 1;
            xo[i] = (unsigned)(list[e * RTOT + s] * 1024 + ch);
        }
#pragma unroll
        for (int i = 0; i < 2; ++i) { int row, ch; gemmB_lane(i, 2, row, ch); wo[i] = (unsigned)(row * 1024 + ch); }
        f32x4 acc[4][8];
        gemmB_mainloop(acc, p.hbuf, xo, wgu + ((size_t)e * 1024 + n0) * 1024, wo, 32, sm);
        const int t2 = tidx(), l2 = t2 & 63, w2 = t2 >> 6;
        const int col0 = ((n0 >> 6) + (w2 & 1)) * 32 + (l2 >> 4) * 4, sb = mtile * 256 + (w2 >> 1) * 128 + (l2 & 15);
#pragma unroll
        for (int nt = 0; nt < 2; ++nt)
#pragma unroll
            for (int mt = 0; mt < 8; ++mt) {
                const int s = sb + mt * 16;
                if (s < ce) {
                    const f32x4 g = acc[nt][mt], uu = acc[nt + 2][mt];
                    u32x2 pk; pk.x = pack2(silu(g[0]) * uu[0], silu(g[1]) * uu[1]); pk.y = pack2(silu(g[2]) * uu[2], silu(g[3]) * uu[3]);
                    *(u32x2*)(act + (size_t)(off + s) * 512 + col0 + nt * 16) = pk;
                }
            }
    }
}

DEV void phase_moe_down(const P& p, int l, int bid, int nb, u16* sm) {
    const int* cnt = p.cnt + l * 16;
    u16* yslot = p.glaS;
    const u16* wd = p.cols + MOE_WD_OFF;
    const u16* act = p.cols + MOE_ACT_OFF;
    for (int u = bid;; u += nb) {
        int e, mtile, off, ce;
        if (!moe_find(cnt, u >> 3, e, mtile, off, ce)) break;
        const int n0 = (u & 7) * 128;
        unsigned xo[4], wo[2];
#pragma unroll
        for (int i = 0; i < 4; ++i) {
            int row, ch; gemmB_lane(i, 4, row, ch);
            int s = mtile * 256 + row; s = s < ce ? s : ce - 1;
            xo[i] = (unsigned)((off + s) * 512 + ch);
        }
#pragma unroll
        for (int i = 0; i < 2; ++i) { int row, ch; gemmB_lane(i, 2, row, ch); wo[i] = (unsigned)(row * 512 + ch); }
        f32x4 acc[4][8];
        gemmB_mainloop(acc, act, xo, wd + ((size_t)e * 1024 + n0) * 512, wo, 16, sm);
        const int t2 = tidx(), l2 = t2 & 63, w2 = t2 >> 6;
        const int en = n0 + (w2 & 1) * 64 + (l2 >> 4) * 4, sb = mtile * 256 + (w2 >> 1) * 128 + (l2 & 15);
#pragma unroll
        for (int mt = 0; mt < 8; ++mt) {
            const int s = sb + mt * 16;
            if (s < ce) {
#pragma unroll
                for (int nt = 0; nt < 4; ++nt) {
                    u32x2 pk; pk.x = pack2(acc[nt][mt][0], acc[nt][mt][1]); pk.y = pack2(acc[nt][mt][2], acc[nt][mt][3]);
                    *(u32x2*)(yslot + (size_t)(off + s) * 1024 + en + nt * 16) = pk;
                }
            }
        }
    }
}

DEV void moe_combine_row(const P& p, int l, int r, int lane, float4 (&v)[4]) {
    const int* cnt = p.cnt + l * 16;
    const int* list = (const int*)(p.cols + MOE_LIST_OFF);
    const int* tokslot = (const int*)((const float*)(list + 16 * RTOT) + 16 * RTOT);
    const float* tokw = (const float*)(tokslot + 2 * RTOT);
    const u16* yslot = p.glaS;
    const float* g2 = p.mod + (size_t)(l * 3 + modidx(r)) * 6144 + 5120;
#pragma unroll
    for (int j = 0; j < 2; ++j) {
        const int ts = tokslot[r * 2 + j], e = ts / RTOT, slot = ts % RTOT;
        const float wg = tokw[r * 2 + j];
        int off = 0;
        for (int k = 0; k < e; ++k) off += cnt[k];
        const u16* yr = yslot + (size_t)(off + slot) * 1024;
#pragma unroll
        for (int i = 0; i < 4; ++i) {
            const int c = lane * 4 + i * 256;
            const u32x2 yv = *(const u32x2*)(yr + c);
            const float4 g = *(const float4*)(g2 + c);
            v[i].x += g.x * wg * __uint_as_float(yv.x << 16); v[i].y += g.y * wg * __uint_as_float(yv.x & 0xffff0000u);
            v[i].z += g.z * wg * __uint_as_float(yv.y << 16); v[i].w += g.w * wg * __uint_as_float(yv.y & 0xffff0000u);
        }
    }
}

DEV void phase_final_norm(const P& p, int bid, int nb) {
    const int lane = tidx() & 63, w = tidx() >> 6;
    for (int r = bid * 4 + w; r < RLAT; r += nb * 4) {
        float* xr = p.out + (size_t)r * DM;
        float4 v[4]; float ss = 0.f;
#pragma unroll
        for (int i = 0; i < 4; ++i) v[i] = *(const float4*)(xr + lane * 4 + i * 256);
        moe_combine_row(p, 1, r, lane, v);
#pragma unroll
        for (int i = 0; i < 4; ++i) ss += v[i].x * v[i].x + v[i].y * v[i].y + v[i].z * v[i].z + v[i].w * v[i].w;
        ss = wsum(ss);
        const float rs = rsqrtf(ss * (1.f / 1024.f) + EPSF);
#pragma unroll
        for (int i = 0; i < 4; ++i) {
            const int c = lane * 4 + i * 256;
            const float4 g = *(const float4*)(p.norm_final + c);
            float4 o; o.x = v[i].x * rs * g.x; o.y = v[i].y * rs * g.y; o.z = v[i].z * rs * g.z; o.w = v[i].w * rs * g.w;
            *(float4*)(xr + c) = o;
        }
    }
}
DEV float wscan_add(float v, int lane) {
#pragma unroll
    for (int o = 1; o < 64; o <<= 1) { const float t = __shfl_up(v, o, 64); if (lane >= o) v += t; }
    return v;
}
DEV float wscan_max(float v, int lane) {
#pragma unroll
    for (int o = 1; o < 64; o <<= 1) { const float t = __shfl_up(v, o, 64); if (lane >= o) v = fmaxf(v, t); }
    return v;
}
DEV void mm64(f32x4 (&acc)[4], const u16* A, int lda, const u16* Bt, int ldb) {
    const int lane = tidx() & 63, w = tidx() >> 6, fr = lane & 15, fq = lane >> 4;
#pragma unroll
    for (int ks = 0; ks < 2; ++ks) {
        const bf16x8 a = *(const bf16x8*)(A + (16 * w + fr) * lda + ks * 32 + fq * 8);
#pragma unroll
        for (int nt = 0; nt < 4; ++nt) {
            const bf16x8 b = *(const bf16x8*)(Bt + (nt * 16 + fr) * ldb + ks * 32 + fq * 8);
            acc[nt] = mfma16(a, b, acc[nt]);
        }
    }
}
DEV void mm64_pre(f32x4 (&acc)[4], const u16* A, int lda, const bf16x8 (&bf)[2][4]) {
    const int lane = tidx() & 63, w = tidx() >> 6, fr = lane & 15, fq = lane >> 4;
#pragma unroll
    for (int ks = 0; ks < 2; ++ks) {
        const bf16x8 a = *(const bf16x8*)(A + (16 * w + fr) * lda + ks * 32 + fq * 8);
#pragma unroll
        for (int nt = 0; nt < 4; ++nt) acc[nt] = mfma16(a, bf[ks][nt], acc[nt]);
    }
}
DEV void ldB64(bf16x8 (&bf)[2][4], const u16* Bt) {
    const int lane = tidx() & 63, fr = lane & 15, fq = lane >> 4;
#pragma unroll
    for (int ks = 0; ks < 2; ++ks)
#pragma unroll
        for (int nt = 0; nt < 4; ++nt) bf[ks][nt] = *(const bf16x8*)(Bt + (nt * 16 + fr) * 64 + ks * 32 + fq * 8);
}
struct Raw16 { u32x4 a, b; };
DEV Raw16 ldraw16(const u16* p) { Raw16 r; r.a = *(const u32x4*)p; r.b = *(const u32x4*)(p + 8); return r; }
DEV void unraw16(const Raw16& r, float (&o)[16]) {
    const unsigned w[8] = {r.a.x, r.a.y, r.a.z, r.a.w, r.b.x, r.b.y, r.b.z, r.b.w};
#pragma unroll
    for (int i = 0; i < 8; ++i) { o[2 * i] = __uint_as_float(w[i] << 16); o[2 * i + 1] = __uint_as_float(w[i] & 0xffff0000u); }
}
DEV void zero4(f32x4 (&acc)[4]) {
#pragma unroll
    for (int i = 0; i < 4; ++i) acc[i] = f32x4{0.f, 0.f, 0.f, 0.f};
}
DEV void ld16bf(const u16* p, float (&o)[16]) {
    const u32x4 a = *(const u32x4*)p, b = *(const u32x4*)(p + 8);
    const unsigned w[8] = {a.x, a.y, a.z, a.w, b.x, b.y, b.z, b.w};
#pragma unroll
    for (int i = 0; i < 8; ++i) { o[2 * i] = __uint_as_float(w[i] << 16); o[2 * i + 1] = __uint_as_float(w[i] & 0xffff0000u); }
}
DEV void st16bf(u16* p, const float (&v)[16]) {
    u32x4 a, b;
    a.x = pack2(v[0], v[1]); a.y = pack2(v[2], v[3]); a.z = pack2(v[4], v[5]); a.w = pack2(v[6], v[7]);
    b.x = pack2(v[8], v[9]); b.y = pack2(v[10], v[11]); b.z = pack2(v[12], v[13]); b.w = pack2(v[14], v[15]);
    *(u32x4*)p = a; *(u32x4*)(p + 8) = b;
}

DEV void phase_rope_table(const P& p, int bid, int nb) {
    for (int i = bid * NTHR + tidx(); i < 192 * 8; i += nb * NTHR) {
        const int e = i >> 3, f = i & 7;
        const float inv = expf(-(float)(2 * f) * (1.f / 16.f) * 9.210340371976184f);
        const float pos = (float)(e < 128 ? e : e - 128);
        const float ang = pos * inv;
        p.rope[2 * i] = cosf(ang); p.rope[2 * i + 1] = sinf(ang);
    }
}
DEV void phase_prep(const P& p, int l, u16* gqkv, int bid, int nb, u16* sm) {
    const int tid = tidx();
    for (int g = bid; g < 264; g += nb) {
        int b, t0, r0, T, pos0;
        if (g < 256) { b = g >> 7; t0 = (g & 127) * 64; r0 = b * SEQ + t0; T = SEQ; pos0 = CTXL + t0; }
        else { const int q = g - 256; b = q >> 2; t0 = (q & 3) * 64; r0 = RLAT + b * CTXL + t0; T = CTXL; pos0 = t0; }
        for (int k = 0; k < 24; ++k) {
            const int id = tid + 256 * k, cg = id % 96, s = id / 96, r = r0 + s, t = t0 + s;
            float a[8];
#pragma unroll
            for (int i = 0; i < 8; ++i) a[i] = 0.f;
#pragma unroll
            for (int j = 0; j < 5; ++j) {
                const int tt = t + j - 2;
                if (tt >= 0 && tt < T) {
                    const u32x4 xv = *(const u32x4*)(p.cols + (size_t)(r + j - 2) * NCM + GD_Q + cg * 8);
                    const float4 w0 = *(const float4*)(p.gdn_conv + (l * 5 + j) * 768 + cg * 8);
                    const float4 w1 = *(const float4*)(p.gdn_conv + (l * 5 + j) * 768 + cg * 8 + 4);
                    a[0] += __uint_as_float(xv.x << 16) * w0.x; a[1] += __uint_as_float(xv.x & 0xffff0000u) * w0.y;
                    a[2] += __uint_as_float(xv.y << 16) * w0.z; a[3] += __uint_as_float(xv.y & 0xffff0000u) * w0.w;
                    a[4] += __uint_as_float(xv.z << 16) * w1.x; a[5] += __uint_as_float(xv.z & 0xffff0000u) * w1.y;
                    a[6] += __uint_as_float(xv.w << 16) * w1.z; a[7] += __uint_as_float(xv.w & 0xffff0000u) * w1.w;
                }
            }
            float ss = 0.f;
#pragma unroll
            for (int i = 0; i < 8; ++i) { a[i] = silu(a[i]); ss += a[i] * a[i]; }
            ss += __shfl_xor(ss, 1, 64); ss += __shfl_xor(ss, 2, 64); ss += __shfl_xor(ss, 4, 64);
            float sc = 1.f;
            if (cg < 64) sc = rsqrtf(ss + EPSF) * (cg < 32 ? 0.125f : 1.f);
            u32x4 o;
            o.x = pack2(a[0] * sc, a[1] * sc); o.y = pack2(a[2] * sc, a[3] * sc); o.z = pack2(a[4] * sc, a[5] * sc); o.w = pack2(a[6] * sc, a[7] * sc);
            *(u32x4*)(gqkv + (size_t)r * 768 + cg * 8) = o;
        }
        for (int k = 0; k < 8; ++k) {
            const int id = tid + 256 * k, c = id & 1, half = (id >> 1) & 1, h = (id >> 2) & 3, qk = (id >> 4) & 1, s = id >> 5;
            const int r = r0 + s, t = t0 + s;
            const u16* src = p.cols + (size_t)r * NCM + (qk ? DF_K : DF_Q) + h * 64 + half * 32 + c * 8;
            const u32x4 v1 = *(const u32x4*)src, v2 = *(const u32x4*)(src + 16);
            const unsigned w1[4] = {v1.x, v1.y, v1.z, v1.w}, w2[4] = {v2.x, v2.y, v2.z, v2.w};
            float x1[8], x2[8], o1[8], o2[8];
#pragma unroll
            for (int i = 0; i < 4; ++i) {
                x1[2 * i] = __uint_as_float(w1[i] << 16); x1[2 * i + 1] = __uint_as_float(w1[i] & 0xffff0000u);
                x2[2 * i] = __uint_as_float(w2[i] << 16); x2[2 * i + 1] = __uint_as_float(w2[i] & 0xffff0000u);
            }
            const float qs = qk ? 1.f : (0.17677669529663687f * 1.4426950408889634f);
            if (g < 256) {
                const float* tb = p.rope + (size_t)(c == 0 ? (t >> 6) : 128 + (t & 63)) * 16;
#pragma unroll
                for (int i = 0; i < 8; ++i) {
                    const float cs = tb[2 * i], sn = tb[2 * i + 1];
                    o1[i] = (x1[i] * cs - x2[i] * sn) * qs; o2[i] = (x1[i] * sn + x2[i] * cs) * qs;
                }
            } else {
#pragma unroll
                for (int i = 0; i < 8; ++i) { o1[i] = x1[i] * qs; o2[i] = x2[i] * qs; }
            }
            u16* dst = (qk ? p.dk : p.dq) + ((size_t)(b * 4 + h) * KPOS + pos0 + s) * 64 + half * 32 + c * 8;
            u32x4 a1, a2;
            a1.x = pack2(o1[0], o1[1]); a1.y = pack2(o1[2], o1[3]); a1.z = pack2(o1[4], o1[5]); a1.w = pack2(o1[6], o1[7]);
            a2.x = pack2(o2[0], o2[1]); a2.y = pack2(o2[2], o2[3]); a2.z = pack2(o2[4], o2[5]); a2.w = pack2(o2[6], o2[7]);
            *(u32x4*)dst = a1; *(u32x4*)(dst + 16) = a2;
        }
        for (int h = 0; h < 4; ++h) {
            __syncthreads();
            {
                const int s = tid >> 2, dg = tid & 3;
                const u32x4 a = *(const u32x4*)(p.cols + (size_t)(r0 + s) * NCM + DF_V + h * 64 + dg * 16);
                const u32x4 c = *(const u32x4*)(p.cols + (size_t)(r0 + s) * NCM + DF_V + h * 64 + dg * 16 + 8);
                const unsigned wv[8] = {a.x, a.y, a.z, a.w, c.x, c.y, c.z, c.w};
#pragma unroll
                for (int k = 0; k < 8; ++k) {
                    sm[(dg * 16 + 2 * k) * 72 + s] = (u16)(wv[k] & 0xffff);
                    sm[(dg * 16 + 2 * k + 1) * 72 + s] = (u16)(wv[k] >> 16);
                }
            }
            __syncthreads();
            {
                const int dv = tid >> 2, sg = tid & 3;
                const u32x4 a = *(const u32x4*)(sm + dv * 72 + sg * 16);
                const u32x4 c = *(const u32x4*)(sm + dv * 72 + sg * 16 + 8);
                u16* o = p.dvT + ((size_t)(b * 4 + h) * 64 + dv) * KPOS + pos0 + sg * 16;
                *(u32x4*)o = a; *(u32x4*)(o + 8) = c;
            }
        }
        __syncthreads();
    }
}
#define TILE_B (64 * LDP * 2)

DEV void gla_cum(const P& p, int l, int dir, int h, int row0, float* cum, float* rt, float* sg) {
    const int tid = tidx();
    const int d = tid & 63, sq = tid >> 6;
    float a2r[16];
#pragma unroll
    for (int j = 0; j < 16; ++j) a2r[j] = p.gla_a2[((size_t)(l * 2 + dir) * 16 + j) * 256 + h * 64 + d];
    const float ab = p.gla_ab[(l * 2 + dir) * 256 + h * 64 + d];
    {
        const int s = tid >> 2, q4 = tid & 3, row = row0 + (dir ? 63 - s : s);
        const u32x2 v = *(const u32x2*)(p.cols + (size_t)row * NCM + GLA_RF + dir * 16 + q4 * 4);
        rt[s * 17 + q4 * 4 + 0] = __uint_as_float(v.x << 16); rt[s * 17 + q4 * 4 + 1] = __uint_as_float(v.x & 0xffff0000u);
        rt[s * 17 + q4 * 4 + 2] = __uint_as_float(v.y << 16); rt[s * 17 + q4 * 4 + 3] = __uint_as_float(v.y & 0xffff0000u);
    }
    __syncthreads();
    float loc[16]; float run = 0.f;
#pragma unroll
    for (int i = 0; i < 16; ++i) {
        const int s = sq * 16 + i;
        float x = ab;
#pragma unroll
        for (int j = 0; j < 16; ++j) x += rt[s * 17 + j] * a2r[j];
        run += logsig(x) * (1.f / 16.f);
        loc[i] = run;
    }
    sg[sq * 64 + d] = run;
    __syncthreads();
    float off = 0.f;
    for (int k = 0; k < sq; ++k) off += sg[k * 64 + d];
#pragma unroll
    for (int i = 0; i < 16; ++i) cum[(sq * 16 + i) * 65 + d] = loc[i] + off;
    __syncthreads();
}

DEV void gla_phaseA(const P& p, int l, int dir, int b, int st, int h, unsigned char* smraw) {
    float* cum = (float*)smraw;
    float* rt = cum + 64 * 65;
    float* sg = rt + 64 * 17;
    u16* kwT = (u16*)(sg + 256);
    u16* vT = kwT + 64 * LDP;
    const int tid = tidx(), lane = tid & 63, w = tid >> 6, fr = lane & 15, fq = lane >> 4;
    const int row0 = chunk_row0(b, dir, st);
    const size_t idx = state_idx(dir, b, st, h);
    Raw16 kraw, vraw;
    {
        const int s = tid >> 2, dg = tid & 3, row = row0 + (dir ? 63 - s : s);
        kraw = ldraw16(p.cols + (size_t)row * NCM + GLA_K + h * 64 + dg * 16);
        vraw = ldraw16(p.cols + (size_t)row * NCM + GLA_V + h * 64 + dg * 16);
    }
    gla_cum(p, l, dir, h, row0, cum, rt, sg);
    {
        const int s = tid >> 2, dg = tid & 3;
        float kk[16], vv[16];
        unraw16(kraw, kk); unraw16(vraw, vv);
#pragma unroll
        for (int i = 0; i < 16; ++i) {
            const int d = dg * 16 + i;
            kwT[d * LDP + s] = f2bf(kk[i] * __expf(cum[63 * 65 + d] - cum[s * 65 + d]));
            vT[d * LDP + s] = f2bf(vv[i]);
        }
        if (tid < 64) p.glaDec[idx * 64 + tid] = __expf(cum[63 * 65 + tid]);
    }
    __syncthreads();
    f32x4 acc[4]; zero4(acc);
    mm64(acc, kwT, LDP, vT, LDP);
#pragma unroll
    for (int nt = 0; nt < 4; ++nt) {
        const int d = 16 * w + fq * 4, e = nt * 16 + fr;
        u32x2 pk; pk.x = pack2(acc[nt][0], acc[nt][1]); pk.y = pack2(acc[nt][2], acc[nt][3]);
        *(u32x2*)(p.glaS + idx * 4096 + e * 64 + d) = pk;
    }
    __syncthreads();
}

DEV void ml_phaseA(const P& p, int l, int dir, int b, int st, int h, unsigned char* smraw) {
    float* wend = (float*)smraw;
    u16* kwT = (u16*)(wend + 64);
    u16* vT = kwT + 64 * LDP;
    const int tid = tidx(), lane = tid & 63, w = tid >> 6, fr = lane & 15, fq = lane >> 4;
    const int row0 = chunk_row0(b, dir, st);
    const size_t idx = state_idx(dir, b, st, h);
    Raw16 kraw, vraw;
    {
        const int s = tid >> 2, dg = tid & 3, row = row0 + (dir ? 63 - s : s);
        kraw = ldraw16(p.cols + (size_t)row * NCM + ML_K + h * 64 + dg * 16);
        vraw = ldraw16(p.cols + (size_t)row * NCM + ML_V + h * 64 + dg * 16);
    }
    if (w == 0) {
        const int row = row0 + (dir ? 63 - lane : lane);
        const float ip = bf2f(p.cols[(size_t)row * NCM + ML_GF + dir * 8 + h]) + p.mlstm_gate_b[((l * 2 + dir) * 2 + 0) * 4 + h];
        const float lf = logsig(bf2f(p.cols[(size_t)row * NCM + ML_GF + dir * 8 + 4 + h]) + p.mlstm_gate_b[((l * 2 + dir) * 2 + 1) * 4 + h]);
        const float fc = wscan_add(lf, lane);
        const float fe = __shfl(fc, 63, 64);
        const float lw = fe - fc + ip;
        const float ae = wmaxr(lw);
        wend[lane] = __expf(lw - ae);
        if (lane == 0) { p.mlFE[idx] = fe; p.mlAE[idx] = ae; }
    }
    __syncthreads();
    {
        const int s = tid >> 2, dg = tid & 3;
        float kk[16], vv[16];
        unraw16(kraw, kk); unraw16(vraw, vv);
        const float ws = wend[s] * 0.125f;
#pragma unroll
        for (int i = 0; i < 16; ++i) {
            const int d = dg * 16 + i;
            kwT[d * LDP + s] = f2bf(kk[i] * ws);
            vT[d * LDP + s] = f2bf(vv[i]);
        }
    }
    __syncthreads();
    if (tid < 64) {
        float a = 0.f;
        for (int s = 0; s < 64; ++s) a += bf2f(kwT[tid * LDP + s]);
        p.mlN[idx * 64 + tid] = a;
    }
    f32x4 acc[4]; zero4(acc);
    mm64(acc, kwT, LDP, vT, LDP);
#pragma unroll
    for (int nt = 0; nt < 4; ++nt) {
        const int d = 16 * w + fq * 4, e = nt * 16 + fr;
        u32x2 pk; pk.x = pack2(acc[nt][0], acc[nt][1]); pk.y = pack2(acc[nt][2], acc[nt][3]);
        *(u32x2*)(p.mlS + idx * 4096 + e * 64 + d) = pk;
    }
    __syncthreads();
}

DEV void gd_phaseA(const P& p, int l, const u16* gqkv, int dir, int b, int st, int h, unsigned char* smraw) {
    float* X = (float*)smraw;
    float* cum = X + 64 * 65 + 32;
    float* beta = cum + 64;
    float* be = beta + 64;
    float* ke = be + 64;
    float* scal = ke + 64;
    u16* Y0 = (u16*)(scal + 64);
    u16* Y1 = Y0 + 64 * LDP;
    u16* Y2 = Y1 + 64 * LDP;
    u16* Y3 = Y2 + 64 * LDP;
    u16* Y4 = Y3 + 64 * LDP;
    u16* Y5 = Y4 + 64 * LDP;
    u16* wT = (u16*)X;
    const int tid = tidx(), lane = tid & 63, w = tid >> 6, fr = lane & 15, fq = lane >> 4;
    const int row0 = chunk_row0(b, dir, st);
    const size_t idx = state_idx(dir, b, st, h);
    if (w == 0) {
        const int row = row0 + (dir ? 63 - lane : lane);
        const float bp = bf2f(p.cols[(size_t)row * NCM + GD_GF + dir * 8 + h]);
        const float ap = bf2f(p.cols[(size_t)row * NCM + GD_GF + dir * 8 + 4 + h]);
        const float bt = sigm(bp);
        const float g = -__expf(p.gdn_a_log[(l * 2 + dir) * 4 + h]) * softplus(ap + p.gdn_dt_bias[(l * 2 + dir) * 4 + h]);
        const float cm = wscan_add(g, lane);
        const float ce = __shfl(cm, 63, 64);
        cum[lane] = cm; beta[lane] = bt; be[lane] = bt * __expf(cm); ke[lane] = __expf(ce - cm);
        if (lane == 0) scal[0] = __expf(ce);
    }
    {
        const int s = tid >> 2, dg = tid & 3, row = row0 + (dir ? 63 - s : s);
        const u16* src = gqkv + (size_t)row * 768 + h * 64 + dg * 16;
        const u32x4 q0 = *(const u32x4*)src, q1 = *(const u32x4*)(src + 8);
        const u32x4 k0 = *(const u32x4*)(src + 256), k1 = *(const u32x4*)(src + 264);
        const u32x4 v0 = *(const u32x4*)(src + 512), v1 = *(const u32x4*)(src + 520);
        *(u32x4*)(Y0 + s * LDP + dg * 16) = q0; *(u32x4*)(Y0 + s * LDP + dg * 16 + 8) = q1;
        *(u32x4*)(Y1 + s * LDP + dg * 16) = k0; *(u32x4*)(Y1 + s * LDP + dg * 16 + 8) = k1;
        const unsigned kw[8] = {k0.x, k0.y, k0.z, k0.w, k1.x, k1.y, k1.z, k1.w};
        const unsigned vw[8] = {v0.x, v0.y, v0.z, v0.w, v1.x, v1.y, v1.z, v1.w};
#pragma unroll
        for (int i = 0; i < 8; ++i) {
            Y2[(dg * 16 + 2 * i) * LDP + s] = (u16)(kw[i] & 0xffff); Y2[(dg * 16 + 2 * i + 1) * LDP + s] = (u16)(kw[i] >> 16);
            Y3[(dg * 16 + 2 * i) * LDP + s] = (u16)(vw[i] & 0xffff); Y3[(dg * 16 + 2 * i + 1) * LDP + s] = (u16)(vw[i] >> 16);
        }
    }
    __syncthreads();
    u32x2 qpre[4];
#pragma unroll
    for (int nt = 0; nt < 4; ++nt) {
        const int c = nt * 16 + fr, row = row0 + (dir ? 63 - c : c);
        qpre[nt] = *(const u32x2*)(gqkv + (size_t)row * 768 + h * 64 + 16 * w + fq * 4);
    }
    {
        f32x4 kk[4], qk[4]; zero4(kk); zero4(qk);
        mm64(kk, Y1, LDP, Y1, LDP);
        mm64(qk, Y0, LDP, Y1, LDP);
#pragma unroll
        for (int nt = 0; nt < 4; ++nt)
#pragma unroll
            for (int j = 0; j < 4; ++j) {
                const int c = 16 * w + fq * 4 + j, s = nt * 16 + fr;
                const float gam = s <= c ? __expf(cum[c] - cum[s]) : 0.f;
                if (s < c) X[c * 65 + s] = beta[c] * kk[nt][j] * gam;
                Y4[c * LDP + s] = f2bf(qk[nt][j] * gam);
            }
    }
    __syncthreads();
    {
        float* Pb = (float*)Y5;
        if (tid < 64) {
            const int blk = tid >> 4, col = tid & 15, base = blk * 16;
            float tc[16];
#pragma unroll
            for (int r = 0; r < 16; ++r) tc[r] = (r == col) ? 1.f : 0.f;
#pragma unroll
            for (int r = 1; r < 16; ++r) {
                float a = 0.f;
#pragma unroll
                for (int s2 = 0; s2 < r; ++s2) a += X[(base + r) * 65 + base + s2] * tc[s2];
                if (r > col) tc[r] = -a;
            }
#pragma unroll
            for (int r = 0; r < 16; ++r) if (r >= col) X[(base + col) * 65 + base + r + 1] = tc[r];
        }
        __syncthreads();
        for (int d = 1; d < 4; ++d) {
            const int nblk = 4 - d;
            for (int e = tid; e < nblk * 256; e += NTHR) {
                const int jb = e >> 8, r = (e >> 4) & 15, c = e & 15, ib = jb + d;
                float a = 0.f;
                for (int k = jb; k < ib; ++k)
#pragma unroll
                    for (int s2 = 0; s2 < 16; ++s2) {
                        const int rr = 16 * k + s2, cc = 16 * jb + c;
                        const float tv = rr >= cc ? X[cc * 65 + rr + 1] : 0.f;
                        a += X[(16 * ib + r) * 65 + rr] * tv;
                    }
                Pb[(jb * 16 + r) * 17 + c] = a;
            }
            __syncthreads();
            for (int e = tid; e < nblk * 256; e += NTHR) {
                const int jb = e >> 8, r = (e >> 4) & 15, c = e & 15, ib = jb + d;
                float a = 0.f;
#pragma unroll
                for (int s2 = 0; s2 < 16; ++s2) {
                    const float tv = s2 <= r ? X[(16 * ib + s2) * 65 + 16 * ib + r + 1] : 0.f;
                    a += tv * Pb[(jb * 16 + s2) * 17 + c];
                }
                X[(16 * jb + c) * 65 + 16 * ib + r + 1] = -a;
            }
            __syncthreads();
        }
    }
    {
        const int c = tid >> 2, sgp = tid & 3;
        float tw[16], tu[16];
#pragma unroll
        for (int i = 0; i < 16; ++i) {
            const int s = sgp * 16 + i;
            const float t = s <= c ? X[s * 65 + c + 1] : 0.f;
            tw[i] = t * be[s]; tu[i] = t * beta[s];
        }
        st16bf(Y0 + c * LDP + sgp * 16, tw);
        st16bf(Y1 + c * LDP + sgp * 16, tu);
    }
    __syncthreads();
    {
        f32x4 wa[4], ua[4]; zero4(wa); zero4(ua);
        mm64(wa, Y0, LDP, Y2, LDP);
        mm64(ua, Y1, LDP, Y3, LDP);
        __syncthreads();
        const int c0 = 16 * w + fq * 4;
        const float k0 = ke[c0], k1 = ke[c0 + 1], k2 = ke[c0 + 2], k3 = ke[c0 + 3];
#pragma unroll
        for (int nt = 0; nt < 4; ++nt) {
            const int d = nt * 16 + fr;
            u32x2 a, bq, c, dq_;
            a.x = pack2(wa[nt][0], wa[nt][1]); a.y = pack2(wa[nt][2], wa[nt][3]);
            bq.x = pack2(wa[nt][0] * k0, wa[nt][1] * k1); bq.y = pack2(wa[nt][2] * k2, wa[nt][3] * k3);
            c.x = pack2(ua[nt][0], ua[nt][1]); c.y = pack2(ua[nt][2], ua[nt][3]);
            dq_.x = pack2(ua[nt][0] * k0, ua[nt][1] * k1); dq_.y = pack2(ua[nt][2] * k2, ua[nt][3] * k3);
            *(u32x2*)(wT + d * LDP + c0) = a;
            *(u32x2*)(Y5 + d * LDP + c0) = bq;
            *(u32x2*)(Y0 + d * LDP + c0) = c;
            *(u32x2*)(Y1 + d * LDP + c0) = dq_;
        }
    }
    __syncthreads();
    {
        const float dec = scal[0];
        f32x4 acc[4];
        zero4(acc); mm64(acc, wT, LDP, Y4, LDP);
#pragma unroll
        for (int nt = 0; nt < 4; ++nt) {
            const int d = 16 * w + fq * 4, c = nt * 16 + fr;
            const u32x2 qv = qpre[nt];
            const float ec = __expf(cum[c]);
            u32x2 pk;
            pk.x = pack2(__uint_as_float(qv.x << 16) * ec - acc[nt][0], __uint_as_float(qv.x & 0xffff0000u) * ec - acc[nt][1]);
            pk.y = pack2(__uint_as_float(qv.y << 16) * ec - acc[nt][2], __uint_as_float(qv.y & 0xffff0000u) * ec - acc[nt][3]);
            *(u32x2*)(p.gdQ + idx * 4096 + c * 64 + d) = pk;
        }
        zero4(acc); mm64(acc, Y5, LDP, Y2, LDP);
#pragma unroll
        for (int nt = 0; nt < 4; ++nt) {
            const int d = 16 * w + fq * 4, d2 = nt * 16 + fr;
            u32x2 pk;
            pk.x = pack2((d == d2 ? dec : 0.f) - acc[nt][0], (d + 1 == d2 ? dec : 0.f) - acc[nt][1]);
            pk.y = pack2((d + 2 == d2 ? dec : 0.f) - acc[nt][2], (d + 3 == d2 ? dec : 0.f) - acc[nt][3]);
            *(u32x2*)(p.gdM + idx * 4096 + d2 * 64 + d) = pk;
        }
        zero4(acc); mm64(acc, Y2, LDP, Y1, LDP);
#pragma unroll
        for (int nt = 0; nt < 4; ++nt) {
            const int d2 = 16 * w + fq * 4, e = nt * 16 + fr;
            u32x2 pk; pk.x = pack2(acc[nt][0], acc[nt][1]); pk.y = pack2(acc[nt][2], acc[nt][3]);
            *(u32x2*)(p.gdN + idx * 4096 + e * 64 + d2) = pk;
        }
        zero4(acc); mm64(acc, Y4, LDP, Y0, LDP);
#pragma unroll
        for (int nt = 0; nt < 4; ++nt) {
            const int c = 16 * w + fq * 4, e = nt * 16 + fr;
            u32x2 pk; pk.x = pack2(acc[nt][0], acc[nt][1]); pk.y = pack2(acc[nt][2], acc[nt][3]);
            *(u32x2*)(p.gdO + idx * 4096 + e * 64 + c) = pk;
        }
    }
    __syncthreads();
}

DEV void phase_chunkA(const P& p, int l, const u16* gqkv, int bid, int nb, unsigned char* sm) {
    for (int u = bid; u < 3 * 2112; u += nb) {
        const int mix = u / 2112, v = u % 2112;
        const int h = v & 3, st = (v >> 2) % NSTEP, db = (v >> 2) / NSTEP, b = db & 1, dir = db >> 1;
        if (mix == 0) { PRB_BEGIN(120); gd_phaseA(p, l, gqkv, dir, b, st, h, sm); PRB_END(120); }
        else if (mix == 1) { PRB_BEGIN(121); gla_phaseA(p, l, dir, b, st, h, sm); PRB_END(121); }
        else { PRB_BEGIN(122); ml_phaseA(p, l, dir, b, st, h, sm); PRB_END(122); }
    }
}
#define GD_STAGE (2 * 64 * 64)
DEV void gd_issue(const P& p, size_t idx, u16* ring, int stg, int w, int lane) {
    u16* md = ring + stg * GD_STAGE;
    u16* nd = md + 64 * 64;
#pragma unroll
    for (int i = 0; i < 2; ++i) {
        const int r = (w * 2 + i) * 8 + (lane >> 3), c = (lane & 7) ^ ((r >> 1) & 7);
        __builtin_amdgcn_global_load_lds((const unsigned*)(p.gdM + idx * 4096 + r * 64 + c * 8), (unsigned*)(md + (w * 2 + i) * 512), 16, 0, 0);
        __builtin_amdgcn_global_load_lds((const unsigned*)(p.gdN + idx * 4096 + r * 64 + c * 8), (unsigned*)(nd + (w * 2 + i) * 512), 16, 0, 0);
    }
}
DEV void gd_frags(const u16* Ms, int w, int fr, int fq, int sw, bf16x8 (&a)[8], u32x2 (&nv)[4]) {
    const u16* Ns = Ms + 64 * 64;
#pragma unroll
    for (int mt = 0; mt < 4; ++mt) {
#pragma unroll
        for (int ks = 0; ks < 2; ++ks) a[mt * 2 + ks] = *(const bf16x8*)(Ms + (mt * 16 + fr) * 64 + (((ks * 4 + fq) ^ sw) * 8));
        nv[mt] = *(const u32x2*)(Ns + (16 * w + fr) * 64 + (((mt * 2 + (fq >> 1)) ^ sw) * 8) + (fq & 1) * 4);
    }
}
DEV void gd_scan(const P& p, int chain, u16* sm) {
    const int dir = chain >> 3, b = (chain >> 2) & 1, h = chain & 3;
    const int tid_ = tidx();
    const int lane = tid_ & 63, w = tid_ >> 6, fr = lane & 15, fq = lane >> 4;
    u16* ring = sm;
    u16* sl = sm + 4 * GD_STAGE + w * 16 * LDP;
    bf16x8 sb[2];
    sb[0] = bf16x8{0, 0, 0, 0, 0, 0, 0, 0}; sb[1] = sb[0];
    const size_t base = state_idx(dir, b, 0, h);
    const int sw = (fr >> 1) & 7;
    asm volatile("s_waitcnt vmcnt(0)" ::: "memory");
    gd_issue(p, base, ring, 0, w, lane);
    gd_issue(p, base + 4, ring, 1, w, lane);
    gd_issue(p, base + 8, ring, 2, w, lane);
    asm volatile("s_waitcnt vmcnt(8)" ::: "memory");
    RAW_BARRIER();
    bf16x8 a[8], an[8]; u32x2 nv[4], nn[4];
    gd_frags(ring, w, fr, fq, sw, a, nv);
    for (int k = 0; k < NSTEP; ++k) {
        if (k == 0) asm volatile("s_waitcnt vmcnt(4)" ::: "memory");
        else if (k == 1) asm volatile("s_waitcnt vmcnt(6)" ::: "memory");
        else if (k + 3 < NSTEP) asm volatile("s_waitcnt vmcnt(8)" ::: "memory");
        else asm volatile("s_waitcnt vmcnt(0)" ::: "memory");
        RAW_BARRIER();
        if (k + 3 < NSTEP) gd_issue(p, base + (size_t)(k + 3) * 4, ring, (k + 3) & 3, w, lane);
        asm volatile("" ::: "memory");
        const size_t idx = base + (size_t)k * 4;
        f32x4 acc[4];
#pragma unroll
        for (int mt = 0; mt < 4; ++mt) {
            acc[mt][0] = __uint_as_float(nv[mt].x << 16); acc[mt][1] = __uint_as_float(nv[mt].x & 0xffff0000u);
            acc[mt][2] = __uint_as_float(nv[mt].y << 16); acc[mt][3] = __uint_as_float(nv[mt].y & 0xffff0000u);
        }
#pragma unroll
        for (int mt = 0; mt < 4; ++mt)
#pragma unroll
            for (int ks = 0; ks < 2; ++ks) acc[mt] = mfma16(a[mt * 2 + ks], sb[ks], acc[mt]);
        if (k + 1 < NSTEP) gd_frags(ring + ((k + 1) & 3) * GD_STAGE, w, fr, fq, sw, an, nn);
#pragma unroll
        for (int ks = 0; ks < 2; ++ks) *(bf16x8*)(p.gdN + idx * 4096 + (16 * w + fr) * 64 + ks * 32 + fq * 8) = sb[ks];
        asm volatile("" ::: "memory");
#pragma unroll
        for (int mt = 0; mt < 4; ++mt) {
            u32x2 pk; pk.x = pack2(acc[mt][0], acc[mt][1]); pk.y = pack2(acc[mt][2], acc[mt][3]);
            *(u32x2*)(sl + fr * LDP + mt * 16 + fq * 4) = pk;
        }
        __builtin_amdgcn_wave_barrier();
#pragma unroll
        for (int ks = 0; ks < 2; ++ks) sb[ks] = *(const bf16x8*)(sl + fr * LDP + ks * 32 + fq * 8);
        __builtin_amdgcn_wave_barrier();
#pragma unroll
        for (int q = 0; q < 8; ++q) a[q] = an[q];
#pragma unroll
        for (int q = 0; q < 4; ++q) nv[q] = nn[q];
    }
    asm volatile("s_waitcnt vmcnt(0)" ::: "memory");
    RAW_BARRIER();
}

DEV void gla_scan(const P& p, int v) {
    const int chain = v >> 3, sub = v & 7;
    const int dir = chain >> 3, b = (chain >> 2) & 1, h = chain & 3;
    const int ep = sub * 256 + tidx(), d = (2 * ep) & 63;
    float s0 = 0.f, s1 = 0.f;
    for (int st0 = 0; st0 < NSTEP; st0 += 12) {
        unsigned kv[12]; float2 dc[12];
#pragma unroll
        for (int k = 0; k < 12; ++k) {
            const size_t idx = state_idx(dir, b, st0 + k, h);
            kv[k] = *(const unsigned*)(p.glaS + idx * 4096 + 2 * ep);
            dc[k] = *(const float2*)(p.glaDec + idx * 64 + d);
        }
#pragma unroll
        for (int k = 0; k < 12; ++k) {
            const size_t idx = state_idx(dir, b, st0 + k, h);
            *(unsigned*)(p.glaS + idx * 4096 + 2 * ep) = pack2(s0, s1);
            s0 = dc[k].x * s0 + __uint_as_float(kv[k] << 16);
            s1 = dc[k].y * s1 + __uint_as_float(kv[k] & 0xffff0000u);
        }
    }
}

DEV void ml_scan(const P& p, int v) {
    const int chain = v >> 3, sub = v & 7;
    const int dir = chain >> 3, b = (chain >> 2) & 1, h = chain & 3;
    const int tid = tidx();
    const int ep = sub * 256 + tid;
    float s0 = 0.f, s1 = 0.f, m = 0.f;
    for (int st0 = 0; st0 < NSTEP; st0 += 12) {
        unsigned kv[12]; float fe[12], ae[12];
#pragma unroll
        for (int k = 0; k < 12; ++k) {
            const size_t idx = state_idx(dir, b, st0 + k, h);
            kv[k] = *(const unsigned*)(p.mlS + idx * 4096 + 2 * ep);
            fe[k] = p.mlFE[idx]; ae[k] = p.mlAE[idx];
        }
#pragma unroll
        for (int k = 0; k < 12; ++k) {
            const size_t idx = state_idx(dir, b, st0 + k, h);
            *(unsigned*)(p.mlS + idx * 4096 + 2 * ep) = pack2(s0, s1);
            const float mn = fmaxf(fe[k] + m, ae[k]);
            const float od = __expf(fe[k] + m - mn), nw = __expf(ae[k] - mn);
            s0 = od * s0 + nw * __uint_as_float(kv[k] << 16);
            s1 = od * s1 + nw * __uint_as_float(kv[k] & 0xffff0000u);
            m = mn;
        }
    }
}
DEV void ml_nscan(const P& p, int v) {
    const int tid = tidx(), chain = v * 4 + (tid >> 6), d = tid & 63;
    const int dir = chain >> 3, b = (chain >> 2) & 1, h = chain & 3;
    float nn = 0.f, m = 0.f;
    for (int st0 = 0; st0 < NSTEP; st0 += 12) {
        float fe[12], ae[12], ks[12];
#pragma unroll
        for (int k = 0; k < 12; ++k) {
            const size_t idx = state_idx(dir, b, st0 + k, h);
            fe[k] = p.mlFE[idx]; ae[k] = p.mlAE[idx]; ks[k] = p.mlN[idx * 64 + d];
        }
#pragma unroll
        for (int k = 0; k < 12; ++k) {
            const size_t idx = state_idx(dir, b, st0 + k, h);
            p.mlN[idx * 64 + d] = nn;
            if (d == 0) p.mlM[idx] = m;
            const float mn = fmaxf(fe[k] + m, ae[k]);
            const float od = __expf(fe[k] + m - mn), nw = __expf(ae[k] - mn);
            nn = od * nn + nw * ks[k];
            m = mn;
        }
    }
}

DEV void phase_scan(const P& p, int bid, int nb, u16* sm) {
    for (int u = bid; u < 16 + 128 + 128 + 4; u += nb) {
        if (u < 16) { PRB_BEGIN(100); gd_scan(p, u, sm); PRB_END(100); }
        else if (u < 144) { PRB_BEGIN(101); gla_scan(p, u - 16); PRB_END(101); }
        else if (u < 272) { PRB_BEGIN(102); ml_scan(p, u - 144); PRB_END(102); }
        else ml_nscan(p, u - 272);
    }
}
DEV void chunk_geom(int g, int& b, int& row0, int& stf, int& stb) {
    b = g / NSTEP; const int wv = g % NSTEP;
    row0 = wv < 4 ? RLAT + b * CTXL + wv * 64 : b * SEQ + (wv - 4) * 64;
    stf = wv; stb = wv < 4 ? 3 - wv : 135 - wv;
}
DEV void obuf_acc(float* obuf, const f32x4 (&acc)[4], int dir) {
    const int lane = tidx() & 63, w = tidx() >> 6, fr = lane & 15, fq = lane >> 4;
#pragma unroll
    for (int nt = 0; nt < 4; ++nt)
#pragma unroll
        for (int j = 0; j < 4; ++j) {
            const int c = 16 * w + fq * 4 + j, e = nt * 16 + fr;
            if (dir == 0) obuf[c * 65 + e] = acc[nt][j]; else obuf[(63 - c) * 65 + e] += acc[nt][j];
        }
}
DEV Raw16 gate_prefetch(const P& p, int h, int row0, int gcol) {
    const int tid = tidx(), row = tid >> 2, eg = tid & 3;
    return ldraw16(p.cols + (size_t)(row0 + row) * NCM + gcol + h * 64 + eg * 16);
}
template <int ACT>
DEV void head_out(const P& p, int l, int br, int h, int row0, const Raw16& graw, const float* obuf) {
    const int tid = tidx(), row = tid >> 2, eg = tid & 3;
    float o[16]; float ss = 0.f;
#pragma unroll
    for (int i = 0; i < 16; ++i) { o[i] = obuf[row * 65 + eg * 16 + i]; ss += o[i] * o[i]; }
    ss += __shfl_xor(ss, 1, 64); ss += __shfl_xor(ss, 2, 64);
    const float rs = rsqrtf(ss * (1.f / 64.f) + EPSF);
    float gt[16];
    unraw16(graw, gt);
    float y[16];
#pragma unroll
    for (int i = 0; i < 16; ++i) {
        const float hn = p.head_norm[(l * 4 + br) * 256 + h * 64 + eg * 16 + i];
        const float a = ACT == 0 ? silu(gt[i]) : sigm(gt[i]);
        y[i] = o[i] * rs * hn * a;
    }
    st16bf(p.ybuf + (size_t)(row0 + row) * 1024 + br * 256 + h * 64 + eg * 16, y);
}

DEV void gla_phaseC(const P& p, int l, int g, int h, unsigned char* smraw) {
    float* cum = (float*)smraw;
    float* rt = cum + 64 * 65;
    float* sg = rt + 64 * 17;
    float* obuf = sg + 256;
    u16* qi = (u16*)(obuf + 64 * 65);
    u16* ko = qi + 64 * LDP;
    u16* vT = ko + 64 * LDP;
    const int tid = tidx(), lane = tid & 63, w = tid >> 6, fr = lane & 15, fq = lane >> 4;
    int b, row0, stf, stb; chunk_geom(g, b, row0, stf, stb);
    const Raw16 graw = gate_prefetch(p, h, row0, GLA_G);
    for (int dir = 0; dir < 2; ++dir) {
        const size_t idx = state_idx(dir, b, dir ? stb : stf, h);
        Raw16 qraw, kraw, vraw; bf16x8 sin_[2][4];
        {
            const int s = tid >> 2, dg = tid & 3, row = row0 + (dir ? 63 - s : s);
            qraw = ldraw16(p.cols + (size_t)row * NCM + GLA_Q + h * 64 + dg * 16);
            kraw = ldraw16(p.cols + (size_t)row * NCM + GLA_K + h * 64 + dg * 16);
            vraw = ldraw16(p.cols + (size_t)row * NCM + GLA_V + h * 64 + dg * 16);
        }
        ldB64(sin_, p.glaS + idx * 4096);
        gla_cum(p, l, dir, h, row0, cum, rt, sg);
        {
            const int s = tid >> 2, dg = tid & 3;
            float qq[16], kk[16], vv[16];
            unraw16(qraw, qq); unraw16(kraw, kk); unraw16(vraw, vv);
#pragma unroll
            for (int i = 0; i < 16; ++i) {
                const float cv = cum[s * 65 + dg * 16 + i];
                qq[i] *= 0.125f * __expf(cv); kk[i] *= __expf(-cv);
                vT[(dg * 16 + i) * LDP + s] = f2bf(vv[i]);
            }
            st16bf(qi + s * LDP + dg * 16, qq);
            st16bf(ko + s * LDP + dg * 16, kk);
        }
        __syncthreads();
        f32x4 sa[4]; zero4(sa);
        mm64(sa, qi, LDP, ko, LDP);
        __syncthreads();
#pragma unroll
        for (int nt = 0; nt < 4; ++nt)
#pragma unroll
            for (int j = 0; j < 4; ++j) {
                const int c = 16 * w + fq * 4 + j, s = nt * 16 + fr;
                ko[c * LDP + s] = f2bf(s <= c ? sa[nt][j] : 0.f);
            }
        __syncthreads();
        f32x4 oa[4]; zero4(oa);
        mm64(oa, ko, LDP, vT, LDP);
        mm64_pre(oa, qi, LDP, sin_);
        obuf_acc(obuf, oa, dir);
        __syncthreads();
    }
    head_out<0>(p, l, 0, h, row0, graw, obuf);
    __syncthreads();
}

DEV void ml_phaseC(const P& p, int l, int g, int h, unsigned char* smraw) {
    float* obuf = (float*)smraw;
    float* fcum = obuf + 64 * 65;
    float* ipre = fcum + 64;
    float* mrow = ipre + 64;
    float* denl = mrow + 64;
    float* qn = denl + 64;
    float* nin = qn + 64;
    u16* qs = (u16*)(nin + 64 + 64);
    u16* ks = qs + 64 * LDP;
    u16* vT = ks + 64 * LDP;
    const int tid = tidx(), lane = tid & 63, w = tid >> 6, fr = lane & 15, fq = lane >> 4;
    int b, row0, stf, stb; chunk_geom(g, b, row0, stf, stb);
    const Raw16 graw = gate_prefetch(p, h, row0, ML_O);
    for (int dir = 0; dir < 2; ++dir) {
        const size_t idx = state_idx(dir, b, dir ? stb : stf, h);
        const float m_in = p.mlM[idx];
        Raw16 qraw, kraw, vraw; bf16x8 cin_[2][4];
        {
            const int s = tid >> 2, dg = tid & 3, row = row0 + (dir ? 63 - s : s);
            qraw = ldraw16(p.cols + (size_t)row * NCM + ML_Q + h * 64 + dg * 16);
            kraw = ldraw16(p.cols + (size_t)row * NCM + ML_K + h * 64 + dg * 16);
            vraw = ldraw16(p.cols + (size_t)row * NCM + ML_V + h * 64 + dg * 16);
        }
        ldB64(cin_, p.mlS + idx * 4096);
        if (w == 0) {
            const int row = row0 + (dir ? 63 - lane : lane);
            const float ip = bf2f(p.cols[(size_t)row * NCM + ML_GF + dir * 8 + h]) + p.mlstm_gate_b[((l * 2 + dir) * 2 + 0) * 4 + h];
            const float lf = logsig(bf2f(p.cols[(size_t)row * NCM + ML_GF + dir * 8 + 4 + h]) + p.mlstm_gate_b[((l * 2 + dir) * 2 + 1) * 4 + h]);
            const float fc = wscan_add(lf, lane);
            const float pm = wscan_max(ip - fc, lane);
            fcum[lane] = fc; ipre[lane] = ip; mrow[lane] = fc + fmaxf(m_in, pm);
            nin[lane] = p.mlN[idx * 64 + lane];
        }
        {
            const int s = tid >> 2, dg = tid & 3;
            float kk[16], vv[16];
            *(u32x4*)(qs + s * LDP + dg * 16) = qraw.a;
            *(u32x4*)(qs + s * LDP + dg * 16 + 8) = qraw.b;
            unraw16(kraw, kk); unraw16(vraw, vv);
#pragma unroll
            for (int i = 0; i < 16; ++i) { kk[i] *= 0.125f; vT[(dg * 16 + i) * LDP + s] = f2bf(vv[i]); }
            st16bf(ks + s * LDP + dg * 16, kk);
        }
        __syncthreads();
        {
            const int c = tid >> 2, dg = tid & 3;
            float a = 0.f;
#pragma unroll
            for (int i = 0; i < 16; ++i) a += bf2f(qs[c * LDP + dg * 16 + i]) * nin[dg * 16 + i];
            a += __shfl_xor(a, 1, 64); a += __shfl_xor(a, 2, 64);
            if (dg == 0) qn[c] = a;
        }
        f32x4 sa[4]; zero4(sa);
        mm64(sa, qs, LDP, ks, LDP);
        __syncthreads();
        float dsum[4] = {0.f, 0.f, 0.f, 0.f};
#pragma unroll
        for (int nt = 0; nt < 4; ++nt)
#pragma unroll
            for (int j = 0; j < 4; ++j) {
                const int c = 16 * w + fq * 4 + j, s = nt * 16 + fr;
                float val = 0.f;
                if (s <= c) val = sa[nt][j] * __expf(fcum[c] - fcum[s] + ipre[s] - mrow[c]);
                dsum[j] += val;
                ks[c * LDP + s] = f2bf(val);
            }
#pragma unroll
        for (int j = 0; j < 4; ++j) {
            float v = dsum[j];
            v += __shfl_xor(v, 1, 64); v += __shfl_xor(v, 2, 64); v += __shfl_xor(v, 4, 64); v += __shfl_xor(v, 8, 64);
            if (fr == 0) denl[16 * w + fq * 4 + j] = v;
        }
        __syncthreads();
        f32x4 n1[4], n2[4]; zero4(n1); zero4(n2);
        mm64(n1, ks, LDP, vT, LDP);
        mm64_pre(n2, qs, LDP, cin_);
        f32x4 oa[4];
#pragma unroll
        for (int j = 0; j < 4; ++j) {
            const int c = 16 * w + fq * 4 + j;
            const float mr = mrow[c];
            const float ec = __expf(fcum[c] + m_in - mr);
            const float den = denl[c] + ec * qn[c];
            const float inv = 1.f / fmaxf(fabsf(den), __expf(-mr));
#pragma unroll
            for (int nt = 0; nt < 4; ++nt) oa[nt][j] = (n1[nt][j] + ec * n2[nt][j]) * inv;
        }
        obuf_acc(obuf, oa, dir);
        __syncthreads();
    }
    head_out<1>(p, l, 1, h, row0, graw, obuf);
    __syncthreads();
}

DEV void gd_phaseC(const P& p, int l, int g, int h, unsigned char* smraw) {
    float* obuf = (float*)smraw;
    const int tid = tidx(), lane = tid & 63, w = tid >> 6, fr = lane & 15, fq = lane >> 4;
    int b, row0, stf, stb; chunk_geom(g, b, row0, stf, stb);
    const Raw16 graw = gate_prefetch(p, h, row0, GD_OG);
    for (int dir = 0; dir < 2; ++dir) {
        const size_t idx = state_idx(dir, b, dir ? stb : stf, h);
        f32x4 oa[4];
#pragma unroll
        for (int nt = 0; nt < 4; ++nt) {
            const u32x2 ov = *(const u32x2*)(p.gdO + idx * 4096 + (nt * 16 + fr) * 64 + 16 * w + fq * 4);
            oa[nt][0] = __uint_as_float(ov.x << 16); oa[nt][1] = __uint_as_float(ov.x & 0xffff0000u);
            oa[nt][2] = __uint_as_float(ov.y << 16); oa[nt][3] = __uint_as_float(ov.y & 0xffff0000u);
        }
        mm64(oa, p.gdQ + idx * 4096, 64, p.gdN + idx * 4096, 64);
        obuf_acc(obuf, oa, dir);
        __syncthreads();
    }
    head_out<0>(p, l, 2, h, row0, graw, obuf);
    __syncthreads();
}
DEV float fexp2(float x) { return __builtin_amdgcn_exp2f(x); }

#define ATT_STAGE_ELEMS (2 * 64 * 64)
DEV void attn_issue(const u16* kbase, const u16* vbase, int kt, u16* ring, int stg, int w, int lane) {
    u16* kd = ring + stg * ATT_STAGE_ELEMS;
    u16* vd = kd + 64 * 64;
#pragma unroll
    for (int i = 0; i < 2; ++i) {
        const int r = (w * 2 + i) * 8 + (lane >> 3), c = (lane & 7) ^ ((r >> 1) & 7);
        __builtin_amdgcn_global_load_lds((const unsigned*)(kbase + (size_t)(kt * 64 + r) * 64 + c * 8), (unsigned*)(kd + (w * 2 + i) * 512), 16, 0, 0);
        __builtin_amdgcn_global_load_lds((const unsigned*)(vbase + (size_t)r * KPOS + kt * 64 + c * 8), (unsigned*)(vd + (w * 2 + i) * 512), 16, 0, 0);
    }
}

DEV void attn_unit(const P& p, int l, int b, int h, int q0pos, int nkeys, int rowbase, u16* ring) {
    const int tid = tidx(), lane = tid & 63, w = tid >> 6, fr = lane & 15, fq = lane >> 4;
    const size_t bh = (size_t)(b * 4 + h);
    float lam;
    {
        const float* lp = p.diff_lambda + (size_t)l * 4 * 4 * 32;
        float a = 0.f, c = 0.f;
        if (lane < 32) { a = lp[(0 * 4 + h) * 32 + lane] * lp[(1 * 4 + h) * 32 + lane]; c = lp[(2 * 4 + h) * 32 + lane] * lp[(3 * 4 + h) * 32 + lane]; }
        a = wsum(a); c = wsum(c);
        lam = expf(a) - expf(c) + (0.8f - 0.6f * expf(-0.3f * (float)l));
    }
    const float lam_init = 0.8f - 0.6f * expf(-0.3f * (float)l);
    bf16x8 qf[2][2];
#pragma unroll
    for (int g = 0; g < 2; ++g)
#pragma unroll
        for (int i = 0; i < 2; ++i)
            qf[g][i] = *(const bf16x8*)(p.dq + (bh * KPOS + q0pos + w * 32 + g * 16 + fr) * 64 + i * 32 + fq * 8);
    f32x4 O[2][2][4], negref[2][2];
    float mref[2][2], lsum[2][2];
#pragma unroll
    for (int i = 0; i < 2; ++i)
#pragma unroll
        for (int g = 0; g < 2; ++g) {
            mref[i][g] = 0.f; lsum[i][g] = 0.f; negref[i][g] = f32x4{0.f, 0.f, 0.f, 0.f};
#pragma unroll
            for (int t = 0; t < 4; ++t) O[i][g][t] = f32x4{0.f, 0.f, 0.f, 0.f};
        }
    const u16* kbase = p.dk + bh * KPOS * 64;
    const u16* vbase = p.dvT + bh * 64 * KPOS;
    const int nk = nkeys >> 6;
    asm volatile("s_waitcnt vmcnt(0)" ::: "memory");
    attn_issue(kbase, vbase, 0, ring, 0, w, lane);
    attn_issue(kbase, vbase, 1, ring, 1, w, lane);
    const int sw = (fr >> 1) & 7;
    for (int kt = 0; kt < nk; ++kt) {
        if (kt + 1 < nk) asm volatile("s_waitcnt vmcnt(4)" ::: "memory"); else asm volatile("s_waitcnt vmcnt(0)" ::: "memory");
        RAW_BARRIER();
        if (kt + 2 < nk) attn_issue(kbase, vbase, kt + 2, ring, (kt + 2) % 3, w, lane);
        const u16* Ks = ring + (kt % 3) * ATT_STAGE_ELEMS;
        const u16* Vs = Ks + 64 * 64;
#pragma unroll
        for (int i = 0; i < 2; ++i) {
            f32x4 s[2][4];
#pragma unroll
            for (int st = 0; st < 4; ++st) {
                const bf16x8 kf = *(const bf16x8*)(Ks + (st * 16 + fr) * 64 + (((i * 4 + fq) ^ sw) * 8));
#pragma unroll
                for (int g = 0; g < 2; ++g) s[g][st] = mfma16(kf, qf[g][i], negref[i][g]);
            }
            float tmx[2];
#pragma unroll
            for (int g = 0; g < 2; ++g) {
                float mx = fmaxf(fmaxf(s[g][0][0], s[g][0][1]), fmaxf(s[g][0][2], s[g][0][3]));
#pragma unroll
                for (int st = 1; st < 4; ++st) mx = fmaxf(fmaxf(mx, s[g][st][0]), fmaxf(fmaxf(s[g][st][1], s[g][st][2]), s[g][st][3]));
                mx = fmaxf(mx, __shfl_xor(mx, 16, 64)); mx = fmaxf(mx, __shfl_xor(mx, 32, 64));
                tmx[g] = mx;
            }
            const bool mv = (tmx[0] > 16.f) || (tmx[1] > 16.f) || (kt == 0 && (tmx[0] < -16.f || tmx[1] < -16.f));
            if (__any(mv)) {
#pragma unroll
                for (int g = 0; g < 2; ++g) {
                    const float d = ((tmx[g] > 16.f) || (kt == 0 && tmx[g] < -16.f)) ? tmx[g] : 0.f;
                    const float fac = fexp2(-d);
                    mref[i][g] += d; lsum[i][g] *= fac;
                    negref[i][g] = f32x4{-mref[i][g], -mref[i][g], -mref[i][g], -mref[i][g]};
#pragma unroll
                    for (int t = 0; t < 4; ++t) { O[i][g][t][0] *= fac; O[i][g][t][1] *= fac; O[i][g][t][2] *= fac; O[i][g][t][3] *= fac; }
#pragma unroll
                    for (int st = 0; st < 4; ++st) { s[g][st][0] -= d; s[g][st][1] -= d; s[g][st][2] -= d; s[g][st][3] -= d; }
                }
            }
            bf16x8 pb[2][2];
#pragma unroll
            for (int g = 0; g < 2; ++g) {
                float ps = 0.f;
#pragma unroll
                for (int st = 0; st < 4; ++st)
#pragma unroll
                    for (int j = 0; j < 4; ++j) { const float e = fexp2(s[g][st][j]); s[g][st][j] = e; ps += e; }
                lsum[i][g] += ps;
#pragma unroll
                for (int ks = 0; ks < 2; ++ks) {
                    union { bf16x8 v; unsigned u[4]; } pk;
                    pk.u[0] = pack2(s[g][2 * ks][0], s[g][2 * ks][1]); pk.u[1] = pack2(s[g][2 * ks][2], s[g][2 * ks][3]);
                    pk.u[2] = pack2(s[g][2 * ks + 1][0], s[g][2 * ks + 1][1]); pk.u[3] = pack2(s[g][2 * ks + 1][2], s[g][2 * ks + 1][3]);
                    pb[g][ks] = pk.v;
                }
            }
#pragma unroll
            for (int ks = 0; ks < 2; ++ks)
#pragma unroll
                for (int t = 0; t < 4; ++t) {
                    union { bf16x8 v; u32x2 h2[2]; } va;
                    va.h2[0] = *(const u32x2*)(Vs + (t * 16 + fr) * 64 + ((((2 * ks) * 2 + (fq >> 1)) ^ sw) * 8) + (fq & 1) * 4);
                    va.h2[1] = *(const u32x2*)(Vs + (t * 16 + fr) * 64 + ((((2 * ks + 1) * 2 + (fq >> 1)) ^ sw) * 8) + (fq & 1) * 4);
#pragma unroll
                    for (int g = 0; g < 2; ++g) O[i][g][t] = mfma16(va.v, pb[g][ks], O[i][g][t]);
                }
        }
    }
    RAW_BARRIER();
#pragma unroll
    for (int g = 0; g < 2; ++g) {
        float l0 = lsum[0][g], l1 = lsum[1][g];
        l0 += __shfl_xor(l0, 16, 64); l0 += __shfl_xor(l0, 32, 64);
        l1 += __shfl_xor(l1, 16, 64); l1 += __shfl_xor(l1, 32, 64);
        const float i0 = 1.f / l0, i1 = lam / l1;
        float o[4][4]; float ss = 0.f;
#pragma unroll
        for (int t = 0; t < 4; ++t)
#pragma unroll
            for (int j = 0; j < 4; ++j) { o[t][j] = O[0][g][t][j] * i0 - O[1][g][t][j] * i1; ss += o[t][j] * o[t][j]; }
        ss += __shfl_xor(ss, 16, 64); ss += __shfl_xor(ss, 32, 64);
        const float rs = rsqrtf(ss * (1.f / 64.f) + EPSF) * (1.f - lam_init);
        const int row = rowbase + w * 32 + g * 16 + fr;
#pragma unroll
        for (int t = 0; t < 4; ++t) {
            const int dv = t * 16 + fq * 4;
            const float4 hn = *(const float4*)(p.head_norm + (l * 4 + 3) * 256 + h * 64 + dv);
            u32x2 pk; pk.x = pack2(o[t][0] * rs * hn.x, o[t][1] * rs * hn.y); pk.y = pack2(o[t][2] * rs * hn.z, o[t][3] * rs * hn.w);
            *(u32x2*)(p.ybuf + (size_t)row * 1024 + 768 + h * 64 + dv) = pk;
        }
    }
}

template <int PART>
DEV void phase_outputs(const P& p, int l, int bid, int nb, unsigned char* sm) {
    if (PART != 2) {
    const int nq = 64 + (l == 0 ? 2 : 0);
    int* qctr = p.cnt + 64 + l * 8;
    volatile int* slot = (volatile int*)(sm + 3 * ATT_STAGE_ELEMS * 2);
    const int x0 = (int)(xb_xcc_id() & 7u);
    for (int a = 0; a < 8; ++a) {
        const int bh = (x0 + a) & 7;
        for (;;) {
            if (tidx() == 0) *slot = atomicAdd(qctr + bh, 1);
            __syncthreads();
            const int qt = *slot;
            __syncthreads();
            if (qt >= nq) break;
            const int b = bh >> 2, h = bh & 3;
            if (qt < 64) attn_unit(p, l, b, h, CTXL + qt * 128, KPOS, b * SEQ + qt * 128, (u16*)sm);
            else attn_unit(p, l, b, h, (qt - 64) * 128, CTXL, RLAT + b * CTXL + (qt - 64) * 128, (u16*)sm);
        }
    }
    }
    __builtin_amdgcn_sched_barrier(0);
    if (PART != 1)
    for (int v = bid; v < 3 * 1056; v += nb) {
        const int mix = v / 1056, r = v % 1056, g = r >> 2, h = r & 3;
        if (l == 1 && (g % NSTEP) < 4) continue;
        if (mix == 0) { PRB_BEGIN(131); gla_phaseC(p, l, g, h, sm); PRB_END(131); }
        else if (mix == 1) { PRB_BEGIN(132); ml_phaseC(p, l, g, h, sm); PRB_END(132); }
        else { PRB_BEGIN(133); gd_phaseC(p, l, g, h, sm); PRB_END(133); }
    }
}
#define LDS_BYTES 75776
#ifndef MULTI
#define MULTI 0
#endif
#ifndef STAGE
#define STAGE 99
#endif

enum { PH_PRO0 = 0, PH_PRO1, PH_NORM1, PH_INPROJ, PH_PREP, PH_CHUNKA, PH_SCAN, PH_OUT, PH_GATES, PH_MERGE1, PH_MERGE2, PH_ROUTER, PH_MOEUP, PH_MOEDOWN, PH_FINAL, PH_OUTC };

template <int PH>
DEV void run_phase(const P& p, int l, int bid_, int nb_, unsigned char* sm) {
    const int bid = launder_s(bid_), nb = launder_s(nb_);
    u16* gqkv = p.ybuf;
    u16* ubuf = p.glaS;
    const int mtiles = l == 0 ? 132 : 128;
    if (PH == PH_PRO0) { phase_conv_mixw(p, 0, bid, nb, (float*)sm); phase_mod_partial(p, bid, nb, (float*)sm); phase_rope_table(p, bid, nb); }
    else if (PH == PH_PRO1) phase_mod_reduce(p, bid, nb);
    else if (PH == PH_NORM1) phase_norm1(p, l, bid, nb);
    else if (PH == PH_INPROJ) phase_inproj<false>(p, 0, 31, NCM, 66, bid, nb, (u16*)sm);
    else if (PH == PH_PREP) phase_prep(p, l, gqkv, bid, nb, (u16*)sm);
    else if (PH == PH_CHUNKA) phase_chunkA(p, l, gqkv, bid, nb, sm);
    else if (PH == PH_SCAN) phase_scan(p, bid, nb, (u16*)sm);
#ifdef PROBE_SPLIT
    else if (PH == PH_OUT) phase_outputs<1>(p, l, bid, nb, sm);
    else if (PH == PH_OUTC) phase_outputs<2>(p, l, bid, nb, sm);
#else
    else if (PH == PH_OUT) phase_outputs<0>(p, l, bid, nb, sm);
#endif
    else if (PH == PH_GATES) phase_inproj<true>(p, 3968, 32, NGATE, mtiles / 2, bid, nb, (u16*)sm);
    else if (PH == PH_MERGE1) phase_merge1(p, ubuf, mtiles, bid, nb, (u16*)sm);
    else if (PH == PH_MERGE2) { if (l == 0) phase_merge2s(p, l, ubuf, mtiles, bid, nb, (u16*)sm); else phase_merge2(p, l, ubuf, mtiles, bid, nb, (u16*)sm); }
    else if (PH == PH_ROUTER) {
        { PRB_BEGIN(110); phase_norm2_router(p, l, l == 0 ? RTOT : RLAT, bid, nb, (float*)sm); PRB_END(110); }
        { PRB_BEGIN(111); phase_conv_moew(p, l, bid, nb, (float*)sm); PRB_END(111); }
        if (l == 0) { PRB_BEGIN(112); phase_conv_mixw(p, 1, bid, nb, (float*)sm); PRB_END(112); }
    }
    else if (PH == PH_MOEUP) phase_moe_up(p, l, bid, nb, (u16*)sm);
    else if (PH == PH_MOEDOWN) phase_moe_down_s(p, l, bid, nb, (u16*)sm);
    else if (PH == PH_FINAL) phase_final_norm(p, bid, nb);
}

#if MULTI
template <int PH>
__global__ void __launch_bounds__(NTHR, 2) k_phase(P p, int l) {
    extern __shared__ __attribute__((aligned(16))) unsigned char smem[];
    run_phase<PH>(p, l, blockIdx.x, gridDim.x, smem);
}
#else
__global__ void __launch_bounds__(NTHR, 2) k_mega(P p) {
    extern __shared__ __attribute__((aligned(16))) unsigned char smem[];
    volatile LAS unsigned* xbw = (volatile LAS unsigned*)(smem + LDS_BYTES);
    if (threadIdx.x == 0) { xbw[0] = 0u; xbw[1] = 0u; xbw[2] = 0u; xbw[3] = 0u; }
    __syncthreads();
    (void)xcd_barrier_post(p.bar, xbw);
    const int bid = blockIdx.x, nb = gridDim.x;
#ifdef PROBE_SEL
    unsigned long long pr_t0 = wall_clock64();
    volatile LAS unsigned long long* pr_acc = (volatile LAS unsigned long long*)(smem + LDS_BYTES + 8);
#ifdef PROBE_CLK
    unsigned long long pr_c0 = __builtin_readcyclecounter();
#define PSTAMP(PH) do { const unsigned long long c_ = __builtin_readcyclecounter(); if ((PH) == PROBE_SEL && threadIdx.x == 0) *pr_acc = *pr_acc + (c_ - pr_c0) / 24ull; pr_c0 = c_; } while (0)
#else
#define PSTAMP(PH) do { const unsigned long long t_ = wall_clock64(); if ((PH) == PROBE_SEL && threadIdx.x == 0) *pr_acc = *pr_acc + (t_ - pr_t0); pr_t0 = t_; } while (0)
#endif
#else
#define PSTAMP(PH) do { } while (0)
#endif
#ifdef PROBE_2BAR
#define GBAR() do { GBAR1(); GBAR1(); } while (0)
#else
#define GBAR() GBAR1()
#endif
#define GBAR1() do { XcdBarrier b_; b_.bar = p.bar; b_.x = xb_xcc_id(); b_.st = (volatile LAS unsigned*)(smem + LDS_BYTES); xcd_barrier(b_); } while (0)
    run_phase<PH_PRO0>(p, 0, bid, nb, smem); GBAR(); PSTAMP(PH_PRO0);
    run_phase<PH_PRO1>(p, 0, bid, nb, smem); GBAR(); PSTAMP(PH_PRO1);
    for (int l = 0; l < 2; ++l) {
        run_phase<PH_NORM1>(p, l, bid, nb, smem); GBAR(); PSTAMP(PH_NORM1);
        run_phase<PH_INPROJ>(p, l, bid, nb, smem); GBAR(); PSTAMP(PH_INPROJ);
#ifdef PROBE_GEMM
        { PRB_BEGIN(200); phase_inproj<false, PROBE_GEMM>(p, 0, 31, NCM, 66, launder_s(bid), launder_s(nb), (u16*)smem); PRB_END(200); } GBAR();
#endif
        run_phase<PH_PREP>(p, l, bid, nb, smem); GBAR(); PSTAMP(PH_PREP);
        run_phase<PH_CHUNKA>(p, l, bid, nb, smem); GBAR(); PSTAMP(PH_CHUNKA);
        run_phase<PH_SCAN>(p, l, bid, nb, smem); GBAR(); PSTAMP(PH_SCAN);
        run_phase<PH_OUT>(p, l, bid, nb, smem); GBAR(); PSTAMP(PH_OUT);
#ifdef PROBE_SPLIT
        run_phase<PH_OUTC>(p, l, bid, nb, smem); GBAR(); PSTAMP(PH_OUTC);
#endif
        run_phase<PH_GATES>(p, l, bid, nb, smem); GBAR(); PSTAMP(PH_GATES);
        run_phase<PH_MERGE1>(p, l, bid, nb, smem); GBAR(); PSTAMP(PH_MERGE1);
        run_phase<PH_MERGE2>(p, l, bid, nb, smem); GBAR(); PSTAMP(PH_MERGE2);
        run_phase<PH_ROUTER>(p, l, bid, nb, smem); GBAR(); PSTAMP(PH_ROUTER);
        run_phase<PH_MOEUP>(p, l, bid, nb, smem); GBAR(); PSTAMP(PH_MOEUP);
        run_phase<PH_MOEDOWN>(p, l, bid, nb, smem); GBAR(); PSTAMP(PH_MOEDOWN);
    }
    run_phase<PH_FINAL>(p, 0, bid, nb, smem);
#ifdef PROBE_SEL
    __syncthreads();
    { const unsigned long long te = wall_clock64(), wt = *pr_acc * 4ull; while (wall_clock64() - te < wt) __builtin_amdgcn_s_sleep(8); }
#endif
}
#endif

static size_t al256(size_t x) { return (x + 255) & ~(size_t)255; }

extern "C" void kernel_launch(void* const* d_in, const int* in_sizes, int n_in, void* d_out, int out_size, void* d_ws, size_t ws_size,
                              hipStream_t stream) {
    (void)in_sizes; (void)n_in; (void)out_size; (void)ws_size;
    P p{};
    p.x = (const float*)d_in[0]; p.c = (const float*)d_in[1]; p.ctx = (const float*)d_in[2]; p.c_ctx = (const float*)d_in[3];
    p.w_mod = (const float*)d_in[4]; p.b_mod = (const float*)d_in[5]; p.norm_mix = (const float*)d_in[6]; p.norm_ffn = (const float*)d_in[7];
    p.w_in = (const float*)d_in[8]; p.gla_a2 = (const float*)d_in[9]; p.gla_ab = (const float*)d_in[10]; p.mlstm_gate_b = (const float*)d_in[11];
    p.gdn_conv = (const float*)d_in[12]; p.gdn_a_log = (const float*)d_in[13]; p.gdn_dt_bias = (const float*)d_in[14];
    p.diff_lambda = (const float*)d_in[15]; p.head_norm = (const float*)d_in[16]; p.w_branch = (const float*)d_in[17];
    p.w_out = (const float*)d_in[18]; p.router_w = (const float*)d_in[19]; p.router_b = (const float*)d_in[20];
    p.w_gate = (const float*)d_in[21]; p.w_up = (const float*)d_in[22]; p.w_down = (const float*)d_in[23]; p.norm_final = (const float*)d_in[24];
    p.out = (float*)d_out;
    unsigned char* ws = (unsigned char*)d_ws;
    size_t o = 0;
    auto take = [&](size_t bytes) { unsigned char* r = ws + o; o = al256(o + bytes); return r; };
    p.bar = (unsigned*)take(XCD_BAR_WORDS * 4);
    p.cnt = (int*)take(1024);
    const size_t zero_bytes = o;
    p.modp = (float*)take((size_t)2 * 16 * 3 * 6144 * 4);
    p.mod = (float*)take((size_t)2 * 3 * 6144 * 4);
    p.xctx = (float*)take((size_t)RCTX * DM * 4);
    p.rope = (float*)take((size_t)192 * 8 * 2 * 4);
    p.hbuf = (u16*)take((size_t)RTOT * DM * 2);
    p.ybuf = (u16*)take((size_t)RTOT * DM * 2);
    p.Wt = (u16*)take((size_t)WT_TOTAL * 2);
    p.dq = (u16*)take((size_t)8 * KPOS * 64 * 2);
    p.dk = (u16*)take((size_t)8 * KPOS * 64 * 2);
    p.dvT = (u16*)take((size_t)8 * KPOS * 64 * 2);
    const size_t nst = (size_t)2 * 2 * NSTEP * 4;
    p.glaDec = (float*)take(nst * 64 * 4);
    p.mlN = (float*)take(nst * 64 * 4);
    p.mlFE = (float*)take(nst * 4);
    p.mlAE = (float*)take(nst * 4);
    p.mlM = (float*)take(nst * 4);
    p.glaS = (u16*)take(nst * 4096 * 2);
    p.mlS = (u16*)take(nst * 4096 * 2);
    p.gdM = (u16*)take(nst * 4096 * 2);
    p.gdN = (u16*)take(nst * 4096 * 2);
    p.gdQ = (u16*)take(nst * 4096 * 2);
    p.gdO = (u16*)take(nst * 4096 * 2);
    p.cols = (u16*)take((size_t)RTOT * NGATE * 2);
    hipMemsetAsync(ws, 0, zero_bytes, stream);

    static int grid = 0;
#if MULTI
#define SETUP(PH) hipFuncSetAttribute((const void*)k_phase<PH>, hipFuncAttributeMaxDynamicSharedMemorySize, LDS_BYTES + 16)
    if (!grid) {
        SETUP(PH_PRO0); SETUP(PH_PRO1); SETUP(PH_NORM1); SETUP(PH_INPROJ); SETUP(PH_PREP); SETUP(PH_CHUNKA); SETUP(PH_SCAN); SETUP(PH_OUT);
        SETUP(PH_GATES); SETUP(PH_MERGE1); SETUP(PH_MERGE2); SETUP(PH_ROUTER); SETUP(PH_MOEUP); SETUP(PH_MOEDOWN); SETUP(PH_FINAL);
        grid = 512;
    }
#define LAUNCH(PH, l) k_phase<PH><<<grid, NTHR, LDS_BYTES + 16, stream>>>(p, l)
    LAUNCH(PH_PRO0, 0); LAUNCH(PH_PRO1, 0);
    for (int l = 0; l < 2; ++l) {
        LAUNCH(PH_NORM1, l);
#if STAGE >= 1
        LAUNCH(PH_INPROJ, l); LAUNCH(PH_PREP, l); LAUNCH(PH_CHUNKA, l); LAUNCH(PH_SCAN, l); LAUNCH(PH_OUT, l);
        LAUNCH(PH_GATES, l); LAUNCH(PH_MERGE1, l); LAUNCH(PH_MERGE2, l);
#endif
        LAUNCH(PH_ROUTER, l); LAUNCH(PH_MOEUP, l); LAUNCH(PH_MOEDOWN, l);
    }
    LAUNCH(PH_FINAL, 0);
#else
    if (!grid) {
        hipFuncSetAttribute((const void*)k_mega, hipFuncAttributeMaxDynamicSharedMemorySize, LDS_BYTES + 16);
        int dev = 0, cus = 0, per_cu = 0;
        hipGetDevice(&dev);
        hipDeviceGetAttribute(&cus, hipDeviceAttributeMultiprocessorCount, dev);
        hipOccupancyMaxActiveBlocksPerMultiprocessor(&per_cu, (const void*)k_mega, NTHR, LDS_BYTES + 16);
        if (per_cu > 2) per_cu = 2;
        if (per_cu < 1) per_cu = 1;
        grid = cus * per_cu;
    }
    k_mega<<<grid, NTHR, LDS_BYTES + 16, stream>>>(p);
#endif
}
```

```cpp
#include <hip/hip_runtime.h>
#include <stdint.h>
#include <math.h>

typedef unsigned short u16;
typedef short bf16x8 __attribute__((ext_vector_type(8)));
typedef float f32x4 __attribute__((ext_vector_type(4)));
typedef unsigned u32x2 __attribute__((ext_vector_type(2)));
typedef unsigned u32x4 __attribute__((ext_vector_type(4)));

#define DEV __device__ __forceinline__
#define NTHR 256

#define DM 1024
#define RLAT 16384
#define RCTX 512
#define RTOT 16896
#define SEQ 8192
#define CTXL 256
#define NCM 3968
#define NGATE 4096
#define NSTEP 132
#define KPOS 8448
#define EPSF 1e-6f
#define GLA_Q 0
#define GLA_K 256
#define GLA_V 512
#define GLA_G 768
#define GLA_RF 1024
#define GLA_RB 1040
#define ML_Q 1056
#define ML_K 1312
#define ML_V 1568
#define ML_O 1824
#define ML_GF 2080
#define ML_GB 2088
#define GD_Q 2096
#define GD_K 2352
#define GD_V 2608
#define GD_OG 2864
#define GD_GF 3120
#define GD_GB 3128
#define DF_Q 3136
#define DF_K 3392
#define DF_V 3648

DEV int tidx() { int t = threadIdx.x; asm volatile("" : "+v"(t)); __builtin_assume(t >= 0 && t < NTHR); return t; }
DEV int launder_s(int v) { asm volatile("" : "+s"(v)); return v; }
typedef __bf16 bf2_t __attribute__((ext_vector_type(2)));
typedef float f2_t __attribute__((ext_vector_type(2)));
DEV unsigned pack2(float a, float b) { f2_t v; v.x = a; v.y = b; return __builtin_bit_cast(unsigned, __builtin_convertvector(v, bf2_t)); }
DEV u16 f2bf(float f) { return (u16)(pack2(f, 0.f) & 0xffffu); }
DEV float bf2f(u16 h) { return __uint_as_float(((unsigned)h) << 16); }
DEV float sigm(float x) { return 1.f / (1.f + __expf(-x)); }
DEV float silu(float x) { return x / (1.f + __expf(-x)); }
DEV float logsig(float x) { return fminf(x, 0.f) - __logf(1.f + __expf(-fabsf(x))); }
DEV float softplus(float x) { return fmaxf(x, 0.f) + __logf(1.f + __expf(-fabsf(x))); }
DEV float shx(float v, int o) { return __shfl_xor(v, o, 64); }
DEV float shidx(float v, int src) { return __int_as_float(__builtin_amdgcn_ds_bpermute(src << 2, __float_as_int(v))); }
DEV float shup(float v, int o) { const int l = tidx() & 63; return __int_as_float(__builtin_amdgcn_ds_bpermute((l >= o ? l - o : l) << 2, __float_as_int(v))); }
DEV float wsum(float v) {
    const int l4 = (tidx() & 63) << 2;
#pragma unroll
    for (int o = 32; o; o >>= 1) v += __int_as_float(__builtin_amdgcn_ds_bpermute(l4 ^ (o << 2), __float_as_int(v)));
    return v;
}
DEV float wmaxr(float v) {
    const int l4 = (tidx() & 63) << 2;
#pragma unroll
    for (int o = 32; o; o >>= 1) v = fmaxf(v, __int_as_float(__builtin_amdgcn_ds_bpermute(l4 ^ (o << 2), __float_as_int(v))));
    return v;
}
DEV f32x4 mfma16(bf16x8 a, bf16x8 b, f32x4 c) { return __builtin_amdgcn_mfma_f32_16x16x32_bf16(a, b, c, 0, 0, 0); }

#ifdef PROBE_SEL
#define PRB_BEGIN(id) unsigned long long prb_t0_##id = ((id) == PROBE_SEL) ? wall_clock64() : 0ull
#define PRB_END(id) do { if ((id) == PROBE_SEL) { __syncthreads(); if (threadIdx.x == 0) { volatile __attribute__((address_space(3))) unsigned long long* a_ = (volatile __attribute__((address_space(3))) unsigned long long*)(size_t)(75776 + 8); *a_ = *a_ + (wall_clock64() - prb_t0_##id); } } } while (0)
#else
#define PRB_BEGIN(id) do { } while (0)
#define PRB_END(id) do { } while (0)
#endif
#define RAW_BARRIER() do { asm volatile("s_waitcnt lgkmcnt(0)" ::: "memory"); __builtin_amdgcn_s_barrier(); } while (0)
struct P {
    const float *x, *c, *ctx, *c_ctx, *w_mod, *b_mod, *norm_mix, *norm_ffn, *w_in, *gla_a2, *gla_ab, *mlstm_gate_b,
        *gdn_conv, *gdn_a_log, *gdn_dt_bias, *diff_lambda, *head_norm, *w_branch, *w_out, *router_w, *router_b,
        *w_gate, *w_up, *w_down, *norm_final;
    float* out;
    unsigned* bar;
    int* cnt;
    float* modp;
    float* mod;
    float* xctx;
    float* rope;
    u16* hbuf;
    u16* ybuf;
    u16* Wt;
    u16* dq;
    u16* dk;
    u16* dvT;
    float* glaDec;
    float* mlN;
    float* mlFE;
    float* mlAE;
    float* mlM;
    u16* glaS;
    u16* mlS;
    u16* gdM;
    u16* gdN;
    u16* gdQ;
    u16* gdO;
    u16* cols;
    u16* Wd;
};
#define MOE_WGU_OFF 0
#define MOE_WD_OFF (16u * 1024u * 1024u)
#define MOE_ACT_OFF (MOE_WD_OFF + 16u * 1024u * 512u)
#define MOE_LIST_OFF (MOE_ACT_OFF + 2u * RTOT * 512u)

DEV const float* xrow_in(const P& p, int l, int r) {
    if (l == 0) return r < RLAT ? p.x + (size_t)r * DM : p.ctx + (size_t)(r - RLAT) * DM;
    return r < RLAT ? p.out + (size_t)r * DM : p.xctx + (size_t)(r - RLAT) * DM;
}
DEV float* xrow_out(const P& p, int r) { return r < RLAT ? p.out + (size_t)r * DM : p.xctx + (size_t)(r - RLAT) * DM; }
DEV int modidx(int r) { return r < RLAT ? (r >> 13) : 2; }
DEV int chunk_row0(int b, int dir, int st) {
    if (st < 4) { int c = dir ? 3 - st : st; return RLAT + b * CTXL + c * 64; }
    int c = dir ? 131 - st : st - 4; return b * SEQ + c * 64;
}
DEV size_t state_idx(int dir, int b, int st, int h) { return ((size_t)((dir * 2 + b) * NSTEP + st) * 4 + h); }
#define XB_TMO      128
#define XB_XCNT(j)  (256  + 64 * (j))
#define XB_XSUB(j)  (1280 + 64 * (j))
#define XB_XGEN(j)  (2304 + 64 * (j))
#define XB_TOP      3328
#define XB_TOPGEN   3392
#define XCD_BAR_WORDS 3456
#define XB_SPIN_CAP (1u << 18)
#define LAS __attribute__((address_space(3)))

__device__ __forceinline__ unsigned xb_ld(unsigned* p)              { return __hip_atomic_load(p, __ATOMIC_RELAXED, __HIP_MEMORY_SCOPE_AGENT); }
__device__ __forceinline__ unsigned xb_add(unsigned* p, unsigned v) { return __hip_atomic_fetch_add(p, v, __ATOMIC_RELAXED, __HIP_MEMORY_SCOPE_AGENT); }
__device__ __forceinline__ unsigned xb_xcc_id() { return (unsigned)__builtin_amdgcn_s_getreg((3 << 11) | 20) & 0xFu; }
#define XB_SPIN(cond, bar) do { unsigned _sp = 0; while (cond) { __builtin_amdgcn_s_sleep(1); \
    if ((++_sp & 255u) == 0u) { if (xb_ld(&(bar)[XB_TMO])) break; if (_sp > XB_SPIN_CAP) { atomicAdd(&(bar)[XB_TMO], 1u); break; } } } } while (0)

struct XcdBarrier {
    unsigned* bar; unsigned x;
    volatile LAS unsigned* st;
};

__device__ __forceinline__ XcdBarrier xcd_barrier_post(unsigned* bar, volatile LAS unsigned* st) {
    XcdBarrier b; b.bar = bar; b.x = xb_xcc_id(); b.st = st;
    if (tidx() == 0) (void)xb_add(&bar[XB_XCNT(b.x)], 1u);
    return b;
}
__device__ __forceinline__ void xcd_barrier_complete(unsigned* bar, unsigned x, unsigned& nloc, unsigned& nx) {
    const unsigned G = gridDim.x * gridDim.y * gridDim.z;
    unsigned sum, cnt, mine, sp = 0u;
    for (;;) {
        sum = 0u; cnt = 0u; mine = 0u;
#pragma unroll
        for (unsigned j = 0; j < 16; ++j) { const unsigned c = xb_ld(&bar[XB_XCNT(j)]); sum += c; cnt += (c > 0u) ? 1u : 0u; mine = (j == x) ? c : mine; }
        if (sum == G) break;
        __builtin_amdgcn_s_sleep(1);
        if ((++sp & 255u) == 0u) { if (xb_ld(&bar[XB_TMO])) break; if (sp > XB_SPIN_CAP) { atomicAdd(&bar[XB_TMO], 1u); break; } }
    }
    nloc = mine > 0u ? mine : 1u; nx = cnt > 0u ? cnt : 1u;
}

__device__ __forceinline__ void xcd_barrier(const XcdBarrier& b) {
    asm volatile("s_waitcnt vmcnt(0)" ::: "memory");
    __syncthreads();
    if (tidx() == 0) {
        unsigned* bar = b.bar;
        __builtin_amdgcn_s_waitcnt(0);
        unsigned nloc = b.st[0], nx = b.st[1];
        if (nloc == 0u) { xcd_barrier_complete(bar, b.x, nloc, nx); b.st[0] = nloc; b.st[1] = nx; }
        const unsigned old = xb_add(&bar[XB_XSUB(b.x)], 1u);
        const unsigned gen = old / nloc;
        if (old + 1u == (gen + 1u) * nloc) {
            __builtin_amdgcn_fence(__ATOMIC_RELEASE, "agent");
            asm volatile("s_waitcnt vmcnt(0)" ::: "memory");
            const unsigned og = xb_add(&bar[XB_TOP], 1u);
            const unsigned tg = og / nx;
            if (og + 1u == (tg + 1u) * nx) xb_add(&bar[XB_TOPGEN], 1u);
            else XB_SPIN(xb_ld(&bar[XB_TOPGEN]) == tg, bar);
            __builtin_amdgcn_fence(__ATOMIC_ACQUIRE, "agent");
            xb_add(&bar[XB_XGEN(b.x)], 1u);
            asm volatile("s_waitcnt vmcnt(0)" ::: "memory");
        } else {
            XB_SPIN(xb_ld(&bar[XB_XGEN(b.x)]) == gen, bar);
            __builtin_amdgcn_fence(__ATOMIC_ACQUIRE, "agent");
            asm volatile("s_waitcnt vmcnt(0)" ::: "memory");
        }
    }
    __syncthreads();
}
struct TrJob { const float* src; u16* dst; int lds_, ldd, map; };
DEV int tr_rowmap(int map, int n) {
    if (map == 1) return n < 3904 ? n : n + 64;
    if (map == 2) return (n >> 5) * 64 + (n & 31);
    if (map == 3) return (n >> 5) * 64 + 32 + (n & 31);
    return n;
}
struct TrRegs { f32x4 r0, r1, r2, r3; };
DEV void tr_load(const TrJob& j, TrRegs& q) {
    const int t = tidx(), n4 = (t & 15) * 4, kp = t >> 4;
    const float* s0 = j.src + (size_t)(2 * kp) * j.lds_ + n4;
    const float* s1 = j.src + (size_t)(2 * (kp + 16)) * j.lds_ + n4;
    q.r0 = *(const f32x4*)s0; q.r1 = *(const f32x4*)(s0 + j.lds_);
    q.r2 = *(const f32x4*)s1; q.r3 = *(const f32x4*)(s1 + j.lds_);
}
DEV void tr_finish(const TrJob& j, int n0, const TrRegs& q, float* smf) {
    unsigned* sm = (unsigned*)smf;
    const int t = tidx();
    {
        const int n4 = (t & 15) * 4, kp = t >> 4;
        sm[(n4 + 0) * 33 + kp] = pack2(q.r0[0], q.r1[0]); sm[(n4 + 1) * 33 + kp] = pack2(q.r0[1], q.r1[1]);
        sm[(n4 + 2) * 33 + kp] = pack2(q.r0[2], q.r1[2]); sm[(n4 + 3) * 33 + kp] = pack2(q.r0[3], q.r1[3]);
        sm[(n4 + 0) * 33 + kp + 16] = pack2(q.r2[0], q.r3[0]); sm[(n4 + 1) * 33 + kp + 16] = pack2(q.r2[1], q.r3[1]);
        sm[(n4 + 2) * 33 + kp + 16] = pack2(q.r2[2], q.r3[2]); sm[(n4 + 3) * 33 + kp + 16] = pack2(q.r2[3], q.r3[3]);
    }
    __syncthreads();
    {
        const int n = t >> 2, kq = (t & 3) * 8;
        u32x4 o0, o1;
        o0.x = sm[n * 33 + kq + 0]; o0.y = sm[n * 33 + kq + 1]; o0.z = sm[n * 33 + kq + 2]; o0.w = sm[n * 33 + kq + 3];
        o1.x = sm[n * 33 + kq + 4]; o1.y = sm[n * 33 + kq + 5]; o1.z = sm[n * 33 + kq + 6]; o1.w = sm[n * 33 + kq + 7];
        u16* d = j.dst + (size_t)tr_rowmap(j.map, n0 + n) * j.ldd + kq * 2;
        *(u32x4*)d = o0; *(u32x4*)(d + 8) = o1;
    }
    __syncthreads();
}
#define WT_WB_OFF (8064u * 1024u)
#define WT_WO_OFF (WT_WB_OFF + 4u * 1024u * 256u)
#define WT_TOTAL (WT_WO_OFF + 1024u * 1024u)

DEV TrJob mixw_job(const P& p, u16* Wb, int l, int u, int& n0) {
    TrJob j;
    if (u < 2000) {
        const int kt = u / 125, nt = u % 125; n0 = nt * 64;
        j.src = p.w_in + (size_t)l * 1024 * 8000 + (size_t)kt * 64 * 8000 + n0; j.lds_ = 8000; j.dst = Wb + kt * 64; j.ldd = 1024; j.map = 1;
    } else if (u < 2256) {
        const int v = u - 2000, i = v >> 6, w = v & 63, kt = w >> 4, nt = w & 15; n0 = nt * 64;
        j.src = p.w_branch + (size_t)(l * 4 + i) * 256 * 1024 + (size_t)kt * 64 * 1024 + n0; j.lds_ = 1024;
        j.dst = Wb + WT_WB_OFF + (size_t)i * 1024 * 256 + kt * 64; j.ldd = 256; j.map = 0;
    } else {
        const int v = u - 2256, kt = v >> 4, nt = v & 15; n0 = nt * 64;
        j.src = p.w_out + (size_t)l * 1024 * 1024 + (size_t)kt * 64 * 1024 + n0; j.lds_ = 1024; j.dst = Wb + WT_WO_OFF + kt * 64; j.ldd = 1024; j.map = 0;
    }
    return j;
}
DEV void phase_conv_mixw(const P& p, u16* Wb, int l, int bid, int nb, int b0, float* sm) {
    if (bid < b0) return;
    const int step = nb - b0;
    if (bid == nb - 1) {
        unsigned* z = (unsigned*)(Wb + (size_t)3904 * 1024);
        for (int i = tidx(); i < 64 * 1024 / 2; i += NTHR) z[i] = 0u;
    }
    int u = bid - b0, n0 = 0, n1 = 0;
    if (u >= 2512) return;
    TrRegs r;
    TrJob j = mixw_job(p, Wb, l, u, n0);
    tr_load(j, r);
    for (;;) {
        const int un = u + step;
        TrRegs rn; TrJob jn = j;
        if (un < 2512) { jn = mixw_job(p, Wb, l, un, n1); tr_load(jn, rn); }
        tr_finish(j, n0, r, sm);
        if (un >= 2512) break;
        u = un; j = jn; n0 = n1; r = rn;
    }
}
DEV TrJob moew_job(const P& p, int l, int u, int& n0) {
    TrJob j;
    u16* wgu = p.cols + MOE_WGU_OFF;
    const int e = u >> 8, v = u & 255;
    const size_t le = (size_t)(l * 16 + e);
    const int w = v & 127, kt = w >> 3, nt = w & 7; n0 = nt * 64;
    j.src = (v < 128 ? p.w_gate : p.w_up) + le * 1024 * 512 + (size_t)kt * 64 * 512 + n0; j.lds_ = 512;
    j.dst = wgu + (size_t)e * 1024 * 1024 + kt * 64; j.ldd = 1024; j.map = v < 128 ? 2 : 3;
    return j;
}
DEV TrJob moed_job(const P& p, int l, int u, int& n0) {
    TrJob j;
    const int e = u >> 7, w = u & 127, kt = w >> 4, nt = w & 15; n0 = nt * 64;
    const size_t le = (size_t)(l * 16 + e);
    j.src = p.w_down + le * 512 * 1024 + (size_t)kt * 64 * 1024 + n0; j.lds_ = 1024; j.dst = p.Wd + (size_t)e * 1024 * 512 + kt * 64; j.ldd = 512; j.map = 0;
    return j;
}
DEV void phase_conv_moed(const P& p, int l, int bid, int nb, int b0, float* sm) {
    if (bid < b0) return;
    const int step = nb - b0;
    int u = bid - b0, n0 = 0, n1 = 0;
    if (u >= 16 * 128) return;
    TrRegs r;
    TrJob j = moed_job(p, l, u, n0);
    tr_load(j, r);
    for (;;) {
        const int un = u + step;
        TrRegs rn; TrJob jn = j;
        if (un < 16 * 128) { jn = moed_job(p, l, un, n1); tr_load(jn, rn); }
        tr_finish(j, n0, r, sm);
        if (un >= 16 * 128) break;
        u = un; j = jn; n0 = n1; r = rn;
    }
}
DEV void phase_conv_moew(const P& p, int l, int bid, int nb, float* sm) {
    int u = bid, n0 = 0, n1 = 0;
    if (u >= 16 * 256) return;
    TrRegs r;
    TrJob j = moew_job(p, l, u, n0);
    tr_load(j, r);
    for (;;) {
        const int un = u + nb;
        TrRegs rn; TrJob jn = j;
        if (un < 16 * 256) { jn = moew_job(p, l, un, n1); tr_load(jn, rn); }
        tr_finish(j, n0, r, sm);
        if (un >= 16 * 256) break;
        u = un; j = jn; n0 = n1; r = rn;
    }
}

DEV void phase_mod_partial(const P& p, int bid, int nb, float* sm) {
    for (int u = bid; u < 768; u += nb) {
        const int l = u / 384, v = u % 384, kc = v / 24, jb = v % 24;
        const int t = tidx();
        __syncthreads();
        if (t < 192) {
            const int m = t >> 6, k = kc * 64 + (t & 63);
            const float cv = m < 2 ? p.c[m * 1024 + k] : p.c_ctx[k];
            sm[t] = silu(cv);
        }
        __syncthreads();
        const int j = jb * 256 + t;
        const float* w = p.w_mod + ((size_t)l * 1024 + kc * 64) * 6144 + j;
        float a0 = 0.f, a1 = 0.f, a2 = 0.f;
#pragma unroll 8
        for (int k = 0; k < 64; ++k) {
            const float wv = w[(size_t)k * 6144];
            a0 += sm[k] * wv; a1 += sm[64 + k] * wv; a2 += sm[128 + k] * wv;
        }
        float* o = p.modp + ((size_t)(l * 16 + kc) * 3) * 6144 + j;
        o[0] = a0; o[6144] = a1; o[2 * 6144] = a2;
    }
}
DEV void phase_mod_reduce(const P& p, int bid, int nb) {
    for (int i = bid * NTHR + tidx(); i < 2 * 3 * 6144; i += nb * NTHR) {
        const int l = i / (3 * 6144), r = i % (3 * 6144), m = r / 6144, j = r % 6144;
        float a = p.b_mod[l * 6144 + j];
        for (int kc = 0; kc < 16; ++kc) a += p.modp[((size_t)(l * 16 + kc) * 3 + m) * 6144 + j];
        p.mod[i] = a;
    }
}

DEV void moe_combine_row(const P& p, int l, int r, int lane, float4 (&v)[4]);
DEV void phase_norm1(const P& p, int l, int bid, int nb) {
    const int lane = tidx() & 63, w = tidx() >> 6;
    for (int r0 = (bid * 4 + w) * 2; r0 < RTOT; r0 += nb * 8) {
        f32x4 v[2][4];
#pragma unroll
        for (int q = 0; q < 2; ++q) {
            const float* xr = xrow_in(p, l, r0 + q);
#pragma unroll
            for (int i = 0; i < 4; ++i) v[q][i] = *(const f32x4*)(xr + lane * 4 + i * 256);
        }
#pragma unroll
        for (int q = 0; q < 2; ++q) {
            const int r = r0 + q;
            const int m = modidx(r);
            const float* sh = p.mod + ((size_t)(l * 3 + m)) * 6144;
            const float* sc = sh + 1024;
            float4 t[4];
#pragma unroll
            for (int i = 0; i < 4; ++i) { t[i].x = v[q][i][0]; t[i].y = v[q][i][1]; t[i].z = v[q][i][2]; t[i].w = v[q][i][3]; }
            if (l == 1) {
                moe_combine_row(p, 0, r, lane, t);
                float* xw = xrow_out(p, r);
#pragma unroll
                for (int i = 0; i < 4; ++i) *(float4*)(xw + lane * 4 + i * 256) = t[i];
            }
            float ss = 0.f;
#pragma unroll
            for (int i = 0; i < 4; ++i) ss += t[i].x * t[i].x + t[i].y * t[i].y + t[i].z * t[i].z + t[i].w * t[i].w;
            ss = wsum(ss);
            const float rs = rsqrtf(ss * (1.f / 1024.f) + EPSF);
#pragma unroll
            for (int i = 0; i < 4; ++i) {
                const int c = lane * 4 + i * 256;
                const float4 g = *(const float4*)(p.norm_mix + l * 1024 + c);
                const float4 s1 = *(const float4*)(sc + c);
                const float4 h1 = *(const float4*)(sh + c);
                const float o0 = t[i].x * rs * g.x * (1.f + s1.x) + h1.x;
                const float o1 = t[i].y * rs * g.y * (1.f + s1.y) + h1.y;
                const float o2 = t[i].z * rs * g.z * (1.f + s1.z) + h1.z;
                const float o3 = t[i].w * rs * g.w * (1.f + s1.w) + h1.w;
                u32x2 pk; pk.x = pack2(o0, o1); pk.y = pack2(o2, o3);
                *(u32x2*)(p.hbuf + (size_t)r * 1024 + c) = pk;
            }
        }
    }
}

#define LDP 72
#define GEMM_STAGE (2 * 128 * 64)
DEV int g_row(int tid, int i) { return (tid >> 6) * 32 + i * 8 + ((tid >> 3) & 7); }
DEV int g_kc(int tid, int row) { return ((tid & 7) ^ ((row >> 1) & 7)) * 8; }
DEV void gemm_mainloop(f32x4 (&acc)[4][4], const u16* const (&xp)[4], const u16* const (&wp)[4], int KT, u16* sm, u16*  ) {
    const int tid = tidx(), lane = tid & 63, w = tid >> 6, wn = w & 1, wm = w >> 1;
    const int fr = lane & 15, fq = lane >> 4, sw = (fr >> 1) & 7;
    asm volatile("s_waitcnt vmcnt(0)" ::: "memory");
#pragma unroll
    for (int i = 0; i < 4; ++i) {
        __builtin_amdgcn_global_load_lds((const unsigned*)xp[i], (unsigned*)(sm + (w * 4 + i) * 512), 16, 0, 0);
        __builtin_amdgcn_global_load_lds((const unsigned*)wp[i], (unsigned*)(sm + 128 * 64 + (w * 4 + i) * 512), 16, 0, 0);
    }
    for (int kt = 0; kt < KT; ++kt) {
        asm volatile("s_waitcnt vmcnt(0)" ::: "memory");
        RAW_BARRIER();
        if (kt + 1 < KT) {
            u16* nx = sm + ((kt + 1) & 1) * GEMM_STAGE;
#pragma unroll
            for (int i = 0; i < 4; ++i) {
                __builtin_amdgcn_global_load_lds((const unsigned*)(xp[i] + (kt + 1) * 64), (unsigned*)(nx + (w * 4 + i) * 512), 16, 0, 0);
                __builtin_amdgcn_global_load_lds((const unsigned*)(wp[i] + (kt + 1) * 64), (unsigned*)(nx + 128 * 64 + (w * 4 + i) * 512), 16, 0, 0);
            }
        }
        const u16* sX = sm + (kt & 1) * GEMM_STAGE;
        const u16* sW = sX + 128 * 64;
#pragma unroll
        for (int ks = 0; ks < 2; ++ks) {
            bf16x8 a[4], b[4];
#pragma unroll
            for (int q = 0; q < 4; ++q) {
                a[q] = *(const bf16x8*)(sW + (wn * 64 + q * 16 + fr) * 64 + (((ks * 4 + fq) ^ sw) * 8));
                b[q] = *(const bf16x8*)(sX + (wm * 64 + q * 16 + fr) * 64 + (((ks * 4 + fq) ^ sw) * 8));
            }
#pragma unroll
            for (int nt = 0; nt < 4; ++nt)
#pragma unroll
                for (int mt = 0; mt < 4; ++mt) acc[nt][mt] = mfma16(a[nt], b[mt], acc[nt][mt]);
        }
    }
    RAW_BARRIER();
}
DEV void zero_acc(f32x4 (&acc)[4][4]) {
#pragma unroll
    for (int a = 0; a < 4; ++a)
#pragma unroll
        for (int b = 0; b < 4; ++b) acc[a][b] = f32x4{0.f, 0.f, 0.f, 0.f};
}

#define GB_STAGE (384 * 32)
DEV void gemmb_issue(const u16* const (&xp)[4], const u16* const (&wp)[2], int kt, u16* stg, int w) {
#pragma unroll
    for (int i = 0; i < 4; ++i) __builtin_amdgcn_global_load_lds((const unsigned*)(xp[i] + kt * 32), (unsigned*)(stg + (w * 4 + i) * 512), 16, 0, 0);
#pragma unroll
    for (int i = 0; i < 2; ++i) __builtin_amdgcn_global_load_lds((const unsigned*)(wp[i] + kt * 32), (unsigned*)(stg + 256 * 32 + (w * 2 + i) * 512), 16, 0, 0);
}
DEV void gemmB_lane(int i, int nrow_pieces_per_wave, int& row, int& chunk) {
    const int t = tidx(), l = t & 63, w = t >> 6;
    row = (w * nrow_pieces_per_wave + i) * 16 + (l >> 2);
    chunk = ((l & 3) ^ ((l >> 4) & 3)) * 8;
}
DEV void gemmB_mainloop(f32x4 (&acc)[4][8], const u16* xb, const unsigned (&xo)[4], const u16* wb, const unsigned (&wo)[2], int KT, u16* sm) {
    const int tid = tidx(), lane = tid & 63, w = tid >> 6, wn = w & 1, wm = w >> 1, fr = lane & 15, fq = lane >> 4;
    const int sw = (fr >> 2) & 3;
    const int aoff = (wn * 64 + fr) * 32 + ((fq ^ sw) * 8) + 256 * 32;
    const int boff = (wm * 128 + fr) * 32 + ((fq ^ sw) * 8);
#pragma unroll
    for (int a = 0; a < 4; ++a)
#pragma unroll
        for (int b = 0; b < 8; ++b) acc[a][b] = f32x4{0.f, 0.f, 0.f, 0.f};
    asm volatile("s_waitcnt vmcnt(0)" ::: "memory");
#pragma unroll
    for (int t0 = 0; t0 < 2; ++t0) {
#pragma unroll
        for (int i = 0; i < 4; ++i) __builtin_amdgcn_global_load_lds((const unsigned*)(xb + xo[i] + t0 * 32), (unsigned*)(sm + t0 * GB_STAGE + (w * 4 + i) * 512), 16, 0, 0);
#pragma unroll
        for (int i = 0; i < 2; ++i) __builtin_amdgcn_global_load_lds((const unsigned*)(wb + wo[i] + t0 * 32), (unsigned*)(sm + t0 * GB_STAGE + 256 * 32 + (w * 2 + i) * 512), 16, 0, 0);
    }
    asm volatile("s_waitcnt vmcnt(6)" ::: "memory");
    RAW_BARRIER();
    bf16x8 a[4], b[8];
#pragma unroll
    for (int q = 0; q < 4; ++q) a[q] = *(const bf16x8*)(sm + aoff + q * 512);
#pragma unroll
    for (int q = 0; q < 8; ++q) b[q] = *(const bf16x8*)(sm + boff + q * 512);
    for (int kt = 0; kt < KT; ++kt) {
        asm volatile("s_waitcnt vmcnt(0)" ::: "memory");
        RAW_BARRIER();
        const bool more = kt + 2 < KT, nxt = kt + 1 < KT;
        u16* nx = sm + ((kt + 2) % 3) * GB_STAGE;
        const u16* cur = sm + ((kt + 1) % 3) * GB_STAGE;
#pragma unroll
        for (int h = 0; h < 2; ++h) {
            if (more) {
                __builtin_amdgcn_global_load_lds((const unsigned*)(xb + (kt + 2) * 32 + xo[2 * h]), (unsigned*)(nx + (w * 4 + 2 * h) * 512), 16, 0, 0);
                __builtin_amdgcn_global_load_lds((const unsigned*)(xb + (kt + 2) * 32 + xo[2 * h + 1]), (unsigned*)(nx + (w * 4 + 2 * h + 1) * 512), 16, 0, 0);
                __builtin_amdgcn_global_load_lds((const unsigned*)(wb + (kt + 2) * 32 + wo[h]), (unsigned*)(nx + 256 * 32 + (w * 2 + h) * 512), 16, 0, 0);
            }
#pragma unroll
            for (int nt = 0; nt < 4; ++nt) {
#pragma unroll
                for (int mt = 0; mt < 4; ++mt) acc[nt][4 * h + mt] = mfma16(a[nt], b[4 * h + mt], acc[nt][4 * h + mt]);
                if (h == 1 && nxt) a[nt] = *(const bf16x8*)(cur + aoff + nt * 512);
            }
            __builtin_amdgcn_sched_barrier(0);
            if (nxt) {
#pragma unroll
                for (int mt = 0; mt < 4; ++mt) b[4 * h + mt] = *(const bf16x8*)(cur + boff + (4 * h + mt) * 512);
            }
        }
    }
    RAW_BARRIER();
}

template <bool SIG, int GMODE = 0>
DEV void phase_inproj(const P& p, int wrow0, int ntn, int ldc, int mtiles256, int bid, int nb, u16* sm) {
    for (int u = bid; u < mtiles256 * ntn; u += nb) {
        const int mt_ = u / ntn, nt_ = u % ntn;
        const int m0 = mt_ * 256, n0 = nt_ * 128;
        unsigned xo[4], wo[2];
#pragma unroll
        for (int i = 0; i < 4; ++i) { int row, ch; gemmB_lane(i, 4, row, ch); xo[i] = (unsigned)(row * 1024 + ch); }
#pragma unroll
        for (int i = 0; i < 2; ++i) { int row, ch; gemmB_lane(i, 2, row, ch); wo[i] = (unsigned)(row * 1024 + ch); }
        f32x4 acc[4][8];
        gemmB_mainloop(acc, p.hbuf + (size_t)m0 * 1024, xo, p.Wt + (size_t)(wrow0 + n0) * 1024, wo, 32, sm);
        const int t2 = tidx(), l2 = t2 & 63, w2 = t2 >> 6;
        const int en = n0 + (w2 & 1) * 64 + (l2 >> 4) * 4, em = m0 + (w2 >> 1) * 128 + (l2 & 15);
#pragma unroll
        for (int nt = 0; nt < 4; ++nt)
#pragma unroll
            for (int mt = 0; mt < 8; ++mt) {
                const int n = en + nt * 16, m = em + mt * 16;
                f32x4 v = acc[nt][mt];
                if (SIG) { v[0] = sigm(v[0]); v[1] = sigm(v[1]); v[2] = sigm(v[2]); v[3] = sigm(v[3]); }
                u32x2 pk; pk.x = pack2(v[0], v[1]); pk.y = pack2(v[2], v[3]);
                *(u32x2*)(p.cols + (size_t)m * ldc + n) = pk;
            }
    }
}

DEV void phase_merge1(const P& p, u16* ubuf, int mtiles, int bid, int nb, u16* sm) {
    for (int u = bid; u < mtiles * 8; u += nb) {
        const int tid = tidx(), lane = tid & 63, w = tid >> 6, wn = w & 1, wm = w >> 1, fr = lane & 15, fq = lane >> 4, sw = (fr >> 1) & 7;
        const int mt_ = u >> 3, nt_ = u & 7;
        const int m0 = mt_ * 128, n0 = nt_ * 128;
        const u16* xp[4]; const u16* wp[4];
#pragma unroll
        for (int i = 0; i < 4; ++i) {
            const int row = g_row(tid, i), kc = g_kc(tid, row);
            xp[i] = p.ybuf + (size_t)(m0 + row) * 1024 + kc;
            wp[i] = p.Wt + WT_WB_OFF + (size_t)(n0 + row) * 256 + kc;
        }
        const u16* gbase = p.cols + (size_t)(m0 + wm * 64 + fr) * NGATE + n0 + wn * 64 + fq * 4;
        f32x4 tot[4][4], acc[4][4]; zero_acc(tot); zero_acc(acc);
        u32x2 gt[4][4];
        asm volatile("s_waitcnt vmcnt(0)" ::: "memory");
#pragma unroll
        for (int i = 0; i < 4; ++i) {
            __builtin_amdgcn_global_load_lds((const unsigned*)xp[i], (unsigned*)(sm + (w * 4 + i) * 512), 16, 0, 0);
            __builtin_amdgcn_global_load_lds((const unsigned*)wp[i], (unsigned*)(sm + 128 * 64 + (w * 4 + i) * 512), 16, 0, 0);
        }
        for (int kt = 0; kt < 16; ++kt) {
            asm volatile("s_waitcnt vmcnt(0)" ::: "memory");
            RAW_BARRIER();
            if (kt + 1 < 16) {
                u16* nx = sm + ((kt + 1) & 1) * GEMM_STAGE;
                const int wof = ((kt + 1) >> 2) * 262144 + ((kt + 1) & 3) * 64;
#pragma unroll
                for (int i = 0; i < 4; ++i) {
                    __builtin_amdgcn_global_load_lds((const unsigned*)(xp[i] + (kt + 1) * 64), (unsigned*)(nx + (w * 4 + i) * 512), 16, 0, 0);
                    __builtin_amdgcn_global_load_lds((const unsigned*)(wp[i] + wof), (unsigned*)(nx + 128 * 64 + (w * 4 + i) * 512), 16, 0, 0);
                }
            }
            if ((kt & 3) == 0) {
                const int br = kt >> 2;
#pragma unroll
                for (int nt = 0; nt < 4; ++nt)
#pragma unroll
                    for (int mt = 0; mt < 4; ++mt) gt[nt][mt] = *(const u32x2*)(gbase + (size_t)mt * 16 * NGATE + nt * 16 + br * 1024);
            }
            const u16* sX = sm + (kt & 1) * GEMM_STAGE;
            const u16* sW = sX + 128 * 64;
#pragma unroll
            for (int ks = 0; ks < 2; ++ks) {
                bf16x8 a[4], b[4];
#pragma unroll
                for (int q = 0; q < 4; ++q) {
                    a[q] = *(const bf16x8*)(sW + (wn * 64 + q * 16 + fr) * 64 + (((ks * 4 + fq) ^ sw) * 8));
                    b[q] = *(const bf16x8*)(sX + (wm * 64 + q * 16 + fr) * 64 + (((ks * 4 + fq) ^ sw) * 8));
                }
#pragma unroll
                for (int nt = 0; nt < 4; ++nt)
#pragma unroll
                    for (int mt = 0; mt < 4; ++mt) acc[nt][mt] = mfma16(a[nt], b[mt], acc[nt][mt]);
            }
            if ((kt & 3) == 3) {
#pragma unroll
                for (int nt = 0; nt < 4; ++nt)
#pragma unroll
                    for (int mt = 0; mt < 4; ++mt) {
                        const u32x2 g = gt[nt][mt];
                        tot[nt][mt][0] += __uint_as_float(g.x << 16) * acc[nt][mt][0];
                        tot[nt][mt][1] += __uint_as_float(g.x & 0xffff0000u) * acc[nt][mt][1];
                        tot[nt][mt][2] += __uint_as_float(g.y << 16) * acc[nt][mt][2];
                        tot[nt][mt][3] += __uint_as_float(g.y & 0xffff0000u) * acc[nt][mt][3];
                        acc[nt][mt] = f32x4{0.f, 0.f, 0.f, 0.f};
                    }
            }
        }
        RAW_BARRIER();
#pragma unroll
        for (int nt = 0; nt < 4; ++nt)
#pragma unroll
            for (int mt = 0; mt < 4; ++mt) {
                const int n = n0 + wn * 64 + nt * 16 + fq * 4, m = m0 + wm * 64 + mt * 16 + fr;
                u32x2 pk; pk.x = pack2(tot[nt][mt][0], tot[nt][mt][1]); pk.y = pack2(tot[nt][mt][2], tot[nt][mt][3]);
                *(u32x2*)(ubuf + (size_t)m * 1024 + n) = pk;
            }
    }
}

DEV void phase_merge2(const P& p, int l, const u16* ubuf, int mtiles, int bid, int nb, u16* sm) {
    const int mt256 = mtiles / 2;
    for (int u = bid; u < mt256 * 8; u += nb) {
        const int mt_ = u >> 3, nt_ = u & 7;
        const int m0 = mt_ * 256, n0 = nt_ * 128;
        unsigned xo[4], wo[2];
#pragma unroll
        for (int i = 0; i < 4; ++i) { int row, ch; gemmB_lane(i, 4, row, ch); xo[i] = (unsigned)(row * 1024 + ch); }
#pragma unroll
        for (int i = 0; i < 2; ++i) { int row, ch; gemmB_lane(i, 2, row, ch); wo[i] = (unsigned)(row * 1024 + ch); }
        f32x4 acc[4][8];
        gemmB_mainloop(acc, ubuf + (size_t)m0 * 1024, xo, p.Wt + WT_WO_OFF + (size_t)n0 * 1024, wo, 32, sm);
        const int t2 = tidx(), l2 = t2 & 63, w2 = t2 >> 6;
        const int en = n0 + (w2 & 1) * 64 + (l2 >> 4) * 4, em = m0 + (w2 >> 1) * 128 + (l2 & 15);
#pragma unroll
        for (int mt = 0; mt < 8; ++mt) {
            const int m = em + mt * 16;
            const float* xi = xrow_in(p, l, m);
            float* xw = xrow_out(p, m);
            const float* g1 = p.mod + (size_t)(l * 3 + modidx(m)) * 6144 + 2048;
#pragma unroll
            for (int nt = 0; nt < 4; ++nt) {
                const int n = en + nt * 16;
                const float4 xo4 = *(const float4*)(xi + n);
                const float4 g = *(const float4*)(g1 + n);
                float4 o;
                o.x = xo4.x + g.x * acc[nt][mt][0]; o.y = xo4.y + g.y * acc[nt][mt][1];
                o.z = xo4.z + g.z * acc[nt][mt][2]; o.w = xo4.w + g.w * acc[nt][mt][3];
                *(float4*)(xw + n) = o;
            }
        }
    }
}

DEV void phase_merge2s(const P& p, int l, const u16* ubuf, int mtiles, int bid, int nb, u16* sm) {
    u16* sX = sm; u16* sW = sm + 128 * LDP;
    const int tid = tidx(), lane = tid & 63, w = tid >> 6, wn = w & 1, wm = w >> 1, fr = lane & 15, fq = lane >> 4;
    for (int u = bid; u < mtiles * 8; u += nb) {
        const int mt_ = u >> 3, nt_ = u & 7;
        const int m0 = mt_ * 128, n0 = nt_ * 128;
        const int tu = tidx();
        const u16* xp[4]; const u16* wp[4];
#pragma unroll
        for (int i = 0; i < 4; ++i) {
            const int row = g_row(tu, i), kc = g_kc(tu, row);
            xp[i] = ubuf + (size_t)(m0 + row) * 1024 + kc;
            wp[i] = p.Wt + WT_WO_OFF + (size_t)(n0 + row) * 1024 + kc;
        }
        f32x4 acc[4][4]; zero_acc(acc);
        gemm_mainloop(acc, xp, wp, 16, sX, sW);
#pragma unroll
        for (int nt = 0; nt < 4; ++nt)
#pragma unroll
            for (int mt = 0; mt < 4; ++mt) {
                const int n = n0 + wn * 64 + nt * 16 + fq * 4, m = m0 + wm * 64 + mt * 16 + fr;
                const float4 xo = *(const float4*)(xrow_in(p, l, m) + n);
                const float4 g = *(const float4*)(p.mod + (size_t)(l * 3 + modidx(m)) * 6144 + 2048 + n);
                float4 o;
                o.x = xo.x + g.x * acc[nt][mt][0]; o.y = xo.y + g.y * acc[nt][mt][1];
                o.z = xo.z + g.z * acc[nt][mt][2]; o.w = xo.w + g.w * acc[nt][mt][3];
                *(float4*)(xrow_out(p, m) + n) = o;
            }
    }
}
DEV void phase_norm2_router(const P& p, int l, int nrows, int bid, int nb, float* sm) {
    const int tid = tidx(), lane = tid & 63, w = tid >> 6;
    int* list = (int*)(p.cols + MOE_LIST_OFF);
    float* slotw = (float*)(list + 16 * RTOT);
    int* tokslot = (int*)(slotw + 16 * RTOT);
    float* tokw = (float*)(tokslot + 2 * RTOT);
    int* lcnt = (int*)(sm + 16 * 1024);
    int* rinfo = lcnt + 32;
    float* rwgt = (float*)(rinfo + 4 * 40 * 2);
#pragma unroll 16
    for (int i = tid; i < 16 * 1024; i += NTHR) { const int c = i >> 4, e = i & 15; sm[e * 1024 + c] = p.router_w[i]; }
    if (tid < 32) lcnt[tid] = 0;
    __syncthreads();
    int kk = 0;
    for (int r = bid * 4 + w; r < nrows; r += nb * 4, ++kk) {
        const float* xr = xrow_out(p, r);
        const int m = modidx(r);
        const float* sh = p.mod + ((size_t)(l * 3 + m)) * 6144 + 3072;
        const float* sc = sh + 1024;
        float4 v[4]; float ss = 0.f;
#pragma unroll
        for (int i = 0; i < 4; ++i) {
            v[i] = *(const float4*)(xr + lane * 4 + i * 256);
            ss += v[i].x * v[i].x + v[i].y * v[i].y + v[i].z * v[i].z + v[i].w * v[i].w;
        }
        ss = wsum(ss);
        const float rs = rsqrtf(ss * (1.f / 1024.f) + EPSF);
#pragma unroll
        for (int i = 0; i < 4; ++i) {
            const int c = lane * 4 + i * 256;
            const float4 g = *(const float4*)(p.norm_ffn + l * 1024 + c);
            const float4 s1 = *(const float4*)(sc + c);
            const float4 h1 = *(const float4*)(sh + c);
            v[i].x = v[i].x * rs * g.x * (1.f + s1.x) + h1.x;
            v[i].y = v[i].y * rs * g.y * (1.f + s1.y) + h1.y;
            v[i].z = v[i].z * rs * g.z * (1.f + s1.z) + h1.z;
            v[i].w = v[i].w * rs * g.w * (1.f + s1.w) + h1.w;
            u32x2 pk; pk.x = pack2(v[i].x, v[i].y); pk.y = pack2(v[i].z, v[i].w);
            *(u32x2*)(p.hbuf + (size_t)r * 1024 + c) = pk;
        }
        float sel[16], scr[16];
#pragma unroll
        for (int e = 0; e < 16; ++e) scr[e] = 0.f;
#pragma unroll
        for (int i = 0; i < 4; ++i) {
#pragma unroll
            for (int e = 0; e < 16; ++e) {
                const float4 rw = *(const float4*)(sm + e * 1024 + lane * 4 + i * 256);
                scr[e] += v[i].x * rw.x + v[i].y * rw.y + v[i].z * rw.z + v[i].w * rw.w;
            }
            __builtin_amdgcn_sched_barrier(0);
        }
#pragma unroll
        for (int e = 0; e < 16; ++e) {
            const float a = wsum(scr[e]);
            scr[e] = sigm(a);
            sel[e] = scr[e] + p.router_b[e];
        }
        int bg = 0; float bgs = -INFINITY;
#pragma unroll
        for (int g = 0; g < 4; ++g) {
            float m1 = -INFINITY, m2 = -INFINITY;
#pragma unroll
            for (int j = 0; j < 4; ++j) {
                const float s = sel[g * 4 + j];
                if (s > m1) { m2 = m1; m1 = s; } else if (s > m2) { m2 = s; }
            }
            const float gs = m1 + m2;
            if (gs > bgs) { bgs = gs; bg = g; }
        }
        float gsel[4], gscr[4];
#pragma unroll
        for (int j = 0; j < 4; ++j) { gsel[j] = -INFINITY; gscr[j] = 0.f; }
#pragma unroll
        for (int g = 0; g < 4; ++g)
#pragma unroll
            for (int j = 0; j < 4; ++j) if (bg == g) { gsel[j] = sel[g * 4 + j]; gscr[j] = scr[g * 4 + j]; }
        int j1 = 0; float v1 = gsel[0], w1 = gscr[0];
#pragma unroll
        for (int j = 1; j < 4; ++j) if (gsel[j] > v1) { v1 = gsel[j]; w1 = gscr[j]; j1 = j; }
        int j2 = -1; float v2 = -INFINITY, w2 = 0.f;
#pragma unroll
        for (int j = 0; j < 4; ++j) if (j != j1 && (j2 < 0 || gsel[j] > v2)) { v2 = gsel[j]; w2 = gscr[j]; j2 = j; }
        const float inv = 1.f / (w1 + w2);
        if (lane == 0) {
            const int e1 = bg * 4 + j1, e2 = bg * 4 + j2;
            const int p1 = atomicAdd(lcnt + e1, 1);
            const int p2 = atomicAdd(lcnt + e2, 1);
            rinfo[(w * 40 + kk) * 2 + 0] = e1 * 65536 + p1; rwgt[(w * 40 + kk) * 2 + 0] = w1 * inv;
            rinfo[(w * 40 + kk) * 2 + 1] = e2 * 65536 + p2; rwgt[(w * 40 + kk) * 2 + 1] = w2 * inv;
        }
    }
    __syncthreads();
    if (tid < 16) lcnt[16 + tid] = lcnt[tid] ? atomicAdd(p.cnt + l * 16 + tid, lcnt[tid]) : 0;
    __syncthreads();
    if (lane < 2) {
        int k2 = 0;
        for (int r = bid * 4 + w; r < nrows; r += nb * 4, ++k2) {
            const int inf = rinfo[(w * 40 + k2) * 2 + lane], e = inf >> 16, slot = lcnt[16 + e] + (inf & 65535);
            const float wg = rwgt[(w * 40 + k2) * 2 + lane];
            list[e * RTOT + slot] = r; slotw[e * RTOT + slot] = wg;
            tokslot[r * 2 + lane] = e * RTOT + slot; tokw[r * 2 + lane] = wg;
        }
    }
    __syncthreads();
}

DEV bool moe_find(const int* cnt, int ut, int& e, int& mt, int& off, int& ce) {
    int tb = 0, o = 0;
    for (int k = 0; k < 16; ++k) {
        const int c = cnt[k], nt = (c + 255) >> 8;
        if (ut < tb + nt) { e = k; mt = ut - tb; off = o; ce = c; return true; }
        tb += nt; o += c;
    }
    return false;
}

DEV bool moe_find128(const int* cnt, int ut, int& e, int& mt, int& off, int& ce) {
    int tb = 0, o = 0;
    for (int k = 0; k < 16; ++k) {
        const int c = cnt[k], nt = (c + 127) >> 7;
        if (ut < tb + nt) { e = k; mt = ut - tb; off = o; ce = c; return true; }
        tb += nt; o += c;
    }
    return false;
}

DEV void phase_moe_up_s(const P& p, int l, int bid, int nb, u16* sm) {
    u16* sX = sm; u16* sW = sm + 128 * LDP;
    const int tid = tidx(), lane = tid & 63, w = tid >> 6, wn = w & 1, wm = w >> 1, fr = lane & 15, fq = lane >> 4;
    const int* cnt = p.cnt + l * 16;
    const int* list = (const int*)(p.cols + MOE_LIST_OFF);
    const u16* wgu = p.cols + MOE_WGU_OFF;
    u16* act = p.cols + MOE_ACT_OFF;
    for (int u = bid;; u += nb) {
        int e, mtile, off, ce;
        if (!moe_find128(cnt, u >> 3, e, mtile, off, ce)) break;
        const int n0 = (u & 7) * 128;
        const int tu = tidx();
        const u16* xp[4]; const u16* wp[4];
#pragma unroll
        for (int i = 0; i < 4; ++i) {
            const int row = g_row(tu, i), kc = g_kc(tu, row);
            int s = mtile * 128 + row; s = s < ce ? s : ce - 1;
            const int tok = list[e * RTOT + s];
            xp[i] = p.hbuf + (size_t)tok * 1024 + kc;
            wp[i] = wgu + ((size_t)e * 1024 + n0 + row) * 1024 + kc;
        }
        f32x4 acc[4][4]; zero_acc(acc);
        gemm_mainloop(acc, xp, wp, 16, sX, sW);
#pragma unroll
        for (int nt = 0; nt < 2; ++nt)
#pragma unroll
            for (int mt = 0; mt < 4; ++mt) {
                const int col = ((n0 >> 6) + wn) * 32 + nt * 16 + fq * 4;
                const int s = mtile * 128 + wm * 64 + mt * 16 + fr;
                if (s < ce) {
                    const f32x4 g = acc[nt][mt], uu = acc[nt + 2][mt];
                    u32x2 pk; pk.x = pack2(silu(g[0]) * uu[0], silu(g[1]) * uu[1]); pk.y = pack2(silu(g[2]) * uu[2], silu(g[3]) * uu[3]);
                    *(u32x2*)(act + (size_t)(off + s) * 512 + col) = pk;
                }
            }
    }
}

DEV void phase_moe_down_s(const P& p, int l, int bid, int nb, u16* sm) {
    u16* sX = sm; u16* sW = sm + 128 * LDP;
    const int tid = tidx(), lane = tid & 63, w = tid >> 6, wn = w & 1, wm = w >> 1, fr = lane & 15, fq = lane >> 4;
    const int* cnt = p.cnt + l * 16;
    const int* list = (const int*)(p.cols + MOE_LIST_OFF);
    u16* yslot = p.glaS;
    const u16* wd = p.Wd;
    const u16* act = p.cols + MOE_ACT_OFF;
    for (int u = bid;; u += nb) {
        int e, mtile, off, ce;
        if (!moe_find128(cnt, u >> 3, e, mtile, off, ce)) break;
        const int n0 = (u & 7) * 128;
        const int tu = tidx();
        const u16* xp[4]; const u16* wp[4];
#pragma unroll
        for (int i = 0; i < 4; ++i) {
            const int row = g_row(tu, i), kc = g_kc(tu, row);
            int s = mtile * 128 + row; s = s < ce ? s : ce - 1;
            xp[i] = act + (size_t)(off + s) * 512 + kc;
            wp[i] = wd + ((size_t)e * 1024 + n0 + row) * 512 + kc;
        }
        f32x4 acc[4][4]; zero_acc(acc);
        gemm_mainloop(acc, xp, wp, 8, sX, sW);
#pragma unroll
        for (int mt = 0; mt < 4; ++mt) {
            const int s = mtile * 128 + wm * 64 + mt * 16 + fr;
            if (s < ce) {
#pragma unroll
                for (int nt = 0; nt < 4; ++nt) {
                    const int n = n0 + wn * 64 + nt * 16 + fq * 4;
                    u32x2 pk; pk.x = pack2(acc[nt][mt][0], acc[nt][mt][1]); pk.y = pack2(acc[nt][mt][2], acc[nt][mt][3]);
                    *(u32x2*)(yslot + (size_t)(off + s) * 1024 + n) = pk;
                }
            }
        }
    }
}

DEV void phase_moe_up(const P& p, int l, int bid, int nb, u16* sm) {
    const int* cnt = p.cnt + l * 16;
    const int* list = (const int*)(p.cols + MOE_LIST_OFF);
    const u16* wgu = p.cols + MOE_WGU_OFF;
    u16* act = p.cols + MOE_ACT_OFF;
    for (int u = bid;; u += nb) {
        int e, mtile, off, ce;
        if (!moe_find(cnt, u >> 3, e, mtile, off, ce)) break;
        const int n0 = (u & 7) * 128;
        unsigned xo[4], wo[2];
#pragma unroll
        for (int i = 0; i < 4; ++i) {
            int row, ch; gemmB_lane(i, 4, row, ch);
            int s = mtile * 256 + row; s = s < ce ? s : ce - 1;
            xo[i] = (unsigned)(list[e * RTOT + s] * 1024 + ch);
        }
#pragma unroll
        for (int i = 0; i < 2; ++i) { int row, ch; gemmB_lane(i, 2, row, ch); wo[i] = (unsigned)(row * 1024 + ch); }
        f32x4 acc[4][8];
        gemmB_mainloop(acc, p.hbuf, xo, wgu + ((size_t)e * 1024 + n0) * 1024, wo, 32, sm);
        const int t2 = tidx(), l2 = t2 & 63, w2 = t2 >> 6;
        const int col0 = ((n0 >> 6) + (w2 & 1)) * 32 + (l2 >> 4) * 4, sb = mtile * 256 + (w2 >> 1) * 128 + (l2 & 15);
#pragma unroll
        for (int nt = 0; nt < 2; ++nt)
#pragma unroll
            for (int mt = 0; mt < 8; ++mt) {
                const int s = sb + mt * 16;
                if (s < ce) {
                    const f32x4 g = acc[nt][mt], uu = acc[nt + 2][mt];
                    u32x2 pk; pk.x = pack2(silu(g[0]) * uu[0], silu(g[1]) * uu[1]); pk.y = pack2(silu(g[2]) * uu[2], silu(g[3]) * uu[3]);
                    *(u32x2*)(act + (size_t)(off + s) * 512 + col0 + nt * 16) = pk;
                }
            }
    }
}

DEV void phase_moe_down(const P& p, int l, int bid, int nb, u16* sm) {
    const int* cnt = p.cnt + l * 16;
    u16* yslot = p.glaS;
    const u16* wd = p.Wd;
    const u16* act = p.cols + MOE_ACT_OFF;
    for (int u = bid;; u += nb) {
        int e, mtile, off, ce;
        if (!moe_find(cnt, u >> 3, e, mtile, off, ce)) break;
        const int n0 = (u & 7) * 128;
        unsigned xo[4], wo[2];
#pragma unroll
        for (int i = 0; i < 4; ++i) {
            int row, ch; gemmB_lane(i, 4, row, ch);
            int s = mtile * 256 + row; s = s < ce ? s : ce - 1;
            xo[i] = (unsigned)((off + s) * 512 + ch);
        }
#pragma unroll
        for (int i = 0; i < 2; ++i) { int row, ch; gemmB_lane(i, 2, row, ch); wo[i] = (unsigned)(row * 512 + ch); }
        f32x4 acc[4][8];
        gemmB_mainloop(acc, act, xo, wd + ((size_t)e * 1024 + n0) * 512, wo, 16, sm);
        const int t2 = tidx(), l2 = t2 & 63, w2 = t2 >> 6;
        const int en = n0 + (w2 & 1) * 64 + (l2 >> 4) * 4, sb = mtile * 256 + (w2 >> 1) * 128 + (l2 & 15);
#pragma unroll
        for (int mt = 0; mt < 8; ++mt) {
            const int s = sb + mt * 16;
            if (s < ce) {
#pragma unroll
                for (int nt = 0; nt < 4; ++nt) {
                    u32x2 pk; pk.x = pack2(acc[nt][mt][0], acc[nt][mt][1]); pk.y = pack2(acc[nt][mt][2], acc[nt][mt][3]);
                    *(u32x2*)(yslot + (size_t)(off + s) * 1024 + en + nt * 16) = pk;
                }
            }
        }
    }
}

DEV void moe_combine_row(const P& p, int l, int r, int lane, float4 (&v)[4]) {
    const int* cnt = p.cnt + l * 16;
    const int* list = (const int*)(p.cols + MOE_LIST_OFF);
    const int* tokslot = (const int*)((const float*)(list + 16 * RTOT) + 16 * RTOT);
    const float* tokw = (const float*)(tokslot + 2 * RTOT);
    const u16* yslot = p.glaS;
    const float* g2 = p.mod + (size_t)(l * 3 + modidx(r)) * 6144 + 5120;
#pragma unroll
    for (int j = 0; j < 2; ++j) {
        const int ts = tokslot[r * 2 + j], e = ts / RTOT, slot = ts % RTOT;
        const float wg = tokw[r * 2 + j];
        int off = 0;
        for (int k = 0; k < e; ++k) off += cnt[k];
        const u16* yr = yslot + (size_t)(off + slot) * 1024;
#pragma unroll
        for (int i = 0; i < 4; ++i) {
            const int c = lane * 4 + i * 256;
            const u32x2 yv = *(const u32x2*)(yr + c);
            const float4 g = *(const float4*)(g2 + c);
            v[i].x += g.x * wg * __uint_as_float(yv.x << 16); v[i].y += g.y * wg * __uint_as_float(yv.x & 0xffff0000u);
            v[i].z += g.z * wg * __uint_as_float(yv.y << 16); v[i].w += g.w * wg * __uint_as_float(yv.y & 0xffff0000u);
        }
    }
}

DEV void phase_final_norm(const P& p, int bid, int nb) {
    const int lane = tidx() & 63, w = tidx() >> 6;
    for (int r = bid * 4 + w; r < RLAT; r += nb * 4) {
        float* xr = p.out + (size_t)r * DM;
        float4 v[4]; float ss = 0.f;
#pragma unroll
        for (int i = 0; i < 4; ++i) v[i] = *(const float4*)(xr + lane * 4 + i * 256);
        moe_combine_row(p, 1, r, lane, v);
#pragma unroll
        for (int i = 0; i < 4; ++i) ss += v[i].x * v[i].x + v[i].y * v[i].y + v[i].z * v[i].z + v[i].w * v[i].w;
        ss = wsum(ss);
        const float rs = rsqrtf(ss * (1.f / 1024.f) + EPSF);
#pragma unroll
        for (int i = 0; i < 4; ++i) {
            const int c = lane * 4 + i * 256;
            const float4 g = *(const float4*)(p.norm_final + c);
            float4 o; o.x = v[i].x * rs * g.x; o.y = v[i].y * rs * g.y; o.z = v[i].z * rs * g.z; o.w = v[i].w * rs * g.w;
            *(float4*)(xr + c) = o;
        }
    }
}
DEV float wscan_add(float v, int lane) {
#pragma unroll
    for (int o = 1; o < 64; o <<= 1) { const float t = shup(v, o); if (lane >= o) v += t; }
    return v;
}
DEV float wscan_max(float v, int lane) {
#pragma unroll
    for (int o = 1; o < 64; o <<= 1) { const float t = shup(v, o); if (lane >= o) v = fmaxf(v, t); }
    return v;
}
DEV void mm64(f32x4 (&acc)[4], const u16* A, int lda, const u16* Bt, int ldb) {
    const int lane = tidx() & 63, w = tidx() >> 6, fr = lane & 15, fq = lane >> 4;
#pragma unroll
    for (int ks = 0; ks < 2; ++ks) {
        const bf16x8 a = *(const bf16x8*)(A + (16 * w + fr) * lda + ks * 32 + fq * 8);
#pragma unroll
        for (int nt = 0; nt < 4; ++nt) {
            const bf16x8 b = *(const bf16x8*)(Bt + (nt * 16 + fr) * ldb + ks * 32 + fq * 8);
            acc[nt] = mfma16(a, b, acc[nt]);
        }
    }
}
DEV void mm64_pre(f32x4 (&acc)[4], const u16* A, int lda, const bf16x8 (&bf)[2][4]) {
    const int lane = tidx() & 63, w = tidx() >> 6, fr = lane & 15, fq = lane >> 4;
#pragma unroll
    for (int ks = 0; ks < 2; ++ks) {
        const bf16x8 a = *(const bf16x8*)(A + (16 * w + fr) * lda + ks * 32 + fq * 8);
#pragma unroll
        for (int nt = 0; nt < 4; ++nt) acc[nt] = mfma16(a, bf[ks][nt], acc[nt]);
    }
}
DEV void ldB64(bf16x8 (&bf)[2][4], const u16* Bt) {
    const int lane = tidx() & 63, fr = lane & 15, fq = lane >> 4;
#pragma unroll
    for (int ks = 0; ks < 2; ++ks)
#pragma unroll
        for (int nt = 0; nt < 4; ++nt) bf[ks][nt] = *(const bf16x8*)(Bt + (nt * 16 + fr) * 64 + ks * 32 + fq * 8);
}
struct Raw16 { u32x4 a, b; };
DEV Raw16 ldraw16(const u16* p) { Raw16 r; r.a = *(const u32x4*)p; r.b = *(const u32x4*)(p + 8); return r; }
DEV void unraw16(const Raw16& r, float (&o)[16]) {
    const unsigned w[8] = {r.a.x, r.a.y, r.a.z, r.a.w, r.b.x, r.b.y, r.b.z, r.b.w};
#pragma unroll
    for (int i = 0; i < 8; ++i) { o[2 * i] = __uint_as_float(w[i] << 16); o[2 * i + 1] = __uint_as_float(w[i] & 0xffff0000u); }
}
DEV void zero4(f32x4 (&acc)[4]) {
#pragma unroll
    for (int i = 0; i < 4; ++i) acc[i] = f32x4{0.f, 0.f, 0.f, 0.f};
}
DEV void ld16bf(const u16* p, float (&o)[16]) {
    const u32x4 a = *(const u32x4*)p, b = *(const u32x4*)(p + 8);
    const unsigned w[8] = {a.x, a.y, a.z, a.w, b.x, b.y, b.z, b.w};
#pragma unroll
    for (int i = 0; i < 8; ++i) { o[2 * i] = __uint_as_float(w[i] << 16); o[2 * i + 1] = __uint_as_float(w[i] & 0xffff0000u); }
}
DEV void st16bf(u16* p, const float (&v)[16]) {
    u32x4 a, b;
    a.x = pack2(v[0], v[1]); a.y = pack2(v[2], v[3]); a.z = pack2(v[4], v[5]); a.w = pack2(v[6], v[7]);
    b.x = pack2(v[8], v[9]); b.y = pack2(v[10], v[11]); b.z = pack2(v[12], v[13]); b.w = pack2(v[14], v[15]);
    *(u32x4*)p = a; *(u32x4*)(p + 8) = b;
}

DEV void phase_rope_table(const P& p, int bid, int nb) {
    for (int i = bid * NTHR + tidx(); i < 192 * 8; i += nb * NTHR) {
        const int e = i >> 3, f = i & 7;
        const float inv = expf(-(float)(2 * f) * (1.f / 16.f) * 9.210340371976184f);
        const float pos = (float)(e < 128 ? e : e - 128);
        const float ang = pos * inv;
        p.rope[2 * i] = cosf(ang); p.rope[2 * i + 1] = sinf(ang);
    }
}
DEV void phase_prep(const P& p, int l, u16* gqkv, int bid, int nb, u16* sm) {
    const int tid = tidx();
    for (int g = bid; g < 264; g += nb) {
        int b, t0, r0, T, pos0;
        if (g < 256) { b = g >> 7; t0 = (g & 127) * 64; r0 = b * SEQ + t0; T = SEQ; pos0 = CTXL + t0; }
        else { const int q = g - 256; b = q >> 2; t0 = (q & 3) * 64; r0 = RLAT + b * CTXL + t0; T = CTXL; pos0 = t0; }
        for (int k = 0; k < 24; ++k) {
            const int id = tid + 256 * k, cg = id % 96, s = id / 96, r = r0 + s, t = t0 + s;
            float a[8];
#pragma unroll
            for (int i = 0; i < 8; ++i) a[i] = 0.f;
#pragma unroll
            for (int j = 0; j < 5; ++j) {
                const int tt = t + j - 2;
                if (tt >= 0 && tt < T) {
                    const u32x4 xv = *(const u32x4*)(p.cols + (size_t)(r + j - 2) * NCM + GD_Q + cg * 8);
                    const float4 w0 = *(const float4*)(p.gdn_conv + (l * 5 + j) * 768 + cg * 8);
                    const float4 w1 = *(const float4*)(p.gdn_conv + (l * 5 + j) * 768 + cg * 8 + 4);
                    a[0] += __uint_as_float(xv.x << 16) * w0.x; a[1] += __uint_as_float(xv.x & 0xffff0000u) * w0.y;
                    a[2] += __uint_as_float(xv.y << 16) * w0.z; a[3] += __uint_as_float(xv.y & 0xffff0000u) * w0.w;
                    a[4] += __uint_as_float(xv.z << 16) * w1.x; a[5] += __uint_as_float(xv.z & 0xffff0000u) * w1.y;
                    a[6] += __uint_as_float(xv.w << 16) * w1.z; a[7] += __uint_as_float(xv.w & 0xffff0000u) * w1.w;
                }
            }
            float ss = 0.f;
#pragma unroll
            for (int i = 0; i < 8; ++i) { a[i] = silu(a[i]); ss += a[i] * a[i]; }
            ss += shx(ss, 1); ss += shx(ss, 2); ss += shx(ss, 4);
            float sc = 1.f;
            if (cg < 64) sc = rsqrtf(ss + EPSF) * (cg < 32 ? 0.125f : 1.f);
            u32x4 o;
            o.x = pack2(a[0] * sc, a[1] * sc); o.y = pack2(a[2] * sc, a[3] * sc); o.z = pack2(a[4] * sc, a[5] * sc); o.w = pack2(a[6] * sc, a[7] * sc);
            *(u32x4*)(gqkv + (size_t)r * 768 + cg * 8) = o;
        }
        for (int k = 0; k < 8; ++k) {
            const int id = tid + 256 * k, c = id & 1, half = (id >> 1) & 1, h = (id >> 2) & 3, qk = (id >> 4) & 1, s = id >> 5;
            const int r = r0 + s, t = t0 + s;
            const u16* src = p.cols + (size_t)r * NCM + (qk ? DF_K : DF_Q) + h * 64 + half * 32 + c * 8;
            const u32x4 v1 = *(const u32x4*)src, v2 = *(const u32x4*)(src + 16);
            const unsigned w1[4] = {v1.x, v1.y, v1.z, v1.w}, w2[4] = {v2.x, v2.y, v2.z, v2.w};
            float x1[8], x2[8], o1[8], o2[8];
#pragma unroll
            for (int i = 0; i < 4; ++i) {
                x1[2 * i] = __uint_as_float(w1[i] << 16); x1[2 * i + 1] = __uint_as_float(w1[i] & 0xffff0000u);
                x2[2 * i] = __uint_as_float(w2[i] << 16); x2[2 * i + 1] = __uint_as_float(w2[i] & 0xffff0000u);
            }
            const float qs = qk ? 1.f : (0.17677669529663687f * 1.4426950408889634f);
            if (g < 256) {
                const float* tb = p.rope + (size_t)(c == 0 ? (t >> 6) : 128 + (t & 63)) * 16;
#pragma unroll
                for (int i = 0; i < 8; ++i) {
                    const float cs = tb[2 * i], sn = tb[2 * i + 1];
                    o1[i] = (x1[i] * cs - x2[i] * sn) * qs; o2[i] = (x1[i] * sn + x2[i] * cs) * qs;
                }
            } else {
#pragma unroll
                for (int i = 0; i < 8; ++i) { o1[i] = x1[i] * qs; o2[i] = x2[i] * qs; }
            }
            u16* dst = (qk ? p.dk : p.dq) + ((size_t)(b * 4 + h) * KPOS + pos0 + s) * 64 + half * 32 + c * 8;
            u32x4 a1, a2;
            a1.x = pack2(o1[0], o1[1]); a1.y = pack2(o1[2], o1[3]); a1.z = pack2(o1[4], o1[5]); a1.w = pack2(o1[6], o1[7]);
            a2.x = pack2(o2[0], o2[1]); a2.y = pack2(o2[2], o2[3]); a2.z = pack2(o2[4], o2[5]); a2.w = pack2(o2[6], o2[7]);
            *(u32x4*)dst = a1; *(u32x4*)(dst + 16) = a2;
        }
        for (int h = 0; h < 4; ++h) {
            __syncthreads();
            {
                const int s = tid >> 2, dg = tid & 3;
                const u32x4 a = *(const u32x4*)(p.cols + (size_t)(r0 + s) * NCM + DF_V + h * 64 + dg * 16);
                const u32x4 c = *(const u32x4*)(p.cols + (size_t)(r0 + s) * NCM + DF_V + h * 64 + dg * 16 + 8);
                const unsigned wv[8] = {a.x, a.y, a.z, a.w, c.x, c.y, c.z, c.w};
#pragma unroll
                for (int k = 0; k < 8; ++k) {
                    sm[(dg * 16 + 2 * k) * 72 + s] = (u16)(wv[k] & 0xffff);
                    sm[(dg * 16 + 2 * k + 1) * 72 + s] = (u16)(wv[k] >> 16);
                }
            }
            __syncthreads();
            {
                const int dv = tid >> 2, sg = tid & 3;
                const u32x4 a = *(const u32x4*)(sm + dv * 72 + sg * 16);
                const u32x4 c = *(const u32x4*)(sm + dv * 72 + sg * 16 + 8);
                u16* o = p.dvT + ((size_t)(b * 4 + h) * 64 + dv) * KPOS + pos0 + sg * 16;
                *(u32x4*)o = a; *(u32x4*)(o + 8) = c;
            }
        }
        __syncthreads();
    }
}
#define TILE_B (64 * LDP * 2)

DEV void gla_cum(const P& p, int l, int dir, int h, int row0, float* cum, float* rt, float* sg) {
    const int tid = tidx();
    const int d = tid & 63, sq = tid >> 6;
    float a2r[16];
#pragma unroll
    for (int j = 0; j < 16; ++j) a2r[j] = p.gla_a2[((size_t)(l * 2 + dir) * 16 + j) * 256 + h * 64 + d];
    const float ab = p.gla_ab[(l * 2 + dir) * 256 + h * 64 + d];
    {
        const int s = tid >> 2, q4 = tid & 3, row = row0 + (dir ? 63 - s : s);
        const u32x2 v = *(const u32x2*)(p.cols + (size_t)row * NCM + GLA_RF + dir * 16 + q4 * 4);
        rt[s * 17 + q4 * 4 + 0] = __uint_as_float(v.x << 16); rt[s * 17 + q4 * 4 + 1] = __uint_as_float(v.x & 0xffff0000u);
        rt[s * 17 + q4 * 4 + 2] = __uint_as_float(v.y << 16); rt[s * 17 + q4 * 4 + 3] = __uint_as_float(v.y & 0xffff0000u);
    }
    __syncthreads();
    float loc[16]; float run = 0.f;
#pragma unroll
    for (int i = 0; i < 16; ++i) {
        const int s = sq * 16 + i;
        float x = ab;
#pragma unroll
        for (int j = 0; j < 16; ++j) x += rt[s * 17 + j] * a2r[j];
        run += logsig(x) * (1.f / 16.f);
        loc[i] = run;
    }
    sg[sq * 64 + d] = run;
    __syncthreads();
    float off = 0.f;
    for (int k = 0; k < sq; ++k) off += sg[k * 64 + d];
#pragma unroll
    for (int i = 0; i < 16; ++i) cum[(sq * 16 + i) * 65 + d] = loc[i] + off;
    __syncthreads();
}

DEV void gla_phaseA(const P& p, int l, int dir, int b, int st, int h, unsigned char* smraw) {
    float* cum = (float*)smraw;
    float* rt = cum + 64 * 65;
    float* sg = rt + 64 * 17;
    u16* kwT = (u16*)(sg + 256);
    u16* vT = kwT + 64 * LDP;
    const int tid = tidx(), lane = tid & 63, w = tid >> 6, fr = lane & 15, fq = lane >> 4;
    const int row0 = chunk_row0(b, dir, st);
    const size_t idx = state_idx(dir, b, st, h);
    Raw16 kraw, vraw;
    {
        const int s = tid >> 2, dg = tid & 3, row = row0 + (dir ? 63 - s : s);
        kraw = ldraw16(p.cols + (size_t)row * NCM + GLA_K + h * 64 + dg * 16);
        vraw = ldraw16(p.cols + (size_t)row * NCM + GLA_V + h * 64 + dg * 16);
    }
    gla_cum(p, l, dir, h, row0, cum, rt, sg);
    {
        const int s = tid >> 2, dg = tid & 3;
        float kk[16], vv[16];
        unraw16(kraw, kk); unraw16(vraw, vv);
#pragma unroll
        for (int i = 0; i < 16; ++i) {
            const int d = dg * 16 + i;
            kwT[d * LDP + s] = f2bf(kk[i] * __expf(cum[63 * 65 + d] - cum[s * 65 + d]));
            vT[d * LDP + s] = f2bf(vv[i]);
        }
        if (tid < 64) p.glaDec[idx * 64 + tid] = __expf(cum[63 * 65 + tid]);
    }
    __syncthreads();
    f32x4 acc[4]; zero4(acc);
    mm64(acc, kwT, LDP, vT, LDP);
#pragma unroll
    for (int nt = 0; nt < 4; ++nt) {
        const int d = 16 * w + fq * 4, e = nt * 16 + fr;
        u32x2 pk; pk.x = pack2(acc[nt][0], acc[nt][1]); pk.y = pack2(acc[nt][2], acc[nt][3]);
        *(u32x2*)(p.glaS + idx * 4096 + e * 64 + d) = pk;
    }
    __syncthreads();
}

DEV void ml_phaseA(const P& p, int l, int dir, int b, int st, int h, unsigned char* smraw) {
    float* wend = (float*)smraw;
    u16* kwT = (u16*)(wend + 64);
    u16* vT = kwT + 64 * LDP;
    const int tid = tidx(), lane = tid & 63, w = tid >> 6, fr = lane & 15, fq = lane >> 4;
    const int row0 = chunk_row0(b, dir, st);
    const size_t idx = state_idx(dir, b, st, h);
    Raw16 kraw, vraw;
    {
        const int s = tid >> 2, dg = tid & 3, row = row0 + (dir ? 63 - s : s);
        kraw = ldraw16(p.cols + (size_t)row * NCM + ML_K + h * 64 + dg * 16);
        vraw = ldraw16(p.cols + (size_t)row * NCM + ML_V + h * 64 + dg * 16);
    }
    if (w == 0) {
        const int row = row0 + (dir ? 63 - lane : lane);
        const float ip = bf2f(p.cols[(size_t)row * NCM + ML_GF + dir * 8 + h]) + p.mlstm_gate_b[((l * 2 + dir) * 2 + 0) * 4 + h];
        const float lf = logsig(bf2f(p.cols[(size_t)row * NCM + ML_GF + dir * 8 + 4 + h]) + p.mlstm_gate_b[((l * 2 + dir) * 2 + 1) * 4 + h]);
        const float fc = wscan_add(lf, lane);
        const float fe = shidx(fc, 63);
        const float lw = fe - fc + ip;
        const float ae = wmaxr(lw);
        wend[lane] = __expf(lw - ae);
        if (lane == 0) { p.mlFE[idx] = fe; p.mlAE[idx] = ae; }
    }
    __syncthreads();
    {
        const int s = tid >> 2, dg = tid & 3;
        float kk[16], vv[16];
        unraw16(kraw, kk); unraw16(vraw, vv);
        const float ws = wend[s] * 0.125f;
#pragma unroll
        for (int i = 0; i < 16; ++i) {
            const int d = dg * 16 + i;
            kwT[d * LDP + s] = f2bf(kk[i] * ws);
            vT[d * LDP + s] = f2bf(vv[i]);
        }
    }
    __syncthreads();
    if (tid < 64) {
        float a = 0.f;
        for (int s = 0; s < 64; ++s) a += bf2f(kwT[tid * LDP + s]);
        p.mlN[idx * 64 + tid] = a;
    }
    f32x4 acc[4]; zero4(acc);
    mm64(acc, kwT, LDP, vT, LDP);
#pragma unroll
    for (int nt = 0; nt < 4; ++nt) {
        const int d = 16 * w + fq * 4, e = nt * 16 + fr;
        u32x2 pk; pk.x = pack2(acc[nt][0], acc[nt][1]); pk.y = pack2(acc[nt][2], acc[nt][3]);
        *(u32x2*)(p.mlS + idx * 4096 + e * 64 + d) = pk;
    }
    __syncthreads();
}

DEV void gd_phaseA(const P& p, int l, const u16* gqkv, int dir, int b, int st, int h, unsigned char* smraw) {
    float* X = (float*)smraw;
    float* cum = X + 64 * 65 + 32;
    float* beta = cum + 64;
    float* be = beta + 64;
    float* ke = be + 64;
    float* scal = ke + 64;
    u16* Y0 = (u16*)(scal + 64);
    u16* Y1 = Y0 + 64 * LDP;
    u16* Y2 = Y1 + 64 * LDP;
    u16* Y3 = Y2 + 64 * LDP;
    u16* Y4 = Y3 + 64 * LDP;
    u16* Y5 = Y4 + 64 * LDP;
    const int tid = tidx(), lane = tid & 63, w = tid >> 6, fr = lane & 15, fq = lane >> 4;
    const int row0 = chunk_row0(b, dir, st);
    const size_t idx = state_idx(dir, b, st, h);
    if (w == 0) {
        const int row = row0 + (dir ? 63 - lane : lane);
        const float bp = bf2f(p.cols[(size_t)row * NCM + GD_GF + dir * 8 + h]);
        const float ap = bf2f(p.cols[(size_t)row * NCM + GD_GF + dir * 8 + 4 + h]);
        const float bt = sigm(bp);
        const float g = -__expf(p.gdn_a_log[(l * 2 + dir) * 4 + h]) * softplus(ap + p.gdn_dt_bias[(l * 2 + dir) * 4 + h]);
        const float cm = wscan_add(g, lane);
        const float ce = shidx(cm, 63);
        cum[lane] = cm; beta[lane] = bt; be[lane] = bt * __expf(cm); ke[lane] = __expf(ce - cm);
        if (lane == 0) scal[0] = __expf(ce);
    }
    {
        const int s = tid >> 2, dg = tid & 3, row = row0 + (dir ? 63 - s : s);
        const u16* src = gqkv + (size_t)row * 768 + h * 64 + dg * 16;
        const u32x4 q0 = *(const u32x4*)src, q1 = *(const u32x4*)(src + 8);
        const u32x4 k0 = *(const u32x4*)(src + 256), k1 = *(const u32x4*)(src + 264);
        const u32x4 v0 = *(const u32x4*)(src + 512), v1 = *(const u32x4*)(src + 520);
        *(u32x4*)(Y0 + s * LDP + dg * 16) = q0; *(u32x4*)(Y0 + s * LDP + dg * 16 + 8) = q1;
        *(u32x4*)(Y1 + s * LDP + dg * 16) = k0; *(u32x4*)(Y1 + s * LDP + dg * 16 + 8) = k1;
        const unsigned kw[8] = {k0.x, k0.y, k0.z, k0.w, k1.x, k1.y, k1.z, k1.w};
        const unsigned vw[8] = {v0.x, v0.y, v0.z, v0.w, v1.x, v1.y, v1.z, v1.w};
#pragma unroll
        for (int i = 0; i < 8; ++i) {
            Y2[(dg * 16 + 2 * i) * LDP + s] = (u16)(kw[i] & 0xffff); Y2[(dg * 16 + 2 * i + 1) * LDP + s] = (u16)(kw[i] >> 16);
            Y3[(dg * 16 + 2 * i) * LDP + s] = (u16)(vw[i] & 0xffff); Y3[(dg * 16 + 2 * i + 1) * LDP + s] = (u16)(vw[i] >> 16);
        }
    }
    __syncthreads();
    u32x2 qpre[4];
#pragma unroll
    for (int nt = 0; nt < 4; ++nt) {
        const int c = nt * 16 + fr, row = row0 + (dir ? 63 - c : c);
        qpre[nt] = *(const u32x2*)(gqkv + (size_t)row * 768 + h * 64 + 16 * w + fq * 4);
    }
    {
        f32x4 kk[4], qk[4]; zero4(kk); zero4(qk);
        mm64(kk, Y1, LDP, Y1, LDP);
        mm64(qk, Y0, LDP, Y1, LDP);
#pragma unroll
        for (int nt = 0; nt < 4; ++nt)
#pragma unroll
            for (int j = 0; j < 4; ++j) {
                const int c = 16 * w + fq * 4 + j, s = nt * 16 + fr;
                const float gam = s <= c ? __expf(cum[c] - cum[s]) : 0.f;
                X[c * 65 + s] = s < c ? beta[c] * kk[nt][j] * gam : 0.f;
                Y4[c * LDP + s] = f2bf(qk[nt][j] * gam);
            }
    }
    __syncthreads();
    float* T = (float*)Y0;
    {
        float* Pb = (float*)Y5;
        for (int e = tid; e < 6 * 256; e += NTHR) {
            const int q = e >> 8, r = (e >> 4) & 15, c = e & 15;
            const int ib = q < 3 ? 0 : (q < 5 ? 1 : 2), jb = q < 3 ? q + 1 : (q < 5 ? q - 1 : 3);
            T[(16 * ib + r) * 65 + 16 * jb + c] = 0.f;
        }
        if (tid < 64) {
            const int blk = tid >> 4, col = tid & 15, base = blk * 16;
            float tc[16];
#pragma unroll
            for (int r = 0; r < 16; ++r) tc[r] = (r == col) ? 1.f : 0.f;
#pragma unroll
            for (int r = 1; r < 16; ++r) {
                float a = 0.f;
#pragma unroll
                for (int s2 = 0; s2 < r; ++s2) a += X[(base + r) * 65 + base + s2] * tc[s2];
                tc[r] = r > col ? -a : tc[r];
            }
#pragma unroll
            for (int r = 0; r < 16; ++r) T[(base + r) * 65 + base + col] = tc[r];
        }
        __syncthreads();
#pragma unroll
        for (int d = 1; d < 4; ++d) {
            const int nblk = 4 - d;
            for (int e = tid; e < nblk * 256; e += NTHR) {
                const int jb = e >> 8, r = (e >> 4) & 15, c = e & 15, ib = jb + d;
                float a = 0.f;
#pragma unroll
                for (int k2 = 0; k2 < d; ++k2)
#pragma unroll
                    for (int s2 = 0; s2 < 16; ++s2) a += X[(16 * ib + r) * 65 + 16 * (jb + k2) + s2] * T[(16 * (jb + k2) + s2) * 65 + 16 * jb + c];
                Pb[(jb * 16 + r) * 17 + c] = a;
            }
            __syncthreads();
            for (int e = tid; e < nblk * 256; e += NTHR) {
                const int jb = e >> 8, r = (e >> 4) & 15, c = e & 15, ib = jb + d;
                float a = 0.f;
#pragma unroll
                for (int s2 = 0; s2 < 16; ++s2) a += T[(16 * ib + r) * 65 + 16 * ib + s2] * Pb[(jb * 16 + s2) * 17 + c];
                T[(16 * ib + r) * 65 + 16 * jb + c] = -a;
            }
            __syncthreads();
        }
    }
    u16* Tw = (u16*)X;
    u16* Tu = Y5;
    {
        const int c = tid >> 2, sgp = tid & 3;
        float tw[16], tu[16];
#pragma unroll
        for (int i = 0; i < 16; ++i) {
            const int s = sgp * 16 + i;
            const float t = T[c * 65 + s];
            tw[i] = t * be[s]; tu[i] = t * beta[s];
        }
        st16bf(Tw + c * LDP + sgp * 16, tw);
        st16bf(Tu + c * LDP + sgp * 16, tu);
    }
    __syncthreads();
    u16* wT = Y0; u16* wkT = Y1; u16* uT = (u16*)X; u16* ukT = Y5;
    {
        f32x4 wa[4], ua[4]; zero4(wa); zero4(ua);
        mm64(wa, Tw, LDP, Y2, LDP);
        mm64(ua, Tu, LDP, Y3, LDP);
        __syncthreads();
        const int c0 = 16 * w + fq * 4;
        const float k0 = ke[c0], k1 = ke[c0 + 1], k2 = ke[c0 + 2], k3 = ke[c0 + 3];
#pragma unroll
        for (int nt = 0; nt < 4; ++nt) {
            const int d = nt * 16 + fr;
            u32x2 a, bq, c, dq_;
            a.x = pack2(wa[nt][0], wa[nt][1]); a.y = pack2(wa[nt][2], wa[nt][3]);
            bq.x = pack2(wa[nt][0] * k0, wa[nt][1] * k1); bq.y = pack2(wa[nt][2] * k2, wa[nt][3] * k3);
            c.x = pack2(ua[nt][0], ua[nt][1]); c.y = pack2(ua[nt][2], ua[nt][3]);
            dq_.x = pack2(ua[nt][0] * k0, ua[nt][1] * k1); dq_.y = pack2(ua[nt][2] * k2, ua[nt][3] * k3);
            *(u32x2*)(wT + d * LDP + c0) = a;
            *(u32x2*)(wkT + d * LDP + c0) = bq;
            *(u32x2*)(uT + d * LDP + c0) = c;
            *(u32x2*)(ukT + d * LDP + c0) = dq_;
        }
    }
    __syncthreads();
    {
        const float dec = scal[0];
        f32x4 acc[4];
        zero4(acc); mm64(acc, wT, LDP, Y4, LDP);
#pragma unroll
        for (int nt = 0; nt < 4; ++nt) {
            const int d = 16 * w + fq * 4, c = nt * 16 + fr;
            const u32x2 qv = qpre[nt];
            const float ec = __expf(cum[c]);
            u32x2 pk;
            pk.x = pack2(__uint_as_float(qv.x << 16) * ec - acc[nt][0], __uint_as_float(qv.x & 0xffff0000u) * ec - acc[nt][1]);
            pk.y = pack2(__uint_as_float(qv.y << 16) * ec - acc[nt][2], __uint_as_float(qv.y & 0xffff0000u) * ec - acc[nt][3]);
            *(u32x2*)(p.gdQ + idx * 4096 + c * 64 + d) = pk;
        }
        zero4(acc); mm64(acc, wkT, LDP, Y2, LDP);
#pragma unroll
        for (int nt = 0; nt < 4; ++nt) {
            const int d = 16 * w + fq * 4, d2 = nt * 16 + fr;
            u32x2 pk;
            pk.x = pack2((d == d2 ? dec : 0.f) - acc[nt][0], (d + 1 == d2 ? dec : 0.f) - acc[nt][1]);
            pk.y = pack2((d + 2 == d2 ? dec : 0.f) - acc[nt][2], (d + 3 == d2 ? dec : 0.f) - acc[nt][3]);
            *(u32x2*)(p.gdM + idx * 4096 + d2 * 64 + d) = pk;
        }
        zero4(acc); mm64(acc, Y2, LDP, ukT, LDP);
#pragma unroll
        for (int nt = 0; nt < 4; ++nt) {
            const int d2 = 16 * w + fq * 4, e = nt * 16 + fr;
            u32x2 pk; pk.x = pack2(acc[nt][0], acc[nt][1]); pk.y = pack2(acc[nt][2], acc[nt][3]);
            *(u32x2*)(p.gdN + idx * 4096 + e * 64 + d2) = pk;
        }
        zero4(acc); mm64(acc, Y4, LDP, uT, LDP);
#pragma unroll
        for (int nt = 0; nt < 4; ++nt) {
            const int c = 16 * w + fq * 4, e = nt * 16 + fr;
            u32x2 pk; pk.x = pack2(acc[nt][0], acc[nt][1]); pk.y = pack2(acc[nt][2], acc[nt][3]);
            *(u32x2*)(p.gdO + idx * 4096 + e * 64 + c) = pk;
        }
    }
    __syncthreads();
}

DEV void phase_chunkA(const P& p, int l, const u16* gqkv, int bid, int nb, unsigned char* sm) {
    for (int u = bid; u < 3 * 2112; u += nb) {
        const int mix = u / 2112, v = u % 2112;
        const int h = v & 3, st = (v >> 2) % NSTEP, db = (v >> 2) / NSTEP, b = db & 1, dir = db >> 1;
        if (mix == 0) { PRB_BEGIN(120); gd_phaseA(p, l, gqkv, dir, b, st, h, sm); PRB_END(120); }
        else if (mix == 1) { PRB_BEGIN(121); gla_phaseA(p, l, dir, b, st, h, sm); PRB_END(121); }
        else { PRB_BEGIN(122); ml_phaseA(p, l, dir, b, st, h, sm); PRB_END(122); }
    }
}
#define GD_STAGE (2 * 64 * 64)
DEV void gd_issue(const P& p, size_t idx, u16* ring, int stg, int w, int lane) {
    u16* md = ring + stg * GD_STAGE;
    u16* nd = md + 64 * 64;
#pragma unroll
    for (int i = 0; i < 2; ++i) {
        const int r = (w * 2 + i) * 8 + (lane >> 3), c = (lane & 7) ^ ((r >> 1) & 7);
        __builtin_amdgcn_global_load_lds((const unsigned*)(p.gdM + idx * 4096 + r * 64 + c * 8), (unsigned*)(md + (w * 2 + i) * 512), 16, 0, 0);
        __builtin_amdgcn_global_load_lds((const unsigned*)(p.gdN + idx * 4096 + r * 64 + c * 8), (unsigned*)(nd + (w * 2 + i) * 512), 16, 0, 0);
    }
}
DEV void gd_frags(const u16* Ms, int w, int fr, int fq, int sw, bf16x8 (&a)[8], u32x2 (&nv)[4]) {
    const u16* Ns = Ms + 64 * 64;
#pragma unroll
    for (int mt = 0; mt < 4; ++mt) {
#pragma unroll
        for (int ks = 0; ks < 2; ++ks) a[mt * 2 + ks] = *(const bf16x8*)(Ms + (mt * 16 + fr) * 64 + (((ks * 4 + fq) ^ sw) * 8));
        nv[mt] = *(const u32x2*)(Ns + (16 * w + fr) * 64 + (((mt * 2 + (fq >> 1)) ^ sw) * 8) + (fq & 1) * 4);
    }
}
DEV void gd_scan(const P& p, int chain, u16* sm) {
    const int dir = chain >> 3, b = (chain >> 2) & 1, h = chain & 3;
    const int tid_ = tidx();
    const int lane = tid_ & 63, w = tid_ >> 6, fr = lane & 15, fq = lane >> 4;
    u16* ring = sm;
    u16* sl = sm + 4 * GD_STAGE + w * 16 * LDP;
    bf16x8 sb[2];
    sb[0] = bf16x8{0, 0, 0, 0, 0, 0, 0, 0}; sb[1] = sb[0];
    const size_t base = state_idx(dir, b, 0, h);
    const int sw = (fr >> 1) & 7;
    asm volatile("s_waitcnt vmcnt(0)" ::: "memory");
    gd_issue(p, base, ring, 0, w, lane);
    gd_issue(p, base + 4, ring, 1, w, lane);
    gd_issue(p, base + 8, ring, 2, w, lane);
    asm volatile("s_waitcnt vmcnt(8)" ::: "memory");
    RAW_BARRIER();
    bf16x8 a[8], an[8]; u32x2 nv[4], nn[4];
    gd_frags(ring, w, fr, fq, sw, a, nv);
    for (int k = 0; k < NSTEP; ++k) {
        if (k == 0) asm volatile("s_waitcnt vmcnt(4)" ::: "memory");
        else if (k == 1) asm volatile("s_waitcnt vmcnt(6)" ::: "memory");
        else if (k + 3 < NSTEP) asm volatile("s_waitcnt vmcnt(8)" ::: "memory");
        else asm volatile("s_waitcnt vmcnt(0)" ::: "memory");
        RAW_BARRIER();
        if (k + 3 < NSTEP) gd_issue(p, base + (size_t)(k + 3) * 4, ring, (k + 3) & 3, w, lane);
        asm volatile("" ::: "memory");
        const size_t idx = base + (size_t)k * 4;
        f32x4 acc[4];
#pragma unroll
        for (int mt = 0; mt < 4; ++mt) {
            acc[mt][0] = __uint_as_float(nv[mt].x << 16); acc[mt][1] = __uint_as_float(nv[mt].x & 0xffff0000u);
            acc[mt][2] = __uint_as_float(nv[mt].y << 16); acc[mt][3] = __uint_as_float(nv[mt].y & 0xffff0000u);
        }
#pragma unroll
        for (int mt = 0; mt < 4; ++mt)
#pragma unroll
            for (int ks = 0; ks < 2; ++ks) acc[mt] = mfma16(a[mt * 2 + ks], sb[ks], acc[mt]);
        if (k + 1 < NSTEP) gd_frags(ring + ((k + 1) & 3) * GD_STAGE, w, fr, fq, sw, an, nn);
#pragma unroll
        for (int ks = 0; ks < 2; ++ks) *(bf16x8*)(p.gdN + idx * 4096 + (16 * w + fr) * 64 + ks * 32 + fq * 8) = sb[ks];
        asm volatile("" ::: "memory");
#pragma unroll
        for (int mt = 0; mt < 4; ++mt) {
            u32x2 pk; pk.x = pack2(acc[mt][0], acc[mt][1]); pk.y = pack2(acc[mt][2], acc[mt][3]);
            *(u32x2*)(sl + fr * LDP + mt * 16 + fq * 4) = pk;
        }
        __builtin_amdgcn_wave_barrier();
#pragma unroll
        for (int ks = 0; ks < 2; ++ks) sb[ks] = *(const bf16x8*)(sl + fr * LDP + ks * 32 + fq * 8);
        __builtin_amdgcn_wave_barrier();
#pragma unroll
        for (int q = 0; q < 8; ++q) a[q] = an[q];
#pragma unroll
        for (int q = 0; q < 4; ++q) nv[q] = nn[q];
    }
    asm volatile("s_waitcnt vmcnt(0)" ::: "memory");
    RAW_BARRIER();
}

DEV void gla_scan(const P& p, int v) {
    const int chain = v >> 3, sub = v & 7;
    const int dir = chain >> 3, b = (chain >> 2) & 1, h = chain & 3;
    const int ep = sub * 256 + tidx(), d = (2 * ep) & 63;
    float s0 = 0.f, s1 = 0.f;
    for (int st0 = 0; st0 < NSTEP; st0 += 12) {
        unsigned kv[12]; float2 dc[12];
#pragma unroll
        for (int k = 0; k < 12; ++k) {
            const size_t idx = state_idx(dir, b, st0 + k, h);
            kv[k] = *(const unsigned*)(p.glaS + idx * 4096 + 2 * ep);
            dc[k] = *(const float2*)(p.glaDec + idx * 64 + d);
        }
#pragma unroll
        for (int k = 0; k < 12; ++k) {
            const size_t idx = state_idx(dir, b, st0 + k, h);
            *(unsigned*)(p.glaS + idx * 4096 + 2 * ep) = pack2(s0, s1);
            s0 = dc[k].x * s0 + __uint_as_float(kv[k] << 16);
            s1 = dc[k].y * s1 + __uint_as_float(kv[k] & 0xffff0000u);
        }
    }
}

DEV void ml_scan(const P& p, int v) {
    const int chain = v >> 3, sub = v & 7;
    const int dir = chain >> 3, b = (chain >> 2) & 1, h = chain & 3;
    const int tid = tidx();
    const int ep = sub * 256 + tid;
    float s0 = 0.f, s1 = 0.f, m = 0.f;
    for (int st0 = 0; st0 < NSTEP; st0 += 12) {
        unsigned kv[12]; float fe[12], ae[12];
#pragma unroll
        for (int k = 0; k < 12; ++k) {
            const size_t idx = state_idx(dir, b, st0 + k, h);
            kv[k] = *(const unsigned*)(p.mlS + idx * 4096 + 2 * ep);
            fe[k] = p.mlFE[idx]; ae[k] = p.mlAE[idx];
        }
#pragma unroll
        for (int k = 0; k < 12; ++k) {
            const size_t idx = state_idx(dir, b, st0 + k, h);
            *(unsigned*)(p.mlS + idx * 4096 + 2 * ep) = pack2(s0, s1);
            const float mn = fmaxf(fe[k] + m, ae[k]);
            const float od = __expf(fe[k] + m - mn), nw = __expf(ae[k] - mn);
            s0 = od * s0 + nw * __uint_as_float(kv[k] << 16);
            s1 = od * s1 + nw * __uint_as_float(kv[k] & 0xffff0000u);
            m = mn;
        }
    }
}
DEV void ml_nscan(const P& p, int v) {
    const int tid = tidx(), chain = v * 4 + (tid >> 6), d = tid & 63;
    const int dir = chain >> 3, b = (chain >> 2) & 1, h = chain & 3;
    float nn = 0.f, m = 0.f;
    for (int st0 = 0; st0 < NSTEP; st0 += 12) {
        float fe[12], ae[12], ks[12];
#pragma unroll
        for (int k = 0; k < 12; ++k) {
            const size_t idx = state_idx(dir, b, st0 + k, h);
            fe[k] = p.mlFE[idx]; ae[k] = p.mlAE[idx]; ks[k] = p.mlN[idx * 64 + d];
        }
#pragma unroll
        for (int k = 0; k < 12; ++k) {
            const size_t idx = state_idx(dir, b, st0 + k, h);
            p.mlN[idx * 64 + d] = nn;
            if (d == 0) p.mlM[idx] = m;
            const float mn = fmaxf(fe[k] + m, ae[k]);
            const float od = __expf(fe[k] + m - mn), nw = __expf(ae[k] - mn);
            nn = od * nn + nw * ks[k];
            m = mn;
        }
    }
}

DEV void phase_scan(const P& p, int bid, int nb, u16* sm) {
    for (int u = bid; u < 16 + 128 + 128 + 4; u += nb) {
        if (u < 16) { PRB_BEGIN(100); gd_scan(p, u, sm); PRB_END(100); }
        else if (u < 144) { PRB_BEGIN(101); gla_scan(p, u - 16); PRB_END(101); }
        else if (u < 272) { PRB_BEGIN(102); ml_scan(p, u - 144); PRB_END(102); }
        else ml_nscan(p, u - 272);
    }
}
DEV void chunk_geom(int g, int& b, int& row0, int& stf, int& stb) {
    b = g / NSTEP; const int wv = g % NSTEP;
    row0 = wv < 4 ? RLAT + b * CTXL + wv * 64 : b * SEQ + (wv - 4) * 64;
    stf = wv; stb = wv < 4 ? 3 - wv : 135 - wv;
}
DEV void obuf_acc(float* obuf, const f32x4 (&acc)[4], int dir) {
    const int lane = tidx() & 63, w = tidx() >> 6, fr = lane & 15, fq = lane >> 4;
#pragma unroll
    for (int nt = 0; nt < 4; ++nt)
#pragma unroll
        for (int j = 0; j < 4; ++j) {
            const int c = 16 * w + fq * 4 + j, e = nt * 16 + fr;
            if (dir == 0) obuf[c * 65 + e] = acc[nt][j]; else obuf[(63 - c) * 65 + e] += acc[nt][j];
        }
}
DEV Raw16 gate_prefetch(const P& p, int h, int row0, int gcol) {
    const int tid = tidx(), row = tid >> 2, eg = tid & 3;
    return ldraw16(p.cols + (size_t)(row0 + row) * NCM + gcol + h * 64 + eg * 16);
}
template <int ACT>
DEV void head_out(const P& p, int l, int br, int h, int row0, const Raw16& graw, const float* obuf) {
    const int tid = tidx(), row = tid >> 2, eg = tid & 3;
    float o[16]; float ss = 0.f;
#pragma unroll
    for (int i = 0; i < 16; ++i) { o[i] = obuf[row * 65 + eg * 16 + i]; ss += o[i] * o[i]; }
    ss += shx(ss, 1); ss += shx(ss, 2);
    const float rs = rsqrtf(ss * (1.f / 64.f) + EPSF);
    float gt[16];
    unraw16(graw, gt);
    float y[16];
#pragma unroll
    for (int i = 0; i < 16; ++i) {
        const float hn = p.head_norm[(l * 4 + br) * 256 + h * 64 + eg * 16 + i];
        const float a = ACT == 0 ? silu(gt[i]) : sigm(gt[i]);
        y[i] = o[i] * rs * hn * a;
    }
    st16bf(p.ybuf + (size_t)(row0 + row) * 1024 + br * 256 + h * 64 + eg * 16, y);
}

DEV void gla_phaseC(const P& p, int l, int g, int h, unsigned char* smraw) {
    float* cum = (float*)smraw;
    float* rt = cum + 64 * 65;
    float* sg = rt + 64 * 17;
    float* obuf = sg + 256;
    u16* qi = (u16*)(obuf + 64 * 65);
    u16* ko = qi + 64 * LDP;
    u16* vT = ko + 64 * LDP;
    const int tid = tidx(), lane = tid & 63, w = tid >> 6, fr = lane & 15, fq = lane >> 4;
    int b, row0, stf, stb; chunk_geom(g, b, row0, stf, stb);
    const Raw16 graw = gate_prefetch(p, h, row0, GLA_G);
    for (int dir = 0; dir < 2; ++dir) {
        const size_t idx = state_idx(dir, b, dir ? stb : stf, h);
        Raw16 qraw, kraw, vraw; bf16x8 sin_[2][4];
        {
            const int s = tid >> 2, dg = tid & 3, row = row0 + (dir ? 63 - s : s);
            qraw = ldraw16(p.cols + (size_t)row * NCM + GLA_Q + h * 64 + dg * 16);
            kraw = ldraw16(p.cols + (size_t)row * NCM + GLA_K + h * 64 + dg * 16);
            vraw = ldraw16(p.cols + (size_t)row * NCM + GLA_V + h * 64 + dg * 16);
        }
        ldB64(sin_, p.glaS + idx * 4096);
        PRB_BEGIN(140);
        gla_cum(p, l, dir, h, row0, cum, rt, sg);
        PRB_END(140);
        PRB_BEGIN(141);
        {
            const int s = tid >> 2, dg = tid & 3;
            float qq[16], kk[16], vv[16];
            unraw16(qraw, qq); unraw16(kraw, kk); unraw16(vraw, vv);
#pragma unroll
            for (int i = 0; i < 16; ++i) {
                const float cv = cum[s * 65 + dg * 16 + i];
                qq[i] *= 0.125f * __expf(cv); kk[i] *= __expf(-cv);
                vT[(dg * 16 + i) * LDP + s] = f2bf(vv[i]);
            }
            st16bf(qi + s * LDP + dg * 16, qq);
            st16bf(ko + s * LDP + dg * 16, kk);
        }
        __syncthreads();
        f32x4 sa[4]; zero4(sa);
        mm64(sa, qi, LDP, ko, LDP);
        __syncthreads();
#pragma unroll
        for (int nt = 0; nt < 4; ++nt)
#pragma unroll
            for (int j = 0; j < 4; ++j) {
                const int c = 16 * w + fq * 4 + j, s = nt * 16 + fr;
                ko[c * LDP + s] = f2bf(s <= c ? sa[nt][j] : 0.f);
            }
        __syncthreads();
        PRB_END(141);
        PRB_BEGIN(142);
        f32x4 oa[4]; zero4(oa);
        mm64(oa, ko, LDP, vT, LDP);
        mm64_pre(oa, qi, LDP, sin_);
        obuf_acc(obuf, oa, dir);
        __syncthreads();
        PRB_END(142);
    }
    PRB_BEGIN(143);
    head_out<0>(p, l, 0, h, row0, graw, obuf);
    __syncthreads();
    PRB_END(143);
}

DEV void ml_phaseC(const P& p, int l, int g, int h, unsigned char* smraw) {
    float* obuf = (float*)smraw;
    float* fcum = obuf + 64 * 65;
    float* ipre = fcum + 64;
    float* mrow = ipre + 64;
    float* denl = mrow + 64;
    float* qn = denl + 64;
    float* nin = qn + 64;
    u16* qs = (u16*)(nin + 64 + 64);
    u16* ks = qs + 64 * LDP;
    u16* vT = ks + 64 * LDP;
    const int tid = tidx(), lane = tid & 63, w = tid >> 6, fr = lane & 15, fq = lane >> 4;
    int b, row0, stf, stb; chunk_geom(g, b, row0, stf, stb);
    const Raw16 graw = gate_prefetch(p, h, row0, ML_O);
    for (int dir = 0; dir < 2; ++dir) {
        const size_t idx = state_idx(dir, b, dir ? stb : stf, h);
        const float m_in = p.mlM[idx];
        Raw16 qraw, kraw, vraw; bf16x8 cin_[2][4];
        {
            const int s = tid >> 2, dg = tid & 3, row = row0 + (dir ? 63 - s : s);
            qraw = ldraw16(p.cols + (size_t)row * NCM + ML_Q + h * 64 + dg * 16);
            kraw = ldraw16(p.cols + (size_t)row * NCM + ML_K + h * 64 + dg * 16);
            vraw = ldraw16(p.cols + (size_t)row * NCM + ML_V + h * 64 + dg * 16);
        }
        ldB64(cin_, p.mlS + idx * 4096);
        if (w == 0) {
            const int row = row0 + (dir ? 63 - lane : lane);
            const float ip = bf2f(p.cols[(size_t)row * NCM + ML_GF + dir * 8 + h]) + p.mlstm_gate_b[((l * 2 + dir) * 2 + 0) * 4 + h];
            const float lf = logsig(bf2f(p.cols[(size_t)row * NCM + ML_GF + dir * 8 + 4 + h]) + p.mlstm_gate_b[((l * 2 + dir) * 2 + 1) * 4 + h]);
            const float fc = wscan_add(lf, lane);
            const float pm = wscan_max(ip - fc, lane);
            fcum[lane] = fc; ipre[lane] = ip; mrow[lane] = fc + fmaxf(m_in, pm);
            nin[lane] = p.mlN[idx * 64 + lane];
        }
        {
            const int s = tid >> 2, dg = tid & 3;
            float kk[16], vv[16];
            *(u32x4*)(qs + s * LDP + dg * 16) = qraw.a;
            *(u32x4*)(qs + s * LDP + dg * 16 + 8) = qraw.b;
            unraw16(kraw, kk); unraw16(vraw, vv);
#pragma unroll
            for (int i = 0; i < 16; ++i) { kk[i] *= 0.125f; vT[(dg * 16 + i) * LDP + s] = f2bf(vv[i]); }
            st16bf(ks + s * LDP + dg * 16, kk);
        }
        __syncthreads();
        {
            const int c = tid >> 2, dg = tid & 3;
            float a = 0.f;
#pragma unroll
            for (int i = 0; i < 16; ++i) a += bf2f(qs[c * LDP + dg * 16 + i]) * nin[dg * 16 + i];
            a += shx(a, 1); a += shx(a, 2);
            if (dg == 0) qn[c] = a;
        }
        f32x4 sa[4]; zero4(sa);
        mm64(sa, qs, LDP, ks, LDP);
        __syncthreads();
        float dsum[4] = {0.f, 0.f, 0.f, 0.f};
#pragma unroll
        for (int nt = 0; nt < 4; ++nt)
#pragma unroll
            for (int j = 0; j < 4; ++j) {
                const int c = 16 * w + fq * 4 + j, s = nt * 16 + fr;
                float val = 0.f;
                if (s <= c) val = sa[nt][j] * __expf(fcum[c] - fcum[s] + ipre[s] - mrow[c]);
                dsum[j] += val;
                ks[c * LDP + s] = f2bf(val);
            }
#pragma unroll
        for (int j = 0; j < 4; ++j) {
            float v = dsum[j];
            v += shx(v, 1); v += shx(v, 2); v += shx(v, 4); v += shx(v, 8);
            if (fr == 0) denl[16 * w + fq * 4 + j] = v;
        }
        __syncthreads();
        f32x4 n1[4], n2[4]; zero4(n1); zero4(n2);
        mm64(n1, ks, LDP, vT, LDP);
        mm64_pre(n2, qs, LDP, cin_);
        f32x4 oa[4];
#pragma unroll
        for (int j = 0; j < 4; ++j) {
            const int c = 16 * w + fq * 4 + j;
            const float mr = mrow[c];
            const float ec = __expf(fcum[c] + m_in - mr);
            const float den = denl[c] + ec * qn[c];
            const float inv = 1.f / fmaxf(fabsf(den), __expf(-mr));
#pragma unroll
            for (int nt = 0; nt < 4; ++nt) oa[nt][j] = (n1[nt][j] + ec * n2[nt][j]) * inv;
        }
        obuf_acc(obuf, oa, dir);
        __syncthreads();
    }
    head_out<1>(p, l, 1, h, row0, graw, obuf);
    __syncthreads();
}

DEV void gd_phaseC(const P& p, int l, int g, int h, unsigned char* smraw) {
    float* obuf = (float*)smraw;
    const int tid = tidx(), lane = tid & 63, w = tid >> 6, fr = lane & 15, fq = lane >> 4;
    int b, row0, stf, stb; chunk_geom(g, b, row0, stf, stb);
    const Raw16 graw = gate_prefetch(p, h, row0, GD_OG);
    for (int dir = 0; dir < 2; ++dir) {
        const size_t idx = state_idx(dir, b, dir ? stb : stf, h);
        f32x4 oa[4];
#pragma unroll
        for (int nt = 0; nt < 4; ++nt) {
            const u32x2 ov = *(const u32x2*)(p.gdO + idx * 4096 + (nt * 16 + fr) * 64 + 16 * w + fq * 4);
            oa[nt][0] = __uint_as_float(ov.x << 16); oa[nt][1] = __uint_as_float(ov.x & 0xffff0000u);
            oa[nt][2] = __uint_as_float(ov.y << 16); oa[nt][3] = __uint_as_float(ov.y & 0xffff0000u);
        }
        mm64(oa, p.gdQ + idx * 4096, 64, p.gdN + idx * 4096, 64);
        obuf_acc(obuf, oa, dir);
        __syncthreads();
    }
    head_out<0>(p, l, 2, h, row0, graw, obuf);
    __syncthreads();
}
DEV float fexp2(float x) { return __builtin_amdgcn_exp2f(x); }

#define ATT_STAGE_ELEMS (2 * 64 * 64)
DEV void attn_issue(const u16* kbase, const u16* vbase, int kt, u16* ring, int stg, int w, int lane) {
    u16* kd = ring + stg * ATT_STAGE_ELEMS;
    u16* vd = kd + 64 * 64;
#pragma unroll
    for (int i = 0; i < 2; ++i) {
        const int r = (w * 2 + i) * 8 + (lane >> 3), c = (lane & 7) ^ ((r >> 1) & 7);
        __builtin_amdgcn_global_load_lds((const unsigned*)(kbase + (size_t)(kt * 64 + r) * 64 + c * 8), (unsigned*)(kd + (w * 2 + i) * 512), 16, 0, 0);
        __builtin_amdgcn_global_load_lds((const unsigned*)(vbase + (size_t)r * KPOS + kt * 64 + c * 8), (unsigned*)(vd + (w * 2 + i) * 512), 16, 0, 0);
    }
}

DEV void attn_unit(const P& p, int l, int b, int h, int q0pos, int nkeys, int rowbase, u16* ring) {
    const int tid = tidx(), lane = tid & 63, w = tid >> 6, fr = lane & 15, fq = lane >> 4;
    const size_t bh = (size_t)(b * 4 + h);
    float lam;
    {
        const float* lp = p.diff_lambda + (size_t)l * 4 * 4 * 32;
        float a = 0.f, c = 0.f;
        if (lane < 32) { a = lp[(0 * 4 + h) * 32 + lane] * lp[(1 * 4 + h) * 32 + lane]; c = lp[(2 * 4 + h) * 32 + lane] * lp[(3 * 4 + h) * 32 + lane]; }
        a = wsum(a); c = wsum(c);
        lam = expf(a) - expf(c) + (0.8f - 0.6f * expf(-0.3f * (float)l));
    }
    const float lam_init = 0.8f - 0.6f * expf(-0.3f * (float)l);
    bf16x8 qf[2][2];
#pragma unroll
    for (int g = 0; g < 2; ++g)
#pragma unroll
        for (int i = 0; i < 2; ++i)
            qf[g][i] = *(const bf16x8*)(p.dq + (bh * KPOS + q0pos + w * 32 + g * 16 + fr) * 64 + i * 32 + fq * 8);
    f32x4 O[2][2][4], negref[2][2];
    float mref[2][2], lsum[2][2];
#pragma unroll
    for (int i = 0; i < 2; ++i)
#pragma unroll
        for (int g = 0; g < 2; ++g) {
            mref[i][g] = 0.f; lsum[i][g] = 0.f; negref[i][g] = f32x4{0.f, 0.f, 0.f, 0.f};
#pragma unroll
            for (int t = 0; t < 4; ++t) O[i][g][t] = f32x4{0.f, 0.f, 0.f, 0.f};
        }
    const u16* kbase = p.dk + bh * KPOS * 64;
    const u16* vbase = p.dvT + bh * 64 * KPOS;
    const int nk = nkeys >> 6;
    asm volatile("s_waitcnt vmcnt(0)" ::: "memory");
    attn_issue(kbase, vbase, 0, ring, 0, w, lane);
    attn_issue(kbase, vbase, 1, ring, 1, w, lane);
    const int sw = (fr >> 1) & 7;
    for (int kt = 0; kt < nk; ++kt) {
        if (kt + 1 < nk) asm volatile("s_waitcnt vmcnt(4)" ::: "memory"); else asm volatile("s_waitcnt vmcnt(0)" ::: "memory");
        RAW_BARRIER();
        if (kt + 2 < nk) attn_issue(kbase, vbase, kt + 2, ring, (kt + 2) % 3, w, lane);
        const u16* Ks = ring + (kt % 3) * ATT_STAGE_ELEMS;
        const u16* Vs = Ks + 64 * 64;
#pragma unroll
        for (int i = 0; i < 2; ++i) {
            f32x4 s[2][4];
#pragma unroll
            for (int st = 0; st < 4; ++st) {
                const bf16x8 kf = *(const bf16x8*)(Ks + (st * 16 + fr) * 64 + (((i * 4 + fq) ^ sw) * 8));
#pragma unroll
                for (int g = 0; g < 2; ++g) s[g][st] = mfma16(kf, qf[g][i], negref[i][g]);
            }
            float tmx[2];
#pragma unroll
            for (int g = 0; g < 2; ++g) {
                float mx = fmaxf(fmaxf(s[g][0][0], s[g][0][1]), fmaxf(s[g][0][2], s[g][0][3]));
#pragma unroll
                for (int st = 1; st < 4; ++st) mx = fmaxf(fmaxf(mx, s[g][st][0]), fmaxf(fmaxf(s[g][st][1], s[g][st][2]), s[g][st][3]));
                mx = fmaxf(mx, shx(mx, 16)); mx = fmaxf(mx, shx(mx, 32));
                tmx[g] = mx;
            }
            const bool mv = (tmx[0] > 16.f) || (tmx[1] > 16.f) || (kt == 0 && (tmx[0] < -16.f || tmx[1] < -16.f));
            if (__any(mv)) {
#pragma unroll
                for (int g = 0; g < 2; ++g) {
                    const float d = ((tmx[g] > 16.f) || (kt == 0 && tmx[g] < -16.f)) ? tmx[g] : 0.f;
                    const float fac = fexp2(-d);
                    mref[i][g] += d; lsum[i][g] *= fac;
                    negref[i][g] = f32x4{-mref[i][g], -mref[i][g], -mref[i][g], -mref[i][g]};
#pragma unroll
                    for (int t = 0; t < 4; ++t) { O[i][g][t][0] *= fac; O[i][g][t][1] *= fac; O[i][g][t][2] *= fac; O[i][g][t][3] *= fac; }
#pragma unroll
                    for (int st = 0; st < 4; ++st) { s[g][st][0] -= d; s[g][st][1] -= d; s[g][st][2] -= d; s[g][st][3] -= d; }
                }
            }
            bf16x8 pb[2][2];
#pragma unroll
            for (int g = 0; g < 2; ++g) {
                float ps = 0.f;
#pragma unroll
                for (int st = 0; st < 4; ++st)
#pragma unroll
                    for (int j = 0; j < 4; ++j) { const float e = fexp2(s[g][st][j]); s[g][st][j] = e; ps += e; }
                lsum[i][g] += ps;
#pragma unroll
                for (int ks = 0; ks < 2; ++ks) {
                    union { bf16x8 v; unsigned u[4]; } pk;
                    pk.u[0] = pack2(s[g][2 * ks][0], s[g][2 * ks][1]); pk.u[1] = pack2(s[g][2 * ks][2], s[g][2 * ks][3]);
                    pk.u[2] = pack2(s[g][2 * ks + 1][0], s[g][2 * ks + 1][1]); pk.u[3] = pack2(s[g][2 * ks + 1][2], s[g][2 * ks + 1][3]);
                    pb[g][ks] = pk.v;
                }
            }
#pragma unroll
            for (int ks = 0; ks < 2; ++ks)
#pragma unroll
                for (int t = 0; t < 4; ++t) {
                    union { bf16x8 v; u32x2 h2[2]; } va;
                    va.h2[0] = *(const u32x2*)(Vs + (t * 16 + fr) * 64 + ((((2 * ks) * 2 + (fq >> 1)) ^ sw) * 8) + (fq & 1) * 4);
                    va.h2[1] = *(const u32x2*)(Vs + (t * 16 + fr) * 64 + ((((2 * ks + 1) * 2 + (fq >> 1)) ^ sw) * 8) + (fq & 1) * 4);
#pragma unroll
                    for (int g = 0; g < 2; ++g) O[i][g][t] = mfma16(va.v, pb[g][ks], O[i][g][t]);
                }
        }
    }
    RAW_BARRIER();
#pragma unroll
    for (int g = 0; g < 2; ++g) {
        float l0 = lsum[0][g], l1 = lsum[1][g];
        l0 += shx(l0, 16); l0 += shx(l0, 32);
        l1 += shx(l1, 16); l1 += shx(l1, 32);
        const float i0 = 1.f / l0, i1 = lam / l1;
        float o[4][4]; float ss = 0.f;
#pragma unroll
        for (int t = 0; t < 4; ++t)
#pragma unroll
            for (int j = 0; j < 4; ++j) { o[t][j] = O[0][g][t][j] * i0 - O[1][g][t][j] * i1; ss += o[t][j] * o[t][j]; }
        ss += shx(ss, 16); ss += shx(ss, 32);
        const float rs = rsqrtf(ss * (1.f / 64.f) + EPSF) * (1.f - lam_init);
        const int row = rowbase + w * 32 + g * 16 + fr;
#pragma unroll
        for (int t = 0; t < 4; ++t) {
            const int dv = t * 16 + fq * 4;
            const float4 hn = *(const float4*)(p.head_norm + (l * 4 + 3) * 256 + h * 64 + dv);
            u32x2 pk; pk.x = pack2(o[t][0] * rs * hn.x, o[t][1] * rs * hn.y); pk.y = pack2(o[t][2] * rs * hn.z, o[t][3] * rs * hn.w);
            *(u32x2*)(p.ybuf + (size_t)row * 1024 + 768 + h * 64 + dv) = pk;
        }
    }
}

template <int PART>
DEV void phase_outputs(const P& p, int l, int bid, int nb, unsigned char* sm) {
    if (PART != 2) {
    const int nq = 64 + (l == 0 ? 2 : 0);
    int* qctr = p.cnt + 64 + l * 8;
    volatile int* slot = (volatile int*)(sm + 3 * ATT_STAGE_ELEMS * 2);
    const int x0 = (int)(xb_xcc_id() & 7u);
    for (int a = 0; a < 8; ++a) {
        const int bh = (x0 + a) & 7;
        for (;;) {
            if (tidx() == 0) *slot = atomicAdd(qctr + bh, 1);
            __syncthreads();
            const int qt = *slot;
            __syncthreads();
            if (qt >= nq) break;
            const int b = bh >> 2, h = bh & 3;
            if (qt < 64) attn_unit(p, l, b, h, CTXL + qt * 128, KPOS, b * SEQ + qt * 128, (u16*)sm);
            else attn_unit(p, l, b, h, (qt - 64) * 128, CTXL, RLAT + b * CTXL + (qt - 64) * 128, (u16*)sm);
        }
    }
    }
    __builtin_amdgcn_sched_barrier(0);
    if (PART != 1)
    for (int v = bid; v < 3 * 1056; v += nb) {
        const int mix = v / 1056, r = v % 1056, g = r >> 2, h = r & 3;
        if (l == 1 && (g % NSTEP) < 4) continue;
        if (mix == 0) { PRB_BEGIN(131); gla_phaseC(p, l, g, h, sm); PRB_END(131); }
        else if (mix == 1) { PRB_BEGIN(132); ml_phaseC(p, l, g, h, sm); PRB_END(132); }
        else { PRB_BEGIN(133); gd_phaseC(p, l, g, h, sm); PRB_END(133); }
    }
}
#define LDS_BYTES 75776
#ifndef MULTI
#define MULTI 0
#endif
#ifndef STAGE
#define STAGE 99
#endif

enum { PH_PRO0 = 0, PH_PRO1, PH_NORM1, PH_INPROJ, PH_PREP, PH_CHUNKA, PH_SCAN, PH_OUT, PH_GATES, PH_MERGE1, PH_MERGE2, PH_ROUTER, PH_MOEUP, PH_MOEDOWN, PH_FINAL, PH_OUTC };

struct KArgs { const float* in[25]; float* out; unsigned char* ws; };
constexpr size_t al256c(size_t x) { return (x + 255) & ~(size_t)255; }
struct WsOff {
    size_t Wd, Wt2, bar, cnt, zero_end, modp, mod, xctx, rope, hbuf, ybuf, Wt, dq, dk, dvT, glaDec, mlN, mlFE, mlAE, mlM, glaS, mlS, gdM, gdN, gdQ, gdO, cols, total;
};
constexpr WsOff make_off() {
    WsOff o{}; size_t c = 0;
    const size_t nst = (size_t)2 * 2 * NSTEP * 4;
    o.bar = c; c = al256c(c + XCD_BAR_WORDS * 4);
    o.cnt = c; c = al256c(c + 1024);
    o.zero_end = c;
    o.modp = c; c = al256c(c + (size_t)2 * 16 * 3 * 6144 * 4);
    o.mod = c; c = al256c(c + (size_t)2 * 3 * 6144 * 4);
    o.xctx = c; c = al256c(c + (size_t)RCTX * DM * 4);
    o.rope = c; c = al256c(c + (size_t)192 * 8 * 2 * 4);
    o.hbuf = c; c = al256c(c + (size_t)RTOT * DM * 2);
    o.ybuf = c; c = al256c(c + (size_t)RTOT * DM * 2);
    o.Wt = c; c = al256c(c + (size_t)WT_TOTAL * 2);
    o.dq = c; c = al256c(c + (size_t)8 * KPOS * 64 * 2);
    o.dk = c; c = al256c(c + (size_t)8 * KPOS * 64 * 2);
    o.dvT = c; c = al256c(c + (size_t)8 * KPOS * 64 * 2);
    o.glaDec = c; c = al256c(c + nst * 64 * 4);
    o.mlN = c; c = al256c(c + nst * 64 * 4);
    o.mlFE = c; c = al256c(c + nst * 4);
    o.mlAE = c; c = al256c(c + nst * 4);
    o.mlM = c; c = al256c(c + nst * 4);
    o.glaS = c; c = al256c(c + nst * 4096 * 2);
    o.mlS = c; c = al256c(c + nst * 4096 * 2);
    o.gdM = c; c = al256c(c + nst * 4096 * 2);
    o.gdN = c; c = al256c(c + nst * 4096 * 2);
    o.gdQ = c; c = al256c(c + nst * 4096 * 2);
    o.gdO = c; c = al256c(c + nst * 4096 * 2);
    o.cols = c; c = al256c(c + (size_t)RTOT * NGATE * 2);
    o.Wd = c; c = al256c(c + (size_t)16 * 1024 * 512 * 2);
    o.Wt2 = c; c = al256c(c + (size_t)WT_TOTAL * 2);
    o.total = c;
    return o;
}
constexpr WsOff WSO = make_off();
template <class T> DEV T* launder_p(T* v) {
    __attribute__((address_space(1))) T* g = (__attribute__((address_space(1))) T*)v;
    asm volatile("" : "+s"(g));
    return (T*)g;
}
DEV P build_P(const KArgs& ka) {
    P p;
    const float* in[25];
#pragma unroll
    for (int i = 0; i < 25; ++i) in[i] = launder_p(ka.in[i]);
    p.x = in[0]; p.c = in[1]; p.ctx = in[2]; p.c_ctx = in[3]; p.w_mod = in[4]; p.b_mod = in[5]; p.norm_mix = in[6]; p.norm_ffn = in[7];
    p.w_in = in[8]; p.gla_a2 = in[9]; p.gla_ab = in[10]; p.mlstm_gate_b = in[11]; p.gdn_conv = in[12]; p.gdn_a_log = in[13];
    p.gdn_dt_bias = in[14]; p.diff_lambda = in[15]; p.head_norm = in[16]; p.w_branch = in[17]; p.w_out = in[18]; p.router_w = in[19];
    p.router_b = in[20]; p.w_gate = in[21]; p.w_up = in[22]; p.w_down = in[23]; p.norm_final = in[24];
    p.out = launder_p(ka.out);
    unsigned char* ws = launder_p(ka.ws);
    p.bar = (unsigned*)(ws + WSO.bar); p.cnt = (int*)(ws + WSO.cnt); p.modp = (float*)(ws + WSO.modp); p.mod = (float*)(ws + WSO.mod);
    p.xctx = (float*)(ws + WSO.xctx); p.rope = (float*)(ws + WSO.rope); p.hbuf = (u16*)(ws + WSO.hbuf); p.ybuf = (u16*)(ws + WSO.ybuf);
    p.Wt = (u16*)(ws + WSO.Wt); p.dq = (u16*)(ws + WSO.dq); p.dk = (u16*)(ws + WSO.dk); p.dvT = (u16*)(ws + WSO.dvT);
    p.glaDec = (float*)(ws + WSO.glaDec); p.mlN = (float*)(ws + WSO.mlN); p.mlFE = (float*)(ws + WSO.mlFE); p.mlAE = (float*)(ws + WSO.mlAE);
    p.mlM = (float*)(ws + WSO.mlM); p.glaS = (u16*)(ws + WSO.glaS); p.mlS = (u16*)(ws + WSO.mlS); p.gdM = (u16*)(ws + WSO.gdM);
    p.gdN = (u16*)(ws + WSO.gdN); p.gdQ = (u16*)(ws + WSO.gdQ); p.gdO = (u16*)(ws + WSO.gdO); p.cols = (u16*)(ws + WSO.cols); p.Wd = (u16*)(ws + WSO.Wd);
    return p;
}

template <int PH>
DEV void run_phase(const KArgs& ka, int l, int bid_, int nb_, unsigned char* sm) {
    P p = build_P(ka);
    u16* const Wt2 = (u16*)(launder_p(ka.ws) + WSO.Wt2);
    if (l == 1) p.Wt = Wt2;
    const int bid = launder_s(bid_), nb = launder_s(nb_);
    u16* gqkv = p.ybuf;
    u16* ubuf = p.glaS;
    const int mtiles = l == 0 ? 132 : 128;
    if (PH == PH_PRO0) { phase_conv_mixw(p, p.Wt, 0, bid, nb, 0, (float*)sm); phase_mod_partial(p, bid, nb, (float*)sm); phase_rope_table(p, bid, nb); }
    else if (PH == PH_PRO1) phase_mod_reduce(p, bid, nb);
    else if (PH == PH_NORM1) phase_norm1(p, l, bid, nb);
    else if (PH == PH_INPROJ) phase_inproj<false>(p, 0, 31, NCM, 66, bid, nb, (u16*)sm);
    else if (PH == PH_PREP) phase_prep(p, l, gqkv, bid, nb, (u16*)sm);
    else if (PH == PH_CHUNKA) phase_chunkA(p, l, gqkv, bid, nb, sm);
    else if (PH == PH_SCAN) {
        phase_scan(p, bid, nb, (u16*)sm);
        phase_conv_moed(p, l, bid, nb, nb > 340 ? 276 : 0, (float*)sm);
        if (l == 0) phase_conv_mixw(p, Wt2, 1, bid, nb, nb > 340 ? 276 : 0, (float*)sm);
    }
#ifdef PROBE_SPLIT
    else if (PH == PH_OUT) phase_outputs<1>(p, l, bid, nb, sm);
    else if (PH == PH_OUTC) phase_outputs<2>(p, l, bid, nb, sm);
#else
    else if (PH == PH_OUT) phase_outputs<0>(p, l, bid, nb, sm);
#endif
    else if (PH == PH_GATES) phase_inproj<true>(p, 3968, 32, NGATE, mtiles / 2, bid, nb, (u16*)sm);
    else if (PH == PH_MERGE1) phase_merge1(p, ubuf, mtiles, bid, nb, (u16*)sm);
    else if (PH == PH_MERGE2) { if (l == 0) phase_merge2s(p, l, ubuf, mtiles, bid, nb, (u16*)sm); else phase_merge2(p, l, ubuf, mtiles, bid, nb, (u16*)sm); }
    else if (PH == PH_ROUTER) {
        { PRB_BEGIN(110); phase_norm2_router(p, l, l == 0 ? RTOT : RLAT, bid, nb, (float*)sm); PRB_END(110); }
        { PRB_BEGIN(111); phase_conv_moew(p, l, bid, nb, (float*)sm); PRB_END(111); }
    }
    else if (PH == PH_MOEUP) phase_moe_up(p, l, bid, nb, (u16*)sm);
    else if (PH == PH_MOEDOWN) phase_moe_down_s(p, l, bid, nb, (u16*)sm);
    else if (PH == PH_FINAL) phase_final_norm(p, bid, nb);
}

#if MULTI
template <int PH>
__global__ void __launch_bounds__(NTHR, 2) k_phase(KArgs p, int l) {
    extern __shared__ __attribute__((aligned(16))) unsigned char smem[];
    run_phase<PH>(p, l, blockIdx.x, gridDim.x, smem);
}
#else
__global__ void __launch_bounds__(NTHR, 2) k_mega(KArgs p) {
    extern __shared__ __attribute__((aligned(16))) unsigned char smem[];
    volatile LAS unsigned* xbw = (volatile LAS unsigned*)(smem + LDS_BYTES);
    if (tidx() == 0) { xbw[0] = 0u; xbw[1] = 0u; xbw[2] = 0u; xbw[3] = 0u; }
    __syncthreads();
    (void)xcd_barrier_post((unsigned*)(p.ws + WSO.bar), xbw);
    const int bid = blockIdx.x, nb = gridDim.x;
#ifdef PROBE_SEL
    unsigned long long pr_t0 = wall_clock64();
    volatile LAS unsigned long long* pr_acc = (volatile LAS unsigned long long*)(smem + LDS_BYTES + 8);
#ifdef PROBE_CLK
    unsigned long long pr_c0 = __builtin_readcyclecounter();
#define PSTAMP(PH) do { const unsigned long long c_ = __builtin_readcyclecounter(); if ((PH) == PROBE_SEL && threadIdx.x == 0) *pr_acc = *pr_acc + (c_ - pr_c0) / 24ull; pr_c0 = c_; } while (0)
#else
#define PSTAMP(PH) do { const unsigned long long t_ = wall_clock64(); if ((PH) == PROBE_SEL && threadIdx.x == 0) *pr_acc = *pr_acc + (t_ - pr_t0); pr_t0 = t_; } while (0)
#endif
#else
#define PSTAMP(PH) do { } while (0)
#endif
#ifdef PROBE_2BAR
#define GBAR() do { GBAR1(); GBAR1(); } while (0)
#else
#define GBAR() GBAR1()
#endif
#define GBAR1() do { XcdBarrier b_; b_.bar = (unsigned*)(launder_p(p.ws) + WSO.bar); b_.x = xb_xcc_id(); b_.st = (volatile LAS unsigned*)(smem + LDS_BYTES); xcd_barrier(b_); } while (0)
    run_phase<PH_PRO0>(p, 0, bid, nb, smem); GBAR(); PSTAMP(PH_PRO0);
    run_phase<PH_PRO1>(p, 0, bid, nb, smem); GBAR(); PSTAMP(PH_PRO1);
    for (int l = 0; l < 2; ++l) {
        run_phase<PH_NORM1>(p, l, bid, nb, smem); GBAR(); PSTAMP(PH_NORM1);
        run_phase<PH_INPROJ>(p, l, bid, nb, smem); GBAR(); PSTAMP(PH_INPROJ);
#ifdef PROBE_GEMM
        { PRB_BEGIN(200); const P pp = build_P(p); phase_inproj<false, PROBE_GEMM>(pp, 0, 31, NCM, 66, launder_s(bid), launder_s(nb), (u16*)smem); PRB_END(200); } GBAR();
#endif
        run_phase<PH_PREP>(p, l, bid, nb, smem); GBAR(); PSTAMP(PH_PREP);
        run_phase<PH_CHUNKA>(p, l, bid, nb, smem); GBAR(); PSTAMP(PH_CHUNKA);
        run_phase<PH_SCAN>(p, l, bid, nb, smem); GBAR(); PSTAMP(PH_SCAN);
        run_phase<PH_OUT>(p, l, bid, nb, smem); GBAR(); PSTAMP(PH_OUT);
#ifdef PROBE_SPLIT
        run_phase<PH_OUTC>(p, l, bid, nb, smem); GBAR(); PSTAMP(PH_OUTC);
#endif
        run_phase<PH_GATES>(p, l, bid, nb, smem); GBAR(); PSTAMP(PH_GATES);
        run_phase<PH_MERGE1>(p, l, bid, nb, smem); GBAR(); PSTAMP(PH_MERGE1);
        run_phase<PH_MERGE2>(p, l, bid, nb, smem); GBAR(); PSTAMP(PH_MERGE2);
        run_phase<PH_ROUTER>(p, l, bid, nb, smem); GBAR(); PSTAMP(PH_ROUTER);
        run_phase<PH_MOEUP>(p, l, bid, nb, smem); GBAR(); PSTAMP(PH_MOEUP);
        run_phase<PH_MOEDOWN>(p, l, bid, nb, smem); GBAR(); PSTAMP(PH_MOEDOWN);
    }
    run_phase<PH_FINAL>(p, 0, bid, nb, smem);
#ifdef PROBE_SEL
    __syncthreads();
    { const unsigned long long te = wall_clock64(), wt = *pr_acc * 4ull; while (wall_clock64() - te < wt) __builtin_amdgcn_s_sleep(8); }
#endif
}
#endif

static size_t al256(size_t x) { return (x + 255) & ~(size_t)255; }

extern "C" void kernel_launch(void* const* d_in, const int* in_sizes, int n_in, void* d_out, int out_size, void* d_ws, size_t ws_size,
                              hipStream_t stream) {
    (void)in_sizes; (void)n_in; (void)out_size;
    if (ws_size < WSO.total) return;
    KArgs p{};
    for (int i = 0; i < 25; ++i) p.in[i] = (const float*)d_in[i];
    p.out = (float*)d_out;
    p.ws = (unsigned char*)d_ws;
    unsigned char* ws = (unsigned char*)d_ws;
    const size_t zero_bytes = WSO.zero_end;
    hipMemsetAsync(ws, 0, zero_bytes, stream);

    static int grid = 0;
#if MULTI
#define SETUP(PH) hipFuncSetAttribute((const void*)k_phase<PH>, hipFuncAttributeMaxDynamicSharedMemorySize, LDS_BYTES + 16)
    if (!grid) {
        SETUP(PH_PRO0); SETUP(PH_PRO1); SETUP(PH_NORM1); SETUP(PH_INPROJ); SETUP(PH_PREP); SETUP(PH_CHUNKA); SETUP(PH_SCAN); SETUP(PH_OUT);
        SETUP(PH_GATES); SETUP(PH_MERGE1); SETUP(PH_MERGE2); SETUP(PH_ROUTER); SETUP(PH_MOEUP); SETUP(PH_MOEDOWN); SETUP(PH_FINAL);
        grid = 512;
    }
#define LAUNCH(PH, l) k_phase<PH><<<grid, NTHR, LDS_BYTES + 16, stream>>>(p, l)
    LAUNCH(PH_PRO0, 0); LAUNCH(PH_PRO1, 0);
    for (int l = 0; l < 2; ++l) {
        LAUNCH(PH_NORM1, l);
#if STAGE >= 1
        LAUNCH(PH_INPROJ, l); LAUNCH(PH_PREP, l); LAUNCH(PH_CHUNKA, l); LAUNCH(PH_SCAN, l); LAUNCH(PH_OUT, l);
        LAUNCH(PH_GATES, l); LAUNCH(PH_MERGE1, l); LAUNCH(PH_MERGE2, l);
#endif
        LAUNCH(PH_ROUTER, l); LAUNCH(PH_MOEUP, l); LAUNCH(PH_MOEDOWN, l);
    }
    LAUNCH(PH_FINAL, 0);
#else
    if (!grid) {
        hipFuncSetAttribute((const void*)k_mega, hipFuncAttributeMaxDynamicSharedMemorySize, LDS_BYTES + 16);
        int dev = 0, cus = 0, per_cu = 0;
        hipGetDevice(&dev);
        hipDeviceGetAttribute(&cus, hipDeviceAttributeMultiprocessorCount, dev);
        hipOccupancyMaxActiveBlocksPerMultiprocessor(&per_cu, (const void*)k_mega, NTHR, LDS_BYTES + 16);
        if (per_cu > 2) per_cu = 2;
        if (per_cu < 1) per_cu = 1;
        grid = cus * per_cu;
    }
    k_mega<<<grid, NTHR, LDS_BYTES + 16, stream>>>(p);
#endif
}
```

```cpp
#include <hip/hip_runtime.h>
#include <stdint.h>
#include <math.h>

typedef unsigned short u16;
typedef short bf16x8 __attribute__((ext_vector_type(8)));
typedef float f32x4 __attribute__((ext_vector_type(4)));
typedef unsigned u32x2 __attribute__((ext_vector_type(2)));
typedef unsigned u32x4 __attribute__((ext_vector_type(4)));

#define DEV __device__ __forceinline__
#define NTHR 256

#define DM 1024
#define RLAT 16384
#define RCTX 512
#define RTOT 16896
#define SEQ 8192
#define CTXL 256
#define NCM 3968
#define NGATE 4096
#define NSTEP 132
#define KPOS 8448
#define EPSF 1e-6f
#define GLA_Q 0
#define GLA_K 256
#define GLA_V 512
#define GLA_G 768
#define GLA_RF 1024
#define GLA_RB 1040
#define ML_Q 1056
#define ML_K 1312
#define ML_V 1568
#define ML_O 1824
#define ML_GF 2080
#define ML_GB 2088
#define GD_Q 2096
#define GD_K 2352
#define GD_V 2608
#define GD_OG 2864
#define GD_GF 3120
#define GD_GB 3128
#define DF_Q 3136
#define DF_K 3392
#define DF_V 3648

DEV int tidx() { int t = threadIdx.x; asm volatile("" : "+v"(t)); __builtin_assume(t >= 0 && t < NTHR); return t; }
DEV int launder_s(int v) { asm volatile("" : "+s"(v)); return v; }
typedef __bf16 bf2_t __attribute__((ext_vector_type(2)));
typedef float f2_t __attribute__((ext_vector_type(2)));
DEV unsigned pack2(float a, float b) { f2_t v; v.x = a; v.y = b; return __builtin_bit_cast(unsigned, __builtin_convertvector(v, bf2_t)); }
DEV u16 f2bf(float f) { return (u16)(pack2(f, 0.f) & 0xffffu); }
DEV float bf2f(u16 h) { return __uint_as_float(((unsigned)h) << 16); }
DEV float sigm(float x) { return 1.f / (1.f + __expf(-x)); }
DEV float silu(float x) { return x / (1.f + __expf(-x)); }
DEV float logsig(float x) { return fminf(x, 0.f) - __logf(1.f + __expf(-fabsf(x))); }
DEV float softplus(float x) { return fmaxf(x, 0.f) + __logf(1.f + __expf(-fabsf(x))); }
DEV float shx(float v, int o) { return __shfl_xor(v, o, 64); }
DEV float shidx(float v, int src) { return __int_as_float(__builtin_amdgcn_ds_bpermute(src << 2, __float_as_int(v))); }
DEV float shup(float v, int o) { const int l = tidx() & 63; return __int_as_float(__builtin_amdgcn_ds_bpermute((l >= o ? l - o : l) << 2, __float_as_int(v))); }
DEV float wsum(float v) {
    const int l4 = (tidx() & 63) << 2;
#pragma unroll
    for (int o = 32; o; o >>= 1) v += __int_as_float(__builtin_amdgcn_ds_bpermute(l4 ^ (o << 2), __float_as_int(v)));
    return v;
}
DEV float wmaxr(float v) {
    const int l4 = (tidx() & 63) << 2;
#pragma unroll
    for (int o = 32; o; o >>= 1) v = fmaxf(v, __int_as_float(__builtin_amdgcn_ds_bpermute(l4 ^ (o << 2), __float_as_int(v))));
    return v;
}
DEV f32x4 mfma16(bf16x8 a, bf16x8 b, f32x4 c) { return __builtin_amdgcn_mfma_f32_16x16x32_bf16(a, b, c, 0, 0, 0); }

#ifdef PROBE_SEL
#define PRB_BEGIN(id) unsigned long long prb_t0_##id = ((id) == PROBE_SEL) ? wall_clock64() : 0ull
#define PRB_END(id) do { if ((id) == PROBE_SEL) { __syncthreads(); if (threadIdx.x == 0) { volatile __attribute__((address_space(3))) unsigned long long* a_ = (volatile __attribute__((address_space(3))) unsigned long long*)(size_t)(75776 + 8); *a_ = *a_ + (wall_clock64() - prb_t0_##id); } } } while (0)
#else
#define PRB_BEGIN(id) do { } while (0)
#define PRB_END(id) do { } while (0)
#endif
#define RAW_BARRIER() do { asm volatile("s_waitcnt lgkmcnt(0)" ::: "memory"); __builtin_amdgcn_s_barrier(); } while (0)
struct P {
    const float *x, *c, *ctx, *c_ctx, *w_mod, *b_mod, *norm_mix, *norm_ffn, *w_in, *gla_a2, *gla_ab, *mlstm_gate_b,
        *gdn_conv, *gdn_a_log, *gdn_dt_bias, *diff_lambda, *head_norm, *w_branch, *w_out, *router_w, *router_b,
        *w_gate, *w_up, *w_down, *norm_final;
    float* out;
    unsigned* bar;
    int* cnt;
    float* modp;
    float* mod;
    float* xctx;
    float* rope;
    u16* hbuf;
    u16* ybuf;
    u16* Wt;
    u16* dq;
    u16* dk;
    u16* dvT;
    float* glaDec;
    float* mlN;
    float* mlFE;
    float* mlAE;
    float* mlM;
    u16* glaS;
    u16* mlS;
    u16* gdM;
    u16* gdN;
    u16* gdQ;
    u16* gdO;
    u16* cols;
    u16* Wd;
};
#define MOE_WGU_OFF 0
#define MOE_WD_OFF (16u * 1024u * 1024u)
#define MOE_ACT_OFF (MOE_WD_OFF + 16u * 1024u * 512u)
#define MOE_LIST_OFF (MOE_ACT_OFF + 2u * RTOT * 512u)

DEV const float* xrow_in(const P& p, int l, int r) {
    if (l == 0) return r < RLAT ? p.x + (size_t)r * DM : p.ctx + (size_t)(r - RLAT) * DM;
    return r < RLAT ? p.out + (size_t)r * DM : p.xctx + (size_t)(r - RLAT) * DM;
}
DEV float* xrow_out(const P& p, int r) { return r < RLAT ? p.out + (size_t)r * DM : p.xctx + (size_t)(r - RLAT) * DM; }
DEV int modidx(int r) { return r < RLAT ? (r >> 13) : 2; }
DEV int chunk_row0(int b, int dir, int st) {
    if (st < 4) { int c = dir ? 3 - st : st; return RLAT + b * CTXL + c * 64; }
    int c = dir ? 131 - st : st - 4; return b * SEQ + c * 64;
}
DEV size_t state_idx(int dir, int b, int st, int h) { return ((size_t)((dir * 2 + b) * NSTEP + st) * 4 + h); }
#define XB_TMO      128
#define XB_XCNT(j)  (256  + 64 * (j))
#define XB_XSUB(j)  (1280 + 64 * (j))
#define XB_XGEN(j)  (2304 + 64 * (j))
#define XB_TOP      3328
#define XB_TOPGEN   3392
#define XCD_BAR_WORDS 3456
#define XB_SPIN_CAP (1u << 18)
#define LAS __attribute__((address_space(3)))

__device__ __forceinline__ unsigned xb_ld(unsigned* p)              { return __hip_atomic_load(p, __ATOMIC_RELAXED, __HIP_MEMORY_SCOPE_AGENT); }
__device__ __forceinline__ unsigned xb_add(unsigned* p, unsigned v) { return __hip_atomic_fetch_add(p, v, __ATOMIC_RELAXED, __HIP_MEMORY_SCOPE_AGENT); }
__device__ __forceinline__ unsigned xb_xcc_id() { return (unsigned)__builtin_amdgcn_s_getreg((3 << 11) | 20) & 0xFu; }
#define XB_SPIN(cond, bar) do { unsigned _sp = 0; while (cond) { __builtin_amdgcn_s_sleep(1); \
    if ((++_sp & 255u) == 0u) { if (xb_ld(&(bar)[XB_TMO])) break; if (_sp > XB_SPIN_CAP) { atomicAdd(&(bar)[XB_TMO], 1u); break; } } } } while (0)

struct XcdBarrier {
    unsigned* bar; unsigned x;
    volatile LAS unsigned* st;
};

__device__ __forceinline__ XcdBarrier xcd_barrier_post(unsigned* bar, volatile LAS unsigned* st) {
    XcdBarrier b; b.bar = bar; b.x = xb_xcc_id(); b.st = st;
    if (tidx() == 0) (void)xb_add(&bar[XB_XCNT(b.x)], 1u);
    return b;
}
__device__ __forceinline__ void xcd_barrier_complete(unsigned* bar, unsigned x, unsigned& nloc, unsigned& nx) {
    const unsigned G = gridDim.x * gridDim.y * gridDim.z;
    unsigned sum, cnt, mine, sp = 0u;
    for (;;) {
        sum = 0u; cnt = 0u; mine = 0u;
#pragma unroll
        for (unsigned j = 0; j < 16; ++j) { const unsigned c = xb_ld(&bar[XB_XCNT(j)]); sum += c; cnt += (c > 0u) ? 1u : 0u; mine = (j == x) ? c : mine; }
        if (sum == G) break;
        __builtin_amdgcn_s_sleep(1);
        if ((++sp & 255u) == 0u) { if (xb_ld(&bar[XB_TMO])) break; if (sp > XB_SPIN_CAP) { atomicAdd(&bar[XB_TMO], 1u); break; } }
    }
    nloc = mine > 0u ? mine : 1u; nx = cnt > 0u ? cnt : 1u;
}

__device__ __forceinline__ void xcd_barrier(const XcdBarrier& b) {
    asm volatile("s_waitcnt vmcnt(0)" ::: "memory");
    __syncthreads();
    if (tidx() == 0) {
        unsigned* bar = b.bar;
        __builtin_amdgcn_s_waitcnt(0);
        unsigned nloc = b.st[0], nx = b.st[1];
        if (nloc == 0u) { xcd_barrier_complete(bar, b.x, nloc, nx); b.st[0] = nloc; b.st[1] = nx; }
        const unsigned old = xb_add(&bar[XB_XSUB(b.x)], 1u);
        const unsigned gen = old / nloc;
        if (old + 1u == (gen + 1u) * nloc) {
            __builtin_amdgcn_fence(__ATOMIC_RELEASE, "agent");
            asm volatile("s_waitcnt vmcnt(0)" ::: "memory");
            const unsigned og = xb_add(&bar[XB_TOP], 1u);
            const unsigned tg = og / nx;
            if (og + 1u == (tg + 1u) * nx) xb_add(&bar[XB_TOPGEN], 1u);
            else XB_SPIN(xb_ld(&bar[XB_TOPGEN]) == tg, bar);
            __builtin_amdgcn_fence(__ATOMIC_ACQUIRE, "agent");
            xb_add(&bar[XB_XGEN(b.x)], 1u);
            asm volatile("s_waitcnt vmcnt(0)" ::: "memory");
        } else {
            XB_SPIN(xb_ld(&bar[XB_XGEN(b.x)]) == gen, bar);
            __builtin_amdgcn_fence(__ATOMIC_ACQUIRE, "agent");
            asm volatile("s_waitcnt vmcnt(0)" ::: "memory");
        }
    }
    __syncthreads();
}
struct TrJob { const float* src; u16* dst; int lds_, ldd, map; };
DEV int tr_rowmap(int map, int n) {
    if (map == 1) return n < 3904 ? n : n + 64;
    if (map == 2) return (n >> 5) * 64 + (n & 31);
    if (map == 3) return (n >> 5) * 64 + 32 + (n & 31);
    return n;
}
struct TrRegs { f32x4 r0, r1, r2, r3; };
DEV void tr_load(const TrJob& j, TrRegs& q) {
    const int t = tidx(), n4 = (t & 15) * 4, kp = t >> 4;
    const float* s0 = j.src + (size_t)(2 * kp) * j.lds_ + n4;
    const float* s1 = j.src + (size_t)(2 * (kp + 16)) * j.lds_ + n4;
    q.r0 = *(const f32x4*)s0; q.r1 = *(const f32x4*)(s0 + j.lds_);
    q.r2 = *(const f32x4*)s1; q.r3 = *(const f32x4*)(s1 + j.lds_);
}
DEV void tr_finish(const TrJob& j, int n0, const TrRegs& q, float* smf) {
    unsigned* sm = (unsigned*)smf;
    const int t = tidx();
    {
        const int n4 = (t & 15) * 4, kp = t >> 4;
        sm[(n4 + 0) * 33 + kp] = pack2(q.r0[0], q.r1[0]); sm[(n4 + 1) * 33 + kp] = pack2(q.r0[1], q.r1[1]);
        sm[(n4 + 2) * 33 + kp] = pack2(q.r0[2], q.r1[2]); sm[(n4 + 3) * 33 + kp] = pack2(q.r0[3], q.r1[3]);
        sm[(n4 + 0) * 33 + kp + 16] = pack2(q.r2[0], q.r3[0]); sm[(n4 + 1) * 33 + kp + 16] = pack2(q.r2[1], q.r3[1]);
        sm[(n4 + 2) * 33 + kp + 16] = pack2(q.r2[2], q.r3[2]); sm[(n4 + 3) * 33 + kp + 16] = pack2(q.r2[3], q.r3[3]);
    }
    __syncthreads();
    {
        const int n = t >> 2, kq = (t & 3) * 8;
        u32x4 o0, o1;
        o0.x = sm[n * 33 + kq + 0]; o0.y = sm[n * 33 + kq + 1]; o0.z = sm[n * 33 + kq + 2]; o0.w = sm[n * 33 + kq + 3];
        o1.x = sm[n * 33 + kq + 4]; o1.y = sm[n * 33 + kq + 5]; o1.z = sm[n * 33 + kq + 6]; o1.w = sm[n * 33 + kq + 7];
        u16* d = j.dst + (size_t)tr_rowmap(j.map, n0 + n) * j.ldd + kq * 2;
        *(u32x4*)d = o0; *(u32x4*)(d + 8) = o1;
    }
    __syncthreads();
}
#define WT_WB_OFF (8064u * 1024u)
#define WT_WO_OFF (WT_WB_OFF + 4u * 1024u * 256u)
#define WT_TOTAL (WT_WO_OFF + 1024u * 1024u)

DEV TrJob mixw_job(const P& p, u16* Wb, int l, int u, int& n0) {
    TrJob j;
    if (u < 2000) {
        const int kt = u / 125, nt = u % 125; n0 = nt * 64;
        j.src = p.w_in + (size_t)l * 1024 * 8000 + (size_t)kt * 64 * 8000 + n0; j.lds_ = 8000; j.dst = Wb + kt * 64; j.ldd = 1024; j.map = 1;
    } else if (u < 2256) {
        const int v = u - 2000, i = v >> 6, w = v & 63, kt = w >> 4, nt = w & 15; n0 = nt * 64;
        j.src = p.w_branch + (size_t)(l * 4 + i) * 256 * 1024 + (size_t)kt * 64 * 1024 + n0; j.lds_ = 1024;
        j.dst = Wb + WT_WB_OFF + (size_t)i * 1024 * 256 + kt * 64; j.ldd = 256; j.map = 0;
    } else {
        const int v = u - 2256, kt = v >> 4, nt = v & 15; n0 = nt * 64;
        j.src = p.w_out + (size_t)l * 1024 * 1024 + (size_t)kt * 64 * 1024 + n0; j.lds_ = 1024; j.dst = Wb + WT_WO_OFF + kt * 64; j.ldd = 1024; j.map = 0;
    }
    return j;
}
DEV void phase_conv_mixw(const P& p, u16* Wb, int l, int bid, int nb, int b0, float* sm) {
    if (bid < b0) return;
    const int step = nb - b0;
    if (bid == nb - 1) {
        unsigned* z = (unsigned*)(Wb + (size_t)3904 * 1024);
        for (int i = tidx(); i < 64 * 1024 / 2; i += NTHR) z[i] = 0u;
    }
    int u = bid - b0, n0 = 0, n1 = 0;
    if (u >= 2512) return;
    TrRegs r;
    TrJob j = mixw_job(p, Wb, l, u, n0);
    tr_load(j, r);
    for (;;) {
        const int un = u + step;
        TrRegs rn; TrJob jn = j;
        if (un < 2512) { jn = mixw_job(p, Wb, l, un, n1); tr_load(jn, rn); }
        tr_finish(j, n0, r, sm);
        if (un >= 2512) break;
        u = un; j = jn; n0 = n1; r = rn;
    }
}
DEV TrJob moew_job(const P& p, int l, int u, int& n0) {
    TrJob j;
    u16* wgu = p.cols + MOE_WGU_OFF;
    const int e = u >> 8, v = u & 255;
    const size_t le = (size_t)(l * 16 + e);
    const int w = v & 127, kt = w >> 3, nt = w & 7; n0 = nt * 64;
    j.src = (v < 128 ? p.w_gate : p.w_up) + le * 1024 * 512 + (size_t)kt * 64 * 512 + n0; j.lds_ = 512;
    j.dst = wgu + (size_t)e * 1024 * 1024 + kt * 64; j.ldd = 1024; j.map = v < 128 ? 2 : 3;
    return j;
}
DEV TrJob moed_job(const P& p, int l, int u, int& n0) {
    TrJob j;
    const int e = u >> 7, w = u & 127, kt = w >> 4, nt = w & 15; n0 = nt * 64;
    const size_t le = (size_t)(l * 16 + e);
    j.src = p.w_down + le * 512 * 1024 + (size_t)kt * 64 * 1024 + n0; j.lds_ = 1024; j.dst = p.Wd + (size_t)e * 1024 * 512 + kt * 64; j.ldd = 512; j.map = 0;
    return j;
}
DEV void phase_conv_moed(const P& p, int l, int bid, int nb, int b0, float* sm) {
    if (bid < b0) return;
    const int step = nb - b0;
    int u = bid - b0, n0 = 0, n1 = 0;
    if (u >= 16 * 128) return;
    TrRegs r;
    TrJob j = moed_job(p, l, u, n0);
    tr_load(j, r);
    for (;;) {
        const int un = u + step;
        TrRegs rn; TrJob jn = j;
        if (un < 16 * 128) { jn = moed_job(p, l, un, n1); tr_load(jn, rn); }
        tr_finish(j, n0, r, sm);
        if (un >= 16 * 128) break;
        u = un; j = jn; n0 = n1; r = rn;
    }
}
DEV void phase_conv_moew(const P& p, int l, int bid, int nb, float* sm) {
    int u = bid, n0 = 0, n1 = 0;
    if (u >= 16 * 256) return;
    TrRegs r;
    TrJob j = moew_job(p, l, u, n0);
    tr_load(j, r);
    for (;;) {
        const int un = u + nb;
        TrRegs rn; TrJob jn = j;
        if (un < 16 * 256) { jn = moew_job(p, l, un, n1); tr_load(jn, rn); }
        tr_finish(j, n0, r, sm);
        if (un >= 16 * 256) break;
        u = un; j = jn; n0 = n1; r = rn;
    }
}

DEV void phase_mod_partial(const P& p, int bid, int nb, float* sm) {
    for (int u = bid; u < 768; u += nb) {
        const int l = u / 384, v = u % 384, kc = v / 24, jb = v % 24;
        const int t = tidx();
        __syncthreads();
        if (t < 192) {
            const int m = t >> 6, k = kc * 64 + (t & 63);
            const float cv = m < 2 ? p.c[m * 1024 + k] : p.c_ctx[k];
            sm[t] = silu(cv);
        }
        __syncthreads();
        const int j = jb * 256 + t;
        const float* w = p.w_mod + ((size_t)l * 1024 + kc * 64) * 6144 + j;
        float a0 = 0.f, a1 = 0.f, a2 = 0.f;
#pragma unroll 8
        for (int k = 0; k < 64; ++k) {
            const float wv = w[(size_t)k * 6144];
            a0 += sm[k] * wv; a1 += sm[64 + k] * wv; a2 += sm[128 + k] * wv;
        }
        float* o = p.modp + ((size_t)(l * 16 + kc) * 3) * 6144 + j;
        o[0] = a0; o[6144] = a1; o[2 * 6144] = a2;
    }
}
DEV void phase_mod_reduce(const P& p, int bid, int nb) {
    for (int i = bid * NTHR + tidx(); i < 2 * 3 * 6144; i += nb * NTHR) {
        const int l = i / (3 * 6144), r = i % (3 * 6144), m = r / 6144, j = r % 6144;
        float a = p.b_mod[l * 6144 + j];
        for (int kc = 0; kc < 16; ++kc) a += p.modp[((size_t)(l * 16 + kc) * 3 + m) * 6144 + j];
        p.mod[i] = a;
    }
}

DEV void moe_combine_row(const P& p, int l, int r, int lane, float4 (&v)[4]);
DEV void phase_norm1(const P& p, int l, int bid, int nb) {
    const int lane = tidx() & 63, w = tidx() >> 6;
    for (int r0 = (bid * 4 + w) * 2; r0 < RTOT; r0 += nb * 8) {
        f32x4 v[2][4];
#pragma unroll
        for (int q = 0; q < 2; ++q) {
            const float* xr = xrow_in(p, l, r0 + q);
#pragma unroll
            for (int i = 0; i < 4; ++i) v[q][i] = *(const f32x4*)(xr + lane * 4 + i * 256);
        }
#pragma unroll
        for (int q = 0; q < 2; ++q) {
            const int r = r0 + q;
            const int m = modidx(r);
            const float* sh = p.mod + ((size_t)(l * 3 + m)) * 6144;
            const float* sc = sh + 1024;
            float4 t[4];
#pragma unroll
            for (int i = 0; i < 4; ++i) { t[i].x = v[q][i][0]; t[i].y = v[q][i][1]; t[i].z = v[q][i][2]; t[i].w = v[q][i][3]; }
            if (l == 1) {
                moe_combine_row(p, 0, r, lane, t);
                float* xw = xrow_out(p, r);
#pragma unroll
                for (int i = 0; i < 4; ++i) *(float4*)(xw + lane * 4 + i * 256) = t[i];
            }
            float ss = 0.f;
#pragma unroll
            for (int i = 0; i < 4; ++i) ss += t[i].x * t[i].x + t[i].y * t[i].y + t[i].z * t[i].z + t[i].w * t[i].w;
            ss = wsum(ss);
            const float rs = rsqrtf(ss * (1.f / 1024.f) + EPSF);
#pragma unroll
            for (int i = 0; i < 4; ++i) {
                const int c = lane * 4 + i * 256;
                const float4 g = *(const float4*)(p.norm_mix + l * 1024 + c);
                const float4 s1 = *(const float4*)(sc + c);
                const float4 h1 = *(const float4*)(sh + c);
                const float o0 = t[i].x * rs * g.x * (1.f + s1.x) + h1.x;
                const float o1 = t[i].y * rs * g.y * (1.f + s1.y) + h1.y;
                const float o2 = t[i].z * rs * g.z * (1.f + s1.z) + h1.z;
                const float o3 = t[i].w * rs * g.w * (1.f + s1.w) + h1.w;
                u32x2 pk; pk.x = pack2(o0, o1); pk.y = pack2(o2, o3);
                *(u32x2*)(p.hbuf + (size_t)r * 1024 + c) = pk;
            }
        }
    }
}

#define LDP 72
#define GEMM_STAGE (2 * 128 * 64)
DEV int g_row(int tid, int i) { return (tid >> 6) * 32 + i * 8 + ((tid >> 3) & 7); }
DEV int g_kc(int tid, int row) { return ((tid & 7) ^ ((row >> 1) & 7)) * 8; }
DEV void gemm_mainloop(f32x4 (&acc)[4][4], const u16* const (&xp)[4], const u16* const (&wp)[4], int KT, u16* sm, u16*  ) {
    const int tid = tidx(), lane = tid & 63, w = tid >> 6, wn = w & 1, wm = w >> 1;
    const int fr = lane & 15, fq = lane >> 4, sw = (fr >> 1) & 7;
    asm volatile("s_waitcnt vmcnt(0)" ::: "memory");
#pragma unroll
    for (int i = 0; i < 4; ++i) {
        __builtin_amdgcn_global_load_lds((const unsigned*)xp[i], (unsigned*)(sm + (w * 4 + i) * 512), 16, 0, 0);
        __builtin_amdgcn_global_load_lds((const unsigned*)wp[i], (unsigned*)(sm + 128 * 64 + (w * 4 + i) * 512), 16, 0, 0);
    }
    for (int kt = 0; kt < KT; ++kt) {
        asm volatile("s_waitcnt vmcnt(0)" ::: "memory");
        RAW_BARRIER();
        if (kt + 1 < KT) {
            u16* nx = sm + ((kt + 1) & 1) * GEMM_STAGE;
#pragma unroll
            for (int i = 0; i < 4; ++i) {
                __builtin_amdgcn_global_load_lds((const unsigned*)(xp[i] + (kt + 1) * 64), (unsigned*)(nx + (w * 4 + i) * 512), 16, 0, 0);
                __builtin_amdgcn_global_load_lds((const unsigned*)(wp[i] + (kt + 1) * 64), (unsigned*)(nx + 128 * 64 + (w * 4 + i) * 512), 16, 0, 0);
            }
        }
        const u16* sX = sm + (kt & 1) * GEMM_STAGE;
        const u16* sW = sX + 128 * 64;
#pragma unroll
        for (int ks = 0; ks < 2; ++ks) {
            bf16x8 a[4], b[4];
#pragma unroll
            for (int q = 0; q < 4; ++q) {
                a[q] = *(const bf16x8*)(sW + (wn * 64 + q * 16 + fr) * 64 + (((ks * 4 + fq) ^ sw) * 8));
                b[q] = *(const bf16x8*)(sX + (wm * 64 + q * 16 + fr) * 64 + (((ks * 4 + fq) ^ sw) * 8));
            }
#pragma unroll
            for (int nt = 0; nt < 4; ++nt)
#pragma unroll
                for (int mt = 0; mt < 4; ++mt) acc[nt][mt] = mfma16(a[nt], b[mt], acc[nt][mt]);
        }
    }
    RAW_BARRIER();
}
DEV void zero_acc(f32x4 (&acc)[4][4]) {
#pragma unroll
    for (int a = 0; a < 4; ++a)
#pragma unroll
        for (int b = 0; b < 4; ++b) acc[a][b] = f32x4{0.f, 0.f, 0.f, 0.f};
}

#define GB_STAGE (384 * 32)
DEV void gemmb_issue(const u16* const (&xp)[4], const u16* const (&wp)[2], int kt, u16* stg, int w) {
#pragma unroll
    for (int i = 0; i < 4; ++i) __builtin_amdgcn_global_load_lds((const unsigned*)(xp[i] + kt * 32), (unsigned*)(stg + (w * 4 + i) * 512), 16, 0, 0);
#pragma unroll
    for (int i = 0; i < 2; ++i) __builtin_amdgcn_global_load_lds((const unsigned*)(wp[i] + kt * 32), (unsigned*)(stg + 256 * 32 + (w * 2 + i) * 512), 16, 0, 0);
}
DEV void gemmB_lane(int i, int nrow_pieces_per_wave, int& row, int& chunk) {
    const int t = tidx(), l = t & 63, w = t >> 6;
    row = (w * nrow_pieces_per_wave + i) * 16 + (l >> 2);
    chunk = ((l & 3) ^ ((l >> 4) & 3)) * 8;
}
DEV void gemmB_mainloop(f32x4 (&acc)[4][8], const u16* xb, const unsigned (&xo)[4], const u16* wb, const unsigned (&wo)[2], int KT, u16* sm) {
    const int tid = tidx(), lane = tid & 63, w = tid >> 6, wn = w & 1, wm = w >> 1, fr = lane & 15, fq = lane >> 4;
    const int sw = (fr >> 2) & 3;
    const int aoff = (wn * 64 + fr) * 32 + ((fq ^ sw) * 8) + 256 * 32;
    const int boff = (wm * 128 + fr) * 32 + ((fq ^ sw) * 8);
#pragma unroll
    for (int a = 0; a < 4; ++a)
#pragma unroll
        for (int b = 0; b < 8; ++b) acc[a][b] = f32x4{0.f, 0.f, 0.f, 0.f};
    asm volatile("s_waitcnt vmcnt(0)" ::: "memory");
#pragma unroll
    for (int t0 = 0; t0 < 2; ++t0) {
#pragma unroll
        for (int i = 0; i < 4; ++i) __builtin_amdgcn_global_load_lds((const unsigned*)(xb + xo[i] + t0 * 32), (unsigned*)(sm + t0 * GB_STAGE + (w * 4 + i) * 512), 16, 0, 0);
#pragma unroll
        for (int i = 0; i < 2; ++i) __builtin_amdgcn_global_load_lds((const unsigned*)(wb + wo[i] + t0 * 32), (unsigned*)(sm + t0 * GB_STAGE + 256 * 32 + (w * 2 + i) * 512), 16, 0, 0);
    }
    asm volatile("s_waitcnt vmcnt(6)" ::: "memory");
    RAW_BARRIER();
    bf16x8 a[4], b[8];
#pragma unroll
    for (int q = 0; q < 4; ++q) a[q] = *(const bf16x8*)(sm + aoff + q * 512);
#pragma unroll
    for (int q = 0; q < 8; ++q) b[q] = *(const bf16x8*)(sm + boff + q * 512);
    for (int kt = 0; kt < KT; ++kt) {
        asm volatile("s_waitcnt vmcnt(0)" ::: "memory");
        RAW_BARRIER();
        const bool more = kt + 2 < KT, nxt = kt + 1 < KT;
        u16* nx = sm + ((kt + 2) % 3) * GB_STAGE;
        const u16* cur = sm + ((kt + 1) % 3) * GB_STAGE;
#pragma unroll
        for (int h = 0; h < 2; ++h) {
            if (more) {
                __builtin_amdgcn_global_load_lds((const unsigned*)(xb + (kt + 2) * 32 + xo[2 * h]), (unsigned*)(nx + (w * 4 + 2 * h) * 512), 16, 0, 0);
                __builtin_amdgcn_global_load_lds((const unsigned*)(xb + (kt + 2) * 32 + xo[2 * h + 1]), (unsigned*)(nx + (w * 4 + 2 * h + 1) * 512), 16, 0, 0);
                __builtin_amdgcn_global_load_lds((const unsigned*)(wb + (kt + 2) * 32 + wo[h]), (unsigned*)(nx + 256 * 32 + (w * 2 + h) * 512), 16, 0, 0);
            }
#pragma unroll
            for (int nt = 0; nt < 4; ++nt) {
#pragma unroll
                for (int mt = 0; mt < 4; ++mt) acc[nt][4 * h + mt] = mfma16(a[nt], b[4 * h + mt], acc[nt][4 * h + mt]);
                if (h == 1 && nxt) a[nt] = *(const bf16x8*)(cur + aoff + nt * 512);
            }
            __builtin_amdgcn_sched_barrier(0);
            if (nxt) {
#pragma unroll
                for (int mt = 0; mt < 4; ++mt) b[4 * h + mt] = *(const bf16x8*)(cur + boff + (4 * h + mt) * 512);
            }
        }
    }
    RAW_BARRIER();
}

template <bool SIG, int GMODE = 0>
DEV void phase_inproj(const P& p, int wrow0, int ntn, int ldc, int mtiles256, int bid, int nb, u16* sm) {
    for (int u = bid; u < mtiles256 * ntn; u += nb) {
        const int mt_ = u / ntn, nt_ = u % ntn;
        const int m0 = mt_ * 256, n0 = nt_ * 128;
        unsigned xo[4], wo[2];
#pragma unroll
        for (int i = 0; i < 4; ++i) { int row, ch; gemmB_lane(i, 4, row, ch); xo[i] = (unsigned)(row * 1024 + ch); }
#pragma unroll
        for (int i = 0; i < 2; ++i) { int row, ch; gemmB_lane(i, 2, row, ch); wo[i] = (unsigned)(row * 1024 + ch); }
        f32x4 acc[4][8];
        gemmB_mainloop(acc, p.hbuf + (size_t)m0 * 1024, xo, p.Wt + (size_t)(wrow0 + n0) * 1024, wo, 32, sm);
        const int t2 = tidx(), l2 = t2 & 63, w2 = t2 >> 6;
        const int en = n0 + (w2 & 1) * 64 + (l2 >> 4) * 4, em = m0 + (w2 >> 1) * 128 + (l2 & 15);
#pragma unroll
        for (int nt = 0; nt < 4; ++nt)
#pragma unroll
            for (int mt = 0; mt < 8; ++mt) {
                const int n = en + nt * 16, m = em + mt * 16;
                f32x4 v = acc[nt][mt];
                if (SIG) { v[0] = sigm(v[0]); v[1] = sigm(v[1]); v[2] = sigm(v[2]); v[3] = sigm(v[3]); }
                u32x2 pk; pk.x = pack2(v[0], v[1]); pk.y = pack2(v[2], v[3]);
                *(u32x2*)(p.cols + (size_t)m * ldc + n) = pk;
            }
    }
}

DEV void phase_merge1(const P& p, u16* ubuf, int mtiles, int bid, int nb, u16* sm) {
    for (int u = bid; u < mtiles * 8; u += nb) {
        const int tid = tidx(), lane = tid & 63, w = tid >> 6, wn = w & 1, wm = w >> 1, fr = lane & 15, fq = lane >> 4, sw = (fr >> 1) & 7;
        const int mt_ = u >> 3, nt_ = u & 7;
        const int m0 = mt_ * 128, n0 = nt_ * 128;
        const u16* xp[4]; const u16* wp[4];
#pragma unroll
        for (int i = 0; i < 4; ++i) {
            const int row = g_row(tid, i), kc = g_kc(tid, row);
            xp[i] = p.ybuf + (size_t)(m0 + row) * 1024 + kc;
            wp[i] = p.Wt + WT_WB_OFF + (size_t)(n0 + row) * 256 + kc;
        }
        const u16* gbase = p.cols + (size_t)(m0 + wm * 64 + fr) * NGATE + n0 + wn * 64 + fq * 4;
        f32x4 tot[4][4], acc[4][4]; zero_acc(tot); zero_acc(acc);
        u32x2 gt[4][4];
        asm volatile("s_waitcnt vmcnt(0)" ::: "memory");
#pragma unroll
        for (int i = 0; i < 4; ++i) {
            __builtin_amdgcn_global_load_lds((const unsigned*)xp[i], (unsigned*)(sm + (w * 4 + i) * 512), 16, 0, 0);
            __builtin_amdgcn_global_load_lds((const unsigned*)wp[i], (unsigned*)(sm + 128 * 64 + (w * 4 + i) * 512), 16, 0, 0);
        }
        for (int kt = 0; kt < 16; ++kt) {
            asm volatile("s_waitcnt vmcnt(0)" ::: "memory");
            RAW_BARRIER();
            if (kt + 1 < 16) {
                u16* nx = sm + ((kt + 1) & 1) * GEMM_STAGE;
                const int wof = ((kt + 1) >> 2) * 262144 + ((kt + 1) & 3) * 64;
#pragma unroll
                for (int i = 0; i < 4; ++i) {
                    __builtin_amdgcn_global_load_lds((const unsigned*)(xp[i] + (kt + 1) * 64), (unsigned*)(nx + (w * 4 + i) * 512), 16, 0, 0);
                    __builtin_amdgcn_global_load_lds((const unsigned*)(wp[i] + wof), (unsigned*)(nx + 128 * 64 + (w * 4 + i) * 512), 16, 0, 0);
                }
            }
            if ((kt & 3) == 0) {
                const int br = kt >> 2;
#pragma unroll
                for (int nt = 0; nt < 4; ++nt)
#pragma unroll
                    for (int mt = 0; mt < 4; ++mt) gt[nt][mt] = *(const u32x2*)(gbase + (size_t)mt * 16 * NGATE + nt * 16 + br * 1024);
            }
            const u16* sX = sm + (kt & 1) * GEMM_STAGE;
            const u16* sW = sX + 128 * 64;
#pragma unroll
            for (int ks = 0; ks < 2; ++ks) {
                bf16x8 a[4], b[4];
#pragma unroll
                for (int q = 0; q < 4; ++q) {
                    a[q] = *(const bf16x8*)(sW + (wn * 64 + q * 16 + fr) * 64 + (((ks * 4 + fq) ^ sw) * 8));
                    b[q] = *(const bf16x8*)(sX + (wm * 64 + q * 16 + fr) * 64 + (((ks * 4 + fq) ^ sw) * 8));
                }
#pragma unroll
                for (int nt = 0; nt < 4; ++nt)
#pragma unroll
                    for (int mt = 0; mt < 4; ++mt) acc[nt][mt] = mfma16(a[nt], b[mt], acc[nt][mt]);
            }
            if ((kt & 3) == 3) {
#pragma unroll
                for (int nt = 0; nt < 4; ++nt)
#pragma unroll
                    for (int mt = 0; mt < 4; ++mt) {
                        const u32x2 g = gt[nt][mt];
                        tot[nt][mt][0] += __uint_as_float(g.x << 16) * acc[nt][mt][0];
                        tot[nt][mt][1] += __uint_as_float(g.x & 0xffff0000u) * acc[nt][mt][1];
                        tot[nt][mt][2] += __uint_as_float(g.y << 16) * acc[nt][mt][2];
                        tot[nt][mt][3] += __uint_as_float(g.y & 0xffff0000u) * acc[nt][mt][3];
                        acc[nt][mt] = f32x4{0.f, 0.f, 0.f, 0.f};
                    }
            }
        }
        RAW_BARRIER();
#pragma unroll
        for (int nt = 0; nt < 4; ++nt)
#pragma unroll
            for (int mt = 0; mt < 4; ++mt) {
                const int n = n0 + wn * 64 + nt * 16 + fq * 4, m = m0 + wm * 64 + mt * 16 + fr;
                u32x2 pk; pk.x = pack2(tot[nt][mt][0], tot[nt][mt][1]); pk.y = pack2(tot[nt][mt][2], tot[nt][mt][3]);
                *(u32x2*)(ubuf + (size_t)m * 1024 + n) = pk;
            }
    }
}

DEV void phase_merge2(const P& p, int l, const u16* ubuf, int mtiles, int bid, int nb, u16* sm) {
    const int mt256 = mtiles / 2;
    for (int u = bid; u < mt256 * 8; u += nb) {
        const int mt_ = u >> 3, nt_ = u & 7;
        const int m0 = mt_ * 256, n0 = nt_ * 128;
        unsigned xo[4], wo[2];
#pragma unroll
        for (int i = 0; i < 4; ++i) { int row, ch; gemmB_lane(i, 4, row, ch); xo[i] = (unsigned)(row * 1024 + ch); }
#pragma unroll
        for (int i = 0; i < 2; ++i) { int row, ch; gemmB_lane(i, 2, row, ch); wo[i] = (unsigned)(row * 1024 + ch); }
        f32x4 acc[4][8];
        gemmB_mainloop(acc, ubuf + (size_t)m0 * 1024, xo, p.Wt + WT_WO_OFF + (size_t)n0 * 1024, wo, 32, sm);
        const int t2 = tidx(), l2 = t2 & 63, w2 = t2 >> 6;
        const int en = n0 + (w2 & 1) * 64 + (l2 >> 4) * 4, em = m0 + (w2 >> 1) * 128 + (l2 & 15);
#pragma unroll
        for (int mt = 0; mt < 8; ++mt) {
            const int m = em + mt * 16;
            const float* xi = xrow_in(p, l, m);
            float* xw = xrow_out(p, m);
            const float* g1 = p.mod + (size_t)(l * 3 + modidx(m)) * 6144 + 2048;
#pragma unroll
            for (int nt = 0; nt < 4; ++nt) {
                const int n = en + nt * 16;
                const float4 xo4 = *(const float4*)(xi + n);
                const float4 g = *(const float4*)(g1 + n);
                float4 o;
                o.x = xo4.x + g.x * acc[nt][mt][0]; o.y = xo4.y + g.y * acc[nt][mt][1];
                o.z = xo4.z + g.z * acc[nt][mt][2]; o.w = xo4.w + g.w * acc[nt][mt][3];
                *(float4*)(xw + n) = o;
            }
        }
    }
}

DEV void phase_merge2s(const P& p, int l, const u16* ubuf, int mtiles, int bid, int nb, u16* sm) {
    u16* sX = sm; u16* sW = sm + 128 * LDP;
    const int tid = tidx(), lane = tid & 63, w = tid >> 6, wn = w & 1, wm = w >> 1, fr = lane & 15, fq = lane >> 4;
    for (int u = bid; u < mtiles * 8; u += nb) {
        const int mt_ = u >> 3, nt_ = u & 7;
        const int m0 = mt_ * 128, n0 = nt_ * 128;
        const int tu = tidx();
        const u16* xp[4]; const u16* wp[4];
#pragma unroll
        for (int i = 0; i < 4; ++i) {
            const int row = g_row(tu, i), kc = g_kc(tu, row);
            xp[i] = ubuf + (size_t)(m0 + row) * 1024 + kc;
            wp[i] = p.Wt + WT_WO_OFF + (size_t)(n0 + row) * 1024 + kc;
        }
        f32x4 acc[4][4]; zero_acc(acc);
        gemm_mainloop(acc, xp, wp, 16, sX, sW);
#pragma unroll
        for (int nt = 0; nt < 4; ++nt)
#pragma unroll
            for (int mt = 0; mt < 4; ++mt) {
                const int n = n0 + wn * 64 + nt * 16 + fq * 4, m = m0 + wm * 64 + mt * 16 + fr;
                const float4 xo = *(const float4*)(xrow_in(p, l, m) + n);
                const float4 g = *(const float4*)(p.mod + (size_t)(l * 3 + modidx(m)) * 6144 + 2048 + n);
                float4 o;
                o.x = xo.x + g.x * acc[nt][mt][0]; o.y = xo.y + g.y * acc[nt][mt][1];
                o.z = xo.z + g.z * acc[nt][mt][2]; o.w = xo.w + g.w * acc[nt][mt][3];
                *(float4*)(xrow_out(p, m) + n) = o;
            }
    }
}
DEV void phase_norm2_router(const P& p, int l, int nrows, int bid, int nb, float* sm) {
    const int tid = tidx(), lane = tid & 63, w = tid >> 6;
    int* list = (int*)(p.cols + MOE_LIST_OFF);
    float* slotw = (float*)(list + 16 * RTOT);
    int* tokslot = (int*)(slotw + 16 * RTOT);
    float* tokw = (float*)(tokslot + 2 * RTOT);
    int* lcnt = (int*)(sm + 16 * 1024);
    int* rinfo = lcnt + 32;
    float* rwgt = (float*)(rinfo + 4 * 40 * 2);
#pragma unroll 16
    for (int i = tid; i < 16 * 1024; i += NTHR) { const int c = i >> 4, e = i & 15; sm[e * 1024 + c] = p.router_w[i]; }
    if (tid < 32) lcnt[tid] = 0;
    __syncthreads();
    int kk = 0;
    for (int r = bid * 4 + w; r < nrows; r += nb * 4, ++kk) {
        const float* xr = xrow_out(p, r);
        const int m = modidx(r);
        const float* sh = p.mod + ((size_t)(l * 3 + m)) * 6144 + 3072;
        const float* sc = sh + 1024;
        float4 v[4]; float ss = 0.f;
#pragma unroll
        for (int i = 0; i < 4; ++i) {
            v[i] = *(const float4*)(xr + lane * 4 + i * 256);
            ss += v[i].x * v[i].x + v[i].y * v[i].y + v[i].z * v[i].z + v[i].w * v[i].w;
        }
        ss = wsum(ss);
        const float rs = rsqrtf(ss * (1.f / 1024.f) + EPSF);
#pragma unroll
        for (int i = 0; i < 4; ++i) {
            const int c = lane * 4 + i * 256;
            const float4 g = *(const float4*)(p.norm_ffn + l * 1024 + c);
            const float4 s1 = *(const float4*)(sc + c);
            const float4 h1 = *(const float4*)(sh + c);
            v[i].x = v[i].x * rs * g.x * (1.f + s1.x) + h1.x;
            v[i].y = v[i].y * rs * g.y * (1.f + s1.y) + h1.y;
            v[i].z = v[i].z * rs * g.z * (1.f + s1.z) + h1.z;
            v[i].w = v[i].w * rs * g.w * (1.f + s1.w) + h1.w;
            u32x2 pk; pk.x = pack2(v[i].x, v[i].y); pk.y = pack2(v[i].z, v[i].w);
            *(u32x2*)(p.hbuf + (size_t)r * 1024 + c) = pk;
        }
        float sel[16], scr[16];
#pragma unroll
        for (int e = 0; e < 16; ++e) scr[e] = 0.f;
#pragma unroll
        for (int i = 0; i < 4; ++i) {
#pragma unroll
            for (int e = 0; e < 16; ++e) {
                const float4 rw = *(const float4*)(sm + e * 1024 + lane * 4 + i * 256);
                scr[e] += v[i].x * rw.x + v[i].y * rw.y + v[i].z * rw.z + v[i].w * rw.w;
            }
            __builtin_amdgcn_sched_barrier(0);
        }
#pragma unroll
        for (int e = 0; e < 16; ++e) {
            const float a = wsum(scr[e]);
            scr[e] = sigm(a);
            sel[e] = scr[e] + p.router_b[e];
        }
        int bg = 0; float bgs = -INFINITY;
#pragma unroll
        for (int g = 0; g < 4; ++g) {
            float m1 = -INFINITY, m2 = -INFINITY;
#pragma unroll
            for (int j = 0; j < 4; ++j) {
                const float s = sel[g * 4 + j];
                if (s > m1) { m2 = m1; m1 = s; } else if (s > m2) { m2 = s; }
            }
            const float gs = m1 + m2;
            if (gs > bgs) { bgs = gs; bg = g; }
        }
        float gsel[4], gscr[4];
#pragma unroll
        for (int j = 0; j < 4; ++j) { gsel[j] = -INFINITY; gscr[j] = 0.f; }
#pragma unroll
        for (int g = 0; g < 4; ++g)
#pragma unroll
            for (int j = 0; j < 4; ++j) if (bg == g) { gsel[j] = sel[g * 4 + j]; gscr[j] = scr[g * 4 + j]; }
        int j1 = 0; float v1 = gsel[0], w1 = gscr[0];
#pragma unroll
        for (int j = 1; j < 4; ++j) if (gsel[j] > v1) { v1 = gsel[j]; w1 = gscr[j]; j1 = j; }
        int j2 = -1; float v2 = -INFINITY, w2 = 0.f;
#pragma unroll
        for (int j = 0; j < 4; ++j) if (j != j1 && (j2 < 0 || gsel[j] > v2)) { v2 = gsel[j]; w2 = gscr[j]; j2 = j; }
        const float inv = 1.f / (w1 + w2);
        if (lane == 0) {
            const int e1 = bg * 4 + j1, e2 = bg * 4 + j2;
            const int p1 = atomicAdd(lcnt + e1, 1);
            const int p2 = atomicAdd(lcnt + e2, 1);
            rinfo[(w * 40 + kk) * 2 + 0] = e1 * 65536 + p1; rwgt[(w * 40 + kk) * 2 + 0] = w1 * inv;
            rinfo[(w * 40 + kk) * 2 + 1] = e2 * 65536 + p2; rwgt[(w * 40 + kk) * 2 + 1] = w2 * inv;
        }
    }
    __syncthreads();
    if (tid < 16) lcnt[16 + tid] = lcnt[tid] ? atomicAdd(p.cnt + l * 16 + tid, lcnt[tid]) : 0;
    __syncthreads();
    if (lane < 2) {
        int k2 = 0;
        for (int r = bid * 4 + w; r < nrows; r += nb * 4, ++k2) {
            const int inf = rinfo[(w * 40 + k2) * 2 + lane], e = inf >> 16, slot = lcnt[16 + e] + (inf & 65535);
            const float wg = rwgt[(w * 40 + k2) * 2 + lane];
            list[e * RTOT + slot] = r; slotw[e * RTOT + slot] = wg;
            tokslot[r * 2 + lane] = e * RTOT + slot; tokw[r * 2 + lane] = wg;
        }
    }
    __syncthreads();
}

DEV bool moe_find(const int* cnt, int ut, int& e, int& mt, int& off, int& ce) {
    int tb = 0, o = 0;
    for (int k = 0; k < 16; ++k) {
        const int c = cnt[k], nt = (c + 255) >> 8;
        if (ut < tb + nt) { e = k; mt = ut - tb; off = o; ce = c; return true; }
        tb += nt; o += c;
    }
    return false;
}

DEV bool moe_find128(const int* cnt, int ut, int& e, int& mt, int& off, int& ce) {
    int tb = 0, o = 0;
    for (int k = 0; k < 16; ++k) {
        const int c = cnt[k], nt = (c + 127) >> 7;
        if (ut < tb + nt) { e = k; mt = ut - tb; off = o; ce = c; return true; }
        tb += nt; o += c;
    }
    return false;
}

DEV void phase_moe_up_s(const P& p, int l, int bid, int nb, u16* sm) {
    u16* sX = sm; u16* sW = sm + 128 * LDP;
    const int tid = tidx(), lane = tid & 63, w = tid >> 6, wn = w & 1, wm = w >> 1, fr = lane & 15, fq = lane >> 4;
    const int* cnt = p.cnt + l * 16;
    const int* list = (const int*)(p.cols + MOE_LIST_OFF);
    const u16* wgu = p.cols + MOE_WGU_OFF;
    u16* act = p.cols + MOE_ACT_OFF;
    for (int u = bid;; u += nb) {
        int e, mtile, off, ce;
        if (!moe_find128(cnt, u >> 3, e, mtile, off, ce)) break;
        const int n0 = (u & 7) * 128;
        const int tu = tidx();
        const u16* xp[4]; const u16* wp[4];
#pragma unroll
        for (int i = 0; i < 4; ++i) {
            const int row = g_row(tu, i), kc = g_kc(tu, row);
            int s = mtile * 128 + row; s = s < ce ? s : ce - 1;
            const int tok = list[e * RTOT + s];
            xp[i] = p.hbuf + (size_t)tok * 1024 + kc;
            wp[i] = wgu + ((size_t)e * 1024 + n0 + row) * 1024 + kc;
        }
        f32x4 acc[4][4]; zero_acc(acc);
        gemm_mainloop(acc, xp, wp, 16, sX, sW);
#pragma unroll
        for (int nt = 0; nt < 2; ++nt)
#pragma unroll
            for (int mt = 0; mt < 4; ++mt) {
                const int col = ((n0 >> 6) + wn) * 32 + nt * 16 + fq * 4;
                const int s = mtile * 128 + wm * 64 + mt * 16 + fr;
                if (s < ce) {
                    const f32x4 g = acc[nt][mt], uu = acc[nt + 2][mt];
                    u32x2 pk; pk.x = pack2(silu(g[0]) * uu[0], silu(g[1]) * uu[1]); pk.y = pack2(silu(g[2]) * uu[2], silu(g[3]) * uu[3]);
                    *(u32x2*)(act + (size_t)(off + s) * 512 + col) = pk;
                }
            }
    }
}

DEV void phase_moe_down_s(const P& p, int l, int bid, int nb, u16* sm) {
    u16* sX = sm; u16* sW = sm + 128 * LDP;
    const int tid = tidx(), lane = tid & 63, w = tid >> 6, wn = w & 1, wm = w >> 1, fr = lane & 15, fq = lane >> 4;
    const int* cnt = p.cnt + l * 16;
    const int* list = (const int*)(p.cols + MOE_LIST_OFF);
    u16* yslot = p.glaS;
    const u16* wd = p.Wd;
    const u16* act = p.cols + MOE_ACT_OFF;
    for (int u = bid;; u += nb) {
        int e, mtile, off, ce;
        if (!moe_find128(cnt, u >> 3, e, mtile, off, ce)) break;
        const int n0 = (u & 7) * 128;
        const int tu = tidx();
        const u16* xp[4]; const u16* wp[4];
#pragma unroll
        for (int i = 0; i < 4; ++i) {
            const int row = g_row(tu, i), kc = g_kc(tu, row);
            int s = mtile * 128 + row; s = s < ce ? s : ce - 1;
            xp[i] = act + (size_t)(off + s) * 512 + kc;
            wp[i] = wd + ((size_t)e * 1024 + n0 + row) * 512 + kc;
        }
        f32x4 acc[4][4]; zero_acc(acc);
        gemm_mainloop(acc, xp, wp, 8, sX, sW);
#pragma unroll
        for (int mt = 0; mt < 4; ++mt) {
            const int s = mtile * 128 + wm * 64 + mt * 16 + fr;
            if (s < ce) {
#pragma unroll
                for (int nt = 0; nt < 4; ++nt) {
                    const int n = n0 + wn * 64 + nt * 16 + fq * 4;
                    u32x2 pk; pk.x = pack2(acc[nt][mt][0], acc[nt][mt][1]); pk.y = pack2(acc[nt][mt][2], acc[nt][mt][3]);
                    *(u32x2*)(yslot + (size_t)(off + s) * 1024 + n) = pk;
                }
            }
        }
    }
}

DEV void phase_moe_up(const P& p, int l, int bid, int nb, u16* sm) {
    const int* cnt = p.cnt + l * 16;
    const int* list = (const int*)(p.cols + MOE_LIST_OFF);
    const u16* wgu = p.cols + MOE_WGU_OFF;
    u16* act = p.cols + MOE_ACT_OFF;
    for (int u = bid;; u += nb) {
        int e, mtile, off, ce;
        if (!moe_find(cnt, u >> 3, e, mtile, off, ce)) break;
        const int n0 = (u & 7) * 128;
        unsigned xo[4], wo[2];
#pragma unroll
        for (int i = 0; i < 4; ++i) {
            int row, ch; gemmB_lane(i, 4, row, ch);
            int s = mtile * 256 + row; s = s < ce ? s : ce - 1;
            xo[i] = (unsigned)(list[e * RTOT + s] * 1024 + ch);
        }
#pragma unroll
        for (int i = 0; i < 2; ++i) { int row, ch; gemmB_lane(i, 2, row, ch); wo[i] = (unsigned)(row * 1024 + ch); }
        f32x4 acc[4][8];
        gemmB_mainloop(acc, p.hbuf, xo, wgu + ((size_t)e * 1024 + n0) * 1024, wo, 32, sm);
        const int t2 = tidx(), l2 = t2 & 63, w2 = t2 >> 6;
        const int col0 = ((n0 >> 6) + (w2 & 1)) * 32 + (l2 >> 4) * 4, sb = mtile * 256 + (w2 >> 1) * 128 + (l2 & 15);
#pragma unroll
        for (int nt = 0; nt < 2; ++nt)
#pragma unroll
            for (int mt = 0; mt < 8; ++mt) {
                const int s = sb + mt * 16;
                if (s < ce) {
                    const f32x4 g = acc[nt][mt], uu = acc[nt + 2][mt];
                    u32x2 pk; pk.x = pack2(silu(g[0]) * uu[0], silu(g[1]) * uu[1]); pk.y = pack2(silu(g[2]) * uu[2], silu(g[3]) * uu[3]);
                    *(u32x2*)(act + (size_t)(off + s) * 512 + col0 + nt * 16) = pk;
                }
            }
    }
}

DEV void phase_moe_down(const P& p, int l, int bid, int nb, u16* sm) {
    const int* cnt = p.cnt + l * 16;
    u16* yslot = p.glaS;
    const u16* wd = p.Wd;
    const u16* act = p.cols + MOE_ACT_OFF;
    for (int u = bid;; u += nb) {
        int e, mtile, off, ce;
        if (!moe_find(cnt, u >> 3, e, mtile, off, ce)) break;
        const int n0 = (u & 7) * 128;
        unsigned xo[4], wo[2];
#pragma unroll
        for (int i = 0; i < 4; ++i) {
            int row, ch; gemmB_lane(i, 4, row, ch);
            int s = mtile * 256 + row; s = s < ce ? s : ce - 1;
            xo[i] = (unsigned)((off + s) * 512 + ch);
        }
#pragma unroll
        for (int i = 0; i < 2; ++i) { int row, ch; gemmB_lane(i, 2, row, ch); wo[i] = (unsigned)(row * 512 + ch); }
        f32x4 acc[4][8];
        gemmB_mainloop(acc, act, xo, wd + ((size_t)e * 1024 + n0) * 512, wo, 16, sm);
        const int t2 = tidx(), l2 = t2 & 63, w2 = t2 >> 6;
        const int en = n0 + (w2 & 1) * 64 + (l2 >> 4) * 4, sb = mtile * 256 + (w2 >> 1) * 128 + (l2 & 15);
#pragma unroll
        for (int mt = 0; mt < 8; ++mt) {
            const int s = sb + mt * 16;
            if (s < ce) {
#pragma unroll
                for (int nt = 0; nt < 4; ++nt) {
                    u32x2 pk; pk.x = pack2(acc[nt][mt][0], acc[nt][mt][1]); pk.y = pack2(acc[nt][mt][2], acc[nt][mt][3]);
                    *(u32x2*)(yslot + (size_t)(off + s) * 1024 + en + nt * 16) = pk;
                }
            }
        }
    }
}

DEV void moe_combine_row(const P& p, int l, int r, int lane, float4 (&v)[4]) {
    const int* cnt = p.cnt + l * 16;
    const int* list = (const int*)(p.cols + MOE_LIST_OFF);
    const int* tokslot = (const int*)((const float*)(list + 16 * RTOT) + 16 * RTOT);
    const float* tokw = (const float*)(tokslot + 2 * RTOT);
    const u16* yslot = p.glaS;
    const float* g2 = p.mod + (size_t)(l * 3 + modidx(r)) * 6144 + 5120;
#pragma unroll
    for (int j = 0; j < 2; ++j) {
        const int ts = tokslot[r * 2 + j], e = ts / RTOT, slot = ts % RTOT;
        const float wg = tokw[r * 2 + j];
        int off = 0;
        for (int k = 0; k < e; ++k) off += cnt[k];
        const u16* yr = yslot + (size_t)(off + slot) * 1024;
#pragma unroll
        for (int i = 0; i < 4; ++i) {
            const int c = lane * 4 + i * 256;
            const u32x2 yv = *(const u32x2*)(yr + c);
            const float4 g = *(const float4*)(g2 + c);
            v[i].x += g.x * wg * __uint_as_float(yv.x << 16); v[i].y += g.y * wg * __uint_as_float(yv.x & 0xffff0000u);
            v[i].z += g.z * wg * __uint_as_float(yv.y << 16); v[i].w += g.w * wg * __uint_as_float(yv.y & 0xffff0000u);
        }
    }
}

DEV void phase_final_norm(const P& p, int bid, int nb) {
    const int lane = tidx() & 63, w = tidx() >> 6;
    for (int r = bid * 4 + w; r < RLAT; r += nb * 4) {
        float* xr = p.out + (size_t)r * DM;
        float4 v[4]; float ss = 0.f;
#pragma unroll
        for (int i = 0; i < 4; ++i) v[i] = *(const float4*)(xr + lane * 4 + i * 256);
        moe_combine_row(p, 1, r, lane, v);
#pragma unroll
        for (int i = 0; i < 4; ++i) ss += v[i].x * v[i].x + v[i].y * v[i].y + v[i].z * v[i].z + v[i].w * v[i].w;
        ss = wsum(ss);
        const float rs = rsqrtf(ss * (1.f / 1024.f) + EPSF);
#pragma unroll
        for (int i = 0; i < 4; ++i) {
            const int c = lane * 4 + i * 256;
            const float4 g = *(const float4*)(p.norm_final + c);
            float4 o; o.x = v[i].x * rs * g.x; o.y = v[i].y * rs * g.y; o.z = v[i].z * rs * g.z; o.w = v[i].w * rs * g.w;
            *(float4*)(xr + c) = o;
        }
    }
}
DEV float wscan_add(float v, int lane) {
#pragma unroll
    for (int o = 1; o < 64; o <<= 1) { const float t = shup(v, o); if (lane >= o) v += t; }
    return v;
}
DEV float wscan_max(float v, int lane) {
#pragma unroll
    for (int o = 1; o < 64; o <<= 1) { const float t = shup(v, o); if (lane >= o) v = fmaxf(v, t); }
    return v;
}
DEV void mm64(f32x4 (&acc)[4], const u16* A, int lda, const u16* Bt, int ldb) {
    const int lane = tidx() & 63, w = tidx() >> 6, fr = lane & 15, fq = lane >> 4;
#pragma unroll
    for (int ks = 0; ks < 2; ++ks) {
        const bf16x8 a = *(const bf16x8*)(A + (16 * w + fr) * lda + ks * 32 + fq * 8);
#pragma unroll
        for (int nt = 0; nt < 4; ++nt) {
            const bf16x8 b = *(const bf16x8*)(Bt + (nt * 16 + fr) * ldb + ks * 32 + fq * 8);
            acc[nt] = mfma16(a, b, acc[nt]);
        }
    }
}
DEV void mm64_pre(f32x4 (&acc)[4], const u16* A, int lda, const bf16x8 (&bf)[2][4]) {
    const int lane = tidx() & 63, w = tidx() >> 6, fr = lane & 15, fq = lane >> 4;
#pragma unroll
    for (int ks = 0; ks < 2; ++ks) {
        const bf16x8 a = *(const bf16x8*)(A + (16 * w + fr) * lda + ks * 32 + fq * 8);
#pragma unroll
        for (int nt = 0; nt < 4; ++nt) acc[nt] = mfma16(a, bf[ks][nt], acc[nt]);
    }
}
DEV void ldB64(bf16x8 (&bf)[2][4], const u16* Bt) {
    const int lane = tidx() & 63, fr = lane & 15, fq = lane >> 4;
#pragma unroll
    for (int ks = 0; ks < 2; ++ks)
#pragma unroll
        for (int nt = 0; nt < 4; ++nt) bf[ks][nt] = *(const bf16x8*)(Bt + (nt * 16 + fr) * 64 + ks * 32 + fq * 8);
}
struct Raw16 { u32x4 a, b; };
DEV Raw16 ldraw16(const u16* p) { Raw16 r; r.a = *(const u32x4*)p; r.b = *(const u32x4*)(p + 8); return r; }
DEV void unraw16(const Raw16& r, float (&o)[16]) {
    const unsigned w[8] = {r.a.x, r.a.y, r.a.z, r.a.w, r.b.x, r.b.y, r.b.z, r.b.w};
#pragma unroll
    for (int i = 0; i < 8; ++i) { o[2 * i] = __uint_as_float(w[i] << 16); o[2 * i + 1] = __uint_as_float(w[i] & 0xffff0000u); }
}
DEV void zero4(f32x4 (&acc)[4]) {
#pragma unroll
    for (int i = 0; i < 4; ++i) acc[i] = f32x4{0.f, 0.f, 0.f, 0.f};
}
DEV void ld16bf(const u16* p, float (&o)[16]) {
    const u32x4 a = *(const u32x4*)p, b = *(const u32x4*)(p + 8);
    const unsigned w[8] = {a.x, a.y, a.z, a.w, b.x, b.y, b.z, b.w};
#pragma unroll
    for (int i = 0; i < 8; ++i) { o[2 * i] = __uint_as_float(w[i] << 16); o[2 * i + 1] = __uint_as_float(w[i] & 0xffff0000u); }
}
DEV void st16bf(u16* p, const float (&v)[16]) {
    u32x4 a, b;
    a.x = pack2(v[0], v[1]); a.y = pack2(v[2], v[3]); a.z = pack2(v[4], v[5]); a.w = pack2(v[6], v[7]);
    b.x = pack2(v[8], v[9]); b.y = pack2(v[10], v[11]); b.z = pack2(v[12], v[13]); b.w = pack2(v[14], v[15]);
    *(u32x4*)p = a; *(u32x4*)(p + 8) = b;
}

DEV void phase_rope_table(const P& p, int bid, int nb) {
    for (int i = bid * NTHR + tidx(); i < 192 * 8; i += nb * NTHR) {
        const int e = i >> 3, f = i & 7;
        const float inv = expf(-(float)(2 * f) * (1.f / 16.f) * 9.210340371976184f);
        const float pos = (float)(e < 128 ? e : e - 128);
        const float ang = pos * inv;
        p.rope[2 * i] = cosf(ang); p.rope[2 * i + 1] = sinf(ang);
    }
}
DEV void phase_prep(const P& p, int l, u16* gqkv, int bid, int nb, u16* sm) {
    const int tid = tidx();
    for (int g = bid; g < 264; g += nb) {
        int b, t0, r0, T, pos0;
        if (g < 256) { b = g >> 7; t0 = (g & 127) * 64; r0 = b * SEQ + t0; T = SEQ; pos0 = CTXL + t0; }
        else { const int q = g - 256; b = q >> 2; t0 = (q & 3) * 64; r0 = RLAT + b * CTXL + t0; T = CTXL; pos0 = t0; }
        for (int k = 0; k < 24; ++k) {
            const int id = tid + 256 * k, cg = id % 96, s = id / 96, r = r0 + s, t = t0 + s;
            float a[8];
#pragma unroll
            for (int i = 0; i < 8; ++i) a[i] = 0.f;
#pragma unroll
            for (int j = 0; j < 5; ++j) {
                const int tt = t + j - 2;
                if (tt >= 0 && tt < T) {
                    const u32x4 xv = *(const u32x4*)(p.cols + (size_t)(r + j - 2) * NCM + GD_Q + cg * 8);
                    const float4 w0 = *(const float4*)(p.gdn_conv + (l * 5 + j) * 768 + cg * 8);
                    const float4 w1 = *(const float4*)(p.gdn_conv + (l * 5 + j) * 768 + cg * 8 + 4);
                    a[0] += __uint_as_float(xv.x << 16) * w0.x; a[1] += __uint_as_float(xv.x & 0xffff0000u) * w0.y;
                    a[2] += __uint_as_float(xv.y << 16) * w0.z; a[3] += __uint_as_float(xv.y & 0xffff0000u) * w0.w;
                    a[4] += __uint_as_float(xv.z << 16) * w1.x; a[5] += __uint_as_float(xv.z & 0xffff0000u) * w1.y;
                    a[6] += __uint_as_float(xv.w << 16) * w1.z; a[7] += __uint_as_float(xv.w & 0xffff0000u) * w1.w;
                }
            }
            float ss = 0.f;
#pragma unroll
            for (int i = 0; i < 8; ++i) { a[i] = silu(a[i]); ss += a[i] * a[i]; }
            ss += shx(ss, 1); ss += shx(ss, 2); ss += shx(ss, 4);
            float sc = 1.f;
            if (cg < 64) sc = rsqrtf(ss + EPSF) * (cg < 32 ? 0.125f : 1.f);
            u32x4 o;
            o.x = pack2(a[0] * sc, a[1] * sc); o.y = pack2(a[2] * sc, a[3] * sc); o.z = pack2(a[4] * sc, a[5] * sc); o.w = pack2(a[6] * sc, a[7] * sc);
            *(u32x4*)(gqkv + (size_t)r * 768 + cg * 8) = o;
        }
        for (int k = 0; k < 8; ++k) {
            const int id = tid + 256 * k, c = id & 1, half = (id >> 1) & 1, h = (id >> 2) & 3, qk = (id >> 4) & 1, s = id >> 5;
            const int r = r0 + s, t = t0 + s;
            const u16* src = p.cols + (size_t)r * NCM + (qk ? DF_K : DF_Q) + h * 64 + half * 32 + c * 8;
            const u32x4 v1 = *(const u32x4*)src, v2 = *(const u32x4*)(src + 16);
            const unsigned w1[4] = {v1.x, v1.y, v1.z, v1.w}, w2[4] = {v2.x, v2.y, v2.z, v2.w};
            float x1[8], x2[8], o1[8], o2[8];
#pragma unroll
            for (int i = 0; i < 4; ++i) {
                x1[2 * i] = __uint_as_float(w1[i] << 16); x1[2 * i + 1] = __uint_as_float(w1[i] & 0xffff0000u);
                x2[2 * i] = __uint_as_float(w2[i] << 16); x2[2 * i + 1] = __uint_as_float(w2[i] & 0xffff0000u);
            }
            const float qs = qk ? 1.f : (0.17677669529663687f * 1.4426950408889634f);
            if (g < 256) {
                const float* tb = p.rope + (size_t)(c == 0 ? (t >> 6) : 128 + (t & 63)) * 16;
#pragma unroll
                for (int i = 0; i < 8; ++i) {
                    const float cs = tb[2 * i], sn = tb[2 * i + 1];
                    o1[i] = (x1[i] * cs - x2[i] * sn) * qs; o2[i] = (x1[i] * sn + x2[i] * cs) * qs;
                }
            } else {
#pragma unroll
                for (int i = 0; i < 8; ++i) { o1[i] = x1[i] * qs; o2[i] = x2[i] * qs; }
            }
            u16* dst = (qk ? p.dk : p.dq) + ((size_t)(b * 4 + h) * KPOS + pos0 + s) * 64 + half * 32 + c * 8;
            u32x4 a1, a2;
            a1.x = pack2(o1[0], o1[1]); a1.y = pack2(o1[2], o1[3]); a1.z = pack2(o1[4], o1[5]); a1.w = pack2(o1[6], o1[7]);
            a2.x = pack2(o2[0], o2[1]); a2.y = pack2(o2[2], o2[3]); a2.z = pack2(o2[4], o2[5]); a2.w = pack2(o2[6], o2[7]);
            *(u32x4*)dst = a1; *(u32x4*)(dst + 16) = a2;
        }
        for (int h = 0; h < 4; ++h) {
            __syncthreads();
            {
                const int s = tid >> 2, dg = tid & 3;
                const u32x4 a = *(const u32x4*)(p.cols + (size_t)(r0 + s) * NCM + DF_V + h * 64 + dg * 16);
                const u32x4 c = *(const u32x4*)(p.cols + (size_t)(r0 + s) * NCM + DF_V + h * 64 + dg * 16 + 8);
                const unsigned wv[8] = {a.x, a.y, a.z, a.w, c.x, c.y, c.z, c.w};
#pragma unroll
                for (int k = 0; k < 8; ++k) {
                    sm[(dg * 16 + 2 * k) * 72 + s] = (u16)(wv[k] & 0xffff);
                    sm[(dg * 16 + 2 * k + 1) * 72 + s] = (u16)(wv[k] >> 16);
                }
            }
            __syncthreads();
            {
                const int dv = tid >> 2, sg = tid & 3;
                const u32x4 a = *(const u32x4*)(sm + dv * 72 + sg * 16);
                const u32x4 c = *(const u32x4*)(sm + dv * 72 + sg * 16 + 8);
                u16* o = p.dvT + ((size_t)(b * 4 + h) * 64 + dv) * KPOS + pos0 + sg * 16;
                *(u32x4*)o = a; *(u32x4*)(o + 8) = c;
            }
        }
        __syncthreads();
    }
}
#define TILE_B (64 * LDP * 2)

DEV void gla_cum(const P& p, int l, int dir, int h, int row0, float* cum, float* rt, float* sg) {
    const int tid = tidx();
    const int d = tid & 63, sq = tid >> 6;
    float a2r[16];
#pragma unroll
    for (int j = 0; j < 16; ++j) a2r[j] = p.gla_a2[((size_t)(l * 2 + dir) * 16 + j) * 256 + h * 64 + d];
    const float ab = p.gla_ab[(l * 2 + dir) * 256 + h * 64 + d];
    {
        const int s = tid >> 2, q4 = tid & 3, row = row0 + (dir ? 63 - s : s);
        const u32x2 v = *(const u32x2*)(p.cols + (size_t)row * NCM + GLA_RF + dir * 16 + q4 * 4);
        rt[s * 17 + q4 * 4 + 0] = __uint_as_float(v.x << 16); rt[s * 17 + q4 * 4 + 1] = __uint_as_float(v.x & 0xffff0000u);
        rt[s * 17 + q4 * 4 + 2] = __uint_as_float(v.y << 16); rt[s * 17 + q4 * 4 + 3] = __uint_as_float(v.y & 0xffff0000u);
    }
    __syncthreads();
    float loc[16]; float run = 0.f;
#pragma unroll
    for (int i = 0; i < 16; ++i) {
        const int s = sq * 16 + i;
        float x = ab;
#pragma unroll
        for (int j = 0; j < 16; ++j) x += rt[s * 17 + j] * a2r[j];
        run += logsig(x) * (1.f / 16.f);
        loc[i] = run;
    }
    sg[sq * 64 + d] = run;
    __syncthreads();
    float off = 0.f;
    for (int k = 0; k < sq; ++k) off += sg[k * 64 + d];
#pragma unroll
    for (int i = 0; i < 16; ++i) cum[(sq * 16 + i) * 65 + d] = loc[i] + off;
    __syncthreads();
}

DEV void gla_phaseA(const P& p, int l, int dir, int b, int st, int h, unsigned char* smraw) {
    float* cum = (float*)smraw;
    float* rt = cum + 64 * 65;
    float* sg = rt + 64 * 17;
    u16* kwT = (u16*)(sg + 256);
    u16* vT = kwT + 64 * LDP;
    const int tid = tidx(), lane = tid & 63, w = tid >> 6, fr = lane & 15, fq = lane >> 4;
    const int row0 = chunk_row0(b, dir, st);
    const size_t idx = state_idx(dir, b, st, h);
    Raw16 kraw, vraw;
    {
        const int s = tid >> 2, dg = tid & 3, row = row0 + (dir ? 63 - s : s);
        kraw = ldraw16(p.cols + (size_t)row * NCM + GLA_K + h * 64 + dg * 16);
        vraw = ldraw16(p.cols + (size_t)row * NCM + GLA_V + h * 64 + dg * 16);
    }
    gla_cum(p, l, dir, h, row0, cum, rt, sg);
    {
        const int s = tid >> 2, dg = tid & 3;
        float kk[16], vv[16];
        unraw16(kraw, kk); unraw16(vraw, vv);
#pragma unroll
        for (int i = 0; i < 16; ++i) {
            const int d = dg * 16 + i;
            kwT[d * LDP + s] = f2bf(kk[i] * __expf(cum[63 * 65 + d] - cum[s * 65 + d]));
            vT[d * LDP + s] = f2bf(vv[i]);
        }
        if (tid < 64) p.glaDec[idx * 64 + tid] = __expf(cum[63 * 65 + tid]);
    }
    __syncthreads();
    f32x4 acc[4]; zero4(acc);
    mm64(acc, kwT, LDP, vT, LDP);
#pragma unroll
    for (int nt = 0; nt < 4; ++nt) {
        const int d = 16 * w + fq * 4, e = nt * 16 + fr;
        u32x2 pk; pk.x = pack2(acc[nt][0], acc[nt][1]); pk.y = pack2(acc[nt][2], acc[nt][3]);
        *(u32x2*)(p.glaS + idx * 4096 + e * 64 + d) = pk;
    }
    __syncthreads();
}

DEV void ml_phaseA(const P& p, int l, int dir, int b, int st, int h, unsigned char* smraw) {
    float* wend = (float*)smraw;
    u16* kwT = (u16*)(wend + 64);
    u16* vT = kwT + 64 * LDP;
    const int tid = tidx(), lane = tid & 63, w = tid >> 6, fr = lane & 15, fq = lane >> 4;
    const int row0 = chunk_row0(b, dir, st);
    const size_t idx = state_idx(dir, b, st, h);
    Raw16 kraw, vraw;
    {
        const int s = tid >> 2, dg = tid & 3, row = row0 + (dir ? 63 - s : s);
        kraw = ldraw16(p.cols + (size_t)row * NCM + ML_K + h * 64 + dg * 16);
        vraw = ldraw16(p.cols + (size_t)row * NCM + ML_V + h * 64 + dg * 16);
    }
    if (w == 0) {
        const int row = row0 + (dir ? 63 - lane : lane);
        const float ip = bf2f(p.cols[(size_t)row * NCM + ML_GF + dir * 8 + h]) + p.mlstm_gate_b[((l * 2 + dir) * 2 + 0) * 4 + h];
        const float lf = logsig(bf2f(p.cols[(size_t)row * NCM + ML_GF + dir * 8 + 4 + h]) + p.mlstm_gate_b[((l * 2 + dir) * 2 + 1) * 4 + h]);
        const float fc = wscan_add(lf, lane);
        const float fe = shidx(fc, 63);
        const float lw = fe - fc + ip;
        const float ae = wmaxr(lw);
        wend[lane] = __expf(lw - ae);
        if (lane == 0) { p.mlFE[idx] = fe; p.mlAE[idx] = ae; }
    }
    __syncthreads();
    {
        const int s = tid >> 2, dg = tid & 3;
        float kk[16], vv[16];
        unraw16(kraw, kk); unraw16(vraw, vv);
        const float ws = wend[s] * 0.125f;
#pragma unroll
        for (int i = 0; i < 16; ++i) {
            const int d = dg * 16 + i;
            kwT[d * LDP + s] = f2bf(kk[i] * ws);
            vT[d * LDP + s] = f2bf(vv[i]);
        }
    }
    __syncthreads();
    if (tid < 64) {
        float a = 0.f;
        for (int s = 0; s < 64; ++s) a += bf2f(kwT[tid * LDP + s]);
        p.mlN[idx * 64 + tid] = a;
    }
    f32x4 acc[4]; zero4(acc);
    mm64(acc, kwT, LDP, vT, LDP);
#pragma unroll
    for (int nt = 0; nt < 4; ++nt) {
        const int d = 16 * w + fq * 4, e = nt * 16 + fr;
        u32x2 pk; pk.x = pack2(acc[nt][0], acc[nt][1]); pk.y = pack2(acc[nt][2], acc[nt][3]);
        *(u32x2*)(p.mlS + idx * 4096 + e * 64 + d) = pk;
    }
    __syncthreads();
}

DEV void gd_phaseA(const P& p, int l, const u16* gqkv, int dir, int b, int st, int h, unsigned char* smraw) {
    float* X = (float*)smraw;
    float* cum = X + 64 * 65 + 32;
    float* beta = cum + 64;
    float* be = beta + 64;
    float* ke = be + 64;
    float* scal = ke + 64;
    u16* Y0 = (u16*)(scal + 64);
    u16* Y1 = Y0 + 64 * LDP;
    u16* Y2 = Y1 + 64 * LDP;
    u16* Y3 = Y2 + 64 * LDP;
    u16* Y4 = Y3 + 64 * LDP;
    u16* Y5 = Y4 + 64 * LDP;
    const int tid = tidx(), lane = tid & 63, w = tid >> 6, fr = lane & 15, fq = lane >> 4;
    const int row0 = chunk_row0(b, dir, st);
    const size_t idx = state_idx(dir, b, st, h);
    if (w == 0) {
        const int row = row0 + (dir ? 63 - lane : lane);
        const float bp = bf2f(p.cols[(size_t)row * NCM + GD_GF + dir * 8 + h]);
        const float ap = bf2f(p.cols[(size_t)row * NCM + GD_GF + dir * 8 + 4 + h]);
        const float bt = sigm(bp);
        const float g = -__expf(p.gdn_a_log[(l * 2 + dir) * 4 + h]) * softplus(ap + p.gdn_dt_bias[(l * 2 + dir) * 4 + h]);
        const float cm = wscan_add(g, lane);
        const float ce = shidx(cm, 63);
        cum[lane] = cm; beta[lane] = bt; be[lane] = bt * __expf(cm); ke[lane] = __expf(ce - cm);
        if (lane == 0) scal[0] = __expf(ce);
    }
    {
        const int s = tid >> 2, dg = tid & 3, row = row0 + (dir ? 63 - s : s);
        const u16* src = gqkv + (size_t)row * 768 + h * 64 + dg * 16;
        const u32x4 q0 = *(const u32x4*)src, q1 = *(const u32x4*)(src + 8);
        const u32x4 k0 = *(const u32x4*)(src + 256), k1 = *(const u32x4*)(src + 264);
        const u32x4 v0 = *(const u32x4*)(src + 512), v1 = *(const u32x4*)(src + 520);
        *(u32x4*)(Y0 + s * LDP + dg * 16) = q0; *(u32x4*)(Y0 + s * LDP + dg * 16 + 8) = q1;
        *(u32x4*)(Y1 + s * LDP + dg * 16) = k0; *(u32x4*)(Y1 + s * LDP + dg * 16 + 8) = k1;
        const unsigned kw[8] = {k0.x, k0.y, k0.z, k0.w, k1.x, k1.y, k1.z, k1.w};
        const unsigned vw[8] = {v0.x, v0.y, v0.z, v0.w, v1.x, v1.y, v1.z, v1.w};
#pragma unroll
        for (int i = 0; i < 8; ++i) {
            Y2[(dg * 16 + 2 * i) * LDP + s] = (u16)(kw[i] & 0xffff); Y2[(dg * 16 + 2 * i + 1) * LDP + s] = (u16)(kw[i] >> 16);
            Y3[(dg * 16 + 2 * i) * LDP + s] = (u16)(vw[i] & 0xffff); Y3[(dg * 16 + 2 * i + 1) * LDP + s] = (u16)(vw[i] >> 16);
        }
    }
    __syncthreads();
    u32x2 qpre[4];
#pragma unroll
    for (int nt = 0; nt < 4; ++nt) {
        const int c = nt * 16 + fr, row = row0 + (dir ? 63 - c : c);
        qpre[nt] = *(const u32x2*)(gqkv + (size_t)row * 768 + h * 64 + 16 * w + fq * 4);
    }
    {
        f32x4 kk[4], qk[4]; zero4(kk); zero4(qk);
        mm64(kk, Y1, LDP, Y1, LDP);
        mm64(qk, Y0, LDP, Y1, LDP);
#pragma unroll
        for (int nt = 0; nt < 4; ++nt)
#pragma unroll
            for (int j = 0; j < 4; ++j) {
                const int c = 16 * w + fq * 4 + j, s = nt * 16 + fr;
                const float gam = s <= c ? __expf(cum[c] - cum[s]) : 0.f;
                X[c * 65 + s] = s < c ? beta[c] * kk[nt][j] * gam : 0.f;
                Y4[c * LDP + s] = f2bf(qk[nt][j] * gam);
            }
    }
    __syncthreads();
    float* T = (float*)Y0;
    {
        float* Pb = (float*)Y5;
        for (int e = tid; e < 6 * 256; e += NTHR) {
            const int q = e >> 8, r = (e >> 4) & 15, c = e & 15;
            const int ib = q < 3 ? 0 : (q < 5 ? 1 : 2), jb = q < 3 ? q + 1 : (q < 5 ? q - 1 : 3);
            T[(16 * ib + r) * 65 + 16 * jb + c] = 0.f;
        }
        if (tid < 64) {
            const int blk = tid >> 4, col = tid & 15, base = blk * 16;
            float tc[16];
#pragma unroll
            for (int r = 0; r < 16; ++r) tc[r] = (r == col) ? 1.f : 0.f;
#pragma unroll
            for (int r = 1; r < 16; ++r) {
                float a = 0.f;
#pragma unroll
                for (int s2 = 0; s2 < r; ++s2) a += X[(base + r) * 65 + base + s2] * tc[s2];
                tc[r] = r > col ? -a : tc[r];
            }
#pragma unroll
            for (int r = 0; r < 16; ++r) T[(base + r) * 65 + base + col] = tc[r];
        }
        __syncthreads();
#pragma unroll
        for (int d = 1; d < 4; ++d) {
            const int nblk = 4 - d;
            for (int e = tid; e < nblk * 256; e += NTHR) {
                const int jb = e >> 8, r = (e >> 4) & 15, c = e & 15, ib = jb + d;
                float a = 0.f;
#pragma unroll
                for (int k2 = 0; k2 < d; ++k2)
#pragma unroll
                    for (int s2 = 0; s2 < 16; ++s2) a += X[(16 * ib + r) * 65 + 16 * (jb + k2) + s2] * T[(16 * (jb + k2) + s2) * 65 + 16 * jb + c];
                Pb[(jb * 16 + r) * 17 + c] = a;
            }
            __syncthreads();
            for (int e = tid; e < nblk * 256; e += NTHR) {
                const int jb = e >> 8, r = (e >> 4) & 15, c = e & 15, ib = jb + d;
                float a = 0.f;
#pragma unroll
                for (int s2 = 0; s2 < 16; ++s2) a += T[(16 * ib + r) * 65 + 16 * ib + s2] * Pb[(jb * 16 + s2) * 17 + c];
                T[(16 * ib + r) * 65 + 16 * jb + c] = -a;
            }
            __syncthreads();
        }
    }
    u16* Tw = (u16*)X;
    u16* Tu = Y5;
    {
        const int c = tid >> 2, sgp = tid & 3;
        float tw[16], tu[16];
#pragma unroll
        for (int i = 0; i < 16; ++i) {
            const int s = sgp * 16 + i;
            const float t = T[c * 65 + s];
            tw[i] = t * be[s]; tu[i] = t * beta[s];
        }
        st16bf(Tw + c * LDP + sgp * 16, tw);
        st16bf(Tu + c * LDP + sgp * 16, tu);
    }
    __syncthreads();
    u16* wT = Y0; u16* wkT = Y1; u16* uT = (u16*)X; u16* ukT = Y5;
    {
        f32x4 wa[4], ua[4]; zero4(wa); zero4(ua);
        mm64(wa, Tw, LDP, Y2, LDP);
        mm64(ua, Tu, LDP, Y3, LDP);
        __syncthreads();
        const int c0 = 16 * w + fq * 4;
        const float k0 = ke[c0], k1 = ke[c0 + 1], k2 = ke[c0 + 2], k3 = ke[c0 + 3];
#pragma unroll
        for (int nt = 0; nt < 4; ++nt) {
            const int d = nt * 16 + fr;
            u32x2 a, bq, c, dq_;
            a.x = pack2(wa[nt][0], wa[nt][1]); a.y = pack2(wa[nt][2], wa[nt][3]);
            bq.x = pack2(wa[nt][0] * k0, wa[nt][1] * k1); bq.y = pack2(wa[nt][2] * k2, wa[nt][3] * k3);
            c.x = pack2(ua[nt][0], ua[nt][1]); c.y = pack2(ua[nt][2], ua[nt][3]);
            dq_.x = pack2(ua[nt][0] * k0, ua[nt][1] * k1); dq_.y = pack2(ua[nt][2] * k2, ua[nt][3] * k3);
            *(u32x2*)(wT + d * LDP + c0) = a;
            *(u32x2*)(wkT + d * LDP + c0) = bq;
            *(u32x2*)(uT + d * LDP + c0) = c;
            *(u32x2*)(ukT + d * LDP + c0) = dq_;
        }
    }
    __syncthreads();
    {
        const float dec = scal[0];
        f32x4 acc[4];
        zero4(acc); mm64(acc, wT, LDP, Y4, LDP);
#pragma unroll
        for (int nt = 0; nt < 4; ++nt) {
            const int d = 16 * w + fq * 4, c = nt * 16 + fr;
            const u32x2 qv = qpre[nt];
            const float ec = __expf(cum[c]);
            u32x2 pk;
            pk.x = pack2(__uint_as_float(qv.x << 16) * ec - acc[nt][0], __uint_as_float(qv.x & 0xffff0000u) * ec - acc[nt][1]);
            pk.y = pack2(__uint_as_float(qv.y << 16) * ec - acc[nt][2], __uint_as_float(qv.y & 0xffff0000u) * ec - acc[nt][3]);
            *(u32x2*)(p.gdQ + idx * 4096 + c * 64 + d) = pk;
        }
        zero4(acc); mm64(acc, wkT, LDP, Y2, LDP);
#pragma unroll
        for (int nt = 0; nt < 4; ++nt) {
            const int d = 16 * w + fq * 4, d2 = nt * 16 + fr;
            u32x2 pk;
            pk.x = pack2((d == d2 ? dec : 0.f) - acc[nt][0], (d + 1 == d2 ? dec : 0.f) - acc[nt][1]);
            pk.y = pack2((d + 2 == d2 ? dec : 0.f) - acc[nt][2], (d + 3 == d2 ? dec : 0.f) - acc[nt][3]);
            *(u32x2*)(p.gdM + idx * 4096 + d2 * 64 + d) = pk;
        }
        zero4(acc); mm64(acc, Y2, LDP, ukT, LDP);
#pragma unroll
        for (int nt = 0; nt < 4; ++nt) {
            const int d2 = 16 * w + fq * 4, e = nt * 16 + fr;
            u32x2 pk; pk.x = pack2(acc[nt][0], acc[nt][1]); pk.y = pack2(acc[nt][2], acc[nt][3]);
            *(u32x2*)(p.gdN + idx * 4096 + e * 64 + d2) = pk;
        }
        zero4(acc); mm64(acc, Y4, LDP, uT, LDP);
#pragma unroll
        for (int nt = 0; nt < 4; ++nt) {
            const int c = 16 * w + fq * 4, e = nt * 16 + fr;
            u32x2 pk; pk.x = pack2(acc[nt][0], acc[nt][1]); pk.y = pack2(acc[nt][2], acc[nt][3]);
            *(u32x2*)(p.gdO + idx * 4096 + e * 64 + c) = pk;
        }
    }
    __syncthreads();
}

DEV void phase_chunkA(const P& p, int l, const u16* gqkv, int bid, int nb, unsigned char* sm) {
    for (int u = bid; u < 3 * 2112; u += nb) {
        const int mix = u / 2112, v = u % 2112;
        const int h = v & 3, st = (v >> 2) % NSTEP, db = (v >> 2) / NSTEP, b = db & 1, dir = db >> 1;
        if (mix == 0) { PRB_BEGIN(120); gd_phaseA(p, l, gqkv, dir, b, st, h, sm); PRB_END(120); }
        else if (mix == 1) { PRB_BEGIN(121); gla_phaseA(p, l, dir, b, st, h, sm); PRB_END(121); }
        else { PRB_BEGIN(122); ml_phaseA(p, l, dir, b, st, h, sm); PRB_END(122); }
    }
}
#define GD_STAGE (64 * 64 + 16 * 64)
#define GD_NST 7
DEV void gd_issue(const P& p, size_t idx, int ct, u16* ring, int stg, int w, int lane) {
    u16* md = ring + stg * GD_STAGE;
    u16* nd = md + 64 * 64;
#pragma unroll
    for (int i = 0; i < 2; ++i) {
        const int r = (w * 2 + i) * 8 + (lane >> 3), c = (lane & 7) ^ ((r >> 1) & 7);
        __builtin_amdgcn_global_load_lds((const unsigned*)(p.gdM + idx * 4096 + r * 64 + c * 8), (unsigned*)(md + (w * 2 + i) * 512), 16, 0, 0);
    }
    {
        const int pi = w & 1, r = pi * 8 + (lane >> 3), c = (lane & 7) ^ ((r >> 1) & 7);
        __builtin_amdgcn_global_load_lds((const unsigned*)(p.gdN + idx * 4096 + (16 * ct + r) * 64 + c * 8), (unsigned*)(nd + pi * 512), 16, 0, 0);
    }
}
DEV void gd_frags(const u16* Ms, int fr, int fq, int sw, bf16x8 (&a)[8], u32x2 (&nv)[4]) {
    const u16* Ns = Ms + 64 * 64;
#pragma unroll
    for (int mt = 0; mt < 4; ++mt) {
#pragma unroll
        for (int ks = 0; ks < 2; ++ks) a[mt * 2 + ks] = *(const bf16x8*)(Ms + (mt * 16 + fr) * 64 + (((ks * 4 + fq) ^ sw) * 8));
        nv[mt] = *(const u32x2*)(Ns + fr * 64 + (((mt * 2 + (fq >> 1)) ^ sw) * 8) + (fq & 1) * 4);
    }
}
DEV void gd_scan(const P& p, int unit, u16* sm) {
    const int chain = unit >> 2, ct = unit & 3;
    const int dir = chain >> 3, b = (chain >> 2) & 1, h = chain & 3;
    const int tid_ = tidx();
    const int lane = tid_ & 63, w = tid_ >> 6, fr = lane & 15, fq = lane >> 4;
    u16* ring = sm;
    u16* sl = sm + GD_NST * GD_STAGE;
    bf16x8 sb[2];
    sb[0] = bf16x8{0, 0, 0, 0, 0, 0, 0, 0}; sb[1] = sb[0];
    const size_t base = state_idx(dir, b, 0, h);
    const int sw = (fr >> 1) & 7;
    asm volatile("s_waitcnt vmcnt(0)" ::: "memory");
#pragma unroll
    for (int t = 0; t < 6; ++t) gd_issue(p, base + (size_t)t * 4, ct, ring, t, w, lane);
    asm volatile("s_waitcnt vmcnt(15)" ::: "memory");
    RAW_BARRIER();
    bf16x8 a[8], an[8]; u32x2 nv[4], nn[4];
    if (w == 0) gd_frags(ring, fr, fq, sw, a, nv);
    for (int k = 0; k < NSTEP; ++k) {
        if (k + 6 >= NSTEP) asm volatile("s_waitcnt vmcnt(0)" ::: "memory");
        else if (w != 0 || k == 0) asm volatile("s_waitcnt vmcnt(12)" ::: "memory");
        else asm volatile("s_waitcnt vmcnt(14)" ::: "memory");
        RAW_BARRIER();
        if (k + 6 < NSTEP) gd_issue(p, base + (size_t)(k + 6) * 4, ct, ring, (k + 6) % GD_NST, w, lane);
        asm volatile("" ::: "memory");
        if (w == 0) {
            const size_t idx = base + (size_t)k * 4;
            f32x4 acc[4];
#pragma unroll
            for (int mt = 0; mt < 4; ++mt) {
                acc[mt][0] = __uint_as_float(nv[mt].x << 16); acc[mt][1] = __uint_as_float(nv[mt].x & 0xffff0000u);
                acc[mt][2] = __uint_as_float(nv[mt].y << 16); acc[mt][3] = __uint_as_float(nv[mt].y & 0xffff0000u);
            }
#pragma unroll
            for (int mt = 0; mt < 4; ++mt)
#pragma unroll
                for (int ks = 0; ks < 2; ++ks) acc[mt] = mfma16(a[mt * 2 + ks], sb[ks], acc[mt]);
            if (k + 1 < NSTEP) gd_frags(ring + ((k + 1) % GD_NST) * GD_STAGE, fr, fq, sw, an, nn);
#pragma unroll
            for (int ks = 0; ks < 2; ++ks) *(bf16x8*)(p.gdN + idx * 4096 + (16 * ct + fr) * 64 + ks * 32 + fq * 8) = sb[ks];
            asm volatile("" ::: "memory");
#pragma unroll
            for (int mt = 0; mt < 4; ++mt) {
                u32x2 pk; pk.x = pack2(acc[mt][0], acc[mt][1]); pk.y = pack2(acc[mt][2], acc[mt][3]);
                *(u32x2*)(sl + fr * LDP + mt * 16 + fq * 4) = pk;
            }
            __builtin_amdgcn_wave_barrier();
#pragma unroll
            for (int ks = 0; ks < 2; ++ks) sb[ks] = *(const bf16x8*)(sl + fr * LDP + ks * 32 + fq * 8);
            __builtin_amdgcn_wave_barrier();
#pragma unroll
            for (int q = 0; q < 8; ++q) a[q] = an[q];
#pragma unroll
            for (int q = 0; q < 4; ++q) nv[q] = nn[q];
        }
    }
    asm volatile("s_waitcnt vmcnt(0)" ::: "memory");
    RAW_BARRIER();
}

DEV void gla_scan(const P& p, int v) {
    const int chain = v >> 3, sub = v & 7;
    const int dir = chain >> 3, b = (chain >> 2) & 1, h = chain & 3;
    const int ep = sub * 256 + tidx(), d = (2 * ep) & 63;
    float s0 = 0.f, s1 = 0.f;
    for (int st0 = 0; st0 < NSTEP; st0 += 12) {
        unsigned kv[12]; float2 dc[12];
#pragma unroll
        for (int k = 0; k < 12; ++k) {
            const size_t idx = state_idx(dir, b, st0 + k, h);
            kv[k] = *(const unsigned*)(p.glaS + idx * 4096 + 2 * ep);
            dc[k] = *(const float2*)(p.glaDec + idx * 64 + d);
        }
#pragma unroll
        for (int k = 0; k < 12; ++k) {
            const size_t idx = state_idx(dir, b, st0 + k, h);
            *(unsigned*)(p.glaS + idx * 4096 + 2 * ep) = pack2(s0, s1);
            s0 = dc[k].x * s0 + __uint_as_float(kv[k] << 16);
            s1 = dc[k].y * s1 + __uint_as_float(kv[k] & 0xffff0000u);
        }
    }
}

DEV void ml_scan(const P& p, int v) {
    const int chain = v >> 3, sub = v & 7;
    const int dir = chain >> 3, b = (chain >> 2) & 1, h = chain & 3;
    const int tid = tidx();
    const int ep = sub * 256 + tid;
    float s0 = 0.f, s1 = 0.f, m = 0.f;
    for (int st0 = 0; st0 < NSTEP; st0 += 12) {
        unsigned kv[12]; float fe[12], ae[12];
#pragma unroll
        for (int k = 0; k < 12; ++k) {
            const size_t idx = state_idx(dir, b, st0 + k, h);
            kv[k] = *(const unsigned*)(p.mlS + idx * 4096 + 2 * ep);
            fe[k] = p.mlFE[idx]; ae[k] = p.mlAE[idx];
        }
#pragma unroll
        for (int k = 0; k < 12; ++k) {
            const size_t idx = state_idx(dir, b, st0 + k, h);
            *(unsigned*)(p.mlS + idx * 4096 + 2 * ep) = pack2(s0, s1);
            const float mn = fmaxf(fe[k] + m, ae[k]);
            const float od = __expf(fe[k] + m - mn), nw = __expf(ae[k] - mn);
            s0 = od * s0 + nw * __uint_as_float(kv[k] << 16);
            s1 = od * s1 + nw * __uint_as_float(kv[k] & 0xffff0000u);
            m = mn;
        }
    }
}
DEV void ml_nscan(const P& p, int v) {
    const int tid = tidx(), chain = v * 4 + (tid >> 6), d = tid & 63;
    const int dir = chain >> 3, b = (chain >> 2) & 1, h = chain & 3;
    float nn = 0.f, m = 0.f;
    for (int st0 = 0; st0 < NSTEP; st0 += 12) {
        float fe[12], ae[12], ks[12];
#pragma unroll
        for (int k = 0; k < 12; ++k) {
            const size_t idx = state_idx(dir, b, st0 + k, h);
            fe[k] = p.mlFE[idx]; ae[k] = p.mlAE[idx]; ks[k] = p.mlN[idx * 64 + d];
        }
#pragma unroll
        for (int k = 0; k < 12; ++k) {
            const size_t idx = state_idx(dir, b, st0 + k, h);
            p.mlN[idx * 64 + d] = nn;
            if (d == 0) p.mlM[idx] = m;
            const float mn = fmaxf(fe[k] + m, ae[k]);
            const float od = __expf(fe[k] + m - mn), nw = __expf(ae[k] - mn);
            nn = od * nn + nw * ks[k];
            m = mn;
        }
    }
}

DEV void phase_scan(const P& p, int bid, int nb, u16* sm) {
    for (int u = bid; u < 64 + 128 + 128 + 4; u += nb) {
        if (u < 64) { PRB_BEGIN(100); gd_scan(p, u, sm); PRB_END(100); }
        else if (u < 192) { PRB_BEGIN(101); gla_scan(p, u - 64); PRB_END(101); }
        else if (u < 320) { PRB_BEGIN(102); ml_scan(p, u - 192); PRB_END(102); }
        else ml_nscan(p, u - 320);
    }
}
DEV void chunk_geom(int g, int& b, int& row0, int& stf, int& stb) {
    b = g / NSTEP; const int wv = g % NSTEP;
    row0 = wv < 4 ? RLAT + b * CTXL + wv * 64 : b * SEQ + (wv - 4) * 64;
    stf = wv; stb = wv < 4 ? 3 - wv : 135 - wv;
}
DEV void obuf_acc(float* obuf, const f32x4 (&acc)[4], int dir) {
    const int lane = tidx() & 63, w = tidx() >> 6, fr = lane & 15, fq = lane >> 4;
#pragma unroll
    for (int nt = 0; nt < 4; ++nt)
#pragma unroll
        for (int j = 0; j < 4; ++j) {
            const int c = 16 * w + fq * 4 + j, e = nt * 16 + fr;
            if (dir == 0) obuf[c * 65 + e] = acc[nt][j]; else obuf[(63 - c) * 65 + e] += acc[nt][j];
        }
}
DEV Raw16 gate_prefetch(const P& p, int h, int row0, int gcol) {
    const int tid = tidx(), row = tid >> 2, eg = tid & 3;
    return ldraw16(p.cols + (size_t)(row0 + row) * NCM + gcol + h * 64 + eg * 16);
}
template <int ACT>
DEV void head_out(const P& p, int l, int br, int h, int row0, const Raw16& graw, const float* obuf) {
    const int tid = tidx(), row = tid >> 2, eg = tid & 3;
    float o[16]; float ss = 0.f;
#pragma unroll
    for (int i = 0; i < 16; ++i) { o[i] = obuf[row * 65 + eg * 16 + i]; ss += o[i] * o[i]; }
    ss += shx(ss, 1); ss += shx(ss, 2);
    const float rs = rsqrtf(ss * (1.f / 64.f) + EPSF);
    float gt[16];
    unraw16(graw, gt);
    float y[16];
#pragma unroll
    for (int i = 0; i < 16; ++i) {
        const float hn = p.head_norm[(l * 4 + br) * 256 + h * 64 + eg * 16 + i];
        const float a = ACT == 0 ? silu(gt[i]) : sigm(gt[i]);
        y[i] = o[i] * rs * hn * a;
    }
    st16bf(p.ybuf + (size_t)(row0 + row) * 1024 + br * 256 + h * 64 + eg * 16, y);
}

DEV void gla_phaseC(const P& p, int l, int g, int h, unsigned char* smraw) {
    float* cum = (float*)smraw;
    float* rt = cum + 64 * 65;
    float* sg = rt + 64 * 17;
    float* obuf = sg + 256;
    u16* qi = (u16*)(obuf + 64 * 65);
    u16* ko = qi + 64 * LDP;
    u16* vT = ko + 64 * LDP;
    const int tid = tidx(), lane = tid & 63, w = tid >> 6, fr = lane & 15, fq = lane >> 4;
    int b, row0, stf, stb; chunk_geom(g, b, row0, stf, stb);
    const Raw16 graw = gate_prefetch(p, h, row0, GLA_G);
    for (int dir = 0; dir < 2; ++dir) {
        const size_t idx = state_idx(dir, b, dir ? stb : stf, h);
        Raw16 qraw, kraw, vraw; bf16x8 sin_[2][4];
        {
            const int s = tid >> 2, dg = tid & 3, row = row0 + (dir ? 63 - s : s);
            qraw = ldraw16(p.cols + (size_t)row * NCM + GLA_Q + h * 64 + dg * 16);
            kraw = ldraw16(p.cols + (size_t)row * NCM + GLA_K + h * 64 + dg * 16);
            vraw = ldraw16(p.cols + (size_t)row * NCM + GLA_V + h * 64 + dg * 16);
        }
        ldB64(sin_, p.glaS + idx * 4096);
        PRB_BEGIN(140);
        gla_cum(p, l, dir, h, row0, cum, rt, sg);
        PRB_END(140);
        PRB_BEGIN(141);
        {
            const int s = tid >> 2, dg = tid & 3;
            float qq[16], kk[16], vv[16];
            unraw16(qraw, qq); unraw16(kraw, kk); unraw16(vraw, vv);
#pragma unroll
            for (int i = 0; i < 16; ++i) {
                const float cv = cum[s * 65 + dg * 16 + i];
                qq[i] *= 0.125f * __expf(cv); kk[i] *= __expf(-cv);
                vT[(dg * 16 + i) * LDP + s] = f2bf(vv[i]);
            }
            st16bf(qi + s * LDP + dg * 16, qq);
            st16bf(ko + s * LDP + dg * 16, kk);
        }
        __syncthreads();
        f32x4 sa[4]; zero4(sa);
        mm64(sa, qi, LDP, ko, LDP);
        __syncthreads();
#pragma unroll
        for (int nt = 0; nt < 4; ++nt)
#pragma unroll
            for (int j = 0; j < 4; ++j) {
                const int c = 16 * w + fq * 4 + j, s = nt * 16 + fr;
                ko[c * LDP + s] = f2bf(s <= c ? sa[nt][j] : 0.f);
            }
        __syncthreads();
        PRB_END(141);
        PRB_BEGIN(142);
        f32x4 oa[4]; zero4(oa);
        mm64(oa, ko, LDP, vT, LDP);
        mm64_pre(oa, qi, LDP, sin_);
        obuf_acc(obuf, oa, dir);
        __syncthreads();
        PRB_END(142);
    }
    PRB_BEGIN(143);
    head_out<0>(p, l, 0, h, row0, graw, obuf);
    __syncthreads();
    PRB_END(143);
}

DEV void ml_phaseC(const P& p, int l, int g, int h, unsigned char* smraw) {
    float* obuf = (float*)smraw;
    float* fcum = obuf + 64 * 65;
    float* ipre = fcum + 64;
    float* mrow = ipre + 64;
    float* denl = mrow + 64;
    float* qn = denl + 64;
    float* nin = qn + 64;
    u16* qs = (u16*)(nin + 64 + 64);
    u16* ks = qs + 64 * LDP;
    u16* vT = ks + 64 * LDP;
    const int tid = tidx(), lane = tid & 63, w = tid >> 6, fr = lane & 15, fq = lane >> 4;
    int b, row0, stf, stb; chunk_geom(g, b, row0, stf, stb);
    const Raw16 graw = gate_prefetch(p, h, row0, ML_O);
    for (int dir = 0; dir < 2; ++dir) {
        const size_t idx = state_idx(dir, b, dir ? stb : stf, h);
        const float m_in = p.mlM[idx];
        Raw16 qraw, kraw, vraw; bf16x8 cin_[2][4];
        {
            const int s = tid >> 2, dg = tid & 3, row = row0 + (dir ? 63 - s : s);
            qraw = ldraw16(p.cols + (size_t)row * NCM + ML_Q + h * 64 + dg * 16);
            kraw = ldraw16(p.cols + (size_t)row * NCM + ML_K + h * 64 + dg * 16);
            vraw = ldraw16(p.cols + (size_t)row * NCM + ML_V + h * 64 + dg * 16);
        }
        ldB64(cin_, p.mlS + idx * 4096);
        if (w == 0) {
            const int row = row0 + (dir ? 63 - lane : lane);
            const float ip = bf2f(p.cols[(size_t)row * NCM + ML_GF + dir * 8 + h]) + p.mlstm_gate_b[((l * 2 + dir) * 2 + 0) * 4 + h];
            const float lf = logsig(bf2f(p.cols[(size_t)row * NCM + ML_GF + dir * 8 + 4 + h]) + p.mlstm_gate_b[((l * 2 + dir) * 2 + 1) * 4 + h]);
            const float fc = wscan_add(lf, lane);
            const float pm = wscan_max(ip - fc, lane);
            fcum[lane] = fc; ipre[lane] = ip; mrow[lane] = fc + fmaxf(m_in, pm);
            nin[lane] = p.mlN[idx * 64 + lane];
        }
        {
            const int s = tid >> 2, dg = tid & 3;
            float kk[16], vv[16];
            *(u32x4*)(qs + s * LDP + dg * 16) = qraw.a;
            *(u32x4*)(qs + s * LDP + dg * 16 + 8) = qraw.b;
            unraw16(kraw, kk); unraw16(vraw, vv);
#pragma unroll
            for (int i = 0; i < 16; ++i) { kk[i] *= 0.125f; vT[(dg * 16 + i) * LDP + s] = f2bf(vv[i]); }
            st16bf(ks + s * LDP + dg * 16, kk);
        }
        __syncthreads();
        {
            const int c = tid >> 2, dg = tid & 3;
            float a = 0.f;
#pragma unroll
            for (int i = 0; i < 16; ++i) a += bf2f(qs[c * LDP + dg * 16 + i]) * nin[dg * 16 + i];
            a += shx(a, 1); a += shx(a, 2);
            if (dg == 0) qn[c] = a;
        }
        f32x4 sa[4]; zero4(sa);
        mm64(sa, qs, LDP, ks, LDP);
        __syncthreads();
        float dsum[4] = {0.f, 0.f, 0.f, 0.f};
#pragma unroll
        for (int nt = 0; nt < 4; ++nt)
#pragma unroll
            for (int j = 0; j < 4; ++j) {
                const int c = 16 * w + fq * 4 + j, s = nt * 16 + fr;
                float val = 0.f;
                if (s <= c) val = sa[nt][j] * __expf(fcum[c] - fcum[s] + ipre[s] - mrow[c]);
                dsum[j] += val;
                ks[c * LDP + s] = f2bf(val);
            }
#pragma unroll
        for (int j = 0; j < 4; ++j) {
            float v = dsum[j];
            v += shx(v, 1); v += shx(v, 2); v += shx(v, 4); v += shx(v, 8);
            if (fr == 0) denl[16 * w + fq * 4 + j] = v;
        }
        __syncthreads();
        f32x4 n1[4], n2[4]; zero4(n1); zero4(n2);
        mm64(n1, ks, LDP, vT, LDP);
        mm64_pre(n2, qs, LDP, cin_);
        f32x4 oa[4];
#pragma unroll
        for (int j = 0; j < 4; ++j) {
            const int c = 16 * w + fq * 4 + j;
            const float mr = mrow[c];
            const float ec = __expf(fcum[c] + m_in - mr);
            const float den = denl[c] + ec * qn[c];
            const float inv = 1.f / fmaxf(fabsf(den), __expf(-mr));
#pragma unroll
            for (int nt = 0; nt < 4; ++nt) oa[nt][j] = (n1[nt][j] + ec * n2[nt][j]) * inv;
        }
        obuf_acc(obuf, oa, dir);
        __syncthreads();
    }
    head_out<1>(p, l, 1, h, row0, graw, obuf);
    __syncthreads();
}

DEV void gd_phaseC(const P& p, int l, int g, int h, unsigned char* smraw) {
    float* obuf = (float*)smraw;
    const int tid = tidx(), lane = tid & 63, w = tid >> 6, fr = lane & 15, fq = lane >> 4;
    int b, row0, stf, stb; chunk_geom(g, b, row0, stf, stb);
    const Raw16 graw = gate_prefetch(p, h, row0, GD_OG);
    for (int dir = 0; dir < 2; ++dir) {
        const size_t idx = state_idx(dir, b, dir ? stb : stf, h);
        f32x4 oa[4];
#pragma unroll
        for (int nt = 0; nt < 4; ++nt) {
            const u32x2 ov = *(const u32x2*)(p.gdO + idx * 4096 + (nt * 16 + fr) * 64 + 16 * w + fq * 4);
            oa[nt][0] = __uint_as_float(ov.x << 16); oa[nt][1] = __uint_as_float(ov.x & 0xffff0000u);
            oa[nt][2] = __uint_as_float(ov.y << 16); oa[nt][3] = __uint_as_float(ov.y & 0xffff0000u);
        }
        mm64(oa, p.gdQ + idx * 4096, 64, p.gdN + idx * 4096, 64);
        obuf_acc(obuf, oa, dir);
        __syncthreads();
    }
    head_out<0>(p, l, 2, h, row0, graw, obuf);
    __syncthreads();
}
DEV float fexp2(float x) { return __builtin_amdgcn_exp2f(x); }

#define ATT_STAGE_ELEMS (2 * 64 * 64)
DEV void attn_issue(const u16* kbase, const u16* vbase, int kt, u16* ring, int stg, int w, int lane) {
    u16* kd = ring + stg * ATT_STAGE_ELEMS;
    u16* vd = kd + 64 * 64;
#pragma unroll
    for (int i = 0; i < 2; ++i) {
        const int r = (w * 2 + i) * 8 + (lane >> 3), c = (lane & 7) ^ ((r >> 1) & 7);
        __builtin_amdgcn_global_load_lds((const unsigned*)(kbase + (size_t)(kt * 64 + r) * 64 + c * 8), (unsigned*)(kd + (w * 2 + i) * 512), 16, 0, 0);
        __builtin_amdgcn_global_load_lds((const unsigned*)(vbase + (size_t)r * KPOS + kt * 64 + c * 8), (unsigned*)(vd + (w * 2 + i) * 512), 16, 0, 0);
    }
}

DEV void attn_unit(const P& p, int l, int b, int h, int q0pos, int nkeys, int rowbase, u16* ring) {
    const int tid = tidx(), lane = tid & 63, w = tid >> 6, fr = lane & 15, fq = lane >> 4;
    const size_t bh = (size_t)(b * 4 + h);
    float lam;
    {
        const float* lp = p.diff_lambda + (size_t)l * 4 * 4 * 32;
        float a = 0.f, c = 0.f;
        if (lane < 32) { a = lp[(0 * 4 + h) * 32 + lane] * lp[(1 * 4 + h) * 32 + lane]; c = lp[(2 * 4 + h) * 32 + lane] * lp[(3 * 4 + h) * 32 + lane]; }
        a = wsum(a); c = wsum(c);
        lam = expf(a) - expf(c) + (0.8f - 0.6f * expf(-0.3f * (float)l));
    }
    const float lam_init = 0.8f - 0.6f * expf(-0.3f * (float)l);
    bf16x8 qf[2][2];
#pragma unroll
    for (int g = 0; g < 2; ++g)
#pragma unroll
        for (int i = 0; i < 2; ++i)
            qf[g][i] = *(const bf16x8*)(p.dq + (bh * KPOS + q0pos + w * 32 + g * 16 + fr) * 64 + i * 32 + fq * 8);
    f32x4 O[2][2][4], negref[2][2];
    float mref[2][2], lsum[2][2];
#pragma unroll
    for (int i = 0; i < 2; ++i)
#pragma unroll
        for (int g = 0; g < 2; ++g) {
            mref[i][g] = 0.f; lsum[i][g] = 0.f; negref[i][g] = f32x4{0.f, 0.f, 0.f, 0.f};
#pragma unroll
            for (int t = 0; t < 4; ++t) O[i][g][t] = f32x4{0.f, 0.f, 0.f, 0.f};
        }
    const u16* kbase = p.dk + bh * KPOS * 64;
    const u16* vbase = p.dvT + bh * 64 * KPOS;
    const int nk = nkeys >> 6;
    asm volatile("s_waitcnt vmcnt(0)" ::: "memory");
    attn_issue(kbase, vbase, 0, ring, 0, w, lane);
    attn_issue(kbase, vbase, 1, ring, 1, w, lane);
    const int sw = (fr >> 1) & 7;
    for (int kt = 0; kt < nk; ++kt) {
        if (kt + 1 < nk) asm volatile("s_waitcnt vmcnt(4)" ::: "memory"); else asm volatile("s_waitcnt vmcnt(0)" ::: "memory");
        RAW_BARRIER();
        if (kt + 2 < nk) attn_issue(kbase, vbase, kt + 2, ring, (kt + 2) % 3, w, lane);
        const u16* Ks = ring + (kt % 3) * ATT_STAGE_ELEMS;
        const u16* Vs = Ks + 64 * 64;
#pragma unroll
        for (int i = 0; i < 2; ++i) {
            f32x4 s[2][4];
#pragma unroll
            for (int st = 0; st < 4; ++st) {
                const bf16x8 kf = *(const bf16x8*)(Ks + (st * 16 + fr) * 64 + (((i * 4 + fq) ^ sw) * 8));
#pragma unroll
                for (int g = 0; g < 2; ++g) s[g][st] = mfma16(kf, qf[g][i], negref[i][g]);
            }
            float tmx[2];
#pragma unroll
            for (int g = 0; g < 2; ++g) {
                float mx = fmaxf(fmaxf(s[g][0][0], s[g][0][1]), fmaxf(s[g][0][2], s[g][0][3]));
#pragma unroll
                for (int st = 1; st < 4; ++st) mx = fmaxf(fmaxf(mx, s[g][st][0]), fmaxf(fmaxf(s[g][st][1], s[g][st][2]), s[g][st][3]));
                mx = fmaxf(mx, shx(mx, 16)); mx = fmaxf(mx, shx(mx, 32));
                tmx[g] = mx;
            }
            const bool mv = (tmx[0] > 16.f) || (tmx[1] > 16.f) || (kt == 0 && (tmx[0] < -16.f || tmx[1] < -16.f));
            if (__any(mv)) {
#pragma unroll
                for (int g = 0; g < 2; ++g) {
                    const float d = ((tmx[g] > 16.f) || (kt == 0 && tmx[g] < -16.f)) ? tmx[g] : 0.f;
                    const float fac = fexp2(-d);
                    mref[i][g] += d; lsum[i][g] *= fac;
                    negref[i][g] = f32x4{-mref[i][g], -mref[i][g], -mref[i][g], -mref[i][g]};
#pragma unroll
                    for (int t = 0; t < 4; ++t) { O[i][g][t][0] *= fac; O[i][g][t][1] *= fac; O[i][g][t][2] *= fac; O[i][g][t][3] *= fac; }
#pragma unroll
                    for (int st = 0; st < 4; ++st) { s[g][st][0] -= d; s[g][st][1] -= d; s[g][st][2] -= d; s[g][st][3] -= d; }
                }
            }
            bf16x8 pb[2][2];
#pragma unroll
            for (int g = 0; g < 2; ++g) {
                float ps = 0.f;
#pragma unroll
                for (int st = 0; st < 4; ++st)
#pragma unroll
                    for (int j = 0; j < 4; ++j) { const float e = fexp2(s[g][st][j]); s[g][st][j] = e; ps += e; }
                lsum[i][g] += ps;
#pragma unroll
                for (int ks = 0; ks < 2; ++ks) {
                    union { bf16x8 v; unsigned u[4]; } pk;
                    pk.u[0] = pack2(s[g][2 * ks][0], s[g][2 * ks][1]); pk.u[1] = pack2(s[g][2 * ks][2], s[g][2 * ks][3]);
                    pk.u[2] = pack2(s[g][2 * ks + 1][0], s[g][2 * ks + 1][1]); pk.u[3] = pack2(s[g][2 * ks + 1][2], s[g][2 * ks + 1][3]);
                    pb[g][ks] = pk.v;
                }
            }
#pragma unroll
            for (int ks = 0; ks < 2; ++ks)
#pragma unroll
                for (int t = 0; t < 4; ++t) {
                    union { bf16x8 v; u32x2 h2[2]; } va;
                    va.h2[0] = *(const u32x2*)(Vs + (t * 16 + fr) * 64 + ((((2 * ks) * 2 + (fq >> 1)) ^ sw) * 8) + (fq & 1) * 4);
                    va.h2[1] = *(const u32x2*)(Vs + (t * 16 + fr) * 64 + ((((2 * ks + 1) * 2 + (fq >> 1)) ^ sw) * 8) + (fq & 1) * 4);
#pragma unroll
                    for (int g = 0; g < 2; ++g) O[i][g][t] = mfma16(va.v, pb[g][ks], O[i][g][t]);
                }
        }
    }
    RAW_BARRIER();
#pragma unroll
    for (int g = 0; g < 2; ++g) {
        float l0 = lsum[0][g], l1 = lsum[1][g];
        l0 += shx(l0, 16); l0 += shx(l0, 32);
        l1 += shx(l1, 16); l1 += shx(l1, 32);
        const float i0 = 1.f / l0, i1 = lam / l1;
        float o[4][4]; float ss = 0.f;
#pragma unroll
        for (int t = 0; t < 4; ++t)
#pragma unroll
            for (int j = 0; j < 4; ++j) { o[t][j] = O[0][g][t][j] * i0 - O[1][g][t][j] * i1; ss += o[t][j] * o[t][j]; }
        ss += shx(ss, 16); ss += shx(ss, 32);
        const float rs = rsqrtf(ss * (1.f / 64.f) + EPSF) * (1.f - lam_init);
        const int row = rowbase + w * 32 + g * 16 + fr;
#pragma unroll
        for (int t = 0; t < 4; ++t) {
            const int dv = t * 16 + fq * 4;
            const float4 hn = *(const float4*)(p.head_norm + (l * 4 + 3) * 256 + h * 64 + dv);
            u32x2 pk; pk.x = pack2(o[t][0] * rs * hn.x, o[t][1] * rs * hn.y); pk.y = pack2(o[t][2] * rs * hn.z, o[t][3] * rs * hn.w);
            *(u32x2*)(p.ybuf + (size_t)row * 1024 + 768 + h * 64 + dv) = pk;
        }
    }
}

template <int PART>
DEV void phase_outputs(const P& p, int l, int bid, int nb, unsigned char* sm) {
    if (PART != 2) {
    const int nq = 64 + (l == 0 ? 2 : 0);
    int* qctr = p.cnt + 64 + l * 8;
    volatile int* slot = (volatile int*)(sm + 3 * ATT_STAGE_ELEMS * 2);
    const int x0 = (int)(xb_xcc_id() & 7u);
    for (int a = 0; a < 8; ++a) {
        const int bh = (x0 + a) & 7;
        for (;;) {
            if (tidx() == 0) *slot = atomicAdd(qctr + bh, 1);
            __syncthreads();
            const int qt = *slot;
            __syncthreads();
            if (qt >= nq) break;
            const int b = bh >> 2, h = bh & 3;
            if (qt < 64) attn_unit(p, l, b, h, CTXL + qt * 128, KPOS, b * SEQ + qt * 128, (u16*)sm);
            else attn_unit(p, l, b, h, (qt - 64) * 128, CTXL, RLAT + b * CTXL + (qt - 64) * 128, (u16*)sm);
        }
    }
    }
    __builtin_amdgcn_sched_barrier(0);
    if (PART != 1)
    for (int v = bid; v < 3 * 1056; v += nb) {
        const int mix = v / 1056, r = v % 1056, g = r >> 2, h = r & 3;
        if (l == 1 && (g % NSTEP) < 4) continue;
        if (mix == 0) { PRB_BEGIN(131); gla_phaseC(p, l, g, h, sm); PRB_END(131); }
        else if (mix == 1) { PRB_BEGIN(132); ml_phaseC(p, l, g, h, sm); PRB_END(132); }
        else { PRB_BEGIN(133); gd_phaseC(p, l, g, h, sm); PRB_END(133); }
    }
}
#define LDS_BYTES 75776
#ifndef MULTI
#define MULTI 0
#endif
#ifndef STAGE
#define STAGE 99
#endif

enum { PH_PRO0 = 0, PH_PRO1, PH_NORM1, PH_INPROJ, PH_PREP, PH_CHUNKA, PH_SCAN, PH_OUT, PH_GATES, PH_MERGE1, PH_MERGE2, PH_ROUTER, PH_MOEUP, PH_MOEDOWN, PH_FINAL, PH_OUTC };

struct KArgs { const float* in[25]; float* out; unsigned char* ws; };
constexpr size_t al256c(size_t x) { return (x + 255) & ~(size_t)255; }
struct WsOff {
    size_t Wd, Wt2, bar, cnt, zero_end, modp, mod, xctx, rope, hbuf, ybuf, Wt, dq, dk, dvT, glaDec, mlN, mlFE, mlAE, mlM, glaS, mlS, gdM, gdN, gdQ, gdO, cols, total;
};
constexpr WsOff make_off() {
    WsOff o{}; size_t c = 0;
    const size_t nst = (size_t)2 * 2 * NSTEP * 4;
    o.bar = c; c = al256c(c + XCD_BAR_WORDS * 4);
    o.cnt = c; c = al256c(c + 1024);
    o.zero_end = c;
    o.modp = c; c = al256c(c + (size_t)2 * 16 * 3 * 6144 * 4);
    o.mod = c; c = al256c(c + (size_t)2 * 3 * 6144 * 4);
    o.xctx = c; c = al256c(c + (size_t)RCTX * DM * 4);
    o.rope = c; c = al256c(c + (size_t)192 * 8 * 2 * 4);
    o.hbuf = c; c = al256c(c + (size_t)RTOT * DM * 2);
    o.ybuf = c; c = al256c(c + (size_t)RTOT * DM * 2);
    o.Wt = c; c = al256c(c + (size_t)WT_TOTAL * 2);
    o.dq = c; c = al256c(c + (size_t)8 * KPOS * 64 * 2);
    o.dk = c; c = al256c(c + (size_t)8 * KPOS * 64 * 2);
    o.dvT = c; c = al256c(c + (size_t)8 * KPOS * 64 * 2);
    o.glaDec = c; c = al256c(c + nst * 64 * 4);
    o.mlN = c; c = al256c(c + nst * 64 * 4);
    o.mlFE = c; c = al256c(c + nst * 4);
    o.mlAE = c; c = al256c(c + nst * 4);
    o.mlM = c; c = al256c(c + nst * 4);
    o.glaS = c; c = al256c(c + nst * 4096 * 2);
    o.mlS = c; c = al256c(c + nst * 4096 * 2);
    o.gdM = c; c = al256c(c + nst * 4096 * 2);
    o.gdN = c; c = al256c(c + nst * 4096 * 2);
    o.gdQ = c; c = al256c(c + nst * 4096 * 2);
    o.gdO = c; c = al256c(c + nst * 4096 * 2);
    o.cols = c; c = al256c(c + (size_t)RTOT * NGATE * 2);
    o.Wd = c; c = al256c(c + (size_t)16 * 1024 * 512 * 2);
    o.Wt2 = c; c = al256c(c + (size_t)WT_TOTAL * 2);
    o.total = c;
    return o;
}
constexpr WsOff WSO = make_off();
template <class T> DEV T* launder_p(T* v) {
    __attribute__((address_space(1))) T* g = (__attribute__((address_space(1))) T*)v;
    asm volatile("" : "+s"(g));
    return (T*)g;
}
DEV P build_P(const KArgs& ka) {
    P p;
    const float* in[25];
#pragma unroll
    for (int i = 0; i < 25; ++i) in[i] = launder_p(ka.in[i]);
    p.x = in[0]; p.c = in[1]; p.ctx = in[2]; p.c_ctx = in[3]; p.w_mod = in[4]; p.b_mod = in[5]; p.norm_mix = in[6]; p.norm_ffn = in[7];
    p.w_in = in[8]; p.gla_a2 = in[9]; p.gla_ab = in[10]; p.mlstm_gate_b = in[11]; p.gdn_conv = in[12]; p.gdn_a_log = in[13];
    p.gdn_dt_bias = in[14]; p.diff_lambda = in[15]; p.head_norm = in[16]; p.w_branch = in[17]; p.w_out = in[18]; p.router_w = in[19];
    p.router_b = in[20]; p.w_gate = in[21]; p.w_up = in[22]; p.w_down = in[23]; p.norm_final = in[24];
    p.out = launder_p(ka.out);
    unsigned char* ws = launder_p(ka.ws);
    p.bar = (unsigned*)(ws + WSO.bar); p.cnt = (int*)(ws + WSO.cnt); p.modp = (float*)(ws + WSO.modp); p.mod = (float*)(ws + WSO.mod);
    p.xctx = (float*)(ws + WSO.xctx); p.rope = (float*)(ws + WSO.rope); p.hbuf = (u16*)(ws + WSO.hbuf); p.ybuf = (u16*)(ws + WSO.ybuf);
    p.Wt = (u16*)(ws + WSO.Wt); p.dq = (u16*)(ws + WSO.dq); p.dk = (u16*)(ws + WSO.dk); p.dvT = (u16*)(ws + WSO.dvT);
    p.glaDec = (float*)(ws + WSO.glaDec); p.mlN = (float*)(ws + WSO.mlN); p.mlFE = (float*)(ws + WSO.mlFE); p.mlAE = (float*)(ws + WSO.mlAE);
    p.mlM = (float*)(ws + WSO.mlM); p.glaS = (u16*)(ws + WSO.glaS); p.mlS = (u16*)(ws + WSO.mlS); p.gdM = (u16*)(ws + WSO.gdM);
    p.gdN = (u16*)(ws + WSO.gdN); p.gdQ = (u16*)(ws + WSO.gdQ); p.gdO = (u16*)(ws + WSO.gdO); p.cols = (u16*)(ws + WSO.cols); p.Wd = (u16*)(ws + WSO.Wd);
    return p;
}

template <int PH>
DEV void run_phase(const KArgs& ka, int l, int bid_, int nb_, unsigned char* sm) {
    P p = build_P(ka);
    u16* const Wt2 = (u16*)(launder_p(ka.ws) + WSO.Wt2);
    if (l == 1) p.Wt = Wt2;
    const int bid = launder_s(bid_), nb = launder_s(nb_);
    u16* gqkv = p.ybuf;
    u16* ubuf = p.glaS;
    const int mtiles = l == 0 ? 132 : 128;
    if (PH == PH_PRO0) { phase_conv_mixw(p, p.Wt, 0, bid, nb, 0, (float*)sm); phase_mod_partial(p, bid, nb, (float*)sm); phase_rope_table(p, bid, nb); }
    else if (PH == PH_PRO1) phase_mod_reduce(p, bid, nb);
    else if (PH == PH_NORM1) phase_norm1(p, l, bid, nb);
    else if (PH == PH_INPROJ) phase_inproj<false>(p, 0, 31, NCM, 66, bid, nb, (u16*)sm);
    else if (PH == PH_PREP) phase_prep(p, l, gqkv, bid, nb, (u16*)sm);
    else if (PH == PH_CHUNKA) phase_chunkA(p, l, gqkv, bid, nb, sm);
    else if (PH == PH_SCAN) {
        phase_scan(p, bid, nb, (u16*)sm);
        phase_conv_moed(p, l, bid, nb, nb > 400 ? 324 : 0, (float*)sm);
        if (l == 0) phase_conv_mixw(p, Wt2, 1, bid, nb, nb > 400 ? 324 : 0, (float*)sm);
    }
#ifdef PROBE_SPLIT
    else if (PH == PH_OUT) phase_outputs<1>(p, l, bid, nb, sm);
    else if (PH == PH_OUTC) phase_outputs<2>(p, l, bid, nb, sm);
#else
    else if (PH == PH_OUT) phase_outputs<0>(p, l, bid, nb, sm);
#endif
    else if (PH == PH_GATES) phase_inproj<true>(p, 3968, 32, NGATE, mtiles / 2, bid, nb, (u16*)sm);
    else if (PH == PH_MERGE1) phase_merge1(p, ubuf, mtiles, bid, nb, (u16*)sm);
    else if (PH == PH_MERGE2) { if (l == 0) phase_merge2s(p, l, ubuf, mtiles, bid, nb, (u16*)sm); else phase_merge2(p, l, ubuf, mtiles, bid, nb, (u16*)sm); }
    else if (PH == PH_ROUTER) {
        { PRB_BEGIN(110); phase_norm2_router(p, l, l == 0 ? RTOT : RLAT, bid, nb, (float*)sm); PRB_END(110); }
        { PRB_BEGIN(111); phase_conv_moew(p, l, bid, nb, (float*)sm); PRB_END(111); }
    }
    else if (PH == PH_MOEUP) phase_moe_up(p, l, bid, nb, (u16*)sm);
    else if (PH == PH_MOEDOWN) phase_moe_down_s(p, l, bid, nb, (u16*)sm);
    else if (PH == PH_FINAL) phase_final_norm(p, bid, nb);
}

#if MULTI
template <int PH>
__global__ void __launch_bounds__(NTHR, 2) k_phase(KArgs p, int l) {
    extern __shared__ __attribute__((aligned(16))) unsigned char smem[];
    run_phase<PH>(p, l, blockIdx.x, gridDim.x, smem);
}
#else
__global__ void __launch_bounds__(NTHR, 2) k_mega(KArgs p) {
    extern __shared__ __attribute__((aligned(16))) unsigned char smem[];
    volatile LAS unsigned* xbw = (volatile LAS unsigned*)(smem + LDS_BYTES);
    if (tidx() == 0) { xbw[0] = 0u; xbw[1] = 0u; xbw[2] = 0u; xbw[3] = 0u; }
    __syncthreads();
    (void)xcd_barrier_post((unsigned*)(p.ws + WSO.bar), xbw);
    const int bid = blockIdx.x, nb = gridDim.x;
#ifdef PROBE_SEL
    unsigned long long pr_t0 = wall_clock64();
    volatile LAS unsigned long long* pr_acc = (volatile LAS unsigned long long*)(smem + LDS_BYTES + 8);
#ifdef PROBE_CLK
    unsigned long long pr_c0 = __builtin_readcyclecounter();
#define PSTAMP(PH) do { const unsigned long long c_ = __builtin_readcyclecounter(); if ((PH) == PROBE_SEL && threadIdx.x == 0) *pr_acc = *pr_acc + (c_ - pr_c0) / 24ull; pr_c0 = c_; } while (0)
#else
#define PSTAMP(PH) do { const unsigned long long t_ = wall_clock64(); if ((PH) == PROBE_SEL && threadIdx.x == 0) *pr_acc = *pr_acc + (t_ - pr_t0); pr_t0 = t_; } while (0)
#endif
#else
#define PSTAMP(PH) do { } while (0)
#endif
#ifdef PROBE_2BAR
#define GBAR() do { GBAR1(); GBAR1(); } while (0)
#else
#define GBAR() GBAR1()
#endif
#define GBAR1() do { XcdBarrier b_; b_.bar = (unsigned*)(launder_p(p.ws) + WSO.bar); b_.x = xb_xcc_id(); b_.st = (volatile LAS unsigned*)(smem + LDS_BYTES); xcd_barrier(b_); } while (0)
    run_phase<PH_PRO0>(p, 0, bid, nb, smem); GBAR(); PSTAMP(PH_PRO0);
    run_phase<PH_PRO1>(p, 0, bid, nb, smem); GBAR(); PSTAMP(PH_PRO1);
    for (int l = 0; l < 2; ++l) {
        run_phase<PH_NORM1>(p, l, bid, nb, smem); GBAR(); PSTAMP(PH_NORM1);
        run_phase<PH_INPROJ>(p, l, bid, nb, smem); GBAR(); PSTAMP(PH_INPROJ);
#ifdef PROBE_GEMM
        { PRB_BEGIN(200); const P pp = build_P(p); phase_inproj<false, PROBE_GEMM>(pp, 0, 31, NCM, 66, launder_s(bid), launder_s(nb), (u16*)smem); PRB_END(200); } GBAR();
#endif
        run_phase<PH_PREP>(p, l, bid, nb, smem); GBAR(); PSTAMP(PH_PREP);
        run_phase<PH_CHUNKA>(p, l, bid, nb, smem); GBAR(); PSTAMP(PH_CHUNKA);
        run_phase<PH_SCAN>(p, l, bid, nb, smem); GBAR(); PSTAMP(PH_SCAN);
        run_phase<PH_OUT>(p, l, bid, nb, smem); GBAR(); PSTAMP(PH_OUT);
#ifdef PROBE_SPLIT
        run_phase<PH_OUTC>(p, l, bid, nb, smem); GBAR(); PSTAMP(PH_OUTC);
#endif
        run_phase<PH_GATES>(p, l, bid, nb, smem); GBAR(); PSTAMP(PH_GATES);
        run_phase<PH_MERGE1>(p, l, bid, nb, smem); GBAR(); PSTAMP(PH_MERGE1);
        run_phase<PH_MERGE2>(p, l, bid, nb, smem); GBAR(); PSTAMP(PH_MERGE2);
        run_phase<PH_ROUTER>(p, l, bid, nb, smem); GBAR(); PSTAMP(PH_ROUTER);
        run_phase<PH_MOEUP>(p, l, bid, nb, smem); GBAR(); PSTAMP(PH_MOEUP);
        run_phase<PH_MOEDOWN>(p, l, bid, nb, smem); GBAR(); PSTAMP(PH_MOEDOWN);
    }
    run_phase<PH_FINAL>(p, 0, bid, nb, smem);
#ifdef PROBE_SEL
    __syncthreads();
    { const unsigned long long te = wall_clock64(), wt = *pr_acc * 4ull; while (wall_clock64() - te < wt) __builtin_amdgcn_s_sleep(8); }
#endif
}
#endif

static size_t al256(size_t x) { return (x + 255) & ~(size_t)255; }

extern "C" void kernel_launch(void* const* d_in, const int* in_sizes, int n_in, void* d_out, int out_size, void* d_ws, size_t ws_size,
                              hipStream_t stream) {
    (void)in_sizes; (void)n_in; (void)out_size;
    if (ws_size < WSO.total) return;
    KArgs p{};
    for (int i = 0; i < 25; ++i) p.in[i] = (const float*)d_in[i];
    p.out = (float*)d_out;
    p.ws = (unsigned char*)d_ws;
    unsigned char* ws = (unsigned char*)d_ws;
    const size_t zero_bytes = WSO.zero_end;
    hipMemsetAsync(ws, 0, zero_bytes, stream);

    static int grid = 0;
#if MULTI
#define SETUP(PH) hipFuncSetAttribute((const void*)k_phase<PH>, hipFuncAttributeMaxDynamicSharedMemorySize, LDS_BYTES + 16)
    if (!grid) {
        SETUP(PH_PRO0); SETUP(PH_PRO1); SETUP(PH_NORM1); SETUP(PH_INPROJ); SETUP(PH_PREP); SETUP(PH_CHUNKA); SETUP(PH_SCAN); SETUP(PH_OUT);
        SETUP(PH_GATES); SETUP(PH_MERGE1); SETUP(PH_MERGE2); SETUP(PH_ROUTER); SETUP(PH_MOEUP); SETUP(PH_MOEDOWN); SETUP(PH_FINAL);
        grid = 512;
    }
#define LAUNCH(PH, l) k_phase<PH><<<grid, NTHR, LDS_BYTES + 16, stream>>>(p, l)
    LAUNCH(PH_PRO0, 0); LAUNCH(PH_PRO1, 0);
    for (int l = 0; l < 2; ++l) {
        LAUNCH(PH_NORM1, l);
#if STAGE >= 1
        LAUNCH(PH_INPROJ, l); LAUNCH(PH_PREP, l); LAUNCH(PH_CHUNKA, l); LAUNCH(PH_SCAN, l); LAUNCH(PH_OUT, l);
        LAUNCH(PH_GATES, l); LAUNCH(PH_MERGE1, l); LAUNCH(PH_MERGE2, l);
#endif
        LAUNCH(PH_ROUTER, l); LAUNCH(PH_MOEUP, l); LAUNCH(PH_MOEDOWN, l);
    }
    LAUNCH(PH_FINAL, 0);
#else
    if (!grid) {
        hipFuncSetAttribute((const void*)k_mega, hipFuncAttributeMaxDynamicSharedMemorySize, LDS_BYTES + 16);
        int dev = 0, cus = 0, per_cu = 0;
        hipGetDevice(&dev);
        hipDeviceGetAttribute(&cus, hipDeviceAttributeMultiprocessorCount, dev);
        hipOccupancyMaxActiveBlocksPerMultiprocessor(&per_cu, (const void*)k_mega, NTHR, LDS_BYTES + 16);
        if (per_cu > 2) per_cu = 2;
        if (per_cu < 1) per_cu = 1;
        grid = cus * per_cu;
    }
    k_mega<<<grid, NTHR, LDS_BYTES + 16, stream>>>(p);
#endif
}
```

```cpp
#include <hip/hip_runtime.h>
#include <stdint.h>
#include <math.h>

typedef unsigned short u16;
typedef short bf16x8 __attribute__((ext_vector_type(8)));
typedef float f32x4 __attribute__((ext_vector_type(4)));
typedef unsigned u32x2 __attribute__((ext_vector_type(2)));
typedef unsigned u32x4 __attribute__((ext_vector_type(4)));

#define DEV __device__ __forceinline__
#define NTHR 256

#define DM 1024
#define RLAT 16384
#define RCTX 512
#define RTOT 16896
#define SEQ 8192
#define CTXL 256
#define NCM 3968
#define NGATE 4096
#define NSTEP 132
#define KPOS 8448
#define EPSF 1e-6f
#define GLA_Q 0
#define GLA_K 256
#define GLA_V 512
#define GLA_G 768
#define GLA_RF 1024
#define GLA_RB 1040
#define ML_Q 1056
#define ML_K 1312
#define ML_V 1568
#define ML_O 1824
#define ML_GF 2080
#define ML_GB 2088
#define GD_Q 2096
#define GD_K 2352
#define GD_V 2608
#define GD_OG 2864
#define GD_GF 3120
#define GD_GB 3128
#define DF_Q 3136
#define DF_K 3392
#define DF_V 3648

DEV int tidx() { int t = threadIdx.x; asm volatile("" : "+v"(t)); __builtin_assume(t >= 0 && t < NTHR); return t; }
DEV int launder_s(int v) { asm volatile("" : "+s"(v)); return v; }
typedef __bf16 bf2_t __attribute__((ext_vector_type(2)));
typedef float f2_t __attribute__((ext_vector_type(2)));
DEV unsigned pack2(float a, float b) { f2_t v; v.x = a; v.y = b; return __builtin_bit_cast(unsigned, __builtin_convertvector(v, bf2_t)); }
DEV u16 f2bf(float f) { return (u16)(pack2(f, 0.f) & 0xffffu); }
DEV float bf2f(u16 h) { return __uint_as_float(((unsigned)h) << 16); }
DEV float sigm(float x) { return 1.f / (1.f + __expf(-x)); }
DEV float silu(float x) { return x / (1.f + __expf(-x)); }
DEV float logsig(float x) { return fminf(x, 0.f) - __logf(1.f + __expf(-fabsf(x))); }
DEV float softplus(float x) { return fmaxf(x, 0.f) + __logf(1.f + __expf(-fabsf(x))); }
DEV float shx(float v, int o) { return __shfl_xor(v, o, 64); }
DEV float shidx(float v, int src) { return __int_as_float(__builtin_amdgcn_ds_bpermute(src << 2, __float_as_int(v))); }
DEV float shup(float v, int o) { const int l = tidx() & 63; return __int_as_float(__builtin_amdgcn_ds_bpermute((l >= o ? l - o : l) << 2, __float_as_int(v))); }
DEV float wsum(float v) {
    const int l4 = (tidx() & 63) << 2;
#pragma unroll
    for (int o = 32; o; o >>= 1) v += __int_as_float(__builtin_amdgcn_ds_bpermute(l4 ^ (o << 2), __float_as_int(v)));
    return v;
}
DEV float wmaxr(float v) {
    const int l4 = (tidx() & 63) << 2;
#pragma unroll
    for (int o = 32; o; o >>= 1) v = fmaxf(v, __int_as_float(__builtin_amdgcn_ds_bpermute(l4 ^ (o << 2), __float_as_int(v))));
    return v;
}
DEV f32x4 mfma16(bf16x8 a, bf16x8 b, f32x4 c) { return __builtin_amdgcn_mfma_f32_16x16x32_bf16(a, b, c, 0, 0, 0); }

#ifdef PROBE_SEL
#define PRB_BEGIN(id) unsigned long long prb_t0_##id = ((id) == PROBE_SEL) ? wall_clock64() : 0ull
#define PRB_END(id) do { if ((id) == PROBE_SEL) { __syncthreads(); if (threadIdx.x == 0) { volatile __attribute__((address_space(3))) unsigned long long* a_ = (volatile __attribute__((address_space(3))) unsigned long long*)(size_t)(75776 + 8); *a_ = *a_ + (wall_clock64() - prb_t0_##id); } } } while (0)
#else
#define PRB_BEGIN(id) do { } while (0)
#define PRB_END(id) do { } while (0)
#endif
#define RAW_BARRIER() do { asm volatile("s_waitcnt lgkmcnt(0)" ::: "memory"); __builtin_amdgcn_s_barrier(); } while (0)
struct P {
    const float *x, *c, *ctx, *c_ctx, *w_mod, *b_mod, *norm_mix, *norm_ffn, *w_in, *gla_a2, *gla_ab, *mlstm_gate_b,
        *gdn_conv, *gdn_a_log, *gdn_dt_bias, *diff_lambda, *head_norm, *w_branch, *w_out, *router_w, *router_b,
        *w_gate, *w_up, *w_down, *norm_final;
    float* out;
    unsigned* bar;
    int* cnt;
    float* modp;
    float* mod;
    float* xctx;
    float* rope;
    u16* hbuf;
    u16* ybuf;
    u16* Wt;
    u16* dq;
    u16* dk;
    u16* dvT;
    float* glaDec;
    float* mlN;
    float* mlFE;
    float* mlAE;
    float* mlM;
    u16* glaS;
    u16* mlS;
    u16* gdM;
    u16* gdN;
    u16* gdQ;
    u16* gdO;
    u16* cols;
    u16* Wd;
};
#define MOE_WGU_OFF 0
#define MOE_WD_OFF (16u * 1024u * 1024u)
#define MOE_ACT_OFF (MOE_WD_OFF + 16u * 1024u * 512u)
#define MOE_LIST_OFF (MOE_ACT_OFF + 2u * RTOT * 512u)

DEV const float* xrow_in(const P& p, int l, int r) {
    if (l == 0) return r < RLAT ? p.x + (size_t)r * DM : p.ctx + (size_t)(r - RLAT) * DM;
    return r < RLAT ? p.out + (size_t)r * DM : p.xctx + (size_t)(r - RLAT) * DM;
}
DEV float* xrow_out(const P& p, int r) { return r < RLAT ? p.out + (size_t)r * DM : p.xctx + (size_t)(r - RLAT) * DM; }
DEV int modidx(int r) { return r < RLAT ? (r >> 13) : 2; }
DEV int chunk_row0(int b, int dir, int st) {
    if (st < 4) { int c = dir ? 3 - st : st; return RLAT + b * CTXL + c * 64; }
    int c = dir ? 131 - st : st - 4; return b * SEQ + c * 64;
}
DEV size_t state_idx(int dir, int b, int st, int h) { return ((size_t)((dir * 2 + b) * NSTEP + st) * 4 + h); }
#define XB_TMO      128
#define XB_XCNT(j)  (256  + 64 * (j))
#define XB_XSUB(j)  (1280 + 64 * (j))
#define XB_XGEN(j)  (2304 + 64 * (j))
#define XB_TOP      3328
#define XB_TOPGEN   3392
#define XCD_BAR_WORDS 3456
#define XB_SPIN_CAP (1u << 18)
#define LAS __attribute__((address_space(3)))

__device__ __forceinline__ unsigned xb_ld(unsigned* p)              { return __hip_atomic_load(p, __ATOMIC_RELAXED, __HIP_MEMORY_SCOPE_AGENT); }
__device__ __forceinline__ unsigned xb_add(unsigned* p, unsigned v) { return __hip_atomic_fetch_add(p, v, __ATOMIC_RELAXED, __HIP_MEMORY_SCOPE_AGENT); }
__device__ __forceinline__ unsigned xb_xcc_id() { return (unsigned)__builtin_amdgcn_s_getreg((3 << 11) | 20) & 0xFu; }
#define XB_SPIN(cond, bar) do { unsigned _sp = 0; while (cond) { __builtin_amdgcn_s_sleep(1); \
    if ((++_sp & 255u) == 0u) { if (xb_ld(&(bar)[XB_TMO])) break; if (_sp > XB_SPIN_CAP) { atomicAdd(&(bar)[XB_TMO], 1u); break; } } } } while (0)

struct XcdBarrier {
    unsigned* bar; unsigned x;
    volatile LAS unsigned* st;
};

__device__ __forceinline__ XcdBarrier xcd_barrier_post(unsigned* bar, volatile LAS unsigned* st) {
    XcdBarrier b; b.bar = bar; b.x = xb_xcc_id(); b.st = st;
    if (tidx() == 0) (void)xb_add(&bar[XB_XCNT(b.x)], 1u);
    return b;
}
__device__ __forceinline__ void xcd_barrier_complete(unsigned* bar, unsigned x, unsigned& nloc, unsigned& nx) {
    const unsigned G = gridDim.x * gridDim.y * gridDim.z;
    unsigned sum, cnt, mine, sp = 0u;
    for (;;) {
        sum = 0u; cnt = 0u; mine = 0u;
#pragma unroll
        for (unsigned j = 0; j < 16; ++j) { const unsigned c = xb_ld(&bar[XB_XCNT(j)]); sum += c; cnt += (c > 0u) ? 1u : 0u; mine = (j == x) ? c : mine; }
        if (sum == G) break;
        __builtin_amdgcn_s_sleep(1);
        if ((++sp & 255u) == 0u) { if (xb_ld(&bar[XB_TMO])) break; if (sp > XB_SPIN_CAP) { atomicAdd(&bar[XB_TMO], 1u); break; } }
    }
    nloc = mine > 0u ? mine : 1u; nx = cnt > 0u ? cnt : 1u;
}

__device__ __forceinline__ void xcd_barrier(const XcdBarrier& b) {
    asm volatile("s_waitcnt vmcnt(0)" ::: "memory");
    __syncthreads();
    if (tidx() == 0) {
        unsigned* bar = b.bar;
        __builtin_amdgcn_s_waitcnt(0);
        unsigned nloc = b.st[0], nx = b.st[1];
        if (nloc == 0u) { xcd_barrier_complete(bar, b.x, nloc, nx); b.st[0] = nloc; b.st[1] = nx; }
        const unsigned old = xb_add(&bar[XB_XSUB(b.x)], 1u);
        const unsigned gen = old / nloc;
        if (old + 1u == (gen + 1u) * nloc) {
            __builtin_amdgcn_fence(__ATOMIC_RELEASE, "agent");
            asm volatile("s_waitcnt vmcnt(0)" ::: "memory");
            const unsigned og = xb_add(&bar[XB_TOP], 1u);
            const unsigned tg = og / nx;
            if (og + 1u == (tg + 1u) * nx) xb_add(&bar[XB_TOPGEN], 1u);
            else XB_SPIN(xb_ld(&bar[XB_TOPGEN]) == tg, bar);
            __builtin_amdgcn_fence(__ATOMIC_ACQUIRE, "agent");
            xb_add(&bar[XB_XGEN(b.x)], 1u);
            asm volatile("s_waitcnt vmcnt(0)" ::: "memory");
        } else {
            XB_SPIN(xb_ld(&bar[XB_XGEN(b.x)]) == gen, bar);
            __builtin_amdgcn_fence(__ATOMIC_ACQUIRE, "agent");
            asm volatile("s_waitcnt vmcnt(0)" ::: "memory");
        }
    }
    __syncthreads();
}
struct TrJob { const float* src; u16* dst; int lds_, ldd, map; };
DEV int tr_rowmap(int map, int n) {
    if (map == 1) return n < 3904 ? n : n + 64;
    if (map == 2) return (n >> 5) * 64 + (n & 31);
    if (map == 3) return (n >> 5) * 64 + 32 + (n & 31);
    return n;
}
struct TrRegs { f32x4 r0, r1, r2, r3; };
DEV void tr_load(const TrJob& j, TrRegs& q) {
    const int t = tidx(), n4 = (t & 15) * 4, kp = t >> 4;
    const float* s0 = j.src + (size_t)(2 * kp) * j.lds_ + n4;
    const float* s1 = j.src + (size_t)(2 * (kp + 16)) * j.lds_ + n4;
    q.r0 = *(const f32x4*)s0; q.r1 = *(const f32x4*)(s0 + j.lds_);
    q.r2 = *(const f32x4*)s1; q.r3 = *(const f32x4*)(s1 + j.lds_);
}
DEV void tr_finish(const TrJob& j, int n0, const TrRegs& q, float* smf) {
    unsigned* sm = (unsigned*)smf;
    const int t = tidx();
    {
        const int n4 = (t & 15) * 4, kp = t >> 4;
        sm[(n4 + 0) * 33 + kp] = pack2(q.r0[0], q.r1[0]); sm[(n4 + 1) * 33 + kp] = pack2(q.r0[1], q.r1[1]);
        sm[(n4 + 2) * 33 + kp] = pack2(q.r0[2], q.r1[2]); sm[(n4 + 3) * 33 + kp] = pack2(q.r0[3], q.r1[3]);
        sm[(n4 + 0) * 33 + kp + 16] = pack2(q.r2[0], q.r3[0]); sm[(n4 + 1) * 33 + kp + 16] = pack2(q.r2[1], q.r3[1]);
        sm[(n4 + 2) * 33 + kp + 16] = pack2(q.r2[2], q.r3[2]); sm[(n4 + 3) * 33 + kp + 16] = pack2(q.r2[3], q.r3[3]);
    }
    __syncthreads();
    {
        const int n = t >> 2, kq = (t & 3) * 8;
        u32x4 o0, o1;
        o0.x = sm[n * 33 + kq + 0]; o0.y = sm[n * 33 + kq + 1]; o0.z = sm[n * 33 + kq + 2]; o0.w = sm[n * 33 + kq + 3];
        o1.x = sm[n * 33 + kq + 4]; o1.y = sm[n * 33 + kq + 5]; o1.z = sm[n * 33 + kq + 6]; o1.w = sm[n * 33 + kq + 7];
        u16* d = j.dst + (size_t)tr_rowmap(j.map, n0 + n) * j.ldd + kq * 2;
        *(u32x4*)d = o0; *(u32x4*)(d + 8) = o1;
    }
    __syncthreads();
}
#define WT_WB_OFF (8064u * 1024u)
#define WT_WO_OFF (WT_WB_OFF + 4u * 1024u * 256u)
#define WT_TOTAL (WT_WO_OFF + 1024u * 1024u)

DEV TrJob mixw_job(const P& p, u16* Wb, int l, int u, int& n0) {
    TrJob j;
    if (u < 2000) {
        const int kt = u / 125, nt = u % 125; n0 = nt * 64;
        j.src = p.w_in + (size_t)l * 1024 * 8000 + (size_t)kt * 64 * 8000 + n0; j.lds_ = 8000; j.dst = Wb + kt * 64; j.ldd = 1024; j.map = 1;
    } else if (u < 2256) {
        const int v = u - 2000, i = v >> 6, w = v & 63, kt = w >> 4, nt = w & 15; n0 = nt * 64;
        j.src = p.w_branch + (size_t)(l * 4 + i) * 256 * 1024 + (size_t)kt * 64 * 1024 + n0; j.lds_ = 1024;
        j.dst = Wb + WT_WB_OFF + (size_t)i * 1024 * 256 + kt * 64; j.ldd = 256; j.map = 0;
    } else {
        const int v = u - 2256, kt = v >> 4, nt = v & 15; n0 = nt * 64;
        j.src = p.w_out + (size_t)l * 1024 * 1024 + (size_t)kt * 64 * 1024 + n0; j.lds_ = 1024; j.dst = Wb + WT_WO_OFF + kt * 64; j.ldd = 1024; j.map = 0;
    }
    return j;
}
DEV void phase_conv_mixw(const P& p, u16* Wb, int l, int bid, int nb, int b0, float* sm) {
    if (bid < b0) return;
    const int step = nb - b0;
    if (bid == nb - 1) {
        unsigned* z = (unsigned*)(Wb + (size_t)3904 * 1024);
        for (int i = tidx(); i < 64 * 1024 / 2; i += NTHR) z[i] = 0u;
    }
    int u = bid - b0, n0 = 0, n1 = 0;
    if (u >= 2512) return;
    TrRegs r;
    TrJob j = mixw_job(p, Wb, l, u, n0);
    tr_load(j, r);
    for (;;) {
        const int un = u + step;
        TrRegs rn; TrJob jn = j;
        if (un < 2512) { jn = mixw_job(p, Wb, l, un, n1); tr_load(jn, rn); }
        tr_finish(j, n0, r, sm);
        if (un >= 2512) break;
        u = un; j = jn; n0 = n1; r = rn;
    }
}
DEV TrJob moew_job(const P& p, int l, int u, int& n0) {
    TrJob j;
    u16* wgu = p.cols + MOE_WGU_OFF;
    const int e = u >> 8, v = u & 255;
    const size_t le = (size_t)(l * 16 + e);
    const int w = v & 127, kt = w >> 3, nt = w & 7; n0 = nt * 64;
    j.src = (v < 128 ? p.w_gate : p.w_up) + le * 1024 * 512 + (size_t)kt * 64 * 512 + n0; j.lds_ = 512;
    j.dst = wgu + (size_t)e * 1024 * 1024 + kt * 64; j.ldd = 1024; j.map = v < 128 ? 2 : 3;
    return j;
}
DEV TrJob moed_job(const P& p, int l, int u, int& n0) {
    TrJob j;
    const int e = u >> 7, w = u & 127, kt = w >> 4, nt = w & 15; n0 = nt * 64;
    const size_t le = (size_t)(l * 16 + e);
    j.src = p.w_down + le * 512 * 1024 + (size_t)kt * 64 * 1024 + n0; j.lds_ = 1024; j.dst = p.Wd + (size_t)e * 1024 * 512 + kt * 64; j.ldd = 512; j.map = 0;
    return j;
}
DEV void phase_conv_moed(const P& p, int l, int bid, int nb, int b0, float* sm) {
    if (bid < b0) return;
    const int step = nb - b0;
    int u = bid - b0, n0 = 0, n1 = 0;
    if (u >= 16 * 128) return;
    TrRegs r;
    TrJob j = moed_job(p, l, u, n0);
    tr_load(j, r);
    for (;;) {
        const int un = u + step;
        TrRegs rn; TrJob jn = j;
        if (un < 16 * 128) { jn = moed_job(p, l, un, n1); tr_load(jn, rn); }
        tr_finish(j, n0, r, sm);
        if (un >= 16 * 128) break;
        u = un; j = jn; n0 = n1; r = rn;
    }
}
DEV void phase_conv_moew(const P& p, int l, int bid, int nb, float* sm) {
    int u = bid, n0 = 0, n1 = 0;
    if (u >= 16 * 256) return;
    TrRegs r;
    TrJob j = moew_job(p, l, u, n0);
    tr_load(j, r);
    for (;;) {
        const int un = u + nb;
        TrRegs rn; TrJob jn = j;
        if (un < 16 * 256) { jn = moew_job(p, l, un, n1); tr_load(jn, rn); }
        tr_finish(j, n0, r, sm);
        if (un >= 16 * 256) break;
        u = un; j = jn; n0 = n1; r = rn;
    }
}

DEV void phase_mod_partial(const P& p, int bid, int nb, float* sm) {
    for (int u = bid; u < 768; u += nb) {
        const int l = u / 384, v = u % 384, kc = v / 24, jb = v % 24;
        const int t = tidx();
        __syncthreads();
        if (t < 192) {
            const int m = t >> 6, k = kc * 64 + (t & 63);
            const float cv = m < 2 ? p.c[m * 1024 + k] : p.c_ctx[k];
            sm[t] = silu(cv);
        }
        __syncthreads();
        const int j = jb * 256 + t;
        const float* w = p.w_mod + ((size_t)l * 1024 + kc * 64) * 6144 + j;
        float a0 = 0.f, a1 = 0.f, a2 = 0.f;
#pragma unroll 8
        for (int k = 0; k < 64; ++k) {
            const float wv = w[(size_t)k * 6144];
            a0 += sm[k] * wv; a1 += sm[64 + k] * wv; a2 += sm[128 + k] * wv;
        }
        float* o = p.modp + ((size_t)(l * 16 + kc) * 3) * 6144 + j;
        o[0] = a0; o[6144] = a1; o[2 * 6144] = a2;
    }
}
DEV void phase_mod_reduce(const P& p, int bid, int nb) {
    for (int i = bid * NTHR + tidx(); i < 2 * 3 * 6144; i += nb * NTHR) {
        const int l = i / (3 * 6144), r = i % (3 * 6144), m = r / 6144, j = r % 6144;
        float a = p.b_mod[l * 6144 + j];
        for (int kc = 0; kc < 16; ++kc) a += p.modp[((size_t)(l * 16 + kc) * 3 + m) * 6144 + j];
        p.mod[i] = a;
    }
}

DEV void moe_combine_row(const P& p, int l, int r, int lane, float4 (&v)[4]);
DEV void phase_norm1(const P& p, int l, int bid, int nb) {
    const int lane = tidx() & 63, w = tidx() >> 6;
    for (int r0 = (bid * 4 + w) * 2; r0 < RTOT; r0 += nb * 8) {
        f32x4 v[2][4];
#pragma unroll
        for (int q = 0; q < 2; ++q) {
            const float* xr = xrow_in(p, l, r0 + q);
#pragma unroll
            for (int i = 0; i < 4; ++i) v[q][i] = *(const f32x4*)(xr + lane * 4 + i * 256);
        }
#pragma unroll
        for (int q = 0; q < 2; ++q) {
            const int r = r0 + q;
            const int m = modidx(r);
            const float* sh = p.mod + ((size_t)(l * 3 + m)) * 6144;
            const float* sc = sh + 1024;
            float4 t[4];
#pragma unroll
            for (int i = 0; i < 4; ++i) { t[i].x = v[q][i][0]; t[i].y = v[q][i][1]; t[i].z = v[q][i][2]; t[i].w = v[q][i][3]; }
            if (l == 1) {
                moe_combine_row(p, 0, r, lane, t);
                float* xw = xrow_out(p, r);
#pragma unroll
                for (int i = 0; i < 4; ++i) *(float4*)(xw + lane * 4 + i * 256) = t[i];
            }
            float ss = 0.f;
#pragma unroll
            for (int i = 0; i < 4; ++i) ss += t[i].x * t[i].x + t[i].y * t[i].y + t[i].z * t[i].z + t[i].w * t[i].w;
            ss = wsum(ss);
            const float rs = rsqrtf(ss * (1.f / 1024.f) + EPSF);
#pragma unroll
            for (int i = 0; i < 4; ++i) {
                const int c = lane * 4 + i * 256;
                const float4 g = *(const float4*)(p.norm_mix + l * 1024 + c);
                const float4 s1 = *(const float4*)(sc + c);
                const float4 h1 = *(const float4*)(sh + c);
                const float o0 = t[i].x * rs * g.x * (1.f + s1.x) + h1.x;
                const float o1 = t[i].y * rs * g.y * (1.f + s1.y) + h1.y;
                const float o2 = t[i].z * rs * g.z * (1.f + s1.z) + h1.z;
                const float o3 = t[i].w * rs * g.w * (1.f + s1.w) + h1.w;
                u32x2 pk; pk.x = pack2(o0, o1); pk.y = pack2(o2, o3);
                *(u32x2*)(p.hbuf + (size_t)r * 1024 + c) = pk;
            }
        }
    }
}

#define LDP 72
#define GEMM_STAGE (2 * 128 * 64)
DEV int g_row(int tid, int i) { return (tid >> 6) * 32 + i * 8 + ((tid >> 3) & 7); }
DEV int g_kc(int tid, int row) { return ((tid & 7) ^ ((row >> 1) & 7)) * 8; }
DEV void gemm_mainloop(f32x4 (&acc)[4][4], const u16* const (&xp)[4], const u16* const (&wp)[4], int KT, u16* sm, u16*  ) {
    const int tid = tidx(), lane = tid & 63, w = tid >> 6, wn = w & 1, wm = w >> 1;
    const int fr = lane & 15, fq = lane >> 4, sw = (fr >> 1) & 7;
    asm volatile("s_waitcnt vmcnt(0)" ::: "memory");
#pragma unroll
    for (int i = 0; i < 4; ++i) {
        __builtin_amdgcn_global_load_lds((const unsigned*)xp[i], (unsigned*)(sm + (w * 4 + i) * 512), 16, 0, 0);
        __builtin_amdgcn_global_load_lds((const unsigned*)wp[i], (unsigned*)(sm + 128 * 64 + (w * 4 + i) * 512), 16, 0, 0);
    }
    for (int kt = 0; kt < KT; ++kt) {
        asm volatile("s_waitcnt vmcnt(0)" ::: "memory");
        RAW_BARRIER();
        if (kt + 1 < KT) {
            u16* nx = sm + ((kt + 1) & 1) * GEMM_STAGE;
#pragma unroll
            for (int i = 0; i < 4; ++i) {
                __builtin_amdgcn_global_load_lds((const unsigned*)(xp[i] + (kt + 1) * 64), (unsigned*)(nx + (w * 4 + i) * 512), 16, 0, 0);
                __builtin_amdgcn_global_load_lds((const unsigned*)(wp[i] + (kt + 1) * 64), (unsigned*)(nx + 128 * 64 + (w * 4 + i) * 512), 16, 0, 0);
            }
        }
        const u16* sX = sm + (kt & 1) * GEMM_STAGE;
        const u16* sW = sX + 128 * 64;
#pragma unroll
        for (int ks = 0; ks < 2; ++ks) {
            bf16x8 a[4], b[4];
#pragma unroll
            for (int q = 0; q < 4; ++q) {
                a[q] = *(const bf16x8*)(sW + (wn * 64 + q * 16 + fr) * 64 + (((ks * 4 + fq) ^ sw) * 8));
                b[q] = *(const bf16x8*)(sX + (wm * 64 + q * 16 + fr) * 64 + (((ks * 4 + fq) ^ sw) * 8));
            }
#pragma unroll
            for (int nt = 0; nt < 4; ++nt)
#pragma unroll
                for (int mt = 0; mt < 4; ++mt) acc[nt][mt] = mfma16(a[nt], b[mt], acc[nt][mt]);
        }
    }
    RAW_BARRIER();
}
DEV void zero_acc(f32x4 (&acc)[4][4]) {
#pragma unroll
    for (int a = 0; a < 4; ++a)
#pragma unroll
        for (int b = 0; b < 4; ++b) acc[a][b] = f32x4{0.f, 0.f, 0.f, 0.f};
}

#define GB_STAGE (384 * 32)
DEV void gemmb_issue(const u16* const (&xp)[4], const u16* const (&wp)[2], int kt, u16* stg, int w) {
#pragma unroll
    for (int i = 0; i < 4; ++i) __builtin_amdgcn_global_load_lds((const unsigned*)(xp[i] + kt * 32), (unsigned*)(stg + (w * 4 + i) * 512), 16, 0, 0);
#pragma unroll
    for (int i = 0; i < 2; ++i) __builtin_amdgcn_global_load_lds((const unsigned*)(wp[i] + kt * 32), (unsigned*)(stg + 256 * 32 + (w * 2 + i) * 512), 16, 0, 0);
}
DEV void gemmB_lane(int i, int nrow_pieces_per_wave, int& row, int& chunk) {
    const int t = tidx(), l = t & 63, w = t >> 6;
    row = (w * nrow_pieces_per_wave + i) * 16 + (l >> 2);
    chunk = ((l & 3) ^ ((l >> 4) & 3)) * 8;
}
DEV void gemmB_mainloop(f32x4 (&acc)[4][8], const u16* xb, const unsigned (&xo)[4], const u16* wb, const unsigned (&wo)[2], int KT, u16* sm) {
    const int tid = tidx(), lane = tid & 63, w = tid >> 6, wn = w & 1, wm = w >> 1, fr = lane & 15, fq = lane >> 4;
    const int sw = (fr >> 2) & 3;
    const int aoff = (wn * 64 + fr) * 32 + ((fq ^ sw) * 8) + 256 * 32;
    const int boff = (wm * 128 + fr) * 32 + ((fq ^ sw) * 8);
#pragma unroll
    for (int a = 0; a < 4; ++a)
#pragma unroll
        for (int b = 0; b < 8; ++b) acc[a][b] = f32x4{0.f, 0.f, 0.f, 0.f};
    asm volatile("s_waitcnt vmcnt(0)" ::: "memory");
#pragma unroll
    for (int t0 = 0; t0 < 2; ++t0) {
#pragma unroll
        for (int i = 0; i < 4; ++i) __builtin_amdgcn_global_load_lds((const unsigned*)(xb + xo[i] + t0 * 32), (unsigned*)(sm + t0 * GB_STAGE + (w * 4 + i) * 512), 16, 0, 0);
#pragma unroll
        for (int i = 0; i < 2; ++i) __builtin_amdgcn_global_load_lds((const unsigned*)(wb + wo[i] + t0 * 32), (unsigned*)(sm + t0 * GB_STAGE + 256 * 32 + (w * 2 + i) * 512), 16, 0, 0);
    }
    asm volatile("s_waitcnt vmcnt(6)" ::: "memory");
    RAW_BARRIER();
    bf16x8 a[4], b[8];
#pragma unroll
    for (int q = 0; q < 4; ++q) a[q] = *(const bf16x8*)(sm + aoff + q * 512);
#pragma unroll
    for (int q = 0; q < 8; ++q) b[q] = *(const bf16x8*)(sm + boff + q * 512);
    for (int kt = 0; kt < KT; ++kt) {
        asm volatile("s_waitcnt vmcnt(0)" ::: "memory");
        RAW_BARRIER();
        const bool more = kt + 2 < KT, nxt = kt + 1 < KT;
        u16* nx = sm + ((kt + 2) % 3) * GB_STAGE;
        const u16* cur = sm + ((kt + 1) % 3) * GB_STAGE;
#pragma unroll
        for (int h = 0; h < 2; ++h) {
            if (more) {
                __builtin_amdgcn_global_load_lds((const unsigned*)(xb + (kt + 2) * 32 + xo[2 * h]), (unsigned*)(nx + (w * 4 + 2 * h) * 512), 16, 0, 0);
                __builtin_amdgcn_global_load_lds((const unsigned*)(xb + (kt + 2) * 32 + xo[2 * h + 1]), (unsigned*)(nx + (w * 4 + 2 * h + 1) * 512), 16, 0, 0);
                __builtin_amdgcn_global_load_lds((const unsigned*)(wb + (kt + 2) * 32 + wo[h]), (unsigned*)(nx + 256 * 32 + (w * 2 + h) * 512), 16, 0, 0);
            }
#pragma unroll
            for (int nt = 0; nt < 4; ++nt) {
#pragma unroll
                for (int mt = 0; mt < 4; ++mt) acc[nt][4 * h + mt] = mfma16(a[nt], b[4 * h + mt], acc[nt][4 * h + mt]);
                if (h == 1 && nxt) a[nt] = *(const bf16x8*)(cur + aoff + nt * 512);
            }
            __builtin_amdgcn_sched_barrier(0);
            if (nxt) {
#pragma unroll
                for (int mt = 0; mt < 4; ++mt) b[4 * h + mt] = *(const bf16x8*)(cur + boff + (4 * h + mt) * 512);
            }
        }
    }
    RAW_BARRIER();
}

template <bool SIG, int GMODE = 0>
DEV void phase_inproj(const P& p, int wrow0, int ntn, int ldc, int mtiles256, int bid, int nb, u16* sm) {
    for (int u = bid; u < mtiles256 * ntn; u += nb) {
        const int mt_ = u / ntn, nt_ = u % ntn;
        const int m0 = mt_ * 256, n0 = nt_ * 128;
        unsigned xo[4], wo[2];
#pragma unroll
        for (int i = 0; i < 4; ++i) { int row, ch; gemmB_lane(i, 4, row, ch); xo[i] = (unsigned)(row * 1024 + ch); }
#pragma unroll
        for (int i = 0; i < 2; ++i) { int row, ch; gemmB_lane(i, 2, row, ch); wo[i] = (unsigned)(row * 1024 + ch); }
        f32x4 acc[4][8];
        gemmB_mainloop(acc, p.hbuf + (size_t)m0 * 1024, xo, p.Wt + (size_t)(wrow0 + n0) * 1024, wo, 32, sm);
        const int t2 = tidx(), l2 = t2 & 63, w2 = t2 >> 6;
        const int en = n0 + (w2 & 1) * 64 + (l2 >> 4) * 4, em = m0 + (w2 >> 1) * 128 + (l2 & 15);
#pragma unroll
        for (int nt = 0; nt < 4; ++nt)
#pragma unroll
            for (int mt = 0; mt < 8; ++mt) {
                const int n = en + nt * 16, m = em + mt * 16;
                f32x4 v = acc[nt][mt];
                if (SIG) { v[0] = sigm(v[0]); v[1] = sigm(v[1]); v[2] = sigm(v[2]); v[3] = sigm(v[3]); }
                u32x2 pk; pk.x = pack2(v[0], v[1]); pk.y = pack2(v[2], v[3]);
                *(u32x2*)(p.cols + (size_t)m * ldc + n) = pk;
            }
    }
}

DEV void phase_merge1(const P& p, u16* ubuf, int mtiles, int bid, int nb, u16* sm) {
    for (int u = bid; u < mtiles * 8; u += nb) {
        const int tid = tidx(), lane = tid & 63, w = tid >> 6, wn = w & 1, wm = w >> 1, fr = lane & 15, fq = lane >> 4, sw = (fr >> 1) & 7;
        const int mt_ = u >> 3, nt_ = u & 7;
        const int m0 = mt_ * 128, n0 = nt_ * 128;
        const u16* xp[4]; const u16* wp[4];
#pragma unroll
        for (int i = 0; i < 4; ++i) {
            const int row = g_row(tid, i), kc = g_kc(tid, row);
            xp[i] = p.ybuf + (size_t)(m0 + row) * 1024 + kc;
            wp[i] = p.Wt + WT_WB_OFF + (size_t)(n0 + row) * 256 + kc;
        }
        const u16* gbase = p.cols + (size_t)(m0 + wm * 64 + fr) * NGATE + n0 + wn * 64 + fq * 4;
        f32x4 tot[4][4], acc[4][4]; zero_acc(tot); zero_acc(acc);
        u32x2 gt[4][4];
        asm volatile("s_waitcnt vmcnt(0)" ::: "memory");
#pragma unroll
        for (int i = 0; i < 4; ++i) {
            __builtin_amdgcn_global_load_lds((const unsigned*)xp[i], (unsigned*)(sm + (w * 4 + i) * 512), 16, 0, 0);
            __builtin_amdgcn_global_load_lds((const unsigned*)wp[i], (unsigned*)(sm + 128 * 64 + (w * 4 + i) * 512), 16, 0, 0);
        }
        for (int kt = 0; kt < 16; ++kt) {
            asm volatile("s_waitcnt vmcnt(0)" ::: "memory");
            RAW_BARRIER();
            if (kt + 1 < 16) {
                u16* nx = sm + ((kt + 1) & 1) * GEMM_STAGE;
                const int wof = ((kt + 1) >> 2) * 262144 + ((kt + 1) & 3) * 64;
#pragma unroll
                for (int i = 0; i < 4; ++i) {
                    __builtin_amdgcn_global_load_lds((const unsigned*)(xp[i] + (kt + 1) * 64), (unsigned*)(nx + (w * 4 + i) * 512), 16, 0, 0);
                    __builtin_amdgcn_global_load_lds((const unsigned*)(wp[i] + wof), (unsigned*)(nx + 128 * 64 + (w * 4 + i) * 512), 16, 0, 0);
                }
            }
            if ((kt & 3) == 0) {
                const int br = kt >> 2;
#pragma unroll
                for (int nt = 0; nt < 4; ++nt)
#pragma unroll
                    for (int mt = 0; mt < 4; ++mt) gt[nt][mt] = *(const u32x2*)(gbase + (size_t)mt * 16 * NGATE + nt * 16 + br * 1024);
            }
            const u16* sX = sm + (kt & 1) * GEMM_STAGE;
            const u16* sW = sX + 128 * 64;
#pragma unroll
            for (int ks = 0; ks < 2; ++ks) {
                bf16x8 a[4], b[4];
#pragma unroll
                for (int q = 0; q < 4; ++q) {
                    a[q] = *(const bf16x8*)(sW + (wn * 64 + q * 16 + fr) * 64 + (((ks * 4 + fq) ^ sw) * 8));
                    b[q] = *(const bf16x8*)(sX + (wm * 64 + q * 16 + fr) * 64 + (((ks * 4 + fq) ^ sw) * 8));
                }
#pragma unroll
                for (int nt = 0; nt < 4; ++nt)
#pragma unroll
                    for (int mt = 0; mt < 4; ++mt) acc[nt][mt] = mfma16(a[nt], b[mt], acc[nt][mt]);
            }
            if ((kt & 3) == 3) {
#pragma unroll
                for (int nt = 0; nt < 4; ++nt)
#pragma unroll
                    for (int mt = 0; mt < 4; ++mt) {
                        const u32x2 g = gt[nt][mt];
                        tot[nt][mt][0] += __uint_as_float(g.x << 16) * acc[nt][mt][0];
                        tot[nt][mt][1] += __uint_as_float(g.x & 0xffff0000u) * acc[nt][mt][1];
                        tot[nt][mt][2] += __uint_as_float(g.y << 16) * acc[nt][mt][2];
                        tot[nt][mt][3] += __uint_as_float(g.y & 0xffff0000u) * acc[nt][mt][3];
                        acc[nt][mt] = f32x4{0.f, 0.f, 0.f, 0.f};
                    }
            }
        }
        RAW_BARRIER();
#pragma unroll
        for (int nt = 0; nt < 4; ++nt)
#pragma unroll
            for (int mt = 0; mt < 4; ++mt) {
                const int n = n0 + wn * 64 + nt * 16 + fq * 4, m = m0 + wm * 64 + mt * 16 + fr;
                u32x2 pk; pk.x = pack2(tot[nt][mt][0], tot[nt][mt][1]); pk.y = pack2(tot[nt][mt][2], tot[nt][mt][3]);
                *(u32x2*)(ubuf + (size_t)m * 1024 + n) = pk;
            }
    }
}

DEV void phase_merge2(const P& p, int l, const u16* ubuf, int mtiles, int bid, int nb, u16* sm) {
    const int mt256 = mtiles / 2;
    for (int u = bid; u < mt256 * 8; u += nb) {
        const int mt_ = u >> 3, nt_ = u & 7;
        const int m0 = mt_ * 256, n0 = nt_ * 128;
        unsigned xo[4], wo[2];
#pragma unroll
        for (int i = 0; i < 4; ++i) { int row, ch; gemmB_lane(i, 4, row, ch); xo[i] = (unsigned)(row * 1024 + ch); }
#pragma unroll
        for (int i = 0; i < 2; ++i) { int row, ch; gemmB_lane(i, 2, row, ch); wo[i] = (unsigned)(row * 1024 + ch); }
        f32x4 acc[4][8];
        gemmB_mainloop(acc, ubuf + (size_t)m0 * 1024, xo, p.Wt + WT_WO_OFF + (size_t)n0 * 1024, wo, 32, sm);
        const int t2 = tidx(), l2 = t2 & 63, w2 = t2 >> 6;
        const int en = n0 + (w2 & 1) * 64 + (l2 >> 4) * 4, em = m0 + (w2 >> 1) * 128 + (l2 & 15);
#pragma unroll
        for (int mt = 0; mt < 8; ++mt) {
            const int m = em + mt * 16;
            const float* xi = xrow_in(p, l, m);
            float* xw = xrow_out(p, m);
            const float* g1 = p.mod + (size_t)(l * 3 + modidx(m)) * 6144 + 2048;
#pragma unroll
            for (int nt = 0; nt < 4; ++nt) {
                const int n = en + nt * 16;
                const float4 xo4 = *(const float4*)(xi + n);
                const float4 g = *(const float4*)(g1 + n);
                float4 o;
                o.x = xo4.x + g.x * acc[nt][mt][0]; o.y = xo4.y + g.y * acc[nt][mt][1];
                o.z = xo4.z + g.z * acc[nt][mt][2]; o.w = xo4.w + g.w * acc[nt][mt][3];
                *(float4*)(xw + n) = o;
            }
        }
    }
}

DEV void phase_merge2s(const P& p, int l, const u16* ubuf, int mtiles, int bid, int nb, u16* sm) {
    u16* sX = sm; u16* sW = sm + 128 * LDP;
    const int tid = tidx(), lane = tid & 63, w = tid >> 6, wn = w & 1, wm = w >> 1, fr = lane & 15, fq = lane >> 4;
    for (int u = bid; u < mtiles * 8; u += nb) {
        const int mt_ = u >> 3, nt_ = u & 7;
        const int m0 = mt_ * 128, n0 = nt_ * 128;
        const int tu = tidx();
        const u16* xp[4]; const u16* wp[4];
#pragma unroll
        for (int i = 0; i < 4; ++i) {
            const int row = g_row(tu, i), kc = g_kc(tu, row);
            xp[i] = ubuf + (size_t)(m0 + row) * 1024 + kc;
            wp[i] = p.Wt + WT_WO_OFF + (size_t)(n0 + row) * 1024 + kc;
        }
        f32x4 acc[4][4]; zero_acc(acc);
        gemm_mainloop(acc, xp, wp, 16, sX, sW);
#pragma unroll
        for (int nt = 0; nt < 4; ++nt)
#pragma unroll
            for (int mt = 0; mt < 4; ++mt) {
                const int n = n0 + wn * 64 + nt * 16 + fq * 4, m = m0 + wm * 64 + mt * 16 + fr;
                const float4 xo = *(const float4*)(xrow_in(p, l, m) + n);
                const float4 g = *(const float4*)(p.mod + (size_t)(l * 3 + modidx(m)) * 6144 + 2048 + n);
                float4 o;
                o.x = xo.x + g.x * acc[nt][mt][0]; o.y = xo.y + g.y * acc[nt][mt][1];
                o.z = xo.z + g.z * acc[nt][mt][2]; o.w = xo.w + g.w * acc[nt][mt][3];
                *(float4*)(xrow_out(p, m) + n) = o;
            }
    }
}
DEV void phase_norm2_router(const P& p, int l, int nrows, int bid, int nb, float* sm) {
    const int tid = tidx(), lane = tid & 63, w = tid >> 6;
    int* list = (int*)(p.cols + MOE_LIST_OFF);
    float* slotw = (float*)(list + 16 * RTOT);
    int* tokslot = (int*)(slotw + 16 * RTOT);
    float* tokw = (float*)(tokslot + 2 * RTOT);
    int* lcnt = (int*)(sm + 16 * 1024);
    int* rinfo = lcnt + 32;
    float* rwgt = (float*)(rinfo + 4 * 40 * 2);
#pragma unroll 16
    for (int i = tid; i < 16 * 1024; i += NTHR) { const int c = i >> 4, e = i & 15; sm[e * 1024 + c] = p.router_w[i]; }
    if (tid < 32) lcnt[tid] = 0;
    __syncthreads();
    int kk = 0;
    for (int r = bid * 4 + w; r < nrows; r += nb * 4, ++kk) {
        const float* xr = xrow_out(p, r);
        const int m = modidx(r);
        const float* sh = p.mod + ((size_t)(l * 3 + m)) * 6144 + 3072;
        const float* sc = sh + 1024;
        float4 v[4]; float ss = 0.f;
#pragma unroll
        for (int i = 0; i < 4; ++i) {
            v[i] = *(const float4*)(xr + lane * 4 + i * 256);
            ss += v[i].x * v[i].x + v[i].y * v[i].y + v[i].z * v[i].z + v[i].w * v[i].w;
        }
        ss = wsum(ss);
        const float rs = rsqrtf(ss * (1.f / 1024.f) + EPSF);
#pragma unroll
        for (int i = 0; i < 4; ++i) {
            const int c = lane * 4 + i * 256;
            const float4 g = *(const float4*)(p.norm_ffn + l * 1024 + c);
            const float4 s1 = *(const float4*)(sc + c);
            const float4 h1 = *(const float4*)(sh + c);
            v[i].x = v[i].x * rs * g.x * (1.f + s1.x) + h1.x;
            v[i].y = v[i].y * rs * g.y * (1.f + s1.y) + h1.y;
            v[i].z = v[i].z * rs * g.z * (1.f + s1.z) + h1.z;
            v[i].w = v[i].w * rs * g.w * (1.f + s1.w) + h1.w;
            u32x2 pk; pk.x = pack2(v[i].x, v[i].y); pk.y = pack2(v[i].z, v[i].w);
            *(u32x2*)(p.hbuf + (size_t)r * 1024 + c) = pk;
        }
        float sel[16], scr[16];
#pragma unroll
        for (int e = 0; e < 16; ++e) scr[e] = 0.f;
#pragma unroll
        for (int i = 0; i < 4; ++i) {
#pragma unroll
            for (int e = 0; e < 16; ++e) {
                const float4 rw = *(const float4*)(sm + e * 1024 + lane * 4 + i * 256);
                scr[e] += v[i].x * rw.x + v[i].y * rw.y + v[i].z * rw.z + v[i].w * rw.w;
            }
            __builtin_amdgcn_sched_barrier(0);
        }
#pragma unroll
        for (int e = 0; e < 16; ++e) {
            const float a = wsum(scr[e]);
            scr[e] = sigm(a);
            sel[e] = scr[e] + p.router_b[e];
        }
        int bg = 0; float bgs = -INFINITY;
#pragma unroll
        for (int g = 0; g < 4; ++g) {
            float m1 = -INFINITY, m2 = -INFINITY;
#pragma unroll
            for (int j = 0; j < 4; ++j) {
                const float s = sel[g * 4 + j];
                if (s > m1) { m2 = m1; m1 = s; } else if (s > m2) { m2 = s; }
            }
            const float gs = m1 + m2;
            if (gs > bgs) { bgs = gs; bg = g; }
        }
        float gsel[4], gscr[4];
#pragma unroll
        for (int j = 0; j < 4; ++j) { gsel[j] = -INFINITY; gscr[j] = 0.f; }
#pragma unroll
        for (int g = 0; g < 4; ++g)
#pragma unroll
            for (int j = 0; j < 4; ++j) if (bg == g) { gsel[j] = sel[g * 4 + j]; gscr[j] = scr[g * 4 + j]; }
        int j1 = 0; float v1 = gsel[0], w1 = gscr[0];
#pragma unroll
        for (int j = 1; j < 4; ++j) if (gsel[j] > v1) { v1 = gsel[j]; w1 = gscr[j]; j1 = j; }
        int j2 = -1; float v2 = -INFINITY, w2 = 0.f;
#pragma unroll
        for (int j = 0; j < 4; ++j) if (j != j1 && (j2 < 0 || gsel[j] > v2)) { v2 = gsel[j]; w2 = gscr[j]; j2 = j; }
        const float inv = 1.f / (w1 + w2);
        if (lane == 0) {
            const int e1 = bg * 4 + j1, e2 = bg * 4 + j2;
            const int p1 = atomicAdd(lcnt + e1, 1);
            const int p2 = atomicAdd(lcnt + e2, 1);
            rinfo[(w * 40 + kk) * 2 + 0] = e1 * 65536 + p1; rwgt[(w * 40 + kk) * 2 + 0] = w1 * inv;
            rinfo[(w * 40 + kk) * 2 + 1] = e2 * 65536 + p2; rwgt[(w * 40 + kk) * 2 + 1] = w2 * inv;
        }
    }
    __syncthreads();
    if (tid < 16) lcnt[16 + tid] = lcnt[tid] ? atomicAdd(p.cnt + l * 16 + tid, lcnt[tid]) : 0;
    __syncthreads();
    if (lane < 2) {
        int k2 = 0;
        for (int r = bid * 4 + w; r < nrows; r += nb * 4, ++k2) {
            const int inf = rinfo[(w * 40 + k2) * 2 + lane], e = inf >> 16, slot = lcnt[16 + e] + (inf & 65535);
            const float wg = rwgt[(w * 40 + k2) * 2 + lane];
            list[e * RTOT + slot] = r; slotw[e * RTOT + slot] = wg;
            tokslot[r * 2 + lane] = e * RTOT + slot; tokw[r * 2 + lane] = wg;
        }
    }
    __syncthreads();
}

DEV bool moe_find(const int* cnt, int ut, int& e, int& mt, int& off, int& ce) {
    int tb = 0, o = 0;
    for (int k = 0; k < 16; ++k) {
        const int c = cnt[k], nt = (c + 255) >> 8;
        if (ut < tb + nt) { e = k; mt = ut - tb; off = o; ce = c; return true; }
        tb += nt; o += c;
    }
    return false;
}

DEV bool moe_find128(const int* cnt, int ut, int& e, int& mt, int& off, int& ce) {
    int tb = 0, o = 0;
    for (int k = 0; k < 16; ++k) {
        const int c = cnt[k], nt = (c + 127) >> 7;
        if (ut < tb + nt) { e = k; mt = ut - tb; off = o; ce = c; return true; }
        tb += nt; o += c;
    }
    return false;
}

DEV void phase_moe_up_s(const P& p, int l, int bid, int nb, u16* sm) {
    u16* sX = sm; u16* sW = sm + 128 * LDP;
    const int tid = tidx(), lane = tid & 63, w = tid >> 6, wn = w & 1, wm = w >> 1, fr = lane & 15, fq = lane >> 4;
    const int* cnt = p.cnt + l * 16;
    const int* list = (const int*)(p.cols + MOE_LIST_OFF);
    const u16* wgu = p.cols + MOE_WGU_OFF;
    u16* act = p.cols + MOE_ACT_OFF;
    for (int u = bid;; u += nb) {
        int e, mtile, off, ce;
        if (!moe_find128(cnt, u >> 3, e, mtile, off, ce)) break;
        const int n0 = (u & 7) * 128;
        const int tu = tidx();
        const u16* xp[4]; const u16* wp[4];
#pragma unroll
        for (int i = 0; i < 4; ++i) {
            const int row = g_row(tu, i), kc = g_kc(tu, row);
            int s = mtile * 128 + row; s = s < ce ? s : ce - 1;
            const int tok = list[e * RTOT + s];
            xp[i] = p.hbuf + (size_t)tok * 1024 + kc;
            wp[i] = wgu + ((size_t)e * 1024 + n0 + row) * 1024 + kc;
        }
        f32x4 acc[4][4]; zero_acc(acc);
        gemm_mainloop(acc, xp, wp, 16, sX, sW);
#pragma unroll
        for (int nt = 0; nt < 2; ++nt)
#pragma unroll
            for (int mt = 0; mt < 4; ++mt) {
                const int col = ((n0 >> 6) + wn) * 32 + nt * 16 + fq * 4;
                const int s = mtile * 128 + wm * 64 + mt * 16 + fr;
                if (s < ce) {
                    const f32x4 g = acc[nt][mt], uu = acc[nt + 2][mt];
                    u32x2 pk; pk.x = pack2(silu(g[0]) * uu[0], silu(g[1]) * uu[1]); pk.y = pack2(silu(g[2]) * uu[2], silu(g[3]) * uu[3]);
                    *(u32x2*)(act + (size_t)(off + s) * 512 + col) = pk;
                }
            }
    }
}

DEV void phase_moe_down_s(const P& p, int l, int bid, int nb, u16* sm) {
    u16* sX = sm; u16* sW = sm + 128 * LDP;
    const int tid = tidx(), lane = tid & 63, w = tid >> 6, wn = w & 1, wm = w >> 1, fr = lane & 15, fq = lane >> 4;
    const int* cnt = p.cnt + l * 16;
    const int* list = (const int*)(p.cols + MOE_LIST_OFF);
    u16* yslot = p.glaS;
    const u16* wd = p.Wd;
    const u16* act = p.cols + MOE_ACT_OFF;
    for (int u = bid;; u += nb) {
        int e, mtile, off, ce;
        if (!moe_find128(cnt, u >> 3, e, mtile, off, ce)) break;
        const int n0 = (u & 7) * 128;
        const int tu = tidx();
        const u16* xp[4]; const u16* wp[4];
#pragma unroll
        for (int i = 0; i < 4; ++i) {
            const int row = g_row(tu, i), kc = g_kc(tu, row);
            int s = mtile * 128 + row; s = s < ce ? s : ce - 1;
            xp[i] = act + (size_t)(off + s) * 512 + kc;
            wp[i] = wd + ((size_t)e * 1024 + n0 + row) * 512 + kc;
        }
        f32x4 acc[4][4]; zero_acc(acc);
        gemm_mainloop(acc, xp, wp, 8, sX, sW);
#pragma unroll
        for (int mt = 0; mt < 4; ++mt) {
            const int s = mtile * 128 + wm * 64 + mt * 16 + fr;
            if (s < ce) {
#pragma unroll
                for (int nt = 0; nt < 4; ++nt) {
                    const int n = n0 + wn * 64 + nt * 16 + fq * 4;
                    u32x2 pk; pk.x = pack2(acc[nt][mt][0], acc[nt][mt][1]); pk.y = pack2(acc[nt][mt][2], acc[nt][mt][3]);
                    *(u32x2*)(yslot + (size_t)(off + s) * 1024 + n) = pk;
                }
            }
        }
    }
}

DEV void phase_moe_up(const P& p, int l, int bid, int nb, u16* sm) {
    const int* cnt = p.cnt + l * 16;
    const int* list = (const int*)(p.cols + MOE_LIST_OFF);
    const u16* wgu = p.cols + MOE_WGU_OFF;
    u16* act = p.cols + MOE_ACT_OFF;
    for (int u = bid;; u += nb) {
        int e, mtile, off, ce;
        if (!moe_find(cnt, u >> 3, e, mtile, off, ce)) break;
        const int n0 = (u & 7) * 128;
        unsigned xo[4], wo[2];
#pragma unroll
        for (int i = 0; i < 4; ++i) {
            int row, ch; gemmB_lane(i, 4, row, ch);
            int s = mtile * 256 + row; s = s < ce ? s : ce - 1;
            xo[i] = (unsigned)(list[e * RTOT + s] * 1024 + ch);
        }
#pragma unroll
        for (int i = 0; i < 2; ++i) { int row, ch; gemmB_lane(i, 2, row, ch); wo[i] = (unsigned)(row * 1024 + ch); }
        f32x4 acc[4][8];
        gemmB_mainloop(acc, p.hbuf, xo, wgu + ((size_t)e * 1024 + n0) * 1024, wo, 32, sm);
        const int t2 = tidx(), l2 = t2 & 63, w2 = t2 >> 6;
        const int col0 = ((n0 >> 6) + (w2 & 1)) * 32 + (l2 >> 4) * 4, sb = mtile * 256 + (w2 >> 1) * 128 + (l2 & 15);
#pragma unroll
        for (int nt = 0; nt < 2; ++nt)
#pragma unroll
            for (int mt = 0; mt < 8; ++mt) {
                const int s = sb + mt * 16;
                if (s < ce) {
                    const f32x4 g = acc[nt][mt], uu = acc[nt + 2][mt];
                    u32x2 pk; pk.x = pack2(silu(g[0]) * uu[0], silu(g[1]) * uu[1]); pk.y = pack2(silu(g[2]) * uu[2], silu(g[3]) * uu[3]);
                    *(u32x2*)(act + (size_t)(off + s) * 512 + col0 + nt * 16) = pk;
                }
            }
    }
}

DEV void phase_moe_down(const P& p, int l, int bid, int nb, u16* sm) {
    const int* cnt = p.cnt + l * 16;
    u16* yslot = p.glaS;
    const u16* wd = p.Wd;
    const u16* act = p.cols + MOE_ACT_OFF;
    for (int u = bid;; u += nb) {
        int e, mtile, off, ce;
        if (!moe_find(cnt, u >> 3, e, mtile, off, ce)) break;
        const int n0 = (u & 7) * 128;
        unsigned xo[4], wo[2];
#pragma unroll
        for (int i = 0; i < 4; ++i) {
            int row, ch; gemmB_lane(i, 4, row, ch);
            int s = mtile * 256 + row; s = s < ce ? s : ce - 1;
            xo[i] = (unsigned)((off + s) * 512 + ch);
        }
#pragma unroll
        for (int i = 0; i < 2; ++i) { int row, ch; gemmB_lane(i, 2, row, ch); wo[i] = (unsigned)(row * 512 + ch); }
        f32x4 acc[4][8];
        gemmB_mainloop(acc, act, xo, wd + ((size_t)e * 1024 + n0) * 512, wo, 16, sm);
        const int t2 = tidx(), l2 = t2 & 63, w2 = t2 >> 6;
        const int en = n0 + (w2 & 1) * 64 + (l2 >> 4) * 4, sb = mtile * 256 + (w2 >> 1) * 128 + (l2 & 15);
#pragma unroll
        for (int mt = 0; mt < 8; ++mt) {
            const int s = sb + mt * 16;
            if (s < ce) {
#pragma unroll
                for (int nt = 0; nt < 4; ++nt) {
                    u32x2 pk; pk.x = pack2(acc[nt][mt][0], acc[nt][mt][1]); pk.y = pack2(acc[nt][mt][2], acc[nt][mt][3]);
                    *(u32x2*)(yslot + (size_t)(off + s) * 1024 + en + nt * 16) = pk;
                }
            }
        }
    }
}

DEV void moe_combine_row(const P& p, int l, int r, int lane, float4 (&v)[4]) {
    const int* cnt = p.cnt + l * 16;
    const int* list = (const int*)(p.cols + MOE_LIST_OFF);
    const int* tokslot = (const int*)((const float*)(list + 16 * RTOT) + 16 * RTOT);
    const float* tokw = (const float*)(tokslot + 2 * RTOT);
    const u16* yslot = p.glaS;
    const float* g2 = p.mod + (size_t)(l * 3 + modidx(r)) * 6144 + 5120;
#pragma unroll
    for (int j = 0; j < 2; ++j) {
        const int ts = tokslot[r * 2 + j], e = ts / RTOT, slot = ts % RTOT;
        const float wg = tokw[r * 2 + j];
        int off = 0;
#pragma unroll
        for (int k = 0; k < 15; ++k) off += cnt[k] & -(int)(k < e);
        const u16* yr = yslot + (size_t)(off + slot) * 1024;
#pragma unroll
        for (int i = 0; i < 4; ++i) {
            const int c = lane * 4 + i * 256;
            const u32x2 yv = *(const u32x2*)(yr + c);
            const float4 g = *(const float4*)(g2 + c);
            v[i].x += g.x * wg * __uint_as_float(yv.x << 16); v[i].y += g.y * wg * __uint_as_float(yv.x & 0xffff0000u);
            v[i].z += g.z * wg * __uint_as_float(yv.y << 16); v[i].w += g.w * wg * __uint_as_float(yv.y & 0xffff0000u);
        }
    }
}

DEV void phase_final_norm(const P& p, int bid, int nb) {
    const int lane = tidx() & 63, w = tidx() >> 6;
    for (int r = bid * 4 + w; r < RLAT; r += nb * 4) {
        float* xr = p.out + (size_t)r * DM;
        float4 v[4]; float ss = 0.f;
#pragma unroll
        for (int i = 0; i < 4; ++i) v[i] = *(const float4*)(xr + lane * 4 + i * 256);
        moe_combine_row(p, 1, r, lane, v);
#pragma unroll
        for (int i = 0; i < 4; ++i) ss += v[i].x * v[i].x + v[i].y * v[i].y + v[i].z * v[i].z + v[i].w * v[i].w;
        ss = wsum(ss);
        const float rs = rsqrtf(ss * (1.f / 1024.f) + EPSF);
#pragma unroll
        for (int i = 0; i < 4; ++i) {
            const int c = lane * 4 + i * 256;
            const float4 g = *(const float4*)(p.norm_final + c);
            float4 o; o.x = v[i].x * rs * g.x; o.y = v[i].y * rs * g.y; o.z = v[i].z * rs * g.z; o.w = v[i].w * rs * g.w;
            *(float4*)(xr + c) = o;
        }
    }
}
DEV float wscan_add(float v, int lane) {
#pragma unroll
    for (int o = 1; o < 64; o <<= 1) { const float t = shup(v, o); if (lane >= o) v += t; }
    return v;
}
DEV float wscan_max(float v, int lane) {
#pragma unroll
    for (int o = 1; o < 64; o <<= 1) { const float t = shup(v, o); if (lane >= o) v = fmaxf(v, t); }
    return v;
}
DEV void mm64(f32x4 (&acc)[4], const u16* A, int lda, const u16* Bt, int ldb) {
    const int lane = tidx() & 63, w = tidx() >> 6, fr = lane & 15, fq = lane >> 4;
#pragma unroll
    for (int ks = 0; ks < 2; ++ks) {
        const bf16x8 a = *(const bf16x8*)(A + (16 * w + fr) * lda + ks * 32 + fq * 8);
#pragma unroll
        for (int nt = 0; nt < 4; ++nt) {
            const bf16x8 b = *(const bf16x8*)(Bt + (nt * 16 + fr) * ldb + ks * 32 + fq * 8);
            acc[nt] = mfma16(a, b, acc[nt]);
        }
    }
}
DEV void mm64_pre(f32x4 (&acc)[4], const u16* A, int lda, const bf16x8 (&bf)[2][4]) {
    const int lane = tidx() & 63, w = tidx() >> 6, fr = lane & 15, fq = lane >> 4;
#pragma unroll
    for (int ks = 0; ks < 2; ++ks) {
        const bf16x8 a = *(const bf16x8*)(A + (16 * w + fr) * lda + ks * 32 + fq * 8);
#pragma unroll
        for (int nt = 0; nt < 4; ++nt) acc[nt] = mfma16(a, bf[ks][nt], acc[nt]);
    }
}
DEV void ldB64(bf16x8 (&bf)[2][4], const u16* Bt) {
    const int lane = tidx() & 63, fr = lane & 15, fq = lane >> 4;
#pragma unroll
    for (int ks = 0; ks < 2; ++ks)
#pragma unroll
        for (int nt = 0; nt < 4; ++nt) bf[ks][nt] = *(const bf16x8*)(Bt + (nt * 16 + fr) * 64 + ks * 32 + fq * 8);
}
struct Raw16 { u32x4 a, b; };
DEV Raw16 ldraw16(const u16* p) { Raw16 r; r.a = *(const u32x4*)p; r.b = *(const u32x4*)(p + 8); return r; }
DEV void unraw16(const Raw16& r, float (&o)[16]) {
    const unsigned w[8] = {r.a.x, r.a.y, r.a.z, r.a.w, r.b.x, r.b.y, r.b.z, r.b.w};
#pragma unroll
    for (int i = 0; i < 8; ++i) { o[2 * i] = __uint_as_float(w[i] << 16); o[2 * i + 1] = __uint_as_float(w[i] & 0xffff0000u); }
}
DEV void zero4(f32x4 (&acc)[4]) {
#pragma unroll
    for (int i = 0; i < 4; ++i) acc[i] = f32x4{0.f, 0.f, 0.f, 0.f};
}
DEV void ld16bf(const u16* p, float (&o)[16]) {
    const u32x4 a = *(const u32x4*)p, b = *(const u32x4*)(p + 8);
    const unsigned w[8] = {a.x, a.y, a.z, a.w, b.x, b.y, b.z, b.w};
#pragma unroll
    for (int i = 0; i < 8; ++i) { o[2 * i] = __uint_as_float(w[i] << 16); o[2 * i + 1] = __uint_as_float(w[i] & 0xffff0000u); }
}
DEV void st16bf(u16* p, const float (&v)[16]) {
    u32x4 a, b;
    a.x = pack2(v[0], v[1]); a.y = pack2(v[2], v[3]); a.z = pack2(v[4], v[5]); a.w = pack2(v[6], v[7]);
    b.x = pack2(v[8], v[9]); b.y = pack2(v[10], v[11]); b.z = pack2(v[12], v[13]); b.w = pack2(v[14], v[15]);
    *(u32x4*)p = a; *(u32x4*)(p + 8) = b;
}

DEV void phase_rope_table(const P& p, int bid, int nb) {
    for (int i = bid * NTHR + tidx(); i < 192 * 8; i += nb * NTHR) {
        const int e = i >> 3, f = i & 7;
        const float inv = expf(-(float)(2 * f) * (1.f / 16.f) * 9.210340371976184f);
        const float pos = (float)(e < 128 ? e : e - 128);
        const float ang = pos * inv;
        p.rope[2 * i] = cosf(ang); p.rope[2 * i + 1] = sinf(ang);
    }
}
DEV void phase_prep(const P& p, int l, u16* gqkv, int bid, int nb, u16* sm) {
    const int tid = tidx();
    for (int g = bid; g < 264; g += nb) {
        int b, t0, r0, T, pos0;
        if (g < 256) { b = g >> 7; t0 = (g & 127) * 64; r0 = b * SEQ + t0; T = SEQ; pos0 = CTXL + t0; }
        else { const int q = g - 256; b = q >> 2; t0 = (q & 3) * 64; r0 = RLAT + b * CTXL + t0; T = CTXL; pos0 = t0; }
        for (int k = 0; k < 24; ++k) {
            const int id = tid + 256 * k, cg = id % 96, s = id / 96, r = r0 + s, t = t0 + s;
            float a[8];
#pragma unroll
            for (int i = 0; i < 8; ++i) a[i] = 0.f;
#pragma unroll
            for (int j = 0; j < 5; ++j) {
                const int tt = t + j - 2;
                if (tt >= 0 && tt < T) {
                    const u32x4 xv = *(const u32x4*)(p.cols + (size_t)(r + j - 2) * NCM + GD_Q + cg * 8);
                    const float4 w0 = *(const float4*)(p.gdn_conv + (l * 5 + j) * 768 + cg * 8);
                    const float4 w1 = *(const float4*)(p.gdn_conv + (l * 5 + j) * 768 + cg * 8 + 4);
                    a[0] += __uint_as_float(xv.x << 16) * w0.x; a[1] += __uint_as_float(xv.x & 0xffff0000u) * w0.y;
                    a[2] += __uint_as_float(xv.y << 16) * w0.z; a[3] += __uint_as_float(xv.y & 0xffff0000u) * w0.w;
                    a[4] += __uint_as_float(xv.z << 16) * w1.x; a[5] += __uint_as_float(xv.z & 0xffff0000u) * w1.y;
                    a[6] += __uint_as_float(xv.w << 16) * w1.z; a[7] += __uint_as_float(xv.w & 0xffff0000u) * w1.w;
                }
            }
            float ss = 0.f;
#pragma unroll
            for (int i = 0; i < 8; ++i) { a[i] = silu(a[i]); ss += a[i] * a[i]; }
            ss += shx(ss, 1); ss += shx(ss, 2); ss += shx(ss, 4);
            float sc = 1.f;
            if (cg < 64) sc = rsqrtf(ss + EPSF) * (cg < 32 ? 0.125f : 1.f);
            u32x4 o;
            o.x = pack2(a[0] * sc, a[1] * sc); o.y = pack2(a[2] * sc, a[3] * sc); o.z = pack2(a[4] * sc, a[5] * sc); o.w = pack2(a[6] * sc, a[7] * sc);
            *(u32x4*)(gqkv + (size_t)r * 768 + cg * 8) = o;
        }
        for (int k = 0; k < 8; ++k) {
            const int id = tid + 256 * k, c = id & 1, half = (id >> 1) & 1, h = (id >> 2) & 3, qk = (id >> 4) & 1, s = id >> 5;
            const int r = r0 + s, t = t0 + s;
            const u16* src = p.cols + (size_t)r * NCM + (qk ? DF_K : DF_Q) + h * 64 + half * 32 + c * 8;
            const u32x4 v1 = *(const u32x4*)src, v2 = *(const u32x4*)(src + 16);
            const unsigned w1[4] = {v1.x, v1.y, v1.z, v1.w}, w2[4] = {v2.x, v2.y, v2.z, v2.w};
            float x1[8], x2[8], o1[8], o2[8];
#pragma unroll
            for (int i = 0; i < 4; ++i) {
                x1[2 * i] = __uint_as_float(w1[i] << 16); x1[2 * i + 1] = __uint_as_float(w1[i] & 0xffff0000u);
                x2[2 * i] = __uint_as_float(w2[i] << 16); x2[2 * i + 1] = __uint_as_float(w2[i] & 0xffff0000u);
            }
            const float qs = qk ? 1.f : (0.17677669529663687f * 1.4426950408889634f);
            if (g < 256) {
                const float* tb = p.rope + (size_t)(c == 0 ? (t >> 6) : 128 + (t & 63)) * 16;
#pragma unroll
                for (int i = 0; i < 8; ++i) {
                    const float cs = tb[2 * i], sn = tb[2 * i + 1];
                    o1[i] = (x1[i] * cs - x2[i] * sn) * qs; o2[i] = (x1[i] * sn + x2[i] * cs) * qs;
                }
            } else {
#pragma unroll
                for (int i = 0; i < 8; ++i) { o1[i] = x1[i] * qs; o2[i] = x2[i] * qs; }
            }
            u16* dst = (qk ? p.dk : p.dq) + ((size_t)(b * 4 + h) * KPOS + pos0 + s) * 64 + half * 32 + c * 8;
            u32x4 a1, a2;
            a1.x = pack2(o1[0], o1[1]); a1.y = pack2(o1[2], o1[3]); a1.z = pack2(o1[4], o1[5]); a1.w = pack2(o1[6], o1[7]);
            a2.x = pack2(o2[0], o2[1]); a2.y = pack2(o2[2], o2[3]); a2.z = pack2(o2[4], o2[5]); a2.w = pack2(o2[6], o2[7]);
            *(u32x4*)dst = a1; *(u32x4*)(dst + 16) = a2;
        }
        for (int h = 0; h < 4; ++h) {
            __syncthreads();
            {
                const int s = tid >> 2, dg = tid & 3;
                const u32x4 a = *(const u32x4*)(p.cols + (size_t)(r0 + s) * NCM + DF_V + h * 64 + dg * 16);
                const u32x4 c = *(const u32x4*)(p.cols + (size_t)(r0 + s) * NCM + DF_V + h * 64 + dg * 16 + 8);
                const unsigned wv[8] = {a.x, a.y, a.z, a.w, c.x, c.y, c.z, c.w};
#pragma unroll
                for (int k = 0; k < 8; ++k) {
                    sm[(dg * 16 + 2 * k) * 72 + s] = (u16)(wv[k] & 0xffff);
                    sm[(dg * 16 + 2 * k + 1) * 72 + s] = (u16)(wv[k] >> 16);
                }
            }
            __syncthreads();
            {
                const int dv = tid >> 2, sg = tid & 3;
                const u32x4 a = *(const u32x4*)(sm + dv * 72 + sg * 16);
                const u32x4 c = *(const u32x4*)(sm + dv * 72 + sg * 16 + 8);
                u16* o = p.dvT + ((size_t)(b * 4 + h) * 64 + dv) * KPOS + pos0 + sg * 16;
                *(u32x4*)o = a; *(u32x4*)(o + 8) = c;
            }
        }
        __syncthreads();
    }
}
#define TILE_B (64 * LDP * 2)

DEV void gla_cum(const P& p, int l, int dir, int h, int row0, float* cum, float* rt, float* sg) {
    const int tid = tidx();
    const int d = tid & 63, sq = tid >> 6;
    float a2r[16];
#pragma unroll
    for (int j = 0; j < 16; ++j) a2r[j] = p.gla_a2[((size_t)(l * 2 + dir) * 16 + j) * 256 + h * 64 + d];
    const float ab = p.gla_ab[(l * 2 + dir) * 256 + h * 64 + d];
    {
        const int s = tid >> 2, q4 = tid & 3, row = row0 + (dir ? 63 - s : s);
        const u32x2 v = *(const u32x2*)(p.cols + (size_t)row * NCM + GLA_RF + dir * 16 + q4 * 4);
        rt[s * 17 + q4 * 4 + 0] = __uint_as_float(v.x << 16); rt[s * 17 + q4 * 4 + 1] = __uint_as_float(v.x & 0xffff0000u);
        rt[s * 17 + q4 * 4 + 2] = __uint_as_float(v.y << 16); rt[s * 17 + q4 * 4 + 3] = __uint_as_float(v.y & 0xffff0000u);
    }
    __syncthreads();
    float loc[16]; float run = 0.f;
#pragma unroll
    for (int i = 0; i < 16; ++i) {
        const int s = sq * 16 + i;
        float x = ab;
#pragma unroll
        for (int j = 0; j < 16; ++j) x += rt[s * 17 + j] * a2r[j];
        run += logsig(x) * (1.f / 16.f);
        loc[i] = run;
    }
    sg[sq * 64 + d] = run;
    __syncthreads();
    float off = 0.f;
    for (int k = 0; k < sq; ++k) off += sg[k * 64 + d];
#pragma unroll
    for (int i = 0; i < 16; ++i) cum[(sq * 16 + i) * 65 + d] = loc[i] + off;
    __syncthreads();
}

DEV void gla_phaseA(const P& p, int l, int dir, int b, int st, int h, unsigned char* smraw) {
    float* cum = (float*)smraw;
    float* rt = cum + 64 * 65;
    float* sg = rt + 64 * 17;
    u16* kwT = (u16*)(sg + 256);
    u16* vT = kwT + 64 * LDP;
    const int tid = tidx(), lane = tid & 63, w = tid >> 6, fr = lane & 15, fq = lane >> 4;
    const int row0 = chunk_row0(b, dir, st);
    const size_t idx = state_idx(dir, b, st, h);
    Raw16 kraw, vraw;
    {
        const int s = tid >> 2, dg = tid & 3, row = row0 + (dir ? 63 - s : s);
        kraw = ldraw16(p.cols + (size_t)row * NCM + GLA_K + h * 64 + dg * 16);
        vraw = ldraw16(p.cols + (size_t)row * NCM + GLA_V + h * 64 + dg * 16);
    }
    gla_cum(p, l, dir, h, row0, cum, rt, sg);
    {
        const int s = tid >> 2, dg = tid & 3;
        float kk[16], vv[16];
        unraw16(kraw, kk); unraw16(vraw, vv);
#pragma unroll
        for (int i = 0; i < 16; ++i) {
            const int d = dg * 16 + i;
            kwT[d * LDP + s] = f2bf(kk[i] * __expf(cum[63 * 65 + d] - cum[s * 65 + d]));
            vT[d * LDP + s] = f2bf(vv[i]);
        }
        if (tid < 64) p.glaDec[idx * 64 + tid] = __expf(cum[63 * 65 + tid]);
    }
    __syncthreads();
    f32x4 acc[4]; zero4(acc);
    mm64(acc, kwT, LDP, vT, LDP);
#pragma unroll
    for (int nt = 0; nt < 4; ++nt) {
        const int d = 16 * w + fq * 4, e = nt * 16 + fr;
        u32x2 pk; pk.x = pack2(acc[nt][0], acc[nt][1]); pk.y = pack2(acc[nt][2], acc[nt][3]);
        *(u32x2*)(p.glaS + idx * 4096 + e * 64 + d) = pk;
    }
    __syncthreads();
}

DEV void ml_phaseA(const P& p, int l, int dir, int b, int st, int h, unsigned char* smraw) {
    float* wend = (float*)smraw;
    u16* kwT = (u16*)(wend + 64);
    u16* vT = kwT + 64 * LDP;
    const int tid = tidx(), lane = tid & 63, w = tid >> 6, fr = lane & 15, fq = lane >> 4;
    const int row0 = chunk_row0(b, dir, st);
    const size_t idx = state_idx(dir, b, st, h);
    Raw16 kraw, vraw;
    {
        const int s = tid >> 2, dg = tid & 3, row = row0 + (dir ? 63 - s : s);
        kraw = ldraw16(p.cols + (size_t)row * NCM + ML_K + h * 64 + dg * 16);
        vraw = ldraw16(p.cols + (size_t)row * NCM + ML_V + h * 64 + dg * 16);
    }
    if (w == 0) {
        const int row = row0 + (dir ? 63 - lane : lane);
        const float ip = bf2f(p.cols[(size_t)row * NCM + ML_GF + dir * 8 + h]) + p.mlstm_gate_b[((l * 2 + dir) * 2 + 0) * 4 + h];
        const float lf = logsig(bf2f(p.cols[(size_t)row * NCM + ML_GF + dir * 8 + 4 + h]) + p.mlstm_gate_b[((l * 2 + dir) * 2 + 1) * 4 + h]);
        const float fc = wscan_add(lf, lane);
        const float fe = shidx(fc, 63);
        const float lw = fe - fc + ip;
        const float ae = wmaxr(lw);
        wend[lane] = __expf(lw - ae);
        if (lane == 0) { p.mlFE[idx] = fe; p.mlAE[idx] = ae; }
    }
    __syncthreads();
    {
        const int s = tid >> 2, dg = tid & 3;
        float kk[16], vv[16];
        unraw16(kraw, kk); unraw16(vraw, vv);
        const float ws = wend[s] * 0.125f;
#pragma unroll
        for (int i = 0; i < 16; ++i) {
            const int d = dg * 16 + i;
            kwT[d * LDP + s] = f2bf(kk[i] * ws);
            vT[d * LDP + s] = f2bf(vv[i]);
        }
    }
    __syncthreads();
    if (tid < 64) {
        float a = 0.f;
        for (int s = 0; s < 64; ++s) a += bf2f(kwT[tid * LDP + s]);
        p.mlN[idx * 64 + tid] = a;
    }
    f32x4 acc[4]; zero4(acc);
    mm64(acc, kwT, LDP, vT, LDP);
#pragma unroll
    for (int nt = 0; nt < 4; ++nt) {
        const int d = 16 * w + fq * 4, e = nt * 16 + fr;
        u32x2 pk; pk.x = pack2(acc[nt][0], acc[nt][1]); pk.y = pack2(acc[nt][2], acc[nt][3]);
        *(u32x2*)(p.mlS + idx * 4096 + e * 64 + d) = pk;
    }
    __syncthreads();
}

DEV void gd_phaseA(const P& p, int l, const u16* gqkv, int dir, int b, int st, int h, unsigned char* smraw) {
    float* X = (float*)smraw;
    float* cum = X + 64 * 65 + 32;
    float* beta = cum + 64;
    float* be = beta + 64;
    float* ke = be + 64;
    float* scal = ke + 64;
    u16* Y0 = (u16*)(scal + 64);
    u16* Y1 = Y0 + 64 * LDP;
    u16* Y2 = Y1 + 64 * LDP;
    u16* Y3 = Y2 + 64 * LDP;
    u16* Y4 = Y3 + 64 * LDP;
    u16* Y5 = Y4 + 64 * LDP;
    const int tid = tidx(), lane = tid & 63, w = tid >> 6, fr = lane & 15, fq = lane >> 4;
    const int row0 = chunk_row0(b, dir, st);
    const size_t idx = state_idx(dir, b, st, h);
    if (w == 0) {
        const int row = row0 + (dir ? 63 - lane : lane);
        const float bp = bf2f(p.cols[(size_t)row * NCM + GD_GF + dir * 8 + h]);
        const float ap = bf2f(p.cols[(size_t)row * NCM + GD_GF + dir * 8 + 4 + h]);
        const float bt = sigm(bp);
        const float g = -__expf(p.gdn_a_log[(l * 2 + dir) * 4 + h]) * softplus(ap + p.gdn_dt_bias[(l * 2 + dir) * 4 + h]);
        const float cm = wscan_add(g, lane);
        const float ce = shidx(cm, 63);
        cum[lane] = cm; beta[lane] = bt; be[lane] = bt * __expf(cm); ke[lane] = __expf(ce - cm);
        if (lane == 0) scal[0] = __expf(ce);
    }
    {
        const int s = tid >> 2, dg = tid & 3, row = row0 + (dir ? 63 - s : s);
        const u16* src = gqkv + (size_t)row * 768 + h * 64 + dg * 16;
        const u32x4 q0 = *(const u32x4*)src, q1 = *(const u32x4*)(src + 8);
        const u32x4 k0 = *(const u32x4*)(src + 256), k1 = *(const u32x4*)(src + 264);
        const u32x4 v0 = *(const u32x4*)(src + 512), v1 = *(const u32x4*)(src + 520);
        *(u32x4*)(Y0 + s * LDP + dg * 16) = q0; *(u32x4*)(Y0 + s * LDP + dg * 16 + 8) = q1;
        *(u32x4*)(Y1 + s * LDP + dg * 16) = k0; *(u32x4*)(Y1 + s * LDP + dg * 16 + 8) = k1;
        const unsigned kw[8] = {k0.x, k0.y, k0.z, k0.w, k1.x, k1.y, k1.z, k1.w};
        const unsigned vw[8] = {v0.x, v0.y, v0.z, v0.w, v1.x, v1.y, v1.z, v1.w};
#pragma unroll
        for (int i = 0; i < 8; ++i) {
            Y2[(dg * 16 + 2 * i) * LDP + s] = (u16)(kw[i] & 0xffff); Y2[(dg * 16 + 2 * i + 1) * LDP + s] = (u16)(kw[i] >> 16);
            Y3[(dg * 16 + 2 * i) * LDP + s] = (u16)(vw[i] & 0xffff); Y3[(dg * 16 + 2 * i + 1) * LDP + s] = (u16)(vw[i] >> 16);
        }
    }
    __syncthreads();
    u32x2 qpre[4];
#pragma unroll
    for (int nt = 0; nt < 4; ++nt) {
        const int c = nt * 16 + fr, row = row0 + (dir ? 63 - c : c);
        qpre[nt] = *(const u32x2*)(gqkv + (size_t)row * 768 + h * 64 + 16 * w + fq * 4);
    }
    {
        f32x4 kk[4], qk[4]; zero4(kk); zero4(qk);
        mm64(kk, Y1, LDP, Y1, LDP);
        mm64(qk, Y0, LDP, Y1, LDP);
        float cc[4], bc[4], cs[4];
#pragma unroll
        for (int j = 0; j < 4; ++j) { cc[j] = cum[16 * w + fq * 4 + j]; bc[j] = beta[16 * w + fq * 4 + j]; cs[j] = cum[j * 16 + fr]; }
#pragma unroll
        for (int nt = 0; nt < 4; ++nt)
#pragma unroll
            for (int j = 0; j < 4; ++j) {
                const int c = 16 * w + fq * 4 + j, s = nt * 16 + fr;
                const float ex = __expf(fminf(cc[j] - cs[nt], 0.f));
                X[c * 65 + s] = bc[j] * kk[nt][j] * ex * (s < c ? 1.f : 0.f);
                Y4[c * LDP + s] = f2bf(qk[nt][j] * ex * (s <= c ? 1.f : 0.f));
            }
    }
    __syncthreads();
    float* T = (float*)Y0;
    {
        float* Pb = (float*)Y5;
        for (int e = tid; e < 6 * 256; e += NTHR) {
            const int q = e >> 8, r = (e >> 4) & 15, c = e & 15;
            const int ib = q < 3 ? 0 : (q < 5 ? 1 : 2), jb = q < 3 ? q + 1 : (q < 5 ? q - 1 : 3);
            T[(16 * ib + r) * 65 + 16 * jb + c] = 0.f;
        }
        if (tid < 64) {
            const int blk = tid >> 4, col = tid & 15, base = blk * 16;
            float tc[16];
#pragma unroll
            for (int r = 0; r < 16; ++r) tc[r] = (r == col) ? 1.f : 0.f;
#pragma unroll
            for (int r = 1; r < 16; ++r) {
                float a = 0.f;
#pragma unroll
                for (int s2 = 0; s2 < r; ++s2) a += X[(base + r) * 65 + base + s2] * tc[s2];
                tc[r] -= (r > col ? 1.f : 0.f) * (a + tc[r]);
            }
#pragma unroll
            for (int r = 0; r < 16; ++r) T[(base + r) * 65 + base + col] = tc[r];
        }
        __syncthreads();
#pragma unroll
        for (int d = 1; d < 4; ++d) {
            const int nblk = 4 - d;
            for (int e = tid; e < nblk * 256; e += NTHR) {
                const int jb = e >> 8, r = (e >> 4) & 15, c = e & 15, ib = jb + d;
                float a = 0.f;
#pragma unroll
                for (int k2 = 0; k2 < d; ++k2)
#pragma unroll
                    for (int s2 = 0; s2 < 16; ++s2) a += X[(16 * ib + r) * 65 + 16 * (jb + k2) + s2] * T[(16 * (jb + k2) + s2) * 65 + 16 * jb + c];
                Pb[(jb * 16 + r) * 17 + c] = a;
            }
            __syncthreads();
            for (int e = tid; e < nblk * 256; e += NTHR) {
                const int jb = e >> 8, r = (e >> 4) & 15, c = e & 15, ib = jb + d;
                float a = 0.f;
#pragma unroll
                for (int s2 = 0; s2 < 16; ++s2) a += T[(16 * ib + r) * 65 + 16 * ib + s2] * Pb[(jb * 16 + s2) * 17 + c];
                T[(16 * ib + r) * 65 + 16 * jb + c] = -a;
            }
            __syncthreads();
        }
    }
    u16* Tw = (u16*)X;
    u16* Tu = Y5;
    {
        const int c = tid >> 2, sgp = tid & 3;
        float tw[16], tu[16];
#pragma unroll
        for (int i = 0; i < 16; ++i) {
            const int s = sgp * 16 + i;
            const float t = T[c * 65 + s];
            tw[i] = t * be[s]; tu[i] = t * beta[s];
        }
        st16bf(Tw + c * LDP + sgp * 16, tw);
        st16bf(Tu + c * LDP + sgp * 16, tu);
    }
    __syncthreads();
    u16* wT = Y0; u16* wkT = Y1; u16* uT = (u16*)X; u16* ukT = Y5;
    {
        f32x4 wa[4], ua[4]; zero4(wa); zero4(ua);
        mm64(wa, Tw, LDP, Y2, LDP);
        mm64(ua, Tu, LDP, Y3, LDP);
        __syncthreads();
        const int c0 = 16 * w + fq * 4;
        const float k0 = ke[c0], k1 = ke[c0 + 1], k2 = ke[c0 + 2], k3 = ke[c0 + 3];
#pragma unroll
        for (int nt = 0; nt < 4; ++nt) {
            const int d = nt * 16 + fr;
            u32x2 a, bq, c, dq_;
            a.x = pack2(wa[nt][0], wa[nt][1]); a.y = pack2(wa[nt][2], wa[nt][3]);
            bq.x = pack2(wa[nt][0] * k0, wa[nt][1] * k1); bq.y = pack2(wa[nt][2] * k2, wa[nt][3] * k3);
            c.x = pack2(ua[nt][0], ua[nt][1]); c.y = pack2(ua[nt][2], ua[nt][3]);
            dq_.x = pack2(ua[nt][0] * k0, ua[nt][1] * k1); dq_.y = pack2(ua[nt][2] * k2, ua[nt][3] * k3);
            *(u32x2*)(wT + d * LDP + c0) = a;
            *(u32x2*)(wkT + d * LDP + c0) = bq;
            *(u32x2*)(uT + d * LDP + c0) = c;
            *(u32x2*)(ukT + d * LDP + c0) = dq_;
        }
    }
    __syncthreads();
    {
        const float dec = scal[0];
        f32x4 acc[4];
        zero4(acc); mm64(acc, wT, LDP, Y4, LDP);
#pragma unroll
        for (int nt = 0; nt < 4; ++nt) {
            const int d = 16 * w + fq * 4, c = nt * 16 + fr;
            const u32x2 qv = qpre[nt];
            const float ec = __expf(cum[c]);
            u32x2 pk;
            pk.x = pack2(__uint_as_float(qv.x << 16) * ec - acc[nt][0], __uint_as_float(qv.x & 0xffff0000u) * ec - acc[nt][1]);
            pk.y = pack2(__uint_as_float(qv.y << 16) * ec - acc[nt][2], __uint_as_float(qv.y & 0xffff0000u) * ec - acc[nt][3]);
            *(u32x2*)(p.gdQ + idx * 4096 + c * 64 + d) = pk;
        }
        zero4(acc); mm64(acc, wkT, LDP, Y2, LDP);
#pragma unroll
        for (int nt = 0; nt < 4; ++nt) {
            const int d = 16 * w + fq * 4, d2 = nt * 16 + fr;
            u32x2 pk;
            pk.x = pack2((d == d2 ? dec : 0.f) - acc[nt][0], (d + 1 == d2 ? dec : 0.f) - acc[nt][1]);
            pk.y = pack2((d + 2 == d2 ? dec : 0.f) - acc[nt][2], (d + 3 == d2 ? dec : 0.f) - acc[nt][3]);
            *(u32x2*)(p.gdM + idx * 4096 + d2 * 64 + d) = pk;
        }
        zero4(acc); mm64(acc, Y2, LDP, ukT, LDP);
#pragma unroll
        for (int nt = 0; nt < 4; ++nt) {
            const int d2 = 16 * w + fq * 4, e = nt * 16 + fr;
            u32x2 pk; pk.x = pack2(acc[nt][0], acc[nt][1]); pk.y = pack2(acc[nt][2], acc[nt][3]);
            *(u32x2*)(p.gdN + idx * 4096 + e * 64 + d2) = pk;
        }
        zero4(acc); mm64(acc, Y4, LDP, uT, LDP);
#pragma unroll
        for (int nt = 0; nt < 4; ++nt) {
            const int c = 16 * w + fq * 4, e = nt * 16 + fr;
            u32x2 pk; pk.x = pack2(acc[nt][0], acc[nt][1]); pk.y = pack2(acc[nt][2], acc[nt][3]);
            *(u32x2*)(p.gdO + idx * 4096 + e * 64 + c) = pk;
        }
    }
    __syncthreads();
}

DEV void phase_chunkA(const P& p, int l, const u16* gqkv, int bid, int nb, unsigned char* sm) {
    for (int u = bid; u < 3 * 2112; u += nb) {
        const int mix = u / 2112, v = u % 2112;
        const int h = v & 3, st = (v >> 2) % NSTEP, db = (v >> 2) / NSTEP, b = db & 1, dir = db >> 1;
        if (mix == 0) { PRB_BEGIN(120); gd_phaseA(p, l, gqkv, dir, b, st, h, sm); PRB_END(120); }
        else if (mix == 1) { PRB_BEGIN(121); gla_phaseA(p, l, dir, b, st, h, sm); PRB_END(121); }
        else { PRB_BEGIN(122); ml_phaseA(p, l, dir, b, st, h, sm); PRB_END(122); }
    }
}
#define GD_STAGE (64 * 64 + 16 * 64)
#define GD_NST 7
DEV void gd_issue(const P& p, size_t idx, int ct, u16* ring, int stg, int w, int lane) {
    u16* md = ring + stg * GD_STAGE;
    u16* nd = md + 64 * 64;
#pragma unroll
    for (int i = 0; i < 2; ++i) {
        const int r = (w * 2 + i) * 8 + (lane >> 3), c = (lane & 7) ^ ((r >> 1) & 7);
        __builtin_amdgcn_global_load_lds((const unsigned*)(p.gdM + idx * 4096 + r * 64 + c * 8), (unsigned*)(md + (w * 2 + i) * 512), 16, 0, 0);
    }
    {
        const int pi = w & 1, r = pi * 8 + (lane >> 3), c = (lane & 7) ^ ((r >> 1) & 7);
        __builtin_amdgcn_global_load_lds((const unsigned*)(p.gdN + idx * 4096 + (16 * ct + r) * 64 + c * 8), (unsigned*)(nd + pi * 512), 16, 0, 0);
    }
}
DEV void gd_frags(const u16* Ms, int fr, int fq, int sw, bf16x8 (&a)[8], u32x2 (&nv)[4]) {
    const u16* Ns = Ms + 64 * 64;
#pragma unroll
    for (int mt = 0; mt < 4; ++mt) {
#pragma unroll
        for (int ks = 0; ks < 2; ++ks) a[mt * 2 + ks] = *(const bf16x8*)(Ms + (mt * 16 + fr) * 64 + (((ks * 4 + fq) ^ sw) * 8));
        nv[mt] = *(const u32x2*)(Ns + fr * 64 + (((mt * 2 + (fq >> 1)) ^ sw) * 8) + (fq & 1) * 4);
    }
}
DEV void gd_scan(const P& p, int unit, u16* sm) {
    const int chain = unit >> 2, ct = unit & 3;
    const int dir = chain >> 3, b = (chain >> 2) & 1, h = chain & 3;
    const int tid_ = tidx();
    const int lane = tid_ & 63, w = tid_ >> 6, fr = lane & 15, fq = lane >> 4;
    u16* ring = sm;
    u16* sl = sm + GD_NST * GD_STAGE;
    bf16x8 sb[2];
    sb[0] = bf16x8{0, 0, 0, 0, 0, 0, 0, 0}; sb[1] = sb[0];
    const size_t base = state_idx(dir, b, 0, h);
    const int sw = (fr >> 1) & 7;
    asm volatile("s_waitcnt vmcnt(0)" ::: "memory");
#pragma unroll
    for (int t = 0; t < 6; ++t) gd_issue(p, base + (size_t)t * 4, ct, ring, t, w, lane);
    asm volatile("s_waitcnt vmcnt(15)" ::: "memory");
    RAW_BARRIER();
    bf16x8 a[8], an[8]; u32x2 nv[4], nn[4];
    if (w == 0) gd_frags(ring, fr, fq, sw, a, nv);
    for (int k = 0; k < NSTEP; ++k) {
        if (k + 6 >= NSTEP) asm volatile("s_waitcnt vmcnt(0)" ::: "memory");
        else if (w != 0 || k == 0) asm volatile("s_waitcnt vmcnt(12)" ::: "memory");
        else asm volatile("s_waitcnt vmcnt(14)" ::: "memory");
        RAW_BARRIER();
        if (k + 6 < NSTEP) gd_issue(p, base + (size_t)(k + 6) * 4, ct, ring, (k + 6) % GD_NST, w, lane);
        asm volatile("" ::: "memory");
        if (w == 0) {
            const size_t idx = base + (size_t)k * 4;
            f32x4 acc[4];
#pragma unroll
            for (int mt = 0; mt < 4; ++mt) {
                acc[mt][0] = __uint_as_float(nv[mt].x << 16); acc[mt][1] = __uint_as_float(nv[mt].x & 0xffff0000u);
                acc[mt][2] = __uint_as_float(nv[mt].y << 16); acc[mt][3] = __uint_as_float(nv[mt].y & 0xffff0000u);
            }
#pragma unroll
            for (int mt = 0; mt < 4; ++mt)
#pragma unroll
                for (int ks = 0; ks < 2; ++ks) acc[mt] = mfma16(a[mt * 2 + ks], sb[ks], acc[mt]);
            if (k + 1 < NSTEP) gd_frags(ring + ((k + 1) % GD_NST) * GD_STAGE, fr, fq, sw, an, nn);
#pragma unroll
            for (int ks = 0; ks < 2; ++ks) *(bf16x8*)(p.gdN + idx * 4096 + (16 * ct + fr) * 64 + ks * 32 + fq * 8) = sb[ks];
            asm volatile("" ::: "memory");
#pragma unroll
            for (int mt = 0; mt < 4; ++mt) {
                u32x2 pk; pk.x = pack2(acc[mt][0], acc[mt][1]); pk.y = pack2(acc[mt][2], acc[mt][3]);
                *(u32x2*)(sl + fr * LDP + mt * 16 + fq * 4) = pk;
            }
            __builtin_amdgcn_wave_barrier();
#pragma unroll
            for (int ks = 0; ks < 2; ++ks) sb[ks] = *(const bf16x8*)(sl + fr * LDP + ks * 32 + fq * 8);
            __builtin_amdgcn_wave_barrier();
#pragma unroll
            for (int q = 0; q < 8; ++q) a[q] = an[q];
#pragma unroll
            for (int q = 0; q < 4; ++q) nv[q] = nn[q];
        }
    }
    asm volatile("s_waitcnt vmcnt(0)" ::: "memory");
    RAW_BARRIER();
}

DEV void gla_scan(const P& p, int v) {
    const int chain = v >> 3, sub = v & 7;
    const int dir = chain >> 3, b = (chain >> 2) & 1, h = chain & 3;
    const int ep = sub * 256 + tidx(), d = (2 * ep) & 63;
    float s0 = 0.f, s1 = 0.f;
    for (int st0 = 0; st0 < NSTEP; st0 += 12) {
        unsigned kv[12]; float2 dc[12];
#pragma unroll
        for (int k = 0; k < 12; ++k) {
            const size_t idx = state_idx(dir, b, st0 + k, h);
            kv[k] = *(const unsigned*)(p.glaS + idx * 4096 + 2 * ep);
            dc[k] = *(const float2*)(p.glaDec + idx * 64 + d);
        }
#pragma unroll
        for (int k = 0; k < 12; ++k) {
            const size_t idx = state_idx(dir, b, st0 + k, h);
            *(unsigned*)(p.glaS + idx * 4096 + 2 * ep) = pack2(s0, s1);
            s0 = dc[k].x * s0 + __uint_as_float(kv[k] << 16);
            s1 = dc[k].y * s1 + __uint_as_float(kv[k] & 0xffff0000u);
        }
    }
}

DEV void ml_scan(const P& p, int v) {
    const int chain = v >> 3, sub = v & 7;
    const int dir = chain >> 3, b = (chain >> 2) & 1, h = chain & 3;
    const int tid = tidx();
    const int ep = sub * 256 + tid;
    float s0 = 0.f, s1 = 0.f, m = 0.f;
    for (int st0 = 0; st0 < NSTEP; st0 += 12) {
        unsigned kv[12]; float fe[12], ae[12];
#pragma unroll
        for (int k = 0; k < 12; ++k) {
            const size_t idx = state_idx(dir, b, st0 + k, h);
            kv[k] = *(const unsigned*)(p.mlS + idx * 4096 + 2 * ep);
            fe[k] = p.mlFE[idx]; ae[k] = p.mlAE[idx];
        }
#pragma unroll
        for (int k = 0; k < 12; ++k) {
            const size_t idx = state_idx(dir, b, st0 + k, h);
            *(unsigned*)(p.mlS + idx * 4096 + 2 * ep) = pack2(s0, s1);
            const float mn = fmaxf(fe[k] + m, ae[k]);
            const float od = __expf(fe[k] + m - mn), nw = __expf(ae[k] - mn);
            s0 = od * s0 + nw * __uint_as_float(kv[k] << 16);
            s1 = od * s1 + nw * __uint_as_float(kv[k] & 0xffff0000u);
            m = mn;
        }
    }
}
DEV void ml_nscan(const P& p, int v) {
    const int tid = tidx(), chain = v * 4 + (tid >> 6), d = tid & 63;
    const int dir = chain >> 3, b = (chain >> 2) & 1, h = chain & 3;
    float nn = 0.f, m = 0.f;
    for (int st0 = 0; st0 < NSTEP; st0 += 12) {
        float fe[12], ae[12], ks[12];
#pragma unroll
        for (int k = 0; k < 12; ++k) {
            const size_t idx = state_idx(dir, b, st0 + k, h);
            fe[k] = p.mlFE[idx]; ae[k] = p.mlAE[idx]; ks[k] = p.mlN[idx * 64 + d];
        }
#pragma unroll
        for (int k = 0; k < 12; ++k) {
            const size_t idx = state_idx(dir, b, st0 + k, h);
            p.mlN[idx * 64 + d] = nn;
            if (d == 0) p.mlM[idx] = m;
            const float mn = fmaxf(fe[k] + m, ae[k]);
            const float od = __expf(fe[k] + m - mn), nw = __expf(ae[k] - mn);
            nn = od * nn + nw * ks[k];
            m = mn;
        }
    }
}

DEV void phase_scan(const P& p, int bid, int nb, u16* sm) {
    for (int u = bid; u < 64 + 128 + 128 + 4; u += nb) {
        if (u < 64) { PRB_BEGIN(100); gd_scan(p, u, sm); PRB_END(100); }
        else if (u < 192) { PRB_BEGIN(101); gla_scan(p, u - 64); PRB_END(101); }
        else if (u < 320) { PRB_BEGIN(102); ml_scan(p, u - 192); PRB_END(102); }
        else ml_nscan(p, u - 320);
    }
}
DEV void chunk_geom(int g, int& b, int& row0, int& stf, int& stb) {
    b = g / NSTEP; const int wv = g % NSTEP;
    row0 = wv < 4 ? RLAT + b * CTXL + wv * 64 : b * SEQ + (wv - 4) * 64;
    stf = wv; stb = wv < 4 ? 3 - wv : 135 - wv;
}
DEV void obuf_acc(float* obuf, const f32x4 (&acc)[4], int dir) {
    const int lane = tidx() & 63, w = tidx() >> 6, fr = lane & 15, fq = lane >> 4;
    if (dir == 0) {
#pragma unroll
        for (int nt = 0; nt < 4; ++nt)
#pragma unroll
            for (int j = 0; j < 4; ++j) obuf[(16 * w + fq * 4 + j) * 65 + nt * 16 + fr] = acc[nt][j];
    } else {
        float old[4][4];
#pragma unroll
        for (int nt = 0; nt < 4; ++nt)
#pragma unroll
            for (int j = 0; j < 4; ++j) old[nt][j] = obuf[(63 - (16 * w + fq * 4 + j)) * 65 + nt * 16 + fr];
#pragma unroll
        for (int nt = 0; nt < 4; ++nt)
#pragma unroll
            for (int j = 0; j < 4; ++j) obuf[(63 - (16 * w + fq * 4 + j)) * 65 + nt * 16 + fr] = old[nt][j] + acc[nt][j];
    }
}
DEV Raw16 gate_prefetch(const P& p, int h, int row0, int gcol) {
    const int tid = tidx(), row = tid >> 2, eg = tid & 3;
    return ldraw16(p.cols + (size_t)(row0 + row) * NCM + gcol + h * 64 + eg * 16);
}
template <int ACT>
DEV void head_out(const P& p, int l, int br, int h, int row0, const Raw16& graw, const float* obuf) {
    const int tid = tidx(), row = tid >> 2, eg = tid & 3;
    float o[16]; float ss = 0.f;
#pragma unroll
    for (int i = 0; i < 16; ++i) { o[i] = obuf[row * 65 + eg * 16 + i]; ss += o[i] * o[i]; }
    ss += shx(ss, 1); ss += shx(ss, 2);
    const float rs = rsqrtf(ss * (1.f / 64.f) + EPSF);
    float gt[16];
    unraw16(graw, gt);
    float y[16];
#pragma unroll
    for (int i = 0; i < 16; ++i) {
        const float hn = p.head_norm[(l * 4 + br) * 256 + h * 64 + eg * 16 + i];
        const float a = ACT == 0 ? silu(gt[i]) : sigm(gt[i]);
        y[i] = o[i] * rs * hn * a;
    }
    st16bf(p.ybuf + (size_t)(row0 + row) * 1024 + br * 256 + h * 64 + eg * 16, y);
}

DEV void gla_phaseC(const P& p, int l, int g, int h, unsigned char* smraw) {
    float* cum = (float*)smraw;
    float* rt = cum + 64 * 65;
    float* sg = rt + 64 * 17;
    float* obuf = sg + 256;
    u16* qi = (u16*)(obuf + 64 * 65);
    u16* ko = qi + 64 * LDP;
    u16* vT = ko + 64 * LDP;
    const int tid = tidx(), lane = tid & 63, w = tid >> 6, fr = lane & 15, fq = lane >> 4;
    int b, row0, stf, stb; chunk_geom(g, b, row0, stf, stb);
    const Raw16 graw = gate_prefetch(p, h, row0, GLA_G);
    for (int dir = 0; dir < 2; ++dir) {
        const size_t idx = state_idx(dir, b, dir ? stb : stf, h);
        Raw16 qraw, kraw, vraw; bf16x8 sin_[2][4];
        {
            const int s = tid >> 2, dg = tid & 3, row = row0 + (dir ? 63 - s : s);
            qraw = ldraw16(p.cols + (size_t)row * NCM + GLA_Q + h * 64 + dg * 16);
            kraw = ldraw16(p.cols + (size_t)row * NCM + GLA_K + h * 64 + dg * 16);
            vraw = ldraw16(p.cols + (size_t)row * NCM + GLA_V + h * 64 + dg * 16);
        }
        ldB64(sin_, p.glaS + idx * 4096);
        PRB_BEGIN(140);
        gla_cum(p, l, dir, h, row0, cum, rt, sg);
        PRB_END(140);
        PRB_BEGIN(141);
        {
            const int s = tid >> 2, dg = tid & 3;
            float qq[16], kk[16], vv[16];
            unraw16(qraw, qq); unraw16(kraw, kk); unraw16(vraw, vv);
#pragma unroll
            for (int i = 0; i < 16; ++i) {
                const float cv = cum[s * 65 + dg * 16 + i];
                qq[i] *= 0.125f * __expf(cv); kk[i] *= __expf(-cv);
                vT[(dg * 16 + i) * LDP + s] = f2bf(vv[i]);
            }
            st16bf(qi + s * LDP + dg * 16, qq);
            st16bf(ko + s * LDP + dg * 16, kk);
        }
        __syncthreads();
        f32x4 sa[4]; zero4(sa);
        mm64(sa, qi, LDP, ko, LDP);
        __syncthreads();
#pragma unroll
        for (int nt = 0; nt < 4; ++nt)
#pragma unroll
            for (int j = 0; j < 4; ++j) {
                const int c = 16 * w + fq * 4 + j, s = nt * 16 + fr;
                ko[c * LDP + s] = f2bf(s <= c ? sa[nt][j] : 0.f);
            }
        __syncthreads();
        PRB_END(141);
        PRB_BEGIN(142);
        f32x4 oa[4]; zero4(oa);
        mm64(oa, ko, LDP, vT, LDP);
        mm64_pre(oa, qi, LDP, sin_);
        obuf_acc(obuf, oa, dir);
        __syncthreads();
        PRB_END(142);
    }
    PRB_BEGIN(143);
    head_out<0>(p, l, 0, h, row0, graw, obuf);
    __syncthreads();
    PRB_END(143);
}

DEV void ml_phaseC(const P& p, int l, int g, int h, unsigned char* smraw) {
    float* obuf = (float*)smraw;
    float* fcum = obuf + 64 * 65;
    float* ipre = fcum + 64;
    float* mrow = ipre + 64;
    float* denl = mrow + 64;
    float* qn = denl + 64;
    float* nin = qn + 64;
    u16* qs = (u16*)(nin + 64 + 64);
    u16* ks = qs + 64 * LDP;
    u16* vT = ks + 64 * LDP;
    const int tid = tidx(), lane = tid & 63, w = tid >> 6, fr = lane & 15, fq = lane >> 4;
    int b, row0, stf, stb; chunk_geom(g, b, row0, stf, stb);
    const Raw16 graw = gate_prefetch(p, h, row0, ML_O);
    for (int dir = 0; dir < 2; ++dir) {
        const size_t idx = state_idx(dir, b, dir ? stb : stf, h);
        const float m_in = p.mlM[idx];
        Raw16 qraw, kraw, vraw; bf16x8 cin_[2][4];
        {
            const int s = tid >> 2, dg = tid & 3, row = row0 + (dir ? 63 - s : s);
            qraw = ldraw16(p.cols + (size_t)row * NCM + ML_Q + h * 64 + dg * 16);
            kraw = ldraw16(p.cols + (size_t)row * NCM + ML_K + h * 64 + dg * 16);
            vraw = ldraw16(p.cols + (size_t)row * NCM + ML_V + h * 64 + dg * 16);
        }
        ldB64(cin_, p.mlS + idx * 4096);
        if (w == 0) {
            const int row = row0 + (dir ? 63 - lane : lane);
            const float ip = bf2f(p.cols[(size_t)row * NCM + ML_GF + dir * 8 + h]) + p.mlstm_gate_b[((l * 2 + dir) * 2 + 0) * 4 + h];
            const float lf = logsig(bf2f(p.cols[(size_t)row * NCM + ML_GF + dir * 8 + 4 + h]) + p.mlstm_gate_b[((l * 2 + dir) * 2 + 1) * 4 + h]);
            const float fc = wscan_add(lf, lane);
            const float pm = wscan_max(ip - fc, lane);
            fcum[lane] = fc; ipre[lane] = ip; mrow[lane] = fc + fmaxf(m_in, pm);
            nin[lane] = p.mlN[idx * 64 + lane];
        }
        {
            const int s = tid >> 2, dg = tid & 3;
            float kk[16], vv[16];
            *(u32x4*)(qs + s * LDP + dg * 16) = qraw.a;
            *(u32x4*)(qs + s * LDP + dg * 16 + 8) = qraw.b;
            unraw16(kraw, kk); unraw16(vraw, vv);
#pragma unroll
            for (int i = 0; i < 16; ++i) { kk[i] *= 0.125f; vT[(dg * 16 + i) * LDP + s] = f2bf(vv[i]); }
            st16bf(ks + s * LDP + dg * 16, kk);
        }
        __syncthreads();
        {
            const int c = tid >> 2, dg = tid & 3;
            float a = 0.f;
#pragma unroll
            for (int i = 0; i < 16; ++i) a += bf2f(qs[c * LDP + dg * 16 + i]) * nin[dg * 16 + i];
            a += shx(a, 1); a += shx(a, 2);
            if (dg == 0) qn[c] = a;
        }
        f32x4 sa[4]; zero4(sa);
        mm64(sa, qs, LDP, ks, LDP);
        __syncthreads();
        float dsum[4] = {0.f, 0.f, 0.f, 0.f};
#pragma unroll
        for (int nt = 0; nt < 4; ++nt)
#pragma unroll
            for (int j = 0; j < 4; ++j) {
                const int c = 16 * w + fq * 4 + j, s = nt * 16 + fr;
                const float ex = __expf(fminf(fcum[c] - fcum[s] + ipre[s] - mrow[c], 0.f));
                const float val = sa[nt][j] * ex * (s <= c ? 1.f : 0.f);
                dsum[j] += val;
                ks[c * LDP + s] = f2bf(val);
            }
#pragma unroll
        for (int j = 0; j < 4; ++j) {
            float v = dsum[j];
            v += shx(v, 1); v += shx(v, 2); v += shx(v, 4); v += shx(v, 8);
            if (fr == 0) denl[16 * w + fq * 4 + j] = v;
        }
        __syncthreads();
        f32x4 n1[4], n2[4]; zero4(n1); zero4(n2);
        mm64(n1, ks, LDP, vT, LDP);
        mm64_pre(n2, qs, LDP, cin_);
        f32x4 oa[4];
#pragma unroll
        for (int j = 0; j < 4; ++j) {
            const int c = 16 * w + fq * 4 + j;
            const float mr = mrow[c];
            const float ec = __expf(fcum[c] + m_in - mr);
            const float den = denl[c] + ec * qn[c];
            const float inv = 1.f / fmaxf(fabsf(den), __expf(-mr));
#pragma unroll
            for (int nt = 0; nt < 4; ++nt) oa[nt][j] = (n1[nt][j] + ec * n2[nt][j]) * inv;
        }
        obuf_acc(obuf, oa, dir);
        __syncthreads();
    }
    head_out<1>(p, l, 1, h, row0, graw, obuf);
    __syncthreads();
}

DEV void gd_phaseC(const P& p, int l, int g, int h, unsigned char* smraw) {
    float* obuf = (float*)smraw;
    const int tid = tidx(), lane = tid & 63, w = tid >> 6, fr = lane & 15, fq = lane >> 4;
    int b, row0, stf, stb; chunk_geom(g, b, row0, stf, stb);
    const Raw16 graw = gate_prefetch(p, h, row0, GD_OG);
    for (int dir = 0; dir < 2; ++dir) {
        const size_t idx = state_idx(dir, b, dir ? stb : stf, h);
        f32x4 oa[4];
#pragma unroll
        for (int nt = 0; nt < 4; ++nt) {
            const u32x2 ov = *(const u32x2*)(p.gdO + idx * 4096 + (nt * 16 + fr) * 64 + 16 * w + fq * 4);
            oa[nt][0] = __uint_as_float(ov.x << 16); oa[nt][1] = __uint_as_float(ov.x & 0xffff0000u);
            oa[nt][2] = __uint_as_float(ov.y << 16); oa[nt][3] = __uint_as_float(ov.y & 0xffff0000u);
        }
        mm64(oa, p.gdQ + idx * 4096, 64, p.gdN + idx * 4096, 64);
        obuf_acc(obuf, oa, dir);
        __syncthreads();
    }
    head_out<0>(p, l, 2, h, row0, graw, obuf);
    __syncthreads();
}
DEV float fexp2(float x) { return __builtin_amdgcn_exp2f(x); }
#define ATT_STAGE_ELEMS (2 * 64 * 64)
DEV void attn_issue(const u16* kbase, const u16* vbase, int kt, u16* ring, int stg, int w, int lane) {
    u16* kd = ring + stg * ATT_STAGE_ELEMS;
    u16* vd = kd + 64 * 64;
#pragma unroll
    for (int i = 0; i < 2; ++i) {
        const int r = (w * 2 + i) * 8 + (lane >> 3), c = (lane & 7) ^ ((r >> 1) & 7);
        __builtin_amdgcn_global_load_lds((const unsigned*)(kbase + (size_t)(kt * 64 + r) * 64 + c * 8), (unsigned*)(kd + (w * 2 + i) * 512), 16, 0, 0);
        __builtin_amdgcn_global_load_lds((const unsigned*)(vbase + (size_t)r * KPOS + kt * 64 + c * 8), (unsigned*)(vd + (w * 2 + i) * 512), 16, 0, 0);
    }
}

DEV void attn_unit(const P& p, int l, int b, int h, int q0pos, int nkeys, int rowbase, u16* ring) {
    const int tid = tidx(), lane = tid & 63, w = tid >> 6, fr = lane & 15, fq = lane >> 4;
    const size_t bh = (size_t)(b * 4 + h);
    float lam;
    {
        const float* lp = p.diff_lambda + (size_t)l * 4 * 4 * 32;
        float a = 0.f, c = 0.f;
        if (lane < 32) { a = lp[(0 * 4 + h) * 32 + lane] * lp[(1 * 4 + h) * 32 + lane]; c = lp[(2 * 4 + h) * 32 + lane] * lp[(3 * 4 + h) * 32 + lane]; }
        a = wsum(a); c = wsum(c);
        lam = expf(a) - expf(c) + (0.8f - 0.6f * expf(-0.3f * (float)l));
    }
    const float lam_init = 0.8f - 0.6f * expf(-0.3f * (float)l);
    bf16x8 qf[2][2];
#pragma unroll
    for (int g = 0; g < 2; ++g)
#pragma unroll
        for (int i = 0; i < 2; ++i)
            qf[g][i] = *(const bf16x8*)(p.dq + (bh * KPOS + q0pos + w * 32 + g * 16 + fr) * 64 + i * 32 + fq * 8);
    f32x4 O[2][2][4], negref[2][2];
    float mref[2][2], lsum[2][2];
#pragma unroll
    for (int i = 0; i < 2; ++i)
#pragma unroll
        for (int g = 0; g < 2; ++g) {
            mref[i][g] = 0.f; lsum[i][g] = 0.f; negref[i][g] = f32x4{0.f, 0.f, 0.f, 0.f};
#pragma unroll
            for (int t = 0; t < 4; ++t) O[i][g][t] = f32x4{0.f, 0.f, 0.f, 0.f};
        }
    const u16* kbase = p.dk + bh * KPOS * 64;
    const u16* vbase = p.dvT + bh * 64 * KPOS;
    const int nk = nkeys >> 6;
    asm volatile("s_waitcnt vmcnt(0)" ::: "memory");
    attn_issue(kbase, vbase, 0, ring, 0, w, lane);
    attn_issue(kbase, vbase, 1, ring, 1, w, lane);
    const int sw = (fr >> 1) & 7;
    for (int kt = 0; kt < nk; ++kt) {
        if (kt + 1 < nk) asm volatile("s_waitcnt vmcnt(4)" ::: "memory"); else asm volatile("s_waitcnt vmcnt(0)" ::: "memory");
        RAW_BARRIER();
        if (kt + 2 < nk) attn_issue(kbase, vbase, kt + 2, ring, (kt + 2) % 3, w, lane);
        const u16* Ks = ring + (kt % 3) * ATT_STAGE_ELEMS;
        const u16* Vs = Ks + 64 * 64;
#pragma unroll
        for (int i = 0; i < 2; ++i) {
            f32x4 s[2][4];
#pragma unroll
            for (int st = 0; st < 4; ++st) {
                const bf16x8 kf = *(const bf16x8*)(Ks + (st * 16 + fr) * 64 + (((i * 4 + fq) ^ sw) * 8));
#pragma unroll
                for (int g = 0; g < 2; ++g) s[g][st] = mfma16(kf, qf[g][i], negref[i][g]);
            }
            float tmx[2];
#pragma unroll
            for (int g = 0; g < 2; ++g) {
                float mx = fmaxf(fmaxf(s[g][0][0], s[g][0][1]), fmaxf(s[g][0][2], s[g][0][3]));
#pragma unroll
                for (int st = 1; st < 4; ++st) mx = fmaxf(fmaxf(mx, s[g][st][0]), fmaxf(fmaxf(s[g][st][1], s[g][st][2]), s[g][st][3]));
                mx = fmaxf(mx, shx(mx, 16)); mx = fmaxf(mx, shx(mx, 32));
                tmx[g] = mx;
            }
            const bool mv = (tmx[0] > 16.f) || (tmx[1] > 16.f) || (kt == 0 && (tmx[0] < -16.f || tmx[1] < -16.f));
            if (__any(mv)) {
#pragma unroll
                for (int g = 0; g < 2; ++g) {
                    const float d = ((tmx[g] > 16.f) || (kt == 0 && tmx[g] < -16.f)) ? tmx[g] : 0.f;
                    const float fac = fexp2(-d);
                    mref[i][g] += d; lsum[i][g] *= fac;
                    negref[i][g] = f32x4{-mref[i][g], -mref[i][g], -mref[i][g], -mref[i][g]};
#pragma unroll
                    for (int t = 0; t < 4; ++t) { O[i][g][t][0] *= fac; O[i][g][t][1] *= fac; O[i][g][t][2] *= fac; O[i][g][t][3] *= fac; }
#pragma unroll
                    for (int st = 0; st < 4; ++st) { s[g][st][0] -= d; s[g][st][1] -= d; s[g][st][2] -= d; s[g][st][3] -= d; }
                }
            }
            bf16x8 pb[2][2];
#pragma unroll
            for (int g = 0; g < 2; ++g) {
                float ps = 0.f;
#pragma unroll
                for (int st = 0; st < 4; ++st)
#pragma unroll
                    for (int j = 0; j < 4; ++j) { const float e = fexp2(s[g][st][j]); s[g][st][j] = e; ps += e; }
                lsum[i][g] += ps;
#pragma unroll
                for (int ks = 0; ks < 2; ++ks) {
                    union { bf16x8 v; unsigned u[4]; } pk;
                    pk.u[0] = pack2(s[g][2 * ks][0], s[g][2 * ks][1]); pk.u[1] = pack2(s[g][2 * ks][2], s[g][2 * ks][3]);
                    pk.u[2] = pack2(s[g][2 * ks + 1][0], s[g][2 * ks + 1][1]); pk.u[3] = pack2(s[g][2 * ks + 1][2], s[g][2 * ks + 1][3]);
                    pb[g][ks] = pk.v;
                }
            }
#pragma unroll
            for (int ks = 0; ks < 2; ++ks)
#pragma unroll
                for (int t = 0; t < 4; ++t) {
                    union { bf16x8 v; u32x2 h2[2]; } va;
                    va.h2[0] = *(const u32x2*)(Vs + (t * 16 + fr) * 64 + ((((2 * ks) * 2 + (fq >> 1)) ^ sw) * 8) + (fq & 1) * 4);
                    va.h2[1] = *(const u32x2*)(Vs + (t * 16 + fr) * 64 + ((((2 * ks + 1) * 2 + (fq >> 1)) ^ sw) * 8) + (fq & 1) * 4);
#pragma unroll
                    for (int g = 0; g < 2; ++g) O[i][g][t] = mfma16(va.v, pb[g][ks], O[i][g][t]);
                }
        }
    }
    RAW_BARRIER();
#pragma unroll
    for (int g = 0; g < 2; ++g) {
        float l0 = lsum[0][g], l1 = lsum[1][g];
        l0 += shx(l0, 16); l0 += shx(l0, 32);
        l1 += shx(l1, 16); l1 += shx(l1, 32);
        const float i0 = 1.f / l0, i1 = lam / l1;
        float o[4][4]; float ss = 0.f;
#pragma unroll
        for (int t = 0; t < 4; ++t)
#pragma unroll
            for (int j = 0; j < 4; ++j) { o[t][j] = O[0][g][t][j] * i0 - O[1][g][t][j] * i1; ss += o[t][j] * o[t][j]; }
        ss += shx(ss, 16); ss += shx(ss, 32);
        const float rs = rsqrtf(ss * (1.f / 64.f) + EPSF) * (1.f - lam_init);
        const int row = rowbase + w * 32 + g * 16 + fr;
#pragma unroll
        for (int t = 0; t < 4; ++t) {
            const int dv = t * 16 + fq * 4;
            const float4 hn = *(const float4*)(p.head_norm + (l * 4 + 3) * 256 + h * 64 + dv);
            u32x2 pk; pk.x = pack2(o[t][0] * rs * hn.x, o[t][1] * rs * hn.y); pk.y = pack2(o[t][2] * rs * hn.z, o[t][3] * rs * hn.w);
            *(u32x2*)(p.ybuf + (size_t)row * 1024 + 768 + h * 64 + dv) = pk;
        }
    }
}

template <int PART>
DEV void phase_outputs(const P& p, int l, int bid, int nb, unsigned char* sm) {
    if (PART != 2) {
    const int nq = 64 + (l == 0 ? 2 : 0);
    int* qctr = p.cnt + 64 + l * 8;
    volatile int* slot = (volatile int*)(sm + 3 * ATT_STAGE_ELEMS * 2);
    const int x0 = (int)(xb_xcc_id() & 7u);
    for (int a = 0; a < 8; ++a) {
        const int bh = (x0 + a) & 7;
        for (;;) {
            if (tidx() == 0) *slot = atomicAdd(qctr + bh, 1);
            __syncthreads();
            const int qt = *slot;
            __syncthreads();
            if (qt >= nq) break;
            const int b = bh >> 2, h = bh & 3;
            if (qt < 64) attn_unit(p, l, b, h, CTXL + qt * 128, KPOS, b * SEQ + qt * 128, (u16*)sm);
            else attn_unit(p, l, b, h, (qt - 64) * 128, CTXL, RLAT + b * CTXL + (qt - 64) * 128, (u16*)sm);
        }
    }
    }
    __builtin_amdgcn_sched_barrier(0);
    if (PART != 1)
    for (int v = bid; v < 3 * 1056; v += nb) {
        const int mix = v / 1056, r = v % 1056, g = r >> 2, h = r & 3;
        if (l == 1 && (g % NSTEP) < 4) continue;
        if (mix == 0) { PRB_BEGIN(131); gla_phaseC(p, l, g, h, sm); PRB_END(131); }
        else if (mix == 1) { PRB_BEGIN(132); ml_phaseC(p, l, g, h, sm); PRB_END(132); }
        else { PRB_BEGIN(133); gd_phaseC(p, l, g, h, sm); PRB_END(133); }
    }
}
#define LDS_BYTES 75776
#ifndef MULTI
#define MULTI 0
#endif
#ifndef STAGE
#define STAGE 99
#endif

enum { PH_PRO0 = 0, PH_PRO1, PH_NORM1, PH_INPROJ, PH_PREP, PH_CHUNKA, PH_SCAN, PH_OUT, PH_GATES, PH_MERGE1, PH_MERGE2, PH_ROUTER, PH_MOEUP, PH_MOEDOWN, PH_FINAL, PH_OUTC };

struct KArgs { const float* in[25]; float* out; unsigned char* ws; };
constexpr size_t al256c(size_t x) { return (x + 255) & ~(size_t)255; }
struct WsOff {
    size_t Wd, Wt2, bar, cnt, zero_end, modp, mod, xctx, rope, hbuf, ybuf, Wt, dq, dk, dvT, glaDec, mlN, mlFE, mlAE, mlM, glaS, mlS, gdM, gdN, gdQ, gdO, cols, total;
};
constexpr WsOff make_off() {
    WsOff o{}; size_t c = 0;
    const size_t nst = (size_t)2 * 2 * NSTEP * 4;
    o.bar = c; c = al256c(c + XCD_BAR_WORDS * 4);
    o.cnt = c; c = al256c(c + 1024);
    o.zero_end = c;
    o.modp = c; c = al256c(c + (size_t)2 * 16 * 3 * 6144 * 4);
    o.mod = c; c = al256c(c + (size_t)2 * 3 * 6144 * 4);
    o.xctx = c; c = al256c(c + (size_t)RCTX * DM * 4);
    o.rope = c; c = al256c(c + (size_t)192 * 8 * 2 * 4);
    o.hbuf = c; c = al256c(c + (size_t)RTOT * DM * 2);
    o.ybuf = c; c = al256c(c + (size_t)RTOT * DM * 2);
    o.Wt = c; c = al256c(c + (size_t)WT_TOTAL * 2);
    o.dq = c; c = al256c(c + (size_t)8 * KPOS * 64 * 2);
    o.dk = c; c = al256c(c + (size_t)8 * KPOS * 64 * 2);
    o.dvT = c; c = al256c(c + (size_t)8 * KPOS * 64 * 2);
    o.glaDec = c; c = al256c(c + nst * 64 * 4);
    o.mlN = c; c = al256c(c + nst * 64 * 4);
    o.mlFE = c; c = al256c(c + nst * 4);
    o.mlAE = c; c = al256c(c + nst * 4);
    o.mlM = c; c = al256c(c + nst * 4);
    o.glaS = c; c = al256c(c + nst * 4096 * 2);
    o.mlS = c; c = al256c(c + nst * 4096 * 2);
    o.gdM = c; c = al256c(c + nst * 4096 * 2);
    o.gdN = c; c = al256c(c + nst * 4096 * 2);
    o.gdQ = c; c = al256c(c + nst * 4096 * 2);
    o.gdO = c; c = al256c(c + nst * 4096 * 2);
    o.cols = c; c = al256c(c + (size_t)RTOT * NGATE * 2);
    o.Wd = c; c = al256c(c + (size_t)16 * 1024 * 512 * 2);
    o.Wt2 = c; c = al256c(c + (size_t)WT_TOTAL * 2);
    o.total = c;
    return o;
}
constexpr WsOff WSO = make_off();
template <class T> DEV T* launder_p(T* v) {
    __attribute__((address_space(1))) T* g = (__attribute__((address_space(1))) T*)v;
    asm volatile("" : "+s"(g));
    return (T*)g;
}
DEV P build_P(const KArgs& ka) {
    P p;
    const float* in[25];
#pragma unroll
    for (int i = 0; i < 25; ++i) in[i] = launder_p(ka.in[i]);
    p.x = in[0]; p.c = in[1]; p.ctx = in[2]; p.c_ctx = in[3]; p.w_mod = in[4]; p.b_mod = in[5]; p.norm_mix = in[6]; p.norm_ffn = in[7];
    p.w_in = in[8]; p.gla_a2 = in[9]; p.gla_ab = in[10]; p.mlstm_gate_b = in[11]; p.gdn_conv = in[12]; p.gdn_a_log = in[13];
    p.gdn_dt_bias = in[14]; p.diff_lambda = in[15]; p.head_norm = in[16]; p.w_branch = in[17]; p.w_out = in[18]; p.router_w = in[19];
    p.router_b = in[20]; p.w_gate = in[21]; p.w_up = in[22]; p.w_down = in[23]; p.norm_final = in[24];
    p.out = launder_p(ka.out);
    unsigned char* ws = launder_p(ka.ws);
    p.bar = (unsigned*)(ws + WSO.bar); p.cnt = (int*)(ws + WSO.cnt); p.modp = (float*)(ws + WSO.modp); p.mod = (float*)(ws + WSO.mod);
    p.xctx = (float*)(ws + WSO.xctx); p.rope = (float*)(ws + WSO.rope); p.hbuf = (u16*)(ws + WSO.hbuf); p.ybuf = (u16*)(ws + WSO.ybuf);
    p.Wt = (u16*)(ws + WSO.Wt); p.dq = (u16*)(ws + WSO.dq); p.dk = (u16*)(ws + WSO.dk); p.dvT = (u16*)(ws + WSO.dvT);
    p.glaDec = (float*)(ws + WSO.glaDec); p.mlN = (float*)(ws + WSO.mlN); p.mlFE = (float*)(ws + WSO.mlFE); p.mlAE = (float*)(ws + WSO.mlAE);
    p.mlM = (float*)(ws + WSO.mlM); p.glaS = (u16*)(ws + WSO.glaS); p.mlS = (u16*)(ws + WSO.mlS); p.gdM = (u16*)(ws + WSO.gdM);
    p.gdN = (u16*)(ws + WSO.gdN); p.gdQ = (u16*)(ws + WSO.gdQ); p.gdO = (u16*)(ws + WSO.gdO); p.cols = (u16*)(ws + WSO.cols); p.Wd = (u16*)(ws + WSO.Wd);
    return p;
}

template <int PH>
DEV void run_phase(const KArgs& ka, int l, int bid_, int nb_, unsigned char* sm) {
    P p = build_P(ka);
    u16* const Wt2 = (u16*)(launder_p(ka.ws) + WSO.Wt2);
    if (l == 1) p.Wt = Wt2;
    const int bid = launder_s(bid_), nb = launder_s(nb_);
    u16* gqkv = p.ybuf;
    u16* ubuf = p.glaS;
    const int mtiles = l == 0 ? 132 : 128;
    if (PH == PH_PRO0) { phase_conv_mixw(p, p.Wt, 0, bid, nb, 0, (float*)sm); phase_mod_partial(p, bid, nb, (float*)sm); phase_rope_table(p, bid, nb); }
    else if (PH == PH_PRO1) phase_mod_reduce(p, bid, nb);
    else if (PH == PH_NORM1) phase_norm1(p, l, bid, nb);
    else if (PH == PH_INPROJ) phase_inproj<false>(p, 0, 31, NCM, 66, bid, nb, (u16*)sm);
    else if (PH == PH_PREP) phase_prep(p, l, gqkv, bid, nb, (u16*)sm);
    else if (PH == PH_CHUNKA) phase_chunkA(p, l, gqkv, bid, nb, sm);
    else if (PH == PH_SCAN) {
        phase_scan(p, bid, nb, (u16*)sm);
        phase_conv_moed(p, l, bid, nb, nb > 400 ? 324 : 0, (float*)sm);
        if (l == 0) phase_conv_mixw(p, Wt2, 1, bid, nb, nb > 400 ? 324 : 0, (float*)sm);
    }
#ifdef PROBE_SPLIT
    else if (PH == PH_OUT) phase_outputs<1>(p, l, bid, nb, sm);
    else if (PH == PH_OUTC) phase_outputs<2>(p, l, bid, nb, sm);
#else
    else if (PH == PH_OUT) phase_outputs<0>(p, l, bid, nb, sm);
#endif
    else if (PH == PH_GATES) phase_inproj<true>(p, 3968, 32, NGATE, mtiles / 2, bid, nb, (u16*)sm);
    else if (PH == PH_MERGE1) phase_merge1(p, ubuf, mtiles, bid, nb, (u16*)sm);
    else if (PH == PH_MERGE2) { if (l == 0) phase_merge2s(p, l, ubuf, mtiles, bid, nb, (u16*)sm); else phase_merge2(p, l, ubuf, mtiles, bid, nb, (u16*)sm); }
    else if (PH == PH_ROUTER) {
        { PRB_BEGIN(110); phase_norm2_router(p, l, l == 0 ? RTOT : RLAT, bid, nb, (float*)sm); PRB_END(110); }
        { PRB_BEGIN(111); phase_conv_moew(p, l, bid, nb, (float*)sm); PRB_END(111); }
    }
    else if (PH == PH_MOEUP) phase_moe_up(p, l, bid, nb, (u16*)sm);
    else if (PH == PH_MOEDOWN) phase_moe_down_s(p, l, bid, nb, (u16*)sm);
    else if (PH == PH_FINAL) phase_final_norm(p, bid, nb);
}

#if MULTI
template <int PH>
__global__ void __launch_bounds__(NTHR, 2) k_phase(KArgs p, int l) {
    extern __shared__ __attribute__((aligned(16))) unsigned char smem[];
    run_phase<PH>(p, l, blockIdx.x, gridDim.x, smem);
}
#else
__global__ void __launch_bounds__(NTHR, 2) k_mega(KArgs p) {
    extern __shared__ __attribute__((aligned(16))) unsigned char smem[];
    volatile LAS unsigned* xbw = (volatile LAS unsigned*)(smem + LDS_BYTES);
    if (tidx() == 0) { xbw[0] = 0u; xbw[1] = 0u; xbw[2] = 0u; xbw[3] = 0u; }
    __syncthreads();
    (void)xcd_barrier_post((unsigned*)(p.ws + WSO.bar), xbw);
    const int bid = blockIdx.x, nb = gridDim.x;
#ifdef PROBE_SEL
    unsigned long long pr_t0 = wall_clock64();
    volatile LAS unsigned long long* pr_acc = (volatile LAS unsigned long long*)(smem + LDS_BYTES + 8);
#ifdef PROBE_CLK
    unsigned long long pr_c0 = __builtin_readcyclecounter();
#define PSTAMP(PH) do { const unsigned long long c_ = __builtin_readcyclecounter(); if ((PH) == PROBE_SEL && threadIdx.x == 0) *pr_acc = *pr_acc + (c_ - pr_c0) / 24ull; pr_c0 = c_; } while (0)
#else
#define PSTAMP(PH) do { const unsigned long long t_ = wall_clock64(); if ((PH) == PROBE_SEL && threadIdx.x == 0) *pr_acc = *pr_acc + (t_ - pr_t0); pr_t0 = t_; } while (0)
#endif
#else
#define PSTAMP(PH) do { } while (0)
#endif
#ifdef PROBE_2BAR
#define GBAR() do { GBAR1(); GBAR1(); } while (0)
#else
#define GBAR() GBAR1()
#endif
#define GBAR1() do { XcdBarrier b_; b_.bar = (unsigned*)(launder_p(p.ws) + WSO.bar); b_.x = xb_xcc_id(); b_.st = (volatile LAS unsigned*)(smem + LDS_BYTES); xcd_barrier(b_); } while (0)
    run_phase<PH_PRO0>(p, 0, bid, nb, smem); GBAR(); PSTAMP(PH_PRO0);
    run_phase<PH_PRO1>(p, 0, bid, nb, smem); GBAR(); PSTAMP(PH_PRO1);
    for (int l = 0; l < 2; ++l) {
        run_phase<PH_NORM1>(p, l, bid, nb, smem); GBAR(); PSTAMP(PH_NORM1);
        run_phase<PH_INPROJ>(p, l, bid, nb, smem); GBAR(); PSTAMP(PH_INPROJ);
#ifdef PROBE_GEMM
        { PRB_BEGIN(200); const P pp = build_P(p); phase_inproj<false, PROBE_GEMM>(pp, 0, 31, NCM, 66, launder_s(bid), launder_s(nb), (u16*)smem); PRB_END(200); } GBAR();
#endif
        run_phase<PH_PREP>(p, l, bid, nb, smem); GBAR(); PSTAMP(PH_PREP);
        run_phase<PH_CHUNKA>(p, l, bid, nb, smem); GBAR(); PSTAMP(PH_CHUNKA);
        run_phase<PH_SCAN>(p, l, bid, nb, smem); GBAR(); PSTAMP(PH_SCAN);
        run_phase<PH_OUT>(p, l, bid, nb, smem); GBAR(); PSTAMP(PH_OUT);
#ifdef PROBE_SPLIT
        run_phase<PH_OUTC>(p, l, bid, nb, smem); GBAR(); PSTAMP(PH_OUTC);
#endif
        run_phase<PH_GATES>(p, l, bid, nb, smem); GBAR(); PSTAMP(PH_GATES);
        run_phase<PH_MERGE1>(p, l, bid, nb, smem); GBAR(); PSTAMP(PH_MERGE1);
        run_phase<PH_MERGE2>(p, l, bid, nb, smem); GBAR(); PSTAMP(PH_MERGE2);
        run_phase<PH_ROUTER>(p, l, bid, nb, smem); GBAR(); PSTAMP(PH_ROUTER);
        run_phase<PH_MOEUP>(p, l, bid, nb, smem); GBAR(); PSTAMP(PH_MOEUP);
        run_phase<PH_MOEDOWN>(p, l, bid, nb, smem); GBAR(); PSTAMP(PH_MOEDOWN);
    }
    run_phase<PH_FINAL>(p, 0, bid, nb, smem);
#ifdef PROBE_SEL
    __syncthreads();
    { const unsigned long long te = wall_clock64(), wt = *pr_acc * 4ull; while (wall_clock64() - te < wt) __builtin_amdgcn_s_sleep(8); }
#endif
}
#endif

static size_t al256(size_t x) { return (x + 255) & ~(size_t)255; }

extern "C" void kernel_launch(void* const* d_in, const int* in_sizes, int n_in, void* d_out, int out_size, void* d_ws, size_t ws_size,
                              hipStream_t stream) {
    (void)in_sizes; (void)n_in; (void)out_size;
    if (ws_size < WSO.total) return;
    KArgs p{};
    for (int i = 0; i < 25; ++i) p.in[i] = (const float*)d_in[i];
    p.out = (float*)d_out;
    p.ws = (unsigned char*)d_ws;
    unsigned char* ws = (unsigned char*)d_ws;
    const size_t zero_bytes = WSO.zero_end;
    hipMemsetAsync(ws, 0, zero_bytes, stream);

    static int grid = 0;
#if MULTI
#define SETUP(PH) hipFuncSetAttribute((const void*)k_phase<PH>, hipFuncAttributeMaxDynamicSharedMemorySize, LDS_BYTES + 16)
    if (!grid) {
        SETUP(PH_PRO0); SETUP(PH_PRO1); SETUP(PH_NORM1); SETUP(PH_INPROJ); SETUP(PH_PREP); SETUP(PH_CHUNKA); SETUP(PH_SCAN); SETUP(PH_OUT);
        SETUP(PH_GATES); SETUP(PH_MERGE1); SETUP(PH_MERGE2); SETUP(PH_ROUTER); SETUP(PH_MOEUP); SETUP(PH_MOEDOWN); SETUP(PH_FINAL);
        grid = 512;
    }
#define LAUNCH(PH, l) k_phase<PH><<<grid, NTHR, LDS_BYTES + 16, stream>>>(p, l)
    LAUNCH(PH_PRO0, 0); LAUNCH(PH_PRO1, 0);
    for (int l = 0; l < 2; ++l) {
        LAUNCH(PH_NORM1, l);
#if STAGE >= 1
        LAUNCH(PH_INPROJ, l); LAUNCH(PH_PREP, l); LAUNCH(PH_CHUNKA, l); LAUNCH(PH_SCAN, l); LAUNCH(PH_OUT, l);
        LAUNCH(PH_GATES, l); LAUNCH(PH_MERGE1, l); LAUNCH(PH_MERGE2, l);
#endif
        LAUNCH(PH_ROUTER, l); LAUNCH(PH_MOEUP, l); LAUNCH(PH_MOEDOWN, l);
    }
    LAUNCH(PH_FINAL, 0);
#else
    if (!grid) {
        hipFuncSetAttribute((const void*)k_mega, hipFuncAttributeMaxDynamicSharedMemorySize, LDS_BYTES + 16);
        int dev = 0, cus = 0, per_cu = 0;
        hipGetDevice(&dev);
        hipDeviceGetAttribute(&cus, hipDeviceAttributeMultiprocessorCount, dev);
        hipOccupancyMaxActiveBlocksPerMultiprocessor(&per_cu, (const void*)k_mega, NTHR, LDS_BYTES + 16);
        if (per_cu > 2) per_cu = 2;
        if (per_cu < 1) per_cu = 1;
        grid = cus * per_cu;
    }
    k_mega<<<grid, NTHR, LDS_BYTES + 16, stream>>>(p);
#endif
}
```

```cpp
#include <hip/hip_runtime.h>
#include <stdint.h>
#include <math.h>

typedef unsigned short u16;
typedef short bf16x8 __attribute__((ext_vector_type(8)));
typedef float f32x4 __attribute__((ext_vector_type(4)));
typedef unsigned u32x2 __attribute__((ext_vector_type(2)));
typedef unsigned u32x4 __attribute__((ext_vector_type(4)));

#define DEV __device__ __forceinline__
#define NTHR 256

#define DM 1024
#define RLAT 16384
#define RCTX 512
#define RTOT 16896
#define SEQ 8192
#define CTXL 256
#define NCM 3968
#define NGATE 4096
#define NSTEP 132
#define KPOS 8448
#define EPSF 1e-6f
#define GLA_Q 0
#define GLA_K 256
#define GLA_V 512
#define GLA_G 768
#define GLA_RF 1024
#define GLA_RB 1040
#define ML_Q 1056
#define ML_K 1312
#define ML_V 1568
#define ML_O 1824
#define ML_GF 2080
#define ML_GB 2088
#define GD_Q 2096
#define GD_K 2352
#define GD_V 2608
#define GD_OG 2864
#define GD_GF 3120
#define GD_GB 3128
#define DF_Q 3136
#define DF_K 3392
#define DF_V 3648

DEV int tidx() { int t = threadIdx.x; asm volatile("" : "+v"(t)); __builtin_assume(t >= 0 && t < NTHR); return t; }
DEV int launder_s(int v) { asm volatile("" : "+s"(v)); return v; }
typedef __bf16 bf2_t __attribute__((ext_vector_type(2)));
typedef float f2_t __attribute__((ext_vector_type(2)));
DEV unsigned pack2(float a, float b) { f2_t v; v.x = a; v.y = b; return __builtin_bit_cast(unsigned, __builtin_convertvector(v, bf2_t)); }
DEV u16 f2bf(float f) { return (u16)(pack2(f, 0.f) & 0xffffu); }
DEV float bf2f(u16 h) { return __uint_as_float(((unsigned)h) << 16); }
DEV float sigm(float x) { return 1.f / (1.f + __expf(-x)); }
DEV float silu(float x) { return x / (1.f + __expf(-x)); }
DEV float logsig(float x) { return fminf(x, 0.f) - __logf(1.f + __expf(-fabsf(x))); }
DEV float softplus(float x) { return fmaxf(x, 0.f) + __logf(1.f + __expf(-fabsf(x))); }
DEV float shx(float v, int o) { return __shfl_xor(v, o, 64); }
DEV float shidx(float v, int src) { return __int_as_float(__builtin_amdgcn_ds_bpermute(src << 2, __float_as_int(v))); }
DEV float shup(float v, int o) { const int l = tidx() & 63; return __int_as_float(__builtin_amdgcn_ds_bpermute((l >= o ? l - o : l) << 2, __float_as_int(v))); }
DEV float wsum(float v) {
    const int l4 = (tidx() & 63) << 2;
#pragma unroll
    for (int o = 32; o; o >>= 1) v += __int_as_float(__builtin_amdgcn_ds_bpermute(l4 ^ (o << 2), __float_as_int(v)));
    return v;
}
DEV float wmaxr(float v) {
    const int l4 = (tidx() & 63) << 2;
#pragma unroll
    for (int o = 32; o; o >>= 1) v = fmaxf(v, __int_as_float(__builtin_amdgcn_ds_bpermute(l4 ^ (o << 2), __float_as_int(v))));
    return v;
}
DEV f32x4 mfma16(bf16x8 a, bf16x8 b, f32x4 c) { return __builtin_amdgcn_mfma_f32_16x16x32_bf16(a, b, c, 0, 0, 0); }

#ifdef PROBE_SEL
#define PRB_BEGIN(id) unsigned long long prb_t0_##id = ((id) == PROBE_SEL) ? wall_clock64() : 0ull
#define PRB_END(id) do { if ((id) == PROBE_SEL) { __syncthreads(); if (threadIdx.x == 0) { volatile __attribute__((address_space(3))) unsigned long long* a_ = (volatile __attribute__((address_space(3))) unsigned long long*)(size_t)(75776 + 8); *a_ = *a_ + (wall_clock64() - prb_t0_##id); } } } while (0)
#else
#define PRB_BEGIN(id) do { } while (0)
#define PRB_END(id) do { } while (0)
#endif
#define RAW_BARRIER() do { asm volatile("s_waitcnt lgkmcnt(0)" ::: "memory"); __builtin_amdgcn_s_barrier(); } while (0)
struct P {
    const float *x, *c, *ctx, *c_ctx, *w_mod, *b_mod, *norm_mix, *norm_ffn, *w_in, *gla_a2, *gla_ab, *mlstm_gate_b,
        *gdn_conv, *gdn_a_log, *gdn_dt_bias, *diff_lambda, *head_norm, *w_branch, *w_out, *router_w, *router_b,
        *w_gate, *w_up, *w_down, *norm_final;
    float* out;
    unsigned* bar;
    int* cnt;
    float* modp;
    float* mod;
    float* xctx;
    float* rope;
    u16* hbuf;
    u16* ybuf;
    u16* Wt;
    u16* dq;
    u16* dk;
    u16* dvT;
    float* glaDec;
    float* mlN;
    float* mlFE;
    float* mlAE;
    float* mlM;
    u16* glaS;
    u16* mlS;
    u16* gdM;
    u16* gdN;
    u16* gdQ;
    u16* gdO;
    u16* cols;
    u16* Wd;
};
#define MOE_WGU_OFF 0
#define MOE_WD_OFF (16u * 1024u * 1024u)
#define MOE_ACT_OFF (MOE_WD_OFF + 16u * 1024u * 512u)
#define MOE_LIST_OFF (MOE_ACT_OFF + 2u * RTOT * 512u)

DEV const float* xrow_in(const P& p, int l, int r) {
    if (l == 0) return r < RLAT ? p.x + (size_t)r * DM : p.ctx + (size_t)(r - RLAT) * DM;
    return r < RLAT ? p.out + (size_t)r * DM : p.xctx + (size_t)(r - RLAT) * DM;
}
DEV float* xrow_out(const P& p, int r) { return r < RLAT ? p.out + (size_t)r * DM : p.xctx + (size_t)(r - RLAT) * DM; }
DEV int modidx(int r) { return r < RLAT ? (r >> 13) : 2; }
DEV int chunk_row0(int b, int dir, int st) {
    if (st < 4) { int c = dir ? 3 - st : st; return RLAT + b * CTXL + c * 64; }
    int c = dir ? 131 - st : st - 4; return b * SEQ + c * 64;
}
DEV size_t state_idx(int dir, int b, int st, int h) { return ((size_t)((dir * 2 + b) * NSTEP + st) * 4 + h); }
#define XB_TMO      128
#define XB_XCNT(j)  (256  + 64 * (j))
#define XB_XSUB(j)  (1280 + 64 * (j))
#define XB_XGEN(j)  (2304 + 64 * (j))
#define XB_TOP      3328
#define XB_TOPGEN   3392
#define XCD_BAR_WORDS 3456
#define XB_SPIN_CAP (1u << 18)
#define LAS __attribute__((address_space(3)))

__device__ __forceinline__ unsigned xb_ld(unsigned* p)              { return __hip_atomic_load(p, __ATOMIC_RELAXED, __HIP_MEMORY_SCOPE_AGENT); }
__device__ __forceinline__ unsigned xb_add(unsigned* p, unsigned v) { return __hip_atomic_fetch_add(p, v, __ATOMIC_RELAXED, __HIP_MEMORY_SCOPE_AGENT); }
__device__ __forceinline__ unsigned xb_xcc_id() { return (unsigned)__builtin_amdgcn_s_getreg((3 << 11) | 20) & 0xFu; }
#define XB_SPIN(cond, bar) do { unsigned _sp = 0; while (cond) { __builtin_amdgcn_s_sleep(1); \
    if ((++_sp & 255u) == 0u) { if (xb_ld(&(bar)[XB_TMO])) break; if (_sp > XB_SPIN_CAP) { atomicAdd(&(bar)[XB_TMO], 1u); break; } } } } while (0)

struct XcdBarrier {
    unsigned* bar; unsigned x;
    volatile LAS unsigned* st;
};

__device__ __forceinline__ XcdBarrier xcd_barrier_post(unsigned* bar, volatile LAS unsigned* st) {
    XcdBarrier b; b.bar = bar; b.x = xb_xcc_id(); b.st = st;
    if (tidx() == 0) (void)xb_add(&bar[XB_XCNT(b.x)], 1u);
    return b;
}
__device__ __forceinline__ void xcd_barrier_complete(unsigned* bar, unsigned x, unsigned& nloc, unsigned& nx) {
    const unsigned G = gridDim.x * gridDim.y * gridDim.z;
    unsigned sum, cnt, mine, sp = 0u;
    for (;;) {
        sum = 0u; cnt = 0u; mine = 0u;
#pragma unroll
        for (unsigned j = 0; j < 16; ++j) { const unsigned c = xb_ld(&bar[XB_XCNT(j)]); sum += c; cnt += (c > 0u) ? 1u : 0u; mine = (j == x) ? c : mine; }
        if (sum == G) break;
        __builtin_amdgcn_s_sleep(1);
        if ((++sp & 255u) == 0u) { if (xb_ld(&bar[XB_TMO])) break; if (sp > XB_SPIN_CAP) { atomicAdd(&bar[XB_TMO], 1u); break; } }
    }
    nloc = mine > 0u ? mine : 1u; nx = cnt > 0u ? cnt : 1u;
}

__device__ __forceinline__ void xcd_barrier(const XcdBarrier& b) {
    asm volatile("s_waitcnt vmcnt(0)" ::: "memory");
    __syncthreads();
    if (tidx() == 0) {
        unsigned* bar = b.bar;
        __builtin_amdgcn_s_waitcnt(0);
        unsigned nloc = b.st[0], nx = b.st[1];
        if (nloc == 0u) { xcd_barrier_complete(bar, b.x, nloc, nx); b.st[0] = nloc; b.st[1] = nx; }
        const unsigned old = xb_add(&bar[XB_XSUB(b.x)], 1u);
        const unsigned gen = old / nloc;
        if (old + 1u == (gen + 1u) * nloc) {
            __builtin_amdgcn_fence(__ATOMIC_RELEASE, "agent");
            asm volatile("s_waitcnt vmcnt(0)" ::: "memory");
            const unsigned og = xb_add(&bar[XB_TOP], 1u);
            const unsigned tg = og / nx;
            if (og + 1u == (tg + 1u) * nx) xb_add(&bar[XB_TOPGEN], 1u);
            else XB_SPIN(xb_ld(&bar[XB_TOPGEN]) == tg, bar);
            __builtin_amdgcn_fence(__ATOMIC_ACQUIRE, "agent");
            xb_add(&bar[XB_XGEN(b.x)], 1u);
            asm volatile("s_waitcnt vmcnt(0)" ::: "memory");
        } else {
            XB_SPIN(xb_ld(&bar[XB_XGEN(b.x)]) == gen, bar);
            __builtin_amdgcn_fence(__ATOMIC_ACQUIRE, "agent");
            asm volatile("s_waitcnt vmcnt(0)" ::: "memory");
        }
    }
    __syncthreads();
}
struct TrJob { const float* src; u16* dst; int lds_, ldd, map; };
DEV int tr_rowmap(int map, int n) {
    if (map == 1) return n < 3904 ? n : n + 64;
    if (map == 2) return (n >> 5) * 64 + (n & 31);
    if (map == 3) return (n >> 5) * 64 + 32 + (n & 31);
    return n;
}
struct TrRegs { f32x4 r0, r1, r2, r3; };
DEV void tr_load(const TrJob& j, TrRegs& q) {
    const int t = tidx(), n4 = (t & 15) * 4, kp = t >> 4;
    const float* s0 = j.src + (size_t)(2 * kp) * j.lds_ + n4;
    const float* s1 = j.src + (size_t)(2 * (kp + 16)) * j.lds_ + n4;
    q.r0 = *(const f32x4*)s0; q.r1 = *(const f32x4*)(s0 + j.lds_);
    q.r2 = *(const f32x4*)s1; q.r3 = *(const f32x4*)(s1 + j.lds_);
}
DEV void tr_finish(const TrJob& j, int n0, const TrRegs& q, float* smf) {
    unsigned* sm = (unsigned*)smf;
    const int t = tidx();
    {
        const int n4 = (t & 15) * 4, kp = t >> 4;
        sm[(n4 + 0) * 33 + kp] = pack2(q.r0[0], q.r1[0]); sm[(n4 + 1) * 33 + kp] = pack2(q.r0[1], q.r1[1]);
        sm[(n4 + 2) * 33 + kp] = pack2(q.r0[2], q.r1[2]); sm[(n4 + 3) * 33 + kp] = pack2(q.r0[3], q.r1[3]);
        sm[(n4 + 0) * 33 + kp + 16] = pack2(q.r2[0], q.r3[0]); sm[(n4 + 1) * 33 + kp + 16] = pack2(q.r2[1], q.r3[1]);
        sm[(n4 + 2) * 33 + kp + 16] = pack2(q.r2[2], q.r3[2]); sm[(n4 + 3) * 33 + kp + 16] = pack2(q.r2[3], q.r3[3]);
    }
    __syncthreads();
    {
        const int n = t >> 2, kq = (t & 3) * 8;
        u32x4 o0, o1;
        o0.x = sm[n * 33 + kq + 0]; o0.y = sm[n * 33 + kq + 1]; o0.z = sm[n * 33 + kq + 2]; o0.w = sm[n * 33 + kq + 3];
        o1.x = sm[n * 33 + kq + 4]; o1.y = sm[n * 33 + kq + 5]; o1.z = sm[n * 33 + kq + 6]; o1.w = sm[n * 33 + kq + 7];
        u16* d = j.dst + (size_t)tr_rowmap(j.map, n0 + n) * j.ldd + kq * 2;
        *(u32x4*)d = o0; *(u32x4*)(d + 8) = o1;
    }
    __syncthreads();
}
#define WT_WB_OFF (8064u * 1024u)
#define WT_WO_OFF (WT_WB_OFF + 4u * 1024u * 256u)
#define WT_TOTAL (WT_WO_OFF + 1024u * 1024u)

DEV TrJob mixw_job(const P& p, u16* Wb, int l, int u, int& n0) {
    TrJob j;
    if (u < 2000) {
        const int kt = u / 125, nt = u % 125; n0 = nt * 64;
        j.src = p.w_in + (size_t)l * 1024 * 8000 + (size_t)kt * 64 * 8000 + n0; j.lds_ = 8000; j.dst = Wb + kt * 64; j.ldd = 1024; j.map = 1;
    } else if (u < 2256) {
        const int v = u - 2000, i = v >> 6, w = v & 63, kt = w >> 4, nt = w & 15; n0 = nt * 64;
        j.src = p.w_branch + (size_t)(l * 4 + i) * 256 * 1024 + (size_t)kt * 64 * 1024 + n0; j.lds_ = 1024;
        j.dst = Wb + WT_WB_OFF + (size_t)i * 1024 * 256 + kt * 64; j.ldd = 256; j.map = 0;
    } else {
        const int v = u - 2256, kt = v >> 4, nt = v & 15; n0 = nt * 64;
        j.src = p.w_out + (size_t)l * 1024 * 1024 + (size_t)kt * 64 * 1024 + n0; j.lds_ = 1024; j.dst = Wb + WT_WO_OFF + kt * 64; j.ldd = 1024; j.map = 0;
    }
    return j;
}
DEV void phase_conv_mixw(const P& p, u16* Wb, int l, int bid, int nb, int b0, float* sm) {
    if (bid < b0) return;
    const int step = nb - b0;
    if (bid == nb - 1) {
        unsigned* z = (unsigned*)(Wb + (size_t)3904 * 1024);
        for (int i = tidx(); i < 64 * 1024 / 2; i += NTHR) z[i] = 0u;
    }
    int u = bid - b0, n0 = 0, n1 = 0;
    if (u >= 2512) return;
    TrRegs r;
    TrJob j = mixw_job(p, Wb, l, u, n0);
    tr_load(j, r);
    for (;;) {
        const int un = u + step;
        TrRegs rn; TrJob jn = j;
        if (un < 2512) { jn = mixw_job(p, Wb, l, un, n1); tr_load(jn, rn); }
        tr_finish(j, n0, r, sm);
        if (un >= 2512) break;
        u = un; j = jn; n0 = n1; r = rn;
    }
}
DEV TrJob moew_job(const P& p, int l, int u, int& n0) {
    TrJob j;
    u16* wgu = p.cols + MOE_WGU_OFF;
    const int e = u >> 8, v = u & 255;
    const size_t le = (size_t)(l * 16 + e);
    const int w = v & 127, kt = w >> 3, nt = w & 7; n0 = nt * 64;
    j.src = (v < 128 ? p.w_gate : p.w_up) + le * 1024 * 512 + (size_t)kt * 64 * 512 + n0; j.lds_ = 512;
    j.dst = wgu + (size_t)e * 1024 * 1024 + kt * 64; j.ldd = 1024; j.map = v < 128 ? 2 : 3;
    return j;
}
DEV TrJob moed_job(const P& p, int l, int u, int& n0) {
    TrJob j;
    const int e = u >> 7, w = u & 127, kt = w >> 4, nt = w & 15; n0 = nt * 64;
    const size_t le = (size_t)(l * 16 + e);
    j.src = p.w_down + le * 512 * 1024 + (size_t)kt * 64 * 1024 + n0; j.lds_ = 1024; j.dst = p.Wd + (size_t)e * 1024 * 512 + kt * 64; j.ldd = 512; j.map = 0;
    return j;
}
DEV void phase_conv_moed(const P& p, int l, int bid, int nb, int b0, float* sm) {
    if (bid < b0) return;
    const int step = nb - b0;
    int u = bid - b0, n0 = 0, n1 = 0;
    if (u >= 16 * 128) return;
    TrRegs r;
    TrJob j = moed_job(p, l, u, n0);
    tr_load(j, r);
    for (;;) {
        const int un = u + step;
        TrRegs rn; TrJob jn = j;
        if (un < 16 * 128) { jn = moed_job(p, l, un, n1); tr_load(jn, rn); }
        tr_finish(j, n0, r, sm);
        if (un >= 16 * 128) break;
        u = un; j = jn; n0 = n1; r = rn;
    }
}
DEV void phase_conv_moew(const P& p, int l, int bid, int nb, float* sm) {
    int u = bid, n0 = 0, n1 = 0;
    if (u >= 16 * 256) return;
    TrRegs r;
    TrJob j = moew_job(p, l, u, n0);
    tr_load(j, r);
    for (;;) {
        const int un = u + nb;
        TrRegs rn; TrJob jn = j;
        if (un < 16 * 256) { jn = moew_job(p, l, un, n1); tr_load(jn, rn); }
        tr_finish(j, n0, r, sm);
        if (un >= 16 * 256) break;
        u = un; j = jn; n0 = n1; r = rn;
    }
}

DEV void phase_mod_partial(const P& p, int bid, int nb, float* sm) {
    for (int u = bid; u < 768; u += nb) {
        const int l = u / 384, v = u % 384, kc = v / 24, jb = v % 24;
        const int t = tidx();
        __syncthreads();
        if (t < 192) {
            const int m = t >> 6, k = kc * 64 + (t & 63);
            const float cv = m < 2 ? p.c[m * 1024 + k] : p.c_ctx[k];
            sm[t] = silu(cv);
        }
        __syncthreads();
        const int j = jb * 256 + t;
        const float* w = p.w_mod + ((size_t)l * 1024 + kc * 64) * 6144 + j;
        float a0 = 0.f, a1 = 0.f, a2 = 0.f;
#pragma unroll 8
        for (int k = 0; k < 64; ++k) {
            const float wv = w[(size_t)k * 6144];
            a0 += sm[k] * wv; a1 += sm[64 + k] * wv; a2 += sm[128 + k] * wv;
        }
        float* o = p.modp + ((size_t)(l * 16 + kc) * 3) * 6144 + j;
        o[0] = a0; o[6144] = a1; o[2 * 6144] = a2;
    }
}
DEV void phase_mod_reduce(const P& p, int bid, int nb) {
    for (int i = bid * NTHR + tidx(); i < 2 * 3 * 6144; i += nb * NTHR) {
        const int l = i / (3 * 6144), r = i % (3 * 6144), m = r / 6144, j = r % 6144;
        float a = p.b_mod[l * 6144 + j];
        for (int kc = 0; kc < 16; ++kc) a += p.modp[((size_t)(l * 16 + kc) * 3 + m) * 6144 + j];
        p.mod[i] = a;
    }
}

DEV void moe_combine_row(const P& p, int l, int r, int lane, float4 (&v)[4]);
DEV void phase_norm1(const P& p, int l, int bid, int nb) {
    const int lane = tidx() & 63, w = tidx() >> 6;
    for (int r0 = (bid * 4 + w) * 2; r0 < RTOT; r0 += nb * 8) {
        f32x4 v[2][4];
#pragma unroll
        for (int q = 0; q < 2; ++q) {
            const float* xr = xrow_in(p, l, r0 + q);
#pragma unroll
            for (int i = 0; i < 4; ++i) v[q][i] = *(const f32x4*)(xr + lane * 4 + i * 256);
        }
#pragma unroll
        for (int q = 0; q < 2; ++q) {
            const int r = r0 + q;
            const int m = modidx(r);
            const float* sh = p.mod + ((size_t)(l * 3 + m)) * 6144;
            const float* sc = sh + 1024;
            float4 t[4];
#pragma unroll
            for (int i = 0; i < 4; ++i) { t[i].x = v[q][i][0]; t[i].y = v[q][i][1]; t[i].z = v[q][i][2]; t[i].w = v[q][i][3]; }
            if (l == 1) {
                moe_combine_row(p, 0, r, lane, t);
                float* xw = xrow_out(p, r);
#pragma unroll
                for (int i = 0; i < 4; ++i) *(float4*)(xw + lane * 4 + i * 256) = t[i];
            }
            float ss = 0.f;
#pragma unroll
            for (int i = 0; i < 4; ++i) ss += t[i].x * t[i].x + t[i].y * t[i].y + t[i].z * t[i].z + t[i].w * t[i].w;
            ss = wsum(ss);
            const float rs = rsqrtf(ss * (1.f / 1024.f) + EPSF);
#pragma unroll
            for (int i = 0; i < 4; ++i) {
                const int c = lane * 4 + i * 256;
                const float4 g = *(const float4*)(p.norm_mix + l * 1024 + c);
                const float4 s1 = *(const float4*)(sc + c);
                const float4 h1 = *(const float4*)(sh + c);
                const float o0 = t[i].x * rs * g.x * (1.f + s1.x) + h1.x;
                const float o1 = t[i].y * rs * g.y * (1.f + s1.y) + h1.y;
                const float o2 = t[i].z * rs * g.z * (1.f + s1.z) + h1.z;
                const float o3 = t[i].w * rs * g.w * (1.f + s1.w) + h1.w;
                u32x2 pk; pk.x = pack2(o0, o1); pk.y = pack2(o2, o3);
                *(u32x2*)(p.hbuf + (size_t)r * 1024 + c) = pk;
            }
        }
    }
}

#define LDP 72
#define GEMM_STAGE (2 * 128 * 64)
DEV int g_row(int tid, int i) { return (tid >> 6) * 32 + i * 8 + ((tid >> 3) & 7); }
DEV int g_kc(int tid, int row) { return ((tid & 7) ^ ((row >> 1) & 7)) * 8; }
DEV void gemm_mainloop(f32x4 (&acc)[4][4], const u16* const (&xp)[4], const u16* const (&wp)[4], int KT, u16* sm, u16*  ) {
    const int tid = tidx(), lane = tid & 63, w = tid >> 6, wn = w & 1, wm = w >> 1;
    const int fr = lane & 15, fq = lane >> 4, sw = (fr >> 1) & 7;
    asm volatile("s_waitcnt vmcnt(0)" ::: "memory");
#pragma unroll
    for (int i = 0; i < 4; ++i) {
        __builtin_amdgcn_global_load_lds((const unsigned*)xp[i], (unsigned*)(sm + (w * 4 + i) * 512), 16, 0, 0);
        __builtin_amdgcn_global_load_lds((const unsigned*)wp[i], (unsigned*)(sm + 128 * 64 + (w * 4 + i) * 512), 16, 0, 0);
    }
    for (int kt = 0; kt < KT; ++kt) {
        asm volatile("s_waitcnt vmcnt(0)" ::: "memory");
        RAW_BARRIER();
        if (kt + 1 < KT) {
            u16* nx = sm + ((kt + 1) & 1) * GEMM_STAGE;
#pragma unroll
            for (int i = 0; i < 4; ++i) {
                __builtin_amdgcn_global_load_lds((const unsigned*)(xp[i] + (kt + 1) * 64), (unsigned*)(nx + (w * 4 + i) * 512), 16, 0, 0);
                __builtin_amdgcn_global_load_lds((const unsigned*)(wp[i] + (kt + 1) * 64), (unsigned*)(nx + 128 * 64 + (w * 4 + i) * 512), 16, 0, 0);
            }
        }
        const u16* sX = sm + (kt & 1) * GEMM_STAGE;
        const u16* sW = sX + 128 * 64;
#pragma unroll
        for (int ks = 0; ks < 2; ++ks) {
            bf16x8 a[4], b[4];
#pragma unroll
            for (int q = 0; q < 4; ++q) {
                a[q] = *(const bf16x8*)(sW + (wn * 64 + q * 16 + fr) * 64 + (((ks * 4 + fq) ^ sw) * 8));
                b[q] = *(const bf16x8*)(sX + (wm * 64 + q * 16 + fr) * 64 + (((ks * 4 + fq) ^ sw) * 8));
            }
#pragma unroll
            for (int nt = 0; nt < 4; ++nt)
#pragma unroll
                for (int mt = 0; mt < 4; ++mt) acc[nt][mt] = mfma16(a[nt], b[mt], acc[nt][mt]);
        }
    }
    RAW_BARRIER();
}
DEV void zero_acc(f32x4 (&acc)[4][4]) {
#pragma unroll
    for (int a = 0; a < 4; ++a)
#pragma unroll
        for (int b = 0; b < 4; ++b) acc[a][b] = f32x4{0.f, 0.f, 0.f, 0.f};
}

#define GB_STAGE (384 * 32)
DEV void gemmb_issue(const u16* const (&xp)[4], const u16* const (&wp)[2], int kt, u16* stg, int w) {
#pragma unroll
    for (int i = 0; i < 4; ++i) __builtin_amdgcn_global_load_lds((const unsigned*)(xp[i] + kt * 32), (unsigned*)(stg + (w * 4 + i) * 512), 16, 0, 0);
#pragma unroll
    for (int i = 0; i < 2; ++i) __builtin_amdgcn_global_load_lds((const unsigned*)(wp[i] + kt * 32), (unsigned*)(stg + 256 * 32 + (w * 2 + i) * 512), 16, 0, 0);
}
DEV void gemmB_lane(int i, int nrow_pieces_per_wave, int& row, int& chunk) {
    const int t = tidx(), l = t & 63, w = t >> 6;
    row = (w * nrow_pieces_per_wave + i) * 16 + (l >> 2);
    chunk = ((l & 3) ^ ((l >> 4) & 3)) * 8;
}
DEV void gemmB_mainloop(f32x4 (&acc)[4][8], const u16* xb, const unsigned (&xo)[4], const u16* wb, const unsigned (&wo)[2], int KT, u16* sm) {
    const int tid = tidx(), lane = tid & 63, w = tid >> 6, wn = w & 1, wm = w >> 1, fr = lane & 15, fq = lane >> 4;
    const int sw = (fr >> 2) & 3;
    const int aoff = (wn * 64 + fr) * 32 + ((fq ^ sw) * 8) + 256 * 32;
    const int boff = (wm * 128 + fr) * 32 + ((fq ^ sw) * 8);
#pragma unroll
    for (int a = 0; a < 4; ++a)
#pragma unroll
        for (int b = 0; b < 8; ++b) acc[a][b] = f32x4{0.f, 0.f, 0.f, 0.f};
    asm volatile("s_waitcnt vmcnt(0)" ::: "memory");
#pragma unroll
    for (int t0 = 0; t0 < 2; ++t0) {
#pragma unroll
        for (int i = 0; i < 4; ++i) __builtin_amdgcn_global_load_lds((const unsigned*)(xb + xo[i] + t0 * 32), (unsigned*)(sm + t0 * GB_STAGE + (w * 4 + i) * 512), 16, 0, 0);
#pragma unroll
        for (int i = 0; i < 2; ++i) __builtin_amdgcn_global_load_lds((const unsigned*)(wb + wo[i] + t0 * 32), (unsigned*)(sm + t0 * GB_STAGE + 256 * 32 + (w * 2 + i) * 512), 16, 0, 0);
    }
    asm volatile("s_waitcnt vmcnt(6)" ::: "memory");
    RAW_BARRIER();
    bf16x8 a[4], b[8];
#pragma unroll
    for (int q = 0; q < 4; ++q) a[q] = *(const bf16x8*)(sm + aoff + q * 512);
#pragma unroll
    for (int q = 0; q < 8; ++q) b[q] = *(const bf16x8*)(sm + boff + q * 512);
    for (int kt = 0; kt < KT; ++kt) {
        asm volatile("s_waitcnt vmcnt(0)" ::: "memory");
        RAW_BARRIER();
        const bool more = kt + 2 < KT, nxt = kt + 1 < KT;
        u16* nx = sm + ((kt + 2) % 3) * GB_STAGE;
        const u16* cur = sm + ((kt + 1) % 3) * GB_STAGE;
#pragma unroll
        for (int h = 0; h < 2; ++h) {
            if (more) {
                __builtin_amdgcn_global_load_lds((const unsigned*)(xb + (kt + 2) * 32 + xo[2 * h]), (unsigned*)(nx + (w * 4 + 2 * h) * 512), 16, 0, 0);
                __builtin_amdgcn_global_load_lds((const unsigned*)(xb + (kt + 2) * 32 + xo[2 * h + 1]), (unsigned*)(nx + (w * 4 + 2 * h + 1) * 512), 16, 0, 0);
                __builtin_amdgcn_global_load_lds((const unsigned*)(wb + (kt + 2) * 32 + wo[h]), (unsigned*)(nx + 256 * 32 + (w * 2 + h) * 512), 16, 0, 0);
            }
#pragma unroll
            for (int nt = 0; nt < 4; ++nt) {
#pragma unroll
                for (int mt = 0; mt < 4; ++mt) acc[nt][4 * h + mt] = mfma16(a[nt], b[4 * h + mt], acc[nt][4 * h + mt]);
                if (h == 1 && nxt) a[nt] = *(const bf16x8*)(cur + aoff + nt * 512);
            }
            __builtin_amdgcn_sched_barrier(0);
            if (nxt) {
#pragma unroll
                for (int mt = 0; mt < 4; ++mt) b[4 * h + mt] = *(const bf16x8*)(cur + boff + (4 * h + mt) * 512);
            }
        }
    }
    RAW_BARRIER();
}

template <bool SIG, int GMODE = 0>
DEV void phase_inproj(const P& p, int wrow0, int ntn, int ldc, int mtiles256, int bid, int nb, u16* sm) {
    for (int u = bid; u < mtiles256 * ntn; u += nb) {
        const int mt_ = u / ntn, nt_ = u % ntn;
        const int m0 = mt_ * 256, n0 = nt_ * 128;
        unsigned xo[4], wo[2];
#pragma unroll
        for (int i = 0; i < 4; ++i) { int row, ch; gemmB_lane(i, 4, row, ch); xo[i] = (unsigned)(row * 1024 + ch); }
#pragma unroll
        for (int i = 0; i < 2; ++i) { int row, ch; gemmB_lane(i, 2, row, ch); wo[i] = (unsigned)(row * 1024 + ch); }
        f32x4 acc[4][8];
        gemmB_mainloop(acc, p.hbuf + (size_t)m0 * 1024, xo, p.Wt + (size_t)(wrow0 + n0) * 1024, wo, 32, sm);
        const int t2 = tidx(), l2 = t2 & 63, w2 = t2 >> 6;
        const int en = n0 + (w2 & 1) * 64 + (l2 >> 4) * 4, em = m0 + (w2 >> 1) * 128 + (l2 & 15);
#pragma unroll
        for (int nt = 0; nt < 4; ++nt)
#pragma unroll
            for (int mt = 0; mt < 8; ++mt) {
                const int n = en + nt * 16, m = em + mt * 16;
                f32x4 v = acc[nt][mt];
                if (SIG) { v[0] = sigm(v[0]); v[1] = sigm(v[1]); v[2] = sigm(v[2]); v[3] = sigm(v[3]); }
                u32x2 pk; pk.x = pack2(v[0], v[1]); pk.y = pack2(v[2], v[3]);
                *(u32x2*)(p.cols + (size_t)m * ldc + n) = pk;
            }
    }
}

DEV void phase_merge1(const P& p, u16* ubuf, int mtiles, int bid, int nb, u16* sm) {
    for (int u = bid; u < mtiles * 8; u += nb) {
        const int tid = tidx(), lane = tid & 63, w = tid >> 6, wn = w & 1, wm = w >> 1, fr = lane & 15, fq = lane >> 4, sw = (fr >> 1) & 7;
        const int mt_ = u >> 3, nt_ = u & 7;
        const int m0 = mt_ * 128, n0 = nt_ * 128;
        const u16* xp[4]; const u16* wp[4];
#pragma unroll
        for (int i = 0; i < 4; ++i) {
            const int row = g_row(tid, i), kc = g_kc(tid, row);
            xp[i] = p.ybuf + (size_t)(m0 + row) * 1024 + kc;
            wp[i] = p.Wt + WT_WB_OFF + (size_t)(n0 + row) * 256 + kc;
        }
        const u16* gbase = p.cols + (size_t)(m0 + wm * 64 + fr) * NGATE + n0 + wn * 64 + fq * 4;
        f32x4 tot[4][4], acc[4][4]; zero_acc(tot); zero_acc(acc);
        u32x2 gt[4][4];
        asm volatile("s_waitcnt vmcnt(0)" ::: "memory");
#pragma unroll
        for (int i = 0; i < 4; ++i) {
            __builtin_amdgcn_global_load_lds((const unsigned*)xp[i], (unsigned*)(sm + (w * 4 + i) * 512), 16, 0, 0);
            __builtin_amdgcn_global_load_lds((const unsigned*)wp[i], (unsigned*)(sm + 128 * 64 + (w * 4 + i) * 512), 16, 0, 0);
        }
        for (int kt = 0; kt < 16; ++kt) {
            asm volatile("s_waitcnt vmcnt(0)" ::: "memory");
            RAW_BARRIER();
            if (kt + 1 < 16) {
                u16* nx = sm + ((kt + 1) & 1) * GEMM_STAGE;
                const int wof = ((kt + 1) >> 2) * 262144 + ((kt + 1) & 3) * 64;
#pragma unroll
                for (int i = 0; i < 4; ++i) {
                    __builtin_amdgcn_global_load_lds((const unsigned*)(xp[i] + (kt + 1) * 64), (unsigned*)(nx + (w * 4 + i) * 512), 16, 0, 0);
                    __builtin_amdgcn_global_load_lds((const unsigned*)(wp[i] + wof), (unsigned*)(nx + 128 * 64 + (w * 4 + i) * 512), 16, 0, 0);
                }
            }
            if ((kt & 3) == 0) {
                const int br = kt >> 2;
#pragma unroll
                for (int nt = 0; nt < 4; ++nt)
#pragma unroll
                    for (int mt = 0; mt < 4; ++mt) gt[nt][mt] = *(const u32x2*)(gbase + (size_t)mt * 16 * NGATE + nt * 16 + br * 1024);
            }
            const u16* sX = sm + (kt & 1) * GEMM_STAGE;
            const u16* sW = sX + 128 * 64;
#pragma unroll
            for (int ks = 0; ks < 2; ++ks) {
                bf16x8 a[4], b[4];
#pragma unroll
                for (int q = 0; q < 4; ++q) {
                    a[q] = *(const bf16x8*)(sW + (wn * 64 + q * 16 + fr) * 64 + (((ks * 4 + fq) ^ sw) * 8));
                    b[q] = *(const bf16x8*)(sX + (wm * 64 + q * 16 + fr) * 64 + (((ks * 4 + fq) ^ sw) * 8));
                }
#pragma unroll
                for (int nt = 0; nt < 4; ++nt)
#pragma unroll
                    for (int mt = 0; mt < 4; ++mt) acc[nt][mt] = mfma16(a[nt], b[mt], acc[nt][mt]);
            }
            if ((kt & 3) == 3) {
#pragma unroll
                for (int nt = 0; nt < 4; ++nt)
#pragma unroll
                    for (int mt = 0; mt < 4; ++mt) {
                        const u32x2 g = gt[nt][mt];
                        tot[nt][mt][0] += __uint_as_float(g.x << 16) * acc[nt][mt][0];
                        tot[nt][mt][1] += __uint_as_float(g.x & 0xffff0000u) * acc[nt][mt][1];
                        tot[nt][mt][2] += __uint_as_float(g.y << 16) * acc[nt][mt][2];
                        tot[nt][mt][3] += __uint_as_float(g.y & 0xffff0000u) * acc[nt][mt][3];
                        acc[nt][mt] = f32x4{0.f, 0.f, 0.f, 0.f};
                    }
            }
        }
        RAW_BARRIER();
#pragma unroll
        for (int nt = 0; nt < 4; ++nt)
#pragma unroll
            for (int mt = 0; mt < 4; ++mt) {
                const int n = n0 + wn * 64 + nt * 16 + fq * 4, m = m0 + wm * 64 + mt * 16 + fr;
                u32x2 pk; pk.x = pack2(tot[nt][mt][0], tot[nt][mt][1]); pk.y = pack2(tot[nt][mt][2], tot[nt][mt][3]);
                *(u32x2*)(ubuf + (size_t)m * 1024 + n) = pk;
            }
    }
}

DEV void phase_merge2(const P& p, int l, const u16* ubuf, int mtiles, int bid, int nb, u16* sm) {
    const int mt256 = mtiles / 2;
    for (int u = bid; u < mt256 * 8; u += nb) {
        const int mt_ = u >> 3, nt_ = u & 7;
        const int m0 = mt_ * 256, n0 = nt_ * 128;
        unsigned xo[4], wo[2];
#pragma unroll
        for (int i = 0; i < 4; ++i) { int row, ch; gemmB_lane(i, 4, row, ch); xo[i] = (unsigned)(row * 1024 + ch); }
#pragma unroll
        for (int i = 0; i < 2; ++i) { int row, ch; gemmB_lane(i, 2, row, ch); wo[i] = (unsigned)(row * 1024 + ch); }
        f32x4 acc[4][8];
        gemmB_mainloop(acc, ubuf + (size_t)m0 * 1024, xo, p.Wt + WT_WO_OFF + (size_t)n0 * 1024, wo, 32, sm);
        const int t2 = tidx(), l2 = t2 & 63, w2 = t2 >> 6;
        const int en = n0 + (w2 & 1) * 64 + (l2 >> 4) * 4, em = m0 + (w2 >> 1) * 128 + (l2 & 15);
#pragma unroll
        for (int mt = 0; mt < 8; ++mt) {
            const int m = em + mt * 16;
            const float* xi = xrow_in(p, l, m);
            float* xw = xrow_out(p, m);
            const float* g1 = p.mod + (size_t)(l * 3 + modidx(m)) * 6144 + 2048;
#pragma unroll
            for (int nt = 0; nt < 4; ++nt) {
                const int n = en + nt * 16;
                const float4 xo4 = *(const float4*)(xi + n);
                const float4 g = *(const float4*)(g1 + n);
                float4 o;
                o.x = xo4.x + g.x * acc[nt][mt][0]; o.y = xo4.y + g.y * acc[nt][mt][1];
                o.z = xo4.z + g.z * acc[nt][mt][2]; o.w = xo4.w + g.w * acc[nt][mt][3];
                *(float4*)(xw + n) = o;
            }
        }
    }
}

DEV void phase_merge2s(const P& p, int l, const u16* ubuf, int mtiles, int bid, int nb, u16* sm) {
    u16* sX = sm; u16* sW = sm + 128 * LDP;
    const int tid = tidx(), lane = tid & 63, w = tid >> 6, wn = w & 1, wm = w >> 1, fr = lane & 15, fq = lane >> 4;
    for (int u = bid; u < mtiles * 8; u += nb) {
        const int mt_ = u >> 3, nt_ = u & 7;
        const int m0 = mt_ * 128, n0 = nt_ * 128;
        const int tu = tidx();
        const u16* xp[4]; const u16* wp[4];
#pragma unroll
        for (int i = 0; i < 4; ++i) {
            const int row = g_row(tu, i), kc = g_kc(tu, row);
            xp[i] = ubuf + (size_t)(m0 + row) * 1024 + kc;
            wp[i] = p.Wt + WT_WO_OFF + (size_t)(n0 + row) * 1024 + kc;
        }
        f32x4 acc[4][4]; zero_acc(acc);
        gemm_mainloop(acc, xp, wp, 16, sX, sW);
#pragma unroll
        for (int nt = 0; nt < 4; ++nt)
#pragma unroll
            for (int mt = 0; mt < 4; ++mt) {
                const int n = n0 + wn * 64 + nt * 16 + fq * 4, m = m0 + wm * 64 + mt * 16 + fr;
                const float4 xo = *(const float4*)(xrow_in(p, l, m) + n);
                const float4 g = *(const float4*)(p.mod + (size_t)(l * 3 + modidx(m)) * 6144 + 2048 + n);
                float4 o;
                o.x = xo.x + g.x * acc[nt][mt][0]; o.y = xo.y + g.y * acc[nt][mt][1];
                o.z = xo.z + g.z * acc[nt][mt][2]; o.w = xo.w + g.w * acc[nt][mt][3];
                *(float4*)(xrow_out(p, m) + n) = o;
            }
    }
}
DEV void phase_norm2_router(const P& p, int l, int nrows, int bid, int nb, float* sm) {
    const int tid = tidx(), lane = tid & 63, w = tid >> 6;
    int* list = (int*)(p.cols + MOE_LIST_OFF);
    float* slotw = (float*)(list + 16 * RTOT);
    int* tokslot = (int*)(slotw + 16 * RTOT);
    float* tokw = (float*)(tokslot + 2 * RTOT);
    int* lcnt = (int*)(sm + 16 * 1024);
    int* rinfo = lcnt + 32;
    float* rwgt = (float*)(rinfo + 4 * 40 * 2);
#pragma unroll 16
    for (int i = tid; i < 16 * 1024; i += NTHR) { const int c = i >> 4, e = i & 15; sm[e * 1024 + c] = p.router_w[i]; }
    if (tid < 32) lcnt[tid] = 0;
    __syncthreads();
    int kk = 0;
    for (int r = bid * 4 + w; r < nrows; r += nb * 4, ++kk) {
        const float* xr = xrow_out(p, r);
        const int m = modidx(r);
        const float* sh = p.mod + ((size_t)(l * 3 + m)) * 6144 + 3072;
        const float* sc = sh + 1024;
        float4 v[4]; float ss = 0.f;
#pragma unroll
        for (int i = 0; i < 4; ++i) {
            v[i] = *(const float4*)(xr + lane * 4 + i * 256);
            ss += v[i].x * v[i].x + v[i].y * v[i].y + v[i].z * v[i].z + v[i].w * v[i].w;
        }
        ss = wsum(ss);
        const float rs = rsqrtf(ss * (1.f / 1024.f) + EPSF);
#pragma unroll
        for (int i = 0; i < 4; ++i) {
            const int c = lane * 4 + i * 256;
            const float4 g = *(const float4*)(p.norm_ffn + l * 1024 + c);
            const float4 s1 = *(const float4*)(sc + c);
            const float4 h1 = *(const float4*)(sh + c);
            v[i].x = v[i].x * rs * g.x * (1.f + s1.x) + h1.x;
            v[i].y = v[i].y * rs * g.y * (1.f + s1.y) + h1.y;
            v[i].z = v[i].z * rs * g.z * (1.f + s1.z) + h1.z;
            v[i].w = v[i].w * rs * g.w * (1.f + s1.w) + h1.w;
            u32x2 pk; pk.x = pack2(v[i].x, v[i].y); pk.y = pack2(v[i].z, v[i].w);
            *(u32x2*)(p.hbuf + (size_t)r * 1024 + c) = pk;
        }
        float sel[16], scr[16];
#pragma unroll
        for (int e = 0; e < 16; ++e) scr[e] = 0.f;
#pragma unroll
        for (int i = 0; i < 4; ++i) {
#pragma unroll
            for (int e = 0; e < 16; ++e) {
                const float4 rw = *(const float4*)(sm + e * 1024 + lane * 4 + i * 256);
                scr[e] += v[i].x * rw.x + v[i].y * rw.y + v[i].z * rw.z + v[i].w * rw.w;
            }
            __builtin_amdgcn_sched_barrier(0);
        }
        {
            float t8[8], t4[4], t2[2];
            const bool b5 = lane & 32, b4 = lane & 16, b3 = lane & 8, b2 = lane & 4;
#pragma unroll
            for (int i = 0; i < 8; ++i) t8[i] = (b5 ? scr[i + 8] : scr[i]) + shx(b5 ? scr[i] : scr[i + 8], 32);
#pragma unroll
            for (int i = 0; i < 4; ++i) t4[i] = (b4 ? t8[i + 4] : t8[i]) + shx(b4 ? t8[i] : t8[i + 4], 16);
#pragma unroll
            for (int i = 0; i < 2; ++i) t2[i] = (b3 ? t4[i + 2] : t4[i]) + shx(b3 ? t4[i] : t4[i + 2], 8);
            float v1 = (b2 ? t2[1] : t2[0]) + shx(b2 ? t2[0] : t2[1], 4);
            v1 += shx(v1, 1); v1 += shx(v1, 2);
#pragma unroll
            for (int e = 0; e < 16; ++e) {
                const float a = __int_as_float(__builtin_amdgcn_readlane(__float_as_int(v1), 4 * e));
                scr[e] = sigm(a);
                sel[e] = scr[e] + p.router_b[e];
            }
        }
        int bg = 0; float bgs = -INFINITY;
#pragma unroll
        for (int g = 0; g < 4; ++g) {
            float m1 = -INFINITY, m2 = -INFINITY;
#pragma unroll
            for (int j = 0; j < 4; ++j) {
                const float s = sel[g * 4 + j];
                if (s > m1) { m2 = m1; m1 = s; } else if (s > m2) { m2 = s; }
            }
            const float gs = m1 + m2;
            if (gs > bgs) { bgs = gs; bg = g; }
        }
        float gsel[4], gscr[4];
#pragma unroll
        for (int j = 0; j < 4; ++j) { gsel[j] = -INFINITY; gscr[j] = 0.f; }
#pragma unroll
        for (int g = 0; g < 4; ++g)
#pragma unroll
            for (int j = 0; j < 4; ++j) if (bg == g) { gsel[j] = sel[g * 4 + j]; gscr[j] = scr[g * 4 + j]; }
        int j1 = 0; float v1 = gsel[0], w1 = gscr[0];
#pragma unroll
        for (int j = 1; j < 4; ++j) if (gsel[j] > v1) { v1 = gsel[j]; w1 = gscr[j]; j1 = j; }
        int j2 = -1; float v2 = -INFINITY, w2 = 0.f;
#pragma unroll
        for (int j = 0; j < 4; ++j) if (j != j1 && (j2 < 0 || gsel[j] > v2)) { v2 = gsel[j]; w2 = gscr[j]; j2 = j; }
        const float inv = 1.f / (w1 + w2);
        if (lane == 0) {
            const int e1 = bg * 4 + j1, e2 = bg * 4 + j2;
            const int p1 = atomicAdd(lcnt + e1, 1);
            const int p2 = atomicAdd(lcnt + e2, 1);
            rinfo[(w * 40 + kk) * 2 + 0] = e1 * 65536 + p1; rwgt[(w * 40 + kk) * 2 + 0] = w1 * inv;
            rinfo[(w * 40 + kk) * 2 + 1] = e2 * 65536 + p2; rwgt[(w * 40 + kk) * 2 + 1] = w2 * inv;
        }
    }
    __syncthreads();
    if (tid < 16) lcnt[16 + tid] = lcnt[tid] ? atomicAdd(p.cnt + l * 16 + tid, lcnt[tid]) : 0;
    __syncthreads();
    if (lane < 2) {
        int k2 = 0;
        for (int r = bid * 4 + w; r < nrows; r += nb * 4, ++k2) {
            const int inf = rinfo[(w * 40 + k2) * 2 + lane], e = inf >> 16, slot = lcnt[16 + e] + (inf & 65535);
            const float wg = rwgt[(w * 40 + k2) * 2 + lane];
            list[e * RTOT + slot] = r; slotw[e * RTOT + slot] = wg;
            tokslot[r * 2 + lane] = e * RTOT + slot; tokw[r * 2 + lane] = wg;
        }
    }
    __syncthreads();
}

DEV bool moe_find(const int* cnt, int ut, int& e, int& mt, int& off, int& ce) {
    int tb = 0, o = 0;
    for (int k = 0; k < 16; ++k) {
        const int c = cnt[k], nt = (c + 255) >> 8;
        if (ut < tb + nt) { e = k; mt = ut - tb; off = o; ce = c; return true; }
        tb += nt; o += c;
    }
    return false;
}

DEV bool moe_find128(const int* cnt, int ut, int& e, int& mt, int& off, int& ce) {
    int tb = 0, o = 0;
    for (int k = 0; k < 16; ++k) {
        const int c = cnt[k], nt = (c + 127) >> 7;
        if (ut < tb + nt) { e = k; mt = ut - tb; off = o; ce = c; return true; }
        tb += nt; o += c;
    }
    return false;
}

DEV void phase_moe_up_s(const P& p, int l, int bid, int nb, u16* sm) {
    u16* sX = sm; u16* sW = sm + 128 * LDP;
    const int tid = tidx(), lane = tid & 63, w = tid >> 6, wn = w & 1, wm = w >> 1, fr = lane & 15, fq = lane >> 4;
    const int* cnt = p.cnt + l * 16;
    const int* list = (const int*)(p.cols + MOE_LIST_OFF);
    const u16* wgu = p.cols + MOE_WGU_OFF;
    u16* act = p.cols + MOE_ACT_OFF;
    for (int u = bid;; u += nb) {
        int e, mtile, off, ce;
        if (!moe_find128(cnt, u >> 3, e, mtile, off, ce)) break;
        const int n0 = (u & 7) * 128;
        const int tu = tidx();
        const u16* xp[4]; const u16* wp[4];
#pragma unroll
        for (int i = 0; i < 4; ++i) {
            const int row = g_row(tu, i), kc = g_kc(tu, row);
            int s = mtile * 128 + row; s = s < ce ? s : ce - 1;
            const int tok = list[e * RTOT + s];
            xp[i] = p.hbuf + (size_t)tok * 1024 + kc;
            wp[i] = wgu + ((size_t)e * 1024 + n0 + row) * 1024 + kc;
        }
        f32x4 acc[4][4]; zero_acc(acc);
        gemm_mainloop(acc, xp, wp, 16, sX, sW);
#pragma unroll
        for (int nt = 0; nt < 2; ++nt)
#pragma unroll
            for (int mt = 0; mt < 4; ++mt) {
                const int col = ((n0 >> 6) + wn) * 32 + nt * 16 + fq * 4;
                const int s = mtile * 128 + wm * 64 + mt * 16 + fr;
                if (s < ce) {
                    const f32x4 g = acc[nt][mt], uu = acc[nt + 2][mt];
                    u32x2 pk; pk.x = pack2(silu(g[0]) * uu[0], silu(g[1]) * uu[1]); pk.y = pack2(silu(g[2]) * uu[2], silu(g[3]) * uu[3]);
                    *(u32x2*)(act + (size_t)(off + s) * 512 + col) = pk;
                }
            }
    }
}

DEV void phase_moe_down_s(const P& p, int l, int bid, int nb, u16* sm) {
    u16* sX = sm; u16* sW = sm + 128 * LDP;
    const int tid = tidx(), lane = tid & 63, w = tid >> 6, wn = w & 1, wm = w >> 1, fr = lane & 15, fq = lane >> 4;
    const int* cnt = p.cnt + l * 16;
    const int* list = (const int*)(p.cols + MOE_LIST_OFF);
    u16* yslot = p.glaS;
    const u16* wd = p.Wd;
    const u16* act = p.cols + MOE_ACT_OFF;
    for (int u = bid;; u += nb) {
        int e, mtile, off, ce;
        if (!moe_find128(cnt, u >> 3, e, mtile, off, ce)) break;
        const int n0 = (u & 7) * 128;
        const int tu = tidx();
        const u16* xp[4]; const u16* wp[4];
#pragma unroll
        for (int i = 0; i < 4; ++i) {
            const int row = g_row(tu, i), kc = g_kc(tu, row);
            int s = mtile * 128 + row; s = s < ce ? s : ce - 1;
            xp[i] = act + (size_t)(off + s) * 512 + kc;
            wp[i] = wd + ((size_t)e * 1024 + n0 + row) * 512 + kc;
        }
        f32x4 acc[4][4]; zero_acc(acc);
        gemm_mainloop(acc, xp, wp, 8, sX, sW);
#pragma unroll
        for (int mt = 0; mt < 4; ++mt) {
            const int s = mtile * 128 + wm * 64 + mt * 16 + fr;
            if (s < ce) {
#pragma unroll
                for (int nt = 0; nt < 4; ++nt) {
                    const int n = n0 + wn * 64 + nt * 16 + fq * 4;
                    u32x2 pk; pk.x = pack2(acc[nt][mt][0], acc[nt][mt][1]); pk.y = pack2(acc[nt][mt][2], acc[nt][mt][3]);
                    *(u32x2*)(yslot + (size_t)(off + s) * 1024 + n) = pk;
                }
            }
        }
    }
}

DEV void phase_moe_up(const P& p, int l, int bid, int nb, u16* sm) {
    const int* cnt = p.cnt + l * 16;
    const int* list = (const int*)(p.cols + MOE_LIST_OFF);
    const u16* wgu = p.cols + MOE_WGU_OFF;
    u16* act = p.cols + MOE_ACT_OFF;
    for (int u = bid;; u += nb) {
        int e, mtile, off, ce;
        if (!moe_find(cnt, u >> 3, e, mtile, off, ce)) break;
        const int n0 = (u & 7) * 128;
        unsigned xo[4], wo[2];
#pragma unroll
        for (int i = 0; i < 4; ++i) {
            int row, ch; gemmB_lane(i, 4, row, ch);
            int s = mtile * 256 + row; s = s < ce ? s : ce - 1;
            xo[i] = (unsigned)(list[e * RTOT + s] * 1024 + ch);
        }
#pragma unroll
        for (int i = 0; i < 2; ++i) { int row, ch; gemmB_lane(i, 2, row, ch); wo[i] = (unsigned)(row * 1024 + ch); }
        f32x4 acc[4][8];
        gemmB_mainloop(acc, p.hbuf, xo, wgu + ((size_t)e * 1024 + n0) * 1024, wo, 32, sm);
        const int t2 = tidx(), l2 = t2 & 63, w2 = t2 >> 6;
        const int col0 = ((n0 >> 6) + (w2 & 1)) * 32 + (l2 >> 4) * 4, sb = mtile * 256 + (w2 >> 1) * 128 + (l2 & 15);
#pragma unroll
        for (int nt = 0; nt < 2; ++nt)
#pragma unroll
            for (int mt = 0; mt < 8; ++mt) {
                const int s = sb + mt * 16;
                if (s < ce) {
                    const f32x4 g = acc[nt][mt], uu = acc[nt + 2][mt];
                    u32x2 pk; pk.x = pack2(silu(g[0]) * uu[0], silu(g[1]) * uu[1]); pk.y = pack2(silu(g[2]) * uu[2], silu(g[3]) * uu[3]);
                    *(u32x2*)(act + (size_t)(off + s) * 512 + col0 + nt * 16) = pk;
                }
            }
    }
}

DEV void phase_moe_down(const P& p, int l, int bid, int nb, u16* sm) {
    const int* cnt = p.cnt + l * 16;
    u16* yslot = p.glaS;
    const u16* wd = p.Wd;
    const u16* act = p.cols + MOE_ACT_OFF;
    for (int u = bid;; u += nb) {
        int e, mtile, off, ce;
        if (!moe_find(cnt, u >> 3, e, mtile, off, ce)) break;
        const int n0 = (u & 7) * 128;
        unsigned xo[4], wo[2];
#pragma unroll
        for (int i = 0; i < 4; ++i) {
            int row, ch; gemmB_lane(i, 4, row, ch);
            int s = mtile * 256 + row; s = s < ce ? s : ce - 1;
            xo[i] = (unsigned)((off + s) * 512 + ch);
        }
#pragma unroll
        for (int i = 0; i < 2; ++i) { int row, ch; gemmB_lane(i, 2, row, ch); wo[i] = (unsigned)(row * 512 + ch); }
        f32x4 acc[4][8];
        gemmB_mainloop(acc, act, xo, wd + ((size_t)e * 1024 + n0) * 512, wo, 16, sm);
        const int t2 = tidx(), l2 = t2 & 63, w2 = t2 >> 6;
        const int en = n0 + (w2 & 1) * 64 + (l2 >> 4) * 4, sb = mtile * 256 + (w2 >> 1) * 128 + (l2 & 15);
#pragma unroll
        for (int mt = 0; mt < 8; ++mt) {
            const int s = sb + mt * 16;
            if (s < ce) {
#pragma unroll
                for (int nt = 0; nt < 4; ++nt) {
                    u32x2 pk; pk.x = pack2(acc[nt][mt][0], acc[nt][mt][1]); pk.y = pack2(acc[nt][mt][2], acc[nt][mt][3]);
                    *(u32x2*)(yslot + (size_t)(off + s) * 1024 + en + nt * 16) = pk;
                }
            }
        }
    }
}

DEV void moe_combine_row(const P& p, int l, int r, int lane, float4 (&v)[4]) {
    const int* cnt = p.cnt + l * 16;
    const int* list = (const int*)(p.cols + MOE_LIST_OFF);
    const int* tokslot = (const int*)((const float*)(list + 16 * RTOT) + 16 * RTOT);
    const float* tokw = (const float*)(tokslot + 2 * RTOT);
    const u16* yslot = p.glaS;
    const float* g2 = p.mod + (size_t)(l * 3 + modidx(r)) * 6144 + 5120;
#pragma unroll
    for (int j = 0; j < 2; ++j) {
        const int ts = tokslot[r * 2 + j], e = ts / RTOT, slot = ts % RTOT;
        const float wg = tokw[r * 2 + j];
        int off = 0;
#pragma unroll
        for (int k = 0; k < 15; ++k) off += cnt[k] & -(int)(k < e);
        const u16* yr = yslot + (size_t)(off + slot) * 1024;
#pragma unroll
        for (int i = 0; i < 4; ++i) {
            const int c = lane * 4 + i * 256;
            const u32x2 yv = *(const u32x2*)(yr + c);
            const float4 g = *(const float4*)(g2 + c);
            v[i].x += g.x * wg * __uint_as_float(yv.x << 16); v[i].y += g.y * wg * __uint_as_float(yv.x & 0xffff0000u);
            v[i].z += g.z * wg * __uint_as_float(yv.y << 16); v[i].w += g.w * wg * __uint_as_float(yv.y & 0xffff0000u);
        }
    }
}

DEV void phase_final_norm(const P& p, int bid, int nb) {
    const int lane = tidx() & 63, w = tidx() >> 6;
    for (int r = bid * 4 + w; r < RLAT; r += nb * 4) {
        float* xr = p.out + (size_t)r * DM;
        float4 v[4]; float ss = 0.f;
#pragma unroll
        for (int i = 0; i < 4; ++i) v[i] = *(const float4*)(xr + lane * 4 + i * 256);
        moe_combine_row(p, 1, r, lane, v);
#pragma unroll
        for (int i = 0; i < 4; ++i) ss += v[i].x * v[i].x + v[i].y * v[i].y + v[i].z * v[i].z + v[i].w * v[i].w;
        ss = wsum(ss);
        const float rs = rsqrtf(ss * (1.f / 1024.f) + EPSF);
#pragma unroll
        for (int i = 0; i < 4; ++i) {
            const int c = lane * 4 + i * 256;
            const float4 g = *(const float4*)(p.norm_final + c);
            float4 o; o.x = v[i].x * rs * g.x; o.y = v[i].y * rs * g.y; o.z = v[i].z * rs * g.z; o.w = v[i].w * rs * g.w;
            *(float4*)(xr + c) = o;
        }
    }
}
DEV float wscan_add(float v, int lane) {
#pragma unroll
    for (int o = 1; o < 64; o <<= 1) { const float t = shup(v, o); if (lane >= o) v += t; }
    return v;
}
DEV float wscan_max(float v, int lane) {
#pragma unroll
    for (int o = 1; o < 64; o <<= 1) { const float t = shup(v, o); if (lane >= o) v = fmaxf(v, t); }
    return v;
}
DEV void mm64(f32x4 (&acc)[4], const u16* A, int lda, const u16* Bt, int ldb) {
    const int lane = tidx() & 63, w = tidx() >> 6, fr = lane & 15, fq = lane >> 4;
#pragma unroll
    for (int ks = 0; ks < 2; ++ks) {
        const bf16x8 a = *(const bf16x8*)(A + (16 * w + fr) * lda + ks * 32 + fq * 8);
#pragma unroll
        for (int nt = 0; nt < 4; ++nt) {
            const bf16x8 b = *(const bf16x8*)(Bt + (nt * 16 + fr) * ldb + ks * 32 + fq * 8);
            acc[nt] = mfma16(a, b, acc[nt]);
        }
    }
}
DEV void mm64_pre(f32x4 (&acc)[4], const u16* A, int lda, const bf16x8 (&bf)[2][4]) {
    const int lane = tidx() & 63, w = tidx() >> 6, fr = lane & 15, fq = lane >> 4;
#pragma unroll
    for (int ks = 0; ks < 2; ++ks) {
        const bf16x8 a = *(const bf16x8*)(A + (16 * w + fr) * lda + ks * 32 + fq * 8);
#pragma unroll
        for (int nt = 0; nt < 4; ++nt) acc[nt] = mfma16(a, bf[ks][nt], acc[nt]);
    }
}
DEV void ldB64(bf16x8 (&bf)[2][4], const u16* Bt) {
    const int lane = tidx() & 63, fr = lane & 15, fq = lane >> 4;
#pragma unroll
    for (int ks = 0; ks < 2; ++ks)
#pragma unroll
        for (int nt = 0; nt < 4; ++nt) bf[ks][nt] = *(const bf16x8*)(Bt + (nt * 16 + fr) * 64 + ks * 32 + fq * 8);
}
struct Raw16 { u32x4 a, b; };
DEV Raw16 ldraw16(const u16* p) { Raw16 r; r.a = *(const u32x4*)p; r.b = *(const u32x4*)(p + 8); return r; }
DEV void unraw16(const Raw16& r, float (&o)[16]) {
    const unsigned w[8] = {r.a.x, r.a.y, r.a.z, r.a.w, r.b.x, r.b.y, r.b.z, r.b.w};
#pragma unroll
    for (int i = 0; i < 8; ++i) { o[2 * i] = __uint_as_float(w[i] << 16); o[2 * i + 1] = __uint_as_float(w[i] & 0xffff0000u); }
}
DEV void zero4(f32x4 (&acc)[4]) {
#pragma unroll
    for (int i = 0; i < 4; ++i) acc[i] = f32x4{0.f, 0.f, 0.f, 0.f};
}
DEV void ld16bf(const u16* p, float (&o)[16]) {
    const u32x4 a = *(const u32x4*)p, b = *(const u32x4*)(p + 8);
    const unsigned w[8] = {a.x, a.y, a.z, a.w, b.x, b.y, b.z, b.w};
#pragma unroll
    for (int i = 0; i < 8; ++i) { o[2 * i] = __uint_as_float(w[i] << 16); o[2 * i + 1] = __uint_as_float(w[i] & 0xffff0000u); }
}
DEV void st16bf(u16* p, const float (&v)[16]) {
    u32x4 a, b;
    a.x = pack2(v[0], v[1]); a.y = pack2(v[2], v[3]); a.z = pack2(v[4], v[5]); a.w = pack2(v[6], v[7]);
    b.x = pack2(v[8], v[9]); b.y = pack2(v[10], v[11]); b.z = pack2(v[12], v[13]); b.w = pack2(v[14], v[15]);
    *(u32x4*)p = a; *(u32x4*)(p + 8) = b;
}

DEV void phase_rope_table(const P& p, int bid, int nb) {
    for (int i = bid * NTHR + tidx(); i < 192 * 8; i += nb * NTHR) {
        const int e = i >> 3, f = i & 7;
        const float inv = expf(-(float)(2 * f) * (1.f / 16.f) * 9.210340371976184f);
        const float pos = (float)(e < 128 ? e : e - 128);
        const float ang = pos * inv;
        p.rope[2 * i] = cosf(ang); p.rope[2 * i + 1] = sinf(ang);
    }
}
DEV void row_geom(int r, int& b, int& t, int& T, int& pos, bool& lat) {
    lat = r < RLAT;
    if (lat) { b = r >> 13; t = r & (SEQ - 1); T = SEQ; pos = CTXL + t; }
    else { const int q = r - RLAT; b = q >> 8; t = q & (CTXL - 1); T = CTXL; pos = t; }
}
DEV void phase_prep(const P& p, int l, u16* gqkv, int bid, int nb, u16* sm) {
    const int tid = tidx();
    for (int id = bid * NTHR + tid; id < RTOT * 96; id += nb * NTHR) {
        const int cg = id % 96, r = id / 96;
        int b, t, T, pos; bool lat; row_geom(r, b, t, T, pos, lat);
        float a[8];
#pragma unroll
        for (int i = 0; i < 8; ++i) a[i] = 0.f;
#pragma unroll
        for (int j = 0; j < 5; ++j) {
            const int tt = t + j - 2;
            const bool ok = tt >= 0 && tt < T;
            const u32x4 xv = *(const u32x4*)(p.cols + (size_t)(ok ? r + j - 2 : r) * NCM + GD_Q + cg * 8);
            const float m = ok ? 1.f : 0.f;
            const float4 w0 = *(const float4*)(p.gdn_conv + (l * 5 + j) * 768 + cg * 8);
            const float4 w1 = *(const float4*)(p.gdn_conv + (l * 5 + j) * 768 + cg * 8 + 4);
            a[0] += __uint_as_float(xv.x << 16) * (w0.x * m); a[1] += __uint_as_float(xv.x & 0xffff0000u) * (w0.y * m);
            a[2] += __uint_as_float(xv.y << 16) * (w0.z * m); a[3] += __uint_as_float(xv.y & 0xffff0000u) * (w0.w * m);
            a[4] += __uint_as_float(xv.z << 16) * (w1.x * m); a[5] += __uint_as_float(xv.z & 0xffff0000u) * (w1.y * m);
            a[6] += __uint_as_float(xv.w << 16) * (w1.z * m); a[7] += __uint_as_float(xv.w & 0xffff0000u) * (w1.w * m);
        }
        float ss = 0.f;
#pragma unroll
        for (int i = 0; i < 8; ++i) { a[i] = silu(a[i]); ss += a[i] * a[i]; }
        ss += shx(ss, 1); ss += shx(ss, 2); ss += shx(ss, 4);
        float sc = 1.f;
        if (cg < 64) sc = rsqrtf(ss + EPSF) * (cg < 32 ? 0.125f : 1.f);
        u32x4 o;
        o.x = pack2(a[0] * sc, a[1] * sc); o.y = pack2(a[2] * sc, a[3] * sc); o.z = pack2(a[4] * sc, a[5] * sc); o.w = pack2(a[6] * sc, a[7] * sc);
        *(u32x4*)(gqkv + (size_t)r * 768 + cg * 8) = o;
    }
    for (int id = bid * NTHR + tid; id < RTOT * 32; id += nb * NTHR) {
        const int c = id & 1, half = (id >> 1) & 1, h = (id >> 2) & 3, qk = (id >> 4) & 1, r = id >> 5;
        int b, t, T, pos; bool lat; row_geom(r, b, t, T, pos, lat);
        const u16* src = p.cols + (size_t)r * NCM + (qk ? DF_K : DF_Q) + h * 64 + half * 32 + c * 8;
        const u32x4 v1 = *(const u32x4*)src, v2 = *(const u32x4*)(src + 16);
        const unsigned w1[4] = {v1.x, v1.y, v1.z, v1.w}, w2[4] = {v2.x, v2.y, v2.z, v2.w};
        float x1[8], x2[8], o1[8], o2[8];
#pragma unroll
        for (int i = 0; i < 4; ++i) {
            x1[2 * i] = __uint_as_float(w1[i] << 16); x1[2 * i + 1] = __uint_as_float(w1[i] & 0xffff0000u);
            x2[2 * i] = __uint_as_float(w2[i] << 16); x2[2 * i + 1] = __uint_as_float(w2[i] & 0xffff0000u);
        }
        const float qs = qk ? 1.f : (0.17677669529663687f * 1.4426950408889634f);
        const float* tb = p.rope + (size_t)(lat ? (c == 0 ? (t >> 6) : 128 + (t & 63)) : 0) * 16;
#pragma unroll
        for (int i = 0; i < 8; ++i) {
            const float cs = tb[2 * i], sn = tb[2 * i + 1];
            o1[i] = (x1[i] * cs - x2[i] * sn) * qs; o2[i] = (x1[i] * sn + x2[i] * cs) * qs;
        }
        u16* dst = (qk ? p.dk : p.dq) + ((size_t)(b * 4 + h) * KPOS + pos) * 64 + half * 32 + c * 8;
        u32x4 a1, a2;
        a1.x = pack2(o1[0], o1[1]); a1.y = pack2(o1[2], o1[3]); a1.z = pack2(o1[4], o1[5]); a1.w = pack2(o1[6], o1[7]);
        a2.x = pack2(o2[0], o2[1]); a2.y = pack2(o2[2], o2[3]); a2.z = pack2(o2[4], o2[5]); a2.w = pack2(o2[6], o2[7]);
        *(u32x4*)dst = a1; *(u32x4*)(dst + 16) = a2;
    }
    for (int u = bid; u < 264 * 4; u += nb) {
        const int g = u >> 2, h = u & 3;
        int b, r0, pos0;
        if (g < 256) { b = g >> 7; const int t0 = (g & 127) * 64; r0 = b * SEQ + t0; pos0 = CTXL + t0; }
        else { const int q = g - 256; b = q >> 2; const int t0 = (q & 3) * 64; r0 = RLAT + b * CTXL + t0; pos0 = t0; }
        __syncthreads();
        {
            const int s = tid >> 2, dg = tid & 3;
            const u32x4 a = *(const u32x4*)(p.cols + (size_t)(r0 + s) * NCM + DF_V + h * 64 + dg * 16);
            const u32x4 c = *(const u32x4*)(p.cols + (size_t)(r0 + s) * NCM + DF_V + h * 64 + dg * 16 + 8);
            const unsigned wv[8] = {a.x, a.y, a.z, a.w, c.x, c.y, c.z, c.w};
#pragma unroll
            for (int k = 0; k < 8; ++k) {
                sm[(dg * 16 + 2 * k) * 72 + s] = (u16)(wv[k] & 0xffff);
                sm[(dg * 16 + 2 * k + 1) * 72 + s] = (u16)(wv[k] >> 16);
            }
        }
        __syncthreads();
        {
            const int dv = tid >> 2, sg = tid & 3;
            const u32x4 a = *(const u32x4*)(sm + dv * 72 + sg * 16);
            const u32x4 c = *(const u32x4*)(sm + dv * 72 + sg * 16 + 8);
            u16* o = p.dvT + ((size_t)(b * 4 + h) * 64 + dv) * KPOS + pos0 + sg * 16;
            *(u32x4*)o = a; *(u32x4*)(o + 8) = c;
        }
    }
    __syncthreads();
}
#define TILE_B (64 * LDP * 2)

DEV void gla_cum(const P& p, int l, int dir, int h, int row0, float* cum, float* rt, float* sg) {
    const int tid = tidx();
    const int d = tid & 63, sq = tid >> 6;
    float a2r[16];
#pragma unroll
    for (int j = 0; j < 16; ++j) a2r[j] = p.gla_a2[((size_t)(l * 2 + dir) * 16 + j) * 256 + h * 64 + d];
    const float ab = p.gla_ab[(l * 2 + dir) * 256 + h * 64 + d];
    {
        const int s = tid >> 2, q4 = tid & 3, row = row0 + (dir ? 63 - s : s);
        const u32x2 v = *(const u32x2*)(p.cols + (size_t)row * NCM + GLA_RF + dir * 16 + q4 * 4);
        rt[s * 17 + q4 * 4 + 0] = __uint_as_float(v.x << 16); rt[s * 17 + q4 * 4 + 1] = __uint_as_float(v.x & 0xffff0000u);
        rt[s * 17 + q4 * 4 + 2] = __uint_as_float(v.y << 16); rt[s * 17 + q4 * 4 + 3] = __uint_as_float(v.y & 0xffff0000u);
    }
    __syncthreads();
    float loc[16]; float run = 0.f;
#pragma unroll
    for (int i = 0; i < 16; ++i) {
        const int s = sq * 16 + i;
        float x = ab;
#pragma unroll
        for (int j = 0; j < 16; ++j) x += rt[s * 17 + j] * a2r[j];
        run += logsig(x) * (1.f / 16.f);
        loc[i] = run;
    }
    sg[sq * 64 + d] = run;
    __syncthreads();
    float off = 0.f;
    for (int k = 0; k < sq; ++k) off += sg[k * 64 + d];
#pragma unroll
    for (int i = 0; i < 16; ++i) cum[(sq * 16 + i) * 65 + d] = loc[i] + off;
    __syncthreads();
}

DEV void gla_phaseA(const P& p, int l, int dir, int b, int st, int h, unsigned char* smraw) {
    float* cum = (float*)smraw;
    float* rt = cum + 64 * 65;
    float* sg = rt + 64 * 17;
    u16* kwT = (u16*)(sg + 256);
    u16* vT = kwT + 64 * LDP;
    const int tid = tidx(), lane = tid & 63, w = tid >> 6, fr = lane & 15, fq = lane >> 4;
    const int row0 = chunk_row0(b, dir, st);
    const size_t idx = state_idx(dir, b, st, h);
    Raw16 kraw, vraw;
    {
        const int s = tid >> 2, dg = tid & 3, row = row0 + (dir ? 63 - s : s);
        kraw = ldraw16(p.cols + (size_t)row * NCM + GLA_K + h * 64 + dg * 16);
        vraw = ldraw16(p.cols + (size_t)row * NCM + GLA_V + h * 64 + dg * 16);
    }
    gla_cum(p, l, dir, h, row0, cum, rt, sg);
    {
        const int s = tid >> 2, dg = tid & 3;
        float kk[16], vv[16];
        unraw16(kraw, kk); unraw16(vraw, vv);
#pragma unroll
        for (int i = 0; i < 16; ++i) {
            const int d = dg * 16 + i;
            kwT[d * LDP + s] = f2bf(kk[i] * __expf(cum[63 * 65 + d] - cum[s * 65 + d]));
            vT[d * LDP + s] = f2bf(vv[i]);
        }
        if (tid < 64) p.glaDec[idx * 64 + tid] = __expf(cum[63 * 65 + tid]);
    }
    __syncthreads();
    f32x4 acc[4]; zero4(acc);
    mm64(acc, kwT, LDP, vT, LDP);
#pragma unroll
    for (int nt = 0; nt < 4; ++nt) {
        const int d = 16 * w + fq * 4, e = nt * 16 + fr;
        u32x2 pk; pk.x = pack2(acc[nt][0], acc[nt][1]); pk.y = pack2(acc[nt][2], acc[nt][3]);
        *(u32x2*)(p.glaS + idx * 4096 + e * 64 + d) = pk;
    }
    __syncthreads();
}

DEV void ml_phaseA(const P& p, int l, int dir, int b, int st, int h, unsigned char* smraw) {
    float* wend = (float*)smraw;
    u16* kwT = (u16*)(wend + 64);
    u16* vT = kwT + 64 * LDP;
    const int tid = tidx(), lane = tid & 63, w = tid >> 6, fr = lane & 15, fq = lane >> 4;
    const int row0 = chunk_row0(b, dir, st);
    const size_t idx = state_idx(dir, b, st, h);
    Raw16 kraw, vraw;
    {
        const int s = tid >> 2, dg = tid & 3, row = row0 + (dir ? 63 - s : s);
        kraw = ldraw16(p.cols + (size_t)row * NCM + ML_K + h * 64 + dg * 16);
        vraw = ldraw16(p.cols + (size_t)row * NCM + ML_V + h * 64 + dg * 16);
    }
    if (w == 0) {
        const int row = row0 + (dir ? 63 - lane : lane);
        const float ip = bf2f(p.cols[(size_t)row * NCM + ML_GF + dir * 8 + h]) + p.mlstm_gate_b[((l * 2 + dir) * 2 + 0) * 4 + h];
        const float lf = logsig(bf2f(p.cols[(size_t)row * NCM + ML_GF + dir * 8 + 4 + h]) + p.mlstm_gate_b[((l * 2 + dir) * 2 + 1) * 4 + h]);
        const float fc = wscan_add(lf, lane);
        const float fe = shidx(fc, 63);
        const float lw = fe - fc + ip;
        const float ae = wmaxr(lw);
        wend[lane] = __expf(lw - ae);
        if (lane == 0) { p.mlFE[idx] = fe; p.mlAE[idx] = ae; }
    }
    __syncthreads();
    {
        const int s = tid >> 2, dg = tid & 3;
        float kk[16], vv[16];
        unraw16(kraw, kk); unraw16(vraw, vv);
        const float ws = wend[s] * 0.125f;
#pragma unroll
        for (int i = 0; i < 16; ++i) {
            const int d = dg * 16 + i;
            kwT[d * LDP + s] = f2bf(kk[i] * ws);
            vT[d * LDP + s] = f2bf(vv[i]);
        }
    }
    __syncthreads();
    if (tid < 64) {
        float a = 0.f;
        for (int s = 0; s < 64; ++s) a += bf2f(kwT[tid * LDP + s]);
        p.mlN[idx * 64 + tid] = a;
    }
    f32x4 acc[4]; zero4(acc);
    mm64(acc, kwT, LDP, vT, LDP);
#pragma unroll
    for (int nt = 0; nt < 4; ++nt) {
        const int d = 16 * w + fq * 4, e = nt * 16 + fr;
        u32x2 pk; pk.x = pack2(acc[nt][0], acc[nt][1]); pk.y = pack2(acc[nt][2], acc[nt][3]);
        *(u32x2*)(p.mlS + idx * 4096 + e * 64 + d) = pk;
    }
    __syncthreads();
}

DEV void gd_phaseA(const P& p, int l, const u16* gqkv, int dir, int b, int st, int h, unsigned char* smraw) {
    float* X = (float*)smraw;
    float* cum = X + 64 * 65 + 32;
    float* beta = cum + 64;
    float* be = beta + 64;
    float* ke = be + 64;
    float* scal = ke + 64;
    u16* Y0 = (u16*)(scal + 64);
    u16* Y1 = Y0 + 64 * LDP;
    u16* Y2 = Y1 + 64 * LDP;
    u16* Y3 = Y2 + 64 * LDP;
    u16* Y4 = Y3 + 64 * LDP;
    u16* Y5 = Y4 + 64 * LDP;
    const int tid = tidx(), lane = tid & 63, w = tid >> 6, fr = lane & 15, fq = lane >> 4;
    const int row0 = chunk_row0(b, dir, st);
    const size_t idx = state_idx(dir, b, st, h);
    if (w == 0) {
        const int row = row0 + (dir ? 63 - lane : lane);
        const float bp = bf2f(p.cols[(size_t)row * NCM + GD_GF + dir * 8 + h]);
        const float ap = bf2f(p.cols[(size_t)row * NCM + GD_GF + dir * 8 + 4 + h]);
        const float bt = sigm(bp);
        const float g = -__expf(p.gdn_a_log[(l * 2 + dir) * 4 + h]) * softplus(ap + p.gdn_dt_bias[(l * 2 + dir) * 4 + h]);
        const float cm = wscan_add(g, lane);
        const float ce = shidx(cm, 63);
        cum[lane] = cm; beta[lane] = bt; be[lane] = bt * __expf(cm); ke[lane] = __expf(ce - cm);
        if (lane == 0) scal[0] = __expf(ce);
    }
    {
        const int s = tid >> 2, dg = tid & 3, row = row0 + (dir ? 63 - s : s);
        const u16* src = gqkv + (size_t)row * 768 + h * 64 + dg * 16;
        const u32x4 q0 = *(const u32x4*)src, q1 = *(const u32x4*)(src + 8);
        const u32x4 k0 = *(const u32x4*)(src + 256), k1 = *(const u32x4*)(src + 264);
        const u32x4 v0 = *(const u32x4*)(src + 512), v1 = *(const u32x4*)(src + 520);
        *(u32x4*)(Y0 + s * LDP + dg * 16) = q0; *(u32x4*)(Y0 + s * LDP + dg * 16 + 8) = q1;
        *(u32x4*)(Y1 + s * LDP + dg * 16) = k0; *(u32x4*)(Y1 + s * LDP + dg * 16 + 8) = k1;
        const unsigned kw[8] = {k0.x, k0.y, k0.z, k0.w, k1.x, k1.y, k1.z, k1.w};
        const unsigned vw[8] = {v0.x, v0.y, v0.z, v0.w, v1.x, v1.y, v1.z, v1.w};
#pragma unroll
        for (int i = 0; i < 8; ++i) {
            Y2[(dg * 16 + 2 * i) * LDP + s] = (u16)(kw[i] & 0xffff); Y2[(dg * 16 + 2 * i + 1) * LDP + s] = (u16)(kw[i] >> 16);
            Y3[(dg * 16 + 2 * i) * LDP + s] = (u16)(vw[i] & 0xffff); Y3[(dg * 16 + 2 * i + 1) * LDP + s] = (u16)(vw[i] >> 16);
        }
    }
    __syncthreads();
    u32x2 qpre[4];
#pragma unroll
    for (int nt = 0; nt < 4; ++nt) {
        const int c = nt * 16 + fr, row = row0 + (dir ? 63 - c : c);
        qpre[nt] = *(const u32x2*)(gqkv + (size_t)row * 768 + h * 64 + 16 * w + fq * 4);
    }
    {
        f32x4 kk[4], qk[4]; zero4(kk); zero4(qk);
        mm64(kk, Y1, LDP, Y1, LDP);
        mm64(qk, Y0, LDP, Y1, LDP);
        float cc[4], bc[4], cs[4];
#pragma unroll
        for (int j = 0; j < 4; ++j) { cc[j] = cum[16 * w + fq * 4 + j]; bc[j] = beta[16 * w + fq * 4 + j]; cs[j] = cum[j * 16 + fr]; }
#pragma unroll
        for (int nt = 0; nt < 4; ++nt)
#pragma unroll
            for (int j = 0; j < 4; ++j) {
                const int c = 16 * w + fq * 4 + j, s = nt * 16 + fr;
                const float ex = __expf(fminf(cc[j] - cs[nt], 0.f));
                X[c * 65 + s] = bc[j] * kk[nt][j] * ex * (s < c ? 1.f : 0.f);
                Y4[c * LDP + s] = f2bf(qk[nt][j] * ex * (s <= c ? 1.f : 0.f));
            }
    }
    __syncthreads();
    float* T = (float*)Y0;
    {
        float* Pb = (float*)Y5;
        for (int e = tid; e < 6 * 256; e += NTHR) {
            const int q = e >> 8, r = (e >> 4) & 15, c = e & 15;
            const int ib = q < 3 ? 0 : (q < 5 ? 1 : 2), jb = q < 3 ? q + 1 : (q < 5 ? q - 1 : 3);
            T[(16 * ib + r) * 65 + 16 * jb + c] = 0.f;
        }
        if (tid < 64) {
            const int blk = tid >> 4, col = tid & 15, base = blk * 16;
            float tc[16];
#pragma unroll
            for (int r = 0; r < 16; ++r) tc[r] = (r == col) ? 1.f : 0.f;
#pragma unroll
            for (int r = 1; r < 16; ++r) {
                float a = 0.f;
#pragma unroll
                for (int s2 = 0; s2 < r; ++s2) a += X[(base + r) * 65 + base + s2] * tc[s2];
                tc[r] -= (r > col ? 1.f : 0.f) * (a + tc[r]);
            }
#pragma unroll
            for (int r = 0; r < 16; ++r) T[(base + r) * 65 + base + col] = tc[r];
        }
        __syncthreads();
#pragma unroll
        for (int d = 1; d < 4; ++d) {
            const int nblk = 4 - d;
            for (int e = tid; e < nblk * 256; e += NTHR) {
                const int jb = e >> 8, r = (e >> 4) & 15, c = e & 15, ib = jb + d;
                float a = 0.f;
#pragma unroll
                for (int k2 = 0; k2 < d; ++k2)
#pragma unroll
                    for (int s2 = 0; s2 < 16; ++s2) a += X[(16 * ib + r) * 65 + 16 * (jb + k2) + s2] * T[(16 * (jb + k2) + s2) * 65 + 16 * jb + c];
                Pb[(jb * 16 + r) * 17 + c] = a;
            }
            __syncthreads();
            for (int e = tid; e < nblk * 256; e += NTHR) {
                const int jb = e >> 8, r = (e >> 4) & 15, c = e & 15, ib = jb + d;
                float a = 0.f;
#pragma unroll
                for (int s2 = 0; s2 < 16; ++s2) a += T[(16 * ib + r) * 65 + 16 * ib + s2] * Pb[(jb * 16 + s2) * 17 + c];
                T[(16 * ib + r) * 65 + 16 * jb + c] = -a;
            }
            __syncthreads();
        }
    }
    u16* Tw = (u16*)X;
    u16* Tu = Y5;
    {
        const int c = tid >> 2, sgp = tid & 3;
        float tw[16], tu[16];
#pragma unroll
        for (int i = 0; i < 16; ++i) {
            const int s = sgp * 16 + i;
            const float t = T[c * 65 + s];
            tw[i] = t * be[s]; tu[i] = t * beta[s];
        }
        st16bf(Tw + c * LDP + sgp * 16, tw);
        st16bf(Tu + c * LDP + sgp * 16, tu);
    }
    __syncthreads();
    u16* wT = Y0; u16* wkT = Y1; u16* uT = (u16*)X; u16* ukT = Y5;
    {
        f32x4 wa[4], ua[4]; zero4(wa); zero4(ua);
        mm64(wa, Tw, LDP, Y2, LDP);
        mm64(ua, Tu, LDP, Y3, LDP);
        __syncthreads();
        const int c0 = 16 * w + fq * 4;
        const float k0 = ke[c0], k1 = ke[c0 + 1], k2 = ke[c0 + 2], k3 = ke[c0 + 3];
#pragma unroll
        for (int nt = 0; nt < 4; ++nt) {
            const int d = nt * 16 + fr;
            u32x2 a, bq, c, dq_;
            a.x = pack2(wa[nt][0], wa[nt][1]); a.y = pack2(wa[nt][2], wa[nt][3]);
            bq.x = pack2(wa[nt][0] * k0, wa[nt][1] * k1); bq.y = pack2(wa[nt][2] * k2, wa[nt][3] * k3);
            c.x = pack2(ua[nt][0], ua[nt][1]); c.y = pack2(ua[nt][2], ua[nt][3]);
            dq_.x = pack2(ua[nt][0] * k0, ua[nt][1] * k1); dq_.y = pack2(ua[nt][2] * k2, ua[nt][3] * k3);
            *(u32x2*)(wT + d * LDP + c0) = a;
            *(u32x2*)(wkT + d * LDP + c0) = bq;
            *(u32x2*)(uT + d * LDP + c0) = c;
            *(u32x2*)(ukT + d * LDP + c0) = dq_;
        }
    }
    __syncthreads();
    {
        const float dec = scal[0];
        f32x4 acc[4];
        zero4(acc); mm64(acc, wT, LDP, Y4, LDP);
#pragma unroll
        for (int nt = 0; nt < 4; ++nt) {
            const int d = 16 * w + fq * 4, c = nt * 16 + fr;
            const u32x2 qv = qpre[nt];
            const float ec = __expf(cum[c]);
            u32x2 pk;
            pk.x = pack2(__uint_as_float(qv.x << 16) * ec - acc[nt][0], __uint_as_float(qv.x & 0xffff0000u) * ec - acc[nt][1]);
            pk.y = pack2(__uint_as_float(qv.y << 16) * ec - acc[nt][2], __uint_as_float(qv.y & 0xffff0000u) * ec - acc[nt][3]);
            *(u32x2*)(p.gdQ + idx * 4096 + c * 64 + d) = pk;
        }
        zero4(acc); mm64(acc, wkT, LDP, Y2, LDP);
#pragma unroll
        for (int nt = 0; nt < 4; ++nt) {
            const int d = 16 * w + fq * 4, d2 = nt * 16 + fr;
            u32x2 pk;
            pk.x = pack2((d == d2 ? dec : 0.f) - acc[nt][0], (d + 1 == d2 ? dec : 0.f) - acc[nt][1]);
            pk.y = pack2((d + 2 == d2 ? dec : 0.f) - acc[nt][2], (d + 3 == d2 ? dec : 0.f) - acc[nt][3]);
            *(u32x2*)(p.gdM + idx * 4096 + d2 * 64 + d) = pk;
        }
        zero4(acc); mm64(acc, Y2, LDP, ukT, LDP);
#pragma unroll
        for (int nt = 0; nt < 4; ++nt) {
            const int d2 = 16 * w + fq * 4, e = nt * 16 + fr;
            u32x2 pk; pk.x = pack2(acc[nt][0], acc[nt][1]); pk.y = pack2(acc[nt][2], acc[nt][3]);
            *(u32x2*)(p.gdN + idx * 4096 + e * 64 + d2) = pk;
        }
        zero4(acc); mm64(acc, Y4, LDP, uT, LDP);
#pragma unroll
        for (int nt = 0; nt < 4; ++nt) {
            const int c = 16 * w + fq * 4, e = nt * 16 + fr;
            u32x2 pk; pk.x = pack2(acc[nt][0], acc[nt][1]); pk.y = pack2(acc[nt][2], acc[nt][3]);
            *(u32x2*)(p.gdO + idx * 4096 + e * 64 + c) = pk;
        }
    }
    __syncthreads();
}

DEV void phase_chunkA(const P& p, int l, const u16* gqkv, int bid, int nb, unsigned char* sm) {
    for (int u = bid; u < 3 * 2112; u += nb) {
        const int mix = u / 2112, v = u % 2112;
        const int h = v & 3, st = (v >> 2) % NSTEP, db = (v >> 2) / NSTEP, b = db & 1, dir = db >> 1;
        if (mix == 0) { PRB_BEGIN(120); gd_phaseA(p, l, gqkv, dir, b, st, h, sm); PRB_END(120); }
        else if (mix == 1) { PRB_BEGIN(121); gla_phaseA(p, l, dir, b, st, h, sm); PRB_END(121); }
        else { PRB_BEGIN(122); ml_phaseA(p, l, dir, b, st, h, sm); PRB_END(122); }
    }
}
#define GD_STAGE (64 * 64 + 16 * 64)
#define GD_NST 7
DEV void gd_issue(const P& p, size_t idx, int ct, u16* ring, int stg, int w, int lane) {
    u16* md = ring + stg * GD_STAGE;
    u16* nd = md + 64 * 64;
#pragma unroll
    for (int i = 0; i < 2; ++i) {
        const int r = (w * 2 + i) * 8 + (lane >> 3), c = (lane & 7) ^ ((r >> 1) & 7);
        __builtin_amdgcn_global_load_lds((const unsigned*)(p.gdM + idx * 4096 + r * 64 + c * 8), (unsigned*)(md + (w * 2 + i) * 512), 16, 0, 0);
    }
    {
        const int pi = w & 1, r = pi * 8 + (lane >> 3), c = (lane & 7) ^ ((r >> 1) & 7);
        __builtin_amdgcn_global_load_lds((const unsigned*)(p.gdN + idx * 4096 + (16 * ct + r) * 64 + c * 8), (unsigned*)(nd + pi * 512), 16, 0, 0);
    }
}
DEV void gd_frags(const u16* Ms, int fr, int fq, int sw, bf16x8 (&a)[8], u32x2 (&nv)[4]) {
    const u16* Ns = Ms + 64 * 64;
#pragma unroll
    for (int mt = 0; mt < 4; ++mt) {
#pragma unroll
        for (int ks = 0; ks < 2; ++ks) a[mt * 2 + ks] = *(const bf16x8*)(Ms + (mt * 16 + fr) * 64 + (((ks * 4 + fq) ^ sw) * 8));
        nv[mt] = *(const u32x2*)(Ns + fr * 64 + (((mt * 2 + (fq >> 1)) ^ sw) * 8) + (fq & 1) * 4);
    }
}
DEV void gd_scan(const P& p, int unit, u16* sm) {
    const int chain = unit >> 2, ct = unit & 3;
    const int dir = chain >> 3, b = (chain >> 2) & 1, h = chain & 3;
    const int tid_ = tidx();
    const int lane = tid_ & 63, w = tid_ >> 6, fr = lane & 15, fq = lane >> 4;
    u16* ring = sm;
    u16* sl = sm + GD_NST * GD_STAGE;
    bf16x8 sb[2];
    sb[0] = bf16x8{0, 0, 0, 0, 0, 0, 0, 0}; sb[1] = sb[0];
    const size_t base = state_idx(dir, b, 0, h);
    const int sw = (fr >> 1) & 7;
    asm volatile("s_waitcnt vmcnt(0)" ::: "memory");
#pragma unroll
    for (int t = 0; t < 6; ++t) gd_issue(p, base + (size_t)t * 4, ct, ring, t, w, lane);
    asm volatile("s_waitcnt vmcnt(15)" ::: "memory");
    RAW_BARRIER();
    bf16x8 a[8], an[8]; u32x2 nv[4], nn[4];
    if (w == 0) gd_frags(ring, fr, fq, sw, a, nv);
    for (int k = 0; k < NSTEP; ++k) {
        if (k + 6 >= NSTEP) asm volatile("s_waitcnt vmcnt(0)" ::: "memory");
        else if (w != 0 || k == 0) asm volatile("s_waitcnt vmcnt(12)" ::: "memory");
        else asm volatile("s_waitcnt vmcnt(14)" ::: "memory");
        RAW_BARRIER();
        if (k + 6 < NSTEP) gd_issue(p, base + (size_t)(k + 6) * 4, ct, ring, (k + 6) % GD_NST, w, lane);
        asm volatile("" ::: "memory");
        if (w == 0) {
            const size_t idx = base + (size_t)k * 4;
            f32x4 acc[4];
#pragma unroll
            for (int mt = 0; mt < 4; ++mt) {
                acc[mt][0] = __uint_as_float(nv[mt].x << 16); acc[mt][1] = __uint_as_float(nv[mt].x & 0xffff0000u);
                acc[mt][2] = __uint_as_float(nv[mt].y << 16); acc[mt][3] = __uint_as_float(nv[mt].y & 0xffff0000u);
            }
#pragma unroll
            for (int mt = 0; mt < 4; ++mt)
#pragma unroll
                for (int ks = 0; ks < 2; ++ks) acc[mt] = mfma16(a[mt * 2 + ks], sb[ks], acc[mt]);
            if (k + 1 < NSTEP) gd_frags(ring + ((k + 1) % GD_NST) * GD_STAGE, fr, fq, sw, an, nn);
#pragma unroll
            for (int ks = 0; ks < 2; ++ks) *(bf16x8*)(p.gdN + idx * 4096 + (16 * ct + fr) * 64 + ks * 32 + fq * 8) = sb[ks];
            asm volatile("" ::: "memory");
#pragma unroll
            for (int mt = 0; mt < 4; ++mt) {
                u32x2 pk; pk.x = pack2(acc[mt][0], acc[mt][1]); pk.y = pack2(acc[mt][2], acc[mt][3]);
                *(u32x2*)(sl + fr * LDP + mt * 16 + fq * 4) = pk;
            }
            __builtin_amdgcn_wave_barrier();
#pragma unroll
            for (int ks = 0; ks < 2; ++ks) sb[ks] = *(const bf16x8*)(sl + fr * LDP + ks * 32 + fq * 8);
            __builtin_amdgcn_wave_barrier();
#pragma unroll
            for (int q = 0; q < 8; ++q) a[q] = an[q];
#pragma unroll
            for (int q = 0; q < 4; ++q) nv[q] = nn[q];
        }
    }
    asm volatile("s_waitcnt vmcnt(0)" ::: "memory");
    RAW_BARRIER();
}

DEV void gla_scan(const P& p, int v) {
    const int chain = v >> 3, sub = v & 7;
    const int dir = chain >> 3, b = (chain >> 2) & 1, h = chain & 3;
    const int ep = sub * 256 + tidx(), d = (2 * ep) & 63;
    float s0 = 0.f, s1 = 0.f;
    for (int st0 = 0; st0 < NSTEP; st0 += 12) {
        unsigned kv[12]; float2 dc[12];
#pragma unroll
        for (int k = 0; k < 12; ++k) {
            const size_t idx = state_idx(dir, b, st0 + k, h);
            kv[k] = *(const unsigned*)(p.glaS + idx * 4096 + 2 * ep);
            dc[k] = *(const float2*)(p.glaDec + idx * 64 + d);
        }
#pragma unroll
        for (int k = 0; k < 12; ++k) {
            const size_t idx = state_idx(dir, b, st0 + k, h);
            *(unsigned*)(p.glaS + idx * 4096 + 2 * ep) = pack2(s0, s1);
            s0 = dc[k].x * s0 + __uint_as_float(kv[k] << 16);
            s1 = dc[k].y * s1 + __uint_as_float(kv[k] & 0xffff0000u);
        }
    }
}

DEV void ml_scan(const P& p, int v) {
    const int chain = v >> 3, sub = v & 7;
    const int dir = chain >> 3, b = (chain >> 2) & 1, h = chain & 3;
    const int tid = tidx();
    const int ep = sub * 256 + tid;
    float s0 = 0.f, s1 = 0.f, m = 0.f;
    for (int st0 = 0; st0 < NSTEP; st0 += 12) {
        unsigned kv[12]; float fe[12], ae[12];
#pragma unroll
        for (int k = 0; k < 12; ++k) {
            const size_t idx = state_idx(dir, b, st0 + k, h);
            kv[k] = *(const unsigned*)(p.mlS + idx * 4096 + 2 * ep);
            fe[k] = p.mlFE[idx]; ae[k] = p.mlAE[idx];
        }
#pragma unroll
        for (int k = 0; k < 12; ++k) {
            const size_t idx = state_idx(dir, b, st0 + k, h);
            *(unsigned*)(p.mlS + idx * 4096 + 2 * ep) = pack2(s0, s1);
            const float mn = fmaxf(fe[k] + m, ae[k]);
            const float od = __expf(fe[k] + m - mn), nw = __expf(ae[k] - mn);
            s0 = od * s0 + nw * __uint_as_float(kv[k] << 16);
            s1 = od * s1 + nw * __uint_as_float(kv[k] & 0xffff0000u);
            m = mn;
        }
    }
}
DEV void ml_nscan(const P& p, int v) {
    const int tid = tidx(), chain = v * 4 + (tid >> 6), d = tid & 63;
    const int dir = chain >> 3, b = (chain >> 2) & 1, h = chain & 3;
    float nn = 0.f, m = 0.f;
    for (int st0 = 0; st0 < NSTEP; st0 += 12) {
        float fe[12], ae[12], ks[12];
#pragma unroll
        for (int k = 0; k < 12; ++k) {
            const size_t idx = state_idx(dir, b, st0 + k, h);
            fe[k] = p.mlFE[idx]; ae[k] = p.mlAE[idx]; ks[k] = p.mlN[idx * 64 + d];
        }
#pragma unroll
        for (int k = 0; k < 12; ++k) {
            const size_t idx = state_idx(dir, b, st0 + k, h);
            p.mlN[idx * 64 + d] = nn;
            if (d == 0) p.mlM[idx] = m;
            const float mn = fmaxf(fe[k] + m, ae[k]);
            const float od = __expf(fe[k] + m - mn), nw = __expf(ae[k] - mn);
            nn = od * nn + nw * ks[k];
            m = mn;
        }
    }
}

DEV void phase_scan(const P& p, int bid, int nb, u16* sm) {
    for (int u = bid; u < 64 + 128 + 128 + 4; u += nb) {
        if (u < 64) { PRB_BEGIN(100); gd_scan(p, u, sm); PRB_END(100); }
        else if (u < 192) { PRB_BEGIN(101); gla_scan(p, u - 64); PRB_END(101); }
        else if (u < 320) { PRB_BEGIN(102); ml_scan(p, u - 192); PRB_END(102); }
        else ml_nscan(p, u - 320);
    }
}
DEV void chunk_geom(int g, int& b, int& row0, int& stf, int& stb) {
    b = g / NSTEP; const int wv = g % NSTEP;
    row0 = wv < 4 ? RLAT + b * CTXL + wv * 64 : b * SEQ + (wv - 4) * 64;
    stf = wv; stb = wv < 4 ? 3 - wv : 135 - wv;
}
DEV void obuf_acc(float* obuf, const f32x4 (&acc)[4], int dir) {
    const int lane = tidx() & 63, w = tidx() >> 6, fr = lane & 15, fq = lane >> 4;
    if (dir == 0) {
#pragma unroll
        for (int nt = 0; nt < 4; ++nt)
#pragma unroll
            for (int j = 0; j < 4; ++j) obuf[(16 * w + fq * 4 + j) * 65 + nt * 16 + fr] = acc[nt][j];
    } else {
        float old[4][4];
#pragma unroll
        for (int nt = 0; nt < 4; ++nt)
#pragma unroll
            for (int j = 0; j < 4; ++j) old[nt][j] = obuf[(63 - (16 * w + fq * 4 + j)) * 65 + nt * 16 + fr];
#pragma unroll
        for (int nt = 0; nt < 4; ++nt)
#pragma unroll
            for (int j = 0; j < 4; ++j) obuf[(63 - (16 * w + fq * 4 + j)) * 65 + nt * 16 + fr] = old[nt][j] + acc[nt][j];
    }
}
DEV Raw16 gate_prefetch(const P& p, int h, int row0, int gcol) {
    const int tid = tidx(), row = tid >> 2, eg = tid & 3;
    return ldraw16(p.cols + (size_t)(row0 + row) * NCM + gcol + h * 64 + eg * 16);
}
template <int ACT>
DEV void head_out(const P& p, int l, int br, int h, int row0, const Raw16& graw, const float* obuf) {
    const int tid = tidx(), row = tid >> 2, eg = tid & 3;
    float o[16]; float ss = 0.f;
#pragma unroll
    for (int i = 0; i < 16; ++i) { o[i] = obuf[row * 65 + eg * 16 + i]; ss += o[i] * o[i]; }
    ss += shx(ss, 1); ss += shx(ss, 2);
    const float rs = rsqrtf(ss * (1.f / 64.f) + EPSF);
    float gt[16];
    unraw16(graw, gt);
    float y[16];
#pragma unroll
    for (int i = 0; i < 16; ++i) {
        const float hn = p.head_norm[(l * 4 + br) * 256 + h * 64 + eg * 16 + i];
        const float a = ACT == 0 ? silu(gt[i]) : sigm(gt[i]);
        y[i] = o[i] * rs * hn * a;
    }
    st16bf(p.ybuf + (size_t)(row0 + row) * 1024 + br * 256 + h * 64 + eg * 16, y);
}

DEV void gla_phaseC(const P& p, int l, int g, int h, unsigned char* smraw) {
    float* cum = (float*)smraw;
    float* rt = cum + 64 * 65;
    float* sg = rt + 64 * 17;
    float* obuf = sg + 256;
    u16* qi = (u16*)(obuf + 64 * 65);
    u16* ko = qi + 64 * LDP;
    u16* vT = ko + 64 * LDP;
    const int tid = tidx(), lane = tid & 63, w = tid >> 6, fr = lane & 15, fq = lane >> 4;
    int b, row0, stf, stb; chunk_geom(g, b, row0, stf, stb);
    const Raw16 graw = gate_prefetch(p, h, row0, GLA_G);
    for (int dir = 0; dir < 2; ++dir) {
        const size_t idx = state_idx(dir, b, dir ? stb : stf, h);
        Raw16 qraw, kraw, vraw; bf16x8 sin_[2][4];
        {
            const int s = tid >> 2, dg = tid & 3, row = row0 + (dir ? 63 - s : s);
            qraw = ldraw16(p.cols + (size_t)row * NCM + GLA_Q + h * 64 + dg * 16);
            kraw = ldraw16(p.cols + (size_t)row * NCM + GLA_K + h * 64 + dg * 16);
            vraw = ldraw16(p.cols + (size_t)row * NCM + GLA_V + h * 64 + dg * 16);
        }
        ldB64(sin_, p.glaS + idx * 4096);
        PRB_BEGIN(140);
        gla_cum(p, l, dir, h, row0, cum, rt, sg);
        PRB_END(140);
        PRB_BEGIN(141);
        {
            const int s = tid >> 2, dg = tid & 3;
            float qq[16], kk[16], vv[16];
            unraw16(qraw, qq); unraw16(kraw, kk); unraw16(vraw, vv);
#pragma unroll
            for (int i = 0; i < 16; ++i) {
                const float cv = cum[s * 65 + dg * 16 + i];
                qq[i] *= 0.125f * __expf(cv); kk[i] *= __expf(-cv);
                vT[(dg * 16 + i) * LDP + s] = f2bf(vv[i]);
            }
            st16bf(qi + s * LDP + dg * 16, qq);
            st16bf(ko + s * LDP + dg * 16, kk);
        }
        __syncthreads();
        f32x4 sa[4]; zero4(sa);
        mm64(sa, qi, LDP, ko, LDP);
        __syncthreads();
#pragma unroll
        for (int nt = 0; nt < 4; ++nt)
#pragma unroll
            for (int j = 0; j < 4; ++j) {
                const int c = 16 * w + fq * 4 + j, s = nt * 16 + fr;
                ko[c * LDP + s] = f2bf(s <= c ? sa[nt][j] : 0.f);
            }
        __syncthreads();
        PRB_END(141);
        PRB_BEGIN(142);
        f32x4 oa[4]; zero4(oa);
        mm64(oa, ko, LDP, vT, LDP);
        mm64_pre(oa, qi, LDP, sin_);
        obuf_acc(obuf, oa, dir);
        __syncthreads();
        PRB_END(142);
    }
    PRB_BEGIN(143);
    head_out<0>(p, l, 0, h, row0, graw, obuf);
    __syncthreads();
    PRB_END(143);
}

DEV void ml_phaseC(const P& p, int l, int g, int h, unsigned char* smraw) {
    float* obuf = (float*)smraw;
    float* fcum = obuf + 64 * 65;
    float* ipre = fcum + 64;
    float* mrow = ipre + 64;
    float* denl = mrow + 64;
    float* qn = denl + 64;
    float* nin = qn + 64;
    u16* qs = (u16*)(nin + 64 + 64);
    u16* ks = qs + 64 * LDP;
    u16* vT = ks + 64 * LDP;
    const int tid = tidx(), lane = tid & 63, w = tid >> 6, fr = lane & 15, fq = lane >> 4;
    int b, row0, stf, stb; chunk_geom(g, b, row0, stf, stb);
    const Raw16 graw = gate_prefetch(p, h, row0, ML_O);
    for (int dir = 0; dir < 2; ++dir) {
        const size_t idx = state_idx(dir, b, dir ? stb : stf, h);
        const float m_in = p.mlM[idx];
        Raw16 qraw, kraw, vraw; bf16x8 cin_[2][4];
        {
            const int s = tid >> 2, dg = tid & 3, row = row0 + (dir ? 63 - s : s);
            qraw = ldraw16(p.cols + (size_t)row * NCM + ML_Q + h * 64 + dg * 16);
            kraw = ldraw16(p.cols + (size_t)row * NCM + ML_K + h * 64 + dg * 16);
            vraw = ldraw16(p.cols + (size_t)row * NCM + ML_V + h * 64 + dg * 16);
        }
        ldB64(cin_, p.mlS + idx * 4096);
        if (w == 0) {
            const int row = row0 + (dir ? 63 - lane : lane);
            const float ip = bf2f(p.cols[(size_t)row * NCM + ML_GF + dir * 8 + h]) + p.mlstm_gate_b[((l * 2 + dir) * 2 + 0) * 4 + h];
            const float lf = logsig(bf2f(p.cols[(size_t)row * NCM + ML_GF + dir * 8 + 4 + h]) + p.mlstm_gate_b[((l * 2 + dir) * 2 + 1) * 4 + h]);
            const float fc = wscan_add(lf, lane);
            const float pm = wscan_max(ip - fc, lane);
            fcum[lane] = fc; ipre[lane] = ip; mrow[lane] = fc + fmaxf(m_in, pm);
            nin[lane] = p.mlN[idx * 64 + lane];
        }
        {
            const int s = tid >> 2, dg = tid & 3;
            float kk[16], vv[16];
            *(u32x4*)(qs + s * LDP + dg * 16) = qraw.a;
            *(u32x4*)(qs + s * LDP + dg * 16 + 8) = qraw.b;
            unraw16(kraw, kk); unraw16(vraw, vv);
#pragma unroll
            for (int i = 0; i < 16; ++i) { kk[i] *= 0.125f; vT[(dg * 16 + i) * LDP + s] = f2bf(vv[i]); }
            st16bf(ks + s * LDP + dg * 16, kk);
        }
        __syncthreads();
        {
            const int c = tid >> 2, dg = tid & 3;
            float a = 0.f;
#pragma unroll
            for (int i = 0; i < 16; ++i) a += bf2f(qs[c * LDP + dg * 16 + i]) * nin[dg * 16 + i];
            a += shx(a, 1); a += shx(a, 2);
            if (dg == 0) qn[c] = a;
        }
        f32x4 sa[4]; zero4(sa);
        mm64(sa, qs, LDP, ks, LDP);
        __syncthreads();
        float dsum[4] = {0.f, 0.f, 0.f, 0.f};
#pragma unroll
        for (int nt = 0; nt < 4; ++nt)
#pragma unroll
            for (int j = 0; j < 4; ++j) {
                const int c = 16 * w + fq * 4 + j, s = nt * 16 + fr;
                const float ex = __expf(fminf(fcum[c] - fcum[s] + ipre[s] - mrow[c], 0.f));
                const float val = sa[nt][j] * ex * (s <= c ? 1.f : 0.f);
                dsum[j] += val;
                ks[c * LDP + s] = f2bf(val);
            }
#pragma unroll
        for (int j = 0; j < 4; ++j) {
            float v = dsum[j];
            v += shx(v, 1); v += shx(v, 2); v += shx(v, 4); v += shx(v, 8);
            if (fr == 0) denl[16 * w + fq * 4 + j] = v;
        }
        __syncthreads();
        f32x4 n1[4], n2[4]; zero4(n1); zero4(n2);
        mm64(n1, ks, LDP, vT, LDP);
        mm64_pre(n2, qs, LDP, cin_);
        f32x4 oa[4];
#pragma unroll
        for (int j = 0; j < 4; ++j) {
            const int c = 16 * w + fq * 4 + j;
            const float mr = mrow[c];
            const float ec = __expf(fcum[c] + m_in - mr);
            const float den = denl[c] + ec * qn[c];
            const float inv = 1.f / fmaxf(fabsf(den), __expf(-mr));
#pragma unroll
            for (int nt = 0; nt < 4; ++nt) oa[nt][j] = (n1[nt][j] + ec * n2[nt][j]) * inv;
        }
        obuf_acc(obuf, oa, dir);
        __syncthreads();
    }
    head_out<1>(p, l, 1, h, row0, graw, obuf);
    __syncthreads();
}

DEV void gd_phaseC(const P& p, int l, int g, int h, unsigned char* smraw) {
    float* obuf = (float*)smraw;
    const int tid = tidx(), lane = tid & 63, w = tid >> 6, fr = lane & 15, fq = lane >> 4;
    int b, row0, stf, stb; chunk_geom(g, b, row0, stf, stb);
    const Raw16 graw = gate_prefetch(p, h, row0, GD_OG);
    for (int dir = 0; dir < 2; ++dir) {
        const size_t idx = state_idx(dir, b, dir ? stb : stf, h);
        f32x4 oa[4];
#pragma unroll
        for (int nt = 0; nt < 4; ++nt) {
            const u32x2 ov = *(const u32x2*)(p.gdO + idx * 4096 + (nt * 16 + fr) * 64 + 16 * w + fq * 4);
            oa[nt][0] = __uint_as_float(ov.x << 16); oa[nt][1] = __uint_as_float(ov.x & 0xffff0000u);
            oa[nt][2] = __uint_as_float(ov.y << 16); oa[nt][3] = __uint_as_float(ov.y & 0xffff0000u);
        }
        mm64(oa, p.gdQ + idx * 4096, 64, p.gdN + idx * 4096, 64);
        obuf_acc(obuf, oa, dir);
        __syncthreads();
    }
    head_out<0>(p, l, 2, h, row0, graw, obuf);
    __syncthreads();
}
DEV float fexp2(float x) { return __builtin_amdgcn_exp2f(x); }
#define ATT_STAGE_ELEMS (2 * 64 * 64)
DEV void attn_issue(const u16* kbase, const u16* vbase, int kt, u16* ring, int stg, int w, int lane) {
    u16* kd = ring + stg * ATT_STAGE_ELEMS;
    u16* vd = kd + 64 * 64;
#pragma unroll
    for (int i = 0; i < 2; ++i) {
        const int r = (w * 2 + i) * 8 + (lane >> 3), c = (lane & 7) ^ ((r >> 1) & 7);
        __builtin_amdgcn_global_load_lds((const unsigned*)(kbase + (size_t)(kt * 64 + r) * 64 + c * 8), (unsigned*)(kd + (w * 2 + i) * 512), 16, 0, 0);
        __builtin_amdgcn_global_load_lds((const unsigned*)(vbase + (size_t)r * KPOS + kt * 64 + c * 8), (unsigned*)(vd + (w * 2 + i) * 512), 16, 0, 0);
    }
}

DEV void attn_unit(const P& p, int l, int b, int h, int q0pos, int nkeys, int rowbase, u16* ring) {
    const int tid = tidx(), lane = tid & 63, w = tid >> 6, fr = lane & 15, fq = lane >> 4;
    const size_t bh = (size_t)(b * 4 + h);
    float lam;
    {
        const float* lp = p.diff_lambda + (size_t)l * 4 * 4 * 32;
        float a = 0.f, c = 0.f;
        if (lane < 32) { a = lp[(0 * 4 + h) * 32 + lane] * lp[(1 * 4 + h) * 32 + lane]; c = lp[(2 * 4 + h) * 32 + lane] * lp[(3 * 4 + h) * 32 + lane]; }
        a = wsum(a); c = wsum(c);
        lam = expf(a) - expf(c) + (0.8f - 0.6f * expf(-0.3f * (float)l));
    }
    const float lam_init = 0.8f - 0.6f * expf(-0.3f * (float)l);
    bf16x8 qf[2][2];
#pragma unroll
    for (int g = 0; g < 2; ++g)
#pragma unroll
        for (int i = 0; i < 2; ++i)
            qf[g][i] = *(const bf16x8*)(p.dq + (bh * KPOS + q0pos + w * 32 + g * 16 + fr) * 64 + i * 32 + fq * 8);
    f32x4 O[2][2][4], negref[2][2];
    float mref[2][2], lsum[2][2];
#pragma unroll
    for (int i = 0; i < 2; ++i)
#pragma unroll
        for (int g = 0; g < 2; ++g) {
            mref[i][g] = 0.f; lsum[i][g] = 0.f; negref[i][g] = f32x4{0.f, 0.f, 0.f, 0.f};
#pragma unroll
            for (int t = 0; t < 4; ++t) O[i][g][t] = f32x4{0.f, 0.f, 0.f, 0.f};
        }
    const u16* kbase = p.dk + bh * KPOS * 64;
    const u16* vbase = p.dvT + bh * 64 * KPOS;
    const int nk = nkeys >> 6;
    asm volatile("s_waitcnt vmcnt(0)" ::: "memory");
    attn_issue(kbase, vbase, 0, ring, 0, w, lane);
    attn_issue(kbase, vbase, 1, ring, 1, w, lane);
    const int sw = (fr >> 1) & 7;
    for (int kt = 0; kt < nk; ++kt) {
        if (kt + 1 < nk) asm volatile("s_waitcnt vmcnt(4)" ::: "memory"); else asm volatile("s_waitcnt vmcnt(0)" ::: "memory");
        RAW_BARRIER();
        if (kt + 2 < nk) attn_issue(kbase, vbase, kt + 2, ring, (kt + 2) % 3, w, lane);
        const u16* Ks = ring + (kt % 3) * ATT_STAGE_ELEMS;
        const u16* Vs = Ks + 64 * 64;
#pragma unroll
        for (int i = 0; i < 2; ++i) {
            f32x4 s[2][4];
#pragma unroll
            for (int st = 0; st < 4; ++st) {
                const bf16x8 kf = *(const bf16x8*)(Ks + (st * 16 + fr) * 64 + (((i * 4 + fq) ^ sw) * 8));
#pragma unroll
                for (int g = 0; g < 2; ++g) s[g][st] = mfma16(kf, qf[g][i], negref[i][g]);
            }
            float tmx[2];
#pragma unroll
            for (int g = 0; g < 2; ++g) {
                float mx = fmaxf(fmaxf(s[g][0][0], s[g][0][1]), fmaxf(s[g][0][2], s[g][0][3]));
#pragma unroll
                for (int st = 1; st < 4; ++st) mx = fmaxf(fmaxf(mx, s[g][st][0]), fmaxf(fmaxf(s[g][st][1], s[g][st][2]), s[g][st][3]));
                mx = fmaxf(mx, shx(mx, 16)); mx = fmaxf(mx, shx(mx, 32));
                tmx[g] = mx;
            }
            const bool mv = (tmx[0] > 16.f) || (tmx[1] > 16.f) || (kt == 0 && (tmx[0] < -16.f || tmx[1] < -16.f));
            if (__any(mv)) {
#pragma unroll
                for (int g = 0; g < 2; ++g) {
                    const float d = ((tmx[g] > 16.f) || (kt == 0 && tmx[g] < -16.f)) ? tmx[g] : 0.f;
                    const float fac = fexp2(-d);
                    mref[i][g] += d; lsum[i][g] *= fac;
                    negref[i][g] = f32x4{-mref[i][g], -mref[i][g], -mref[i][g], -mref[i][g]};
#pragma unroll
                    for (int t = 0; t < 4; ++t) { O[i][g][t][0] *= fac; O[i][g][t][1] *= fac; O[i][g][t][2] *= fac; O[i][g][t][3] *= fac; }
#pragma unroll
                    for (int st = 0; st < 4; ++st) { s[g][st][0] -= d; s[g][st][1] -= d; s[g][st][2] -= d; s[g][st][3] -= d; }
                }
            }
            bf16x8 pb[2][2];
#pragma unroll
            for (int g = 0; g < 2; ++g) {
                float ps = 0.f;
#pragma unroll
                for (int st = 0; st < 4; ++st)
#pragma unroll
                    for (int j = 0; j < 4; ++j) { const float e = fexp2(s[g][st][j]); s[g][st][j] = e; ps += e; }
                lsum[i][g] += ps;
#pragma unroll
                for (int ks = 0; ks < 2; ++ks) {
                    union { bf16x8 v; unsigned u[4]; } pk;
                    pk.u[0] = pack2(s[g][2 * ks][0], s[g][2 * ks][1]); pk.u[1] = pack2(s[g][2 * ks][2], s[g][2 * ks][3]);
                    pk.u[2] = pack2(s[g][2 * ks + 1][0], s[g][2 * ks + 1][1]); pk.u[3] = pack2(s[g][2 * ks + 1][2], s[g][2 * ks + 1][3]);
                    pb[g][ks] = pk.v;
                }
            }
#pragma unroll
            for (int ks = 0; ks < 2; ++ks)
#pragma unroll
                for (int t = 0; t < 4; ++t) {
                    union { bf16x8 v; u32x2 h2[2]; } va;
                    va.h2[0] = *(const u32x2*)(Vs + (t * 16 + fr) * 64 + ((((2 * ks) * 2 + (fq >> 1)) ^ sw) * 8) + (fq & 1) * 4);
                    va.h2[1] = *(const u32x2*)(Vs + (t * 16 + fr) * 64 + ((((2 * ks + 1) * 2 + (fq >> 1)) ^ sw) * 8) + (fq & 1) * 4);
#pragma unroll
                    for (int g = 0; g < 2; ++g) O[i][g][t] = mfma16(va.v, pb[g][ks], O[i][g][t]);
                }
        }
    }
    RAW_BARRIER();
#pragma unroll
    for (int g = 0; g < 2; ++g) {
        float l0 = lsum[0][g], l1 = lsum[1][g];
        l0 += shx(l0, 16); l0 += shx(l0, 32);
        l1 += shx(l1, 16); l1 += shx(l1, 32);
        const float i0 = 1.f / l0, i1 = lam / l1;
        float o[4][4]; float ss = 0.f;
#pragma unroll
        for (int t = 0; t < 4; ++t)
#pragma unroll
            for (int j = 0; j < 4; ++j) { o[t][j] = O[0][g][t][j] * i0 - O[1][g][t][j] * i1; ss += o[t][j] * o[t][j]; }
        ss += shx(ss, 16); ss += shx(ss, 32);
        const float rs = rsqrtf(ss * (1.f / 64.f) + EPSF) * (1.f - lam_init);
        const int row = rowbase + w * 32 + g * 16 + fr;
#pragma unroll
        for (int t = 0; t < 4; ++t) {
            const int dv = t * 16 + fq * 4;
            const float4 hn = *(const float4*)(p.head_norm + (l * 4 + 3) * 256 + h * 64 + dv);
            u32x2 pk; pk.x = pack2(o[t][0] * rs * hn.x, o[t][1] * rs * hn.y); pk.y = pack2(o[t][2] * rs * hn.z, o[t][3] * rs * hn.w);
            *(u32x2*)(p.ybuf + (size_t)row * 1024 + 768 + h * 64 + dv) = pk;
        }
    }
}

template <int PART>
DEV void phase_outputs(const P& p, int l, int bid, int nb, unsigned char* sm) {
    if (PART != 2) {
    const int nq = 64 + (l == 0 ? 2 : 0);
    int* qctr = p.cnt + 64 + l * 8;
    volatile int* slot = (volatile int*)(sm + 3 * ATT_STAGE_ELEMS * 2);
    const int x0 = (int)(xb_xcc_id() & 7u);
    for (int a = 0; a < 8; ++a) {
        const int bh = (x0 + a) & 7;
        for (;;) {
            if (tidx() == 0) *slot = atomicAdd(qctr + bh, 1);
            __syncthreads();
            const int qt = *slot;
            __syncthreads();
            if (qt >= nq) break;
            const int b = bh >> 2, h = bh & 3;
            if (qt < 64) attn_unit(p, l, b, h, CTXL + qt * 128, KPOS, b * SEQ + qt * 128, (u16*)sm);
            else attn_unit(p, l, b, h, (qt - 64) * 128, CTXL, RLAT + b * CTXL + (qt - 64) * 128, (u16*)sm);
        }
    }
    }
    __builtin_amdgcn_sched_barrier(0);
    if (PART != 1)
    for (int v = bid; v < 3 * 1056; v += nb) {
        const int mix = v / 1056, r = v % 1056, g = r >> 2, h = r & 3;
        if (l == 1 && (g % NSTEP) < 4) continue;
        if (mix == 0) { PRB_BEGIN(131); gla_phaseC(p, l, g, h, sm); PRB_END(131); }
        else if (mix == 1) { PRB_BEGIN(132); ml_phaseC(p, l, g, h, sm); PRB_END(132); }
        else { PRB_BEGIN(133); gd_phaseC(p, l, g, h, sm); PRB_END(133); }
    }
}
#define LDS_BYTES 75776
#ifndef MULTI
#define MULTI 0
#endif
#ifndef STAGE
#define STAGE 99
#endif

enum { PH_PRO0 = 0, PH_PRO1, PH_NORM1, PH_INPROJ, PH_PREP, PH_CHUNKA, PH_SCAN, PH_OUT, PH_GATES, PH_MERGE1, PH_MERGE2, PH_ROUTER, PH_MOEUP, PH_MOEDOWN, PH_FINAL, PH_OUTC };

struct KArgs { const float* in[25]; float* out; unsigned char* ws; };
constexpr size_t al256c(size_t x) { return (x + 255) & ~(size_t)255; }
struct WsOff {
    size_t Wd, Wt2, bar, cnt, zero_end, modp, mod, xctx, rope, hbuf, ybuf, Wt, dq, dk, dvT, glaDec, mlN, mlFE, mlAE, mlM, glaS, mlS, gdM, gdN, gdQ, gdO, cols, total;
};
constexpr WsOff make_off() {
    WsOff o{}; size_t c = 0;
    const size_t nst = (size_t)2 * 2 * NSTEP * 4;
    o.bar = c; c = al256c(c + XCD_BAR_WORDS * 4);
    o.cnt = c; c = al256c(c + 1024);
    o.zero_end = c;
    o.modp = c; c = al256c(c + (size_t)2 * 16 * 3 * 6144 * 4);
    o.mod = c; c = al256c(c + (size_t)2 * 3 * 6144 * 4);
    o.xctx = c; c = al256c(c + (size_t)RCTX * DM * 4);
    o.rope = c; c = al256c(c + (size_t)192 * 8 * 2 * 4);
    o.hbuf = c; c = al256c(c + (size_t)RTOT * DM * 2);
    o.ybuf = c; c = al256c(c + (size_t)RTOT * DM * 2);
    o.Wt = c; c = al256c(c + (size_t)WT_TOTAL * 2);
    o.dq = c; c = al256c(c + (size_t)8 * KPOS * 64 * 2);
    o.dk = c; c = al256c(c + (size_t)8 * KPOS * 64 * 2);
    o.dvT = c; c = al256c(c + (size_t)8 * KPOS * 64 * 2);
    o.glaDec = c; c = al256c(c + nst * 64 * 4);
    o.mlN = c; c = al256c(c + nst * 64 * 4);
    o.mlFE = c; c = al256c(c + nst * 4);
    o.mlAE = c; c = al256c(c + nst * 4);
    o.mlM = c; c = al256c(c + nst * 4);
    o.glaS = c; c = al256c(c + nst * 4096 * 2);
    o.mlS = c; c = al256c(c + nst * 4096 * 2);
    o.gdM = c; c = al256c(c + nst * 4096 * 2);
    o.gdN = c; c = al256c(c + nst * 4096 * 2);
    o.gdQ = c; c = al256c(c + nst * 4096 * 2);
    o.gdO = c; c = al256c(c + nst * 4096 * 2);
    o.cols = c; c = al256c(c + (size_t)RTOT * NGATE * 2);
    o.Wd = c; c = al256c(c + (size_t)16 * 1024 * 512 * 2);
    o.Wt2 = c; c = al256c(c + (size_t)WT_TOTAL * 2);
    o.total = c;
    return o;
}
constexpr WsOff WSO = make_off();
template <class T> DEV T* launder_p(T* v) {
    __attribute__((address_space(1))) T* g = (__attribute__((address_space(1))) T*)v;
    asm volatile("" : "+s"(g));
    return (T*)g;
}
DEV P build_P(const KArgs& ka) {
    P p;
    const float* in[25];
#pragma unroll
    for (int i = 0; i < 25; ++i) in[i] = launder_p(ka.in[i]);
    p.x = in[0]; p.c = in[1]; p.ctx = in[2]; p.c_ctx = in[3]; p.w_mod = in[4]; p.b_mod = in[5]; p.norm_mix = in[6]; p.norm_ffn = in[7];
    p.w_in = in[8]; p.gla_a2 = in[9]; p.gla_ab = in[10]; p.mlstm_gate_b = in[11]; p.gdn_conv = in[12]; p.gdn_a_log = in[13];
    p.gdn_dt_bias = in[14]; p.diff_lambda = in[15]; p.head_norm = in[16]; p.w_branch = in[17]; p.w_out = in[18]; p.router_w = in[19];
    p.router_b = in[20]; p.w_gate = in[21]; p.w_up = in[22]; p.w_down = in[23]; p.norm_final = in[24];
    p.out = launder_p(ka.out);
    unsigned char* ws = launder_p(ka.ws);
    p.bar = (unsigned*)(ws + WSO.bar); p.cnt = (int*)(ws + WSO.cnt); p.modp = (float*)(ws + WSO.modp); p.mod = (float*)(ws + WSO.mod);
    p.xctx = (float*)(ws + WSO.xctx); p.rope = (float*)(ws + WSO.rope); p.hbuf = (u16*)(ws + WSO.hbuf); p.ybuf = (u16*)(ws + WSO.ybuf);
    p.Wt = (u16*)(ws + WSO.Wt); p.dq = (u16*)(ws + WSO.dq); p.dk = (u16*)(ws + WSO.dk); p.dvT = (u16*)(ws + WSO.dvT);
    p.glaDec = (float*)(ws + WSO.glaDec); p.mlN = (float*)(ws + WSO.mlN); p.mlFE = (float*)(ws + WSO.mlFE); p.mlAE = (float*)(ws + WSO.mlAE);
    p.mlM = (float*)(ws + WSO.mlM); p.glaS = (u16*)(ws + WSO.glaS); p.mlS = (u16*)(ws + WSO.mlS); p.gdM = (u16*)(ws + WSO.gdM);
    p.gdN = (u16*)(ws + WSO.gdN); p.gdQ = (u16*)(ws + WSO.gdQ); p.gdO = (u16*)(ws + WSO.gdO); p.cols = (u16*)(ws + WSO.cols); p.Wd = (u16*)(ws + WSO.Wd);
    return p;
}

template <int PH>
DEV void run_phase(const KArgs& ka, int l, int bid_, int nb_, unsigned char* sm) {
    P p = build_P(ka);
    u16* const Wt2 = (u16*)(launder_p(ka.ws) + WSO.Wt2);
    if (l == 1) p.Wt = Wt2;
    const int bid = launder_s(bid_), nb = launder_s(nb_);
    u16* gqkv = p.ybuf;
    u16* ubuf = p.glaS;
    const int mtiles = l == 0 ? 132 : 128;
    if (PH == PH_PRO0) { phase_conv_mixw(p, p.Wt, 0, bid, nb, 0, (float*)sm); phase_mod_partial(p, bid, nb, (float*)sm); phase_rope_table(p, bid, nb); }
    else if (PH == PH_PRO1) phase_mod_reduce(p, bid, nb);
    else if (PH == PH_NORM1) phase_norm1(p, l, bid, nb);
    else if (PH == PH_INPROJ) phase_inproj<false>(p, 0, 31, NCM, 66, bid, nb, (u16*)sm);
    else if (PH == PH_PREP) phase_prep(p, l, gqkv, bid, nb, (u16*)sm);
    else if (PH == PH_CHUNKA) phase_chunkA(p, l, gqkv, bid, nb, sm);
    else if (PH == PH_SCAN) {
        phase_scan(p, bid, nb, (u16*)sm);
        phase_conv_moed(p, l, bid, nb, nb > 400 ? 324 : 0, (float*)sm);
        if (l == 0) phase_conv_mixw(p, Wt2, 1, bid, nb, nb > 400 ? 324 : 0, (float*)sm);
    }
#ifdef PROBE_SPLIT
    else if (PH == PH_OUT) phase_outputs<1>(p, l, bid, nb, sm);
    else if (PH == PH_OUTC) phase_outputs<2>(p, l, bid, nb, sm);
#else
    else if (PH == PH_OUT) phase_outputs<0>(p, l, bid, nb, sm);
#endif
    else if (PH == PH_GATES) phase_inproj<true>(p, 3968, 32, NGATE, mtiles / 2, bid, nb, (u16*)sm);
    else if (PH == PH_MERGE1) phase_merge1(p, ubuf, mtiles, bid, nb, (u16*)sm);
    else if (PH == PH_MERGE2) { if (l == 0) phase_merge2s(p, l, ubuf, mtiles, bid, nb, (u16*)sm); else phase_merge2(p, l, ubuf, mtiles, bid, nb, (u16*)sm); }
    else if (PH == PH_ROUTER) {
        { PRB_BEGIN(110); phase_norm2_router(p, l, l == 0 ? RTOT : RLAT, bid, nb, (float*)sm); PRB_END(110); }
        { PRB_BEGIN(111); phase_conv_moew(p, l, bid, nb, (float*)sm); PRB_END(111); }
    }
    else if (PH == PH_MOEUP) phase_moe_up(p, l, bid, nb, (u16*)sm);
    else if (PH == PH_MOEDOWN) phase_moe_down_s(p, l, bid, nb, (u16*)sm);
    else if (PH == PH_FINAL) phase_final_norm(p, bid, nb);
}

#if MULTI
template <int PH>
__global__ void __launch_bounds__(NTHR, 2) k_phase(KArgs p, int l) {
    extern __shared__ __attribute__((aligned(16))) unsigned char smem[];
    run_phase<PH>(p, l, blockIdx.x, gridDim.x, smem);
}
#else
__global__ void __launch_bounds__(NTHR, 2) k_mega(KArgs p) {
    extern __shared__ __attribute__((aligned(16))) unsigned char smem[];
    volatile LAS unsigned* xbw = (volatile LAS unsigned*)(smem + LDS_BYTES);
    if (tidx() == 0) { xbw[0] = 0u; xbw[1] = 0u; xbw[2] = 0u; xbw[3] = 0u; }
    __syncthreads();
    (void)xcd_barrier_post((unsigned*)(p.ws + WSO.bar), xbw);
    const int bid = blockIdx.x, nb = gridDim.x;
#ifdef PROBE_SEL
    unsigned long long pr_t0 = wall_clock64();
    volatile LAS unsigned long long* pr_acc = (volatile LAS unsigned long long*)(smem + LDS_BYTES + 8);
#ifdef PROBE_CLK
    unsigned long long pr_c0 = __builtin_readcyclecounter();
#define PSTAMP(PH) do { const unsigned long long c_ = __builtin_readcyclecounter(); if ((PH) == PROBE_SEL && threadIdx.x == 0) *pr_acc = *pr_acc + (c_ - pr_c0) / 24ull; pr_c0 = c_; } while (0)
#else
#define PSTAMP(PH) do { const unsigned long long t_ = wall_clock64(); if ((PH) == PROBE_SEL && threadIdx.x == 0) *pr_acc = *pr_acc + (t_ - pr_t0); pr_t0 = t_; } while (0)
#endif
#else
#define PSTAMP(PH) do { } while (0)
#endif
#ifdef PROBE_2BAR
#define GBAR() do { GBAR1(); GBAR1(); } while (0)
#else
#define GBAR() GBAR1()
#endif
#define GBAR1() do { XcdBarrier b_; b_.bar = (unsigned*)(launder_p(p.ws) + WSO.bar); b_.x = xb_xcc_id(); b_.st = (volatile LAS unsigned*)(smem + LDS_BYTES); xcd_barrier(b_); } while (0)
    run_phase<PH_PRO0>(p, 0, bid, nb, smem); GBAR(); PSTAMP(PH_PRO0);
    run_phase<PH_PRO1>(p, 0, bid, nb, smem); GBAR(); PSTAMP(PH_PRO1);
    for (int l = 0; l < 2; ++l) {
        run_phase<PH_NORM1>(p, l, bid, nb, smem); GBAR(); PSTAMP(PH_NORM1);
        run_phase<PH_INPROJ>(p, l, bid, nb, smem); GBAR(); PSTAMP(PH_INPROJ);
#ifdef PROBE_GEMM
        { PRB_BEGIN(200); const P pp = build_P(p); phase_inproj<false, PROBE_GEMM>(pp, 0, 31, NCM, 66, launder_s(bid), launder_s(nb), (u16*)smem); PRB_END(200); } GBAR();
#endif
        run_phase<PH_PREP>(p, l, bid, nb, smem); GBAR(); PSTAMP(PH_PREP);
        run_phase<PH_CHUNKA>(p, l, bid, nb, smem); GBAR(); PSTAMP(PH_CHUNKA);
        run_phase<PH_SCAN>(p, l, bid, nb, smem); GBAR(); PSTAMP(PH_SCAN);
        run_phase<PH_OUT>(p, l, bid, nb, smem); GBAR(); PSTAMP(PH_OUT);
#ifdef PROBE_SPLIT
        run_phase<PH_OUTC>(p, l, bid, nb, smem); GBAR(); PSTAMP(PH_OUTC);
#endif
        run_phase<PH_GATES>(p, l, bid, nb, smem); GBAR(); PSTAMP(PH_GATES);
        run_phase<PH_MERGE1>(p, l, bid, nb, smem); GBAR(); PSTAMP(PH_MERGE1);
        run_phase<PH_MERGE2>(p, l, bid, nb, smem); GBAR(); PSTAMP(PH_MERGE2);
        run_phase<PH_ROUTER>(p, l, bid, nb, smem); GBAR(); PSTAMP(PH_ROUTER);
        run_phase<PH_MOEUP>(p, l, bid, nb, smem); GBAR(); PSTAMP(PH_MOEUP);
        run_phase<PH_MOEDOWN>(p, l, bid, nb, smem); GBAR(); PSTAMP(PH_MOEDOWN);
    }
    run_phase<PH_FINAL>(p, 0, bid, nb, smem);
#ifdef PROBE_SEL
    __syncthreads();
    { const unsigned long long te = wall_clock64(), wt = *pr_acc * 4ull; while (wall_clock64() - te < wt) __builtin_amdgcn_s_sleep(8); }
#endif
}
#endif

static size_t al256(size_t x) { return (x + 255) & ~(size_t)255; }

extern "C" void kernel_launch(void* const* d_in, const int* in_sizes, int n_in, void* d_out, int out_size, void* d_ws, size_t ws_size,
                              hipStream_t stream) {
    (void)in_sizes; (void)n_in; (void)out_size;
    if (ws_size < WSO.total) return;
    KArgs p{};
    for (int i = 0; i < 25; ++i) p.in[i] = (const float*)d_in[i];
    p.out = (float*)d_out;
    p.ws = (unsigned char*)d_ws;
    unsigned char* ws = (unsigned char*)d_ws;
    const size_t zero_bytes = WSO.zero_end;
    hipMemsetAsync(ws, 0, zero_bytes, stream);

    static int grid = 0;
#if MULTI
#define SETUP(PH) hipFuncSetAttribute((const void*)k_phase<PH>, hipFuncAttributeMaxDynamicSharedMemorySize, LDS_BYTES + 16)
    if (!grid) {
        SETUP(PH_PRO0); SETUP(PH_PRO1); SETUP(PH_NORM1); SETUP(PH_INPROJ); SETUP(PH_PREP); SETUP(PH_CHUNKA); SETUP(PH_SCAN); SETUP(PH_OUT);
        SETUP(PH_GATES); SETUP(PH_MERGE1); SETUP(PH_MERGE2); SETUP(PH_ROUTER); SETUP(PH_MOEUP); SETUP(PH_MOEDOWN); SETUP(PH_FINAL);
        grid = 512;
    }
#define LAUNCH(PH, l) k_phase<PH><<<grid, NTHR, LDS_BYTES + 16, stream>>>(p, l)
    LAUNCH(PH_PRO0, 0); LAUNCH(PH_PRO1, 0);
    for (int l = 0; l < 2; ++l) {
        LAUNCH(PH_NORM1, l);
#if STAGE >= 1
        LAUNCH(PH_INPROJ, l); LAUNCH(PH_PREP, l); LAUNCH(PH_CHUNKA, l); LAUNCH(PH_SCAN, l); LAUNCH(PH_OUT, l);
        LAUNCH(PH_GATES, l); LAUNCH(PH_MERGE1, l); LAUNCH(PH_MERGE2, l);
#endif
        LAUNCH(PH_ROUTER, l); LAUNCH(PH_MOEUP, l); LAUNCH(PH_MOEDOWN, l);
    }
    LAUNCH(PH_FINAL, 0);
#else
    if (!grid) {
        hipFuncSetAttribute((const void*)k_mega, hipFuncAttributeMaxDynamicSharedMemorySize, LDS_BYTES + 16);
        int dev = 0, cus = 0, per_cu = 0;
        hipGetDevice(&dev);
        hipDeviceGetAttribute(&cus, hipDeviceAttributeMultiprocessorCount, dev);
        hipOccupancyMaxActiveBlocksPerMultiprocessor(&per_cu, (const void*)k_mega, NTHR, LDS_BYTES + 16);
        if (per_cu > 2) per_cu = 2;
        if (per_cu < 1) per_cu = 1;
        grid = cus * per_cu;
    }
    k_mega<<<grid, NTHR, LDS_BYTES + 16, stream>>>(p);
#endif
}
```

```cpp
#include <hip/hip_runtime.h>
#include <stdint.h>
#include <math.h>

typedef unsigned short u16;
typedef short bf16x8 __attribute__((ext_vector_type(8)));
typedef float f32x4 __attribute__((ext_vector_type(4)));
typedef unsigned u32x2 __attribute__((ext_vector_type(2)));
typedef unsigned u32x4 __attribute__((ext_vector_type(4)));

#define DEV __device__ __forceinline__
#define NTHR 256

#define DM 1024
#define RLAT 16384
#define RCTX 512
#define RTOT 16896
#define SEQ 8192
#define CTXL 256
#define NCM 3968
#define NGATE 4096
#define NSTEP 132
#define KPOS 8448
#define EPSF 1e-6f
#define GLA_Q 0
#define GLA_K 256
#define GLA_V 512
#define GLA_G 768
#define GLA_RF 1024
#define GLA_RB 1040
#define ML_Q 1056
#define ML_K 1312
#define ML_V 1568
#define ML_O 1824
#define ML_GF 2080
#define ML_GB 2088
#define GD_Q 2096
#define GD_K 2352
#define GD_V 2608
#define GD_OG 2864
#define GD_GF 3120
#define GD_GB 3128
#define DF_Q 3136
#define DF_K 3392
#define DF_V 3648

DEV int tidx() { int t = threadIdx.x; asm volatile("" : "+v"(t)); __builtin_assume(t >= 0 && t < NTHR); return t; }
DEV int launder_s(int v) { asm volatile("" : "+s"(v)); return v; }
typedef __bf16 bf2_t __attribute__((ext_vector_type(2)));
typedef float f2_t __attribute__((ext_vector_type(2)));
DEV unsigned pack2(float a, float b) { f2_t v; v.x = a; v.y = b; return __builtin_bit_cast(unsigned, __builtin_convertvector(v, bf2_t)); }
DEV u16 f2bf(float f) { return (u16)(pack2(f, 0.f) & 0xffffu); }
DEV float bf2f(u16 h) { return __uint_as_float(((unsigned)h) << 16); }
DEV float sigm(float x) { return __builtin_amdgcn_rcpf(1.f + __expf(-x)); }
DEV float silu(float x) { return x * __builtin_amdgcn_rcpf(1.f + __expf(-x)); }
DEV float logsig(float x) { return fminf(x, 0.f) - __logf(1.f + __expf(-fabsf(x))); }
DEV float softplus(float x) { return fmaxf(x, 0.f) + __logf(1.f + __expf(-fabsf(x))); }
DEV float shx(float v, int o) {
    if (o == 1) return __int_as_float(__builtin_amdgcn_update_dpp(0, __float_as_int(v), 0xB1, 0xf, 0xf, false));
    if (o == 2) return __int_as_float(__builtin_amdgcn_update_dpp(0, __float_as_int(v), 0x4E, 0xf, 0xf, false));
    if (o == 8) return __int_as_float(__builtin_amdgcn_update_dpp(0, __float_as_int(v), 0x128, 0xf, 0xf, false));
    return __shfl_xor(v, o, 64);
}
DEV float shidx(float v, int src) { return __int_as_float(__builtin_amdgcn_ds_bpermute(src << 2, __float_as_int(v))); }
DEV float shup(float v, int o) { const int l = tidx() & 63; return __int_as_float(__builtin_amdgcn_ds_bpermute((l >= o ? l - o : l) << 2, __float_as_int(v))); }
#define DPPF(old_, v_, ctrl_, rmask_) __int_as_float(__builtin_amdgcn_update_dpp(__float_as_int(old_), __float_as_int(v_), ctrl_, rmask_, 0xf, false))
DEV float wscan_add_dpp(float v) {
    v += DPPF(0.f, v, 0x111, 0xf); v += DPPF(0.f, v, 0x112, 0xf); v += DPPF(0.f, v, 0x114, 0xf); v += DPPF(0.f, v, 0x118, 0xf);
    v += DPPF(0.f, v, 0x142, 0xa); v += DPPF(0.f, v, 0x143, 0xc);
    return v;
}
DEV float wscan_max_dpp(float v) {
    const float ninf = -INFINITY;
    v = fmaxf(v, DPPF(ninf, v, 0x111, 0xf)); v = fmaxf(v, DPPF(ninf, v, 0x112, 0xf)); v = fmaxf(v, DPPF(ninf, v, 0x114, 0xf)); v = fmaxf(v, DPPF(ninf, v, 0x118, 0xf));
    v = fmaxf(v, DPPF(ninf, v, 0x142, 0xa)); v = fmaxf(v, DPPF(ninf, v, 0x143, 0xc));
    return v;
}
DEV float wsum(float v) { return __int_as_float(__builtin_amdgcn_readlane(__float_as_int(wscan_add_dpp(v)), 63)); }
DEV float wmaxr(float v) { return __int_as_float(__builtin_amdgcn_readlane(__float_as_int(wscan_max_dpp(v)), 63)); }
DEV f32x4 mfma16(bf16x8 a, bf16x8 b, f32x4 c) { return __builtin_amdgcn_mfma_f32_16x16x32_bf16(a, b, c, 0, 0, 0); }

#ifdef PROBE_SEL
#define PRB_BEGIN(id) unsigned long long prb_t0_##id = ((id) == PROBE_SEL) ? wall_clock64() : 0ull
#define PRB_END(id) do { if ((id) == PROBE_SEL) { __syncthreads(); if (threadIdx.x == 0) { volatile __attribute__((address_space(3))) unsigned long long* a_ = (volatile __attribute__((address_space(3))) unsigned long long*)(size_t)(75776 + 8); *a_ = *a_ + (wall_clock64() - prb_t0_##id); } } } while (0)
#else
#define PRB_BEGIN(id) do { } while (0)
#define PRB_END(id) do { } while (0)
#endif
#define ROLE_LDS_OFF (75776 + 16)
#define RAW_BARRIER() do { asm volatile("s_waitcnt lgkmcnt(0)" ::: "memory"); __builtin_amdgcn_s_barrier(); } while (0)
struct P {
    const float *x, *c, *ctx, *c_ctx, *w_mod, *b_mod, *norm_mix, *norm_ffn, *w_in, *gla_a2, *gla_ab, *mlstm_gate_b,
        *gdn_conv, *gdn_a_log, *gdn_dt_bias, *diff_lambda, *head_norm, *w_branch, *w_out, *router_w, *router_b,
        *w_gate, *w_up, *w_down, *norm_final;
    float* out;
    unsigned* bar;
    int* cnt;
    float* modp;
    float* mod;
    float* xctx;
    float* rope;
    u16* hbuf;
    u16* ybuf;
    u16* Wt;
    u16* dq;
    u16* dk;
    u16* dvT;
    float* glaDec;
    float* mlN;
    float* mlFE;
    float* mlAE;
    float* mlM;
    u16* glaS;
    u16* mlS;
    u16* gdM;
    u16* gdN;
    u16* gdQ;
    u16* gdO;
    u16* cols;
    u16* Wd;
};
#define MOE_WGU_OFF 0
#define MOE_WD_OFF (16u * 1024u * 1024u)
#define MOE_ACT_OFF (MOE_WD_OFF + 16u * 1024u * 512u)
#define MOE_LIST_OFF (MOE_ACT_OFF + 2u * RTOT * 512u)

DEV const float* xrow_in(const P& p, int l, int r) {
    if (l == 0) return r < RLAT ? p.x + (size_t)r * DM : p.ctx + (size_t)(r - RLAT) * DM;
    return r < RLAT ? p.out + (size_t)r * DM : p.xctx + (size_t)(r - RLAT) * DM;
}
DEV float* xrow_out(const P& p, int r) { return r < RLAT ? p.out + (size_t)r * DM : p.xctx + (size_t)(r - RLAT) * DM; }
DEV int modidx(int r) { return r < RLAT ? (r >> 13) : 2; }
DEV int chunk_row0(int b, int dir, int st) {
    if (st < 4) { int c = dir ? 3 - st : st; return RLAT + b * CTXL + c * 64; }
    int c = dir ? 131 - st : st - 4; return b * SEQ + c * 64;
}
DEV size_t state_idx(int dir, int b, int st, int h) { return ((size_t)((dir * 2 + b) * NSTEP + st) * 4 + h); }
#define XB_TMO      128
#define XB_XCNT(j)  (256  + 64 * (j))
#define XB_XSUB(j)  (1280 + 64 * (j))
#define XB_XGEN(j)  (2304 + 64 * (j))
#define XB_TOP      3328
#define XB_TOPGEN   3392
#define XCD_BAR_WORDS 3456
#define XB_SPIN_CAP (1u << 18)
#define LAS __attribute__((address_space(3)))

__device__ __forceinline__ unsigned xb_ld(unsigned* p)              { return __hip_atomic_load(p, __ATOMIC_RELAXED, __HIP_MEMORY_SCOPE_AGENT); }
__device__ __forceinline__ unsigned xb_add(unsigned* p, unsigned v) { return __hip_atomic_fetch_add(p, v, __ATOMIC_RELAXED, __HIP_MEMORY_SCOPE_AGENT); }
__device__ __forceinline__ unsigned xb_xcc_id() { return (unsigned)__builtin_amdgcn_s_getreg((3 << 11) | 20) & 0xFu; }
#define XB_SPIN(cond, bar) do { unsigned _sp = 0; while (cond) { __builtin_amdgcn_s_sleep(1); \
    if ((++_sp & 255u) == 0u) { if (xb_ld(&(bar)[XB_TMO])) break; if (_sp > XB_SPIN_CAP) { atomicAdd(&(bar)[XB_TMO], 1u); break; } } } } while (0)

struct XcdBarrier {
    unsigned* bar; unsigned x;
    volatile LAS unsigned* st;
};

__device__ __forceinline__ XcdBarrier xcd_barrier_post(unsigned* bar, volatile LAS unsigned* st) {
    XcdBarrier b; b.bar = bar; b.x = xb_xcc_id(); b.st = st;
    if (tidx() == 0) (void)xb_add(&bar[XB_XCNT(b.x)], 1u);
    return b;
}
__device__ __forceinline__ void xcd_barrier_complete(unsigned* bar, unsigned x, unsigned& nloc, unsigned& nx) {
    const unsigned G = gridDim.x * gridDim.y * gridDim.z;
    unsigned sum, cnt, mine, sp = 0u;
    for (;;) {
        sum = 0u; cnt = 0u; mine = 0u;
#pragma unroll
        for (unsigned j = 0; j < 16; ++j) { const unsigned c = xb_ld(&bar[XB_XCNT(j)]); sum += c; cnt += (c > 0u) ? 1u : 0u; mine = (j == x) ? c : mine; }
        if (sum == G) break;
        __builtin_amdgcn_s_sleep(1);
        if ((++sp & 255u) == 0u) { if (xb_ld(&bar[XB_TMO])) break; if (sp > XB_SPIN_CAP) { atomicAdd(&bar[XB_TMO], 1u); break; } }
    }
    nloc = mine > 0u ? mine : 1u; nx = cnt > 0u ? cnt : 1u;
}

__device__ __forceinline__ void xcd_barrier(const XcdBarrier& b) {
    asm volatile("s_waitcnt vmcnt(0)" ::: "memory");
    __syncthreads();
    if (tidx() == 0) {
        unsigned* bar = b.bar;
        __builtin_amdgcn_s_waitcnt(0);
        unsigned nloc = b.st[0], nx = b.st[1];
        if (nloc == 0u) { xcd_barrier_complete(bar, b.x, nloc, nx); b.st[0] = nloc; b.st[1] = nx; }
        const unsigned old = xb_add(&bar[XB_XSUB(b.x)], 1u);
        const unsigned gen = old / nloc;
        if (old + 1u == (gen + 1u) * nloc) {
            __builtin_amdgcn_fence(__ATOMIC_RELEASE, "agent");
            asm volatile("s_waitcnt vmcnt(0)" ::: "memory");
            const unsigned og = xb_add(&bar[XB_TOP], 1u);
            const unsigned tg = og / nx;
            if (og + 1u == (tg + 1u) * nx) xb_add(&bar[XB_TOPGEN], 1u);
            else XB_SPIN(xb_ld(&bar[XB_TOPGEN]) == tg, bar);
            __builtin_amdgcn_fence(__ATOMIC_ACQUIRE, "agent");
            xb_add(&bar[XB_XGEN(b.x)], 1u);
            asm volatile("s_waitcnt vmcnt(0)" ::: "memory");
        } else {
            XB_SPIN(xb_ld(&bar[XB_XGEN(b.x)]) == gen, bar);
            __builtin_amdgcn_fence(__ATOMIC_ACQUIRE, "agent");
            asm volatile("s_waitcnt vmcnt(0)" ::: "memory");
        }
    }
    __syncthreads();
}
struct TrJob { const float* src; u16* dst; int lds_, ldd, map; };
DEV int tr_rowmap(int map, int n) {
    if (map == 1) return n < 3904 ? n : n + 64;
    if (map == 2) return (n >> 5) * 64 + (n & 31);
    if (map == 3) return (n >> 5) * 64 + 32 + (n & 31);
    return n;
}
struct TrRegs { f32x4 r0, r1, r2, r3; };
DEV void tr_load(const TrJob& j, TrRegs& q) {
    const int t = tidx(), n4 = (t & 15) * 4, kp = t >> 4;
    const float* s0 = j.src + (size_t)(2 * kp) * j.lds_ + n4;
    const float* s1 = j.src + (size_t)(2 * (kp + 16)) * j.lds_ + n4;
    q.r0 = __builtin_nontemporal_load((const f32x4*)s0); q.r1 = __builtin_nontemporal_load((const f32x4*)(s0 + j.lds_));
    q.r2 = __builtin_nontemporal_load((const f32x4*)s1); q.r3 = __builtin_nontemporal_load((const f32x4*)(s1 + j.lds_));
}
DEV void tr_finish(const TrJob& j, int n0, const TrRegs& q, float* smf) {
    unsigned* sm = (unsigned*)smf;
    const int t = tidx();
    {
        const int n4 = (t & 15) * 4, kp = t >> 4;
        sm[(n4 + 0) * 33 + kp] = pack2(q.r0[0], q.r1[0]); sm[(n4 + 1) * 33 + kp] = pack2(q.r0[1], q.r1[1]);
        sm[(n4 + 2) * 33 + kp] = pack2(q.r0[2], q.r1[2]); sm[(n4 + 3) * 33 + kp] = pack2(q.r0[3], q.r1[3]);
        sm[(n4 + 0) * 33 + kp + 16] = pack2(q.r2[0], q.r3[0]); sm[(n4 + 1) * 33 + kp + 16] = pack2(q.r2[1], q.r3[1]);
        sm[(n4 + 2) * 33 + kp + 16] = pack2(q.r2[2], q.r3[2]); sm[(n4 + 3) * 33 + kp + 16] = pack2(q.r2[3], q.r3[3]);
    }
    __syncthreads();
    {
        const int n = t >> 2, kq = (t & 3) * 8;
        u32x4 o0, o1;
        o0.x = sm[n * 33 + kq + 0]; o0.y = sm[n * 33 + kq + 1]; o0.z = sm[n * 33 + kq + 2]; o0.w = sm[n * 33 + kq + 3];
        o1.x = sm[n * 33 + kq + 4]; o1.y = sm[n * 33 + kq + 5]; o1.z = sm[n * 33 + kq + 6]; o1.w = sm[n * 33 + kq + 7];
        u16* d = j.dst + (size_t)tr_rowmap(j.map, n0 + n) * j.ldd + kq * 2;
        *(u32x4*)d = o0; *(u32x4*)(d + 8) = o1;
    }
    __syncthreads();
}
#define WT_WB_OFF (8064u * 1024u)
#define WT_WO_OFF (WT_WB_OFF + 4u * 1024u * 256u)
#define WT_TOTAL (WT_WO_OFF + 1024u * 1024u)

DEV TrJob mixw_job(const P& p, u16* Wb, int l, int u, int& n0) {
    TrJob j;
    if (u < 2000) {
        const int kt = u / 125, nt = u % 125; n0 = nt * 64;
        j.src = p.w_in + (size_t)l * 1024 * 8000 + (size_t)kt * 64 * 8000 + n0; j.lds_ = 8000; j.dst = Wb + kt * 64; j.ldd = 1024; j.map = 1;
    } else if (u < 2256) {
        const int v = u - 2000, i = v >> 6, w = v & 63, kt = w >> 4, nt = w & 15; n0 = nt * 64;
        j.src = p.w_branch + (size_t)(l * 4 + i) * 256 * 1024 + (size_t)kt * 64 * 1024 + n0; j.lds_ = 1024;
        j.dst = Wb + WT_WB_OFF + (size_t)i * 1024 * 256 + kt * 64; j.ldd = 256; j.map = 0;
    } else {
        const int v = u - 2256, kt = v >> 4, nt = v & 15; n0 = nt * 64;
        j.src = p.w_out + (size_t)l * 1024 * 1024 + (size_t)kt * 64 * 1024 + n0; j.lds_ = 1024; j.dst = Wb + WT_WO_OFF + kt * 64; j.ldd = 1024; j.map = 0;
    }
    return j;
}
DEV void phase_conv_mixw(const P& p, u16* Wb, int l, int bid, int nb, int b0, float* sm) {
    if (bid < b0) return;
    const int step = nb - b0;
    if (bid == nb - 1) {
        unsigned* z = (unsigned*)(Wb + (size_t)3904 * 1024);
        for (int i = tidx(); i < 64 * 1024 / 2; i += NTHR) z[i] = 0u;
    }
    int u = bid - b0, n0 = 0, n1 = 0;
    if (u >= 2512) return;
    TrRegs r;
    TrJob j = mixw_job(p, Wb, l, u, n0);
    tr_load(j, r);
    for (;;) {
        const int un = u + step;
        TrRegs rn; TrJob jn = j;
        if (un < 2512) { jn = mixw_job(p, Wb, l, un, n1); tr_load(jn, rn); }
        tr_finish(j, n0, r, sm);
        if (un >= 2512) break;
        u = un; j = jn; n0 = n1; r = rn;
    }
}
DEV TrJob moew_job(const P& p, int l, int u, int& n0) {
    TrJob j;
    u16* wgu = p.cols + MOE_WGU_OFF;
    const int e = u >> 8, v = u & 255;
    const size_t le = (size_t)(l * 16 + e);
    const int w = v & 127, kt = w >> 3, nt = w & 7; n0 = nt * 64;
    j.src = (v < 128 ? p.w_gate : p.w_up) + le * 1024 * 512 + (size_t)kt * 64 * 512 + n0; j.lds_ = 512;
    j.dst = wgu + (size_t)e * 1024 * 1024 + kt * 64; j.ldd = 1024; j.map = v < 128 ? 2 : 3;
    return j;
}
DEV TrJob moed_job(const P& p, int l, int u, int& n0) {
    TrJob j;
    const int e = u >> 7, w = u & 127, kt = w >> 4, nt = w & 15; n0 = nt * 64;
    const size_t le = (size_t)(l * 16 + e);
    j.src = p.w_down + le * 512 * 1024 + (size_t)kt * 64 * 1024 + n0; j.lds_ = 1024; j.dst = p.Wd + (size_t)e * 1024 * 512 + kt * 64; j.ldd = 512; j.map = 0;
    return j;
}
DEV void phase_conv_moed(const P& p, int l, int bid, int nb, int b0, float* sm) {
    if (bid < b0) return;
    const int step = nb - b0;
    int u = bid - b0, n0 = 0, n1 = 0;
    if (u >= 16 * 128) return;
    TrRegs r;
    TrJob j = moed_job(p, l, u, n0);
    tr_load(j, r);
    for (;;) {
        const int un = u + step;
        TrRegs rn; TrJob jn = j;
        if (un < 16 * 128) { jn = moed_job(p, l, un, n1); tr_load(jn, rn); }
        tr_finish(j, n0, r, sm);
        if (un >= 16 * 128) break;
        u = un; j = jn; n0 = n1; r = rn;
    }
}
DEV void phase_conv_moew(const P& p, int l, int bid, int nb, float* sm) {
    int u = bid, n0 = 0, n1 = 0;
    if (u >= 16 * 256) return;
    TrRegs r;
    TrJob j = moew_job(p, l, u, n0);
    tr_load(j, r);
    for (;;) {
        const int un = u + nb;
        TrRegs rn; TrJob jn = j;
        if (un < 16 * 256) { jn = moew_job(p, l, un, n1); tr_load(jn, rn); }
        tr_finish(j, n0, r, sm);
        if (un >= 16 * 256) break;
        u = un; j = jn; n0 = n1; r = rn;
    }
}

DEV void phase_mod_partial(const P& p, int bid, int nb, float* sm) {
    for (int u = bid; u < 768; u += nb) {
        const int l = u / 384, v = u % 384, kc = v / 24, jb = v % 24;
        const int t = tidx();
        __syncthreads();
        if (t < 192) {
            const int m = t >> 6, k = kc * 64 + (t & 63);
            const float cv = m < 2 ? p.c[m * 1024 + k] : p.c_ctx[k];
            sm[t] = silu(cv);
        }
        __syncthreads();
        const int j = jb * 256 + t;
        const float* w = p.w_mod + ((size_t)l * 1024 + kc * 64) * 6144 + j;
        float a0 = 0.f, a1 = 0.f, a2 = 0.f;
#pragma unroll
        for (int kb = 0; kb < 64; kb += 32) {
            float wv[32];
#pragma unroll
            for (int k = 0; k < 32; ++k) wv[k] = __builtin_nontemporal_load(w + (size_t)(kb + k) * 6144);
#pragma unroll
            for (int k = 0; k < 32; ++k) { a0 += sm[kb + k] * wv[k]; a1 += sm[64 + kb + k] * wv[k]; a2 += sm[128 + kb + k] * wv[k]; }
        }
        float* o = p.modp + ((size_t)(l * 16 + kc) * 3) * 6144 + j;
        o[0] = a0; o[6144] = a1; o[2 * 6144] = a2;
    }
}
DEV void phase_mod_reduce(const P& p, int bid, int nb) {
    for (int i = bid * NTHR + tidx(); i < 2 * 3 * 6144; i += nb * NTHR) {
        const int l = i / (3 * 6144), r = i % (3 * 6144), m = r / 6144, j = r % 6144;
        float a = p.b_mod[l * 6144 + j];
        for (int kc = 0; kc < 16; ++kc) a += p.modp[((size_t)(l * 16 + kc) * 3 + m) * 6144 + j];
        p.mod[i] = a;
    }
}

DEV void moe_combine_row(const P& p, const int (&cnt)[16], int r, int lane, const float4 (&g2c)[4], float4 (&v)[4]);
DEV void phase_norm1(const P& p, int l, int bid, int nb) {
    const int lane = tidx() & 63, w = tidx() >> 6;
    int cn[16];
#pragma unroll
    for (int k = 0; k < 16; ++k) cn[k] = (l == 1) ? p.cnt[k] : 0;
    int mcur = -1; float4 fa[4], fb[4], g2c[4];
    for (int r0 = (bid * 4 + w) * 2; r0 < RTOT; r0 += nb * 8) {
        f32x4 v[2][4];
#pragma unroll
        for (int q = 0; q < 2; ++q) {
            const float* xr = xrow_in(p, l, r0 + q);
#pragma unroll
            for (int i = 0; i < 4; ++i) v[q][i] = __builtin_nontemporal_load((const f32x4*)(xr + lane * 4 + i * 256));
        }
        {
            const int m = modidx(r0);
            if (m != mcur) {
                mcur = m;
                const float* sh = p.mod + ((size_t)(l * 3 + m)) * 6144;
                const float* sc = sh + 1024;
#pragma unroll
                for (int i = 0; i < 4; ++i) {
                    const int c = lane * 4 + i * 256;
                    const float4 g = *(const float4*)(p.norm_mix + l * 1024 + c);
                    const float4 s1 = *(const float4*)(sc + c);
                    fb[i] = *(const float4*)(sh + c);
                    fa[i].x = g.x * (1.f + s1.x); fa[i].y = g.y * (1.f + s1.y); fa[i].z = g.z * (1.f + s1.z); fa[i].w = g.w * (1.f + s1.w);
                    if (l == 1) g2c[i] = *(const float4*)(p.mod + (size_t)(0 * 3 + m) * 6144 + 5120 + c);
                }
            }
        }
#pragma unroll
        for (int q = 0; q < 2; ++q) {
            const int r = r0 + q;
            float4 t[4];
#pragma unroll
            for (int i = 0; i < 4; ++i) { t[i].x = v[q][i][0]; t[i].y = v[q][i][1]; t[i].z = v[q][i][2]; t[i].w = v[q][i][3]; }
            if (l == 1) {
                moe_combine_row(p, cn, r, lane, g2c, t);
                float* xw = xrow_out(p, r);
#pragma unroll
                for (int i = 0; i < 4; ++i) *(float4*)(xw + lane * 4 + i * 256) = t[i];
            }
            float ss = 0.f;
#pragma unroll
            for (int i = 0; i < 4; ++i) ss += t[i].x * t[i].x + t[i].y * t[i].y + t[i].z * t[i].z + t[i].w * t[i].w;
            ss = wsum(ss);
            const float rs = rsqrtf(ss * (1.f / 1024.f) + EPSF);
#pragma unroll
            for (int i = 0; i < 4; ++i) {
                const int c = lane * 4 + i * 256;
                const float o0 = t[i].x * rs * fa[i].x + fb[i].x;
                const float o1 = t[i].y * rs * fa[i].y + fb[i].y;
                const float o2 = t[i].z * rs * fa[i].z + fb[i].z;
                const float o3 = t[i].w * rs * fa[i].w + fb[i].w;
                u32x2 pk; pk.x = pack2(o0, o1); pk.y = pack2(o2, o3);
                *(u32x2*)(p.hbuf + (size_t)r * 1024 + c) = pk;
            }
        }
    }
}

#define LDP 72
#define GEMM_STAGE (2 * 128 * 64)
DEV int g_row(int tid, int i) { return (tid >> 6) * 32 + i * 8 + ((tid >> 3) & 7); }
DEV int g_kc(int tid, int row) { return ((tid & 7) ^ ((row >> 1) & 7)) * 8; }
DEV void gemm_mainloop(f32x4 (&acc)[4][4], const u16* const (&xp)[4], const u16* const (&wp)[4], int KT, u16* sm, u16*  ) {
    const int tid = tidx(), lane = tid & 63, w = tid >> 6, wn = w & 1, wm = w >> 1;
    const int fr = lane & 15, fq = lane >> 4, sw = (fr >> 1) & 7;
    asm volatile("s_waitcnt vmcnt(0)" ::: "memory");
#pragma unroll
    for (int i = 0; i < 4; ++i) {
        __builtin_amdgcn_global_load_lds((const unsigned*)xp[i], (unsigned*)(sm + (w * 4 + i) * 512), 16, 0, 0);
        __builtin_amdgcn_global_load_lds((const unsigned*)wp[i], (unsigned*)(sm + 128 * 64 + (w * 4 + i) * 512), 16, 0, 0);
    }
    for (int kt = 0; kt < KT; ++kt) {
        asm volatile("s_waitcnt vmcnt(0)" ::: "memory");
        RAW_BARRIER();
        if (kt + 1 < KT) {
            u16* nx = sm + ((kt + 1) & 1) * GEMM_STAGE;
#pragma unroll
            for (int i = 0; i < 4; ++i) {
                __builtin_amdgcn_global_load_lds((const unsigned*)(xp[i] + (kt + 1) * 64), (unsigned*)(nx + (w * 4 + i) * 512), 16, 0, 0);
                __builtin_amdgcn_global_load_lds((const unsigned*)(wp[i] + (kt + 1) * 64), (unsigned*)(nx + 128 * 64 + (w * 4 + i) * 512), 16, 0, 0);
            }
        }
        const u16* sX = sm + (kt & 1) * GEMM_STAGE;
        const u16* sW = sX + 128 * 64;
#pragma unroll
        for (int ks = 0; ks < 2; ++ks) {
            bf16x8 a[4], b[4];
#pragma unroll
            for (int q = 0; q < 4; ++q) {
                a[q] = *(const bf16x8*)(sW + (wn * 64 + q * 16 + fr) * 64 + (((ks * 4 + fq) ^ sw) * 8));
                b[q] = *(const bf16x8*)(sX + (wm * 64 + q * 16 + fr) * 64 + (((ks * 4 + fq) ^ sw) * 8));
            }
#pragma unroll
            for (int nt = 0; nt < 4; ++nt)
#pragma unroll
                for (int mt = 0; mt < 4; ++mt) acc[nt][mt] = mfma16(a[nt], b[mt], acc[nt][mt]);
        }
    }
    RAW_BARRIER();
}
DEV void zero_acc(f32x4 (&acc)[4][4]) {
#pragma unroll
    for (int a = 0; a < 4; ++a)
#pragma unroll
        for (int b = 0; b < 4; ++b) acc[a][b] = f32x4{0.f, 0.f, 0.f, 0.f};
}

#define GB_STAGE (384 * 32)
#define GB_KEY(g) ((0x78 >> (2 * (g))) & 3)
DEV void gemmb_issue(const u16* const (&xp)[4], const u16* const (&wp)[2], int kt, u16* stg, int w) {
#pragma unroll
    for (int i = 0; i < 4; ++i) __builtin_amdgcn_global_load_lds((const unsigned*)(xp[i] + kt * 32), (unsigned*)(stg + (w * 4 + i) * 512), 16, 0, 0);
#pragma unroll
    for (int i = 0; i < 2; ++i) __builtin_amdgcn_global_load_lds((const unsigned*)(wp[i] + kt * 32), (unsigned*)(stg + 256 * 32 + (w * 2 + i) * 512), 16, 0, 0);
}
DEV void gemmB_lane(int i, int nrow_pieces_per_wave, int& row, int& chunk) {
    const int t = tidx(), l = t & 63, w = t >> 6;
    row = (w * nrow_pieces_per_wave + i) * 16 + (l >> 2);
    chunk = ((l & 3) ^ GB_KEY((l >> 4) & 3)) * 8;
}
DEV void gemmB_mainloop(f32x4 (&acc)[4][8], const u16* xb, const unsigned (&xo)[4], const u16* wb, const unsigned (&wo)[2], int KT, u16* sm) {
    const int tid = tidx(), lane = tid & 63, w = tid >> 6, wn = w & 1, wm = w >> 1, fr = lane & 15, fq = lane >> 4;
    const int sw = GB_KEY((fr >> 2) & 3);
    const int aoff = (wn * 64 + fr) * 32 + ((fq ^ sw) * 8) + 256 * 32;
    const int boff = (wm * 128 + fr) * 32 + ((fq ^ sw) * 8);
#pragma unroll
    for (int a = 0; a < 4; ++a)
#pragma unroll
        for (int b = 0; b < 8; ++b) acc[a][b] = f32x4{0.f, 0.f, 0.f, 0.f};
    asm volatile("s_waitcnt vmcnt(0)" ::: "memory");
#pragma unroll
    for (int t0 = 0; t0 < 3; ++t0) {
#pragma unroll
        for (int i = 0; i < 4; ++i) __builtin_amdgcn_global_load_lds((const unsigned*)(xb + xo[i] + t0 * 32), (unsigned*)(sm + t0 * GB_STAGE + (w * 4 + i) * 512), 16, 0, 0);
#pragma unroll
        for (int i = 0; i < 2; ++i) __builtin_amdgcn_global_load_lds((const unsigned*)(wb + wo[i] + t0 * 32), (unsigned*)(sm + t0 * GB_STAGE + 256 * 32 + (w * 2 + i) * 512), 16, 0, 0);
    }
    asm volatile("s_waitcnt vmcnt(12)" ::: "memory");
    RAW_BARRIER();
    bf16x8 a[4], b[8];
#pragma unroll
    for (int q = 0; q < 4; ++q) a[q] = *(const bf16x8*)(sm + aoff + q * 512);
#pragma unroll
    for (int q = 0; q < 8; ++q) b[q] = *(const bf16x8*)(sm + boff + q * 512);
    for (int kt = 0; kt < KT; ++kt) {
        if (kt + 2 < KT) asm volatile("s_waitcnt vmcnt(6)" ::: "memory");
        else asm volatile("s_waitcnt vmcnt(0)" ::: "memory");
        RAW_BARRIER();
        const bool more = kt + 3 < KT, nxt = kt + 1 < KT;
        u16* nx = sm + (kt % 3) * GB_STAGE;
        const u16* cur = sm + ((kt + 1) % 3) * GB_STAGE;
#pragma unroll
        for (int h = 0; h < 2; ++h) {
            if (more) {
                __builtin_amdgcn_global_load_lds((const unsigned*)(xb + (kt + 3) * 32 + xo[2 * h]), (unsigned*)(nx + (w * 4 + 2 * h) * 512), 16, 0, 0);
                __builtin_amdgcn_global_load_lds((const unsigned*)(xb + (kt + 3) * 32 + xo[2 * h + 1]), (unsigned*)(nx + (w * 4 + 2 * h + 1) * 512), 16, 0, 0);
                __builtin_amdgcn_global_load_lds((const unsigned*)(wb + (kt + 3) * 32 + wo[h]), (unsigned*)(nx + 256 * 32 + (w * 2 + h) * 512), 16, 0, 0);
            }
#pragma unroll
            for (int nt = 0; nt < 4; ++nt) {
#pragma unroll
                for (int mt = 0; mt < 4; ++mt) acc[nt][4 * h + mt] = mfma16(a[nt], b[4 * h + mt], acc[nt][4 * h + mt]);
                if (h == 1 && nxt) a[nt] = *(const bf16x8*)(cur + aoff + nt * 512);
            }
            __builtin_amdgcn_sched_barrier(0);
            if (nxt) {
#pragma unroll
                for (int mt = 0; mt < 4; ++mt) b[4 * h + mt] = *(const bf16x8*)(cur + boff + (4 * h + mt) * 512);
            }
        }
    }
    RAW_BARRIER();
}

DEV int xcd_unit(int bid, int nb, int it, int total) {
    const int per = (total + 7) >> 3, idx = (bid >> 3) + it * (nb >> 3);
    if (idx >= per) return -1;
    const int v = (bid & 7) * per + idx;
    return v < total ? v : -1;
}

template <bool SIG, int GMODE = 3>
DEV void phase_inproj(const P& p, int wrow0, int ntn, int ldc, int mtiles256, int bid, int nb, u16* sm) {
    const int total_ = mtiles256 * ntn, per_ = (total_ + 7) >> 3, slots_ = nb >> 3;
    for (int it = (GMODE == 3 ? (bid >> 3) : bid); it < (GMODE == 3 ? per_ : total_); it += (GMODE == 3 ? slots_ : nb)) {
        int mt_, nt_;
        if (GMODE == 3) {
            const int v = (bid & 7) * per_ + it;
            if (v >= total_) break;
            const int G = mtiles256 >> 3, gsz = ntn * 8;
            if (v < G * gsz) { const int g = v / gsz, rem = v - g * gsz; nt_ = rem >> 3; mt_ = g * 8 + (rem & 7); }
            else { const int rem = v - G * gsz, rg = mtiles256 - G * 8; nt_ = rem / rg; mt_ = G * 8 + rem % rg; }
        } else { mt_ = it / ntn; nt_ = it % ntn; }
        const int m0 = (GMODE == 1) ? 0 : mt_ * 256, n0 = (GMODE == 1) ? 0 : nt_ * 128;
        unsigned xo[4], wo[2];
#pragma unroll
        for (int i = 0; i < 4; ++i) { int row, ch; gemmB_lane(i, 4, row, ch); xo[i] = (unsigned)(row * 1024 + ch); }
#pragma unroll
        for (int i = 0; i < 2; ++i) { int row, ch; gemmB_lane(i, 2, row, ch); wo[i] = (unsigned)(row * 1024 + ch); }
        f32x4 acc[4][8];
        gemmB_mainloop(acc, p.hbuf + (size_t)m0 * 1024, xo, p.Wt + (size_t)(wrow0 + n0) * 1024, wo, 32, sm);
        const int t2 = tidx(), l2 = t2 & 63, w2 = t2 >> 6;
        const int ln = (w2 & 1) * 64 + (l2 >> 4) * 4, lm = (w2 >> 1) * 128 + (l2 & 15);
#pragma unroll
        for (int nt = 0; nt < 4; ++nt)
#pragma unroll
            for (int mt = 0; mt < 8; ++mt) {
                f32x4 v = acc[nt][mt];
                if (SIG) { v[0] = sigm(v[0]); v[1] = sigm(v[1]); v[2] = sigm(v[2]); v[3] = sigm(v[3]); }
                u32x2 pk; pk.x = pack2(v[0], v[1]); pk.y = pack2(v[2], v[3]);
                *(u32x2*)(sm + (lm + mt * 16) * 136 + ln + nt * 16) = pk;
            }
        __syncthreads();
#pragma unroll
        for (int i = 0; i < 16; ++i) {
            const int id = t2 + i * 256, row = id >> 4, cc = id & 15;
            const u32x4 v = *(const u32x4*)(sm + row * 136 + cc * 8);
            if (GMODE == 1) *(u32x4*)(p.ybuf + (size_t)((mt_ * 256 + row) & 4095) * ldc + nt_ * 128 + cc * 8) = v;
            else *(u32x4*)(p.cols + (size_t)(m0 + row) * ldc + n0 + cc * 8) = v;
        }
        __syncthreads();
    }
}

DEV void phase_merge1(const P& p, u16* ubuf, int mtiles, int bid, int nb, u16* sm) {
    for (int it = 0;; ++it) {
        const int u = xcd_unit(bid, nb, it, mtiles * 8);
        if (u < 0) break;
        const int tid = tidx(), lane = tid & 63, w = tid >> 6, wn = w & 1, wm = w >> 1, fr = lane & 15, fq = lane >> 4, sw = (fr >> 1) & 7;
        const int mt_ = u >> 3, nt_ = u & 7;
        const int m0 = mt_ * 128, n0 = nt_ * 128;
        const u16* xp[4]; const u16* wp[4];
#pragma unroll
        for (int i = 0; i < 4; ++i) {
            const int row = g_row(tid, i), kc = g_kc(tid, row);
            const int nperm = (row & 64) + ((row & 15) >> 2) * 16 + ((row >> 4) & 3) * 4 + (row & 3);
            xp[i] = p.ybuf + (size_t)(m0 + row) * 1024 + kc;
            wp[i] = p.Wt + WT_WB_OFF + (size_t)(n0 + nperm) * 256 + kc;
        }
        const int ncol = n0 + wn * 64 + fq * 16;
        const u16* gbase = p.cols + (size_t)(m0 + wm * 64 + fr) * NGATE + ncol;
        f32x4 tot[4][4], acc[4][4]; zero_acc(tot); zero_acc(acc);
        u32x4 gt[4][2];
        asm volatile("s_waitcnt vmcnt(0)" ::: "memory");
#pragma unroll
        for (int i = 0; i < 4; ++i) {
            __builtin_amdgcn_global_load_lds((const unsigned*)xp[i], (unsigned*)(sm + (w * 4 + i) * 512), 16, 0, 0);
            __builtin_amdgcn_global_load_lds((const unsigned*)wp[i], (unsigned*)(sm + 128 * 64 + (w * 4 + i) * 512), 16, 0, 0);
        }
        for (int kt = 0; kt < 16; ++kt) {
            asm volatile("s_waitcnt vmcnt(0)" ::: "memory");
            RAW_BARRIER();
            if (kt + 1 < 16) {
                u16* nx = sm + ((kt + 1) & 1) * GEMM_STAGE;
                const int wof = ((kt + 1) >> 2) * 262144 + ((kt + 1) & 3) * 64;
#pragma unroll
                for (int i = 0; i < 4; ++i) {
                    __builtin_amdgcn_global_load_lds((const unsigned*)(xp[i] + (kt + 1) * 64), (unsigned*)(nx + (w * 4 + i) * 512), 16, 0, 0);
                    __builtin_amdgcn_global_load_lds((const unsigned*)(wp[i] + wof), (unsigned*)(nx + 128 * 64 + (w * 4 + i) * 512), 16, 0, 0);
                }
            }
            if ((kt & 3) == 0) {
                const int br = kt >> 2;
#pragma unroll
                for (int mt = 0; mt < 4; ++mt) {
                    gt[mt][0] = *(const u32x4*)(gbase + (size_t)mt * 16 * NGATE + br * 1024);
                    gt[mt][1] = *(const u32x4*)(gbase + (size_t)mt * 16 * NGATE + br * 1024 + 8);
                }
            }
            const u16* sX = sm + (kt & 1) * GEMM_STAGE;
            const u16* sW = sX + 128 * 64;
#pragma unroll
            for (int ks = 0; ks < 2; ++ks) {
                bf16x8 a[4], b[4];
#pragma unroll
                for (int q = 0; q < 4; ++q) {
                    a[q] = *(const bf16x8*)(sW + (wn * 64 + q * 16 + fr) * 64 + (((ks * 4 + fq) ^ sw) * 8));
                    b[q] = *(const bf16x8*)(sX + (wm * 64 + q * 16 + fr) * 64 + (((ks * 4 + fq) ^ sw) * 8));
                }
#pragma unroll
                for (int nt = 0; nt < 4; ++nt)
#pragma unroll
                    for (int mt = 0; mt < 4; ++mt) acc[nt][mt] = mfma16(a[nt], b[mt], acc[nt][mt]);
            }
            if ((kt & 3) == 3) {
#pragma unroll
                for (int mt = 0; mt < 4; ++mt) {
                    const unsigned gw[8] = {gt[mt][0].x, gt[mt][0].y, gt[mt][0].z, gt[mt][0].w, gt[mt][1].x, gt[mt][1].y, gt[mt][1].z, gt[mt][1].w};
#pragma unroll
                    for (int nt = 0; nt < 4; ++nt) {
                        tot[nt][mt][0] += __uint_as_float(gw[nt * 2] << 16) * acc[nt][mt][0];
                        tot[nt][mt][1] += __uint_as_float(gw[nt * 2] & 0xffff0000u) * acc[nt][mt][1];
                        tot[nt][mt][2] += __uint_as_float(gw[nt * 2 + 1] << 16) * acc[nt][mt][2];
                        tot[nt][mt][3] += __uint_as_float(gw[nt * 2 + 1] & 0xffff0000u) * acc[nt][mt][3];
                        acc[nt][mt] = f32x4{0.f, 0.f, 0.f, 0.f};
                    }
                }
            }
        }
        RAW_BARRIER();
#pragma unroll
        for (int mt = 0; mt < 4; ++mt) {
            const int m = m0 + wm * 64 + mt * 16 + fr;
            u32x4 o0, o1;
            o0.x = pack2(tot[0][mt][0], tot[0][mt][1]); o0.y = pack2(tot[0][mt][2], tot[0][mt][3]);
            o0.z = pack2(tot[1][mt][0], tot[1][mt][1]); o0.w = pack2(tot[1][mt][2], tot[1][mt][3]);
            o1.x = pack2(tot[2][mt][0], tot[2][mt][1]); o1.y = pack2(tot[2][mt][2], tot[2][mt][3]);
            o1.z = pack2(tot[3][mt][0], tot[3][mt][1]); o1.w = pack2(tot[3][mt][2], tot[3][mt][3]);
            *(u32x4*)(ubuf + (size_t)m * 1024 + ncol) = o0;
            *(u32x4*)(ubuf + (size_t)m * 1024 + ncol + 8) = o1;
        }
    }
}

DEV void phase_merge2(const P& p, int l, const u16* ubuf, int mtiles, int bid, int nb, u16* sm) {
    const int mt256 = mtiles / 2;
    for (int it = 0;; ++it) {
        const int u = xcd_unit(bid, nb, it, mt256 * 8);
        if (u < 0) break;
        const int mt_ = u >> 3, nt_ = u & 7;
        const int m0 = mt_ * 256, n0 = nt_ * 128;
        unsigned xo[4], wo[2];
#pragma unroll
        for (int i = 0; i < 4; ++i) { int row, ch; gemmB_lane(i, 4, row, ch); xo[i] = (unsigned)(row * 1024 + ch); }
#pragma unroll
        for (int i = 0; i < 2; ++i) { int row, ch; gemmB_lane(i, 2, row, ch); wo[i] = (unsigned)(row * 1024 + ch); }
        f32x4 acc[4][8];
        gemmB_mainloop(acc, ubuf + (size_t)m0 * 1024, xo, p.Wt + WT_WO_OFF + (size_t)n0 * 1024, wo, 32, sm);
        const int t2 = tidx(), l2 = t2 & 63, w2 = t2 >> 6;
        float* st = (float*)sm;
        const float* g1 = p.mod + (size_t)(l * 3 + modidx(m0)) * 6144 + 2048 + n0;
#pragma unroll
        for (int hp = 0; hp < 2; ++hp) {
            if ((w2 >> 1) == hp) {
                const int lr = l2 & 15, lc = (w2 & 1) * 64 + (l2 >> 4) * 4;
#pragma unroll
                for (int mt = 0; mt < 8; ++mt)
#pragma unroll
                    for (int nt = 0; nt < 4; ++nt) *(f32x4*)(st + (mt * 16 + lr) * 132 + lc + nt * 16) = acc[nt][mt];
            }
            __syncthreads();
            const int cc = t2 & 31, r0 = t2 >> 5;
            const float4 g = *(const float4*)(g1 + cc * 4);
#pragma unroll
            for (int bq = 0; bq < 2; ++bq) {
                float4 xv[8];
#pragma unroll
                for (int i = 0; i < 8; ++i) xv[i] = *(const float4*)(xrow_in(p, l, m0 + hp * 128 + r0 + 8 * (bq * 8 + i)) + n0 + cc * 4);
#pragma unroll
                for (int i = 0; i < 8; ++i) {
                    const int rr = r0 + 8 * (bq * 8 + i);
                    const f32x4 v = *(const f32x4*)(st + rr * 132 + cc * 4);
                    float4 o;
                    o.x = xv[i].x + g.x * v[0]; o.y = xv[i].y + g.y * v[1]; o.z = xv[i].z + g.z * v[2]; o.w = xv[i].w + g.w * v[3];
                    *(float4*)(xrow_out(p, m0 + hp * 128 + rr) + n0 + cc * 4) = o;
                }
            }
            __syncthreads();
        }
    }
}

DEV void phase_merge2s(const P& p, int l, const u16* ubuf, int mtiles, int bid, int nb, u16* sm) {
    u16* sX = sm; u16* sW = sm + 128 * LDP;
    const int tid = tidx(), lane = tid & 63, w = tid >> 6, wn = w & 1, wm = w >> 1, fr = lane & 15, fq = lane >> 4;
    for (int it = 0;; ++it) {
        const int u = xcd_unit(bid, nb, it, mtiles * 8);
        if (u < 0) break;
        const int mt_ = u >> 3, nt_ = u & 7;
        const int m0 = mt_ * 128, n0 = nt_ * 128;
        const int tu = tidx();
        const u16* xp[4]; const u16* wp[4];
#pragma unroll
        for (int i = 0; i < 4; ++i) {
            const int row = g_row(tu, i), kc = g_kc(tu, row);
            xp[i] = ubuf + (size_t)(m0 + row) * 1024 + kc;
            wp[i] = p.Wt + WT_WO_OFF + (size_t)(n0 + row) * 1024 + kc;
        }
        f32x4 acc[4][4]; zero_acc(acc);
        gemm_mainloop(acc, xp, wp, 16, sX, sW);
        float* st = (float*)sm;
#pragma unroll
        for (int mt = 0; mt < 4; ++mt)
#pragma unroll
            for (int nt = 0; nt < 4; ++nt) *(f32x4*)(st + (wm * 64 + mt * 16 + fr) * 132 + wn * 64 + nt * 16 + fq * 4) = acc[nt][mt];
        __syncthreads();
        {
            const int t2 = tidx(), cc = t2 & 31, r0 = t2 >> 5;
            const float4 g = *(const float4*)(p.mod + (size_t)(l * 3 + modidx(m0)) * 6144 + 2048 + n0 + cc * 4);
#pragma unroll
            for (int bq = 0; bq < 2; ++bq) {
                float4 xv[8];
#pragma unroll
                for (int i = 0; i < 8; ++i) xv[i] = *(const float4*)(xrow_in(p, l, m0 + r0 + 8 * (bq * 8 + i)) + n0 + cc * 4);
#pragma unroll
                for (int i = 0; i < 8; ++i) {
                    const int rr = r0 + 8 * (bq * 8 + i);
                    const f32x4 v = *(const f32x4*)(st + rr * 132 + cc * 4);
                    float4 o;
                    o.x = xv[i].x + g.x * v[0]; o.y = xv[i].y + g.y * v[1]; o.z = xv[i].z + g.z * v[2]; o.w = xv[i].w + g.w * v[3];
                    *(float4*)(xrow_out(p, m0 + rr) + n0 + cc * 4) = o;
                }
            }
        }
        __syncthreads();
    }
}
DEV void phase_norm2_router(const P& p, int l, int nrows, int bid, int nb, float* sm) {
    const int tid = tidx(), lane = tid & 63, w = tid >> 6;
    int* list = (int*)(p.cols + MOE_LIST_OFF);
    float* slotw = (float*)(list + 16 * RTOT);
    int* tokslot = (int*)(slotw + 16 * RTOT);
    float* tokw = (float*)(tokslot + 2 * RTOT);
    int* lcnt = (int*)(sm + 16 * 1024);
    int* rinfo = lcnt + 32;
    float* rwgt = (float*)(rinfo + 4 * 40 * 2);
#pragma unroll
    for (int k = 0; k < 4; ++k) {
        const int c = tid + k * NTHR;
        f32x4 rw[4];
#pragma unroll
        for (int q = 0; q < 4; ++q) rw[q] = *(const f32x4*)(p.router_w + c * 16 + q * 4);
#pragma unroll
        for (int q = 0; q < 4; ++q)
#pragma unroll
            for (int j = 0; j < 4; ++j) sm[(q * 4 + j) * 1024 + c] = rw[q][j];
    }
    if (tid < 32) lcnt[tid] = 0;
    __syncthreads();
    int kk = 0;
    float4 vn[4];
    {
        const int r = bid * 4 + w;
        if (r < nrows) {
            const float* xr = xrow_out(p, r);
#pragma unroll
            for (int i = 0; i < 4; ++i) vn[i] = *(const float4*)(xr + lane * 4 + i * 256);
        }
    }
    int mcur = -1; float4 fa[4], fb[4];
    for (int r = bid * 4 + w; r < nrows; r += nb * 4, ++kk) {
        const int m = modidx(r);
        if (m != mcur) {
            mcur = m;
            const float* sh = p.mod + ((size_t)(l * 3 + m)) * 6144 + 3072;
            const float* sc = sh + 1024;
#pragma unroll
            for (int i = 0; i < 4; ++i) {
                const int c = lane * 4 + i * 256;
                const float4 g = *(const float4*)(p.norm_ffn + l * 1024 + c);
                const float4 s1 = *(const float4*)(sc + c);
                fb[i] = *(const float4*)(sh + c);
                fa[i].x = g.x * (1.f + s1.x); fa[i].y = g.y * (1.f + s1.y); fa[i].z = g.z * (1.f + s1.z); fa[i].w = g.w * (1.f + s1.w);
            }
        }
        float4 v[4]; float ss = 0.f;
#pragma unroll
        for (int i = 0; i < 4; ++i) v[i] = vn[i];
#pragma unroll
        for (int i = 0; i < 4; ++i) ss += v[i].x * v[i].x + v[i].y * v[i].y + v[i].z * v[i].z + v[i].w * v[i].w;
        ss = wsum(ss);
        const float rs = rsqrtf(ss * (1.f / 1024.f) + EPSF);
#pragma unroll
        for (int i = 0; i < 4; ++i) {
            const int c = lane * 4 + i * 256;
            v[i].x = v[i].x * rs * fa[i].x + fb[i].x;
            v[i].y = v[i].y * rs * fa[i].y + fb[i].y;
            v[i].z = v[i].z * rs * fa[i].z + fb[i].z;
            v[i].w = v[i].w * rs * fa[i].w + fb[i].w;
            u32x2 pk; pk.x = pack2(v[i].x, v[i].y); pk.y = pack2(v[i].z, v[i].w);
            *(u32x2*)(p.hbuf + (size_t)r * 1024 + c) = pk;
        }
        if (r + nb * 4 < nrows) {
            const float* xr = xrow_out(p, r + nb * 4);
#pragma unroll
            for (int i = 0; i < 4; ++i) vn[i] = *(const float4*)(xr + lane * 4 + i * 256);
        }
        float sel[16], scr[16];
#pragma unroll
        for (int e = 0; e < 16; ++e) scr[e] = 0.f;
#pragma unroll
        for (int i = 0; i < 4; ++i) {
#pragma unroll
            for (int e = 0; e < 16; ++e) {
                const float4 rw = *(const float4*)(sm + e * 1024 + lane * 4 + i * 256);
                scr[e] += v[i].x * rw.x + v[i].y * rw.y + v[i].z * rw.z + v[i].w * rw.w;
            }
            __builtin_amdgcn_sched_barrier(0);
        }
        {
            float t8[8], t4[4], t2[2];
            const bool b5 = lane & 32, b4 = lane & 16, b3 = lane & 8, b2 = lane & 4;
#pragma unroll
            for (int i = 0; i < 8; ++i) t8[i] = (b5 ? scr[i + 8] : scr[i]) + shx(b5 ? scr[i] : scr[i + 8], 32);
#pragma unroll
            for (int i = 0; i < 4; ++i) t4[i] = (b4 ? t8[i + 4] : t8[i]) + shx(b4 ? t8[i] : t8[i + 4], 16);
#pragma unroll
            for (int i = 0; i < 2; ++i) t2[i] = (b3 ? t4[i + 2] : t4[i]) + shx(b3 ? t4[i] : t4[i + 2], 8);
            float v1 = (b2 ? t2[1] : t2[0]) + shx(b2 ? t2[0] : t2[1], 4);
            v1 += shx(v1, 1); v1 += shx(v1, 2);
#pragma unroll
            for (int e = 0; e < 16; ++e) {
                const float a = __int_as_float(__builtin_amdgcn_readlane(__float_as_int(v1), 4 * e));
                scr[e] = sigm(a);
                sel[e] = scr[e] + p.router_b[e];
            }
        }
        int bg = 0; float bgs = -INFINITY;
#pragma unroll
        for (int g = 0; g < 4; ++g) {
            float m1 = -INFINITY, m2 = -INFINITY;
#pragma unroll
            for (int j = 0; j < 4; ++j) {
                const float s = sel[g * 4 + j];
                if (s > m1) { m2 = m1; m1 = s; } else if (s > m2) { m2 = s; }
            }
            const float gs = m1 + m2;
            if (gs > bgs) { bgs = gs; bg = g; }
        }
        float gsel[4], gscr[4];
#pragma unroll
        for (int j = 0; j < 4; ++j) { gsel[j] = -INFINITY; gscr[j] = 0.f; }
#pragma unroll
        for (int g = 0; g < 4; ++g)
#pragma unroll
            for (int j = 0; j < 4; ++j) if (bg == g) { gsel[j] = sel[g * 4 + j]; gscr[j] = scr[g * 4 + j]; }
        int j1 = 0; float v1 = gsel[0], w1 = gscr[0];
#pragma unroll
        for (int j = 1; j < 4; ++j) if (gsel[j] > v1) { v1 = gsel[j]; w1 = gscr[j]; j1 = j; }
        int j2 = -1; float v2 = -INFINITY, w2 = 0.f;
#pragma unroll
        for (int j = 0; j < 4; ++j) if (j != j1 && (j2 < 0 || gsel[j] > v2)) { v2 = gsel[j]; w2 = gscr[j]; j2 = j; }
        const float inv = 1.f / (w1 + w2);
        if (lane == 0) {
            const int e1 = bg * 4 + j1, e2 = bg * 4 + j2;
            const int p1 = atomicAdd(lcnt + e1, 1);
            const int p2 = atomicAdd(lcnt + e2, 1);
            rinfo[(w * 40 + kk) * 2 + 0] = e1 * 65536 + p1; rwgt[(w * 40 + kk) * 2 + 0] = w1 * inv;
            rinfo[(w * 40 + kk) * 2 + 1] = e2 * 65536 + p2; rwgt[(w * 40 + kk) * 2 + 1] = w2 * inv;
        }
    }
    __syncthreads();
    if (tid < 16) lcnt[16 + tid] = lcnt[tid] ? atomicAdd(p.cnt + l * 16 + tid, lcnt[tid]) : 0;
    __syncthreads();
    if (lane < 2) {
        int k2 = 0;
        for (int r = bid * 4 + w; r < nrows; r += nb * 4, ++k2) {
            const int inf = rinfo[(w * 40 + k2) * 2 + lane], e = inf >> 16, slot = lcnt[16 + e] + (inf & 65535);
            const float wg = rwgt[(w * 40 + k2) * 2 + lane];
            list[e * RTOT + slot] = r; slotw[e * RTOT + slot] = wg;
            tokslot[r * 2 + lane] = e * RTOT + slot; tokw[r * 2 + lane] = wg;
        }
    }
    __syncthreads();
}

template <int SH>
DEV bool moe_find_sh(const int* cnt, int ut, int& e, int& mt, int& off, int& ce) {
    int cn[16];
#pragma unroll
    for (int k = 0; k < 16; ++k) cn[k] = cnt[k];
    int tb = 0, o = 0; e = -1; mt = 0; off = 0; ce = 0;
#pragma unroll
    for (int k = 0; k < 16; ++k) {
        const int nt = (cn[k] + (1 << SH) - 1) >> SH;
        const bool hit = (e < 0) && (ut < tb + nt);
        e = hit ? k : e; mt = hit ? ut - tb : mt; off = hit ? o : off; ce = hit ? cn[k] : ce;
        tb += nt; o += cn[k];
    }
    return e >= 0;
}
DEV bool moe_find(const int* cnt, int ut, int& e, int& mt, int& off, int& ce) { return moe_find_sh<8>(cnt, ut, e, mt, off, ce); }
DEV bool moe_find128(const int* cnt, int ut, int& e, int& mt, int& off, int& ce) { return moe_find_sh<7>(cnt, ut, e, mt, off, ce); }

DEV int moe_tiles(const int* cnt, int sh) {
    int t = 0;
    for (int k = 0; k < 16; ++k) t += (cnt[k] + (1 << sh) - 1) >> sh;
    return t * 8;
}

DEV void phase_moe_up_s(const P& p, int l, int bid, int nb, u16* sm) {
    u16* sX = sm; u16* sW = sm + 128 * LDP;
    const int tid = tidx(), lane = tid & 63, w = tid >> 6, wn = w & 1, wm = w >> 1, fr = lane & 15, fq = lane >> 4;
    const int* cnt = p.cnt + l * 16;
    const int* list = (const int*)(p.cols + MOE_LIST_OFF);
    const u16* wgu = p.cols + MOE_WGU_OFF;
    u16* act = p.cols + MOE_ACT_OFF;
    const int total_ = moe_tiles(cnt, 7);
    for (int it = 0;; ++it) {
        const int u = xcd_unit(bid, nb, it, total_);
        if (u < 0) break;
        int e, mtile, off, ce;
        if (!moe_find128(cnt, u >> 3, e, mtile, off, ce)) break;
        const int n0 = (u & 7) * 128;
        const int tu = tidx();
        const u16* xp[4]; const u16* wp[4];
#pragma unroll
        for (int i = 0; i < 4; ++i) {
            const int row = g_row(tu, i), kc = g_kc(tu, row);
            int s = mtile * 128 + row; s = s < ce ? s : ce - 1;
            const int tok = list[e * RTOT + s];
            xp[i] = p.hbuf + (size_t)tok * 1024 + kc;
            wp[i] = wgu + ((size_t)e * 1024 + n0 + row) * 1024 + kc;
        }
        f32x4 acc[4][4]; zero_acc(acc);
        gemm_mainloop(acc, xp, wp, 16, sX, sW);
#pragma unroll
        for (int nt = 0; nt < 2; ++nt)
#pragma unroll
            for (int mt = 0; mt < 4; ++mt) {
                const int col = ((n0 >> 6) + wn) * 32 + nt * 16 + fq * 4;
                const int s = mtile * 128 + wm * 64 + mt * 16 + fr;
                if (s < ce) {
                    const f32x4 g = acc[nt][mt], uu = acc[nt + 2][mt];
                    u32x2 pk; pk.x = pack2(silu(g[0]) * uu[0], silu(g[1]) * uu[1]); pk.y = pack2(silu(g[2]) * uu[2], silu(g[3]) * uu[3]);
                    *(u32x2*)(act + (size_t)(off + s) * 512 + col) = pk;
                }
            }
    }
}

DEV void phase_moe_down_s(const P& p, int l, int bid, int nb, u16* sm) {
    u16* sX = sm; u16* sW = sm + 128 * LDP;
    const int tid = tidx(), lane = tid & 63, w = tid >> 6, wn = w & 1, wm = w >> 1, fr = lane & 15, fq = lane >> 4;
    const int* cnt = p.cnt + l * 16;
    const int* list = (const int*)(p.cols + MOE_LIST_OFF);
    u16* yslot = p.glaS;
    const u16* wd = p.Wd;
    const u16* act = p.cols + MOE_ACT_OFF;
    const int total_ = moe_tiles(cnt, 7);
    for (int it = 0;; ++it) {
        const int u = xcd_unit(bid, nb, it, total_);
        if (u < 0) break;
        int e, mtile, off, ce;
        if (!moe_find128(cnt, u >> 3, e, mtile, off, ce)) break;
        const int n0 = (u & 7) * 128;
        const int tu = tidx();
        const u16* xp[4]; const u16* wp[4];
#pragma unroll
        for (int i = 0; i < 4; ++i) {
            const int row = g_row(tu, i), kc = g_kc(tu, row);
            int s = mtile * 128 + row; s = s < ce ? s : ce - 1;
            xp[i] = act + (size_t)(off + s) * 512 + kc;
            wp[i] = wd + ((size_t)e * 1024 + n0 + row) * 512 + kc;
        }
        f32x4 acc[4][4]; zero_acc(acc);
        gemm_mainloop(acc, xp, wp, 8, sX, sW);
#pragma unroll
        for (int mt = 0; mt < 4; ++mt) {
            const int s = mtile * 128 + wm * 64 + mt * 16 + fr;
            if (s < ce) {
#pragma unroll
                for (int nt = 0; nt < 4; ++nt) {
                    const int n = n0 + wn * 64 + nt * 16 + fq * 4;
                    u32x2 pk; pk.x = pack2(acc[nt][mt][0], acc[nt][mt][1]); pk.y = pack2(acc[nt][mt][2], acc[nt][mt][3]);
                    *(u32x2*)(yslot + (size_t)(off + s) * 1024 + n) = pk;
                }
            }
        }
    }
}

DEV void phase_moe_up(const P& p, int l, int bid, int nb, u16* sm) {
    const int* cnt = p.cnt + l * 16;
    const int* list = (const int*)(p.cols + MOE_LIST_OFF);
    const u16* wgu = p.cols + MOE_WGU_OFF;
    u16* act = p.cols + MOE_ACT_OFF;
    const int total_ = moe_tiles(cnt, 8);
    for (int it = 0;; ++it) {
        const int u = xcd_unit(bid, nb, it, total_);
        if (u < 0) break;
        int e, mtile, off, ce;
        if (!moe_find(cnt, u >> 3, e, mtile, off, ce)) break;
        const int n0 = (u & 7) * 128;
        unsigned xo[4], wo[2];
#pragma unroll
        for (int i = 0; i < 4; ++i) {
            int row, ch; gemmB_lane(i, 4, row, ch);
            int s = mtile * 256 + row; s = s < ce ? s : ce - 1;
            xo[i] = (unsigned)(list[e * RTOT + s] * 1024 + ch);
        }
#pragma unroll
        for (int i = 0; i < 2; ++i) { int row, ch; gemmB_lane(i, 2, row, ch); wo[i] = (unsigned)(row * 1024 + ch); }
        f32x4 acc[4][8];
        gemmB_mainloop(acc, p.hbuf, xo, wgu + ((size_t)e * 1024 + n0) * 1024, wo, 32, sm);
        const int t2 = tidx(), l2 = t2 & 63, w2 = t2 >> 6;
        const int lc = (w2 & 1) * 32 + (l2 >> 4) * 4, lm = (w2 >> 1) * 128 + (l2 & 15);
#pragma unroll
        for (int nt = 0; nt < 2; ++nt)
#pragma unroll
            for (int mt = 0; mt < 8; ++mt) {
                const f32x4 g = acc[nt][mt], uu = acc[nt + 2][mt];
                u32x2 pk; pk.x = pack2(silu(g[0]) * uu[0], silu(g[1]) * uu[1]); pk.y = pack2(silu(g[2]) * uu[2], silu(g[3]) * uu[3]);
                *(u32x2*)(sm + (lm + mt * 16) * 72 + lc + nt * 16) = pk;
            }
        __syncthreads();
#pragma unroll
        for (int i = 0; i < 8; ++i) {
            const int id = t2 + i * 256, row = id >> 3, cc = id & 7, s = mtile * 256 + row;
            const u32x4 v = *(const u32x4*)(sm + row * 72 + cc * 8);
            if (s < ce) *(u32x4*)(act + (size_t)(off + s) * 512 + (n0 >> 1) + cc * 8) = v;
        }
        __syncthreads();
    }
}

DEV void phase_moe_down(const P& p, int l, int bid, int nb, u16* sm) {
    const int* cnt = p.cnt + l * 16;
    u16* yslot = p.glaS;
    const u16* wd = p.Wd;
    const u16* act = p.cols + MOE_ACT_OFF;
    const int total_ = moe_tiles(cnt, 8);
    for (int it = 0;; ++it) {
        const int u = xcd_unit(bid, nb, it, total_);
        if (u < 0) break;
        int e, mtile, off, ce;
        if (!moe_find(cnt, u >> 3, e, mtile, off, ce)) break;
        const int n0 = (u & 7) * 128;
        unsigned xo[4], wo[2];
#pragma unroll
        for (int i = 0; i < 4; ++i) {
            int row, ch; gemmB_lane(i, 4, row, ch);
            int s = mtile * 256 + row; s = s < ce ? s : ce - 1;
            xo[i] = (unsigned)((off + s) * 512 + ch);
        }
#pragma unroll
        for (int i = 0; i < 2; ++i) { int row, ch; gemmB_lane(i, 2, row, ch); wo[i] = (unsigned)(row * 512 + ch); }
        f32x4 acc[4][8];
        gemmB_mainloop(acc, act, xo, wd + ((size_t)e * 1024 + n0) * 512, wo, 16, sm);
        const int t2 = tidx(), l2 = t2 & 63, w2 = t2 >> 6;
        const int ln = (w2 & 1) * 64 + (l2 >> 4) * 4, lm = (w2 >> 1) * 128 + (l2 & 15);
#pragma unroll
        for (int nt = 0; nt < 4; ++nt)
#pragma unroll
            for (int mt = 0; mt < 8; ++mt) {
                u32x2 pk; pk.x = pack2(acc[nt][mt][0], acc[nt][mt][1]); pk.y = pack2(acc[nt][mt][2], acc[nt][mt][3]);
                *(u32x2*)(sm + (lm + mt * 16) * 136 + ln + nt * 16) = pk;
            }
        __syncthreads();
#pragma unroll
        for (int i = 0; i < 16; ++i) {
            const int id = t2 + i * 256, row = id >> 4, cc = id & 15, s = mtile * 256 + row;
            const u32x4 v = *(const u32x4*)(sm + row * 136 + cc * 8);
            if (s < ce) *(u32x4*)(yslot + (size_t)(off + s) * 1024 + n0 + cc * 8) = v;
        }
        __syncthreads();
    }
}

DEV void moe_combine_row(const P& p, const int (&cnt)[16], int r, int lane, const float4 (&g2c)[4], float4 (&v)[4]) {
    const int* list = (const int*)(p.cols + MOE_LIST_OFF);
    const int* tokslot = (const int*)((const float*)(list + 16 * RTOT) + 16 * RTOT);
    const float* tokw = (const float*)(tokslot + 2 * RTOT);
    const u16* yslot = p.glaS;
#pragma unroll
    for (int j = 0; j < 2; ++j) {
        const int ts = tokslot[r * 2 + j], e = ts / RTOT, slot = ts % RTOT;
        const float wg = tokw[r * 2 + j];
        int off = 0;
#pragma unroll
        for (int k = 0; k < 15; ++k) off += cnt[k] & -(int)(k < e);
        const u16* yr = yslot + (size_t)(off + slot) * 1024;
#pragma unroll
        for (int i = 0; i < 4; ++i) {
            const int c = lane * 4 + i * 256;
            const u32x2 yv = *(const u32x2*)(yr + c);
            const float4 g = g2c[i];
            v[i].x += g.x * wg * __uint_as_float(yv.x << 16); v[i].y += g.y * wg * __uint_as_float(yv.x & 0xffff0000u);
            v[i].z += g.z * wg * __uint_as_float(yv.y << 16); v[i].w += g.w * wg * __uint_as_float(yv.y & 0xffff0000u);
        }
    }
}

DEV void phase_final_norm(const P& p, int bid, int nb) {
    const int lane = tidx() & 63, w = tidx() >> 6;
    float4 nf[4], g2c[4]; int mcur = -1;
    int cn[16];
#pragma unroll
    for (int k = 0; k < 16; ++k) cn[k] = p.cnt[16 + k];
#pragma unroll
    for (int i = 0; i < 4; ++i) nf[i] = *(const float4*)(p.norm_final + lane * 4 + i * 256);
    for (int r = bid * 4 + w; r < RLAT; r += nb * 4) {
        if (modidx(r) != mcur) {
            mcur = modidx(r);
#pragma unroll
            for (int i = 0; i < 4; ++i) g2c[i] = *(const float4*)(p.mod + (size_t)(1 * 3 + mcur) * 6144 + 5120 + lane * 4 + i * 256);
        }
        float* xr = p.out + (size_t)r * DM;
        float4 v[4]; float ss = 0.f;
#pragma unroll
        for (int i = 0; i < 4; ++i) { const f32x4 t_ = __builtin_nontemporal_load((const f32x4*)(xr + lane * 4 + i * 256)); v[i].x = t_[0]; v[i].y = t_[1]; v[i].z = t_[2]; v[i].w = t_[3]; }
        moe_combine_row(p, cn, r, lane, g2c, v);
#pragma unroll
        for (int i = 0; i < 4; ++i) ss += v[i].x * v[i].x + v[i].y * v[i].y + v[i].z * v[i].z + v[i].w * v[i].w;
        ss = wsum(ss);
        const float rs = rsqrtf(ss * (1.f / 1024.f) + EPSF);
#pragma unroll
        for (int i = 0; i < 4; ++i) {
            const int c = lane * 4 + i * 256;
            const float4 g = nf[i];
            float4 o; o.x = v[i].x * rs * g.x; o.y = v[i].y * rs * g.y; o.z = v[i].z * rs * g.z; o.w = v[i].w * rs * g.w;
            { f32x4 o_; o_[0] = o.x; o_[1] = o.y; o_[2] = o.z; o_[3] = o.w; __builtin_nontemporal_store(o_, (f32x4*)(xr + c)); }
        }
    }
}
DEV float wscan_add(float v, int  ) { return wscan_add_dpp(v); }
DEV float wscan_max(float v, int  ) { return wscan_max_dpp(v); }
DEV void mm64(f32x4 (&acc)[4], const u16* A, int lda, const u16* Bt, int ldb) {
    const int lane = tidx() & 63, w = tidx() >> 6, fr = lane & 15, fq = lane >> 4;
#pragma unroll
    for (int ks = 0; ks < 2; ++ks) {
        const bf16x8 a = *(const bf16x8*)(A + (16 * w + fr) * lda + ks * 32 + fq * 8);
#pragma unroll
        for (int nt = 0; nt < 4; ++nt) {
            const bf16x8 b = *(const bf16x8*)(Bt + (nt * 16 + fr) * ldb + ks * 32 + fq * 8);
            acc[nt] = mfma16(a, b, acc[nt]);
        }
    }
}
DEV void mm64_pre(f32x4 (&acc)[4], const u16* A, int lda, const bf16x8 (&bf)[2][4]) {
    const int lane = tidx() & 63, w = tidx() >> 6, fr = lane & 15, fq = lane >> 4;
#pragma unroll
    for (int ks = 0; ks < 2; ++ks) {
        const bf16x8 a = *(const bf16x8*)(A + (16 * w + fr) * lda + ks * 32 + fq * 8);
#pragma unroll
        for (int nt = 0; nt < 4; ++nt) acc[nt] = mfma16(a, bf[ks][nt], acc[nt]);
    }
}
DEV void ldB64(bf16x8 (&bf)[2][4], const u16* Bt) {
    const int lane = tidx() & 63, fr = lane & 15, fq = lane >> 4;
#pragma unroll
    for (int ks = 0; ks < 2; ++ks)
#pragma unroll
        for (int nt = 0; nt < 4; ++nt) bf[ks][nt] = *(const bf16x8*)(Bt + (nt * 16 + fr) * 64 + ks * 32 + fq * 8);
}
struct Raw16 { u32x4 a, b; };
DEV Raw16 ldraw16(const u16* p) { Raw16 r; r.a = *(const u32x4*)p; r.b = *(const u32x4*)(p + 8); return r; }
DEV void unraw16(const Raw16& r, float (&o)[16]) {
    const unsigned w[8] = {r.a.x, r.a.y, r.a.z, r.a.w, r.b.x, r.b.y, r.b.z, r.b.w};
#pragma unroll
    for (int i = 0; i < 8; ++i) { o[2 * i] = __uint_as_float(w[i] << 16); o[2 * i + 1] = __uint_as_float(w[i] & 0xffff0000u); }
}
DEV void zero4(f32x4 (&acc)[4]) {
#pragma unroll
    for (int i = 0; i < 4; ++i) acc[i] = f32x4{0.f, 0.f, 0.f, 0.f};
}
DEV void ld16bf(const u16* p, float (&o)[16]) {
    const u32x4 a = *(const u32x4*)p, b = *(const u32x4*)(p + 8);
    const unsigned w[8] = {a.x, a.y, a.z, a.w, b.x, b.y, b.z, b.w};
#pragma unroll
    for (int i = 0; i < 8; ++i) { o[2 * i] = __uint_as_float(w[i] << 16); o[2 * i + 1] = __uint_as_float(w[i] & 0xffff0000u); }
}
DEV void st16bf(u16* p, const float (&v)[16]) {
    u32x4 a, b;
    a.x = pack2(v[0], v[1]); a.y = pack2(v[2], v[3]); a.z = pack2(v[4], v[5]); a.w = pack2(v[6], v[7]);
    b.x = pack2(v[8], v[9]); b.y = pack2(v[10], v[11]); b.z = pack2(v[12], v[13]); b.w = pack2(v[14], v[15]);
    *(u32x4*)p = a; *(u32x4*)(p + 8) = b;
}

DEV void phase_rope_table(const P& p, int bid, int nb) {
    for (int i = bid * NTHR + tidx(); i < 192 * 8; i += nb * NTHR) {
        const int e = i >> 3, f = i & 7;
        const float inv = expf(-(float)(2 * f) * (1.f / 16.f) * 9.210340371976184f);
        const float pos = (float)(e < 128 ? e : e - 128);
        const float ang = pos * inv;
        p.rope[2 * i] = cosf(ang); p.rope[2 * i + 1] = sinf(ang);
    }
}
DEV void row_geom(int r, int& b, int& t, int& T, int& pos, bool& lat) {
    lat = r < RLAT;
    if (lat) { b = r >> 13; t = r & (SEQ - 1); T = SEQ; pos = CTXL + t; }
    else { const int q = r - RLAT; b = q >> 8; t = q & (CTXL - 1); T = CTXL; pos = t; }
}
DEV void phase_prep(const P& p, int l, u16* gqkv, int bid, int nb, u16* sm) {
    const int tid = tidx();
    if (tid < 192) {
        const int cg = tid % 96, rsub = tid / 96;
        float4 w0[5], w1[5];
#pragma unroll
        for (int j = 0; j < 5; ++j) {
            w0[j] = *(const float4*)(p.gdn_conv + (l * 5 + j) * 768 + cg * 8);
            w1[j] = *(const float4*)(p.gdn_conv + (l * 5 + j) * 768 + cg * 8 + 4);
        }
        for (int r = bid * 2 + rsub; r < RTOT; r += nb * 2) {
            int b, t, T, pos; bool lat; row_geom(r, b, t, T, pos, lat);
            u32x4 xv[5]; float msk[5];
#pragma unroll
            for (int j = 0; j < 5; ++j) {
                const int tt = t + j - 2;
                const bool ok = tt >= 0 && tt < T;
                xv[j] = *(const u32x4*)(p.cols + (size_t)(ok ? r + j - 2 : r) * NCM + GD_Q + cg * 8);
                msk[j] = ok ? 1.f : 0.f;
            }
            float a[8];
#pragma unroll
            for (int i = 0; i < 8; ++i) a[i] = 0.f;
#pragma unroll
            for (int j = 0; j < 5; ++j) {
                const u32x4 x = xv[j]; const float m = msk[j];
                a[0] += __uint_as_float(x.x << 16) * (w0[j].x * m); a[1] += __uint_as_float(x.x & 0xffff0000u) * (w0[j].y * m);
                a[2] += __uint_as_float(x.y << 16) * (w0[j].z * m); a[3] += __uint_as_float(x.y & 0xffff0000u) * (w0[j].w * m);
                a[4] += __uint_as_float(x.z << 16) * (w1[j].x * m); a[5] += __uint_as_float(x.z & 0xffff0000u) * (w1[j].y * m);
                a[6] += __uint_as_float(x.w << 16) * (w1[j].z * m); a[7] += __uint_as_float(x.w & 0xffff0000u) * (w1[j].w * m);
            }
            float ss = 0.f;
#pragma unroll
            for (int i = 0; i < 8; ++i) { a[i] = silu(a[i]); ss += a[i] * a[i]; }
            ss += shx(ss, 1); ss += shx(ss, 2); ss += shx(ss, 4);
            float sc = 1.f;
            if (cg < 64) sc = rsqrtf(ss + EPSF) * (cg < 32 ? 0.125f : 1.f);
            u32x4 o;
            o.x = pack2(a[0] * sc, a[1] * sc); o.y = pack2(a[2] * sc, a[3] * sc); o.z = pack2(a[4] * sc, a[5] * sc); o.w = pack2(a[6] * sc, a[7] * sc);
            *(u32x4*)(gqkv + (size_t)r * 768 + cg * 8) = o;
        }
    }
    int* lmx = (int*)(sm + 64 * 72);
    if (tid < 16) lmx[tid] = 0;
    __syncthreads();
    for (int id = bid * NTHR + tid; id < RTOT * 32; id += nb * NTHR) {
        const int c = id & 1, half = (id >> 1) & 1, h = (id >> 2) & 3, qk = (id >> 4) & 1, r = id >> 5;
        int b, t, T, pos; bool lat; row_geom(r, b, t, T, pos, lat);
        const u16* src = p.cols + (size_t)r * NCM + (qk ? DF_K : DF_Q) + h * 64 + half * 32 + c * 8;
        const u32x4 v1 = *(const u32x4*)src, v2 = *(const u32x4*)(src + 16);
        const unsigned w1[4] = {v1.x, v1.y, v1.z, v1.w}, w2[4] = {v2.x, v2.y, v2.z, v2.w};
        float x1[8], x2[8], o1[8], o2[8];
#pragma unroll
        for (int i = 0; i < 4; ++i) {
            x1[2 * i] = __uint_as_float(w1[i] << 16); x1[2 * i + 1] = __uint_as_float(w1[i] & 0xffff0000u);
            x2[2 * i] = __uint_as_float(w2[i] << 16); x2[2 * i + 1] = __uint_as_float(w2[i] & 0xffff0000u);
        }
        const float qs = qk ? 1.f : (0.17677669529663687f * 1.4426950408889634f);
        const float* tb = p.rope + (size_t)(lat ? (c == 0 ? (t >> 6) : 128 + (t & 63)) : 0) * 16;
#pragma unroll
        for (int i = 0; i < 8; ++i) {
            const float cs = tb[2 * i], sn = tb[2 * i + 1];
            o1[i] = (x1[i] * cs - x2[i] * sn) * qs; o2[i] = (x1[i] * sn + x2[i] * cs) * qs;
        }
        {
            float ss = 0.f;
#pragma unroll
            for (int i = 0; i < 8; ++i) ss += o1[i] * o1[i] + o2[i] * o2[i];
            ss += shx(ss, 1);
            if (qk && c == 0) atomicMax(lmx + (b * 4 + h) * 2 + half, __float_as_int(ss));
        }
        u16* dst = (qk ? p.dk : p.dq) + ((size_t)(b * 4 + h) * KPOS + pos) * 64 + half * 32 + c * 8;
        u32x4 a1, a2;
        a1.x = pack2(o1[0], o1[1]); a1.y = pack2(o1[2], o1[3]); a1.z = pack2(o1[4], o1[5]); a1.w = pack2(o1[6], o1[7]);
        a2.x = pack2(o2[0], o2[1]); a2.y = pack2(o2[2], o2[3]); a2.z = pack2(o2[4], o2[5]); a2.w = pack2(o2[6], o2[7]);
        *(u32x4*)dst = a1; *(u32x4*)(dst + 16) = a2;
    }
    __syncthreads();
    if (tid < 16 && lmx[tid] > 0) atomicMax(p.cnt + 192 + l * 16 + tid, lmx[tid]);
    {
        auto geom = [&](int u, int& b, int& h, int& r0, int& pos0) {
            const int g = u >> 2; h = u & 3;
            if (g < 256) { b = g >> 7; const int t0 = (g & 127) * 64; r0 = b * SEQ + t0; pos0 = CTXL + t0; }
            else { const int q = g - 256; b = q >> 2; const int t0 = (q & 3) * 64; r0 = RLAT + b * CTXL + t0; pos0 = t0; }
        };
        const int s = tid >> 2, dg = tid & 3;
        int u = bid;
        u32x4 a = u32x4{0u, 0u, 0u, 0u}, c = a;
        if (u < 264 * 4) {
            int b, h, r0, pos0; geom(u, b, h, r0, pos0);
            a = *(const u32x4*)(p.cols + (size_t)(r0 + s) * NCM + DF_V + h * 64 + dg * 16);
            c = *(const u32x4*)(p.cols + (size_t)(r0 + s) * NCM + DF_V + h * 64 + dg * 16 + 8);
        }
        for (; u < 264 * 4; u += nb) {
            int b, h, r0, pos0; geom(u, b, h, r0, pos0);
            u32x4 an = a, cn = c;
            if (u + nb < 264 * 4) {
                int b2, h2, r2, p2; geom(u + nb, b2, h2, r2, p2);
                an = *(const u32x4*)(p.cols + (size_t)(r2 + s) * NCM + DF_V + h2 * 64 + dg * 16);
                cn = *(const u32x4*)(p.cols + (size_t)(r2 + s) * NCM + DF_V + h2 * 64 + dg * 16 + 8);
            }
            __syncthreads();
            {
                const unsigned wv[8] = {a.x, a.y, a.z, a.w, c.x, c.y, c.z, c.w};
#pragma unroll
                for (int k = 0; k < 8; ++k) {
                    sm[(dg * 16 + 2 * k) * 72 + s] = (u16)(wv[k] & 0xffff);
                    sm[(dg * 16 + 2 * k + 1) * 72 + s] = (u16)(wv[k] >> 16);
                }
            }
            __syncthreads();
            {
                const int dv = tid >> 2, sg = tid & 3, grp = (sg >> 1) * 32, q0 = (sg & 1) * 2;
                const u16* src = sm + dv * 72 + grp;
                const u32x2 a0 = *(const u32x2*)(src + 4 * q0), a1 = *(const u32x2*)(src + 16 + 4 * q0);
                const u32x2 c0 = *(const u32x2*)(src + 4 * q0 + 4), c1 = *(const u32x2*)(src + 16 + 4 * q0 + 4);
                u32x4 oa, oc;
                oa.x = a0.x; oa.y = a0.y; oa.z = a1.x; oa.w = a1.y;
                oc.x = c0.x; oc.y = c0.y; oc.z = c1.x; oc.w = c1.y;
                u16* o = p.dvT + ((size_t)(b * 4 + h) * 64 + dv) * KPOS + pos0 + sg * 16;
                *(u32x4*)o = oa; *(u32x4*)(o + 8) = oc;
            }
            a = an; c = cn;
        }
    }
    __syncthreads();
}
#define TILE_B (64 * LDP * 2)

struct GlaCumIn { float bv[4][4]; float abv[4]; u32x2 rv; };
DEV void gla_cum_load(const P& p, int l, int dir, int h, int row0, GlaCumIn& in) {
    const int tid = tidx(), lane = tid & 63, fr = lane & 15, kq = lane >> 4;
#pragma unroll
    for (int nt = 0; nt < 4; ++nt) {
#pragma unroll
        for (int ks = 0; ks < 4; ++ks) in.bv[nt][ks] = p.gla_a2[((size_t)(l * 2 + dir) * 16 + 4 * ks + kq) * 256 + h * 64 + 16 * nt + fr];
        in.abv[nt] = p.gla_ab[(l * 2 + dir) * 256 + h * 64 + 16 * nt + fr];
    }
    const int s = tid >> 2, q4 = tid & 3, row = row0 + (dir ? 63 - s : s);
    in.rv = *(const u32x2*)(p.cols + (size_t)row * NCM + GLA_RF + dir * 16 + q4 * 4);
}
DEV void gla_cum_run(const GlaCumIn& in, float* cum, float* rt, float* sg) {
    const int tid = tidx(), lane = tid & 63, w = tid >> 6, fr = lane & 15, kq = lane >> 4;
    {
        const int s = tid >> 2, q4 = tid & 3;
        const u32x2 v = in.rv;
        rt[s * 17 + q4 * 4 + 0] = __uint_as_float(v.x << 16); rt[s * 17 + q4 * 4 + 1] = __uint_as_float(v.x & 0xffff0000u);
        rt[s * 17 + q4 * 4 + 2] = __uint_as_float(v.y << 16); rt[s * 17 + q4 * 4 + 3] = __uint_as_float(v.y & 0xffff0000u);
    }
    __syncthreads();
    f32x4 x[4];
#pragma unroll
    for (int nt = 0; nt < 4; ++nt) x[nt] = f32x4{in.abv[nt], in.abv[nt], in.abv[nt], in.abv[nt]};
#pragma unroll
    for (int ks = 0; ks < 4; ++ks) {
        const float av = rt[(16 * w + fr) * 17 + 4 * ks + kq];
#pragma unroll
        for (int nt = 0; nt < 4; ++nt) x[nt] = __builtin_amdgcn_mfma_f32_16x16x4f32(av, in.bv[nt][ks], x[nt], 0, 0, 0);
    }
    float pre[4];
#pragma unroll
    for (int nt = 0; nt < 4; ++nt) {
        float run = 0.f;
#pragma unroll
        for (int j = 0; j < 4; ++j) { run += logsig(x[nt][j]) * (1.f / 16.f); x[nt][j] = run; }
        float v = run;
        const float t1 = shup(v, 16); v += (lane >= 16) ? t1 : 0.f;
        const float t2 = shup(v, 32); v += (lane >= 32) ? t2 : 0.f;
        pre[nt] = v - run;
        if (kq == 3) sg[w * 64 + 16 * nt + fr] = v;
    }
    __syncthreads();
#pragma unroll
    for (int nt = 0; nt < 4; ++nt) {
        float off = pre[nt];
        for (int k = 0; k < w; ++k) off += sg[k * 64 + 16 * nt + fr];
#pragma unroll
        for (int j = 0; j < 4; ++j) cum[(16 * w + 4 * kq + j) * 65 + 16 * nt + fr] = x[nt][j] + off;
    }
    __syncthreads();
}
DEV void gla_cum(const P& p, int l, int dir, int h, int row0, float* cum, float* rt, float* sg) {
    GlaCumIn in;
    gla_cum_load(p, l, dir, h, row0, in);
    gla_cum_run(in, cum, rt, sg);
}

struct GlaAIn { Raw16 k, v; GlaCumIn c; };
DEV void gla_a_load(const P& p, int l, int dir, int b, int st, int h, GlaAIn& in) {
    const int tid = tidx(), s = tid >> 2, dg = tid & 3;
    const int row0 = chunk_row0(b, dir, st), row = row0 + (dir ? 63 - s : s);
    in.k = ldraw16(p.cols + (size_t)row * NCM + GLA_K + h * 64 + dg * 16);
    in.v = ldraw16(p.cols + (size_t)row * NCM + GLA_V + h * 64 + dg * 16);
    gla_cum_load(p, l, dir, h, row0, in.c);
}
DEV void gla_a_run(const P& p, int l, const GlaAIn& in, int dir, int b, int st, int h, unsigned char* smraw) {
    float* cum = (float*)smraw;
    float* rt = cum + 64 * 65;
    float* sg = rt + 64 * 17;
    u16* kwT = (u16*)(sg + 256);
    u16* vT = kwT + 64 * LDP;
    const int tid = tidx(), lane = tid & 63, w = tid >> 6, fr = lane & 15, fq = lane >> 4;
    const int row0 = chunk_row0(b, dir, st);
    const size_t idx = state_idx(dir, b, st, h);
    gla_cum_run(in.c, cum, rt, sg);
    {
        const int s = tid >> 2, dg = tid & 3;
        float kk[16], vv[16];
        unraw16(in.k, kk); unraw16(in.v, vv);
#pragma unroll
        for (int i = 0; i < 16; ++i) {
            const int d = dg * 16 + i;
            kwT[d * LDP + s] = f2bf(kk[i] * __expf(cum[63 * 65 + d] - cum[s * 65 + d]));
            vT[d * LDP + s] = f2bf(vv[i]);
        }
        if (tid < 64) p.glaDec[idx * 64 + tid] = __expf(cum[63 * 65 + tid]);
    }
    __syncthreads();
    f32x4 acc[4]; zero4(acc);
    mm64(acc, kwT, LDP, vT, LDP);
#pragma unroll
    for (int nt = 0; nt < 4; ++nt) {
        const int d = 16 * w + fq * 4, e = nt * 16 + fr;
        u32x2 pk; pk.x = pack2(acc[nt][0], acc[nt][1]); pk.y = pack2(acc[nt][2], acc[nt][3]);
        *(u32x2*)(p.glaS + idx * 4096 + e * 64 + d) = pk;
    }
    __syncthreads();
}

struct MlAIn { Raw16 k, v; u16 g0, g1; float gb0, gb1; };
DEV void ml_a_load(const P& p, int l, int dir, int b, int st, int h, MlAIn& in) {
    const int tid = tidx(), lane = tid & 63, s = tid >> 2, dg = tid & 3;
    const int row0 = chunk_row0(b, dir, st), row = row0 + (dir ? 63 - s : s);
    in.k = ldraw16(p.cols + (size_t)row * NCM + ML_K + h * 64 + dg * 16);
    in.v = ldraw16(p.cols + (size_t)row * NCM + ML_V + h * 64 + dg * 16);
    const int grow = row0 + (dir ? 63 - lane : lane);
    in.g0 = p.cols[(size_t)grow * NCM + ML_GF + dir * 8 + h];
    in.g1 = p.cols[(size_t)grow * NCM + ML_GF + dir * 8 + 4 + h];
    in.gb0 = p.mlstm_gate_b[((l * 2 + dir) * 2 + 0) * 4 + h];
    in.gb1 = p.mlstm_gate_b[((l * 2 + dir) * 2 + 1) * 4 + h];
}
DEV void ml_a_run(const P& p, int l, const MlAIn& in, int dir, int b, int st, int h, unsigned char* smraw) {
    float* wend = (float*)smraw;
    u16* kwT = (u16*)(wend + 64);
    u16* vT = kwT + 64 * LDP;
    const int tid = tidx(), lane = tid & 63, w = tid >> 6, fr = lane & 15, fq = lane >> 4;
    const int row0 = chunk_row0(b, dir, st);
    const size_t idx = state_idx(dir, b, st, h);
    if (w == 0) {
        const float ip = bf2f(in.g0) + in.gb0;
        const float lf = logsig(bf2f(in.g1) + in.gb1);
        const float fc = wscan_add(lf, lane);
        const float fe = shidx(fc, 63);
        const float lw = fe - fc + ip;
        const float ae = wmaxr(lw);
        wend[lane] = __expf(lw - ae);
        if (lane == 0) { p.mlFE[idx] = fe; p.mlAE[idx] = ae; }
    }
    __syncthreads();
    {
        const int s = tid >> 2, dg = tid & 3;
        float kk[16], vv[16];
        unraw16(in.k, kk); unraw16(in.v, vv);
        const float ws = wend[s] * 0.125f;
#pragma unroll
        for (int i = 0; i < 16; ++i) {
            const int d = dg * 16 + i;
            kwT[d * LDP + s] = f2bf(kk[i] * ws);
            vT[d * LDP + s] = f2bf(vv[i]);
        }
    }
    __syncthreads();
    if (tid < 64) {
        float a = 0.f;
        for (int s = 0; s < 64; ++s) a += bf2f(kwT[tid * LDP + s]);
        p.mlN[idx * 64 + tid] = a;
    }
    f32x4 acc[4]; zero4(acc);
    mm64(acc, kwT, LDP, vT, LDP);
#pragma unroll
    for (int nt = 0; nt < 4; ++nt) {
        const int d = 16 * w + fq * 4, e = nt * 16 + fr;
        u32x2 pk; pk.x = pack2(acc[nt][0], acc[nt][1]); pk.y = pack2(acc[nt][2], acc[nt][3]);
        *(u32x2*)(p.mlS + idx * 4096 + e * 64 + d) = pk;
    }
    __syncthreads();
}

struct GdAIn { u32x4 q0, q1, k0, k1, v0, v1; u32x2 qpre[4]; u16 gb, ga; float alog, dtb; };
DEV void gd_a_load(const P& p, int l, const u16* gqkv, int dir, int b, int st, int h, GdAIn& in) {
    const int tid = tidx(), lane = tid & 63, w = tid >> 6, fr = lane & 15, fq = lane >> 4;
    const int row0 = chunk_row0(b, dir, st);
    {
        const int row = row0 + (dir ? 63 - lane : lane);
        in.gb = p.cols[(size_t)row * NCM + GD_GF + dir * 8 + h];
        in.ga = p.cols[(size_t)row * NCM + GD_GF + dir * 8 + 4 + h];
        in.alog = p.gdn_a_log[(l * 2 + dir) * 4 + h]; in.dtb = p.gdn_dt_bias[(l * 2 + dir) * 4 + h];
    }
    {
        const int s = tid >> 2, dg = tid & 3, row = row0 + (dir ? 63 - s : s);
        const u16* src = gqkv + (size_t)row * 768 + h * 64 + dg * 16;
        in.q0 = *(const u32x4*)src; in.q1 = *(const u32x4*)(src + 8);
        in.k0 = *(const u32x4*)(src + 256); in.k1 = *(const u32x4*)(src + 264);
        in.v0 = *(const u32x4*)(src + 512); in.v1 = *(const u32x4*)(src + 520);
    }
#pragma unroll
    for (int nt = 0; nt < 4; ++nt) {
        const int c = nt * 16 + fr, row = row0 + (dir ? 63 - c : c);
        in.qpre[nt] = *(const u32x2*)(gqkv + (size_t)row * 768 + h * 64 + 16 * w + fq * 4);
    }
}
DEV void gd_a_run(const P& p, int l, const GdAIn& in, int dir, int b, int st, int h, unsigned char* smraw) {
    float* X = (float*)smraw;
    float* cum = X + 64 * 65 + 32;
    float* beta = cum + 64;
    float* be = beta + 64;
    float* ke = be + 64;
    float* scal = ke + 64;
    u16* Y0 = (u16*)(scal + 64);
    u16* Y1 = Y0 + 64 * LDP;
    u16* Y2 = Y1 + 64 * LDP;
    u16* Y3 = Y2 + 64 * LDP;
    u16* Y4 = Y3 + 64 * LDP;
    u16* Y5 = Y4 + 64 * LDP;
    const int tid = tidx(), lane = tid & 63, w = tid >> 6, fr = lane & 15, fq = lane >> 4;
    PRB_BEGIN(130);
    const int row0 = chunk_row0(b, dir, st);
    const size_t idx = state_idx(dir, b, st, h);
    if (w == 0) {
        const float bp = bf2f(in.gb);
        const float ap = bf2f(in.ga);
        const float bt = sigm(bp);
        const float g = -__expf(in.alog) * softplus(ap + in.dtb);
        const float cm = wscan_add(g, lane);
        const float ce = shidx(cm, 63);
        cum[lane] = cm; beta[lane] = bt; be[lane] = bt * __expf(cm); ke[lane] = __expf(ce - cm);
        if (lane == 0) scal[0] = __expf(ce);
    }
    {
        const int s = tid >> 2, dg = tid & 3;
        const u32x4 q0 = in.q0, q1 = in.q1, k0 = in.k0, k1 = in.k1, v0 = in.v0, v1 = in.v1;
        *(u32x4*)(Y0 + s * LDP + dg * 16) = q0; *(u32x4*)(Y0 + s * LDP + dg * 16 + 8) = q1;
        *(u32x4*)(Y1 + s * LDP + dg * 16) = k0; *(u32x4*)(Y1 + s * LDP + dg * 16 + 8) = k1;
        const unsigned kw[8] = {k0.x, k0.y, k0.z, k0.w, k1.x, k1.y, k1.z, k1.w};
        const unsigned vw[8] = {v0.x, v0.y, v0.z, v0.w, v1.x, v1.y, v1.z, v1.w};
#pragma unroll
        for (int i = 0; i < 8; ++i) {
            Y2[(dg * 16 + 2 * i) * LDP + s] = (u16)(kw[i] & 0xffff); Y2[(dg * 16 + 2 * i + 1) * LDP + s] = (u16)(kw[i] >> 16);
            Y3[(dg * 16 + 2 * i) * LDP + s] = (u16)(vw[i] & 0xffff); Y3[(dg * 16 + 2 * i + 1) * LDP + s] = (u16)(vw[i] >> 16);
        }
    }
    __syncthreads();
    PRB_END(130);
    PRB_BEGIN(135);
    u32x2 qpre[4];
#pragma unroll
    for (int nt = 0; nt < 4; ++nt) qpre[nt] = in.qpre[nt];
    {
        f32x4 kk[4], qk[4]; zero4(kk); zero4(qk);
        mm64(kk, Y1, LDP, Y1, LDP);
        mm64(qk, Y0, LDP, Y1, LDP);
        float cc[4], bc[4], cs[4];
#pragma unroll
        for (int j = 0; j < 4; ++j) { cc[j] = cum[16 * w + fq * 4 + j]; bc[j] = beta[16 * w + fq * 4 + j]; cs[j] = cum[j * 16 + fr]; }
#pragma unroll
        for (int nt = 0; nt < 4; ++nt)
#pragma unroll
            for (int j = 0; j < 4; ++j) {
                const int c = 16 * w + fq * 4 + j, s = nt * 16 + fr;
                const float ex = __expf(fminf(cc[j] - cs[nt], 0.f));
                X[c * 65 + s] = bc[j] * kk[nt][j] * ex * (s < c ? 1.f : 0.f);
                Y4[c * LDP + s] = f2bf(qk[nt][j] * ex * (s <= c ? 1.f : 0.f));
            }
    }
    __syncthreads();
    PRB_END(135);
    PRB_BEGIN(136);
    float* T = (float*)Y0;
    {
        float* Qb = (float*)Y5;
        for (int e = tid; e < 6 * 256; e += NTHR) {
            const int q = e >> 8, r = (e >> 4) & 15, c = e & 15;
            const int ib = q < 3 ? 0 : (q < 5 ? 1 : 2), jb = q < 3 ? q + 1 : (q < 5 ? q - 1 : 3);
            T[(16 * ib + r) * 65 + 16 * jb + c] = 0.f;
        }
        if (tid < 64) {
            const int blk = tid >> 4, col = tid & 15, base = blk * 16;
            float xr[120];
#pragma unroll
            for (int r = 1; r < 16; ++r)
#pragma unroll
                for (int s2 = 0; s2 < r; ++s2) xr[r * (r - 1) / 2 + s2] = X[(base + r) * 65 + base + s2];
            __builtin_amdgcn_sched_barrier(0);
            float tc[16];
#pragma unroll
            for (int r = 0; r < 16; ++r) tc[r] = (r == col) ? 1.f : 0.f;
#pragma unroll
            for (int r = 1; r < 16; ++r) {
                float a = 0.f;
#pragma unroll
                for (int s2 = 0; s2 < r; ++s2) a += xr[r * (r - 1) / 2 + s2] * tc[s2];
                tc[r] -= (r > col ? 1.f : 0.f) * (a + tc[r]);
            }
#pragma unroll
            for (int r = 0; r < 16; ++r) T[(base + r) * 65 + base + col] = tc[r];
        }
        __syncthreads();
        const int wu = __builtin_amdgcn_readfirstlane(w), fr16 = lane & 15, kq = lane >> 4;
        if (wu < 2) {
            const int lo = 32 * wu, hi = lo + 16;
            f32x4 acc = f32x4{0.f, 0.f, 0.f, 0.f};
#pragma unroll
            for (int s4 = 0; s4 < 4; ++s4)
                acc = __builtin_amdgcn_mfma_f32_16x16x4f32(X[(hi + fr16) * 65 + lo + 4 * s4 + kq], T[(lo + 4 * s4 + kq) * 65 + lo + fr16], acc, 0, 0, 0);
#pragma unroll
            for (int j = 0; j < 4; ++j) Qb[(16 * wu + 4 * kq + j) * 33 + fr16] = acc[j];
            acc = f32x4{0.f, 0.f, 0.f, 0.f};
#pragma unroll
            for (int s4 = 0; s4 < 4; ++s4)
                acc = __builtin_amdgcn_mfma_f32_16x16x4f32(T[(hi + fr16) * 65 + hi + 4 * s4 + kq], Qb[(16 * wu + 4 * s4 + kq) * 33 + fr16], acc, 0, 0, 0);
#pragma unroll
            for (int j = 0; j < 4; ++j) T[(hi + 4 * kq + j) * 65 + lo + fr16] = -acc[j];
        }
        __syncthreads();
        {
            const int ib = 2 + (wu >> 1), jb = wu & 1;
            f32x4 acc = f32x4{0.f, 0.f, 0.f, 0.f};
#pragma unroll
            for (int s4 = 0; s4 < 8; ++s4)
                acc = __builtin_amdgcn_mfma_f32_16x16x4f32(X[(16 * ib + fr16) * 65 + 4 * s4 + kq], T[(4 * s4 + kq) * 65 + 16 * jb + fr16], acc, 0, 0, 0);
#pragma unroll
            for (int j = 0; j < 4; ++j) Qb[(16 * (ib - 2) + 4 * kq + j) * 33 + 16 * jb + fr16] = acc[j];
            __syncthreads();
            acc = f32x4{0.f, 0.f, 0.f, 0.f};
#pragma unroll
            for (int s4 = 0; s4 < 8; ++s4)
                acc = __builtin_amdgcn_mfma_f32_16x16x4f32(T[(16 * ib + fr16) * 65 + 32 + 4 * s4 + kq], Qb[(4 * s4 + kq) * 33 + 16 * jb + fr16], acc, 0, 0, 0);
#pragma unroll
            for (int j = 0; j < 4; ++j) T[(16 * ib + 4 * kq + j) * 65 + 16 * jb + fr16] = -acc[j];
        }
        __syncthreads();
    }
    PRB_END(136);
    PRB_BEGIN(137);
    u16* Tw = (u16*)X;
    u16* Tu = Y5;
    {
        const int c = tid >> 2, sgp = tid & 3;
        float tw[16], tu[16];
#pragma unroll
        for (int i = 0; i < 16; ++i) {
            const int s = sgp * 16 + i;
            const float t = T[c * 65 + s];
            tw[i] = t * be[s]; tu[i] = t * beta[s];
        }
        st16bf(Tw + c * LDP + sgp * 16, tw);
        st16bf(Tu + c * LDP + sgp * 16, tu);
    }
    __syncthreads();
    u16* wT = Y0; u16* wkT = Y1; u16* uT = (u16*)X; u16* ukT = Y5;
    {
        f32x4 wa[4], ua[4]; zero4(wa); zero4(ua);
        mm64(wa, Tw, LDP, Y2, LDP);
        mm64(ua, Tu, LDP, Y3, LDP);
        __syncthreads();
        const int c0 = 16 * w + fq * 4;
        const float k0 = ke[c0], k1 = ke[c0 + 1], k2 = ke[c0 + 2], k3 = ke[c0 + 3];
#pragma unroll
        for (int nt = 0; nt < 4; ++nt) {
            const int d = nt * 16 + fr;
            u32x2 a, bq, c, dq_;
            a.x = pack2(wa[nt][0], wa[nt][1]); a.y = pack2(wa[nt][2], wa[nt][3]);
            bq.x = pack2(wa[nt][0] * k0, wa[nt][1] * k1); bq.y = pack2(wa[nt][2] * k2, wa[nt][3] * k3);
            c.x = pack2(ua[nt][0], ua[nt][1]); c.y = pack2(ua[nt][2], ua[nt][3]);
            dq_.x = pack2(ua[nt][0] * k0, ua[nt][1] * k1); dq_.y = pack2(ua[nt][2] * k2, ua[nt][3] * k3);
            *(u32x2*)(wT + d * LDP + c0) = a;
            *(u32x2*)(wkT + d * LDP + c0) = bq;
            *(u32x2*)(uT + d * LDP + c0) = c;
            *(u32x2*)(ukT + d * LDP + c0) = dq_;
        }
    }
    __syncthreads();
    PRB_END(137);
    PRB_BEGIN(134);
    {
        const float dec = scal[0];
        f32x4 acc[4];
        zero4(acc); mm64(acc, wT, LDP, Y4, LDP);
#pragma unroll
        for (int nt = 0; nt < 4; ++nt) {
            const int d = 16 * w + fq * 4, c = nt * 16 + fr;
            const u32x2 qv = qpre[nt];
            const float ec = __expf(cum[c]);
            u32x2 pk;
            pk.x = pack2(__uint_as_float(qv.x << 16) * ec - acc[nt][0], __uint_as_float(qv.x & 0xffff0000u) * ec - acc[nt][1]);
            pk.y = pack2(__uint_as_float(qv.y << 16) * ec - acc[nt][2], __uint_as_float(qv.y & 0xffff0000u) * ec - acc[nt][3]);
            *(u32x2*)(p.gdQ + idx * 4096 + c * 64 + d) = pk;
        }
        zero4(acc); mm64(acc, wkT, LDP, Y2, LDP);
#pragma unroll
        for (int nt = 0; nt < 4; ++nt) {
            const int d = 16 * w + fq * 4, d2 = nt * 16 + fr;
            u32x2 pk;
            pk.x = pack2((d == d2 ? dec : 0.f) - acc[nt][0], (d + 1 == d2 ? dec : 0.f) - acc[nt][1]);
            pk.y = pack2((d + 2 == d2 ? dec : 0.f) - acc[nt][2], (d + 3 == d2 ? dec : 0.f) - acc[nt][3]);
            *(u32x2*)(p.gdM + idx * 4096 + d2 * 64 + d) = pk;
        }
        zero4(acc); mm64(acc, Y2, LDP, ukT, LDP);
#pragma unroll
        for (int nt = 0; nt < 4; ++nt) {
            const int d2 = 16 * w + fq * 4, e = nt * 16 + fr;
            u32x2 pk; pk.x = pack2(acc[nt][0], acc[nt][1]); pk.y = pack2(acc[nt][2], acc[nt][3]);
            *(u32x2*)(p.gdN + idx * 4096 + e * 64 + d2) = pk;
        }
        zero4(acc); mm64(acc, Y4, LDP, uT, LDP);
#pragma unroll
        for (int nt = 0; nt < 4; ++nt) {
            const int c = 16 * w + fq * 4, e = nt * 16 + fr;
            u32x2 pk; pk.x = pack2(acc[nt][0], acc[nt][1]); pk.y = pack2(acc[nt][2], acc[nt][3]);
            *(u32x2*)(p.gdO + idx * 4096 + e * 64 + c) = pk;
        }
    }
    __syncthreads();
    PRB_END(134);
}

struct UnitA { int dir, b, st, h; };
DEV UnitA unit_a(int v) { UnitA t; t.h = v & 3; t.st = (v >> 2) % NSTEP; const int db = (v >> 2) / NSTEP; t.b = db & 1; t.dir = db >> 1; return t; }
DEV void phase_chunkA(const P& p, int l, const u16* gqkv, int bid, int nb, unsigned char* sm) {
    {
        int u = bid;
        if (u < 2112) {
            GdAIn cur; { const UnitA t = unit_a(u); gd_a_load(p, l, gqkv, t.dir, t.b, t.st, t.h, cur); }
            for (; u < 2112; u += nb) {
                const UnitA t = unit_a(u), tn = unit_a(u + nb < 2112 ? u + nb : u);
                GdAIn nxt; gd_a_load(p, l, gqkv, tn.dir, tn.b, tn.st, tn.h, nxt);
                PRB_BEGIN(120); gd_a_run(p, l, cur, t.dir, t.b, t.st, t.h, sm); PRB_END(120);
                cur = nxt;
            }
        }
    }
    {
        int u = bid + ((2112 - bid + nb - 1) / nb) * nb;
        if (u < 4224) {
            GlaAIn cur; { const UnitA t = unit_a(u - 2112); gla_a_load(p, l, t.dir, t.b, t.st, t.h, cur); }
            for (; u < 4224; u += nb) {
                const UnitA t = unit_a(u - 2112), tn = unit_a((u + nb < 4224 ? u + nb : u) - 2112);
                GlaAIn nxt; gla_a_load(p, l, tn.dir, tn.b, tn.st, tn.h, nxt);
                PRB_BEGIN(121); gla_a_run(p, l, cur, t.dir, t.b, t.st, t.h, sm); PRB_END(121);
                cur = nxt;
            }
        }
    }
    {
        int u = bid + ((4224 - bid + nb - 1) / nb) * nb;
        if (u < 6336) {
            MlAIn cur; { const UnitA t = unit_a(u - 4224); ml_a_load(p, l, t.dir, t.b, t.st, t.h, cur); }
            for (; u < 6336; u += nb) {
                const UnitA t = unit_a(u - 4224), tn = unit_a((u + nb < 6336 ? u + nb : u) - 4224);
                MlAIn nxt; ml_a_load(p, l, tn.dir, tn.b, tn.st, tn.h, nxt);
                PRB_BEGIN(122); ml_a_run(p, l, cur, t.dir, t.b, t.st, t.h, sm); PRB_END(122);
                cur = nxt;
            }
        }
    }
}
#define GD_STAGE (64 * 64 + 16 * 64)
#define GD_NST 7
struct GdSrc { const u16* s[4]; int dst[4]; int n; };
DEV GdSrc gd_src(const P& p, size_t idx0, int ct, int w, int lane) {
    GdSrc g; g.n = w == 0 ? 0 : (w == 1 ? 4 : 3);
    const int p0 = w == 1 ? 0 : (w == 2 ? 4 : 7);
#pragma unroll
    for (int i = 0; i < 4; ++i) {
        const int pi = p0 + i;
        if (pi < 8) {
            const int r = pi * 8 + (lane >> 3), c = (lane & 7) ^ ((r >> 1) & 7);
            g.s[i] = p.gdM + idx0 * 4096 + r * 64 + c * 8; g.dst[i] = pi * 512;
        } else {
            const int q = (pi - 8) & 1, r = q * 8 + (lane >> 3), c = (lane & 7) ^ ((r >> 1) & 7);
            g.s[i] = p.gdN + idx0 * 4096 + (16 * ct + r) * 64 + c * 8; g.dst[i] = 64 * 64 + q * 512;
        }
    }
    return g;
}
DEV void gd_issue(const GdSrc& g, int step, u16* ring, int stg) {
    u16* md = ring + stg * GD_STAGE;
    const size_t off = (size_t)step * 4 * 4096;
#pragma unroll
    for (int i = 0; i < 4; ++i)
        if (i < g.n) __builtin_amdgcn_global_load_lds((const unsigned*)(g.s[i] + off), (unsigned*)(md + g.dst[i]), 16, 0, 0);
}
DEV void gd_frags(const u16* Ms, int fr, int fq, int sw, bf16x8 (&a)[8], u32x2 (&nv)[4]) {
    const u16* Ns = Ms + 64 * 64;
#pragma unroll
    for (int mt = 0; mt < 4; ++mt) {
#pragma unroll
        for (int t = 0; t < 2; ++t) {
            union { bf16x8 v; u32x2 h2[2]; } u;
            u.h2[0] = *(const u32x2*)(Ms + (mt * 16 + fr) * 64 + (((4 * t + (fq >> 1)) ^ sw) * 8) + (fq & 1) * 4);
            u.h2[1] = *(const u32x2*)(Ms + (mt * 16 + fr) * 64 + (((4 * t + 2 + (fq >> 1)) ^ sw) * 8) + (fq & 1) * 4);
            a[mt * 2 + t] = u.v;
        }
        nv[mt] = *(const u32x2*)(Ns + fr * 64 + (((mt * 2 + (fq >> 1)) ^ sw) * 8) + (fq & 1) * 4);
    }
}
DEV void gd_scan(const P& p, int unit, u16* sm) {
    const int chain = unit >> 2, ct = unit & 3;
    const int dir = chain >> 3, b = (chain >> 2) & 1, h = chain & 3;
    const int tid_ = tidx();
    const int lane = tid_ & 63, w = tid_ >> 6, fr = lane & 15, fq = lane >> 4;
    u16* ring = sm;
    u32x2 sb[2][2];
    sb[0][0] = u32x2{0u, 0u}; sb[0][1] = sb[0][0]; sb[1][0] = sb[0][0]; sb[1][1] = sb[0][0];
    const size_t base = state_idx(dir, b, 0, h);
    const int sw = (fr >> 1) & 7;
    asm volatile("s_waitcnt vmcnt(0)" ::: "memory");
    const GdSrc gs = gd_src(p, base, ct, w, lane);
#pragma unroll
    for (int t = 0; t < 6; ++t) gd_issue(gs, t, ring, t);
    if (w == 1) asm volatile("s_waitcnt vmcnt(20)" ::: "memory"); else asm volatile("s_waitcnt vmcnt(15)" ::: "memory");
    RAW_BARRIER();
    bf16x8 a[8], an[8]; u32x2 nv[4], nn[4];
    if (w == 0) gd_frags(ring, fr, fq, sw, a, nv);
    for (int k = 0; k < NSTEP; ++k) {
        if (w == 0) { }
        else if (k + 6 >= NSTEP) asm volatile("s_waitcnt vmcnt(0)" ::: "memory");
        else if (w == 1) asm volatile("s_waitcnt vmcnt(16)" ::: "memory");
        else asm volatile("s_waitcnt vmcnt(12)" ::: "memory");
        RAW_BARRIER();
        if (k + 6 < NSTEP) gd_issue(gs, k + 6, ring, (k + 6) % GD_NST);
        asm volatile("" ::: "memory");
        if (w == 0) {
            const size_t idx = base + (size_t)k * 4;
            f32x4 acc[4];
#pragma unroll
            for (int mt = 0; mt < 4; ++mt) {
                acc[mt][0] = __uint_as_float(nv[mt].x << 16); acc[mt][1] = __uint_as_float(nv[mt].x & 0xffff0000u);
                acc[mt][2] = __uint_as_float(nv[mt].y << 16); acc[mt][3] = __uint_as_float(nv[mt].y & 0xffff0000u);
            }
#pragma unroll
            for (int mt = 0; mt < 4; ++mt)
#pragma unroll
                for (int t = 0; t < 2; ++t) {
                    union { bf16x8 v; u32x2 h2[2]; } bb; bb.h2[0] = sb[t][0]; bb.h2[1] = sb[t][1];
                    acc[mt] = mfma16(a[mt * 2 + t], bb.v, acc[mt]);
                }
            if (k + 1 < NSTEP) gd_frags(ring + ((k + 1) % GD_NST) * GD_STAGE, fr, fq, sw, an, nn);
            u16* so = p.gdN + idx * 4096 + (16 * ct + fr) * 64 + fq * 4;
#pragma unroll
            for (int t = 0; t < 2; ++t) { *(u32x2*)(so + 32 * t) = sb[t][0]; *(u32x2*)(so + 32 * t + 16) = sb[t][1]; }
            asm volatile("" ::: "memory");
#pragma unroll
            for (int t = 0; t < 2; ++t) {
                sb[t][0].x = pack2(acc[2 * t][0], acc[2 * t][1]); sb[t][0].y = pack2(acc[2 * t][2], acc[2 * t][3]);
                sb[t][1].x = pack2(acc[2 * t + 1][0], acc[2 * t + 1][1]); sb[t][1].y = pack2(acc[2 * t + 1][2], acc[2 * t + 1][3]);
            }
#pragma unroll
            for (int q = 0; q < 8; ++q) a[q] = an[q];
#pragma unroll
            for (int q = 0; q < 4; ++q) nv[q] = nn[q];
        }
    }
    asm volatile("s_waitcnt vmcnt(0)" ::: "memory");
    RAW_BARRIER();
}

DEV void gla_scan(const P& p, int v) {
    const int chain = v >> 3, sub = v & 7;
    const int dir = chain >> 3, b = (chain >> 2) & 1, h = chain & 3;
    const int ep = sub * 256 + tidx(), d = (2 * ep) & 63;
    float s0 = 0.f, s1 = 0.f;
    for (int st0 = 0; st0 < NSTEP; st0 += 12) {
        unsigned kv[12]; float2 dc[12];
#pragma unroll
        for (int k = 0; k < 12; ++k) {
            const size_t idx = state_idx(dir, b, st0 + k, h);
            kv[k] = *(const unsigned*)(p.glaS + idx * 4096 + 2 * ep);
            dc[k] = *(const float2*)(p.glaDec + idx * 64 + d);
        }
#pragma unroll
        for (int k = 0; k < 12; ++k) {
            const size_t idx = state_idx(dir, b, st0 + k, h);
            *(unsigned*)(p.glaS + idx * 4096 + 2 * ep) = pack2(s0, s1);
            s0 = dc[k].x * s0 + __uint_as_float(kv[k] << 16);
            s1 = dc[k].y * s1 + __uint_as_float(kv[k] & 0xffff0000u);
        }
    }
}

DEV void ml_scan(const P& p, int v) {
    const int chain = v >> 3, sub = v & 7;
    const int dir = chain >> 3, b = (chain >> 2) & 1, h = chain & 3;
    const int tid = tidx();
    const int ep = sub * 256 + tid;
    float s0 = 0.f, s1 = 0.f, m = 0.f;
    for (int st0 = 0; st0 < NSTEP; st0 += 12) {
        unsigned kv[12]; float fe[12], ae[12];
#pragma unroll
        for (int k = 0; k < 12; ++k) {
            const size_t idx = state_idx(dir, b, st0 + k, h);
            kv[k] = *(const unsigned*)(p.mlS + idx * 4096 + 2 * ep);
            fe[k] = p.mlFE[idx]; ae[k] = p.mlAE[idx];
        }
#pragma unroll
        for (int k = 0; k < 12; ++k) {
            const size_t idx = state_idx(dir, b, st0 + k, h);
            *(unsigned*)(p.mlS + idx * 4096 + 2 * ep) = pack2(s0, s1);
            const float mn = fmaxf(fe[k] + m, ae[k]);
            const float od = __expf(fe[k] + m - mn), nw = __expf(ae[k] - mn);
            s0 = od * s0 + nw * __uint_as_float(kv[k] << 16);
            s1 = od * s1 + nw * __uint_as_float(kv[k] & 0xffff0000u);
            m = mn;
        }
    }
}
DEV void ml_nscan(const P& p, int v) {
    const int tid = tidx(), chain = v * 4 + (tid >> 6), d = tid & 63;
    const int dir = chain >> 3, b = (chain >> 2) & 1, h = chain & 3;
    float nn = 0.f, m = 0.f;
    for (int st0 = 0; st0 < NSTEP; st0 += 12) {
        float fe[12], ae[12], ks[12];
#pragma unroll
        for (int k = 0; k < 12; ++k) {
            const size_t idx = state_idx(dir, b, st0 + k, h);
            fe[k] = p.mlFE[idx]; ae[k] = p.mlAE[idx]; ks[k] = p.mlN[idx * 64 + d];
        }
#pragma unroll
        for (int k = 0; k < 12; ++k) {
            const size_t idx = state_idx(dir, b, st0 + k, h);
            p.mlN[idx * 64 + d] = nn;
            if (d == 0) p.mlM[idx] = m;
            const float mn = fmaxf(fe[k] + m, ae[k]);
            const float od = __expf(fe[k] + m - mn), nw = __expf(ae[k] - mn);
            nn = od * nn + nw * ks[k];
            m = mn;
        }
    }
}

DEV void phase_scan(const P& p, int bid, int nb, u16* sm) {
    for (int u = bid; u < 64 + 128 + 128 + 4; u += nb) {
        if (u < 64) { PRB_BEGIN(100); gd_scan(p, u, sm); PRB_END(100); }
        else if (u < 192) { PRB_BEGIN(101); gla_scan(p, u - 64); PRB_END(101); }
        else if (u < 320) { PRB_BEGIN(102); ml_scan(p, u - 192); PRB_END(102); }
        else ml_nscan(p, u - 320);
    }
}
DEV void chunk_geom(int g, int& b, int& row0, int& stf, int& stb) {
    b = g / NSTEP; const int wv = g % NSTEP;
    row0 = wv < 4 ? RLAT + b * CTXL + wv * 64 : b * SEQ + (wv - 4) * 64;
    stf = wv; stb = wv < 4 ? 3 - wv : 135 - wv;
}
DEV void obuf_acc(float* obuf, const f32x4 (&acc)[4], int dir) {
    const int lane = tidx() & 63, w = tidx() >> 6, fr = lane & 15, fq = lane >> 4;
    if (dir == 0) {
#pragma unroll
        for (int nt = 0; nt < 4; ++nt)
#pragma unroll
            for (int j = 0; j < 4; ++j) obuf[(16 * w + fq * 4 + j) * 65 + nt * 16 + fr] = acc[nt][j];
    } else {
        float old[4][4];
#pragma unroll
        for (int nt = 0; nt < 4; ++nt)
#pragma unroll
            for (int j = 0; j < 4; ++j) old[nt][j] = obuf[(63 - (16 * w + fq * 4 + j)) * 65 + nt * 16 + fr];
#pragma unroll
        for (int nt = 0; nt < 4; ++nt)
#pragma unroll
            for (int j = 0; j < 4; ++j) obuf[(63 - (16 * w + fq * 4 + j)) * 65 + nt * 16 + fr] = old[nt][j] + acc[nt][j];
    }
}
DEV Raw16 gate_prefetch(const P& p, int h, int row0, int gcol) {
    const int tid = tidx(), row = tid >> 2, eg = tid & 3;
    return ldraw16(p.cols + (size_t)(row0 + row) * NCM + gcol + h * 64 + eg * 16);
}
template <int ACT>
DEV void head_out(const P& p, int l, int br, int h, int row0, const Raw16& graw, const float* obuf) {
    const int tid = tidx(), row = tid >> 2, eg = tid & 3;
    float o[16]; float ss = 0.f;
#pragma unroll
    for (int i = 0; i < 16; ++i) { o[i] = obuf[row * 65 + eg * 16 + i]; ss += o[i] * o[i]; }
    ss += shx(ss, 1); ss += shx(ss, 2);
    const float rs = rsqrtf(ss * (1.f / 64.f) + EPSF);
    float gt[16];
    unraw16(graw, gt);
    float y[16];
#pragma unroll
    for (int i = 0; i < 16; ++i) {
        const float hn = p.head_norm[(l * 4 + br) * 256 + h * 64 + eg * 16 + i];
        const float a = ACT == 0 ? silu(gt[i]) : sigm(gt[i]);
        y[i] = o[i] * rs * hn * a;
    }
    st16bf(p.ybuf + (size_t)(row0 + row) * 1024 + br * 256 + h * 64 + eg * 16, y);
}

struct GlaDirIn { Raw16 q, k, v; bf16x8 sin_[2][4]; GlaCumIn c; };
DEV void gla_dir_load(const P& p, int l, int dir, int b, int h, int row0, int st, GlaDirIn& in) {
    const int tid = tidx(), s = tid >> 2, dg = tid & 3, row = row0 + (dir ? 63 - s : s);
    in.q = ldraw16(p.cols + (size_t)row * NCM + GLA_Q + h * 64 + dg * 16);
    in.k = ldraw16(p.cols + (size_t)row * NCM + GLA_K + h * 64 + dg * 16);
    in.v = ldraw16(p.cols + (size_t)row * NCM + GLA_V + h * 64 + dg * 16);
    ldB64(in.sin_, p.glaS + state_idx(dir, b, st, h) * 4096);
    gla_cum_load(p, l, dir, h, row0, in.c);
}
DEV void gla_dir_run(const GlaDirIn& in, int dir, float* cum, float* rt, float* sg, float* obuf, u16* qi, u16* ko, u16* vT) {
    const int tid = tidx(), lane = tid & 63, w = tid >> 6, fr = lane & 15, fq = lane >> 4;
    PRB_BEGIN(140);
    gla_cum_run(in.c, cum, rt, sg);
    PRB_END(140);
    PRB_BEGIN(141);
    {
        const int s = tid >> 2, dg = tid & 3;
        float qq[16], kk[16], vv[16];
        unraw16(in.q, qq); unraw16(in.k, kk); unraw16(in.v, vv);
#pragma unroll
        for (int i = 0; i < 16; ++i) {
            const float cv = cum[s * 65 + dg * 16 + i];
            qq[i] *= 0.125f * __expf(cv); kk[i] *= __expf(-cv);
            vT[(dg * 16 + i) * LDP + s] = f2bf(vv[i]);
        }
        st16bf(qi + s * LDP + dg * 16, qq);
        st16bf(ko + s * LDP + dg * 16, kk);
    }
    __syncthreads();
    f32x4 sa[4]; zero4(sa);
    mm64(sa, qi, LDP, ko, LDP);
    __syncthreads();
#pragma unroll
    for (int nt = 0; nt < 4; ++nt)
#pragma unroll
        for (int j = 0; j < 4; ++j) {
            const int c = 16 * w + fq * 4 + j, s = nt * 16 + fr;
            ko[c * LDP + s] = f2bf(s <= c ? sa[nt][j] : 0.f);
        }
    __syncthreads();
    PRB_END(141);
    PRB_BEGIN(142);
    f32x4 oa[4]; zero4(oa);
    mm64(oa, ko, LDP, vT, LDP);
    mm64_pre(oa, qi, LDP, in.sin_);
    obuf_acc(obuf, oa, dir);
    __syncthreads();
    PRB_END(142);
}
DEV void gla_phaseC(const P& p, int l, int g, int h, unsigned char* smraw) {
    float* cum = (float*)smraw;
    float* rt = cum + 64 * 65;
    float* sg = rt + 64 * 17;
    float* obuf = sg + 256;
    u16* qi = (u16*)(obuf + 64 * 65);
    u16* ko = qi + 64 * LDP;
    u16* vT = ko + 64 * LDP;
    int b, row0, stf, stb; chunk_geom(g, b, row0, stf, stb);
    GlaDirIn i0, i1;
    gla_dir_load(p, l, 0, b, h, row0, stf, i0);
    gla_dir_load(p, l, 1, b, h, row0, stb, i1);
    const Raw16 graw = gate_prefetch(p, h, row0, GLA_G);
    gla_dir_run(i0, 0, cum, rt, sg, obuf, qi, ko, vT);
    gla_dir_run(i1, 1, cum, rt, sg, obuf, qi, ko, vT);
    PRB_BEGIN(143);
    head_out<0>(p, l, 0, h, row0, graw, obuf);
    __syncthreads();
    PRB_END(143);
}

struct MlDirIn { Raw16 q, k, v; bf16x8 cin_[2][4]; float m_in, nin, gb0, gb1; u16 g0, g1; };
DEV void ml_dir_load(const P& p, int l, int dir, int b, int h, int row0, int st, MlDirIn& in) {
    const int tid = tidx(), lane = tid & 63, s = tid >> 2, dg = tid & 3, row = row0 + (dir ? 63 - s : s);
    const size_t idx = state_idx(dir, b, st, h);
    in.m_in = p.mlM[idx];
    in.q = ldraw16(p.cols + (size_t)row * NCM + ML_Q + h * 64 + dg * 16);
    in.k = ldraw16(p.cols + (size_t)row * NCM + ML_K + h * 64 + dg * 16);
    in.v = ldraw16(p.cols + (size_t)row * NCM + ML_V + h * 64 + dg * 16);
    ldB64(in.cin_, p.mlS + idx * 4096);
    const int grow = row0 + (dir ? 63 - lane : lane);
    in.g0 = p.cols[(size_t)grow * NCM + ML_GF + dir * 8 + h];
    in.g1 = p.cols[(size_t)grow * NCM + ML_GF + dir * 8 + 4 + h];
    in.gb0 = p.mlstm_gate_b[((l * 2 + dir) * 2 + 0) * 4 + h];
    in.gb1 = p.mlstm_gate_b[((l * 2 + dir) * 2 + 1) * 4 + h];
    in.nin = p.mlN[idx * 64 + lane];
}
DEV void ml_dir_run(const MlDirIn& in, int dir, float* obuf, float* fcum, float* ipre, float* mrow, float* denl, float* qn, float* nin,
                    u16* qs, u16* ks, u16* vT) {
    const int tid = tidx(), lane = tid & 63, w = tid >> 6, fr = lane & 15, fq = lane >> 4;
    const float m_in = in.m_in;
    if (w == 0) {
        const float ip = bf2f(in.g0) + in.gb0;
        const float lf = logsig(bf2f(in.g1) + in.gb1);
        const float fc = wscan_add(lf, lane);
        const float pm = wscan_max(ip - fc, lane);
        fcum[lane] = fc; ipre[lane] = ip; mrow[lane] = fc + fmaxf(m_in, pm);
        nin[lane] = in.nin;
    }
    {
        const int s = tid >> 2, dg = tid & 3;
        float kk[16], vv[16];
        *(u32x4*)(qs + s * LDP + dg * 16) = in.q.a;
        *(u32x4*)(qs + s * LDP + dg * 16 + 8) = in.q.b;
        unraw16(in.k, kk); unraw16(in.v, vv);
#pragma unroll
        for (int i = 0; i < 16; ++i) { kk[i] *= 0.125f; vT[(dg * 16 + i) * LDP + s] = f2bf(vv[i]); }
        st16bf(ks + s * LDP + dg * 16, kk);
    }
    __syncthreads();
    {
        const int c = tid >> 2, dg = tid & 3;
        float a = 0.f;
#pragma unroll
        for (int i = 0; i < 16; ++i) a += bf2f(qs[c * LDP + dg * 16 + i]) * nin[dg * 16 + i];
        a += shx(a, 1); a += shx(a, 2);
        if (dg == 0) qn[c] = a;
    }
    f32x4 sa[4]; zero4(sa);
    mm64(sa, qs, LDP, ks, LDP);
    __syncthreads();
    float dsum[4] = {0.f, 0.f, 0.f, 0.f};
#pragma unroll
    for (int nt = 0; nt < 4; ++nt)
#pragma unroll
        for (int j = 0; j < 4; ++j) {
            const int c = 16 * w + fq * 4 + j, s = nt * 16 + fr;
            const float ex = __expf(fminf(fcum[c] - fcum[s] + ipre[s] - mrow[c], 0.f));
            const float val = sa[nt][j] * ex * (s <= c ? 1.f : 0.f);
            dsum[j] += val;
            ks[c * LDP + s] = f2bf(val);
        }
#pragma unroll
    for (int j = 0; j < 4; ++j) {
        float v = dsum[j];
        v += shx(v, 1); v += shx(v, 2); v += shx(v, 4); v += shx(v, 8);
        if (fr == 0) denl[16 * w + fq * 4 + j] = v;
    }
    __syncthreads();
    f32x4 n1[4], n2[4]; zero4(n1); zero4(n2);
    mm64(n1, ks, LDP, vT, LDP);
    mm64_pre(n2, qs, LDP, in.cin_);
    f32x4 oa[4];
#pragma unroll
    for (int j = 0; j < 4; ++j) {
        const int c = 16 * w + fq * 4 + j;
        const float mr = mrow[c];
        const float ec = __expf(fcum[c] + m_in - mr);
        const float den = denl[c] + ec * qn[c];
        const float inv = 1.f / fmaxf(fabsf(den), __expf(-mr));
#pragma unroll
        for (int nt = 0; nt < 4; ++nt) oa[nt][j] = (n1[nt][j] + ec * n2[nt][j]) * inv;
    }
    obuf_acc(obuf, oa, dir);
    __syncthreads();
}
DEV void ml_phaseC(const P& p, int l, int g, int h, unsigned char* smraw) {
    float* obuf = (float*)smraw;
    float* fcum = obuf + 64 * 65;
    float* ipre = fcum + 64;
    float* mrow = ipre + 64;
    float* denl = mrow + 64;
    float* qn = denl + 64;
    float* nin = qn + 64;
    u16* qs = (u16*)(nin + 64 + 64);
    u16* ks = qs + 64 * LDP;
    u16* vT = ks + 64 * LDP;
    int b, row0, stf, stb; chunk_geom(g, b, row0, stf, stb);
    MlDirIn i0, i1;
    ml_dir_load(p, l, 0, b, h, row0, stf, i0);
    ml_dir_load(p, l, 1, b, h, row0, stb, i1);
    const Raw16 graw = gate_prefetch(p, h, row0, ML_O);
    ml_dir_run(i0, 0, obuf, fcum, ipre, mrow, denl, qn, nin, qs, ks, vT);
    ml_dir_run(i1, 1, obuf, fcum, ipre, mrow, denl, qn, nin, qs, ks, vT);
    head_out<1>(p, l, 1, h, row0, graw, obuf);
    __syncthreads();
}

struct GdDirIn { u32x2 ov[4]; bf16x8 qa[2]; bf16x8 nb[2][4]; };
DEV void gd_dir_load(const P& p, int dir, int b, int h, int st, GdDirIn& in) {
    const int tid = tidx(), lane = tid & 63, w = tid >> 6, fr = lane & 15, fq = lane >> 4;
    const size_t idx = state_idx(dir, b, st, h);
#pragma unroll
    for (int nt = 0; nt < 4; ++nt) in.ov[nt] = *(const u32x2*)(p.gdO + idx * 4096 + (nt * 16 + fr) * 64 + 16 * w + fq * 4);
#pragma unroll
    for (int ks = 0; ks < 2; ++ks) in.qa[ks] = *(const bf16x8*)(p.gdQ + idx * 4096 + (16 * w + fr) * 64 + ks * 32 + fq * 8);
    ldB64(in.nb, p.gdN + idx * 4096);
}
DEV void gd_dir_run(const GdDirIn& in, int dir, float* obuf) {
    f32x4 oa[4];
#pragma unroll
    for (int nt = 0; nt < 4; ++nt) {
        oa[nt][0] = __uint_as_float(in.ov[nt].x << 16); oa[nt][1] = __uint_as_float(in.ov[nt].x & 0xffff0000u);
        oa[nt][2] = __uint_as_float(in.ov[nt].y << 16); oa[nt][3] = __uint_as_float(in.ov[nt].y & 0xffff0000u);
    }
#pragma unroll
    for (int ks = 0; ks < 2; ++ks)
#pragma unroll
        for (int nt = 0; nt < 4; ++nt) oa[nt] = mfma16(in.qa[ks], in.nb[ks][nt], oa[nt]);
    obuf_acc(obuf, oa, dir);
    __syncthreads();
}
DEV void gd_phaseC(const P& p, int l, int g, int h, unsigned char* smraw) {
    float* obuf = (float*)smraw;
    int b, row0, stf, stb; chunk_geom(g, b, row0, stf, stb);
    GdDirIn i0, i1;
    gd_dir_load(p, 0, b, h, stf, i0);
    gd_dir_load(p, 1, b, h, stb, i1);
    const Raw16 graw = gate_prefetch(p, h, row0, GD_OG);
    PRB_BEGIN(150); gd_dir_run(i0, 0, obuf); PRB_END(150);
    PRB_BEGIN(151); gd_dir_run(i1, 1, obuf); PRB_END(151);
    PRB_BEGIN(152);
    head_out<0>(p, l, 2, h, row0, graw, obuf);
    __syncthreads();
    PRB_END(152);
}
DEV float fexp2(float x) { return __builtin_amdgcn_exp2f(x); }
#define ATT_STAGE_ELEMS (2 * 64 * 64)
DEV void attn_issue(const u16* kbase, const u16* vbase, int kt, u16* ring, int stg, int w, int lane) {
    u16* kd = ring + stg * ATT_STAGE_ELEMS;
    u16* vd = kd + 64 * 64;
#pragma unroll
    for (int i = 0; i < 2; ++i) {
        const int r = (w * 2 + i) * 8 + (lane >> 3), c = (lane & 7) ^ ((r >> 1) & 7);
        __builtin_amdgcn_global_load_lds((const unsigned*)(kbase + (size_t)(kt * 64 + r) * 64 + c * 8), (unsigned*)(kd + (w * 2 + i) * 512), 16, 0, 0);
        __builtin_amdgcn_global_load_lds((const unsigned*)(vbase + (size_t)r * KPOS + kt * 64 + c * 8), (unsigned*)(vd + (w * 2 + i) * 512), 16, 0, 0);
    }
}

DEV void attn_unit_exact(const P& p, int l, int b, int h, int q0pos, int nkeys, int rowbase, u16* ring) {
    const int tid = tidx(), lane = tid & 63, w = tid >> 6, fr = lane & 15, fq = lane >> 4;
    const size_t bh = (size_t)(b * 4 + h);
    float lam;
    {
        const float* lp = p.diff_lambda + (size_t)l * 4 * 4 * 32;
        float a = 0.f, c = 0.f;
        if (lane < 32) { a = lp[(0 * 4 + h) * 32 + lane] * lp[(1 * 4 + h) * 32 + lane]; c = lp[(2 * 4 + h) * 32 + lane] * lp[(3 * 4 + h) * 32 + lane]; }
        a = wsum(a); c = wsum(c);
        lam = expf(a) - expf(c) + (0.8f - 0.6f * expf(-0.3f * (float)l));
    }
    const float lam_init = 0.8f - 0.6f * expf(-0.3f * (float)l);
    u16* Qs = ring + 3 * ATT_STAGE_ELEMS + w * 32 * 64;
    asm volatile("s_waitcnt vmcnt(0)" ::: "memory");
#pragma unroll
    for (int i = 0; i < 4; ++i) {
        const int r = i * 8 + (lane >> 3), c = (lane & 7) ^ ((r >> 1) & 7);
        __builtin_amdgcn_global_load_lds((const unsigned*)(p.dq + (bh * KPOS + q0pos + w * 32 + r) * 64 + c * 8), (unsigned*)(Qs + i * 512), 16, 0, 0);
    }
    union { bf16x8 v; unsigned u[4]; } onesf;
    onesf.u[0] = onesf.u[1] = onesf.u[2] = onesf.u[3] = (fr == 0) ? 0x3f803f80u : 0u;
    f32x4 O[2][2][4], negref[2][2], Ol[2][2];
    float mref[2][2];
#pragma unroll
    for (int i = 0; i < 2; ++i)
#pragma unroll
        for (int g = 0; g < 2; ++g) {
            mref[i][g] = 0.f; Ol[i][g] = f32x4{0.f, 0.f, 0.f, 0.f}; negref[i][g] = f32x4{0.f, 0.f, 0.f, 0.f};
#pragma unroll
            for (int t = 0; t < 4; ++t) O[i][g][t] = f32x4{0.f, 0.f, 0.f, 0.f};
        }
    const u16* kbase = p.dk + bh * KPOS * 64;
    const u16* vbase = p.dvT + bh * 64 * KPOS;
    const int nk = nkeys >> 6;
    asm volatile("s_waitcnt vmcnt(0)" ::: "memory");
    attn_issue(kbase, vbase, 0, ring, 0, w, lane);
    attn_issue(kbase, vbase, 1, ring, 1, w, lane);
    const int sw = (fr >> 1) & 7;
    for (int kt = 0; kt < nk; ++kt) {
        if (kt + 1 < nk) asm volatile("s_waitcnt vmcnt(4)" ::: "memory"); else asm volatile("s_waitcnt vmcnt(0)" ::: "memory");
        RAW_BARRIER();
        if (kt + 2 < nk) attn_issue(kbase, vbase, kt + 2, ring, (kt + 2) % 3, w, lane);
        const u16* Ks = ring + (kt % 3) * ATT_STAGE_ELEMS;
        const u16* Vs = Ks + 64 * 64;
#pragma unroll
        for (int i = 0; i < 2; ++i) {
            f32x4 s[2][4];
            bf16x8 qfr[2];
#pragma unroll
            for (int g = 0; g < 2; ++g) qfr[g] = *(const bf16x8*)(Qs + (g * 16 + fr) * 64 + (((i * 4 + fq) ^ sw) * 8));
#pragma unroll
            for (int st = 0; st < 4; ++st) {
                const bf16x8 kf = *(const bf16x8*)(Ks + (st * 16 + fr) * 64 + (((i * 4 + fq) ^ sw) * 8));
#pragma unroll
                for (int g = 0; g < 2; ++g) s[g][st] = mfma16(kf, qfr[g], negref[i][g]);
            }
            float tmx[2];
#pragma unroll
            for (int g = 0; g < 2; ++g) {
                float mx = fmaxf(fmaxf(s[g][0][0], s[g][0][1]), fmaxf(s[g][0][2], s[g][0][3]));
#pragma unroll
                for (int st = 1; st < 4; ++st) mx = fmaxf(fmaxf(mx, s[g][st][0]), fmaxf(fmaxf(s[g][st][1], s[g][st][2]), s[g][st][3]));
                mx = fmaxf(mx, shx(mx, 16)); mx = fmaxf(mx, shx(mx, 32));
                tmx[g] = mx;
            }
            const bool mv = (tmx[0] > 16.f) || (tmx[1] > 16.f) || (kt == 0 && (tmx[0] < -16.f || tmx[1] < -16.f));
            if (__any(mv)) {
#pragma unroll
                for (int g = 0; g < 2; ++g) {
                    const float d = ((tmx[g] > 16.f) || (kt == 0 && tmx[g] < -16.f)) ? tmx[g] : 0.f;
                    const float fac = fexp2(-d);
                    mref[i][g] += d; Ol[i][g][0] *= fac; Ol[i][g][1] *= fac; Ol[i][g][2] *= fac; Ol[i][g][3] *= fac;
                    negref[i][g] = f32x4{-mref[i][g], -mref[i][g], -mref[i][g], -mref[i][g]};
#pragma unroll
                    for (int t = 0; t < 4; ++t) { O[i][g][t][0] *= fac; O[i][g][t][1] *= fac; O[i][g][t][2] *= fac; O[i][g][t][3] *= fac; }
#pragma unroll
                    for (int st = 0; st < 4; ++st) { s[g][st][0] -= d; s[g][st][1] -= d; s[g][st][2] -= d; s[g][st][3] -= d; }
                }
            }
            bf16x8 pb[2][2];
#pragma unroll
            for (int g = 0; g < 2; ++g) {
#pragma unroll
                for (int st = 0; st < 4; ++st)
#pragma unroll
                    for (int j = 0; j < 4; ++j) s[g][st][j] = fexp2(s[g][st][j]);
#pragma unroll
                for (int ks = 0; ks < 2; ++ks) {
                    union { bf16x8 v; unsigned u[4]; } pk;
                    pk.u[0] = pack2(s[g][2 * ks][0], s[g][2 * ks][1]); pk.u[1] = pack2(s[g][2 * ks][2], s[g][2 * ks][3]);
                    pk.u[2] = pack2(s[g][2 * ks + 1][0], s[g][2 * ks + 1][1]); pk.u[3] = pack2(s[g][2 * ks + 1][2], s[g][2 * ks + 1][3]);
                    pb[g][ks] = pk.v;
                }
            }
#pragma unroll
            for (int ks = 0; ks < 2; ++ks)
#pragma unroll
                for (int g = 0; g < 2; ++g) Ol[i][g] = mfma16(onesf.v, pb[g][ks], Ol[i][g]);
#pragma unroll
            for (int ks = 0; ks < 2; ++ks)
#pragma unroll
                for (int t = 0; t < 4; ++t) {
                    union { bf16x8 v; u32x2 h2[2]; } va;
                    va.v = *(const bf16x8*)(Vs + (t * 16 + fr) * 64 + (((ks * 4 + fq) ^ sw) * 8));
#pragma unroll
                    for (int g = 0; g < 2; ++g) O[i][g][t] = mfma16(va.v, pb[g][ks], O[i][g][t]);
                }
        }
    }
    RAW_BARRIER();
#pragma unroll
    for (int g = 0; g < 2; ++g) {
        const float l0 = shidx(Ol[0][g][0], fr), l1 = shidx(Ol[1][g][0], fr);
        const float i0 = 1.f / l0, i1 = lam / l1;
        float o[4][4]; float ss = 0.f;
#pragma unroll
        for (int t = 0; t < 4; ++t)
#pragma unroll
            for (int j = 0; j < 4; ++j) { o[t][j] = O[0][g][t][j] * i0 - O[1][g][t][j] * i1; ss += o[t][j] * o[t][j]; }
        ss += shx(ss, 16); ss += shx(ss, 32);
        const float rs = rsqrtf(ss * (1.f / 64.f) + EPSF) * (1.f - lam_init);
        const int row = rowbase + w * 32 + g * 16 + fr;
#pragma unroll
        for (int t = 0; t < 4; ++t) {
            const int dv = t * 16 + fq * 4;
            const float4 hn = *(const float4*)(p.head_norm + (l * 4 + 3) * 256 + h * 64 + dv);
            u32x2 pk; pk.x = pack2(o[t][0] * rs * hn.x, o[t][1] * rs * hn.y); pk.y = pack2(o[t][2] * rs * hn.z, o[t][3] * rs * hn.w);
            *(u32x2*)(p.ybuf + (size_t)row * 1024 + 768 + h * 64 + dv) = pk;
        }
    }
}

DEV void attn_unit(const P& p, int l, int b, int h, int q0pos, int nkeys, int rowbase, u16* ring) {
    const int tid = tidx(), lane = tid & 63, w = tid >> 6, fr = lane & 15, fq = lane >> 4;
    const size_t bh = (size_t)(b * 4 + h);
    float lam;
    {
        const float* lp = p.diff_lambda + (size_t)l * 4 * 4 * 32;
        float a = 0.f, c = 0.f;
        if (lane < 32) { a = lp[(0 * 4 + h) * 32 + lane] * lp[(1 * 4 + h) * 32 + lane]; c = lp[(2 * 4 + h) * 32 + lane] * lp[(3 * 4 + h) * 32 + lane]; }
        a = wsum(a); c = wsum(c);
        lam = expf(a) - expf(c) + (0.8f - 0.6f * expf(-0.3f * (float)l));
    }
    const float lam_init = 0.8f - 0.6f * expf(-0.3f * (float)l);
    u16* Qs = ring + 3 * ATT_STAGE_ELEMS + w * 32 * 64;
    asm volatile("s_waitcnt vmcnt(0)" ::: "memory");
#pragma unroll
    for (int i = 0; i < 4; ++i) {
        const int r = i * 8 + (lane >> 3), c = (lane & 7) ^ ((r >> 1) & 7);
        __builtin_amdgcn_global_load_lds((const unsigned*)(p.dq + (bh * KPOS + q0pos + w * 32 + r) * 64 + c * 8), (unsigned*)(Qs + i * 512), 16, 0, 0);
    }
    union { bf16x8 v; unsigned u[4]; } onesf;
    onesf.u[0] = onesf.u[1] = onesf.u[2] = onesf.u[3] = (fr == 0) ? 0x3f803f80u : 0u;
    f32x4 O[2][2][4], negref[2][2], Ol[2][2];
    float mref[2][2];
#pragma unroll
    for (int i = 0; i < 2; ++i)
#pragma unroll
        for (int g = 0; g < 2; ++g) {
            mref[i][g] = 0.f; Ol[i][g] = f32x4{0.f, 0.f, 0.f, 0.f};
#pragma unroll
            for (int t = 0; t < 4; ++t) O[i][g][t] = f32x4{0.f, 0.f, 0.f, 0.f};
        }
    const u16* kbase = p.dk + bh * KPOS * 64;
    const u16* vbase = p.dvT + bh * 64 * KPOS;
    const int nk = nkeys >> 6;
    asm volatile("s_waitcnt vmcnt(0)" ::: "memory");
    {
        const int sw0 = (fr >> 1) & 7;
        bool loose = false;
#pragma unroll
        for (int i = 0; i < 2; ++i) {
            const float kmx = sqrtf(__int_as_float(p.cnt[192 + l * 16 + (int)bh * 2 + i]));
#pragma unroll
            for (int g = 0; g < 2; ++g) {
                const u32x4 qv = *(const u32x4*)(Qs + (g * 16 + fr) * 64 + (((i * 4 + fq) ^ sw0) * 8));
                const unsigned qw[4] = {qv.x, qv.y, qv.z, qv.w};
                float ss = 0.f;
#pragma unroll
                for (int k2 = 0; k2 < 4; ++k2) { const float lo = __uint_as_float(qw[k2] << 16), hi = __uint_as_float(qw[k2] & 0xffff0000u); ss += lo * lo + hi * hi; }
                ss += shx(ss, 16); ss += shx(ss, 32);
                mref[i][g] = sqrtf(ss) * kmx;
                negref[i][g] = f32x4{-mref[i][g], -mref[i][g], -mref[i][g], -mref[i][g]};
                loose = loose || (mref[i][g] > 60.f);
            }
        }
        if (__any(loose)) { attn_unit_exact(p, l, b, h, q0pos, nkeys, rowbase, ring); return; }
    }
    attn_issue(kbase, vbase, 0, ring, 0, w, lane);
    attn_issue(kbase, vbase, 1, ring, 1, w, lane);
    const int sw = (fr >> 1) & 7;
    bf16x8 qreg[2][2];
#pragma unroll
    for (int i = 0; i < 2; ++i)
#pragma unroll
        for (int g = 0; g < 2; ++g) qreg[i][g] = *(const bf16x8*)(Qs + (g * 16 + fr) * 64 + (((i * 4 + fq) ^ sw) * 8));
    const int np = nk >> 1;
    for (int kp = 0; kp < np; ++kp) {
        asm volatile("s_waitcnt vmcnt(0)" ::: "memory");
        RAW_BARRIER();
        if (kp + 1 < np) {
            attn_issue(kbase, vbase, 2 * kp + 2, ring, ((kp + 1) & 1) * 2, w, lane);
            attn_issue(kbase, vbase, 2 * kp + 3, ring, ((kp + 1) & 1) * 2 + 1, w, lane);
        }
#pragma unroll
      for (int tt = 0; tt < 2; ++tt) {
        const u16* Ks = ring + ((kp & 1) * 2 + tt) * ATT_STAGE_ELEMS;
        const u16* Vs = Ks + 64 * 64;
        f32x4 sc[2][2][4];
#pragma unroll
        for (int i = 0; i < 2; ++i)
#pragma unroll
            for (int st = 0; st < 4; ++st) {
                const bf16x8 kf = *(const bf16x8*)(Ks + (st * 16 + fr) * 64 + (((i * 4 + fq) ^ sw) * 8));
#pragma unroll
                for (int g = 0; g < 2; ++g) sc[i][g][st] = mfma16(kf, qreg[i][g], negref[i][g]);
            }
#pragma unroll
        for (int i = 0; i < 2; ++i) {
            f32x4 (&s)[2][4] = sc[i];
            bf16x8 pb[2][2];
#pragma unroll
            for (int g = 0; g < 2; ++g) {
#pragma unroll
                for (int st = 0; st < 4; ++st)
#pragma unroll
                    for (int j = 0; j < 4; ++j) s[g][st][j] = fexp2(s[g][st][j]);
#pragma unroll
                for (int ks = 0; ks < 2; ++ks) {
                    union { bf16x8 v; unsigned u[4]; } pk;
                    pk.u[0] = pack2(s[g][2 * ks][0], s[g][2 * ks][1]); pk.u[1] = pack2(s[g][2 * ks][2], s[g][2 * ks][3]);
                    pk.u[2] = pack2(s[g][2 * ks + 1][0], s[g][2 * ks + 1][1]); pk.u[3] = pack2(s[g][2 * ks + 1][2], s[g][2 * ks + 1][3]);
                    pb[g][ks] = pk.v;
                }
            }
#pragma unroll
            for (int ks = 0; ks < 2; ++ks)
#pragma unroll
                for (int g = 0; g < 2; ++g) Ol[i][g] = mfma16(onesf.v, pb[g][ks], Ol[i][g]);
#pragma unroll
            for (int ks = 0; ks < 2; ++ks)
#pragma unroll
                for (int t = 0; t < 4; ++t) {
                    union { bf16x8 v; u32x2 h2[2]; } va;
                    va.v = *(const bf16x8*)(Vs + (t * 16 + fr) * 64 + (((ks * 4 + fq) ^ sw) * 8));
#pragma unroll
                    for (int g = 0; g < 2; ++g) O[i][g][t] = mfma16(va.v, pb[g][ks], O[i][g][t]);
                }
        }
      }
    }
    RAW_BARRIER();
#pragma unroll
    for (int g = 0; g < 2; ++g) {
        const float l0 = shidx(Ol[0][g][0], fr), l1 = shidx(Ol[1][g][0], fr);
        const float i0 = 1.f / l0, i1 = lam / l1;
        float o[4][4]; float ss = 0.f;
#pragma unroll
        for (int t = 0; t < 4; ++t)
#pragma unroll
            for (int j = 0; j < 4; ++j) { o[t][j] = O[0][g][t][j] * i0 - O[1][g][t][j] * i1; ss += o[t][j] * o[t][j]; }
        ss += shx(ss, 16); ss += shx(ss, 32);
        const float rs = rsqrtf(ss * (1.f / 64.f) + EPSF) * (1.f - lam_init);
        const int row = rowbase + w * 32 + g * 16 + fr;
#pragma unroll
        for (int t = 0; t < 4; ++t) {
            const int dv = t * 16 + fq * 4;
            const float4 hn = *(const float4*)(p.head_norm + (l * 4 + 3) * 256 + h * 64 + dv);
            u32x2 pk; pk.x = pack2(o[t][0] * rs * hn.x, o[t][1] * rs * hn.y); pk.y = pack2(o[t][2] * rs * hn.z, o[t][3] * rs * hn.w);
            *(u32x2*)(p.ybuf + (size_t)row * 1024 + 768 + h * 64 + dv) = pk;
        }
    }
}

template <int PART>
DEV void phase_outputs(const P& p, int l, int bid, int nb, unsigned char* sm) {
    const int role = (PART == 0) ? (__builtin_amdgcn_readfirstlane(*(volatile __attribute__((address_space(3))) int*)(size_t)ROLE_LDS_OFF) & 1) : 0;
    for (int half = 0; half < 2; ++half) {
    const bool attn_now = (half ^ role) == 0;
    if (attn_now && PART != 2) {
    const int nq = 64 + (l == 0 ? 2 : 0);
    int* qctr = p.cnt + 64 + l * 8;
    volatile int* slot = (volatile int*)(sm + 3 * ATT_STAGE_ELEMS * 2 + 128 * 64 * 2);
    const int x0 = (int)(xb_xcc_id() & 7u);
    for (int a = 0; a < 8; ++a) {
        const int bh = (x0 + a) & 7;
        for (;;) {
            if (tidx() == 0) *slot = atomicAdd(qctr + bh, 1);
            __syncthreads();
            const int qt = *slot;
            __syncthreads();
            if (qt >= nq) break;
            const int b = bh >> 2, h = bh & 3;
            if (qt < 64) attn_unit(p, l, b, h, CTXL + qt * 128, KPOS, b * SEQ + qt * 128, (u16*)sm);
            else attn_unit(p, l, b, h, (qt - 64) * 128, CTXL, RLAT + b * CTXL + (qt - 64) * 128, (u16*)sm);
        }
    }
    }
    __builtin_amdgcn_sched_barrier(0);
    if (!attn_now && PART != 1)
    for (int v = bid; v < 3 * 1056; v += nb) {
        const int mix = v / 1056, r = v % 1056, g = r >> 2, h = r & 3;
        if (l == 1 && (g % NSTEP) < 4) continue;
        if (mix == 0) { PRB_BEGIN(131); gla_phaseC(p, l, g, h, sm); PRB_END(131); }
        else if (mix == 1) { PRB_BEGIN(132); ml_phaseC(p, l, g, h, sm); PRB_END(132); }
        else { PRB_BEGIN(133); gd_phaseC(p, l, g, h, sm); PRB_END(133); }
    }
    __builtin_amdgcn_sched_barrier(0);
    }
}
#define LDS_BYTES 75776
static_assert(LDS_BYTES + 16 == ROLE_LDS_OFF, "role word sits right behind the barrier words");
#ifndef MULTI
#define MULTI 0
#endif
#ifndef STAGE
#define STAGE 99
#endif

enum { PH_PRO0 = 0, PH_PRO1, PH_NORM1, PH_INPROJ, PH_PREP, PH_CHUNKA, PH_SCAN, PH_OUT, PH_GATES, PH_MERGE1, PH_MERGE2, PH_ROUTER, PH_MOEUP, PH_MOEDOWN, PH_FINAL, PH_OUTC };

struct KArgs { const float* in[25]; float* out; unsigned char* ws; };
constexpr size_t al256c(size_t x) { return (x + 255) & ~(size_t)255; }
struct WsOff {
    size_t Wd, Wt2, bar, cnt, cuslot, zero_end, modp, mod, xctx, rope, hbuf, ybuf, Wt, dq, dk, dvT, glaDec, mlN, mlFE, mlAE, mlM, glaS, mlS, gdM, gdN, gdQ, gdO, cols, total;
};
constexpr WsOff make_off() {
    WsOff o{}; size_t c = 0;
    const size_t nst = (size_t)2 * 2 * NSTEP * 4;
    o.bar = c; c = al256c(c + XCD_BAR_WORDS * 4);
    o.cnt = c; c = al256c(c + 1024);
    o.cuslot = c; c = al256c(c + 4096 * 4);
    o.zero_end = c;
    o.modp = c; c = al256c(c + (size_t)2 * 16 * 3 * 6144 * 4);
    o.mod = c; c = al256c(c + (size_t)2 * 3 * 6144 * 4);
    o.xctx = c; c = al256c(c + (size_t)RCTX * DM * 4);
    o.rope = c; c = al256c(c + (size_t)192 * 8 * 2 * 4);
    o.hbuf = c; c = al256c(c + (size_t)RTOT * DM * 2);
    o.ybuf = c; c = al256c(c + (size_t)RTOT * DM * 2);
    o.Wt = c; c = al256c(c + (size_t)WT_TOTAL * 2);
    o.dq = c; c = al256c(c + (size_t)8 * KPOS * 64 * 2);
    o.dk = c; c = al256c(c + (size_t)8 * KPOS * 64 * 2);
    o.dvT = c; c = al256c(c + (size_t)8 * KPOS * 64 * 2);
    o.glaDec = c; c = al256c(c + nst * 64 * 4);
    o.mlN = c; c = al256c(c + nst * 64 * 4);
    o.mlFE = c; c = al256c(c + nst * 4);
    o.mlAE = c; c = al256c(c + nst * 4);
    o.mlM = c; c = al256c(c + nst * 4);
    o.glaS = c; c = al256c(c + nst * 4096 * 2);
    o.mlS = c; c = al256c(c + nst * 4096 * 2);
    o.gdM = c; c = al256c(c + nst * 4096 * 2);
    o.gdN = c; c = al256c(c + nst * 4096 * 2);
    o.gdQ = c; c = al256c(c + nst * 4096 * 2);
    o.gdO = c; c = al256c(c + nst * 4096 * 2);
    o.cols = c; c = al256c(c + (size_t)RTOT * NGATE * 2);
    o.Wd = c; c = al256c(c + (size_t)16 * 1024 * 512 * 2);
    o.Wt2 = c; c = al256c(c + (size_t)WT_TOTAL * 2);
    o.total = c;
    return o;
}
constexpr WsOff WSO = make_off();
template <class T> DEV T* launder_p(T* v) {
    __attribute__((address_space(1))) T* g = (__attribute__((address_space(1))) T*)v;
    asm volatile("" : "+s"(g));
    return (T*)g;
}
DEV P build_P(const KArgs& ka) {
    P p;
    const float* in[25];
#pragma unroll
    for (int i = 0; i < 25; ++i) in[i] = launder_p(ka.in[i]);
    p.x = in[0]; p.c = in[1]; p.ctx = in[2]; p.c_ctx = in[3]; p.w_mod = in[4]; p.b_mod = in[5]; p.norm_mix = in[6]; p.norm_ffn = in[7];
    p.w_in = in[8]; p.gla_a2 = in[9]; p.gla_ab = in[10]; p.mlstm_gate_b = in[11]; p.gdn_conv = in[12]; p.gdn_a_log = in[13];
    p.gdn_dt_bias = in[14]; p.diff_lambda = in[15]; p.head_norm = in[16]; p.w_branch = in[17]; p.w_out = in[18]; p.router_w = in[19];
    p.router_b = in[20]; p.w_gate = in[21]; p.w_up = in[22]; p.w_down = in[23]; p.norm_final = in[24];
    p.out = launder_p(ka.out);
    unsigned char* ws = launder_p(ka.ws);
    p.bar = (unsigned*)(ws + WSO.bar); p.cnt = (int*)(ws + WSO.cnt); p.modp = (float*)(ws + WSO.modp); p.mod = (float*)(ws + WSO.mod);
    p.xctx = (float*)(ws + WSO.xctx); p.rope = (float*)(ws + WSO.rope); p.hbuf = (u16*)(ws + WSO.hbuf); p.ybuf = (u16*)(ws + WSO.ybuf);
    p.Wt = (u16*)(ws + WSO.Wt); p.dq = (u16*)(ws + WSO.dq); p.dk = (u16*)(ws + WSO.dk); p.dvT = (u16*)(ws + WSO.dvT);
    p.glaDec = (float*)(ws + WSO.glaDec); p.mlN = (float*)(ws + WSO.mlN); p.mlFE = (float*)(ws + WSO.mlFE); p.mlAE = (float*)(ws + WSO.mlAE);
    p.mlM = (float*)(ws + WSO.mlM); p.glaS = (u16*)(ws + WSO.glaS); p.mlS = (u16*)(ws + WSO.mlS); p.gdM = (u16*)(ws + WSO.gdM);
    p.gdN = (u16*)(ws + WSO.gdN); p.gdQ = (u16*)(ws + WSO.gdQ); p.gdO = (u16*)(ws + WSO.gdO); p.cols = (u16*)(ws + WSO.cols); p.Wd = (u16*)(ws + WSO.Wd);
    return p;
}

template <int PH>
DEV void run_phase(const KArgs& ka, int l, int bid_, int nb_, unsigned char* sm) {
    P p = build_P(ka);
    u16* const Wt2 = (u16*)(launder_p(ka.ws) + WSO.Wt2);
    if (l == 1) p.Wt = Wt2;
    const int bid = launder_s(bid_), nb = launder_s(nb_);
    u16* gqkv = p.ybuf;
    u16* ubuf = p.glaS;
    const int mtiles = l == 0 ? 132 : 128;
    if (PH == PH_PRO0) { phase_conv_mixw(p, p.Wt, 0, bid, nb, 0, (float*)sm); phase_mod_partial(p, bid, nb, (float*)sm); phase_rope_table(p, bid, nb); }
    else if (PH == PH_PRO1) phase_mod_reduce(p, bid, nb);
    else if (PH == PH_NORM1) phase_norm1(p, l, bid, nb);
    else if (PH == PH_INPROJ) phase_inproj<false>(p, 0, 31, NCM, 66, bid, nb, (u16*)sm);
    else if (PH == PH_PREP) phase_prep(p, l, gqkv, bid, nb, (u16*)sm);
    else if (PH == PH_CHUNKA) phase_chunkA(p, l, gqkv, bid, nb, sm);
    else if (PH == PH_SCAN) {
        phase_scan(p, bid, nb, (u16*)sm);
        phase_conv_moed(p, l, bid, nb, nb > 400 ? 324 : 0, (float*)sm);
        if (l == 0) phase_conv_mixw(p, Wt2, 1, bid, nb, nb > 400 ? 324 : 0, (float*)sm);
    }
#ifdef PROBE_SPLIT
    else if (PH == PH_OUT) phase_outputs<1>(p, l, bid, nb, sm);
    else if (PH == PH_OUTC) phase_outputs<2>(p, l, bid, nb, sm);
#else
    else if (PH == PH_OUT) phase_outputs<0>(p, l, bid, nb, sm);
#endif
    else if (PH == PH_GATES) phase_inproj<true>(p, 3968, 32, NGATE, mtiles / 2, bid, nb, (u16*)sm);
    else if (PH == PH_MERGE1) phase_merge1(p, ubuf, mtiles, bid, nb, (u16*)sm);
    else if (PH == PH_MERGE2) { if (l == 0) phase_merge2s(p, l, ubuf, mtiles, bid, nb, (u16*)sm); else phase_merge2(p, l, ubuf, mtiles, bid, nb, (u16*)sm); }
    else if (PH == PH_ROUTER) {
        const int role = __builtin_amdgcn_readfirstlane(*(volatile __attribute__((address_space(3))) int*)(size_t)ROLE_LDS_OFF) & 1;
        for (int half = 0; half < 2; ++half) {
            if ((half ^ role) == 0) { PRB_BEGIN(110); phase_norm2_router(p, l, l == 0 ? RTOT : RLAT, bid, nb, (float*)sm); PRB_END(110); }
            else { PRB_BEGIN(111); phase_conv_moew(p, l, bid, nb, (float*)sm); PRB_END(111); }
        }
    }
    else if (PH == PH_MOEUP) phase_moe_up(p, l, bid, nb, (u16*)sm);
    else if (PH == PH_MOEDOWN) phase_moe_down(p, l, bid, nb, (u16*)sm);
    else if (PH == PH_FINAL) phase_final_norm(p, bid, nb);
}

#if MULTI
template <int PH>
__global__ void __launch_bounds__(NTHR, 2) k_phase(KArgs p, int l) {
    extern __shared__ __attribute__((aligned(16))) unsigned char smem[];
    run_phase<PH>(p, l, blockIdx.x, gridDim.x, smem);
}
#else
__global__ void __launch_bounds__(NTHR, 2) k_mega(KArgs p) {
    extern __shared__ __attribute__((aligned(16))) unsigned char smem[];
    volatile LAS unsigned* xbw = (volatile LAS unsigned*)(smem + LDS_BYTES);
    if (tidx() == 0) { xbw[0] = 0u; xbw[1] = 0u; xbw[2] = 0u; xbw[3] = 0u; }
    __syncthreads();
    (void)xcd_barrier_post((unsigned*)(p.ws + WSO.bar), xbw);
    if (tidx() == 0) {
        const unsigned hw = (unsigned)__builtin_amdgcn_s_getreg((31 << 11) | 4);
        const unsigned key = ((xb_xcc_id() & 15u) << 8) | ((hw >> 8) & 0xffu);
        *(volatile LAS int*)(smem + ROLE_LDS_OFF) = atomicAdd((int*)(launder_p(p.ws) + WSO.cuslot) + key, 1);
    }
    __syncthreads();
    const int bid = blockIdx.x, nb = gridDim.x;
#ifdef PROBE_SEL
    unsigned long long pr_t0 = wall_clock64();
    volatile LAS unsigned long long* pr_acc = (volatile LAS unsigned long long*)(smem + LDS_BYTES + 8);
#ifdef PROBE_CLK
    unsigned long long pr_c0 = __builtin_readcyclecounter();
#define PSTAMP(PH) do { const unsigned long long c_ = __builtin_readcyclecounter(); if ((PH) == PROBE_SEL && threadIdx.x == 0) *pr_acc = *pr_acc + (c_ - pr_c0) / 24ull; pr_c0 = c_; } while (0)
#else
#define PSTAMP(PH) do { const unsigned long long t_ = wall_clock64(); if ((PH) == PROBE_SEL && threadIdx.x == 0) *pr_acc = *pr_acc + (t_ - pr_t0); pr_t0 = t_; } while (0)
#endif
#else
#define PSTAMP(PH) do { } while (0)
#endif
#ifdef PROBE_2BAR
#define GBAR() do { GBAR1(); GBAR1(); } while (0)
#else
#define GBAR() GBAR1()
#endif
#define GBAR1() do { XcdBarrier b_; b_.bar = (unsigned*)(launder_p(p.ws) + WSO.bar); b_.x = xb_xcc_id(); b_.st = (volatile LAS unsigned*)(smem + LDS_BYTES); xcd_barrier(b_); } while (0)
    run_phase<PH_PRO0>(p, 0, bid, nb, smem); GBAR(); PSTAMP(PH_PRO0);
    run_phase<PH_PRO1>(p, 0, bid, nb, smem); GBAR(); PSTAMP(PH_PRO1);
    for (int l = 0; l < 2; ++l) {
        run_phase<PH_NORM1>(p, l, bid, nb, smem); GBAR(); PSTAMP(PH_NORM1);
        run_phase<PH_INPROJ>(p, l, bid, nb, smem); GBAR(); PSTAMP(PH_INPROJ);
#ifdef PROBE_GEMM
        { PRB_BEGIN(200); P pp = build_P(p); if (l == 1) pp.Wt = (u16*)(launder_p(p.ws) + WSO.Wt2); phase_inproj<false, PROBE_GEMM>(pp, 0, 31, NCM, 66, launder_s(bid), launder_s(nb), (u16*)smem); PRB_END(200); } GBAR();
#endif
        run_phase<PH_PREP>(p, l, bid, nb, smem); GBAR(); PSTAMP(PH_PREP);
        run_phase<PH_CHUNKA>(p, l, bid, nb, smem); GBAR(); PSTAMP(PH_CHUNKA);
        run_phase<PH_SCAN>(p, l, bid, nb, smem); GBAR(); PSTAMP(PH_SCAN);
        run_phase<PH_OUT>(p, l, bid, nb, smem); GBAR(); PSTAMP(PH_OUT);
#ifdef PROBE_SPLIT
        run_phase<PH_OUTC>(p, l, bid, nb, smem); GBAR(); PSTAMP(PH_OUTC);
#endif
        run_phase<PH_GATES>(p, l, bid, nb, smem); GBAR(); PSTAMP(PH_GATES);
        run_phase<PH_MERGE1>(p, l, bid, nb, smem); GBAR(); PSTAMP(PH_MERGE1);
        run_phase<PH_MERGE2>(p, l, bid, nb, smem); GBAR(); PSTAMP(PH_MERGE2);
        run_phase<PH_ROUTER>(p, l, bid, nb, smem); GBAR(); PSTAMP(PH_ROUTER);
        run_phase<PH_MOEUP>(p, l, bid, nb, smem); GBAR(); PSTAMP(PH_MOEUP);
        run_phase<PH_MOEDOWN>(p, l, bid, nb, smem); GBAR(); PSTAMP(PH_MOEDOWN);
    }
    run_phase<PH_FINAL>(p, 0, bid, nb, smem); PSTAMP(PH_FINAL);
#ifdef PROBE_SEL
    __syncthreads();
    { const unsigned long long te = wall_clock64(), wt = *pr_acc * 4ull; while (wall_clock64() - te < wt) __builtin_amdgcn_s_sleep(8); }
#endif
}
#endif

static size_t al256(size_t x) { return (x + 255) & ~(size_t)255; }

extern "C" void kernel_launch(void* const* d_in, const int* in_sizes, int n_in, void* d_out, int out_size, void* d_ws, size_t ws_size,
                              hipStream_t stream) {
    (void)in_sizes; (void)n_in; (void)out_size;
    if (ws_size < WSO.total) return;
    KArgs p{};
    for (int i = 0; i < 25; ++i) p.in[i] = (const float*)d_in[i];
    p.out = (float*)d_out;
    p.ws = (unsigned char*)d_ws;
    unsigned char* ws = (unsigned char*)d_ws;
    const size_t zero_bytes = WSO.zero_end;
    hipMemsetAsync(ws, 0, zero_bytes, stream);

    static int grid = 0;
#if MULTI
#define SETUP(PH) hipFuncSetAttribute((const void*)k_phase<PH>, hipFuncAttributeMaxDynamicSharedMemorySize, LDS_BYTES + 32)
    if (!grid) {
        SETUP(PH_PRO0); SETUP(PH_PRO1); SETUP(PH_NORM1); SETUP(PH_INPROJ); SETUP(PH_PREP); SETUP(PH_CHUNKA); SETUP(PH_SCAN); SETUP(PH_OUT);
        SETUP(PH_GATES); SETUP(PH_MERGE1); SETUP(PH_MERGE2); SETUP(PH_ROUTER); SETUP(PH_MOEUP); SETUP(PH_MOEDOWN); SETUP(PH_FINAL);
        grid = 512;
    }
#define LAUNCH(PH, l) k_phase<PH><<<grid, NTHR, LDS_BYTES + 32, stream>>>(p, l)
    LAUNCH(PH_PRO0, 0); LAUNCH(PH_PRO1, 0);
    for (int l = 0; l < 2; ++l) {
        LAUNCH(PH_NORM1, l);
#if STAGE >= 1
        LAUNCH(PH_INPROJ, l); LAUNCH(PH_PREP, l); LAUNCH(PH_CHUNKA, l); LAUNCH(PH_SCAN, l); LAUNCH(PH_OUT, l);
        LAUNCH(PH_GATES, l); LAUNCH(PH_MERGE1, l); LAUNCH(PH_MERGE2, l);
#endif
        LAUNCH(PH_ROUTER, l); LAUNCH(PH_MOEUP, l); LAUNCH(PH_MOEDOWN, l);
    }
    LAUNCH(PH_FINAL, 0);
#else
    if (!grid) {
        hipFuncSetAttribute((const void*)k_mega, hipFuncAttributeMaxDynamicSharedMemorySize, LDS_BYTES + 32);
        int dev = 0, cus = 0, per_cu = 0;
        hipGetDevice(&dev);
        hipDeviceGetAttribute(&cus, hipDeviceAttributeMultiprocessorCount, dev);
        hipOccupancyMaxActiveBlocksPerMultiprocessor(&per_cu, (const void*)k_mega, NTHR, LDS_BYTES + 32);
        if (per_cu > 2) per_cu = 2;
        if (per_cu < 1) per_cu = 1;
        grid = cus * per_cu;
    }
    k_mega<<<grid, NTHR, LDS_BYTES + 32, stream>>>(p);
#endif
}
```
